# Optimizing an MI355X kernel written in HIP

```python
import jax
import jax.numpy as jnp
from jax import lax
import numpy as np


D_MODEL = 1024
BATCH = 16
SEQ = 2048
DEPTH = 4

HEAD_DIM = 64
RWKV_HEADS = 8
RWKV_DIM = RWKV_HEADS * HEAD_DIM
DECAY_LORA = 64
ICLR_LORA = 64
GATE_LORA = 128
GA_Q_HEADS = 8
GA_KV_HEADS = 2
WA_Q_HEADS = 8
WA_KV_HEADS = 2
WINDOW = 128
BLOCK = 128
GRID_W = 64
ROPE_THETA = 10000.0
D_FF = 2816
N_BRANCH = 3
NORM_EPS = 1e-6
LNX_EPS = HEAD_DIM * 1e-5
NEG_INF = -1e30

RWKV_SPLITS = (RWKV_DIM, RWKV_DIM, RWKV_DIM, DECAY_LORA, DECAY_LORA, ICLR_LORA, ICLR_LORA, GATE_LORA)
RWKV_COLS = 3 * RWKV_DIM + 2 * DECAY_LORA + 2 * ICLR_LORA + GATE_LORA
GA_COLS = (GA_Q_HEADS + 2 * GA_KV_HEADS) * HEAD_DIM
WA_COLS = (WA_Q_HEADS + 2 * WA_KV_HEADS) * HEAD_DIM
GATE_COLS = N_BRANCH * D_MODEL
IN_COLS = RWKV_COLS + GA_COLS + WA_COLS + GATE_COLS

kernel_name = 'hybrid_rwkv7_axial_gqa_swa_macaron'


def _split(t, sizes):
    return jnp.split(t, np.cumsum(sizes)[:-1].tolist(), axis=-1)


def rmsnorm(x, g):
    xf = x.astype(jnp.float32)
    y = xf * lax.rsqrt(jnp.mean(xf * xf, axis=-1, keepdims=True) + NORM_EPS)
    return (y * g.astype(jnp.float32)).astype(x.dtype)


def swiglu(h, w_up, w_down):
    gate, up = jnp.split(h @ w_up, 2, axis=-1)
    return (jax.nn.silu(gate) * up) @ w_down


def centred_shift(p):
    prev = jnp.pad(p[:, :-1], ((0, 0), (1, 0), (0, 0)))
    nxt = jnp.pad(p[:, 1:], ((0, 0), (0, 1), (0, 0)))
    return 0.5 * (prev + nxt)


def rope_angles(pos, dim):
    inv_freq = ROPE_THETA ** (-jnp.arange(0, dim, 2, dtype=jnp.float32) / dim)
    return pos.astype(jnp.float32)[:, None] * inv_freq[None, :]


def apply_rope(x, ang):
    ang = ang.reshape(ang.shape[0], *([1] * (x.ndim - 3)), ang.shape[-1])
    cos, sin = jnp.cos(ang), jnp.sin(ang)
    x1, x2 = jnp.split(x.astype(jnp.float32), 2, axis=-1)
    return jnp.concatenate([x1 * cos - x2 * sin, x2 * cos + x1 * sin], axis=-1).astype(x.dtype)


def apply_axial_rope(x, ang_row, ang_col):
    x_row, x_col = jnp.split(x, 2, axis=-1)
    return jnp.concatenate([apply_rope(x_row, ang_row), apply_rope(x_col, ang_col)], axis=-1)


def wkv_scan(r, w, k, v, a, b, reverse):
    bsz, _, nh, n = r.shape
    xs = tuple(jnp.moveaxis(t, 1, 0) for t in (r, w, k, v, a, b))

    def step(state, inp):
        r_t, w_t, k_t, v_t, a_t, b_t = inp
        sa = jnp.einsum('bhij,bhj->bhi', state, a_t)
        state = (state * w_t[:, :, None, :] + sa[..., None] * b_t[:, :, None, :]
                 + v_t[..., None] * k_t[:, :, None, :])
        return state, jnp.einsum('bhij,bhj->bhi', state, r_t)

    s0 = jnp.zeros((bsz, nh, n, n), jnp.float32)
    _, ys = lax.scan(step, s0, xs, reverse=reverse)
    return jnp.moveaxis(ys, 0, 1)


def rwkv_mixer(p, mu, w0, w2, a0, a2, g2, k_k, k_a, r_k, lnx_g, lnx_b):
    bsz, s, _ = p.shape
    p = p.astype(jnp.float32)
    p = p + mu * (centred_shift(p) - p)
    r, k, v, wl_f, wl_b, al_f, al_b, gl = _split(p, RWKV_SPLITS)
    heads = lambda t: t.reshape(bsz, s, RWKV_HEADS, HEAD_DIM)
    kk = heads(k * k_k)
    kk = kk / jnp.maximum(jnp.linalg.norm(kk, axis=-1, keepdims=True), 1e-12)
    kk = kk.reshape(bsz, s, RWKV_DIM)
    wkv = jnp.zeros((bsz, s, RWKV_HEADS, HEAD_DIM), jnp.float32)
    bonus = jnp.zeros((bsz, s, RWKV_HEADS, HEAD_DIM), jnp.float32)
    for d, (wl, al) in enumerate(((wl_f, al_f), (wl_b, al_b))):
        w_log = -jax.nn.softplus(-(w0[d] + jnp.tanh(wl) @ w2[d])) - 0.5
        decay = jnp.exp(-jnp.exp(w_log))
        a = jax.nn.sigmoid(a0[d] + al @ a2[d])
        k_d = k * (1.0 + (a - 1.0) * k_a)
        wkv = wkv + wkv_scan(heads(r), heads(decay), heads(k_d), heads(v),
                             heads(-kk), heads(kk * a), reverse=(d == 1))
        bonus = bonus + jnp.sum(heads(r) * heads(k_d) * r_k, axis=-1, keepdims=True) * heads(v)
    mean = jnp.mean(wkv, axis=-1, keepdims=True)
    var = jnp.mean(jnp.square(wkv - mean), axis=-1, keepdims=True)
    y = ((wkv - mean) * lax.rsqrt(var + LNX_EPS)).reshape(bsz, s, RWKV_DIM) * lnx_g + lnx_b
    y = y + bonus.reshape(bsz, s, RWKV_DIM)
    gate = jax.nn.sigmoid(gl) @ g2
    return y * gate


def global_attention(q, k, v):
    bsz, s, nkv, ng, hd = q.shape
    nblk = s // BLOCK
    scale = HEAD_DIM ** -0.5
    qb = jnp.moveaxis(q.reshape(bsz, nblk, BLOCK, nkv, ng, hd), 1, 0)

    def one_block(q_blk):
        sc = jnp.einsum('bqkgd,bskd->bkgqs', q_blk, k, preferred_element_type=jnp.float32) * scale
        pr = jax.nn.softmax(sc, axis=-1)
        return jnp.einsum('bkgqs,bskd->bqkgd', pr.astype(v.dtype), v)

    o = lax.map(one_block, qb)
    return jnp.moveaxis(o, 0, 1).reshape(bsz, s, nkv * ng * hd)


def window_attention(q, k, v, sink):
    bsz, s, nkv, ng, hd = q.shape
    nblk = s // BLOCK
    span = BLOCK + 2 * WINDOW
    scale = HEAD_DIM ** -0.5
    kp = jnp.pad(k, ((0, 0), (WINDOW, WINDOW), (0, 0), (0, 0)))
    vp = jnp.pad(v, ((0, 0), (WINDOW, WINDOW), (0, 0), (0, 0)))
    rel = jnp.arange(span)[None, :] - WINDOW - jnp.arange(BLOCK)[:, None]
    band = jnp.abs(rel) <= WINDOW
    sink_l = sink.astype(jnp.float32).reshape(nkv, ng)[None, :, :, None, None]

    def one_block(i):
        q_blk = lax.dynamic_slice_in_dim(q, i * BLOCK, BLOCK, axis=1)
        k_blk = lax.dynamic_slice_in_dim(kp, i * BLOCK, span, axis=1)
        v_blk = lax.dynamic_slice_in_dim(vp, i * BLOCK, span, axis=1)
        kpos = i * BLOCK - WINDOW + jnp.arange(span)
        valid = band & ((kpos >= 0) & (kpos < s))[None, :]
        sc = jnp.einsum('bqkgd,bjkd->bkgqj', q_blk, k_blk, preferred_element_type=jnp.float32) * scale
        sc = jnp.where(valid, sc, NEG_INF)
        m = jnp.maximum(jnp.max(sc, axis=-1, keepdims=True), sink_l)
        e = jnp.exp(sc - m)
        pr = e / (jnp.sum(e, axis=-1, keepdims=True) + jnp.exp(sink_l - m))
        return jnp.einsum('bkgqj,bjkd->bqkgd', pr.astype(v.dtype), v_blk)

    o = lax.map(one_block, jnp.arange(nblk))
    return jnp.moveaxis(o, 0, 1).reshape(bsz, s, nkv * ng * hd)


def setup_inputs(seed: int = 0) -> dict:
    key = jax.random.key(seed)
    ks = jax.random.split(key, 40)
    f32 = jnp.float32
    nrm = lambda kk, shape, scale: (jax.random.normal(kk, shape, f32) * scale).astype(f32)
    gain = lambda kk, shape: 1.0 + 0.02 * jax.random.normal(kk, shape, f32)
    L = DEPTH
    return {
        'x': jax.random.normal(ks[0], (BATCH, SEQ, D_MODEL), f32),
        'ffn1_norm': gain(ks[1], (L, D_MODEL)),
        'ffn1_w_up': nrm(ks[2], (L, D_MODEL, 2 * D_FF), D_MODEL ** -0.5),
        'ffn1_w_down': nrm(ks[3], (L, D_FF, D_MODEL), 0.5 * D_FF ** -0.5),
        'mix_norm': gain(ks[4], (L, D_MODEL)),
        'w_in': nrm(ks[5], (L, D_MODEL, IN_COLS), D_MODEL ** -0.5),
        'rwkv_mu': jax.random.uniform(ks[6], (L, RWKV_COLS), f32, 0.0, 1.0),
        'rwkv_w0': jax.random.uniform(ks[7], (L, 2, RWKV_DIM), f32, -6.0, -0.5),
        'rwkv_w2': nrm(ks[8], (L, 2, DECAY_LORA, RWKV_DIM), 0.1 * DECAY_LORA ** -0.5),
        'rwkv_a0': nrm(ks[9], (L, 2, RWKV_DIM), 0.1),
        'rwkv_a2': nrm(ks[10], (L, 2, ICLR_LORA, RWKV_DIM), 0.5 * ICLR_LORA ** -0.5),
        'rwkv_g2': nrm(ks[11], (L, GATE_LORA, RWKV_DIM), GATE_LORA ** -0.5),
        'rwkv_k_k': 0.85 + nrm(ks[12], (L, RWKV_DIM), 0.05),
        'rwkv_k_a': 1.0 + nrm(ks[13], (L, RWKV_DIM), 0.05),
        'rwkv_r_k': nrm(ks[14], (L, RWKV_HEADS, HEAD_DIM), 0.1),
        'rwkv_lnx_g': gain(ks[15], (L, RWKV_DIM)),
        'rwkv_lnx_b': nrm(ks[16], (L, RWKV_DIM), 0.02),
        'ga_q_norm': gain(ks[17], (L, HEAD_DIM)),
        'ga_k_norm': gain(ks[18], (L, HEAD_DIM)),
        'wa_sink': nrm(ks[19], (L, WA_Q_HEADS), 0.5),
        'w_o_rwkv': nrm(ks[20], (L, RWKV_DIM, D_MODEL), RWKV_DIM ** -0.5),
        'w_o_ga': nrm(ks[21], (L, GA_Q_HEADS * HEAD_DIM, D_MODEL), (GA_Q_HEADS * HEAD_DIM) ** -0.5),
        'w_o_wa': nrm(ks[22], (L, WA_Q_HEADS * HEAD_DIM, D_MODEL), (WA_Q_HEADS * HEAD_DIM) ** -0.5),
        'w_out': nrm(ks[23], (L, D_MODEL, D_MODEL), 0.5 * D_MODEL ** -0.5),
        'ffn2_norm': gain(ks[24], (L, D_MODEL)),
        'ffn2_w_up': nrm(ks[25], (L, D_MODEL, 2 * D_FF), D_MODEL ** -0.5),
        'ffn2_w_down': nrm(ks[26], (L, D_FF, D_MODEL), 0.5 * D_FF ** -0.5),
        'final_norm': gain(ks[27], (D_MODEL,)),
    }


def reference(x, ffn1_norm, ffn1_w_up, ffn1_w_down, mix_norm, w_in, rwkv_mu, rwkv_w0, rwkv_w2,
              rwkv_a0, rwkv_a2, rwkv_g2, rwkv_k_k, rwkv_k_a, rwkv_r_k, rwkv_lnx_g, rwkv_lnx_b,
              ga_q_norm, ga_k_norm, wa_sink, w_o_rwkv, w_o_ga, w_o_wa, w_out,
              ffn2_norm, ffn2_w_up, ffn2_w_down, final_norm):
    bsz, s, dm = x.shape
    rows = s // GRID_W
    t = jnp.arange(s)
    row = jnp.repeat(jnp.arange(rows), GRID_W)
    col = jnp.tile(jnp.arange(GRID_W), rows)
    ang_row = rope_angles(row, HEAD_DIM // 2)
    ang_col = rope_angles(col, HEAD_DIM // 2)
    ang_1d = rope_angles(t, HEAD_DIM)
    ga_g = GA_Q_HEADS // GA_KV_HEADS
    wa_g = WA_Q_HEADS // WA_KV_HEADS

    for l in range(DEPTH):
        x = x + 0.5 * swiglu(rmsnorm(x, ffn1_norm[l]), ffn1_w_up[l], ffn1_w_down[l])

        h = rmsnorm(x, mix_norm[l])
        p = h @ w_in[l]
        p_rwkv, p_ga, p_wa, p_gate = _split(p, (RWKV_COLS, GA_COLS, WA_COLS, GATE_COLS))

        y_a = rwkv_mixer(p_rwkv, rwkv_mu[l], rwkv_w0[l], rwkv_w2[l], rwkv_a0[l], rwkv_a2[l],
                         rwkv_g2[l], rwkv_k_k[l], rwkv_k_a[l], rwkv_r_k[l],
                         rwkv_lnx_g[l], rwkv_lnx_b[l]).astype(x.dtype)

        qb, kb, vb = _split(p_ga, (GA_Q_HEADS * HEAD_DIM, GA_KV_HEADS * HEAD_DIM, GA_KV_HEADS * HEAD_DIM))
        qb = qb.reshape(bsz, s, GA_KV_HEADS, ga_g, HEAD_DIM)
        kb = kb.reshape(bsz, s, GA_KV_HEADS, HEAD_DIM)
        vb = vb.reshape(bsz, s, GA_KV_HEADS, HEAD_DIM)
        qb = apply_axial_rope(rmsnorm(qb, ga_q_norm[l]), ang_row, ang_col)
        kb = apply_axial_rope(rmsnorm(kb, ga_k_norm[l]), ang_row, ang_col)
        y_b = global_attention(qb, kb, vb)

        qc, kc, vc = _split(p_wa, (WA_Q_HEADS * HEAD_DIM, WA_KV_HEADS * HEAD_DIM, WA_KV_HEADS * HEAD_DIM))
        qc = apply_rope(qc.reshape(bsz, s, WA_KV_HEADS, wa_g, HEAD_DIM), ang_1d)
        kc = apply_rope(kc.reshape(bsz, s, WA_KV_HEADS, HEAD_DIM), ang_1d)
        vc = vc.reshape(bsz, s, WA_KV_HEADS, HEAD_DIM)
        y_c = window_attention(qc, kc, vc, wa_sink[l])

        gates = jax.nn.sigmoid(p_gate).reshape(bsz, s, N_BRANCH, dm)
        merged = (gates[:, :, 0] * (y_a @ w_o_rwkv[l]) + gates[:, :, 1] * (y_b @ w_o_ga[l])
                  + gates[:, :, 2] * (y_c @ w_o_wa[l]))
        x = x + merged @ w_out[l]

        x = x + 0.5 * swiglu(rmsnorm(x, ffn2_norm[l]), ffn2_w_up[l], ffn2_w_down[l])

    return rmsnorm(x, final_norm)
```

```cpp
#include <hip/hip_runtime.h>
#include <hip/hip_cooperative_groups.h>
#include <cstdio>
#include <cstdint>
namespace cg = cooperative_groups;
namespace pg8 {
#define PG8_LAS __attribute__((address_space(3)))
typedef unsigned short bf16_t;
typedef short bf16x8 __attribute__((ext_vector_type(8)));
typedef float f32x4 __attribute__((ext_vector_type(4)));
typedef unsigned u32x4 __attribute__((ext_vector_type(4)));
constexpr int BM = 256, BK = 64, HALF = 128, HTB = HALF * BK * 2  , STAGE_BYTES = 8 * HTB, NXCD = 8, WGM = 8;

__host__ __device__ __forceinline__ int lds_byte(int r, int c) { const int st = (r >> 4) * 2 + (c >> 5), rr = r & 15, cc = c & 31, ob = rr * 64 + cc * 2; return st * 1024 + (ob ^ (((ob >> 9) & 1) << 5)); }
__host__ __device__ __forceinline__ void stage_rc(int b, int& R, int& C) { const int st = b / 1024, sb = b % 1024, swz = sb ^ (((sb >> 9) & 1) << 5); R = (st >> 1) * 16 + swz / 64; C = (st & 1) * 32 + (swz % 64) / 2; }
__host__ __device__ __forceinline__ int perm32(int rho) { const int n = rho >> 4, i = rho & 15; return 8 * (i >> 2) + 4 * n + (i & 3); }

struct Unit { int pm, pn; };
struct Gemm { const bf16_t* A; const bf16_t* Bt; int M, N, K; };

struct StaticOrder {
    int nM, nN, nwg, G, c;
    __host__ __device__ void init(int M, int N, int G_, int c_) { nM = M / BM; nN = N / BM; nwg = nM * nN; G = G_; c = c_; }
    __host__ __device__ bool next(int i, Unit& u) const {
        const long L = (long)i * G + c; if (L >= nwg) return false;
        int wgid = (int)L; { const int q = nwg / NXCD, r = nwg % NXCD, xcd = wgid % NXCD, off = wgid / NXCD; wgid = (xcd < r ? xcd * (q + 1) : r * (q + 1) + (xcd - r) * q) + off; }
        const int nig = WGM * nN, gid = wgid / nig, fm = gid * WGM, gsz = (nM - fm) < WGM ? (nM - fm) : WGM;
        u.pm = fm + ((wgid % nig) % gsz); u.pn = (wgid % nig) / gsz; return true;
    }
    __device__ __forceinline__ void a_ready(const Unit&) const {}
    __device__ __forceinline__ void done(const Unit&) const {}
};
typedef float f32x2_t __attribute__((ext_vector_type(2))); typedef __bf16 bf16x2_t __attribute__((ext_vector_type(2)));
__device__ __forceinline__ unsigned cvt_pk_bf16(float lo, float hi) { f32x2_t v = {lo, hi}; bf16x2_t b = __builtin_convertvector(v, bf16x2_t); return __builtin_bit_cast(unsigned, b); }
typedef float f32x2 __attribute__((ext_vector_type(2)));
__device__ __forceinline__ float fast_sigmoid(float x) { return __builtin_amdgcn_rcpf(1.0f + __builtin_amdgcn_exp2f(-1.4426950408889634f * x)); }
__device__ __forceinline__ u32x4 ld16_agent(const bf16_t* p) { const unsigned long long a = __hip_atomic_load((const unsigned long long*)p, __ATOMIC_RELAXED, __HIP_MEMORY_SCOPE_AGENT), b = __hip_atomic_load((const unsigned long long*)p + 1, __ATOMIC_RELAXED, __HIP_MEMORY_SCOPE_AGENT); u32x4 r; r.x = (unsigned)a; r.y = (unsigned)(a >> 32); r.z = (unsigned)b; r.w = (unsigned)(b >> 32); return r; }
__device__ __forceinline__ float bf_lo(unsigned w) { return __uint_as_float(w << 16); }
__device__ __forceinline__ float bf_hi(unsigned w) { return __uint_as_float(w & 0xffff0000u); }

struct EpiSwiglu {
    static constexpr bool PERM = true, AFTER_DRAIN = false;
    bf16_t* O; int ldc;
    __device__ __forceinline__ void operator()(const f32x4 (&acc)[2][2][4][2], const Unit& u, int wr, int wc, int fr, int fq) const {
        const int row0 = u.pm * BM + wr * 64 + fr, col0 = u.pn * HALF + wc * 32 + 8 * fq;
#pragma unroll
        for (int ai = 0; ai < 2; ++ai)
#pragma unroll
            for (int m = 0; m < 4; ++m) {
                bf16_t* rowp = O + (size_t)(row0 + ai * HALF + m * 16) * ldc + col0;
                float v[8];
#pragma unroll
                for (int n = 0; n < 2; ++n)
#pragma unroll
                    for (int j = 0; j < 4; ++j) { const float g = acc[ai][0][m][n][j], up = acc[ai][1][m][n][j]; v[n * 4 + j] = g * fast_sigmoid(g) * up; }
                u32x4 w; w.x = cvt_pk_bf16(v[0], v[1]); w.y = cvt_pk_bf16(v[2], v[3]); w.z = cvt_pk_bf16(v[4], v[5]); w.w = cvt_pk_bf16(v[6], v[7]);
                *(u32x4*)rowp = w;
            }
    }
};
struct EpiResid {
    static constexpr bool PERM = false, AFTER_DRAIN = false;
    const float* src; float* dst; int ldc; float scale;
    __device__ __forceinline__ void operator()(const f32x4 (&acc)[2][2][4][2], const Unit& u, int wr, int wc, int fr, int fq) const {
        const int col0 = u.pn * BM + wc * 32 + 4 * fq;
#pragma unroll
        for (int ai = 0; ai < 2; ++ai)
#pragma unroll
            for (int m = 0; m < 4; ++m) {
                const size_t off = (size_t)(u.pm * BM + ai * HALF + wr * 64 + m * 16 + fr) * ldc + col0;
#pragma unroll
                for (int bj = 0; bj < 2; ++bj)
#pragma unroll
                    for (int n = 0; n < 2; ++n) { const f32x4 b = *(const f32x4*)(src + off + bj * HALF + n * 16); *(f32x4*)(dst + off + bj * HALF + n * 16) = b + acc[ai][bj][m][n] * scale; }
            }
    }
};
struct EpiWin {
    static constexpr bool PERM = true, AFTER_DRAIN = false;
    bf16_t *PR, *QB, *KVB, *QC, *KVC;
    __device__ __forceinline__ void operator()(const f32x4 (&acc)[2][2][4][2], const Unit& u, int wr, int wc, int fr, int fq) const {
        bf16_t* base; int ldc, colt;
        const int pn = u.pn;
        if (pn < 8) { base = PR; ldc = 2048; colt = pn * 256; }
        else if (pn < 10) { base = QB; ldc = 512; colt = (pn - 8) * 256; }
        else if (pn == 10) { base = KVB; ldc = 256; colt = 0; }
        else if (pn < 13) { base = QC; ldc = 512; colt = (pn - 11) * 256; }
        else { base = KVC; ldc = 256; colt = 0; }
        const int row0 = u.pm * BM + wr * 64 + fr, col0 = colt + wc * 32 + 8 * fq;
#pragma unroll
        for (int ai = 0; ai < 2; ++ai)
#pragma unroll
            for (int m = 0; m < 4; ++m) {
                bf16_t* rowp = base + (size_t)(row0 + ai * HALF + m * 16) * ldc + col0;
#pragma unroll
                for (int bj = 0; bj < 2; ++bj) { const f32x4 v0 = acc[ai][bj][m][0], v1 = acc[ai][bj][m][1];
                    u32x4 w; w.x = cvt_pk_bf16(v0[0], v0[1]); w.y = cvt_pk_bf16(v0[2], v0[3]); w.z = cvt_pk_bf16(v1[0], v1[1]); w.w = cvt_pk_bf16(v1[2], v1[3]);
                    *(u32x4*)(rowp + bj * HALF) = w; }
            }
    }
};
struct EpiGate {
    static constexpr bool PERM = true, AFTER_DRAIN = false;
    bf16_t* G;
    __device__ __forceinline__ void operator()(const f32x4 (&acc)[2][2][4][2], const Unit& u, int wr, int wc, int fr, int fq) const {
        const int row0 = u.pm * BM + wr * 64 + fr, col0 = u.pn * BM + wc * 32 + 8 * fq;
#pragma unroll
        for (int ai = 0; ai < 2; ++ai)
#pragma unroll
            for (int m = 0; m < 4; ++m) {
                bf16_t* rowp = G + (size_t)(row0 + ai * HALF + m * 16) * 1024 + col0;
#pragma unroll
                for (int bj = 0; bj < 2; ++bj) { const f32x4 v0 = acc[ai][bj][m][0], v1 = acc[ai][bj][m][1];
                    u32x4 w; w.x = cvt_pk_bf16(fast_sigmoid(v0[0]), fast_sigmoid(v0[1])); w.y = cvt_pk_bf16(fast_sigmoid(v0[2]), fast_sigmoid(v0[3]));
                    w.z = cvt_pk_bf16(fast_sigmoid(v1[0]), fast_sigmoid(v1[1])); w.w = cvt_pk_bf16(fast_sigmoid(v1[2]), fast_sigmoid(v1[3]));
#ifdef DBG_GCONST
                    w = (u32x4){0x3f003f00u, 0x3f003f00u, 0x3f003f00u, 0x3f003f00u};
#endif
                    *(u32x4*)(rowp + bj * HALF) = w; }
            }
    }
};
struct EpiMerge {
    static constexpr bool PERM = true, AFTER_DRAIN = false;
    const bf16_t* G; bf16_t* Mg; int first;
    __device__ __forceinline__ void operator()(const f32x4 (&acc)[2][2][4][2], const Unit& u, int wr, int wc, int fr, int fq) const {
        const int row0 = u.pm * BM + wr * 64 + fr, col0 = u.pn * BM + wc * 32 + 8 * fq;
#pragma unroll
        for (int ai = 0; ai < 2; ++ai)
#pragma unroll
            for (int m = 0; m < 4; ++m) {
                const size_t off = (size_t)(row0 + ai * HALF + m * 16) * 1024 + col0;
#pragma unroll
                for (int bj = 0; bj < 2; ++bj) { const f32x4 v0 = acc[ai][bj][m][0], v1 = acc[ai][bj][m][1];
#ifdef DBG_NOG
                    const u32x4 g = (u32x4){0x3f803f80u, 0x3f803f80u, 0x3f803f80u, 0x3f803f80u};
#else
                    const u32x4 g = *(const u32x4*)(G + off + bj * HALF);
#endif
                    float r[8];
                    r[0] = bf_lo(g.x) * v0[0]; r[1] = bf_hi(g.x) * v0[1]; r[2] = bf_lo(g.y) * v0[2]; r[3] = bf_hi(g.y) * v0[3];
                    r[4] = bf_lo(g.z) * v1[0]; r[5] = bf_hi(g.z) * v1[1]; r[6] = bf_lo(g.w) * v1[2]; r[7] = bf_hi(g.w) * v1[3];
#ifdef DBG_NOG
                    if (false) { const u32x4 p = *(const u32x4*)(Mg + off + bj * HALF);
#else
                    if (!first) { const u32x4 p = *(const u32x4*)(Mg + off + bj * HALF);
#endif
                        r[0] += bf_lo(p.x); r[1] += bf_hi(p.x); r[2] += bf_lo(p.y); r[3] += bf_hi(p.y); r[4] += bf_lo(p.z); r[5] += bf_hi(p.z); r[6] += bf_lo(p.w); r[7] += bf_hi(p.w); }
                    u32x4 w; w.x = cvt_pk_bf16(r[0], r[1]); w.y = cvt_pk_bf16(r[2], r[3]); w.z = cvt_pk_bf16(r[4], r[5]); w.w = cvt_pk_bf16(r[6], r[7]);
                    *(u32x4*)(Mg + off + bj * HALF) = w; }
            }
    }
};
template <class Epi, class Sched, bool ALIGN_EPI = false, bool SP2 = false>
__device__ __forceinline__ void gemm_phase(PG8_LAS unsigned char* lds, const Gemm g, const Sched& S, const Epi& E) {
    int tid_o = threadIdx.x; asm volatile("" : "+v"(tid_o));
    const int tid = tid_o, wid = __builtin_amdgcn_readfirstlane(tid >> 6), lane = tid & 63, wr = wid >> 2, wc = wid & 3, fr = lane & 15, fq = lane >> 4;
    const int K = g.K, nt = K / BK;
    unsigned voffA[2], voffB[2];
#pragma unroll
    for (int i = 0; i < 2; ++i) { int R, C; stage_rc(tid * 16 + i * 8192, R, C); const int Rb = Epi::PERM ? ((R & ~31) + perm32(R & 31)) : R;
        voffA[i] = (unsigned)(R * K + C) * 2u; voffB[i] = (unsigned)(Rb * K + C) * 2u; }
    const size_t kstep = (size_t)(BK * 2);
    const size_t hstep = (size_t)HALF * K * 2;
    const size_t tstep = 2 * hstep;
    const unsigned ldsw = (unsigned)wid * 1024u;
    const int aoff = lds_byte(wr * 64 + fr, fq * 8), boff = lds_byte(wc * 32 + fr, fq * 8);
#define PG8_SA(b, h) (((b) * 2 + (h)) * HTB)
#define PG8_SB(b, h) ((4 + (b) * 2 + (h)) * HTB)
#define PG8_STAGE(bufoff, gbase, voff) do { _Pragma("unroll") for (int _i = 0; _i < 2; ++_i) \
        __builtin_amdgcn_global_load_lds((const unsigned*)((const char*)(gbase) + (voff)[_i]), (PG8_LAS unsigned*)(lds + (bufoff) + ldsw + _i * 8192), 16, 0, 0); } while (0)
#define PG8_LDA(dst, b, h) do { _Pragma("unroll") for (int m = 0; m < 4; ++m) _Pragma("unroll") for (int k = 0; k < 2; ++k) dst[m][k] = *(const PG8_LAS bf16x8*)(lds + PG8_SA(b, h) + aoff + m * 2048 + k * 1024); } while (0)
#define PG8_LDB(dst, b, h) do { _Pragma("unroll") for (int n = 0; n < 2; ++n) _Pragma("unroll") for (int k = 0; k < 2; ++k) dst[n][k] = *(const PG8_LAS bf16x8*)(lds + PG8_SB(b, h) + boff + n * 2048 + k * 1024); } while (0)
#define PG8_MMA(ai, bj, At, Bt) do { __builtin_amdgcn_s_setprio(1); _Pragma("unroll") for (int m = 0; m < 4; ++m) _Pragma("unroll") for (int n = 0; n < 2; ++n) _Pragma("unroll") for (int k = 0; k < 2; ++k) \
        acc[ai][bj][m][n] = __builtin_amdgcn_mfma_f32_16x16x32_bf16(Bt[n][k], At[m][k], acc[ai][bj][m][n], 0, 0, 0); __builtin_amdgcn_s_setprio(0); } while (0)
#define PG8_WAIT_V(n) asm volatile("s_waitcnt vmcnt(" #n ")" ::: "memory")
#define PG8_WAIT_L(n) asm volatile("s_waitcnt lgkmcnt(" #n ")" ::: "memory")
#define PG8_BAR __builtin_amdgcn_s_barrier()
#define PG8_SCHED __builtin_amdgcn_sched_barrier(0)
    Unit cur, nxt; int ui = 0;
    if (!S.next(0, cur)) return;
    f32x4 acc[2][2][4][2];
#pragma unroll
    for (int a = 0; a < 2; ++a)
#pragma unroll
        for (int b = 0; b < 2; ++b)
#pragma unroll
            for (int m = 0; m < 4; ++m)
#pragma unroll
                for (int n = 0; n < 2; ++n) acc[a][b][m][n] = (f32x4){0.f, 0.f, 0.f, 0.f};
    bf16x8 At[4][2], B0[2][2], B1[2][2];
    const char* cA = (const char*)g.A + (size_t)cur.pm * tstep; const char* cB = (const char*)g.Bt + (size_t)cur.pn * tstep;
    S.a_ready(cur);
    if constexpr (SP2) {
        PG8_STAGE(PG8_SB(0, 0), cB, voffB); PG8_STAGE(PG8_SB(0, 1), cB + hstep, voffB); PG8_STAGE(PG8_SA(0, 0), cA, voffA); PG8_STAGE(PG8_SA(0, 1), cA + hstep, voffA);
        if (wr == 1) PG8_BAR;
        PG8_WAIT_V(2); PG8_BAR;
        PG8_STAGE(PG8_SB(1, 0), cB + kstep, voffB); PG8_STAGE(PG8_SA(1, 0), cA + kstep, voffA); PG8_STAGE(PG8_SB(1, 1), cB + hstep + kstep, voffB);
        PG8_WAIT_V(6); PG8_BAR;
    } else {
        PG8_STAGE(PG8_SB(0, 0), cB, voffB); PG8_STAGE(PG8_SA(0, 0), cA, voffA); PG8_STAGE(PG8_SB(0, 1), cB + hstep, voffB); PG8_STAGE(PG8_SA(0, 1), cA + hstep, voffA);
        if (wr == 1) PG8_BAR;
        PG8_WAIT_V(4); PG8_BAR;
        PG8_STAGE(PG8_SB(1, 0), cB + kstep, voffB); PG8_STAGE(PG8_SA(1, 0), cA + kstep, voffA); PG8_STAGE(PG8_SB(1, 1), cB + hstep + kstep, voffB);
        PG8_WAIT_V(6); PG8_BAR;
    }
    for (;;) {
        const bool has_next = S.next(ui + 1, nxt);
        const char* nA = has_next ? (const char*)g.A + (size_t)nxt.pm * tstep : cA; const char* nB = has_next ? (const char*)g.Bt + (size_t)nxt.pn * tstep : cB;
        for (int t = 0; t < nt; t += 2) {
            const bool last = (t == nt - 2);
            const char* a1 = cA + (size_t)(t + 1) * kstep;
            const char* a2 = last ? nA : cA + (size_t)(t + 2) * kstep; const char* b2 = last ? nB : cB + (size_t)(t + 2) * kstep;
            const char* a3 = a2 + kstep; const char* b3 = b2 + kstep;
            if (last && has_next) S.a_ready(nxt);
            if constexpr (SP2) {
            PG8_LDB(B0, 0, 0); PG8_LDB(B1, 0, 1); PG8_SCHED; PG8_LDA(At, 0, 0); PG8_STAGE(PG8_SA(1, 1), a1 + hstep, voffA);
            PG8_WAIT_V(8); PG8_WAIT_L(0); PG8_BAR; PG8_MMA(0, 0, At, B0); PG8_MMA(0, 1, At, B1); PG8_BAR; PG8_SCHED;
            PG8_LDA(At, 0, 1); PG8_STAGE(PG8_SB(0, 0), b2, voffB); PG8_STAGE(PG8_SB(0, 1), b2 + hstep, voffB); PG8_STAGE(PG8_SA(0, 0), a2, voffA);
            PG8_WAIT_V(8); PG8_WAIT_L(0); PG8_BAR; PG8_MMA(1, 0, At, B0); PG8_MMA(1, 1, At, B1); PG8_BAR; PG8_SCHED;
            PG8_LDB(B0, 1, 0); PG8_LDB(B1, 1, 1); PG8_SCHED; PG8_LDA(At, 1, 0); PG8_STAGE(PG8_SA(0, 1), a2 + hstep, voffA);
            PG8_WAIT_V(8); PG8_WAIT_L(0); PG8_BAR; PG8_MMA(0, 0, At, B0); PG8_MMA(0, 1, At, B1); PG8_BAR; PG8_SCHED;
            PG8_LDA(At, 1, 1); PG8_STAGE(PG8_SB(1, 0), b3, voffB); PG8_STAGE(PG8_SB(1, 1), b3 + hstep, voffB); PG8_STAGE(PG8_SA(1, 0), a3, voffA);
            PG8_WAIT_V(8); PG8_WAIT_L(0); PG8_BAR; PG8_MMA(1, 0, At, B0); PG8_MMA(1, 1, At, B1); PG8_BAR; PG8_SCHED;
            } else {
            PG8_LDB(B0, 0, 0); PG8_SCHED; PG8_LDA(At, 0, 0); PG8_STAGE(PG8_SA(1, 1), a1 + hstep, voffA);
            PG8_WAIT_L(8); PG8_BAR; PG8_WAIT_L(0); PG8_MMA(0, 0, At, B0); PG8_BAR; PG8_SCHED;
            PG8_LDB(B1, 0, 1); PG8_STAGE(PG8_SB(0, 0), b2, voffB);
            PG8_BAR; PG8_WAIT_L(0); PG8_MMA(0, 1, At, B1); PG8_BAR;
            PG8_LDA(At, 0, 1); PG8_STAGE(PG8_SA(0, 0), a2, voffA);
            PG8_BAR; PG8_WAIT_L(0); PG8_MMA(1, 0, At, B0); PG8_BAR; PG8_SCHED;
            PG8_STAGE(PG8_SB(0, 1), b2 + hstep, voffB);
            PG8_WAIT_V(6); PG8_BAR; PG8_MMA(1, 1, At, B1); PG8_BAR;
            PG8_LDB(B0, 1, 0); PG8_SCHED; PG8_LDA(At, 1, 0); PG8_STAGE(PG8_SA(0, 1), a2 + hstep, voffA);
            PG8_WAIT_L(8); PG8_BAR; PG8_WAIT_L(0); PG8_MMA(0, 0, At, B0); PG8_BAR; PG8_SCHED;
            PG8_LDB(B1, 1, 1); PG8_STAGE(PG8_SB(1, 0), b3, voffB);
            PG8_BAR; PG8_WAIT_L(0); PG8_MMA(0, 1, At, B1); PG8_BAR;
            PG8_LDA(At, 1, 1); PG8_STAGE(PG8_SA(1, 0), a3, voffA);
            PG8_BAR; PG8_WAIT_L(0); PG8_MMA(1, 0, At, B0); PG8_BAR; PG8_SCHED;
            PG8_STAGE(PG8_SB(1, 1), b3 + hstep, voffB);
            PG8_WAIT_V(6); PG8_BAR; PG8_MMA(1, 1, At, B1); PG8_BAR;
            }
        }
        if constexpr (ALIGN_EPI) { if (wr == 0) PG8_BAR; }
        if constexpr (!Epi::AFTER_DRAIN) { E(acc, cur, wr, wc, fr, fq); S.done(cur); }
        if (!has_next) break;
#pragma unroll
        for (int a = 0; a < 2; ++a)
#pragma unroll
            for (int b = 0; b < 2; ++b)
#pragma unroll
                for (int m = 0; m < 4; ++m)
#pragma unroll
                    for (int n = 0; n < 2; ++n) acc[a][b][m][n] = (f32x4){0.f, 0.f, 0.f, 0.f};
        cur = nxt; cA = nA; cB = nB; ++ui;
        if constexpr (ALIGN_EPI) { if (wr == 1) PG8_BAR; }
    }
    PG8_WAIT_V(0);
    if constexpr (!ALIGN_EPI) { if (wr == 0) PG8_BAR; }
    PG8_BAR;
    if constexpr (Epi::AFTER_DRAIN) { E.fused(acc, cur, wr, wc, fr, fq, lds, wid, lane); S.done(cur); }
#undef PG8_SA
#undef PG8_SB
#undef PG8_STAGE
#undef PG8_LDA
#undef PG8_LDB
#undef PG8_MMA
#undef PG8_WAIT_V
#undef PG8_WAIT_L
#undef PG8_BAR
#undef PG8_SCHED
}
}
#define LAS __attribute__((address_space(3)))
typedef unsigned short bf16;
typedef unsigned v4u __attribute__((ext_vector_type(4)));
typedef unsigned v2u __attribute__((ext_vector_type(2)));
typedef float f4 __attribute__((ext_vector_type(4)));
constexpr int T_ = 32768, S_ = 2048, NB = 16, DM = 1024, FF = 2816, NL = 4;
constexpr int NWAVES = 8, NTHREADS = 512;
constexpr int LDS_BYTES = 147456;
constexpr float LOG2E = 1.4426950408889634f;
constexpr float C2 = 0.125f * LOG2E;
constexpr float LOG2_THETA = 13.287712379549449f;

enum { I_X = 0, I_F1N, I_F1UP, I_F1DN, I_MIXN, I_WIN, I_MU, I_W0, I_W2, I_A0, I_A2, I_G2, I_KK, I_KA, I_RK, I_LNG, I_LNB, I_QN, I_KN, I_SINK,
       I_WOA, I_WOB, I_WOC, I_WOUT, I_F2N, I_F2UP, I_F2DN, I_FINN, N_IN };

constexpr size_t SZ_WUP = (size_t)2 * FF * DM * 2, SZ_WDN = (size_t)DM * FF * 2, SZ_WIN = (size_t)3584 * DM * 2, SZ_WG = (size_t)3072 * DM * 2,
                 SZ_WO = (size_t)3 * DM * 512 * 2, SZ_WOUT = (size_t)DM * DM * 2;
constexpr size_t WS_WUP1 = 0, WS_WDN1 = WS_WUP1 + SZ_WUP, WS_WIN = WS_WDN1 + SZ_WDN, WS_WG = WS_WIN + SZ_WIN, WS_WO = WS_WG + SZ_WG, WS_WOUT = WS_WO + SZ_WO,
                 WS_WUP2 = WS_WOUT + SZ_WOUT, WS_WDN2 = WS_WUP2 + SZ_WUP, WS_H = WS_WDN2 + SZ_WDN;
constexpr size_t WS_R = WS_H + (size_t)T_ * DM * 2;
constexpr size_t WS_ACT = WS_R;
constexpr size_t WS_PR = WS_R, WS_QB = WS_PR + (size_t)T_ * 2048 * 2, WS_KVB = WS_QB + (size_t)T_ * 512 * 2, WS_QC = WS_KVB + (size_t)T_ * 256 * 2, WS_KVC = WS_QC + (size_t)T_ * 512 * 2,
                 WS_KG = WS_KVC + (size_t)T_ * 256 * 2, WS_VG = WS_KG + (size_t)NB * 2 * S_ * 64 * 2, WS_KW = WS_VG + (size_t)NB * 2 * S_ * 64 * 2, WS_VW = WS_KW + (size_t)NB * 2 * S_ * 64 * 2,
                 WS_YA = WS_VW + (size_t)NB * 2 * S_ * 64 * 2, WS_WKVF = WS_YA + (size_t)T_ * 512 * 2, WS_WKVB = WS_WKVF + (size_t)T_ * 512 * 2, WS_BONUS = WS_WKVB + (size_t)T_ * 512 * 2,
                 WS_END = WS_BONUS + (size_t)T_ * 16 * 4;
#ifdef DBG_GATE_ALT
constexpr size_t WS_GATE = WS_WKVF, WS_MERGED = WS_PR + (size_t)T_ * DM * 2;
#else
constexpr size_t WS_GATE = WS_PR, WS_MERGED = WS_PR + (size_t)T_ * DM * 2;
#endif
static_assert(WS_ACT + (size_t)T_ * FF * 2 <= WS_END, "map");
static_assert(WS_END < 520000000ull, "workspace budget");

struct Params { const float* in[N_IN]; float* out; unsigned char* ws; };

__device__ __forceinline__ unsigned f2bf(float f) { unsigned u = __float_as_uint(f); return (u + 0x7fffu + ((u >> 16) & 1u)) >> 16; }
__device__ __forceinline__ unsigned pk2(float lo, float hi) { return f2bf(lo) | (f2bf(hi) << 16); }
__device__ __forceinline__ float bf2f(bf16 h) { return __uint_as_float((unsigned)h << 16); }
__device__ __forceinline__ int opaque_tid() { int t = threadIdx.x; asm volatile("" : "+v"(t)); return t; }
#define STAGE_IDS const int tid = opaque_tid(), lane = tid & 63, wave = __builtin_amdgcn_readfirstlane(tid >> 6); const int gw = blockIdx.x * NWAVES + wave, ngw = gridDim.x * NWAVES, gtid = blockIdx.x * NTHREADS + tid, gthreads = gridDim.x * NTHREADS; (void)lane; (void)gw; (void)ngw; (void)gtid; (void)gthreads;
__device__ __forceinline__ float wave_sum(float v) {
#pragma unroll
    for (int o = 1; o < 64; o <<= 1) v += __shfl_xor(v, o);
    return v;
}

__device__ __forceinline__ void cvt_wt(const float* W, int K, int ld, bf16* Wt, int nrows, int mode, int gw, int ngw, int lane, float* scr) {
    const int nblk = nrows >> 5, nitems = (K >> 6) * nblk;
    for (int it = gw; it < nitems; it += ngw) {
        const int kb = it / nblk, nb = it % nblk, k0 = kb * 64, n0 = nb * 32;
        int col0;
        if (mode == 0) col0 = n0;
        else if (mode == 1) { const int t = n0 >> 8, r = n0 & 255; col0 = (r < 128) ? t * 128 + r : FF + t * 128 + (r - 128); }
        else if (mode == 2) col0 = n0 < 1920 ? n0 : (n0 < 2048 ? -1 : n0 - 128);
        else col0 = 3456 + n0;
        if (col0 >= 0) {
#pragma unroll 8
            for (int i = 0; i < 32; ++i) { const int kk = 2 * i + (lane >> 5); scr[kk * 33 + (lane & 31)] = W[(size_t)(k0 + kk) * ld + col0 + (lane & 31)]; }
        }
        asm volatile("s_waitcnt lgkmcnt(0)" ::: "memory");
        const int c = lane & 7;
#pragma unroll
        for (int j = 0; j < 4; ++j) { const int n = (lane >> 3) + 8 * j; const float* sp = scr + (8 * c) * 33 + n;
            v4u o = (v4u){0u, 0u, 0u, 0u};
            if (col0 >= 0) { o.x = pk2(sp[0 * 33], sp[1 * 33]); o.y = pk2(sp[2 * 33], sp[3 * 33]); o.z = pk2(sp[4 * 33], sp[5 * 33]); o.w = pk2(sp[6 * 33], sp[7 * 33]); }
            *(v4u*)(Wt + (size_t)(n0 + n) * K + k0 + 8 * c) = o; }
        asm volatile("s_waitcnt lgkmcnt(0)" ::: "memory");
    }
}
__device__ __forceinline__ void cvt_layer(const Params& P, int l, unsigned char* ldsg) {
    STAGE_IDS
    unsigned char* ws = P.ws; float* scr = (float*)(ldsg + wave * 8448);
    cvt_wt(P.in[I_F1UP] + (size_t)l * DM * 2 * FF, DM, 2 * FF, (bf16*)(ws + WS_WUP1), 2 * FF, 1, gw, ngw, lane, scr);
    cvt_wt(P.in[I_F1DN] + (size_t)l * FF * DM, FF, DM, (bf16*)(ws + WS_WDN1), DM, 0, gw, ngw, lane, scr);
    cvt_wt(P.in[I_WIN] + (size_t)l * DM * 6528, DM, 6528, (bf16*)(ws + WS_WIN), 3584, 2, gw, ngw, lane, scr);
    cvt_wt(P.in[I_WIN] + (size_t)l * DM * 6528, DM, 6528, (bf16*)(ws + WS_WG), 3072, 3, gw, ngw, lane, scr);
    cvt_wt(P.in[I_WOA] + (size_t)l * 512 * DM, 512, DM, (bf16*)(ws + WS_WO), DM, 0, gw, ngw, lane, scr);
    cvt_wt(P.in[I_WOB] + (size_t)l * 512 * DM, 512, DM, (bf16*)(ws + WS_WO) + (size_t)DM * 512, DM, 0, gw, ngw, lane, scr);
    cvt_wt(P.in[I_WOC] + (size_t)l * 512 * DM, 512, DM, (bf16*)(ws + WS_WO) + (size_t)2 * DM * 512, DM, 0, gw, ngw, lane, scr);
    cvt_wt(P.in[I_WOUT] + (size_t)l * DM * DM, DM, DM, (bf16*)(ws + WS_WOUT), DM, 0, gw, ngw, lane, scr);
    cvt_wt(P.in[I_F2UP] + (size_t)l * DM * 2 * FF, DM, 2 * FF, (bf16*)(ws + WS_WUP2), 2 * FF, 1, gw, ngw, lane, scr);
    cvt_wt(P.in[I_F2DN] + (size_t)l * FF * DM, FF, DM, (bf16*)(ws + WS_WDN2), DM, 0, gw, ngw, lane, scr);
}

__device__ __forceinline__ void rms_rows_bf16(const float* x, const float* g, bf16* o) {
    STAGE_IDS
    const f4* gr = (const f4*)g + lane; f4 gv[4];
#pragma unroll
    for (int j = 0; j < 4; ++j) gv[j] = gr[64 * j];
    for (int m = gw; m < T_; m += ngw) {
        const f4* xr = (const f4*)(x + (size_t)m * DM) + lane; f4 v[4]; float s = 0.f;
#pragma unroll
        for (int j = 0; j < 4; ++j) { v[j] = xr[64 * j]; s += (v[j].x * v[j].x + v[j].y * v[j].y) + (v[j].z * v[j].z + v[j].w * v[j].w); }
        const float rs = 1.0f / sqrtf(wave_sum(s) * (1.0f / DM) + 1e-6f);
        v2u* op = (v2u*)(o + (size_t)m * DM) + lane;
#pragma unroll
        for (int j = 0; j < 4; ++j) { v2u w; w.x = pk2(v[j].x * rs * gv[j].x, v[j].y * rs * gv[j].y); w.y = pk2(v[j].z * rs * gv[j].z, v[j].w * rs * gv[j].w); op[64 * j] = w; }
    }
}
__device__ __forceinline__ void rms_rows_f32_inplace(float* x, const float* g) {
    STAGE_IDS
    const f4* gr = (const f4*)g + lane; f4 gv[4];
#pragma unroll
    for (int j = 0; j < 4; ++j) gv[j] = gr[64 * j];
    for (int m = gw; m < T_; m += ngw) {
        f4* xr = (f4*)(x + (size_t)m * DM) + lane; f4 v[4]; float s = 0.f;
#pragma unroll
        for (int j = 0; j < 4; ++j) { v[j] = xr[64 * j]; s += (v[j].x * v[j].x + v[j].y * v[j].y) + (v[j].z * v[j].z + v[j].w * v[j].w); }
        const float rs = 1.0f / sqrtf(wave_sum(s) * (1.0f / DM) + 1e-6f);
#pragma unroll
        for (int j = 0; j < 4; ++j) xr[64 * j] = v[j] * rs * gv[j];
    }
}

__device__ __forceinline__ void qkprep(const Params& P, int l) {
    STAGE_IDS
    unsigned char* ws = P.ws;
    bf16* QB = (bf16*)(ws + WS_QB); const bf16* KVB = (const bf16*)(ws + WS_KVB); bf16* QC = (bf16*)(ws + WS_QC); const bf16* KVC = (const bf16*)(ws + WS_KVC);
    bf16* KG = (bf16*)(ws + WS_KG); bf16* VG = (bf16*)(ws + WS_VG); bf16* KW = (bf16*)(ws + WS_KW); bf16* VW = (bf16*)(ws + WS_VW);
    const float qg = P.in[I_QN][l * 64 + lane], kg = P.in[I_KN][l * 64 + lane];
    const float inv_ax = exp2f(-(float)(lane & 15) * (LOG2_THETA / 16.0f)), inv_1d = exp2f(-(float)(lane & 31) * (LOG2_THETA / 32.0f));
    for (long it = gw; it < (long)T_ * 24; it += ngw) {
        const int t = (int)(it / 24); int slot = (int)(it % 24); const int b = t >> 11, s = t & 2047;
        if (slot < 12) {
            if (slot < 10) {
                bf16* src = slot < 8 ? QB + (size_t)t * 512 + slot * 64 : (bf16*)KVB + (size_t)t * 256 + (slot - 8) * 64;
                const float x = bf2f(src[lane]);
                const float ss = wave_sum(x * x) * (1.0f / 64.0f);
                const float y = x * (1.0f / sqrtf(ss + 1e-6f)) * (slot < 8 ? qg : kg);
                const float pos = lane < 32 ? (float)(s >> 6) : (float)(s & 63);
                const float ang = pos * inv_ax; const float cs = cosf(ang), sn = sinf(ang);
                const float p = __shfl_xor(y, 16);
                const float r = (lane & 16) ? y * cs + p * sn : y * cs - p * sn;
                if (slot < 8) src[lane] = (bf16)f2bf(r * C2);
                else KG[((size_t)(b * 2 + (slot - 8)) * S_ + s) * 64 + lane] = (bf16)f2bf(r);
            } else {
                VG[((size_t)(b * 2 + (slot - 10)) * S_ + s) * 64 + lane] = KVB[(size_t)t * 256 + 128 + (slot - 10) * 64 + lane];
            }
        } else {
            slot -= 12;
            if (slot < 10) {
                bf16* src = slot < 8 ? QC + (size_t)t * 512 + slot * 64 : (bf16*)KVC + (size_t)t * 256 + (slot - 8) * 64;
                const float x = bf2f(src[lane]);
                const float ang = (float)s * inv_1d; const float cs = cosf(ang), sn = sinf(ang);
                const float p = __shfl_xor(x, 32);
                const float r = (lane & 32) ? x * cs + p * sn : x * cs - p * sn;
                if (slot < 8) src[lane] = (bf16)f2bf(r * C2);
                else KW[((size_t)(b * 2 + (slot - 8)) * S_ + s) * 64 + lane] = (bf16)f2bf(r);
            } else {
                VW[((size_t)(b * 2 + (slot - 10)) * S_ + s) * 64 + lane] = KVC[(size_t)t * 256 + 128 + (slot - 10) * 64 + lane];
            }
        }
    }
}

__device__ __forceinline__ void attn_naive(bf16* Q, const bf16* Kx, const bf16* Vx, const float* sink, int window) {
    STAGE_IDS
    for (int it = gtid; it < T_ * 8; it += gthreads) {
        const int q = it & 2047, h = (it >> 11) & 7, b = it >> 14, kvh = h >> 2;
        bf16* qp = Q + ((size_t)(b * S_ + q)) * 512 + h * 64;
        float qf[64], o[64];
#pragma unroll
        for (int c = 0; c < 8; ++c) { const v4u w = ((const v4u*)qp)[c];
            qf[c * 8 + 0] = __uint_as_float(w.x << 16); qf[c * 8 + 1] = __uint_as_float(w.x & 0xffff0000u); qf[c * 8 + 2] = __uint_as_float(w.y << 16); qf[c * 8 + 3] = __uint_as_float(w.y & 0xffff0000u);
            qf[c * 8 + 4] = __uint_as_float(w.z << 16); qf[c * 8 + 5] = __uint_as_float(w.z & 0xffff0000u); qf[c * 8 + 6] = __uint_as_float(w.w << 16); qf[c * 8 + 7] = __uint_as_float(w.w & 0xffff0000u); }
#pragma unroll
        for (int d = 0; d < 64; ++d) o[d] = 0.f;
        float m, lsum;
        if (sink) { m = sink[h] * LOG2E; lsum = 1.0f; } else { m = -1e30f; lsum = 0.f; }
        const int k0 = window ? (q - 128 > 0 ? q - 128 : 0) : 0, k1 = window ? (q + 128 < S_ - 1 ? q + 128 : S_ - 1) : S_ - 1;
        const bf16* kp = Kx + (size_t)(b * 2 + kvh) * S_ * 64; const bf16* vp = Vx + (size_t)(b * 2 + kvh) * S_ * 64;
        for (int k = k0; k <= k1; ++k) {
            const v4u* kr = (const v4u*)(kp + (size_t)k * 64); float s = 0.f;
#pragma unroll
            for (int c = 0; c < 8; ++c) { const v4u w = kr[c];
                s += qf[c * 8 + 0] * __uint_as_float(w.x << 16) + qf[c * 8 + 1] * __uint_as_float(w.x & 0xffff0000u) + qf[c * 8 + 2] * __uint_as_float(w.y << 16) + qf[c * 8 + 3] * __uint_as_float(w.y & 0xffff0000u)
                   + qf[c * 8 + 4] * __uint_as_float(w.z << 16) + qf[c * 8 + 5] * __uint_as_float(w.z & 0xffff0000u) + qf[c * 8 + 6] * __uint_as_float(w.w << 16) + qf[c * 8 + 7] * __uint_as_float(w.w & 0xffff0000u); }
            const float mn = fmaxf(m, s), corr = exp2f(m - mn), p = exp2f(s - mn);
            lsum = lsum * corr + p; m = mn;
            const v4u* vr = (const v4u*)(vp + (size_t)k * 64);
#pragma unroll
            for (int c = 0; c < 8; ++c) { const v4u w = vr[c];
                o[c * 8 + 0] = o[c * 8 + 0] * corr + p * __uint_as_float(w.x << 16); o[c * 8 + 1] = o[c * 8 + 1] * corr + p * __uint_as_float(w.x & 0xffff0000u);
                o[c * 8 + 2] = o[c * 8 + 2] * corr + p * __uint_as_float(w.y << 16); o[c * 8 + 3] = o[c * 8 + 3] * corr + p * __uint_as_float(w.y & 0xffff0000u);
                o[c * 8 + 4] = o[c * 8 + 4] * corr + p * __uint_as_float(w.z << 16); o[c * 8 + 5] = o[c * 8 + 5] * corr + p * __uint_as_float(w.z & 0xffff0000u);
                o[c * 8 + 6] = o[c * 8 + 6] * corr + p * __uint_as_float(w.w << 16); o[c * 8 + 7] = o[c * 8 + 7] * corr + p * __uint_as_float(w.w & 0xffff0000u); }
        }
        const float inv = 1.0f / lsum;
#pragma unroll
        for (int c = 0; c < 8; ++c) { v4u w; w.x = pk2(o[c * 8 + 0] * inv, o[c * 8 + 1] * inv); w.y = pk2(o[c * 8 + 2] * inv, o[c * 8 + 3] * inv); w.z = pk2(o[c * 8 + 4] * inv, o[c * 8 + 5] * inv); w.w = pk2(o[c * 8 + 6] * inv, o[c * 8 + 7] * inv);
            ((v4u*)qp)[c] = w; }
    }
}

struct ScanRaw { float c[5], p[5], n[5]; };
__device__ __forceinline__ void scan_load(ScanRaw& R, const bf16* PR, int b, int t, const int (&cols)[5]) {
    const bf16* pc = PR + ((size_t)(b * S_ + t)) * 2048;
#pragma unroll
    for (int i = 0; i < 5; ++i) { R.c[i] = bf2f(pc[cols[i]]); R.p[i] = t > 0 ? bf2f(pc[cols[i] - 2048]) : 0.f; R.n[i] = t < S_ - 1 ? bf2f(pc[cols[i] + 2048]) : 0.f; }
}
__device__ __forceinline__ void scan_naive(const Params& P, int l, unsigned char* ldsg) {
    STAGE_IDS
    if (wave != 0) return;
    unsigned char* ws = P.ws;
    const bf16* PR = (const bf16*)(ws + WS_PR); float* BONUS = (float*)(ws + WS_BONUS);
    float* sW2 = (float*)ldsg; float* sA2 = sW2 + 4096; float* sh = sA2 + 4096; float* sv = sh + 128;
    for (int sid = blockIdx.x; sid < 256; sid += gridDim.x) {
        const int dir = sid & 1, h = (sid >> 1) & 7, b = sid >> 4, hc = h * 64 + lane;
        bf16* WKV = (bf16*)(ws + (dir ? WS_WKVB : WS_WKVF));
        const float* w2b = P.in[I_W2] + (size_t)(l * 2 + dir) * 64 * 512; const float* a2b = P.in[I_A2] + (size_t)(l * 2 + dir) * 64 * 512;
        for (int m = 0; m < 64; ++m) { sW2[m * 64 + lane] = w2b[m * 512 + hc]; sA2[m * 64 + lane] = a2b[m * 512 + hc]; }
        const float* mu = P.in[I_MU] + (size_t)l * 1920;
        const int cols[5] = {hc, 512 + hc, 1024 + hc, 1536 + 64 * dir + lane, 1664 + 64 * dir + lane};
        float mus[5];
#pragma unroll
        for (int i = 0; i < 5; ++i) mus[i] = mu[cols[i]];
        const float w0c = P.in[I_W0][(size_t)(l * 2 + dir) * 512 + hc], a0c = P.in[I_A0][(size_t)(l * 2 + dir) * 512 + hc];
        const float kkc = P.in[I_KK][l * 512 + hc], kac = P.in[I_KA][l * 512 + hc], rkc = P.in[I_RK][l * 512 + hc];
        float S[64];
#pragma unroll
        for (int j = 0; j < 64; ++j) S[j] = 0.f;
        ScanRaw cur, nxt;
        scan_load(cur, PR, b, dir ? S_ - 1 : 0, cols);
        for (int step = 0; step < S_; ++step) {
            const int t = dir ? S_ - 1 - step : step;
            if (step + 1 < S_) scan_load(nxt, PR, b, dir ? t - 1 : t + 1, cols); else nxt = cur;
            float sx[5];
#pragma unroll
            for (int i = 0; i < 5; ++i) sx[i] = cur.c[i] + mus[i] * (0.5f * (cur.p[i] + cur.n[i]) - cur.c[i]);
            const float r = sx[0], k = sx[1], v = sx[2];
            sh[lane] = tanhf(sx[3]); sh[64 + lane] = sx[4];
            float wlin = w0c, alin = a0c;
#pragma unroll 8
            for (int m = 0; m < 64; ++m) { wlin += sh[m] * sW2[m * 64 + lane]; alin += sh[64 + m] * sA2[m * 64 + lane]; }
            const float wlog = -log1pf(expf(-wlin)) - 0.5f;
            const float decay = expf(-expf(wlog));
            const float a = 1.0f / (1.0f + expf(-alin));
            float kkv = k * kkc; const float nrm = sqrtf(wave_sum(kkv * kkv)); kkv = kkv / fmaxf(nrm, 1e-12f);
            const float kd = k * (1.0f + (a - 1.0f) * kac);
            const float bon = wave_sum(r * kd * rkc);
            if (lane == 0) BONUS[((size_t)((dir * NB + b) * 8 + h)) * S_ + t] = bon;
            sv[lane] = decay; sv[64 + lane] = kd; sv[128 + lane] = -kkv; sv[192 + lane] = kkv * a; sv[256 + lane] = r;
            float sa = 0.f;
#pragma unroll
            for (int j = 0; j < 64; ++j) sa += S[j] * sv[128 + j];
            float y = 0.f;
#pragma unroll
            for (int j = 0; j < 64; ++j) { S[j] = S[j] * sv[j] + sa * sv[192 + j] + v * sv[64 + j]; y += S[j] * sv[256 + j]; }
            WKV[((size_t)(b * S_ + t)) * 512 + hc] = (bf16)f2bf(y);
            cur = nxt;
        }
    }
}

__device__ __forceinline__ void finalize_naive(const Params& P, int l, unsigned char* ldsg) {
    STAGE_IDS
    unsigned char* ws = P.ws;
    const bf16* PR = (const bf16*)(ws + WS_PR); const bf16* WF = (const bf16*)(ws + WS_WKVF); const bf16* WBk = (const bf16*)(ws + WS_WKVB); const float* BONUS = (const float*)(ws + WS_BONUS);
    bf16* YA = (bf16*)(ws + WS_YA);
    float* sg = (float*)ldsg;
    const float* mu = P.in[I_MU] + (size_t)l * 1920; const float* g2 = P.in[I_G2] + (size_t)l * 128 * 512;
    const float lng = P.in[I_LNG][l * 512 + tid], lnb = P.in[I_LNB][l * 512 + tid];
    const float mu_v = mu[1024 + tid], mu_g = tid < 128 ? mu[1792 + tid] : 0.f;
    for (int t = blockIdx.x; t < T_; t += gridDim.x) {
        const int s = t & 2047; const bf16* pc = PR + (size_t)t * 2048;
        if (tid < 128) { const int col = 1792 + tid; const float c = bf2f(pc[col]), p = s > 0 ? bf2f(pc[col - 2048]) : 0.f, n = s < S_ - 1 ? bf2f(pc[col + 2048]) : 0.f;
            const float x = c + mu_g * (0.5f * (p + n) - c); sg[tid] = 1.0f / (1.0f + expf(-x)); }
        __syncthreads();
        float gate = 0.f;
#pragma unroll 8
        for (int m = 0; m < 128; ++m) gate += sg[m] * g2[m * 512 + tid];
        const float wkv = bf2f(WF[(size_t)t * 512 + tid]) + bf2f(WBk[(size_t)t * 512 + tid]);
        const float mean = wave_sum(wkv) * (1.0f / 64.0f); const float dv = wkv - mean; const float var = wave_sum(dv * dv) * (1.0f / 64.0f);
        float y = dv * (1.0f / sqrtf(var + 64e-5f)) * lng + lnb;
        { const int col = 1024 + tid; const float c = bf2f(pc[col]), p = s > 0 ? bf2f(pc[col - 2048]) : 0.f, n = s < S_ - 1 ? bf2f(pc[col + 2048]) : 0.f;
          const float vs = c + mu_v * (0.5f * (p + n) - c); const int h = tid >> 6;
          const int b = t >> 11; y += (BONUS[((size_t)(b * 8 + h)) * S_ + s] + BONUS[((size_t)((NB + b) * 8 + h)) * S_ + s]) * vs; }
        YA[(size_t)t * 512 + tid] = (bf16)f2bf(y * gate);
        __syncthreads();
    }
}

#ifndef DBG_NL
#define DBG_NL NL
#endif
#ifndef DBG_BR
#define DBG_BR 7
#endif
#ifndef DBG_STOP
#define DBG_STOP 0
#endif
#define L1_INVALIDATE() do { asm volatile("s_waitcnt vmcnt(0)" ::: "memory"); __builtin_amdgcn_fence(__ATOMIC_ACQUIRE, "agent"); asm volatile("s_waitcnt vmcnt(0)" ::: "memory"); } while (0)
#define GRID_SYNC() do { asm volatile("s_waitcnt vmcnt(0) lgkmcnt(0)" ::: "memory"); grid.sync(); __builtin_amdgcn_fence(__ATOMIC_ACQUIRE, "agent"); asm volatile("s_waitcnt vmcnt(0)" ::: "memory"); } while (0)
#define GEMM_PHASE(EPI, A_, Bt_, M_, N_, K_, E_) do { pg8::Gemm g_{(const pg8::bf16_t*)(A_), (const pg8::bf16_t*)(Bt_), (M_), (N_), (K_)}; pg8::StaticOrder S_o; S_o.init((M_), (N_), (int)gridDim.x, (int)blockIdx.x); \
    pg8::gemm_phase<EPI, pg8::StaticOrder, true, true>((PG8_LAS unsigned char*)lds, g_, S_o, (E_)); } while (0)

__global__ void __launch_bounds__(NTHREADS, 2) fwd_kernel(Params P) {
    extern __shared__ __attribute__((aligned(16))) unsigned char lds[];
    cg::grid_group grid = cg::this_grid();
    unsigned char* ws = P.ws;
    bf16* H = (bf16*)(ws + WS_H); bf16* ACT = (bf16*)(ws + WS_ACT);
#ifdef DBG_HA
    bf16* HA = (bf16*)(ws + WS_QC);
#else
    bf16* HA = H;
#endif
#pragma unroll 1
    for (int l = 0; l < DBG_NL; ++l) {
        const float* xin = (l == 0) ? P.in[I_X] : P.out;
        cvt_layer(P, l, lds);
        __syncthreads();
        rms_rows_bf16(xin, P.in[I_F1N] + l * DM, HA);
        GRID_SYNC();
        { pg8::EpiSwiglu E{(pg8::bf16_t*)ACT, FF}; GEMM_PHASE(pg8::EpiSwiglu, HA, ws + WS_WUP1, T_, 2 * FF, DM, E); }
        GRID_SYNC();
        { pg8::EpiResid E{xin, P.out, DM, 0.5f}; GEMM_PHASE(pg8::EpiResid, ACT, ws + WS_WDN1, T_, DM, FF, E); }
        GRID_SYNC();
#if DBG_STOP == 1
        break;
#endif
        rms_rows_bf16(P.out, P.in[I_MIXN] + l * DM, H);
        GRID_SYNC();
        { pg8::EpiWin E{(pg8::bf16_t*)(ws + WS_PR), (pg8::bf16_t*)(ws + WS_QB), (pg8::bf16_t*)(ws + WS_KVB), (pg8::bf16_t*)(ws + WS_QC), (pg8::bf16_t*)(ws + WS_KVC)};
          GEMM_PHASE(pg8::EpiWin, H, ws + WS_WIN, T_, 3584, DM, E); }
        GRID_SYNC();
#ifndef NO_QKPREP
        qkprep(P, l);
#endif
#ifndef NO_SCAN
        scan_naive(P, l, lds);
#endif
        GRID_SYNC();
#ifndef NO_ATTN
        attn_naive((bf16*)(ws + WS_QB), (const bf16*)(ws + WS_KG), (const bf16*)(ws + WS_VG), nullptr, 0);
        attn_naive((bf16*)(ws + WS_QC), (const bf16*)(ws + WS_KW), (const bf16*)(ws + WS_VW), P.in[I_SINK] + l * 8, 1);
#endif
        __syncthreads();
#ifndef NO_FIN
        finalize_naive(P, l, lds);
#endif
        GRID_SYNC();
#pragma unroll 1
        for (int i = 0; i < 3; ++i) {
            { pg8::EpiGate E{(pg8::bf16_t*)(ws + WS_GATE)};
#ifdef DBG_GW
              GEMM_PHASE(pg8::EpiGate, H, ws + WS_WOUT, T_, DM, DM, E); }
#else
              GEMM_PHASE(pg8::EpiGate, H, ws + WS_WG + (size_t)i * DM * DM * 2, T_, DM, DM, E); }
#endif
            GRID_SYNC();
#ifdef DBG_YSRC
            const unsigned char* yi = ws + WS_H;
#else
            const unsigned char* yi = ws + (i == 0 ? WS_YA : (i == 1 ? WS_QB : WS_QC));
#endif
            { pg8::EpiMerge E{(const pg8::bf16_t*)(ws + WS_GATE), (pg8::bf16_t*)(ws + WS_MERGED), i == 0 ? 1 : 0}; GEMM_PHASE(pg8::EpiMerge, yi, ws + WS_WO + (size_t)i * DM * 512 * 2, T_, DM, 512, E); }
            if (i < 2) GRID_SYNC();
        }
        GRID_SYNC();
        { pg8::EpiResid E{P.out, P.out, DM, 1.0f}; GEMM_PHASE(pg8::EpiResid, ws + WS_MERGED, ws + WS_WOUT, T_, DM, DM, E); }
        GRID_SYNC();
#if DBG_STOP == 2
        break;
#endif
        rms_rows_bf16(P.out, P.in[I_F2N] + l * DM, H);
        GRID_SYNC();
        { pg8::EpiSwiglu E{(pg8::bf16_t*)ACT, FF}; GEMM_PHASE(pg8::EpiSwiglu, H, ws + WS_WUP2, T_, 2 * FF, DM, E); }
        GRID_SYNC();
        { pg8::EpiResid E{P.out, P.out, DM, 0.5f}; GEMM_PHASE(pg8::EpiResid, ACT, ws + WS_WDN2, T_, DM, FF, E); }
        GRID_SYNC();
    }
    rms_rows_f32_inplace(P.out, P.in[I_FINN]);
}

extern "C" void kernel_launch(void* const* d_in, const int* in_sizes, int n_in, void* d_out, int out_size, void* d_ws, size_t ws_size, hipStream_t stream) {
    static int grid_blocks = 0;
    if (grid_blocks == 0) {
        if (n_in != N_IN || out_size != T_ * DM || ws_size < WS_END) { fprintf(stderr, "kernel_launch: unexpected shapes (n_in %d, out %d, ws %zu < %zu)\n", n_in, out_size, ws_size, (size_t)WS_END); grid_blocks = -1; return; }
        int dev = 0, cus = 0, per_cu = 0;
        hipGetDevice(&dev);
        hipDeviceGetAttribute(&cus, hipDeviceAttributeMultiprocessorCount, dev);
        hipFuncSetAttribute((const void*)fwd_kernel, hipFuncAttributeMaxDynamicSharedMemorySize, LDS_BYTES);
        hipOccupancyMaxActiveBlocksPerMultiprocessor(&per_cu, (const void*)fwd_kernel, NTHREADS, LDS_BYTES);
        if (per_cu < 1) per_cu = 1;
        grid_blocks = cus * per_cu;
    }
    if (grid_blocks < 0) return;
    Params p{};
    for (int i = 0; i < N_IN; ++i) p.in[i] = (const float*)d_in[i];
    p.out = (float*)d_out; p.ws = (unsigned char*)d_ws;
    void* args[] = {&p};
    hipError_t e = hipLaunchCooperativeKernel((const void*)fwd_kernel, dim3(grid_blocks), dim3(NTHREADS), args, LDS_BYTES, stream);
    if (e != hipSuccess) fprintf(stderr, "cooperative launch failed: %s (grid %d)\n", hipGetErrorString(e), grid_blocks);
}
```

```cpp
#include <hip/hip_runtime.h>
#include <hip/hip_cooperative_groups.h>
#include <cstdio>
#include <cstdint>
namespace cg = cooperative_groups;
namespace pg8 {
#define PG8_LAS __attribute__((address_space(3)))
typedef unsigned short bf16_t;
typedef short bf16x8 __attribute__((ext_vector_type(8)));
typedef float f32x4 __attribute__((ext_vector_type(4)));
typedef unsigned u32x4 __attribute__((ext_vector_type(4)));
constexpr int BM = 256, BK = 64, HALF = 128, HTB = HALF * BK * 2  , STAGE_BYTES = 8 * HTB, NXCD = 8, WGM = 8;

__host__ __device__ __forceinline__ int lds_byte(int r, int c) { const int st = (r >> 4) * 2 + (c >> 5), rr = r & 15, cc = c & 31, ob = rr * 64 + cc * 2; return st * 1024 + (ob ^ (((ob >> 9) & 1) << 5)); }
__host__ __device__ __forceinline__ void stage_rc(int b, int& R, int& C) { const int st = b / 1024, sb = b % 1024, swz = sb ^ (((sb >> 9) & 1) << 5); R = (st >> 1) * 16 + swz / 64; C = (st & 1) * 32 + (swz % 64) / 2; }
__host__ __device__ __forceinline__ int perm32(int rho) { const int n = rho >> 4, i = rho & 15; return 8 * (i >> 2) + 4 * n + (i & 3); }

struct Unit { int pm, pn; };
struct Gemm { const bf16_t* A; const bf16_t* Bt; int M, N, K; };

struct StaticOrder {
    int nM, nN, nwg, G, c;
    __host__ __device__ void init(int M, int N, int G_, int c_) { nM = M / BM; nN = N / BM; nwg = nM * nN; G = G_; c = c_; }
    __host__ __device__ bool next(int i, Unit& u) const {
        const long L = (long)i * G + c; if (L >= nwg) return false;
        int wgid = (int)L; { const int q = nwg / NXCD, r = nwg % NXCD, xcd = wgid % NXCD, off = wgid / NXCD; wgid = (xcd < r ? xcd * (q + 1) : r * (q + 1) + (xcd - r) * q) + off; }
        const int nig = WGM * nN, gid = wgid / nig, fm = gid * WGM, gsz = (nM - fm) < WGM ? (nM - fm) : WGM;
        u.pm = fm + ((wgid % nig) % gsz); u.pn = (wgid % nig) / gsz; return true;
    }
    __device__ __forceinline__ void a_ready(const Unit&) const {}
    __device__ __forceinline__ void done(const Unit&) const {}
};
typedef float f32x2_t __attribute__((ext_vector_type(2))); typedef __bf16 bf16x2_t __attribute__((ext_vector_type(2)));
__device__ __forceinline__ unsigned cvt_pk_bf16(float lo, float hi) { f32x2_t v = {lo, hi}; bf16x2_t b = __builtin_convertvector(v, bf16x2_t); return __builtin_bit_cast(unsigned, b); }
typedef float f32x2 __attribute__((ext_vector_type(2)));
__device__ __forceinline__ float fast_sigmoid(float x) { return __builtin_amdgcn_rcpf(1.0f + __builtin_amdgcn_exp2f(-1.4426950408889634f * x)); }
__device__ __forceinline__ u32x4 ld16_agent(const bf16_t* p) { const unsigned long long a = __hip_atomic_load((const unsigned long long*)p, __ATOMIC_RELAXED, __HIP_MEMORY_SCOPE_AGENT), b = __hip_atomic_load((const unsigned long long*)p + 1, __ATOMIC_RELAXED, __HIP_MEMORY_SCOPE_AGENT); u32x4 r; r.x = (unsigned)a; r.y = (unsigned)(a >> 32); r.z = (unsigned)b; r.w = (unsigned)(b >> 32); return r; }
__device__ __forceinline__ float bf_lo(unsigned w) { return __uint_as_float(w << 16); }
__device__ __forceinline__ float bf_hi(unsigned w) { return __uint_as_float(w & 0xffff0000u); }

struct EpiSwiglu {
    static constexpr bool PERM = true, AFTER_DRAIN = false;
    bf16_t* O; int ldc;
    __device__ __forceinline__ void operator()(const f32x4 (&acc)[2][2][4][2], const Unit& u, int wr, int wc, int fr, int fq) const {
        const int row0 = u.pm * BM + wr * 64 + fr, col0 = u.pn * HALF + wc * 32 + 8 * fq;
#pragma unroll
        for (int ai = 0; ai < 2; ++ai)
#pragma unroll
            for (int m = 0; m < 4; ++m) {
                bf16_t* rowp = O + (size_t)(row0 + ai * HALF + m * 16) * ldc + col0;
                float v[8];
#pragma unroll
                for (int n = 0; n < 2; ++n)
#pragma unroll
                    for (int j = 0; j < 4; ++j) { const float g = acc[ai][0][m][n][j], up = acc[ai][1][m][n][j]; v[n * 4 + j] = g * fast_sigmoid(g) * up; }
                u32x4 w; w.x = cvt_pk_bf16(v[0], v[1]); w.y = cvt_pk_bf16(v[2], v[3]); w.z = cvt_pk_bf16(v[4], v[5]); w.w = cvt_pk_bf16(v[6], v[7]);
                *(u32x4*)rowp = w;
            }
    }
};
struct EpiResid {
    static constexpr bool PERM = false, AFTER_DRAIN = false;
    const float* src; float* dst; int ldc; float scale;
    __device__ __forceinline__ void operator()(const f32x4 (&acc)[2][2][4][2], const Unit& u, int wr, int wc, int fr, int fq) const {
        const int col0 = u.pn * BM + wc * 32 + 4 * fq;
#pragma unroll
        for (int ai = 0; ai < 2; ++ai)
#pragma unroll
            for (int m = 0; m < 4; ++m) {
                const size_t off = (size_t)(u.pm * BM + ai * HALF + wr * 64 + m * 16 + fr) * ldc + col0;
#pragma unroll
                for (int bj = 0; bj < 2; ++bj)
#pragma unroll
                    for (int n = 0; n < 2; ++n) { const f32x4 b = *(const f32x4*)(src + off + bj * HALF + n * 16); *(f32x4*)(dst + off + bj * HALF + n * 16) = b + acc[ai][bj][m][n] * scale; }
            }
    }
};
struct EpiWin {
    static constexpr bool PERM = true, AFTER_DRAIN = false;
    bf16_t *PR, *QB, *KVB, *QC, *KVC;
    __device__ __forceinline__ void operator()(const f32x4 (&acc)[2][2][4][2], const Unit& u, int wr, int wc, int fr, int fq) const {
        bf16_t* base; int ldc, colt;
        const int pn = u.pn;
        if (pn < 8) { base = PR; ldc = 2048; colt = pn * 256; }
        else if (pn < 10) { base = QB; ldc = 512; colt = (pn - 8) * 256; }
        else if (pn == 10) { base = KVB; ldc = 256; colt = 0; }
        else if (pn < 13) { base = QC; ldc = 512; colt = (pn - 11) * 256; }
        else { base = KVC; ldc = 256; colt = 0; }
        const int row0 = u.pm * BM + wr * 64 + fr, col0 = colt + wc * 32 + 8 * fq;
#pragma unroll
        for (int ai = 0; ai < 2; ++ai)
#pragma unroll
            for (int m = 0; m < 4; ++m) {
                bf16_t* rowp = base + (size_t)(row0 + ai * HALF + m * 16) * ldc + col0;
#pragma unroll
                for (int bj = 0; bj < 2; ++bj) { const f32x4 v0 = acc[ai][bj][m][0], v1 = acc[ai][bj][m][1];
                    u32x4 w; w.x = cvt_pk_bf16(v0[0], v0[1]); w.y = cvt_pk_bf16(v0[2], v0[3]); w.z = cvt_pk_bf16(v1[0], v1[1]); w.w = cvt_pk_bf16(v1[2], v1[3]);
                    *(u32x4*)(rowp + bj * HALF) = w; }
            }
    }
};
struct EpiGate {
    static constexpr bool PERM = true, AFTER_DRAIN = false;
    bf16_t* G;
    __device__ __forceinline__ void operator()(const f32x4 (&acc)[2][2][4][2], const Unit& u, int wr, int wc, int fr, int fq) const {
        const int row0 = u.pm * BM + wr * 64 + fr, col0 = u.pn * BM + wc * 32 + 8 * fq;
#pragma unroll
        for (int ai = 0; ai < 2; ++ai)
#pragma unroll
            for (int m = 0; m < 4; ++m) {
                bf16_t* rowp = G + (size_t)(row0 + ai * HALF + m * 16) * 1024 + col0;
#pragma unroll
                for (int bj = 0; bj < 2; ++bj) { const f32x4 v0 = acc[ai][bj][m][0], v1 = acc[ai][bj][m][1];
                    u32x4 w; w.x = cvt_pk_bf16(fast_sigmoid(v0[0]), fast_sigmoid(v0[1])); w.y = cvt_pk_bf16(fast_sigmoid(v0[2]), fast_sigmoid(v0[3]));
                    w.z = cvt_pk_bf16(fast_sigmoid(v1[0]), fast_sigmoid(v1[1])); w.w = cvt_pk_bf16(fast_sigmoid(v1[2]), fast_sigmoid(v1[3]));
#ifdef DBG_GCONST
                    w = (u32x4){0x3f003f00u, 0x3f003f00u, 0x3f003f00u, 0x3f003f00u};
#endif
                    *(u32x4*)(rowp + bj * HALF) = w; }
            }
    }
};
struct EpiMerge {
    static constexpr bool PERM = true, AFTER_DRAIN = false;
    const bf16_t* G; bf16_t* Mg; int first;
    __device__ __forceinline__ void operator()(const f32x4 (&acc)[2][2][4][2], const Unit& u, int wr, int wc, int fr, int fq) const {
        const int row0 = u.pm * BM + wr * 64 + fr, col0 = u.pn * BM + wc * 32 + 8 * fq;
#pragma unroll
        for (int ai = 0; ai < 2; ++ai)
#pragma unroll
            for (int m = 0; m < 4; ++m) {
                const size_t off = (size_t)(row0 + ai * HALF + m * 16) * 1024 + col0;
#pragma unroll
                for (int bj = 0; bj < 2; ++bj) { const f32x4 v0 = acc[ai][bj][m][0], v1 = acc[ai][bj][m][1];
#ifdef DBG_NOG
                    const u32x4 g = (u32x4){0x3f803f80u, 0x3f803f80u, 0x3f803f80u, 0x3f803f80u};
#else
                    const u32x4 g = *(const u32x4*)(G + off + bj * HALF);
#endif
                    float r[8];
                    r[0] = bf_lo(g.x) * v0[0]; r[1] = bf_hi(g.x) * v0[1]; r[2] = bf_lo(g.y) * v0[2]; r[3] = bf_hi(g.y) * v0[3];
                    r[4] = bf_lo(g.z) * v1[0]; r[5] = bf_hi(g.z) * v1[1]; r[6] = bf_lo(g.w) * v1[2]; r[7] = bf_hi(g.w) * v1[3];
#ifdef DBG_NOG
                    if (false) { const u32x4 p = *(const u32x4*)(Mg + off + bj * HALF);
#else
                    if (!first) { const u32x4 p = *(const u32x4*)(Mg + off + bj * HALF);
#endif
                        r[0] += bf_lo(p.x); r[1] += bf_hi(p.x); r[2] += bf_lo(p.y); r[3] += bf_hi(p.y); r[4] += bf_lo(p.z); r[5] += bf_hi(p.z); r[6] += bf_lo(p.w); r[7] += bf_hi(p.w); }
                    u32x4 w; w.x = cvt_pk_bf16(r[0], r[1]); w.y = cvt_pk_bf16(r[2], r[3]); w.z = cvt_pk_bf16(r[4], r[5]); w.w = cvt_pk_bf16(r[6], r[7]);
                    *(u32x4*)(Mg + off + bj * HALF) = w; }
            }
    }
};
template <class Epi, class Sched, bool ALIGN_EPI = false, bool SP2 = false>
__device__ __forceinline__ void gemm_phase(PG8_LAS unsigned char* lds, const Gemm g, const Sched& S, const Epi& E) {
    int tid_o = threadIdx.x; asm volatile("" : "+v"(tid_o));
    const int tid = tid_o, wid = __builtin_amdgcn_readfirstlane(tid >> 6), lane = tid & 63, wr = wid >> 2, wc = wid & 3, fr = lane & 15, fq = lane >> 4;
    const int K = g.K, nt = K / BK;
    unsigned voffA[2], voffB[2];
#pragma unroll
    for (int i = 0; i < 2; ++i) { int R, C; stage_rc(tid * 16 + i * 8192, R, C); const int Rb = Epi::PERM ? ((R & ~31) + perm32(R & 31)) : R;
        voffA[i] = (unsigned)(R * K + C) * 2u; voffB[i] = (unsigned)(Rb * K + C) * 2u; }
    const size_t kstep = (size_t)(BK * 2);
    const size_t hstep = (size_t)HALF * K * 2;
    const size_t tstep = 2 * hstep;
    const unsigned ldsw = (unsigned)wid * 1024u;
    const int aoff = lds_byte(wr * 64 + fr, fq * 8), boff = lds_byte(wc * 32 + fr, fq * 8);
#define PG8_SA(b, h) (((b) * 2 + (h)) * HTB)
#define PG8_SB(b, h) ((4 + (b) * 2 + (h)) * HTB)
#define PG8_STAGE(bufoff, gbase, voff) do { _Pragma("unroll") for (int _i = 0; _i < 2; ++_i) \
        __builtin_amdgcn_global_load_lds((const unsigned*)((const char*)(gbase) + (voff)[_i]), (PG8_LAS unsigned*)(lds + (bufoff) + ldsw + _i * 8192), 16, 0, 0); } while (0)
#define PG8_LDA(dst, b, h) do { _Pragma("unroll") for (int m = 0; m < 4; ++m) _Pragma("unroll") for (int k = 0; k < 2; ++k) dst[m][k] = *(const PG8_LAS bf16x8*)(lds + PG8_SA(b, h) + aoff + m * 2048 + k * 1024); } while (0)
#define PG8_LDB(dst, b, h) do { _Pragma("unroll") for (int n = 0; n < 2; ++n) _Pragma("unroll") for (int k = 0; k < 2; ++k) dst[n][k] = *(const PG8_LAS bf16x8*)(lds + PG8_SB(b, h) + boff + n * 2048 + k * 1024); } while (0)
#define PG8_MMA(ai, bj, At, Bt) do { __builtin_amdgcn_s_setprio(1); _Pragma("unroll") for (int m = 0; m < 4; ++m) _Pragma("unroll") for (int n = 0; n < 2; ++n) _Pragma("unroll") for (int k = 0; k < 2; ++k) \
        acc[ai][bj][m][n] = __builtin_amdgcn_mfma_f32_16x16x32_bf16(Bt[n][k], At[m][k], acc[ai][bj][m][n], 0, 0, 0); __builtin_amdgcn_s_setprio(0); } while (0)
#define PG8_WAIT_V(n) asm volatile("s_waitcnt vmcnt(" #n ")" ::: "memory")
#define PG8_WAIT_L(n) asm volatile("s_waitcnt lgkmcnt(" #n ")" ::: "memory")
#define PG8_BAR __builtin_amdgcn_s_barrier()
#define PG8_SCHED __builtin_amdgcn_sched_barrier(0)
    Unit cur, nxt; int ui = 0;
    if (!S.next(0, cur)) return;
    f32x4 acc[2][2][4][2];
#pragma unroll
    for (int a = 0; a < 2; ++a)
#pragma unroll
        for (int b = 0; b < 2; ++b)
#pragma unroll
            for (int m = 0; m < 4; ++m)
#pragma unroll
                for (int n = 0; n < 2; ++n) acc[a][b][m][n] = (f32x4){0.f, 0.f, 0.f, 0.f};
    bf16x8 At[4][2], B0[2][2], B1[2][2];
    const char* cA = (const char*)g.A + (size_t)cur.pm * tstep; const char* cB = (const char*)g.Bt + (size_t)cur.pn * tstep;
    S.a_ready(cur);
    if constexpr (SP2) {
        PG8_STAGE(PG8_SB(0, 0), cB, voffB); PG8_STAGE(PG8_SB(0, 1), cB + hstep, voffB); PG8_STAGE(PG8_SA(0, 0), cA, voffA); PG8_STAGE(PG8_SA(0, 1), cA + hstep, voffA);
        if (wr == 1) PG8_BAR;
        PG8_WAIT_V(2); PG8_BAR;
        PG8_STAGE(PG8_SB(1, 0), cB + kstep, voffB); PG8_STAGE(PG8_SA(1, 0), cA + kstep, voffA); PG8_STAGE(PG8_SB(1, 1), cB + hstep + kstep, voffB);
        PG8_WAIT_V(6); PG8_BAR;
    } else {
        PG8_STAGE(PG8_SB(0, 0), cB, voffB); PG8_STAGE(PG8_SA(0, 0), cA, voffA); PG8_STAGE(PG8_SB(0, 1), cB + hstep, voffB); PG8_STAGE(PG8_SA(0, 1), cA + hstep, voffA);
        if (wr == 1) PG8_BAR;
        PG8_WAIT_V(4); PG8_BAR;
        PG8_STAGE(PG8_SB(1, 0), cB + kstep, voffB); PG8_STAGE(PG8_SA(1, 0), cA + kstep, voffA); PG8_STAGE(PG8_SB(1, 1), cB + hstep + kstep, voffB);
        PG8_WAIT_V(6); PG8_BAR;
    }
    for (;;) {
        const bool has_next = S.next(ui + 1, nxt);
        const char* nA = has_next ? (const char*)g.A + (size_t)nxt.pm * tstep : cA; const char* nB = has_next ? (const char*)g.Bt + (size_t)nxt.pn * tstep : cB;
        for (int t = 0; t < nt; t += 2) {
            const bool last = (t == nt - 2);
            const char* a1 = cA + (size_t)(t + 1) * kstep;
            const char* a2 = last ? nA : cA + (size_t)(t + 2) * kstep; const char* b2 = last ? nB : cB + (size_t)(t + 2) * kstep;
            const char* a3 = a2 + kstep; const char* b3 = b2 + kstep;
            if (last && has_next) S.a_ready(nxt);
            if constexpr (SP2) {
            PG8_LDB(B0, 0, 0); PG8_LDB(B1, 0, 1); PG8_SCHED; PG8_LDA(At, 0, 0); PG8_STAGE(PG8_SA(1, 1), a1 + hstep, voffA);
            PG8_WAIT_V(8); PG8_WAIT_L(0); PG8_BAR; PG8_MMA(0, 0, At, B0); PG8_MMA(0, 1, At, B1); PG8_BAR; PG8_SCHED;
            PG8_LDA(At, 0, 1); PG8_STAGE(PG8_SB(0, 0), b2, voffB); PG8_STAGE(PG8_SB(0, 1), b2 + hstep, voffB); PG8_STAGE(PG8_SA(0, 0), a2, voffA);
            PG8_WAIT_V(8); PG8_WAIT_L(0); PG8_BAR; PG8_MMA(1, 0, At, B0); PG8_MMA(1, 1, At, B1); PG8_BAR; PG8_SCHED;
            PG8_LDB(B0, 1, 0); PG8_LDB(B1, 1, 1); PG8_SCHED; PG8_LDA(At, 1, 0); PG8_STAGE(PG8_SA(0, 1), a2 + hstep, voffA);
            PG8_WAIT_V(8); PG8_WAIT_L(0); PG8_BAR; PG8_MMA(0, 0, At, B0); PG8_MMA(0, 1, At, B1); PG8_BAR; PG8_SCHED;
            PG8_LDA(At, 1, 1); PG8_STAGE(PG8_SB(1, 0), b3, voffB); PG8_STAGE(PG8_SB(1, 1), b3 + hstep, voffB); PG8_STAGE(PG8_SA(1, 0), a3, voffA);
            PG8_WAIT_V(8); PG8_WAIT_L(0); PG8_BAR; PG8_MMA(1, 0, At, B0); PG8_MMA(1, 1, At, B1); PG8_BAR; PG8_SCHED;
            } else {
            PG8_LDB(B0, 0, 0); PG8_SCHED; PG8_LDA(At, 0, 0); PG8_STAGE(PG8_SA(1, 1), a1 + hstep, voffA);
            PG8_WAIT_L(8); PG8_BAR; PG8_WAIT_L(0); PG8_MMA(0, 0, At, B0); PG8_BAR; PG8_SCHED;
            PG8_LDB(B1, 0, 1); PG8_STAGE(PG8_SB(0, 0), b2, voffB);
            PG8_BAR; PG8_WAIT_L(0); PG8_MMA(0, 1, At, B1); PG8_BAR;
            PG8_LDA(At, 0, 1); PG8_STAGE(PG8_SA(0, 0), a2, voffA);
            PG8_BAR; PG8_WAIT_L(0); PG8_MMA(1, 0, At, B0); PG8_BAR; PG8_SCHED;
            PG8_STAGE(PG8_SB(0, 1), b2 + hstep, voffB);
            PG8_WAIT_V(6); PG8_BAR; PG8_MMA(1, 1, At, B1); PG8_BAR;
            PG8_LDB(B0, 1, 0); PG8_SCHED; PG8_LDA(At, 1, 0); PG8_STAGE(PG8_SA(0, 1), a2 + hstep, voffA);
            PG8_WAIT_L(8); PG8_BAR; PG8_WAIT_L(0); PG8_MMA(0, 0, At, B0); PG8_BAR; PG8_SCHED;
            PG8_LDB(B1, 1, 1); PG8_STAGE(PG8_SB(1, 0), b3, voffB);
            PG8_BAR; PG8_WAIT_L(0); PG8_MMA(0, 1, At, B1); PG8_BAR;
            PG8_LDA(At, 1, 1); PG8_STAGE(PG8_SA(1, 0), a3, voffA);
            PG8_BAR; PG8_WAIT_L(0); PG8_MMA(1, 0, At, B0); PG8_BAR; PG8_SCHED;
            PG8_STAGE(PG8_SB(1, 1), b3 + hstep, voffB);
            PG8_WAIT_V(6); PG8_BAR; PG8_MMA(1, 1, At, B1); PG8_BAR;
            }
        }
        if constexpr (ALIGN_EPI) { if (wr == 0) PG8_BAR; }
        if constexpr (!Epi::AFTER_DRAIN) { E(acc, cur, wr, wc, fr, fq); S.done(cur); }
        if (!has_next) break;
#pragma unroll
        for (int a = 0; a < 2; ++a)
#pragma unroll
            for (int b = 0; b < 2; ++b)
#pragma unroll
                for (int m = 0; m < 4; ++m)
#pragma unroll
                    for (int n = 0; n < 2; ++n) acc[a][b][m][n] = (f32x4){0.f, 0.f, 0.f, 0.f};
        cur = nxt; cA = nA; cB = nB; ++ui;
        if constexpr (ALIGN_EPI) { if (wr == 1) PG8_BAR; }
    }
    PG8_WAIT_V(0);
    if constexpr (!ALIGN_EPI) { if (wr == 0) PG8_BAR; }
    PG8_BAR;
    if constexpr (Epi::AFTER_DRAIN) { E.fused(acc, cur, wr, wc, fr, fq, lds, wid, lane); S.done(cur); }
#undef PG8_SA
#undef PG8_SB
#undef PG8_STAGE
#undef PG8_LDA
#undef PG8_LDB
#undef PG8_MMA
#undef PG8_WAIT_V
#undef PG8_WAIT_L
#undef PG8_BAR
#undef PG8_SCHED
}
}
#define LAS __attribute__((address_space(3)))
typedef unsigned short bf16;
typedef unsigned v4u __attribute__((ext_vector_type(4)));
typedef unsigned v2u __attribute__((ext_vector_type(2)));
typedef float f4 __attribute__((ext_vector_type(4)));
constexpr int T_ = 32768, S_ = 2048, NB = 16, DM = 1024, FF = 2816, NL = 4;
constexpr int NWAVES = 8, NTHREADS = 512;
constexpr int LDS_BYTES = 147456;
constexpr float LOG2E = 1.4426950408889634f;
constexpr float C2 = 0.125f * LOG2E;
constexpr float LOG2_THETA = 13.287712379549449f;

enum { I_X = 0, I_F1N, I_F1UP, I_F1DN, I_MIXN, I_WIN, I_MU, I_W0, I_W2, I_A0, I_A2, I_G2, I_KK, I_KA, I_RK, I_LNG, I_LNB, I_QN, I_KN, I_SINK,
       I_WOA, I_WOB, I_WOC, I_WOUT, I_F2N, I_F2UP, I_F2DN, I_FINN, N_IN };

constexpr size_t SZ_WUP = (size_t)2 * FF * DM * 2, SZ_WDN = (size_t)DM * FF * 2, SZ_WIN = (size_t)3584 * DM * 2, SZ_WG = (size_t)3072 * DM * 2,
                 SZ_WO = (size_t)3 * DM * 512 * 2, SZ_WOUT = (size_t)DM * DM * 2;
constexpr size_t WS_WUP1 = 0, WS_WDN1 = WS_WUP1 + SZ_WUP, WS_WIN = WS_WDN1 + SZ_WDN, WS_WG = WS_WIN + SZ_WIN, WS_WO = WS_WG + SZ_WG, WS_WOUT = WS_WO + SZ_WO,
                 WS_WUP2 = WS_WOUT + SZ_WOUT, WS_WDN2 = WS_WUP2 + SZ_WUP, WS_H = WS_WDN2 + SZ_WDN;
constexpr size_t WS_R = WS_H + (size_t)T_ * DM * 2;
constexpr size_t WS_ACT = WS_R;
constexpr size_t WS_PR = WS_R, WS_QB = WS_PR + (size_t)T_ * 2048 * 2, WS_KVB = WS_QB + (size_t)T_ * 512 * 2, WS_QC = WS_KVB + (size_t)T_ * 256 * 2, WS_KVC = WS_QC + (size_t)T_ * 512 * 2,
                 WS_KG = WS_KVC + (size_t)T_ * 256 * 2, WS_VG = WS_KG + (size_t)NB * 2 * S_ * 64 * 2, WS_KW = WS_VG + (size_t)NB * 2 * S_ * 64 * 2, WS_VW = WS_KW + (size_t)NB * 2 * S_ * 64 * 2,
                 WS_YA = WS_VW + (size_t)NB * 2 * S_ * 64 * 2, WS_WKVF = WS_YA + (size_t)T_ * 512 * 2, WS_WKVB = WS_WKVF + (size_t)T_ * 512 * 2, WS_BONUS = WS_WKVB + (size_t)T_ * 512 * 2,
                 WS_SCR = WS_BONUS + (size_t)T_ * 16 * 4, WS_END = WS_SCR + (size_t)256 * 65 * 320 * 4;
#ifdef DBG_GATE_ALT
constexpr size_t WS_GATE = WS_WKVF, WS_MERGED = WS_PR + (size_t)T_ * DM * 2;
#else
constexpr size_t WS_GATE = WS_PR, WS_MERGED = WS_PR + (size_t)T_ * DM * 2;
#endif
static_assert(WS_ACT + (size_t)T_ * FF * 2 <= WS_END, "map");
static_assert(WS_END < 530000000ull, "workspace budget");

struct Params { const float* in[N_IN]; float* out; unsigned char* ws; };

__device__ __forceinline__ unsigned f2bf(float f) { unsigned u = __float_as_uint(f); return (u + 0x7fffu + ((u >> 16) & 1u)) >> 16; }
__device__ __forceinline__ unsigned pk2(float lo, float hi) { return f2bf(lo) | (f2bf(hi) << 16); }
__device__ __forceinline__ float bf2f(bf16 h) { return __uint_as_float((unsigned)h << 16); }
__device__ __forceinline__ int opaque_tid() { int t = threadIdx.x; asm volatile("" : "+v"(t)); return t; }
#define STAGE_IDS const int tid = opaque_tid(), lane = tid & 63, wave = __builtin_amdgcn_readfirstlane(tid >> 6); const int gw = blockIdx.x * NWAVES + wave, ngw = gridDim.x * NWAVES, gtid = blockIdx.x * NTHREADS + tid, gthreads = gridDim.x * NTHREADS; (void)lane; (void)gw; (void)ngw; (void)gtid; (void)gthreads;
__device__ __forceinline__ float wave_sum(float v) {
#pragma unroll
    for (int o = 1; o < 64; o <<= 1) v += __shfl_xor(v, o);
    return v;
}

__device__ __forceinline__ void cvt_wt(const float* W, int K, int ld, bf16* Wt, int nrows, int mode, int gw, int ngw, int lane, float* scr) {
    const int nblk = nrows >> 5, nitems = (K >> 6) * nblk;
    for (int it = gw; it < nitems; it += ngw) {
        const int kb = it / nblk, nb = it % nblk, k0 = kb * 64, n0 = nb * 32;
        int col0;
        if (mode == 0) col0 = n0;
        else if (mode == 1) { const int t = n0 >> 8, r = n0 & 255; col0 = (r < 128) ? t * 128 + r : FF + t * 128 + (r - 128); }
        else if (mode == 2) col0 = n0 < 1920 ? n0 : (n0 < 2048 ? -1 : n0 - 128);
        else col0 = 3456 + n0;
        if (col0 >= 0) {
#pragma unroll 8
            for (int i = 0; i < 32; ++i) { const int kk = 2 * i + (lane >> 5); scr[kk * 33 + (lane & 31)] = W[(size_t)(k0 + kk) * ld + col0 + (lane & 31)]; }
        }
        asm volatile("s_waitcnt lgkmcnt(0)" ::: "memory");
        const int c = lane & 7;
#pragma unroll
        for (int j = 0; j < 4; ++j) { const int n = (lane >> 3) + 8 * j; const float* sp = scr + (8 * c) * 33 + n;
            v4u o = (v4u){0u, 0u, 0u, 0u};
            if (col0 >= 0) { o.x = pk2(sp[0 * 33], sp[1 * 33]); o.y = pk2(sp[2 * 33], sp[3 * 33]); o.z = pk2(sp[4 * 33], sp[5 * 33]); o.w = pk2(sp[6 * 33], sp[7 * 33]); }
            *(v4u*)(Wt + (size_t)(n0 + n) * K + k0 + 8 * c) = o; }
        asm volatile("s_waitcnt lgkmcnt(0)" ::: "memory");
    }
}
__device__ __forceinline__ void cvt_layer(const Params& P, int l, unsigned char* ldsg) {
    STAGE_IDS
    unsigned char* ws = P.ws; float* scr = (float*)(ldsg + wave * 8448);
    cvt_wt(P.in[I_F1UP] + (size_t)l * DM * 2 * FF, DM, 2 * FF, (bf16*)(ws + WS_WUP1), 2 * FF, 1, gw, ngw, lane, scr);
    cvt_wt(P.in[I_F1DN] + (size_t)l * FF * DM, FF, DM, (bf16*)(ws + WS_WDN1), DM, 0, gw, ngw, lane, scr);
    cvt_wt(P.in[I_WIN] + (size_t)l * DM * 6528, DM, 6528, (bf16*)(ws + WS_WIN), 3584, 2, gw, ngw, lane, scr);
    cvt_wt(P.in[I_WIN] + (size_t)l * DM * 6528, DM, 6528, (bf16*)(ws + WS_WG), 3072, 3, gw, ngw, lane, scr);
    cvt_wt(P.in[I_WOA] + (size_t)l * 512 * DM, 512, DM, (bf16*)(ws + WS_WO), DM, 0, gw, ngw, lane, scr);
    cvt_wt(P.in[I_WOB] + (size_t)l * 512 * DM, 512, DM, (bf16*)(ws + WS_WO) + (size_t)DM * 512, DM, 0, gw, ngw, lane, scr);
    cvt_wt(P.in[I_WOC] + (size_t)l * 512 * DM, 512, DM, (bf16*)(ws + WS_WO) + (size_t)2 * DM * 512, DM, 0, gw, ngw, lane, scr);
    cvt_wt(P.in[I_WOUT] + (size_t)l * DM * DM, DM, DM, (bf16*)(ws + WS_WOUT), DM, 0, gw, ngw, lane, scr);
    cvt_wt(P.in[I_F2UP] + (size_t)l * DM * 2 * FF, DM, 2 * FF, (bf16*)(ws + WS_WUP2), 2 * FF, 1, gw, ngw, lane, scr);
    cvt_wt(P.in[I_F2DN] + (size_t)l * FF * DM, FF, DM, (bf16*)(ws + WS_WDN2), DM, 0, gw, ngw, lane, scr);
}

__device__ __forceinline__ void rms_rows_bf16(const float* x, const float* g, bf16* o) {
    STAGE_IDS
    const f4* gr = (const f4*)g + lane; f4 gv[4];
#pragma unroll
    for (int j = 0; j < 4; ++j) gv[j] = gr[64 * j];
    for (int m = gw; m < T_; m += ngw) {
        const f4* xr = (const f4*)(x + (size_t)m * DM) + lane; f4 v[4]; float s = 0.f;
#pragma unroll
        for (int j = 0; j < 4; ++j) { v[j] = xr[64 * j]; s += (v[j].x * v[j].x + v[j].y * v[j].y) + (v[j].z * v[j].z + v[j].w * v[j].w); }
        const float rs = 1.0f / sqrtf(wave_sum(s) * (1.0f / DM) + 1e-6f);
        v2u* op = (v2u*)(o + (size_t)m * DM) + lane;
#pragma unroll
        for (int j = 0; j < 4; ++j) { v2u w; w.x = pk2(v[j].x * rs * gv[j].x, v[j].y * rs * gv[j].y); w.y = pk2(v[j].z * rs * gv[j].z, v[j].w * rs * gv[j].w); op[64 * j] = w; }
    }
}
__device__ __forceinline__ void rms_rows_f32_inplace(float* x, const float* g) {
    STAGE_IDS
    const f4* gr = (const f4*)g + lane; f4 gv[4];
#pragma unroll
    for (int j = 0; j < 4; ++j) gv[j] = gr[64 * j];
    for (int m = gw; m < T_; m += ngw) {
        f4* xr = (f4*)(x + (size_t)m * DM) + lane; f4 v[4]; float s = 0.f;
#pragma unroll
        for (int j = 0; j < 4; ++j) { v[j] = xr[64 * j]; s += (v[j].x * v[j].x + v[j].y * v[j].y) + (v[j].z * v[j].z + v[j].w * v[j].w); }
        const float rs = 1.0f / sqrtf(wave_sum(s) * (1.0f / DM) + 1e-6f);
#pragma unroll
        for (int j = 0; j < 4; ++j) xr[64 * j] = v[j] * rs * gv[j];
    }
}

__device__ __forceinline__ void qkprep(const Params& P, int l) {
    STAGE_IDS
    unsigned char* ws = P.ws;
    bf16* QB = (bf16*)(ws + WS_QB); const bf16* KVB = (const bf16*)(ws + WS_KVB); bf16* QC = (bf16*)(ws + WS_QC); const bf16* KVC = (const bf16*)(ws + WS_KVC);
    bf16* KG = (bf16*)(ws + WS_KG); bf16* KW = (bf16*)(ws + WS_KW);
    const float qg = P.in[I_QN][l * 64 + lane], kg = P.in[I_KN][l * 64 + lane];
    const float inv_ax = exp2f(-(float)(lane & 15) * (LOG2_THETA / 16.0f)), inv_1d = exp2f(-(float)(lane & 31) * (LOG2_THETA / 32.0f));
    for (long it = gw; it < (long)T_ * 24; it += ngw) {
        const int t = (int)(it / 24); int slot = (int)(it % 24); const int b = t >> 11, s = t & 2047;
        if (slot < 12) {
            if (slot < 10) {
                bf16* src = slot < 8 ? QB + (size_t)t * 512 + slot * 64 : (bf16*)KVB + (size_t)t * 256 + (slot - 8) * 64;
                const float x = bf2f(src[lane]);
                const float ss = wave_sum(x * x) * (1.0f / 64.0f);
                const float y = x * (1.0f / sqrtf(ss + 1e-6f)) * (slot < 8 ? qg : kg);
                const float pos = lane < 32 ? (float)(s >> 6) : (float)(s & 63);
                const float ang = pos * inv_ax; const float cs = cosf(ang), sn = sinf(ang);
                const float p = __shfl_xor(y, 16);
                const float r = (lane & 16) ? y * cs + p * sn : y * cs - p * sn;
                if (slot < 8) src[lane] = (bf16)f2bf(r * C2);
                else KG[((size_t)(b * 2 + (slot - 8)) * S_ + s) * 64 + lane] = (bf16)f2bf(r);
            }
        } else {
            slot -= 12;
            if (slot < 10) {
                bf16* src = slot < 8 ? QC + (size_t)t * 512 + slot * 64 : (bf16*)KVC + (size_t)t * 256 + (slot - 8) * 64;
                const float x = bf2f(src[lane]);
                const float ang = (float)s * inv_1d; const float cs = cosf(ang), sn = sinf(ang);
                const float p = __shfl_xor(x, 32);
                const float r = (lane & 32) ? x * cs + p * sn : x * cs - p * sn;
                if (slot < 8) src[lane] = (bf16)f2bf(r * C2);
                else KW[((size_t)(b * 2 + (slot - 8)) * S_ + s) * 64 + lane] = (bf16)f2bf(r);
            }
        }
    }
}


__device__ __forceinline__ void vt_prep(const Params& P, unsigned char* ldsg) {
    STAGE_IDS
    unsigned char* ws = P.ws;
    bf16* tile = (bf16*)(ldsg + wave * 8448);
    for (int it = gw; it < 2 * NB * 2 * 32; it += ngw) {
        const int tb = it & 31, kvh = (it >> 5) & 1, b = (it >> 6) & 15, att = it >> 10;
        const bf16* src = (const bf16*)(ws + (att ? WS_KVC : WS_KVB)) + (size_t)(b * S_ + tb * 64) * 256 + 128 + kvh * 64;
        bf16* dst = (bf16*)(ws + (att ? WS_VW : WS_VG)) + (size_t)(b * 2 + kvh) * 64 * S_ + tb * 64;
#pragma unroll 8
        for (int r = 0; r < 64; ++r) tile[r * 66 + lane] = src[(size_t)r * 256 + lane];
        asm volatile("s_waitcnt lgkmcnt(0)" ::: "memory");
#pragma unroll 8
        for (int d = 0; d < 64; ++d) dst[(size_t)d * S_ + lane] = tile[lane * 66 + d];
        asm volatile("s_waitcnt lgkmcnt(0)" ::: "memory");
    }
}

typedef short bf16x8_t __attribute__((ext_vector_type(8)));
typedef short s16x4_t __attribute__((ext_vector_type(4)));
typedef float f32x16 __attribute__((ext_vector_type(16)));
typedef float f32x2a __attribute__((ext_vector_type(2))); typedef __bf16 bf16x2a __attribute__((ext_vector_type(2)));
__device__ __forceinline__ unsigned cvtpk(float lo, float hi) { f32x2a v = {lo, hi}; bf16x2a b = __builtin_convertvector(v, bf16x2a); return __builtin_bit_cast(unsigned, b); }
__device__ __forceinline__ int crow(int r, int hi) { return (r & 3) + 8 * (r >> 2) + 4 * hi; }
template <bool WINDOW>
__device__ __forceinline__ void attn_mfma(bf16* Q, const bf16* Kx, const bf16* VTx, const float* sink, unsigned char* ldsg) {
    STAGE_IDS
    const int r32 = lane & 31, hi = lane >> 5, g = wave >> 1, qs = wave & 1;
    const int srow = tid >> 3, sch = tid & 7;
    for (int unit = blockIdx.x; unit < 1024; unit += gridDim.x) {
        const int qb = unit & 31, kvh = (unit >> 5) & 1, b = unit >> 6, h = kvh * 4 + g, q0 = qb * 64 + qs * 32;
        bf16* qp = Q + ((size_t)(b * S_ + q0 + r32)) * 512 + h * 64;
        bf16x8_t qr[4];
#pragma unroll
        for (int d0 = 0; d0 < 4; ++d0) qr[d0] = *(const bf16x8_t*)(qp + 16 * d0 + 8 * hi);
        f32x16 o0, o1;
#pragma unroll
        for (int r = 0; r < 16; ++r) { o0[r] = 0.f; o1[r] = 0.f; }
        float m, l;
        if (WINDOW) { m = sink[h] * LOG2E; l = hi == 0 ? 1.0f : 0.f; } else { m = -1e30f; l = 0.f; }
        const int t0 = WINDOW ? (qb - 2 > 0 ? qb - 2 : 0) : 0, t1 = WINDOW ? (qb + 2 < 31 ? qb + 2 : 31) : 31;
        const bf16* kbase = Kx + (size_t)(b * 2 + kvh) * S_ * 64 + (size_t)srow * 64 + sch * 8;
        const bf16* vbase = VTx + (size_t)(b * 2 + kvh) * 64 * S_ + (size_t)srow * S_ + sch * 8;
        v4u kreg = *(const v4u*)(kbase + (size_t)t0 * 64 * 64);
        v4u vreg = *(const v4u*)(vbase + t0 * 64);
        __syncthreads();
        *(v4u*)(ldsg + srow * 144 + sch * 16) = kreg;
        *(v4u*)(ldsg + 9216 + srow * 144 + sch * 16) = vreg;
        __syncthreads();
        for (int t = t0; t <= t1; ++t) {
            const int buf = (t - t0) & 1;
            if (t < t1) { kreg = *(const v4u*)(kbase + (size_t)(t + 1) * 64 * 64); vreg = *(const v4u*)(vbase + (t + 1) * 64); }
            const unsigned char* Kb = ldsg + buf * 18432; const unsigned char* Vb = Kb + 9216;
            f32x16 p0, p1;
#pragma unroll
            for (int r = 0; r < 16; ++r) { p0[r] = 0.f; p1[r] = 0.f; }
#pragma unroll
            for (int d0 = 0; d0 < 4; ++d0) {
                const bf16x8_t a0 = *(const bf16x8_t*)(Kb + r32 * 144 + (16 * d0 + 8 * hi) * 2);
                const bf16x8_t a1 = *(const bf16x8_t*)(Kb + (32 + r32) * 144 + (16 * d0 + 8 * hi) * 2);
                p0 = __builtin_amdgcn_mfma_f32_32x32x16_bf16(a0, qr[d0], p0, 0, 0, 0);
                p1 = __builtin_amdgcn_mfma_f32_32x32x16_bf16(a1, qr[d0], p1, 0, 0, 0);
            }
            if (WINDOW) {
                const int qpos = q0 + r32;
#pragma unroll
                for (int r = 0; r < 16; ++r) { const int kv = t * 64 + crow(r, hi); int dlt = qpos - kv; dlt = dlt < 0 ? -dlt : dlt; if (dlt > 128) p0[r] = -1e30f;
                    int dl2 = qpos - (kv + 32); dl2 = dl2 < 0 ? -dl2 : dl2; if (dl2 > 128) p1[r] = -1e30f; }
            }
            float mt = fmaxf(p0[0], p1[0]);
#pragma unroll
            for (int r = 1; r < 16; ++r) mt = fmaxf(mt, fmaxf(p0[r], p1[r]));
            mt = fmaxf(mt, __shfl_xor(mt, 32));
            const float mn = fmaxf(m, mt), corr = __builtin_amdgcn_exp2f(m - mn); m = mn;
            float ps = 0.f;
#pragma unroll
            for (int r = 0; r < 16; ++r) { p0[r] = __builtin_amdgcn_exp2f(p0[r] - mn); p1[r] = __builtin_amdgcn_exp2f(p1[r] - mn); ps += p0[r] + p1[r]; }
            l = l * corr + ps;
#pragma unroll
            for (int r = 0; r < 16; ++r) { o0[r] *= corr; o1[r] *= corr; }
            v4u pw[4];
            pw[0] = (v4u){cvtpk(p0[0], p0[1]), cvtpk(p0[2], p0[3]), cvtpk(p0[4], p0[5]), cvtpk(p0[6], p0[7])};
            pw[1] = (v4u){cvtpk(p0[8], p0[9]), cvtpk(p0[10], p0[11]), cvtpk(p0[12], p0[13]), cvtpk(p0[14], p0[15])};
            pw[2] = (v4u){cvtpk(p1[0], p1[1]), cvtpk(p1[2], p1[3]), cvtpk(p1[4], p1[5]), cvtpk(p1[6], p1[7])};
            pw[3] = (v4u){cvtpk(p1[8], p1[9]), cvtpk(p1[10], p1[11]), cvtpk(p1[12], p1[13]), cvtpk(p1[14], p1[15])};
#pragma unroll
            for (int kb = 0; kb < 4; ++kb) {
                const bf16x8_t pb = __builtin_bit_cast(bf16x8_t, pw[kb]);
                { const unsigned char* vp = Vb + r32 * 144 + (16 * kb + 4 * hi) * 2; const s16x4_t lo = *(const s16x4_t*)vp, hh = *(const s16x4_t*)(vp + 16);
                  const bf16x8_t a = (bf16x8_t){lo[0], lo[1], lo[2], lo[3], hh[0], hh[1], hh[2], hh[3]};
                  o0 = __builtin_amdgcn_mfma_f32_32x32x16_bf16(a, pb, o0, 0, 0, 0); }
                { const unsigned char* vp = Vb + (32 + r32) * 144 + (16 * kb + 4 * hi) * 2; const s16x4_t lo = *(const s16x4_t*)vp, hh = *(const s16x4_t*)(vp + 16);
                  const bf16x8_t a = (bf16x8_t){lo[0], lo[1], lo[2], lo[3], hh[0], hh[1], hh[2], hh[3]};
                  o1 = __builtin_amdgcn_mfma_f32_32x32x16_bf16(a, pb, o1, 0, 0, 0); }
            }
            if (t < t1) { unsigned char* nb = ldsg + (buf ^ 1) * 18432; *(v4u*)(nb + srow * 144 + sch * 16) = kreg; *(v4u*)(nb + 9216 + srow * 144 + sch * 16) = vreg; }
            __syncthreads();
        }
        l += __shfl_xor(l, 32);
        const float inv = 1.0f / l;
#pragma unroll
        for (int g4 = 0; g4 < 4; ++g4) {
            v2u w0, w1;
            w0.x = cvtpk(o0[4 * g4 + 0] * inv, o0[4 * g4 + 1] * inv); w0.y = cvtpk(o0[4 * g4 + 2] * inv, o0[4 * g4 + 3] * inv);
            w1.x = cvtpk(o1[4 * g4 + 0] * inv, o1[4 * g4 + 1] * inv); w1.y = cvtpk(o1[4 * g4 + 2] * inv, o1[4 * g4 + 3] * inv);
            *(v2u*)(qp + 8 * g4 + 4 * hi) = w0;
            *(v2u*)(qp + 32 + 8 * g4 + 4 * hi) = w1;
        }
    }
}

__device__ __forceinline__ void attn_naive(bf16* Q, const bf16* Kx, const bf16* Vx, const float* sink, int window) {
    STAGE_IDS
    for (int it = gtid; it < T_ * 8; it += gthreads) {
        const int q = it & 2047, h = (it >> 11) & 7, b = it >> 14, kvh = h >> 2;
        bf16* qp = Q + ((size_t)(b * S_ + q)) * 512 + h * 64;
        float qf[64], o[64];
#pragma unroll
        for (int c = 0; c < 8; ++c) { const v4u w = ((const v4u*)qp)[c];
            qf[c * 8 + 0] = __uint_as_float(w.x << 16); qf[c * 8 + 1] = __uint_as_float(w.x & 0xffff0000u); qf[c * 8 + 2] = __uint_as_float(w.y << 16); qf[c * 8 + 3] = __uint_as_float(w.y & 0xffff0000u);
            qf[c * 8 + 4] = __uint_as_float(w.z << 16); qf[c * 8 + 5] = __uint_as_float(w.z & 0xffff0000u); qf[c * 8 + 6] = __uint_as_float(w.w << 16); qf[c * 8 + 7] = __uint_as_float(w.w & 0xffff0000u); }
#pragma unroll
        for (int d = 0; d < 64; ++d) o[d] = 0.f;
        float m, lsum;
        if (sink) { m = sink[h] * LOG2E; lsum = 1.0f; } else { m = -1e30f; lsum = 0.f; }
        const int k0 = window ? (q - 128 > 0 ? q - 128 : 0) : 0, k1 = window ? (q + 128 < S_ - 1 ? q + 128 : S_ - 1) : S_ - 1;
        const bf16* kp = Kx + (size_t)(b * 2 + kvh) * S_ * 64; const bf16* vp = Vx + (size_t)(b * 2 + kvh) * S_ * 64;
        for (int k = k0; k <= k1; ++k) {
            const v4u* kr = (const v4u*)(kp + (size_t)k * 64); float s = 0.f;
#pragma unroll
            for (int c = 0; c < 8; ++c) { const v4u w = kr[c];
                s += qf[c * 8 + 0] * __uint_as_float(w.x << 16) + qf[c * 8 + 1] * __uint_as_float(w.x & 0xffff0000u) + qf[c * 8 + 2] * __uint_as_float(w.y << 16) + qf[c * 8 + 3] * __uint_as_float(w.y & 0xffff0000u)
                   + qf[c * 8 + 4] * __uint_as_float(w.z << 16) + qf[c * 8 + 5] * __uint_as_float(w.z & 0xffff0000u) + qf[c * 8 + 6] * __uint_as_float(w.w << 16) + qf[c * 8 + 7] * __uint_as_float(w.w & 0xffff0000u); }
            const float mn = fmaxf(m, s), corr = exp2f(m - mn), p = exp2f(s - mn);
            lsum = lsum * corr + p; m = mn;
            const v4u* vr = (const v4u*)(vp + (size_t)k * 64);
#pragma unroll
            for (int c = 0; c < 8; ++c) { const v4u w = vr[c];
                o[c * 8 + 0] = o[c * 8 + 0] * corr + p * __uint_as_float(w.x << 16); o[c * 8 + 1] = o[c * 8 + 1] * corr + p * __uint_as_float(w.x & 0xffff0000u);
                o[c * 8 + 2] = o[c * 8 + 2] * corr + p * __uint_as_float(w.y << 16); o[c * 8 + 3] = o[c * 8 + 3] * corr + p * __uint_as_float(w.y & 0xffff0000u);
                o[c * 8 + 4] = o[c * 8 + 4] * corr + p * __uint_as_float(w.z << 16); o[c * 8 + 5] = o[c * 8 + 5] * corr + p * __uint_as_float(w.z & 0xffff0000u);
                o[c * 8 + 6] = o[c * 8 + 6] * corr + p * __uint_as_float(w.w << 16); o[c * 8 + 7] = o[c * 8 + 7] * corr + p * __uint_as_float(w.w & 0xffff0000u); }
        }
        const float inv = 1.0f / lsum;
#pragma unroll
        for (int c = 0; c < 8; ++c) { v4u w; w.x = pk2(o[c * 8 + 0] * inv, o[c * 8 + 1] * inv); w.y = pk2(o[c * 8 + 2] * inv, o[c * 8 + 3] * inv); w.z = pk2(o[c * 8 + 4] * inv, o[c * 8 + 5] * inv); w.w = pk2(o[c * 8 + 6] * inv, o[c * 8 + 7] * inv);
            ((v4u*)qp)[c] = w; }
    }
}


typedef float f8s __attribute__((ext_vector_type(8)));
typedef float f32x4m __attribute__((ext_vector_type(4)));
constexpr int SC_A1 = 0, SC_A2 = 9216, SC_W2T = 18432, SC_A2T = 27648, SC_AL = 36864, SC_VS = 53504, SC_XCH = 69888, SC_YP = 73984, SC_END = SC_YP + 65536;
static_assert(SC_END <= LDS_BYTES, "scan LDS");
__device__ __forceinline__ void ld8bf(const bf16* p, float (&f)[8]) { const v4u w = *(const v4u*)p;
    f[0] = __uint_as_float(w.x << 16); f[1] = __uint_as_float(w.x & 0xffff0000u); f[2] = __uint_as_float(w.y << 16); f[3] = __uint_as_float(w.y & 0xffff0000u);
    f[4] = __uint_as_float(w.z << 16); f[5] = __uint_as_float(w.z & 0xffff0000u); f[6] = __uint_as_float(w.w << 16); f[7] = __uint_as_float(w.w & 0xffff0000u); }
__device__ __forceinline__ void shifted8(const bf16* pc, int col, bool hasp, bool hasn, const float* mu, float (&o)[8]) {
    float c[8], p[8], n[8];
    ld8bf(pc + col, c);
    if (hasp) ld8bf(pc + col - 2048, p); else { for (int e = 0; e < 8; ++e) p[e] = 0.f; }
    if (hasn) ld8bf(pc + col + 2048, n); else { for (int e = 0; e < 8; ++e) n[e] = 0.f; }
    const f4 m0 = *(const f4*)(mu + col), m1 = *(const f4*)(mu + col + 4);
    const float mm[8] = {m0.x, m0.y, m0.z, m0.w, m1.x, m1.y, m1.z, m1.w};
#pragma unroll
    for (int e = 0; e < 8; ++e) o[e] = c[e] + mm[e] * (0.5f * (p[e] + n[e]) - c[e]);
}
__device__ __forceinline__ void scan_fast(const Params& P, int l, unsigned char* ldsg) {
    STAGE_IDS
    unsigned char* ws = P.ws;
    const bf16* PR = (const bf16*)(ws + WS_PR); float* BONUS = (float*)(ws + WS_BONUS);
    float* scr = (float*)(ws + WS_SCR) + (size_t)blockIdx.x * (65 * 320);
    const int fr = lane & 15, fq = lane >> 4, ps = tid >> 3, pcg = tid & 7;
    float* XCH = (float*)(ldsg + SC_XCH); float* YP = (float*)(ldsg + SC_YP); float* VS = (float*)(ldsg + SC_VS); float* AL = (float*)(ldsg + SC_AL);
    for (int sid = blockIdx.x; sid < 256; sid += gridDim.x) {
        const int dir = sid & 1, h = (sid >> 1) & 7, b = sid >> 4, hc0 = h * 64;
        bf16* WKV = (bf16*)(ws + (dir ? WS_WKVB : WS_WKVF));
        const float* mu = P.in[I_MU] + (size_t)l * 1920;
        __syncthreads();
        {
            const float* w2b = P.in[I_W2] + (size_t)(l * 2 + dir) * 64 * 512 + (size_t)ps * 512 + hc0 + 8 * pcg;
            const float* a2b = P.in[I_A2] + (size_t)(l * 2 + dir) * 64 * 512 + (size_t)ps * 512 + hc0 + 8 * pcg;
#pragma unroll
            for (int e = 0; e < 8; ++e) { ((bf16*)(ldsg + SC_W2T))[(8 * pcg + e) * 72 + ps] = (bf16)f2bf(w2b[e]); ((bf16*)(ldsg + SC_A2T))[(8 * pcg + e) * 72 + ps] = (bf16)f2bf(a2b[e]); }
        }
        float S[8];
#pragma unroll
        for (int j = 0; j < 8; ++j) S[j] = 0.f;
#pragma unroll 1
        for (int ch = 0; ch < S_ / 64; ++ch) {
            const int step0 = ch * 64;
            const int tp = dir ? S_ - 1 - (step0 + ps) : step0 + ps;
            const bf16* pc = PR + ((size_t)(b * S_ + tp)) * 2048;
            const bool hasp = tp > 0, hasn = tp < S_ - 1;
            float r8[8], k8[8], v8[8];
            shifted8(pc, hc0 + 8 * pcg, hasp, hasn, mu, r8);
            shifted8(pc, 512 + hc0 + 8 * pcg, hasp, hasn, mu, k8);
            shifted8(pc, 1024 + hc0 + 8 * pcg, hasp, hasn, mu, v8);
            { float wl[8], al[8];
              shifted8(pc, 1536 + 64 * dir + 8 * pcg, hasp, hasn, mu, wl);
              shifted8(pc, 1664 + 64 * dir + 8 * pcg, hasp, hasn, mu, al);
#pragma unroll
              for (int e = 0; e < 8; ++e) { const float t2 = __builtin_amdgcn_exp2f(2.0f * LOG2E * wl[e]); wl[e] = (t2 - 1.0f) * __builtin_amdgcn_rcpf(t2 + 1.0f); }
              v4u w1, w2v; w1.x = cvtpk(wl[0], wl[1]); w1.y = cvtpk(wl[2], wl[3]); w1.z = cvtpk(wl[4], wl[5]); w1.w = cvtpk(wl[6], wl[7]);
              w2v.x = cvtpk(al[0], al[1]); w2v.y = cvtpk(al[2], al[3]); w2v.z = cvtpk(al[4], al[5]); w2v.w = cvtpk(al[6], al[7]);
              *(v4u*)(ldsg + SC_A1 + ps * 144 + pcg * 16) = w1; *(v4u*)(ldsg + SC_A2 + ps * 144 + pcg * 16) = w2v; }
            *(f4*)(VS + ps * 64 + 8 * pcg) = (f4){v8[0], v8[1], v8[2], v8[3]}; *(f4*)(VS + ps * 64 + 8 * pcg + 4) = (f4){v8[4], v8[5], v8[6], v8[7]};
            __syncthreads();
            {
                const int wq = wave & 3; const bool isw = wave < 4;
                const unsigned char* Ab = ldsg + (isw ? SC_A1 : SC_A2) + (16 * wq + fr) * 144 + 16 * fq;
                const unsigned char* Bb = ldsg + (isw ? SC_W2T : SC_A2T) + fr * 144 + 16 * fq;
                const bf16x8_t a0 = *(const bf16x8_t*)Ab, a1 = *(const bf16x8_t*)(Ab + 64);
                const float* bias = P.in[isw ? I_W0 : I_A0] + (size_t)(l * 2 + dir) * 512 + hc0;
#pragma unroll
                for (int n = 0; n < 4; ++n) {
                    const bf16x8_t b0 = *(const bf16x8_t*)(Bb + n * 16 * 144), b1 = *(const bf16x8_t*)(Bb + n * 16 * 144 + 64);
                    f32x4m acc = (f32x4m){0.f, 0.f, 0.f, 0.f};
                    acc = __builtin_amdgcn_mfma_f32_16x16x32_bf16(a0, b0, acc, 0, 0, 0);
                    acc = __builtin_amdgcn_mfma_f32_16x16x32_bf16(a1, b1, acc, 0, 0, 0);
                    const float bz = bias[16 * n + fr];
#pragma unroll
                    for (int v = 0; v < 4; ++v) {
                        const int st = 16 * wq + 4 * fq + v; const float x = acc[v] + bz;
                        if (isw) { const float sp = __builtin_amdgcn_logf(1.0f + __builtin_amdgcn_exp2f(-x * LOG2E)) * 0.6931471805599453f;
                                   const float wlog = -sp - 0.5f; scr[st * 320 + 16 * n + fr] = __builtin_amdgcn_exp2f(-__builtin_amdgcn_exp2f(wlog * LOG2E) * LOG2E); }
                        else AL[st * 65 + 16 * n + fr] = __builtin_amdgcn_rcpf(1.0f + __builtin_amdgcn_exp2f(-x * LOG2E));
                    }
                }
            }
            __syncthreads();
            {
                const float* kkp = P.in[I_KK] + l * 512 + hc0 + 8 * pcg; const float* kap = P.in[I_KA] + l * 512 + hc0 + 8 * pcg; const float* rkp = P.in[I_RK] + l * 512 + hc0 + 8 * pcg;
                float a8[8], kk[8], kd[8]; float ss = 0.f, bon = 0.f;
#pragma unroll
                for (int e = 0; e < 8; ++e) { a8[e] = AL[ps * 65 + 8 * pcg + e]; kk[e] = k8[e] * kkp[e]; ss += kk[e] * kk[e]; kd[e] = k8[e] * (1.0f + (a8[e] - 1.0f) * kap[e]); bon += r8[e] * kd[e] * rkp[e]; }
                ss += __shfl_xor(ss, 1); ss += __shfl_xor(ss, 2); ss += __shfl_xor(ss, 4);
                bon += __shfl_xor(bon, 1); bon += __shfl_xor(bon, 2); bon += __shfl_xor(bon, 4);
                const float rn = 1.0f / fmaxf(sqrtf(ss), 1e-12f);
                float* sp = scr + ps * 320 + 8 * pcg;
                *(f4*)(sp + 64) = (f4){kd[0], kd[1], kd[2], kd[3]}; *(f4*)(sp + 68) = (f4){kd[4], kd[5], kd[6], kd[7]};
                *(f4*)(sp + 128) = (f4){-kk[0] * rn, -kk[1] * rn, -kk[2] * rn, -kk[3] * rn}; *(f4*)(sp + 132) = (f4){-kk[4] * rn, -kk[5] * rn, -kk[6] * rn, -kk[7] * rn};
                *(f4*)(sp + 192) = (f4){kk[0] * rn * a8[0], kk[1] * rn * a8[1], kk[2] * rn * a8[2], kk[3] * rn * a8[3]}; *(f4*)(sp + 196) = (f4){kk[4] * rn * a8[4], kk[5] * rn * a8[5], kk[6] * rn * a8[6], kk[7] * rn * a8[7]};
                *(f4*)(sp + 256) = (f4){r8[0], r8[1], r8[2], r8[3]}; *(f4*)(sp + 260) = (f4){r8[4], r8[5], r8[6], r8[7]};
                if (pcg == 0) BONUS[((size_t)((dir * NB + b) * 8 + h)) * S_ + tp] = bon;
            }
            asm volatile("s_waitcnt vmcnt(0) lgkmcnt(0)" ::: "memory");
            __syncthreads();
            const float* sb = scr + wave * 8;
            f8s w8, kd8, nk8, bb8, rr8;
            asm volatile("s_load_dwordx8 %0, %5, 0 glc\n\ts_load_dwordx8 %1, %5, 256 glc\n\ts_load_dwordx8 %2, %5, 512 glc\n\ts_load_dwordx8 %3, %5, 768 glc\n\ts_load_dwordx8 %4, %5, 1024 glc\n\ts_waitcnt lgkmcnt(0)"
                         : "=&s"(w8), "=&s"(kd8), "=&s"(nk8), "=&s"(bb8), "=&s"(rr8) : "s"(sb) : "memory");
#pragma unroll 1
            for (int s = 0; s < 64; ++s) {
                const float v = VS[s * 64 + lane];
                float part = 0.f;
#pragma unroll
                for (int j = 0; j < 8; ++j) part += S[j] * nk8[j];
                XCH[(s & 1) * 512 + wave * 64 + lane] = part;
                float Tt[8];
#pragma unroll
                for (int j = 0; j < 8; ++j) Tt[j] = S[j] * w8[j] + v * kd8[j];
                sb += 320;
                f8s nw8, nkd8, nnk8, nbb8, nrr8;
                asm volatile("s_load_dwordx8 %0, %5, 0 glc\n\ts_load_dwordx8 %1, %5, 256 glc\n\ts_load_dwordx8 %2, %5, 512 glc\n\ts_load_dwordx8 %3, %5, 768 glc\n\ts_load_dwordx8 %4, %5, 1024 glc\n\ts_waitcnt lgkmcnt(0)\n\ts_barrier"
                             : "=&s"(nw8), "=&s"(nkd8), "=&s"(nnk8), "=&s"(nbb8), "=&s"(nrr8) : "s"(sb) : "memory");
                float sa = 0.f;
#pragma unroll
                for (int w = 0; w < 8; ++w) sa += XCH[(s & 1) * 512 + w * 64 + lane];
                float y = 0.f;
#pragma unroll
                for (int j = 0; j < 8; ++j) { S[j] = Tt[j] + sa * bb8[j]; y += S[j] * rr8[j]; }
                w8 = nw8; kd8 = nkd8; nk8 = nnk8; bb8 = nbb8; rr8 = nrr8;
                YP[(s & 31) * 512 + wave * 64 + lane] = y;
                if ((s & 15) == 15) {
                    asm volatile("s_waitcnt lgkmcnt(0)\n\ts_barrier" ::: "memory");
                    const int sl = (s - 15) + (tid >> 5), i2 = (tid & 31) * 2;
                    float y0 = 0.f, y1 = 0.f;
#pragma unroll
                    for (int w = 0; w < 8; ++w) { const float2 t2 = *(const float2*)(YP + (sl & 31) * 512 + w * 64 + i2); y0 += t2.x; y1 += t2.y; }
                    const int tt = dir ? S_ - 1 - (step0 + sl) : step0 + sl;
                    *(unsigned*)(WKV + ((size_t)(b * S_ + tt)) * 512 + hc0 + i2) = cvtpk(y0, y1);
                }
            }
            __syncthreads();
        }
    }
}

struct ScanRaw { float c[5], p[5], n[5]; };
__device__ __forceinline__ void scan_load(ScanRaw& R, const bf16* PR, int b, int t, const int (&cols)[5]) {
    const bf16* pc = PR + ((size_t)(b * S_ + t)) * 2048;
#pragma unroll
    for (int i = 0; i < 5; ++i) { R.c[i] = bf2f(pc[cols[i]]); R.p[i] = t > 0 ? bf2f(pc[cols[i] - 2048]) : 0.f; R.n[i] = t < S_ - 1 ? bf2f(pc[cols[i] + 2048]) : 0.f; }
}
__device__ __forceinline__ void scan_naive(const Params& P, int l, unsigned char* ldsg) {
    STAGE_IDS
    if (wave != 0) return;
    unsigned char* ws = P.ws;
    const bf16* PR = (const bf16*)(ws + WS_PR); float* BONUS = (float*)(ws + WS_BONUS);
    float* sW2 = (float*)ldsg; float* sA2 = sW2 + 4096; float* sh = sA2 + 4096; float* sv = sh + 128;
    for (int sid = blockIdx.x; sid < 256; sid += gridDim.x) {
        const int dir = sid & 1, h = (sid >> 1) & 7, b = sid >> 4, hc = h * 64 + lane;
        bf16* WKV = (bf16*)(ws + (dir ? WS_WKVB : WS_WKVF));
        const float* w2b = P.in[I_W2] + (size_t)(l * 2 + dir) * 64 * 512; const float* a2b = P.in[I_A2] + (size_t)(l * 2 + dir) * 64 * 512;
        for (int m = 0; m < 64; ++m) { sW2[m * 64 + lane] = w2b[m * 512 + hc]; sA2[m * 64 + lane] = a2b[m * 512 + hc]; }
        const float* mu = P.in[I_MU] + (size_t)l * 1920;
        const int cols[5] = {hc, 512 + hc, 1024 + hc, 1536 + 64 * dir + lane, 1664 + 64 * dir + lane};
        float mus[5];
#pragma unroll
        for (int i = 0; i < 5; ++i) mus[i] = mu[cols[i]];
        const float w0c = P.in[I_W0][(size_t)(l * 2 + dir) * 512 + hc], a0c = P.in[I_A0][(size_t)(l * 2 + dir) * 512 + hc];
        const float kkc = P.in[I_KK][l * 512 + hc], kac = P.in[I_KA][l * 512 + hc], rkc = P.in[I_RK][l * 512 + hc];
        float S[64];
#pragma unroll
        for (int j = 0; j < 64; ++j) S[j] = 0.f;
        ScanRaw cur, nxt;
        scan_load(cur, PR, b, dir ? S_ - 1 : 0, cols);
        for (int step = 0; step < S_; ++step) {
            const int t = dir ? S_ - 1 - step : step;
            if (step + 1 < S_) scan_load(nxt, PR, b, dir ? t - 1 : t + 1, cols); else nxt = cur;
            float sx[5];
#pragma unroll
            for (int i = 0; i < 5; ++i) sx[i] = cur.c[i] + mus[i] * (0.5f * (cur.p[i] + cur.n[i]) - cur.c[i]);
            const float r = sx[0], k = sx[1], v = sx[2];
            sh[lane] = tanhf(sx[3]); sh[64 + lane] = sx[4];
            float wlin = w0c, alin = a0c;
#pragma unroll 8
            for (int m = 0; m < 64; ++m) { wlin += sh[m] * sW2[m * 64 + lane]; alin += sh[64 + m] * sA2[m * 64 + lane]; }
            const float wlog = -log1pf(expf(-wlin)) - 0.5f;
            const float decay = expf(-expf(wlog));
            const float a = 1.0f / (1.0f + expf(-alin));
            float kkv = k * kkc; const float nrm = sqrtf(wave_sum(kkv * kkv)); kkv = kkv / fmaxf(nrm, 1e-12f);
            const float kd = k * (1.0f + (a - 1.0f) * kac);
            const float bon = wave_sum(r * kd * rkc);
            if (lane == 0) BONUS[((size_t)((dir * NB + b) * 8 + h)) * S_ + t] = bon;
            sv[lane] = decay; sv[64 + lane] = kd; sv[128 + lane] = -kkv; sv[192 + lane] = kkv * a; sv[256 + lane] = r;
            float sa = 0.f;
#pragma unroll
            for (int j = 0; j < 64; ++j) sa += S[j] * sv[128 + j];
            float y = 0.f;
#pragma unroll
            for (int j = 0; j < 64; ++j) { S[j] = S[j] * sv[j] + sa * sv[192 + j] + v * sv[64 + j]; y += S[j] * sv[256 + j]; }
            WKV[((size_t)(b * S_ + t)) * 512 + hc] = (bf16)f2bf(y);
            cur = nxt;
        }
    }
}

__device__ __forceinline__ void finalize_naive(const Params& P, int l, unsigned char* ldsg) {
    STAGE_IDS
    unsigned char* ws = P.ws;
    const bf16* PR = (const bf16*)(ws + WS_PR); const bf16* WF = (const bf16*)(ws + WS_WKVF); const bf16* WBk = (const bf16*)(ws + WS_WKVB); const float* BONUS = (const float*)(ws + WS_BONUS);
    bf16* YA = (bf16*)(ws + WS_YA);
    float* sg = (float*)ldsg;
    const float* mu = P.in[I_MU] + (size_t)l * 1920; const float* g2 = P.in[I_G2] + (size_t)l * 128 * 512;
    const float lng = P.in[I_LNG][l * 512 + tid], lnb = P.in[I_LNB][l * 512 + tid];
    const float mu_v = mu[1024 + tid], mu_g = tid < 128 ? mu[1792 + tid] : 0.f;
    for (int t = blockIdx.x; t < T_; t += gridDim.x) {
        const int s = t & 2047; const bf16* pc = PR + (size_t)t * 2048;
        if (tid < 128) { const int col = 1792 + tid; const float c = bf2f(pc[col]), p = s > 0 ? bf2f(pc[col - 2048]) : 0.f, n = s < S_ - 1 ? bf2f(pc[col + 2048]) : 0.f;
            const float x = c + mu_g * (0.5f * (p + n) - c); sg[tid] = 1.0f / (1.0f + expf(-x)); }
        __syncthreads();
        float gate = 0.f;
#pragma unroll 8
        for (int m = 0; m < 128; ++m) gate += sg[m] * g2[m * 512 + tid];
        const float wkv = bf2f(WF[(size_t)t * 512 + tid]) + bf2f(WBk[(size_t)t * 512 + tid]);
        const float mean = wave_sum(wkv) * (1.0f / 64.0f); const float dv = wkv - mean; const float var = wave_sum(dv * dv) * (1.0f / 64.0f);
        float y = dv * (1.0f / sqrtf(var + 64e-5f)) * lng + lnb;
        { const int col = 1024 + tid; const float c = bf2f(pc[col]), p = s > 0 ? bf2f(pc[col - 2048]) : 0.f, n = s < S_ - 1 ? bf2f(pc[col + 2048]) : 0.f;
          const float vs = c + mu_v * (0.5f * (p + n) - c); const int h = tid >> 6;
          const int b = t >> 11; y += (BONUS[((size_t)(b * 8 + h)) * S_ + s] + BONUS[((size_t)((NB + b) * 8 + h)) * S_ + s]) * vs; }
        YA[(size_t)t * 512 + tid] = (bf16)f2bf(y * gate);
        __syncthreads();
    }
}

#ifndef DBG_NL
#define DBG_NL NL
#endif
#ifndef DBG_BR
#define DBG_BR 7
#endif
#ifndef DBG_STOP
#define DBG_STOP 0
#endif
#define L1_INVALIDATE() do { asm volatile("s_waitcnt vmcnt(0)" ::: "memory"); __builtin_amdgcn_fence(__ATOMIC_ACQUIRE, "agent"); asm volatile("s_waitcnt vmcnt(0)" ::: "memory"); } while (0)
#define GRID_SYNC() do { asm volatile("s_waitcnt vmcnt(0) lgkmcnt(0)" ::: "memory"); grid.sync(); __builtin_amdgcn_fence(__ATOMIC_ACQUIRE, "agent"); asm volatile("s_waitcnt vmcnt(0)" ::: "memory"); } while (0)
#define GEMM_PHASE(EPI, A_, Bt_, M_, N_, K_, E_) do { pg8::Gemm g_{(const pg8::bf16_t*)(A_), (const pg8::bf16_t*)(Bt_), (M_), (N_), (K_)}; pg8::StaticOrder S_o; S_o.init((M_), (N_), (int)gridDim.x, (int)blockIdx.x); \
    pg8::gemm_phase<EPI, pg8::StaticOrder, true, true>((PG8_LAS unsigned char*)lds, g_, S_o, (E_)); } while (0)

__global__ void __launch_bounds__(NTHREADS, 2) fwd_kernel(Params P) {
    extern __shared__ __attribute__((aligned(16))) unsigned char lds[];
    cg::grid_group grid = cg::this_grid();
    unsigned char* ws = P.ws;
    bf16* H = (bf16*)(ws + WS_H); bf16* ACT = (bf16*)(ws + WS_ACT);
#ifdef DBG_HA
    bf16* HA = (bf16*)(ws + WS_QC);
#else
    bf16* HA = H;
#endif
#pragma unroll 1
    for (int l = 0; l < DBG_NL; ++l) {
        const float* xin = (l == 0) ? P.in[I_X] : P.out;
        cvt_layer(P, l, lds);
        __syncthreads();
        rms_rows_bf16(xin, P.in[I_F1N] + l * DM, HA);
        GRID_SYNC();
        { pg8::EpiSwiglu E{(pg8::bf16_t*)ACT, FF}; GEMM_PHASE(pg8::EpiSwiglu, HA, ws + WS_WUP1, T_, 2 * FF, DM, E); }
        GRID_SYNC();
        { pg8::EpiResid E{xin, P.out, DM, 0.5f}; GEMM_PHASE(pg8::EpiResid, ACT, ws + WS_WDN1, T_, DM, FF, E); }
        GRID_SYNC();
#if DBG_STOP == 1
        break;
#endif
        rms_rows_bf16(P.out, P.in[I_MIXN] + l * DM, H);
        GRID_SYNC();
        { pg8::EpiWin E{(pg8::bf16_t*)(ws + WS_PR), (pg8::bf16_t*)(ws + WS_QB), (pg8::bf16_t*)(ws + WS_KVB), (pg8::bf16_t*)(ws + WS_QC), (pg8::bf16_t*)(ws + WS_KVC)};
          GEMM_PHASE(pg8::EpiWin, H, ws + WS_WIN, T_, 3584, DM, E); }
        GRID_SYNC();
#ifndef NO_QKPREP
        qkprep(P, l);
        vt_prep(P, lds);
        __syncthreads();
#endif
#ifdef NAIVE_SCAN
        scan_naive(P, l, lds);
#else
        scan_fast(P, l, lds);
#endif
        GRID_SYNC();
#ifndef NO_ATTN
        attn_mfma<false>((bf16*)(ws + WS_QB), (const bf16*)(ws + WS_KG), (const bf16*)(ws + WS_VG), nullptr, lds);
        attn_mfma<true>((bf16*)(ws + WS_QC), (const bf16*)(ws + WS_KW), (const bf16*)(ws + WS_VW), P.in[I_SINK] + l * 8, lds);
#endif
        __syncthreads();
#ifndef NO_FIN
        finalize_naive(P, l, lds);
#endif
        GRID_SYNC();
#pragma unroll 1
        for (int i = 0; i < 3; ++i) {
            { pg8::EpiGate E{(pg8::bf16_t*)(ws + WS_GATE)};
#ifdef DBG_GW
              GEMM_PHASE(pg8::EpiGate, H, ws + WS_WOUT, T_, DM, DM, E); }
#else
              GEMM_PHASE(pg8::EpiGate, H, ws + WS_WG + (size_t)i * DM * DM * 2, T_, DM, DM, E); }
#endif
            GRID_SYNC();
#ifdef DBG_YSRC
            const unsigned char* yi = ws + WS_H;
#else
            const unsigned char* yi = ws + (i == 0 ? WS_YA : (i == 1 ? WS_QB : WS_QC));
#endif
            { pg8::EpiMerge E{(const pg8::bf16_t*)(ws + WS_GATE), (pg8::bf16_t*)(ws + WS_MERGED), i == 0 ? 1 : 0}; GEMM_PHASE(pg8::EpiMerge, yi, ws + WS_WO + (size_t)i * DM * 512 * 2, T_, DM, 512, E); }
            if (i < 2) GRID_SYNC();
        }
        GRID_SYNC();
        { pg8::EpiResid E{P.out, P.out, DM, 1.0f}; GEMM_PHASE(pg8::EpiResid, ws + WS_MERGED, ws + WS_WOUT, T_, DM, DM, E); }
        GRID_SYNC();
#if DBG_STOP == 2
        break;
#endif
        rms_rows_bf16(P.out, P.in[I_F2N] + l * DM, H);
        GRID_SYNC();
        { pg8::EpiSwiglu E{(pg8::bf16_t*)ACT, FF}; GEMM_PHASE(pg8::EpiSwiglu, H, ws + WS_WUP2, T_, 2 * FF, DM, E); }
        GRID_SYNC();
        { pg8::EpiResid E{P.out, P.out, DM, 0.5f}; GEMM_PHASE(pg8::EpiResid, ACT, ws + WS_WDN2, T_, DM, FF, E); }
        GRID_SYNC();
    }
    rms_rows_f32_inplace(P.out, P.in[I_FINN]);
}

extern "C" void kernel_launch(void* const* d_in, const int* in_sizes, int n_in, void* d_out, int out_size, void* d_ws, size_t ws_size, hipStream_t stream) {
    static int grid_blocks = 0;
    if (grid_blocks == 0) {
        if (n_in != N_IN || out_size != T_ * DM || ws_size < WS_END) { fprintf(stderr, "kernel_launch: unexpected shapes (n_in %d, out %d, ws %zu < %zu)\n", n_in, out_size, ws_size, (size_t)WS_END); grid_blocks = -1; return; }
        int dev = 0, cus = 0, per_cu = 0;
        hipGetDevice(&dev);
        hipDeviceGetAttribute(&cus, hipDeviceAttributeMultiprocessorCount, dev);
        hipFuncSetAttribute((const void*)fwd_kernel, hipFuncAttributeMaxDynamicSharedMemorySize, LDS_BYTES);
        hipOccupancyMaxActiveBlocksPerMultiprocessor(&per_cu, (const void*)fwd_kernel, NTHREADS, LDS_BYTES);
        if (per_cu < 1) per_cu = 1;
        grid_blocks = cus * per_cu;
    }
    if (grid_blocks < 0) return;
    Params p{};
    for (int i = 0; i < N_IN; ++i) p.in[i] = (const float*)d_in[i];
    p.out = (float*)d_out; p.ws = (unsigned char*)d_ws;
    void* args[] = {&p};
    hipError_t e = hipLaunchCooperativeKernel((const void*)fwd_kernel, dim3(grid_blocks), dim3(NTHREADS), args, LDS_BYTES, stream);
    if (e != hipSuccess) fprintf(stderr, "cooperative launch failed: %s (grid %d)\n", hipGetErrorString(e), grid_blocks);
}
```

```cpp
#include <hip/hip_runtime.h>
#include <hip/hip_cooperative_groups.h>
#include <cstdio>
#include <cstdint>
namespace cg = cooperative_groups;
namespace pg8 {
#define PG8_LAS __attribute__((address_space(3)))
typedef unsigned short bf16_t;
typedef short bf16x8 __attribute__((ext_vector_type(8)));
typedef float f32x4 __attribute__((ext_vector_type(4)));
typedef unsigned u32x4 __attribute__((ext_vector_type(4)));
constexpr int BM = 256, BK = 64, HALF = 128, HTB = HALF * BK * 2  , STAGE_BYTES = 8 * HTB, NXCD = 8, WGM = 8;

__host__ __device__ __forceinline__ int lds_byte(int r, int c) { const int st = (r >> 4) * 2 + (c >> 5), rr = r & 15, cc = c & 31, ob = rr * 64 + cc * 2; return st * 1024 + (ob ^ (((ob >> 9) & 1) << 5)); }
__host__ __device__ __forceinline__ void stage_rc(int b, int& R, int& C) { const int st = b / 1024, sb = b % 1024, swz = sb ^ (((sb >> 9) & 1) << 5); R = (st >> 1) * 16 + swz / 64; C = (st & 1) * 32 + (swz % 64) / 2; }
__host__ __device__ __forceinline__ int perm32(int rho) { const int n = rho >> 4, i = rho & 15; return 8 * (i >> 2) + 4 * n + (i & 3); }

struct Unit { int pm, pn; };
struct Gemm { const bf16_t* A; const bf16_t* Bt; int M, N, K; };

struct StaticOrder {
    int nM, nN, nwg, G, c;
    __host__ __device__ void init(int M, int N, int G_, int c_) { nM = M / BM; nN = N / BM; nwg = nM * nN; G = G_; c = c_; }
    __host__ __device__ bool next(int i, Unit& u) const {
        const long L = (long)i * G + c; if (L >= nwg) return false;
        int wgid = (int)L; { const int q = nwg / NXCD, r = nwg % NXCD, xcd = wgid % NXCD, off = wgid / NXCD; wgid = (xcd < r ? xcd * (q + 1) : r * (q + 1) + (xcd - r) * q) + off; }
        const int nig = WGM * nN, gid = wgid / nig, fm = gid * WGM, gsz = (nM - fm) < WGM ? (nM - fm) : WGM;
        u.pm = fm + ((wgid % nig) % gsz); u.pn = (wgid % nig) / gsz; return true;
    }
    __device__ __forceinline__ void a_ready(const Unit&) const {}
    __device__ __forceinline__ void done(const Unit&) const {}
};
typedef float f32x2_t __attribute__((ext_vector_type(2))); typedef __bf16 bf16x2_t __attribute__((ext_vector_type(2)));
__device__ __forceinline__ unsigned cvt_pk_bf16(float lo, float hi) { f32x2_t v = {lo, hi}; bf16x2_t b = __builtin_convertvector(v, bf16x2_t); return __builtin_bit_cast(unsigned, b); }
typedef float f32x2 __attribute__((ext_vector_type(2)));
__device__ __forceinline__ float fast_sigmoid(float x) { return __builtin_amdgcn_rcpf(1.0f + __builtin_amdgcn_exp2f(-1.4426950408889634f * x)); }
__device__ __forceinline__ u32x4 ld16_agent(const bf16_t* p) { const unsigned long long a = __hip_atomic_load((const unsigned long long*)p, __ATOMIC_RELAXED, __HIP_MEMORY_SCOPE_AGENT), b = __hip_atomic_load((const unsigned long long*)p + 1, __ATOMIC_RELAXED, __HIP_MEMORY_SCOPE_AGENT); u32x4 r; r.x = (unsigned)a; r.y = (unsigned)(a >> 32); r.z = (unsigned)b; r.w = (unsigned)(b >> 32); return r; }
__device__ __forceinline__ float bf_lo(unsigned w) { return __uint_as_float(w << 16); }
__device__ __forceinline__ float bf_hi(unsigned w) { return __uint_as_float(w & 0xffff0000u); }

struct EpiSwiglu {
    static constexpr bool PERM = true, AFTER_DRAIN = false;
    bf16_t* O; int ldc;
    __device__ __forceinline__ void operator()(const f32x4 (&acc)[2][2][4][2], const Unit& u, int wr, int wc, int fr, int fq) const {
        const int row0 = u.pm * BM + wr * 64 + fr, col0 = u.pn * HALF + wc * 32 + 8 * fq;
#pragma unroll
        for (int ai = 0; ai < 2; ++ai)
#pragma unroll
            for (int m = 0; m < 4; ++m) {
                bf16_t* rowp = O + (size_t)(row0 + ai * HALF + m * 16) * ldc + col0;
                float v[8];
#pragma unroll
                for (int n = 0; n < 2; ++n)
#pragma unroll
                    for (int j = 0; j < 4; ++j) { const float g = acc[ai][0][m][n][j], up = acc[ai][1][m][n][j]; v[n * 4 + j] = g * fast_sigmoid(g) * up; }
                u32x4 w; w.x = cvt_pk_bf16(v[0], v[1]); w.y = cvt_pk_bf16(v[2], v[3]); w.z = cvt_pk_bf16(v[4], v[5]); w.w = cvt_pk_bf16(v[6], v[7]);
                *(u32x4*)rowp = w;
            }
    }
};
struct EpiResid {
    static constexpr bool PERM = false, AFTER_DRAIN = false;
    const float* src; float* dst; int ldc; float scale;
    __device__ __forceinline__ void operator()(const f32x4 (&acc)[2][2][4][2], const Unit& u, int wr, int wc, int fr, int fq) const {
        const int col0 = u.pn * BM + wc * 32 + 4 * fq;
#pragma unroll
        for (int ai = 0; ai < 2; ++ai)
#pragma unroll
            for (int m = 0; m < 4; ++m) {
                const size_t off = (size_t)(u.pm * BM + ai * HALF + wr * 64 + m * 16 + fr) * ldc + col0;
#pragma unroll
                for (int bj = 0; bj < 2; ++bj)
#pragma unroll
                    for (int n = 0; n < 2; ++n) { const f32x4 b = *(const f32x4*)(src + off + bj * HALF + n * 16); *(f32x4*)(dst + off + bj * HALF + n * 16) = b + acc[ai][bj][m][n] * scale; }
            }
    }
};
struct EpiWin {
    static constexpr bool PERM = true, AFTER_DRAIN = false;
    bf16_t *PR, *QB, *KVB, *QC, *KVC;
    __device__ __forceinline__ void operator()(const f32x4 (&acc)[2][2][4][2], const Unit& u, int wr, int wc, int fr, int fq) const {
        bf16_t* base; int ldc, colt;
        const int pn = u.pn;
        if (pn < 8) { base = PR; ldc = 2048; colt = pn * 256; }
        else if (pn < 10) { base = QB; ldc = 512; colt = (pn - 8) * 256; }
        else if (pn == 10) { base = KVB; ldc = 256; colt = 0; }
        else if (pn < 13) { base = QC; ldc = 512; colt = (pn - 11) * 256; }
        else { base = KVC; ldc = 256; colt = 0; }
        const int row0 = u.pm * BM + wr * 64 + fr, col0 = colt + wc * 32 + 8 * fq;
#pragma unroll
        for (int ai = 0; ai < 2; ++ai)
#pragma unroll
            for (int m = 0; m < 4; ++m) {
                bf16_t* rowp = base + (size_t)(row0 + ai * HALF + m * 16) * ldc + col0;
#pragma unroll
                for (int bj = 0; bj < 2; ++bj) { const f32x4 v0 = acc[ai][bj][m][0], v1 = acc[ai][bj][m][1];
                    u32x4 w; w.x = cvt_pk_bf16(v0[0], v0[1]); w.y = cvt_pk_bf16(v0[2], v0[3]); w.z = cvt_pk_bf16(v1[0], v1[1]); w.w = cvt_pk_bf16(v1[2], v1[3]);
                    *(u32x4*)(rowp + bj * HALF) = w; }
            }
    }
};
struct EpiGate {
    static constexpr bool PERM = true, AFTER_DRAIN = false;
    bf16_t* G;
    __device__ __forceinline__ void operator()(const f32x4 (&acc)[2][2][4][2], const Unit& u, int wr, int wc, int fr, int fq) const {
        const int row0 = u.pm * BM + wr * 64 + fr, col0 = u.pn * BM + wc * 32 + 8 * fq;
#pragma unroll
        for (int ai = 0; ai < 2; ++ai)
#pragma unroll
            for (int m = 0; m < 4; ++m) {
                bf16_t* rowp = G + (size_t)(row0 + ai * HALF + m * 16) * 1024 + col0;
#pragma unroll
                for (int bj = 0; bj < 2; ++bj) { const f32x4 v0 = acc[ai][bj][m][0], v1 = acc[ai][bj][m][1];
                    u32x4 w; w.x = cvt_pk_bf16(fast_sigmoid(v0[0]), fast_sigmoid(v0[1])); w.y = cvt_pk_bf16(fast_sigmoid(v0[2]), fast_sigmoid(v0[3]));
                    w.z = cvt_pk_bf16(fast_sigmoid(v1[0]), fast_sigmoid(v1[1])); w.w = cvt_pk_bf16(fast_sigmoid(v1[2]), fast_sigmoid(v1[3]));
#ifdef DBG_GCONST
                    w = (u32x4){0x3f003f00u, 0x3f003f00u, 0x3f003f00u, 0x3f003f00u};
#endif
                    *(u32x4*)(rowp + bj * HALF) = w; }
            }
    }
};
struct EpiMerge {
    static constexpr bool PERM = true, AFTER_DRAIN = false;
    const bf16_t* G; bf16_t* Mg; int first;
    __device__ __forceinline__ void operator()(const f32x4 (&acc)[2][2][4][2], const Unit& u, int wr, int wc, int fr, int fq) const {
        const int row0 = u.pm * BM + wr * 64 + fr, col0 = u.pn * BM + wc * 32 + 8 * fq;
#pragma unroll
        for (int ai = 0; ai < 2; ++ai)
#pragma unroll
            for (int m = 0; m < 4; ++m) {
                const size_t off = (size_t)(row0 + ai * HALF + m * 16) * 1024 + col0;
#pragma unroll
                for (int bj = 0; bj < 2; ++bj) { const f32x4 v0 = acc[ai][bj][m][0], v1 = acc[ai][bj][m][1];
#ifdef DBG_NOG
                    const u32x4 g = (u32x4){0x3f803f80u, 0x3f803f80u, 0x3f803f80u, 0x3f803f80u};
#else
                    const u32x4 g = *(const u32x4*)(G + off + bj * HALF);
#endif
                    float r[8];
                    r[0] = bf_lo(g.x) * v0[0]; r[1] = bf_hi(g.x) * v0[1]; r[2] = bf_lo(g.y) * v0[2]; r[3] = bf_hi(g.y) * v0[3];
                    r[4] = bf_lo(g.z) * v1[0]; r[5] = bf_hi(g.z) * v1[1]; r[6] = bf_lo(g.w) * v1[2]; r[7] = bf_hi(g.w) * v1[3];
#ifdef DBG_NOG
                    if (false) { const u32x4 p = *(const u32x4*)(Mg + off + bj * HALF);
#else
                    if (!first) { const u32x4 p = *(const u32x4*)(Mg + off + bj * HALF);
#endif
                        r[0] += bf_lo(p.x); r[1] += bf_hi(p.x); r[2] += bf_lo(p.y); r[3] += bf_hi(p.y); r[4] += bf_lo(p.z); r[5] += bf_hi(p.z); r[6] += bf_lo(p.w); r[7] += bf_hi(p.w); }
                    u32x4 w; w.x = cvt_pk_bf16(r[0], r[1]); w.y = cvt_pk_bf16(r[2], r[3]); w.z = cvt_pk_bf16(r[4], r[5]); w.w = cvt_pk_bf16(r[6], r[7]);
                    *(u32x4*)(Mg + off + bj * HALF) = w; }
            }
    }
};
template <class Epi, class Sched, bool ALIGN_EPI = false, bool SP2 = false>
__device__ __forceinline__ void gemm_phase(PG8_LAS unsigned char* lds, const Gemm g, const Sched& S, const Epi& E) {
    int tid_o = threadIdx.x; asm volatile("" : "+v"(tid_o));
    const int tid = tid_o, wid = __builtin_amdgcn_readfirstlane(tid >> 6), lane = tid & 63, wr = wid >> 2, wc = wid & 3, fr = lane & 15, fq = lane >> 4;
    const int K = g.K, nt = K / BK;
    unsigned voffA[2], voffB[2];
#pragma unroll
    for (int i = 0; i < 2; ++i) { int R, C; stage_rc(tid * 16 + i * 8192, R, C); const int Rb = Epi::PERM ? ((R & ~31) + perm32(R & 31)) : R;
        voffA[i] = (unsigned)(R * K + C) * 2u; voffB[i] = (unsigned)(Rb * K + C) * 2u; }
    const size_t kstep = (size_t)(BK * 2);
    const size_t hstep = (size_t)HALF * K * 2;
    const size_t tstep = 2 * hstep;
    const unsigned ldsw = (unsigned)wid * 1024u;
    const int aoff = lds_byte(wr * 64 + fr, fq * 8), boff = lds_byte(wc * 32 + fr, fq * 8);
#define PG8_SA(b, h) (((b) * 2 + (h)) * HTB)
#define PG8_SB(b, h) ((4 + (b) * 2 + (h)) * HTB)
#define PG8_STAGE(bufoff, gbase, voff) do { _Pragma("unroll") for (int _i = 0; _i < 2; ++_i) \
        __builtin_amdgcn_global_load_lds((const unsigned*)((const char*)(gbase) + (voff)[_i]), (PG8_LAS unsigned*)(lds + (bufoff) + ldsw + _i * 8192), 16, 0, 0); } while (0)
#define PG8_LDA(dst, b, h) do { _Pragma("unroll") for (int m = 0; m < 4; ++m) _Pragma("unroll") for (int k = 0; k < 2; ++k) dst[m][k] = *(const PG8_LAS bf16x8*)(lds + PG8_SA(b, h) + aoff + m * 2048 + k * 1024); } while (0)
#define PG8_LDB(dst, b, h) do { _Pragma("unroll") for (int n = 0; n < 2; ++n) _Pragma("unroll") for (int k = 0; k < 2; ++k) dst[n][k] = *(const PG8_LAS bf16x8*)(lds + PG8_SB(b, h) + boff + n * 2048 + k * 1024); } while (0)
#define PG8_MMA(ai, bj, At, Bt) do { __builtin_amdgcn_s_setprio(1); _Pragma("unroll") for (int m = 0; m < 4; ++m) _Pragma("unroll") for (int n = 0; n < 2; ++n) _Pragma("unroll") for (int k = 0; k < 2; ++k) \
        acc[ai][bj][m][n] = __builtin_amdgcn_mfma_f32_16x16x32_bf16(Bt[n][k], At[m][k], acc[ai][bj][m][n], 0, 0, 0); __builtin_amdgcn_s_setprio(0); } while (0)
#define PG8_WAIT_V(n) asm volatile("s_waitcnt vmcnt(" #n ")" ::: "memory")
#define PG8_WAIT_L(n) asm volatile("s_waitcnt lgkmcnt(" #n ")" ::: "memory")
#define PG8_BAR __builtin_amdgcn_s_barrier()
#define PG8_SCHED __builtin_amdgcn_sched_barrier(0)
    Unit cur, nxt; int ui = 0;
    if (!S.next(0, cur)) return;
    f32x4 acc[2][2][4][2];
#pragma unroll
    for (int a = 0; a < 2; ++a)
#pragma unroll
        for (int b = 0; b < 2; ++b)
#pragma unroll
            for (int m = 0; m < 4; ++m)
#pragma unroll
                for (int n = 0; n < 2; ++n) acc[a][b][m][n] = (f32x4){0.f, 0.f, 0.f, 0.f};
    bf16x8 At[4][2], B0[2][2], B1[2][2];
    const char* cA = (const char*)g.A + (size_t)cur.pm * tstep; const char* cB = (const char*)g.Bt + (size_t)cur.pn * tstep;
    S.a_ready(cur);
    if constexpr (SP2) {
        PG8_STAGE(PG8_SB(0, 0), cB, voffB); PG8_STAGE(PG8_SB(0, 1), cB + hstep, voffB); PG8_STAGE(PG8_SA(0, 0), cA, voffA); PG8_STAGE(PG8_SA(0, 1), cA + hstep, voffA);
        if (wr == 1) PG8_BAR;
        PG8_WAIT_V(2); PG8_BAR;
        PG8_STAGE(PG8_SB(1, 0), cB + kstep, voffB); PG8_STAGE(PG8_SA(1, 0), cA + kstep, voffA); PG8_STAGE(PG8_SB(1, 1), cB + hstep + kstep, voffB);
        PG8_WAIT_V(6); PG8_BAR;
    } else {
        PG8_STAGE(PG8_SB(0, 0), cB, voffB); PG8_STAGE(PG8_SA(0, 0), cA, voffA); PG8_STAGE(PG8_SB(0, 1), cB + hstep, voffB); PG8_STAGE(PG8_SA(0, 1), cA + hstep, voffA);
        if (wr == 1) PG8_BAR;
        PG8_WAIT_V(4); PG8_BAR;
        PG8_STAGE(PG8_SB(1, 0), cB + kstep, voffB); PG8_STAGE(PG8_SA(1, 0), cA + kstep, voffA); PG8_STAGE(PG8_SB(1, 1), cB + hstep + kstep, voffB);
        PG8_WAIT_V(6); PG8_BAR;
    }
    for (;;) {
        const bool has_next = S.next(ui + 1, nxt);
        const char* nA = has_next ? (const char*)g.A + (size_t)nxt.pm * tstep : cA; const char* nB = has_next ? (const char*)g.Bt + (size_t)nxt.pn * tstep : cB;
        for (int t = 0; t < nt; t += 2) {
            const bool last = (t == nt - 2);
            const char* a1 = cA + (size_t)(t + 1) * kstep;
            const char* a2 = last ? nA : cA + (size_t)(t + 2) * kstep; const char* b2 = last ? nB : cB + (size_t)(t + 2) * kstep;
            const char* a3 = a2 + kstep; const char* b3 = b2 + kstep;
            if (last && has_next) S.a_ready(nxt);
            if constexpr (SP2) {
            PG8_LDB(B0, 0, 0); PG8_LDB(B1, 0, 1); PG8_SCHED; PG8_LDA(At, 0, 0); PG8_STAGE(PG8_SA(1, 1), a1 + hstep, voffA);
            PG8_WAIT_V(8); PG8_WAIT_L(0); PG8_BAR; PG8_MMA(0, 0, At, B0); PG8_MMA(0, 1, At, B1); PG8_BAR; PG8_SCHED;
            PG8_LDA(At, 0, 1); PG8_STAGE(PG8_SB(0, 0), b2, voffB); PG8_STAGE(PG8_SB(0, 1), b2 + hstep, voffB); PG8_STAGE(PG8_SA(0, 0), a2, voffA);
            PG8_WAIT_V(8); PG8_WAIT_L(0); PG8_BAR; PG8_MMA(1, 0, At, B0); PG8_MMA(1, 1, At, B1); PG8_BAR; PG8_SCHED;
            PG8_LDB(B0, 1, 0); PG8_LDB(B1, 1, 1); PG8_SCHED; PG8_LDA(At, 1, 0); PG8_STAGE(PG8_SA(0, 1), a2 + hstep, voffA);
            PG8_WAIT_V(8); PG8_WAIT_L(0); PG8_BAR; PG8_MMA(0, 0, At, B0); PG8_MMA(0, 1, At, B1); PG8_BAR; PG8_SCHED;
            PG8_LDA(At, 1, 1); PG8_STAGE(PG8_SB(1, 0), b3, voffB); PG8_STAGE(PG8_SB(1, 1), b3 + hstep, voffB); PG8_STAGE(PG8_SA(1, 0), a3, voffA);
            PG8_WAIT_V(8); PG8_WAIT_L(0); PG8_BAR; PG8_MMA(1, 0, At, B0); PG8_MMA(1, 1, At, B1); PG8_BAR; PG8_SCHED;
            } else {
            PG8_LDB(B0, 0, 0); PG8_SCHED; PG8_LDA(At, 0, 0); PG8_STAGE(PG8_SA(1, 1), a1 + hstep, voffA);
            PG8_WAIT_L(8); PG8_BAR; PG8_WAIT_L(0); PG8_MMA(0, 0, At, B0); PG8_BAR; PG8_SCHED;
            PG8_LDB(B1, 0, 1); PG8_STAGE(PG8_SB(0, 0), b2, voffB);
            PG8_BAR; PG8_WAIT_L(0); PG8_MMA(0, 1, At, B1); PG8_BAR;
            PG8_LDA(At, 0, 1); PG8_STAGE(PG8_SA(0, 0), a2, voffA);
            PG8_BAR; PG8_WAIT_L(0); PG8_MMA(1, 0, At, B0); PG8_BAR; PG8_SCHED;
            PG8_STAGE(PG8_SB(0, 1), b2 + hstep, voffB);
            PG8_WAIT_V(6); PG8_BAR; PG8_MMA(1, 1, At, B1); PG8_BAR;
            PG8_LDB(B0, 1, 0); PG8_SCHED; PG8_LDA(At, 1, 0); PG8_STAGE(PG8_SA(0, 1), a2 + hstep, voffA);
            PG8_WAIT_L(8); PG8_BAR; PG8_WAIT_L(0); PG8_MMA(0, 0, At, B0); PG8_BAR; PG8_SCHED;
            PG8_LDB(B1, 1, 1); PG8_STAGE(PG8_SB(1, 0), b3, voffB);
            PG8_BAR; PG8_WAIT_L(0); PG8_MMA(0, 1, At, B1); PG8_BAR;
            PG8_LDA(At, 1, 1); PG8_STAGE(PG8_SA(1, 0), a3, voffA);
            PG8_BAR; PG8_WAIT_L(0); PG8_MMA(1, 0, At, B0); PG8_BAR; PG8_SCHED;
            PG8_STAGE(PG8_SB(1, 1), b3 + hstep, voffB);
            PG8_WAIT_V(6); PG8_BAR; PG8_MMA(1, 1, At, B1); PG8_BAR;
            }
        }
        if constexpr (ALIGN_EPI) { if (wr == 0) PG8_BAR; }
        if constexpr (!Epi::AFTER_DRAIN) { E(acc, cur, wr, wc, fr, fq); S.done(cur); }
        if (!has_next) break;
#pragma unroll
        for (int a = 0; a < 2; ++a)
#pragma unroll
            for (int b = 0; b < 2; ++b)
#pragma unroll
                for (int m = 0; m < 4; ++m)
#pragma unroll
                    for (int n = 0; n < 2; ++n) acc[a][b][m][n] = (f32x4){0.f, 0.f, 0.f, 0.f};
        cur = nxt; cA = nA; cB = nB; ++ui;
        if constexpr (ALIGN_EPI) { if (wr == 1) PG8_BAR; }
    }
    PG8_WAIT_V(0);
    if constexpr (!ALIGN_EPI) { if (wr == 0) PG8_BAR; }
    PG8_BAR;
    if constexpr (Epi::AFTER_DRAIN) { E.fused(acc, cur, wr, wc, fr, fq, lds, wid, lane); S.done(cur); }
#undef PG8_SA
#undef PG8_SB
#undef PG8_STAGE
#undef PG8_LDA
#undef PG8_LDB
#undef PG8_MMA
#undef PG8_WAIT_V
#undef PG8_WAIT_L
#undef PG8_BAR
#undef PG8_SCHED
}
}
#define LAS __attribute__((address_space(3)))
typedef unsigned short bf16;
typedef unsigned v4u __attribute__((ext_vector_type(4)));
typedef unsigned v2u __attribute__((ext_vector_type(2)));
typedef float f4 __attribute__((ext_vector_type(4)));
constexpr int T_ = 32768, S_ = 2048, NB = 16, DM = 1024, FF = 2816, NL = 4;
constexpr int NWAVES = 8, NTHREADS = 512;
constexpr int LDS_BYTES = 163840;
constexpr float LOG2E = 1.4426950408889634f;
constexpr float C2 = 0.125f * LOG2E;
constexpr float LOG2_THETA = 13.287712379549449f;

enum { I_X = 0, I_F1N, I_F1UP, I_F1DN, I_MIXN, I_WIN, I_MU, I_W0, I_W2, I_A0, I_A2, I_G2, I_KK, I_KA, I_RK, I_LNG, I_LNB, I_QN, I_KN, I_SINK,
       I_WOA, I_WOB, I_WOC, I_WOUT, I_F2N, I_F2UP, I_F2DN, I_FINN, N_IN };

constexpr size_t SZ_WUP = (size_t)2 * FF * DM * 2, SZ_WDN = (size_t)DM * FF * 2, SZ_WIN = (size_t)3584 * DM * 2, SZ_WG = (size_t)3072 * DM * 2,
                 SZ_WO = (size_t)3 * DM * 512 * 2, SZ_WOUT = (size_t)DM * DM * 2;
constexpr size_t WS_WUP1 = 0, WS_WDN1 = WS_WUP1 + SZ_WUP, WS_WIN = WS_WDN1 + SZ_WDN, WS_WG = WS_WIN + SZ_WIN, WS_WO = WS_WG + SZ_WG, WS_WOUT = WS_WO + SZ_WO,
                 WS_WUP2 = WS_WOUT + SZ_WOUT, WS_WDN2 = WS_WUP2 + SZ_WUP, WS_H = WS_WDN2 + SZ_WDN;
constexpr size_t WS_R = WS_H + (size_t)T_ * DM * 2;
constexpr size_t WS_ACT = WS_R;
constexpr size_t WS_PR = WS_R, WS_QB = WS_PR + (size_t)T_ * 2048 * 2, WS_KVB = WS_QB + (size_t)T_ * 512 * 2, WS_QC = WS_KVB + (size_t)T_ * 256 * 2, WS_KVC = WS_QC + (size_t)T_ * 512 * 2,
                 WS_KG = WS_KVC + (size_t)T_ * 256 * 2, WS_VG = WS_KG + (size_t)NB * 2 * S_ * 64 * 2, WS_KW = WS_VG + (size_t)NB * 2 * S_ * 64 * 2, WS_VW = WS_KW + (size_t)NB * 2 * S_ * 64 * 2,
                 WS_YA = WS_VW + (size_t)NB * 2 * S_ * 64 * 2, WS_WKVF = WS_YA + (size_t)T_ * 512 * 2, WS_WKVB = WS_WKVF + (size_t)T_ * 512 * 2, WS_BONUS = WS_WKVB + (size_t)T_ * 512 * 2,
                 WS_SCR = WS_BONUS + (size_t)T_ * 16 * 4, WS_END = WS_SCR + 4096;
#ifdef DBG_GATE_ALT
constexpr size_t WS_GATE = WS_WKVF, WS_MERGED = WS_PR + (size_t)T_ * DM * 2;
#else
constexpr size_t WS_GATE = WS_PR, WS_MERGED = WS_PR + (size_t)T_ * DM * 2;
#endif
static_assert(WS_ACT + (size_t)T_ * FF * 2 <= WS_END, "map");
static_assert(WS_END < 530000000ull, "workspace budget");

struct Params { const float* in[N_IN]; float* out; unsigned char* ws; };

__device__ __forceinline__ unsigned f2bf(float f) { unsigned u = __float_as_uint(f); return (u + 0x7fffu + ((u >> 16) & 1u)) >> 16; }
__device__ __forceinline__ unsigned pk2(float lo, float hi) { return f2bf(lo) | (f2bf(hi) << 16); }
__device__ __forceinline__ float bf2f(bf16 h) { return __uint_as_float((unsigned)h << 16); }
__device__ __forceinline__ int opaque_tid() { int t = threadIdx.x; asm volatile("" : "+v"(t)); return t; }
#define STAGE_IDS const int tid = opaque_tid(), lane = tid & 63, wave = __builtin_amdgcn_readfirstlane(tid >> 6); const int gw = blockIdx.x * NWAVES + wave, ngw = gridDim.x * NWAVES, gtid = blockIdx.x * NTHREADS + tid, gthreads = gridDim.x * NTHREADS; (void)lane; (void)gw; (void)ngw; (void)gtid; (void)gthreads;
__device__ __forceinline__ float wave_sum(float v) {
#pragma unroll
    for (int o = 1; o < 64; o <<= 1) v += __shfl_xor(v, o);
    return v;
}

__device__ __forceinline__ void cvt_wt(const float* W, int K, int ld, bf16* Wt, int nrows, int mode, int gw, int ngw, int lane, float* scr) {
    const int nblk = nrows >> 5, nitems = (K >> 6) * nblk;
    for (int it = gw; it < nitems; it += ngw) {
        const int kb = it / nblk, nb = it % nblk, k0 = kb * 64, n0 = nb * 32;
        int col0;
        if (mode == 0) col0 = n0;
        else if (mode == 1) { const int t = n0 >> 8, r = n0 & 255; col0 = (r < 128) ? t * 128 + r : FF + t * 128 + (r - 128); }
        else if (mode == 2) col0 = n0 < 1920 ? n0 : (n0 < 2048 ? -1 : n0 - 128);
        else col0 = 3456 + n0;
        if (col0 >= 0) {
#pragma unroll 8
            for (int i = 0; i < 32; ++i) { const int kk = 2 * i + (lane >> 5); scr[kk * 33 + (lane & 31)] = W[(size_t)(k0 + kk) * ld + col0 + (lane & 31)]; }
        }
        asm volatile("s_waitcnt lgkmcnt(0)" ::: "memory");
        const int c = lane & 7;
#pragma unroll
        for (int j = 0; j < 4; ++j) { const int n = (lane >> 3) + 8 * j; const float* sp = scr + (8 * c) * 33 + n;
            v4u o = (v4u){0u, 0u, 0u, 0u};
            if (col0 >= 0) { o.x = pk2(sp[0 * 33], sp[1 * 33]); o.y = pk2(sp[2 * 33], sp[3 * 33]); o.z = pk2(sp[4 * 33], sp[5 * 33]); o.w = pk2(sp[6 * 33], sp[7 * 33]); }
            *(v4u*)(Wt + (size_t)(n0 + n) * K + k0 + 8 * c) = o; }
        asm volatile("s_waitcnt lgkmcnt(0)" ::: "memory");
    }
}
__device__ __forceinline__ void cvt_layer(const Params& P, int l, unsigned char* ldsg) {
    STAGE_IDS
    unsigned char* ws = P.ws; float* scr = (float*)(ldsg + wave * 8448);
    cvt_wt(P.in[I_F1UP] + (size_t)l * DM * 2 * FF, DM, 2 * FF, (bf16*)(ws + WS_WUP1), 2 * FF, 1, gw, ngw, lane, scr);
    cvt_wt(P.in[I_F1DN] + (size_t)l * FF * DM, FF, DM, (bf16*)(ws + WS_WDN1), DM, 0, gw, ngw, lane, scr);
    cvt_wt(P.in[I_WIN] + (size_t)l * DM * 6528, DM, 6528, (bf16*)(ws + WS_WIN), 3584, 2, gw, ngw, lane, scr);
    cvt_wt(P.in[I_WIN] + (size_t)l * DM * 6528, DM, 6528, (bf16*)(ws + WS_WG), 3072, 3, gw, ngw, lane, scr);
    cvt_wt(P.in[I_WOA] + (size_t)l * 512 * DM, 512, DM, (bf16*)(ws + WS_WO), DM, 0, gw, ngw, lane, scr);
    cvt_wt(P.in[I_WOB] + (size_t)l * 512 * DM, 512, DM, (bf16*)(ws + WS_WO) + (size_t)DM * 512, DM, 0, gw, ngw, lane, scr);
    cvt_wt(P.in[I_WOC] + (size_t)l * 512 * DM, 512, DM, (bf16*)(ws + WS_WO) + (size_t)2 * DM * 512, DM, 0, gw, ngw, lane, scr);
    cvt_wt(P.in[I_WOUT] + (size_t)l * DM * DM, DM, DM, (bf16*)(ws + WS_WOUT), DM, 0, gw, ngw, lane, scr);
    cvt_wt(P.in[I_F2UP] + (size_t)l * DM * 2 * FF, DM, 2 * FF, (bf16*)(ws + WS_WUP2), 2 * FF, 1, gw, ngw, lane, scr);
    cvt_wt(P.in[I_F2DN] + (size_t)l * FF * DM, FF, DM, (bf16*)(ws + WS_WDN2), DM, 0, gw, ngw, lane, scr);
}

__device__ __forceinline__ void rms_rows_bf16(const float* x, const float* g, bf16* o) {
    STAGE_IDS
    const f4* gr = (const f4*)g + lane; f4 gv[4];
#pragma unroll
    for (int j = 0; j < 4; ++j) gv[j] = gr[64 * j];
    for (int m = gw; m < T_; m += ngw) {
        const f4* xr = (const f4*)(x + (size_t)m * DM) + lane; f4 v[4]; float s = 0.f;
#pragma unroll
        for (int j = 0; j < 4; ++j) { v[j] = xr[64 * j]; s += (v[j].x * v[j].x + v[j].y * v[j].y) + (v[j].z * v[j].z + v[j].w * v[j].w); }
        const float rs = 1.0f / sqrtf(wave_sum(s) * (1.0f / DM) + 1e-6f);
        v2u* op = (v2u*)(o + (size_t)m * DM) + lane;
#pragma unroll
        for (int j = 0; j < 4; ++j) { v2u w; w.x = pk2(v[j].x * rs * gv[j].x, v[j].y * rs * gv[j].y); w.y = pk2(v[j].z * rs * gv[j].z, v[j].w * rs * gv[j].w); op[64 * j] = w; }
    }
}
__device__ __forceinline__ void rms_rows_f32_inplace(float* x, const float* g) {
    STAGE_IDS
    const f4* gr = (const f4*)g + lane; f4 gv[4];
#pragma unroll
    for (int j = 0; j < 4; ++j) gv[j] = gr[64 * j];
    for (int m = gw; m < T_; m += ngw) {
        f4* xr = (f4*)(x + (size_t)m * DM) + lane; f4 v[4]; float s = 0.f;
#pragma unroll
        for (int j = 0; j < 4; ++j) { v[j] = xr[64 * j]; s += (v[j].x * v[j].x + v[j].y * v[j].y) + (v[j].z * v[j].z + v[j].w * v[j].w); }
        const float rs = 1.0f / sqrtf(wave_sum(s) * (1.0f / DM) + 1e-6f);
#pragma unroll
        for (int j = 0; j < 4; ++j) xr[64 * j] = v[j] * rs * gv[j];
    }
}

__device__ __forceinline__ float fast_sin_rev(float rev) { return __builtin_amdgcn_sinf(__builtin_amdgcn_fractf(rev)); }
__device__ __forceinline__ float fast_cos_rev(float rev) { return __builtin_amdgcn_cosf(__builtin_amdgcn_fractf(rev)); }
__device__ __forceinline__ void qkprep(const Params& P, int l) {
    STAGE_IDS
    unsigned char* ws = P.ws;
    bf16* QB = (bf16*)(ws + WS_QB); const bf16* KVB = (const bf16*)(ws + WS_KVB); bf16* QC = (bf16*)(ws + WS_QC); const bf16* KVC = (const bf16*)(ws + WS_KVC);
    bf16* KG = (bf16*)(ws + WS_KG); bf16* KW = (bf16*)(ws + WS_KW);
    const float qg = P.in[I_QN][l * 64 + lane], kg = P.in[I_KN][l * 64 + lane];
    const float inv_ax = exp2f(-(float)(lane & 15) * (LOG2_THETA / 16.0f)), inv_1d = exp2f(-(float)(lane & 31) * (LOG2_THETA / 32.0f));
    const float INV2PI = 0.15915494309189535f;
    for (int t = gw; t < T_; t += ngw) {
        const int b = t >> 11, s = t & 2047;
        const float pos = lane < 32 ? (float)(s >> 6) : (float)(s & 63);
        const float ra = (pos * inv_ax) * INV2PI, r1 = ((float)s * inv_1d) * INV2PI;
        const float csa = fast_cos_rev(ra), sna = (lane & 16) ? fast_sin_rev(ra) : -fast_sin_rev(ra);
        const float cs1 = fast_cos_rev(r1), sn1 = (lane & 32) ? fast_sin_rev(r1) : -fast_sin_rev(r1);
#pragma unroll
        for (int slot = 0; slot < 10; ++slot) {
            bf16* src = slot < 8 ? QB + (size_t)t * 512 + slot * 64 : (bf16*)KVB + (size_t)t * 256 + (slot - 8) * 64;
            const float x = bf2f(src[lane]);
            const float ss = wave_sum(x * x) * (1.0f / 64.0f);
            const float y = x * (1.0f / sqrtf(ss + 1e-6f)) * (slot < 8 ? qg : kg);
            const float r = y * csa + __shfl_xor(y, 16) * sna;
            if (slot < 8) src[lane] = (bf16)f2bf(r * C2);
            else KG[((size_t)(b * 2 + (slot - 8)) * S_ + s) * 64 + lane] = (bf16)f2bf(r);
        }
#pragma unroll
        for (int slot = 0; slot < 10; ++slot) {
            bf16* src = slot < 8 ? QC + (size_t)t * 512 + slot * 64 : (bf16*)KVC + (size_t)t * 256 + (slot - 8) * 64;
            const float x = bf2f(src[lane]);
            const float r = x * cs1 + __shfl_xor(x, 32) * sn1;
            if (slot < 8) src[lane] = (bf16)f2bf(r * C2);
            else KW[((size_t)(b * 2 + (slot - 8)) * S_ + s) * 64 + lane] = (bf16)f2bf(r);
        }
    }
}

__device__ __forceinline__ void vt_prep(const Params& P, unsigned char* ldsg) {
    STAGE_IDS
    unsigned char* ws = P.ws;
    bf16* tile = (bf16*)(ldsg + wave * 8448);
    for (int it = gw; it < 2 * NB * 2 * 32; it += ngw) {
        const int tb = it & 31, kvh = (it >> 5) & 1, b = (it >> 6) & 15, att = it >> 10;
        const bf16* src = (const bf16*)(ws + (att ? WS_KVC : WS_KVB)) + (size_t)(b * S_ + tb * 64) * 256 + 128 + kvh * 64;
        bf16* dst = (bf16*)(ws + (att ? WS_VW : WS_VG)) + (size_t)(b * 2 + kvh) * 64 * S_ + tb * 64;
#pragma unroll 8
        for (int r = 0; r < 64; ++r) tile[r * 66 + lane] = src[(size_t)r * 256 + lane];
        asm volatile("s_waitcnt lgkmcnt(0)" ::: "memory");
#pragma unroll 8
        for (int d = 0; d < 64; ++d) dst[(size_t)d * S_ + lane] = tile[lane * 66 + d];
        asm volatile("s_waitcnt lgkmcnt(0)" ::: "memory");
    }
}

typedef short bf16x8_t __attribute__((ext_vector_type(8)));
typedef short s16x4_t __attribute__((ext_vector_type(4)));
typedef float f32x16 __attribute__((ext_vector_type(16)));
typedef float f32x2a __attribute__((ext_vector_type(2))); typedef __bf16 bf16x2a __attribute__((ext_vector_type(2)));
__device__ __forceinline__ unsigned cvtpk(float lo, float hi) { f32x2a v = {lo, hi}; bf16x2a b = __builtin_convertvector(v, bf16x2a); return __builtin_bit_cast(unsigned, b); }
__device__ __forceinline__ int crow(int r, int hi) { return (r & 3) + 8 * (r >> 2) + 4 * hi; }
template <bool WINDOW>
__device__ __forceinline__ void attn_mfma(bf16* Q, const bf16* Kx, const bf16* VTx, const float* sink, unsigned char* ldsg) {
    STAGE_IDS
    const int r32 = lane & 31, hi = lane >> 5, g = wave >> 1, qs = wave & 1;
    const int srow = tid >> 3, sch = tid & 7;
    for (int unit = blockIdx.x; unit < 1024; unit += gridDim.x) {
        const int qb = unit & 31, kvh = (unit >> 5) & 1, b = unit >> 6, h = kvh * 4 + g, q0 = qb * 64 + qs * 32;
        bf16* qp = Q + ((size_t)(b * S_ + q0 + r32)) * 512 + h * 64;
        bf16x8_t qr[4];
#pragma unroll
        for (int d0 = 0; d0 < 4; ++d0) qr[d0] = *(const bf16x8_t*)(qp + 16 * d0 + 8 * hi);
        f32x16 o0, o1;
#pragma unroll
        for (int r = 0; r < 16; ++r) { o0[r] = 0.f; o1[r] = 0.f; }
        float m, l;
        if (WINDOW) { m = sink[h] * LOG2E; l = hi == 0 ? 1.0f : 0.f; } else { m = -1e30f; l = 0.f; }
        const int t0 = WINDOW ? (qb - 2 > 0 ? qb - 2 : 0) : 0, t1 = WINDOW ? (qb + 2 < 31 ? qb + 2 : 31) : 31;
        const bf16* kbase = Kx + (size_t)(b * 2 + kvh) * S_ * 64 + (size_t)srow * 64 + sch * 8;
        const bf16* vbase = VTx + (size_t)(b * 2 + kvh) * 64 * S_ + (size_t)srow * S_ + sch * 8;
        v4u kreg = *(const v4u*)(kbase + (size_t)t0 * 64 * 64);
        v4u vreg = *(const v4u*)(vbase + t0 * 64);
        __syncthreads();
        *(v4u*)(ldsg + srow * 144 + sch * 16) = kreg;
        *(v4u*)(ldsg + 9216 + srow * 144 + sch * 16) = vreg;
        __syncthreads();
        for (int t = t0; t <= t1; ++t) {
            const int buf = (t - t0) & 1;
            if (t < t1) { kreg = *(const v4u*)(kbase + (size_t)(t + 1) * 64 * 64); vreg = *(const v4u*)(vbase + (t + 1) * 64); }
            const unsigned char* Kb = ldsg + buf * 18432; const unsigned char* Vb = Kb + 9216;
            f32x16 p0, p1;
#pragma unroll
            for (int r = 0; r < 16; ++r) { p0[r] = 0.f; p1[r] = 0.f; }
#pragma unroll
            for (int d0 = 0; d0 < 4; ++d0) {
                const bf16x8_t a0 = *(const bf16x8_t*)(Kb + r32 * 144 + (16 * d0 + 8 * hi) * 2);
                const bf16x8_t a1 = *(const bf16x8_t*)(Kb + (32 + r32) * 144 + (16 * d0 + 8 * hi) * 2);
                p0 = __builtin_amdgcn_mfma_f32_32x32x16_bf16(a0, qr[d0], p0, 0, 0, 0);
                p1 = __builtin_amdgcn_mfma_f32_32x32x16_bf16(a1, qr[d0], p1, 0, 0, 0);
            }
            if (WINDOW) {
                const int qpos = q0 + r32;
#pragma unroll
                for (int r = 0; r < 16; ++r) { const int kv = t * 64 + crow(r, hi); int dlt = qpos - kv; dlt = dlt < 0 ? -dlt : dlt; if (dlt > 128) p0[r] = -1e30f;
                    int dl2 = qpos - (kv + 32); dl2 = dl2 < 0 ? -dl2 : dl2; if (dl2 > 128) p1[r] = -1e30f; }
            }
            float mt = fmaxf(p0[0], p1[0]);
#pragma unroll
            for (int r = 1; r < 16; ++r) mt = fmaxf(mt, fmaxf(p0[r], p1[r]));
            mt = fmaxf(mt, __shfl_xor(mt, 32));
            const float mn = fmaxf(m, mt), corr = __builtin_amdgcn_exp2f(m - mn); m = mn;
            float ps = 0.f;
#pragma unroll
            for (int r = 0; r < 16; ++r) { p0[r] = __builtin_amdgcn_exp2f(p0[r] - mn); p1[r] = __builtin_amdgcn_exp2f(p1[r] - mn); ps += p0[r] + p1[r]; }
            l = l * corr + ps;
#pragma unroll
            for (int r = 0; r < 16; ++r) { o0[r] *= corr; o1[r] *= corr; }
            v4u pw[4];
            pw[0] = (v4u){cvtpk(p0[0], p0[1]), cvtpk(p0[2], p0[3]), cvtpk(p0[4], p0[5]), cvtpk(p0[6], p0[7])};
            pw[1] = (v4u){cvtpk(p0[8], p0[9]), cvtpk(p0[10], p0[11]), cvtpk(p0[12], p0[13]), cvtpk(p0[14], p0[15])};
            pw[2] = (v4u){cvtpk(p1[0], p1[1]), cvtpk(p1[2], p1[3]), cvtpk(p1[4], p1[5]), cvtpk(p1[6], p1[7])};
            pw[3] = (v4u){cvtpk(p1[8], p1[9]), cvtpk(p1[10], p1[11]), cvtpk(p1[12], p1[13]), cvtpk(p1[14], p1[15])};
#pragma unroll
            for (int kb = 0; kb < 4; ++kb) {
                const bf16x8_t pb = __builtin_bit_cast(bf16x8_t, pw[kb]);
                { const unsigned char* vp = Vb + r32 * 144 + (16 * kb + 4 * hi) * 2; const s16x4_t lo = *(const s16x4_t*)vp, hh = *(const s16x4_t*)(vp + 16);
                  const bf16x8_t a = (bf16x8_t){lo[0], lo[1], lo[2], lo[3], hh[0], hh[1], hh[2], hh[3]};
                  o0 = __builtin_amdgcn_mfma_f32_32x32x16_bf16(a, pb, o0, 0, 0, 0); }
                { const unsigned char* vp = Vb + (32 + r32) * 144 + (16 * kb + 4 * hi) * 2; const s16x4_t lo = *(const s16x4_t*)vp, hh = *(const s16x4_t*)(vp + 16);
                  const bf16x8_t a = (bf16x8_t){lo[0], lo[1], lo[2], lo[3], hh[0], hh[1], hh[2], hh[3]};
                  o1 = __builtin_amdgcn_mfma_f32_32x32x16_bf16(a, pb, o1, 0, 0, 0); }
            }
            if (t < t1) { unsigned char* nb = ldsg + (buf ^ 1) * 18432; *(v4u*)(nb + srow * 144 + sch * 16) = kreg; *(v4u*)(nb + 9216 + srow * 144 + sch * 16) = vreg; }
            __syncthreads();
        }
        l += __shfl_xor(l, 32);
        const float inv = 1.0f / l;
#pragma unroll
        for (int g4 = 0; g4 < 4; ++g4) {
            v2u w0, w1;
            w0.x = cvtpk(o0[4 * g4 + 0] * inv, o0[4 * g4 + 1] * inv); w0.y = cvtpk(o0[4 * g4 + 2] * inv, o0[4 * g4 + 3] * inv);
            w1.x = cvtpk(o1[4 * g4 + 0] * inv, o1[4 * g4 + 1] * inv); w1.y = cvtpk(o1[4 * g4 + 2] * inv, o1[4 * g4 + 3] * inv);
            *(v2u*)(qp + 8 * g4 + 4 * hi) = w0;
            *(v2u*)(qp + 32 + 8 * g4 + 4 * hi) = w1;
        }
    }
}

__device__ __forceinline__ void attn_naive(bf16* Q, const bf16* Kx, const bf16* Vx, const float* sink, int window) {
    STAGE_IDS
    for (int it = gtid; it < T_ * 8; it += gthreads) {
        const int q = it & 2047, h = (it >> 11) & 7, b = it >> 14, kvh = h >> 2;
        bf16* qp = Q + ((size_t)(b * S_ + q)) * 512 + h * 64;
        float qf[64], o[64];
#pragma unroll
        for (int c = 0; c < 8; ++c) { const v4u w = ((const v4u*)qp)[c];
            qf[c * 8 + 0] = __uint_as_float(w.x << 16); qf[c * 8 + 1] = __uint_as_float(w.x & 0xffff0000u); qf[c * 8 + 2] = __uint_as_float(w.y << 16); qf[c * 8 + 3] = __uint_as_float(w.y & 0xffff0000u);
            qf[c * 8 + 4] = __uint_as_float(w.z << 16); qf[c * 8 + 5] = __uint_as_float(w.z & 0xffff0000u); qf[c * 8 + 6] = __uint_as_float(w.w << 16); qf[c * 8 + 7] = __uint_as_float(w.w & 0xffff0000u); }
#pragma unroll
        for (int d = 0; d < 64; ++d) o[d] = 0.f;
        float m, lsum;
        if (sink) { m = sink[h] * LOG2E; lsum = 1.0f; } else { m = -1e30f; lsum = 0.f; }
        const int k0 = window ? (q - 128 > 0 ? q - 128 : 0) : 0, k1 = window ? (q + 128 < S_ - 1 ? q + 128 : S_ - 1) : S_ - 1;
        const bf16* kp = Kx + (size_t)(b * 2 + kvh) * S_ * 64; const bf16* vp = Vx + (size_t)(b * 2 + kvh) * S_ * 64;
        for (int k = k0; k <= k1; ++k) {
            const v4u* kr = (const v4u*)(kp + (size_t)k * 64); float s = 0.f;
#pragma unroll
            for (int c = 0; c < 8; ++c) { const v4u w = kr[c];
                s += qf[c * 8 + 0] * __uint_as_float(w.x << 16) + qf[c * 8 + 1] * __uint_as_float(w.x & 0xffff0000u) + qf[c * 8 + 2] * __uint_as_float(w.y << 16) + qf[c * 8 + 3] * __uint_as_float(w.y & 0xffff0000u)
                   + qf[c * 8 + 4] * __uint_as_float(w.z << 16) + qf[c * 8 + 5] * __uint_as_float(w.z & 0xffff0000u) + qf[c * 8 + 6] * __uint_as_float(w.w << 16) + qf[c * 8 + 7] * __uint_as_float(w.w & 0xffff0000u); }
            const float mn = fmaxf(m, s), corr = exp2f(m - mn), p = exp2f(s - mn);
            lsum = lsum * corr + p; m = mn;
            const v4u* vr = (const v4u*)(vp + (size_t)k * 64);
#pragma unroll
            for (int c = 0; c < 8; ++c) { const v4u w = vr[c];
                o[c * 8 + 0] = o[c * 8 + 0] * corr + p * __uint_as_float(w.x << 16); o[c * 8 + 1] = o[c * 8 + 1] * corr + p * __uint_as_float(w.x & 0xffff0000u);
                o[c * 8 + 2] = o[c * 8 + 2] * corr + p * __uint_as_float(w.y << 16); o[c * 8 + 3] = o[c * 8 + 3] * corr + p * __uint_as_float(w.y & 0xffff0000u);
                o[c * 8 + 4] = o[c * 8 + 4] * corr + p * __uint_as_float(w.z << 16); o[c * 8 + 5] = o[c * 8 + 5] * corr + p * __uint_as_float(w.z & 0xffff0000u);
                o[c * 8 + 6] = o[c * 8 + 6] * corr + p * __uint_as_float(w.w << 16); o[c * 8 + 7] = o[c * 8 + 7] * corr + p * __uint_as_float(w.w & 0xffff0000u); }
        }
        const float inv = 1.0f / lsum;
#pragma unroll
        for (int c = 0; c < 8; ++c) { v4u w; w.x = pk2(o[c * 8 + 0] * inv, o[c * 8 + 1] * inv); w.y = pk2(o[c * 8 + 2] * inv, o[c * 8 + 3] * inv); w.z = pk2(o[c * 8 + 4] * inv, o[c * 8 + 5] * inv); w.w = pk2(o[c * 8 + 6] * inv, o[c * 8 + 7] * inv);
            ((v4u*)qp)[c] = w; }
    }
}


typedef float f8s __attribute__((ext_vector_type(8)));
typedef float f32x4m __attribute__((ext_vector_type(4)));
constexpr int SC_VEC = 0, SC_VS = 81920, SC_W2T = 98304, SC_A2T = 107520, SC_XCH = 116736, SC_YP = 120832, SC_A1 = SC_YP, SC_A2 = SC_YP + 9216, SC_AL = SC_YP + 18432, SC_END = SC_AL + 16640;
static_assert(SC_END <= LDS_BYTES, "scan LDS");
__device__ __forceinline__ void ld8bf(const bf16* p, float (&f)[8]) { const v4u w = *(const v4u*)p;
    f[0] = __uint_as_float(w.x << 16); f[1] = __uint_as_float(w.x & 0xffff0000u); f[2] = __uint_as_float(w.y << 16); f[3] = __uint_as_float(w.y & 0xffff0000u);
    f[4] = __uint_as_float(w.z << 16); f[5] = __uint_as_float(w.z & 0xffff0000u); f[6] = __uint_as_float(w.w << 16); f[7] = __uint_as_float(w.w & 0xffff0000u); }
__device__ __forceinline__ void shifted8(const bf16* pc, int col, bool hasp, bool hasn, const float* mu, float (&o)[8]) {
    float c[8], p[8], n[8];
    ld8bf(pc + col, c);
    if (hasp) ld8bf(pc + col - 2048, p); else { for (int e = 0; e < 8; ++e) p[e] = 0.f; }
    if (hasn) ld8bf(pc + col + 2048, n); else { for (int e = 0; e < 8; ++e) n[e] = 0.f; }
    const f4 m0 = *(const f4*)(mu + col), m1 = *(const f4*)(mu + col + 4);
    const float mm[8] = {m0.x, m0.y, m0.z, m0.w, m1.x, m1.y, m1.z, m1.w};
#pragma unroll
    for (int e = 0; e < 8; ++e) o[e] = c[e] + mm[e] * (0.5f * (p[e] + n[e]) - c[e]);
}
__device__ __forceinline__ void scan_fast(const Params& P, int l, unsigned char* ldsg) {
    STAGE_IDS
    unsigned char* ws = P.ws;
    const bf16* PR = (const bf16*)(ws + WS_PR); float* BONUS = (float*)(ws + WS_BONUS);
    float* VEC = (float*)(ldsg + SC_VEC);
    const int fr = lane & 15, fq = lane >> 4, ps = tid >> 3, pcg = tid & 7;
    float* XCH = (float*)(ldsg + SC_XCH); float* YP = (float*)(ldsg + SC_YP); float* VS = (float*)(ldsg + SC_VS); float* AL = (float*)(ldsg + SC_AL);
    for (int sid = blockIdx.x; sid < 256; sid += gridDim.x) {
        const int dir = sid & 1, h = (sid >> 1) & 7, b = sid >> 4, hc0 = h * 64;
        bf16* WKV = (bf16*)(ws + (dir ? WS_WKVB : WS_WKVF));
        const float* mu = P.in[I_MU] + (size_t)l * 1920;
        __syncthreads();
        {
            const float* w2b = P.in[I_W2] + (size_t)(l * 2 + dir) * 64 * 512 + (size_t)ps * 512 + hc0 + 8 * pcg;
            const float* a2b = P.in[I_A2] + (size_t)(l * 2 + dir) * 64 * 512 + (size_t)ps * 512 + hc0 + 8 * pcg;
#pragma unroll
            for (int e = 0; e < 8; ++e) { ((bf16*)(ldsg + SC_W2T))[(8 * pcg + e) * 72 + ps] = (bf16)f2bf(w2b[e]); ((bf16*)(ldsg + SC_A2T))[(8 * pcg + e) * 72 + ps] = (bf16)f2bf(a2b[e]); }
        }
        float S[8];
#pragma unroll
        for (int j = 0; j < 8; ++j) S[j] = 0.f;
#pragma unroll 1
        for (int ch = 0; ch < S_ / 64; ++ch) {
            const int step0 = ch * 64;
            const int tp = dir ? S_ - 1 - (step0 + ps) : step0 + ps;
            const bf16* pc = PR + ((size_t)(b * S_ + tp)) * 2048;
            const bool hasp = tp > 0, hasn = tp < S_ - 1;
            float r8[8], k8[8], v8[8];
            shifted8(pc, hc0 + 8 * pcg, hasp, hasn, mu, r8);
            shifted8(pc, 512 + hc0 + 8 * pcg, hasp, hasn, mu, k8);
            shifted8(pc, 1024 + hc0 + 8 * pcg, hasp, hasn, mu, v8);
            { float wl[8], al[8];
              shifted8(pc, 1536 + 64 * dir + 8 * pcg, hasp, hasn, mu, wl);
              shifted8(pc, 1664 + 64 * dir + 8 * pcg, hasp, hasn, mu, al);
#pragma unroll
              for (int e = 0; e < 8; ++e) { const float t2 = __builtin_amdgcn_exp2f(2.0f * LOG2E * wl[e]); wl[e] = (t2 - 1.0f) * __builtin_amdgcn_rcpf(t2 + 1.0f); }
              v4u w1, w2v; w1.x = cvtpk(wl[0], wl[1]); w1.y = cvtpk(wl[2], wl[3]); w1.z = cvtpk(wl[4], wl[5]); w1.w = cvtpk(wl[6], wl[7]);
              w2v.x = cvtpk(al[0], al[1]); w2v.y = cvtpk(al[2], al[3]); w2v.z = cvtpk(al[4], al[5]); w2v.w = cvtpk(al[6], al[7]);
              *(v4u*)(ldsg + SC_A1 + ps * 144 + pcg * 16) = w1; *(v4u*)(ldsg + SC_A2 + ps * 144 + pcg * 16) = w2v; }
            *(f4*)(VS + ps * 64 + 8 * pcg) = (f4){v8[0], v8[1], v8[2], v8[3]}; *(f4*)(VS + ps * 64 + 8 * pcg + 4) = (f4){v8[4], v8[5], v8[6], v8[7]};
            __syncthreads();
            {
                const int wq = wave & 3; const bool isw = wave < 4;
                const unsigned char* Ab = ldsg + (isw ? SC_A1 : SC_A2) + (16 * wq + fr) * 144 + 16 * fq;
                const unsigned char* Bb = ldsg + (isw ? SC_W2T : SC_A2T) + fr * 144 + 16 * fq;
                const bf16x8_t a0 = *(const bf16x8_t*)Ab, a1 = *(const bf16x8_t*)(Ab + 64);
                const float* bias = P.in[isw ? I_W0 : I_A0] + (size_t)(l * 2 + dir) * 512 + hc0;
#pragma unroll
                for (int n = 0; n < 4; ++n) {
                    const bf16x8_t b0 = *(const bf16x8_t*)(Bb + n * 16 * 144), b1 = *(const bf16x8_t*)(Bb + n * 16 * 144 + 64);
                    f32x4m acc = (f32x4m){0.f, 0.f, 0.f, 0.f};
                    acc = __builtin_amdgcn_mfma_f32_16x16x32_bf16(a0, b0, acc, 0, 0, 0);
                    acc = __builtin_amdgcn_mfma_f32_16x16x32_bf16(a1, b1, acc, 0, 0, 0);
                    const float bz = bias[16 * n + fr];
#pragma unroll
                    for (int v = 0; v < 4; ++v) {
                        const int st = 16 * wq + 4 * fq + v; const float x = acc[v] + bz;
                        if (isw) { const float sp = __builtin_amdgcn_logf(1.0f + __builtin_amdgcn_exp2f(-x * LOG2E)) * 0.6931471805599453f;
                                   const float wlog = -sp - 0.5f; VEC[st * 320 + (2 * n + (fr >> 3)) * 40 + (fr & 7)] = __builtin_amdgcn_exp2f(-__builtin_amdgcn_exp2f(wlog * LOG2E) * LOG2E); }
                        else AL[st * 65 + 16 * n + fr] = __builtin_amdgcn_rcpf(1.0f + __builtin_amdgcn_exp2f(-x * LOG2E));
                    }
                }
            }
            __syncthreads();
            {
                const float* kkp = P.in[I_KK] + l * 512 + hc0 + 8 * pcg; const float* kap = P.in[I_KA] + l * 512 + hc0 + 8 * pcg; const float* rkp = P.in[I_RK] + l * 512 + hc0 + 8 * pcg;
                float a8[8], kk[8], kd[8]; float ss = 0.f, bon = 0.f;
#pragma unroll
                for (int e = 0; e < 8; ++e) { a8[e] = AL[ps * 65 + 8 * pcg + e]; kk[e] = k8[e] * kkp[e]; ss += kk[e] * kk[e]; kd[e] = k8[e] * (1.0f + (a8[e] - 1.0f) * kap[e]); bon += r8[e] * kd[e] * rkp[e]; }
                ss += __shfl_xor(ss, 1); ss += __shfl_xor(ss, 2); ss += __shfl_xor(ss, 4);
                bon += __shfl_xor(bon, 1); bon += __shfl_xor(bon, 2); bon += __shfl_xor(bon, 4);
                const float rn = 1.0f / fmaxf(sqrtf(ss), 1e-12f);
                float* sp = VEC + ps * 320 + 40 * pcg;
                *(f4*)(sp + 8) = (f4){kd[0], kd[1], kd[2], kd[3]}; *(f4*)(sp + 12) = (f4){kd[4], kd[5], kd[6], kd[7]};
                *(f4*)(sp + 16) = (f4){-kk[0] * rn, -kk[1] * rn, -kk[2] * rn, -kk[3] * rn}; *(f4*)(sp + 20) = (f4){-kk[4] * rn, -kk[5] * rn, -kk[6] * rn, -kk[7] * rn};
                *(f4*)(sp + 24) = (f4){kk[0] * rn * a8[0], kk[1] * rn * a8[1], kk[2] * rn * a8[2], kk[3] * rn * a8[3]}; *(f4*)(sp + 28) = (f4){kk[4] * rn * a8[4], kk[5] * rn * a8[5], kk[6] * rn * a8[6], kk[7] * rn * a8[7]};
                *(f4*)(sp + 32) = (f4){r8[0], r8[1], r8[2], r8[3]}; *(f4*)(sp + 36) = (f4){r8[4], r8[5], r8[6], r8[7]};
                if (pcg == 0) BONUS[((size_t)((dir * NB + b) * 8 + h)) * S_ + tp] = bon;
            }
            asm volatile("s_waitcnt vmcnt(0) lgkmcnt(0)" ::: "memory");
            __syncthreads();
            const float* vecb = VEC + wave * 40 + (lane < 40 ? lane : 0);
            float xv = vecb[0];
#pragma unroll 1
            for (int s = 0; s < 64; ++s) {
                const float xn = vecb[((s + 1) & 63) * 320];
                const float v = VS[s * 64 + lane];
                float w8[8], kd8[8], nk8[8], bb8[8], rr8[8];
#pragma unroll
                for (int j = 0; j < 8; ++j) { w8[j] = __int_as_float(__builtin_amdgcn_readlane(__float_as_int(xv), j)); kd8[j] = __int_as_float(__builtin_amdgcn_readlane(__float_as_int(xv), 8 + j));
                    nk8[j] = __int_as_float(__builtin_amdgcn_readlane(__float_as_int(xv), 16 + j)); bb8[j] = __int_as_float(__builtin_amdgcn_readlane(__float_as_int(xv), 24 + j));
                    rr8[j] = __int_as_float(__builtin_amdgcn_readlane(__float_as_int(xv), 32 + j)); }
                float pa = S[0] * nk8[0], pb = S[1] * nk8[1];
                pa += S[2] * nk8[2]; pb += S[3] * nk8[3]; pa += S[4] * nk8[4]; pb += S[5] * nk8[5]; pa += S[6] * nk8[6]; pb += S[7] * nk8[7];
                XCH[(s & 1) * 512 + wave * 64 + lane] = pa + pb;
                float Tt[8];
#pragma unroll
                for (int j = 0; j < 8; ++j) Tt[j] = S[j] * w8[j] + v * kd8[j];
                asm volatile("s_waitcnt lgkmcnt(0)\n\ts_barrier" ::: "memory");
                const float* xp = XCH + (s & 1) * 512 + lane;
                const float sa = ((xp[0] + xp[64]) + (xp[128] + xp[192])) + ((xp[256] + xp[320]) + (xp[384] + xp[448]));
                float ya = 0.f, yb = 0.f;
#pragma unroll
                for (int j = 0; j < 8; j += 2) { S[j] = Tt[j] + sa * bb8[j]; S[j + 1] = Tt[j + 1] + sa * bb8[j + 1]; ya += S[j] * rr8[j]; yb += S[j + 1] * rr8[j + 1]; }
                YP[(s & 15) * 512 + wave * 64 + lane] = ya + yb;
                xv = xn;
                if ((s & 7) == 7) {
                    asm volatile("s_waitcnt lgkmcnt(0)\n\ts_barrier" ::: "memory");
                    const int sl = (s - 7) + wave;
                    const float* yp = YP + (sl & 15) * 512 + lane;
                    const float y0 = ((yp[0] + yp[64]) + (yp[128] + yp[192])) + ((yp[256] + yp[320]) + (yp[384] + yp[448]));
                    const int tt = dir ? S_ - 1 - (step0 + sl) : step0 + sl;
                    WKV[((size_t)(b * S_ + tt)) * 512 + hc0 + lane] = (bf16)f2bf(y0);
                }
            }
            __syncthreads();
        }
    }
}

struct ScanRaw { float c[5], p[5], n[5]; };
__device__ __forceinline__ void scan_load(ScanRaw& R, const bf16* PR, int b, int t, const int (&cols)[5]) {
    const bf16* pc = PR + ((size_t)(b * S_ + t)) * 2048;
#pragma unroll
    for (int i = 0; i < 5; ++i) { R.c[i] = bf2f(pc[cols[i]]); R.p[i] = t > 0 ? bf2f(pc[cols[i] - 2048]) : 0.f; R.n[i] = t < S_ - 1 ? bf2f(pc[cols[i] + 2048]) : 0.f; }
}
__device__ __forceinline__ void scan_naive(const Params& P, int l, unsigned char* ldsg) {
    STAGE_IDS
    if (wave != 0) return;
    unsigned char* ws = P.ws;
    const bf16* PR = (const bf16*)(ws + WS_PR); float* BONUS = (float*)(ws + WS_BONUS);
    float* sW2 = (float*)ldsg; float* sA2 = sW2 + 4096; float* sh = sA2 + 4096; float* sv = sh + 128;
    for (int sid = blockIdx.x; sid < 256; sid += gridDim.x) {
        const int dir = sid & 1, h = (sid >> 1) & 7, b = sid >> 4, hc = h * 64 + lane;
        bf16* WKV = (bf16*)(ws + (dir ? WS_WKVB : WS_WKVF));
        const float* w2b = P.in[I_W2] + (size_t)(l * 2 + dir) * 64 * 512; const float* a2b = P.in[I_A2] + (size_t)(l * 2 + dir) * 64 * 512;
        for (int m = 0; m < 64; ++m) { sW2[m * 64 + lane] = w2b[m * 512 + hc]; sA2[m * 64 + lane] = a2b[m * 512 + hc]; }
        const float* mu = P.in[I_MU] + (size_t)l * 1920;
        const int cols[5] = {hc, 512 + hc, 1024 + hc, 1536 + 64 * dir + lane, 1664 + 64 * dir + lane};
        float mus[5];
#pragma unroll
        for (int i = 0; i < 5; ++i) mus[i] = mu[cols[i]];
        const float w0c = P.in[I_W0][(size_t)(l * 2 + dir) * 512 + hc], a0c = P.in[I_A0][(size_t)(l * 2 + dir) * 512 + hc];
        const float kkc = P.in[I_KK][l * 512 + hc], kac = P.in[I_KA][l * 512 + hc], rkc = P.in[I_RK][l * 512 + hc];
        float S[64];
#pragma unroll
        for (int j = 0; j < 64; ++j) S[j] = 0.f;
        ScanRaw cur, nxt;
        scan_load(cur, PR, b, dir ? S_ - 1 : 0, cols);
        for (int step = 0; step < S_; ++step) {
            const int t = dir ? S_ - 1 - step : step;
            if (step + 1 < S_) scan_load(nxt, PR, b, dir ? t - 1 : t + 1, cols); else nxt = cur;
            float sx[5];
#pragma unroll
            for (int i = 0; i < 5; ++i) sx[i] = cur.c[i] + mus[i] * (0.5f * (cur.p[i] + cur.n[i]) - cur.c[i]);
            const float r = sx[0], k = sx[1], v = sx[2];
            sh[lane] = tanhf(sx[3]); sh[64 + lane] = sx[4];
            float wlin = w0c, alin = a0c;
#pragma unroll 8
            for (int m = 0; m < 64; ++m) { wlin += sh[m] * sW2[m * 64 + lane]; alin += sh[64 + m] * sA2[m * 64 + lane]; }
            const float wlog = -log1pf(expf(-wlin)) - 0.5f;
            const float decay = expf(-expf(wlog));
            const float a = 1.0f / (1.0f + expf(-alin));
            float kkv = k * kkc; const float nrm = sqrtf(wave_sum(kkv * kkv)); kkv = kkv / fmaxf(nrm, 1e-12f);
            const float kd = k * (1.0f + (a - 1.0f) * kac);
            const float bon = wave_sum(r * kd * rkc);
            if (lane == 0) BONUS[((size_t)((dir * NB + b) * 8 + h)) * S_ + t] = bon;
            sv[lane] = decay; sv[64 + lane] = kd; sv[128 + lane] = -kkv; sv[192 + lane] = kkv * a; sv[256 + lane] = r;
            float sa = 0.f;
#pragma unroll
            for (int j = 0; j < 64; ++j) sa += S[j] * sv[128 + j];
            float y = 0.f;
#pragma unroll
            for (int j = 0; j < 64; ++j) { S[j] = S[j] * sv[j] + sa * sv[192 + j] + v * sv[64 + j]; y += S[j] * sv[256 + j]; }
            WKV[((size_t)(b * S_ + t)) * 512 + hc] = (bf16)f2bf(y);
            cur = nxt;
        }
    }
}


__device__ __forceinline__ void finalize_fast(const Params& P, int l, unsigned char* ldsg) {
    STAGE_IDS
    unsigned char* ws = P.ws;
    const bf16* PR = (const bf16*)(ws + WS_PR); const bf16* WF = (const bf16*)(ws + WS_WKVF); const bf16* WBk = (const bf16*)(ws + WS_WKVB); const float* BONUS = (const float*)(ws + WS_BONUS);
    bf16* YA = (bf16*)(ws + WS_YA);
    const int fr = lane & 15, fq = lane >> 4;
    const float* mu = P.in[I_MU] + (size_t)l * 1920; const float* g2 = P.in[I_G2] + (size_t)l * 128 * 512;
    const float* lngp = P.in[I_LNG] + l * 512; const float* lnbp = P.in[I_LNB] + l * 512;
    bf16x8_t gf[4][4];
#pragma unroll
    for (int n = 0; n < 4; ++n)
#pragma unroll
        for (int ks = 0; ks < 4; ++ks) { float gv[8];
#pragma unroll
            for (int e = 0; e < 8; ++e) gv[e] = g2[(size_t)(32 * ks + 8 * fq + e) * 512 + 64 * wave + 16 * n + fr];
            const v4u w = (v4u){cvtpk(gv[0], gv[1]), cvtpk(gv[2], gv[3]), cvtpk(gv[4], gv[5]), cvtpk(gv[6], gv[7])};
            gf[n][ks] = __builtin_bit_cast(bf16x8_t, w); }
    for (int tile = blockIdx.x; tile < T_ / 32; tile += gridDim.x) {
        const int t0 = tile * 32;
        __syncthreads();
        { const int tok = tid >> 4, mg = tid & 15, t = t0 + tok, s = t & 2047; float x[8];
          shifted8(PR + (size_t)t * 2048, 1792 + 8 * mg, s > 0, s < S_ - 1, mu, x);
#pragma unroll
          for (int e = 0; e < 8; ++e) x[e] = __builtin_amdgcn_rcpf(1.0f + __builtin_amdgcn_exp2f(-x[e] * LOG2E));
          *(v4u*)(ldsg + tok * 272 + mg * 16) = (v4u){cvtpk(x[0], x[1]), cvtpk(x[2], x[3]), cvtpk(x[4], x[5]), cvtpk(x[6], x[7])}; }
        __syncthreads();
#pragma unroll
        for (int mt = 0; mt < 2; ++mt) {
            f32x4m acc[4];
#pragma unroll
            for (int n = 0; n < 4; ++n) acc[n] = (f32x4m){0.f, 0.f, 0.f, 0.f};
#pragma unroll
            for (int ks = 0; ks < 4; ++ks) { const bf16x8_t bb = *(const bf16x8_t*)(ldsg + (16 * mt + fr) * 272 + (32 * ks + 8 * fq) * 2);
#pragma unroll
                for (int n = 0; n < 4; ++n) acc[n] = __builtin_amdgcn_mfma_f32_16x16x32_bf16(gf[n][ks], bb, acc[n], 0, 0, 0); }
            const int t = t0 + 16 * mt + fr, s = t & 2047, bb_ = t >> 11;
            float wk[4][4]; float sm = 0.f;
#pragma unroll
            for (int n = 0; n < 4; ++n) { const int c0 = 64 * wave + 16 * n + 4 * fq;
                const v2u a = *(const v2u*)(WF + (size_t)t * 512 + c0), b2 = *(const v2u*)(WBk + (size_t)t * 512 + c0);
                wk[n][0] = __uint_as_float(a.x << 16) + __uint_as_float(b2.x << 16); wk[n][1] = __uint_as_float(a.x & 0xffff0000u) + __uint_as_float(b2.x & 0xffff0000u);
                wk[n][2] = __uint_as_float(a.y << 16) + __uint_as_float(b2.y << 16); wk[n][3] = __uint_as_float(a.y & 0xffff0000u) + __uint_as_float(b2.y & 0xffff0000u);
                sm += (wk[n][0] + wk[n][1]) + (wk[n][2] + wk[n][3]); }
            sm += __shfl_xor(sm, 16); sm += __shfl_xor(sm, 32);
            const float mean = sm * (1.0f / 64.0f); float sq = 0.f;
#pragma unroll
            for (int n = 0; n < 4; ++n)
#pragma unroll
                for (int v = 0; v < 4; ++v) { wk[n][v] -= mean; sq += wk[n][v] * wk[n][v]; }
            sq += __shfl_xor(sq, 16); sq += __shfl_xor(sq, 32);
            const float rstd = 1.0f / sqrtf(sq * (1.0f / 64.0f) + 64e-5f);
            const float bon = BONUS[((size_t)(bb_ * 8 + wave)) * S_ + s] + BONUS[((size_t)((NB + bb_) * 8 + wave)) * S_ + s];
            const bf16* pc = PR + (size_t)t * 2048;
#pragma unroll
            for (int n = 0; n < 4; ++n) { const int c0 = 64 * wave + 16 * n + 4 * fq;
                const f4 lg = *(const f4*)(lngp + c0), lb = *(const f4*)(lnbp + c0), mv = *(const f4*)(mu + 1024 + c0);
                const v2u vc = *(const v2u*)(pc + 1024 + c0);
                v2u vp = (v2u){0u, 0u}, vn = (v2u){0u, 0u};
                if (s > 0) vp = *(const v2u*)(pc + 1024 + c0 - 2048);
                if (s < S_ - 1) vn = *(const v2u*)(pc + 1024 + c0 + 2048);
                const float cc[4] = {__uint_as_float(vc.x << 16), __uint_as_float(vc.x & 0xffff0000u), __uint_as_float(vc.y << 16), __uint_as_float(vc.y & 0xffff0000u)};
                const float pp[4] = {__uint_as_float(vp.x << 16), __uint_as_float(vp.x & 0xffff0000u), __uint_as_float(vp.y << 16), __uint_as_float(vp.y & 0xffff0000u)};
                const float nn[4] = {__uint_as_float(vn.x << 16), __uint_as_float(vn.x & 0xffff0000u), __uint_as_float(vn.y << 16), __uint_as_float(vn.y & 0xffff0000u)};
                float yv[4];
#pragma unroll
                for (int v = 0; v < 4; ++v) { const float vs = cc[v] + mv[v] * (0.5f * (pp[v] + nn[v]) - cc[v]);
                    yv[v] = (wk[n][v] * rstd * lg[v] + lb[v] + bon * vs) * acc[n][v]; }
                *(v2u*)(YA + (size_t)t * 512 + c0) = (v2u){cvtpk(yv[0], yv[1]), cvtpk(yv[2], yv[3])}; }
        }
    }
}

__device__ __forceinline__ void finalize_naive(const Params& P, int l, unsigned char* ldsg) {
    STAGE_IDS
    unsigned char* ws = P.ws;
    const bf16* PR = (const bf16*)(ws + WS_PR); const bf16* WF = (const bf16*)(ws + WS_WKVF); const bf16* WBk = (const bf16*)(ws + WS_WKVB); const float* BONUS = (const float*)(ws + WS_BONUS);
    bf16* YA = (bf16*)(ws + WS_YA);
    float* sg = (float*)ldsg;
    const float* mu = P.in[I_MU] + (size_t)l * 1920; const float* g2 = P.in[I_G2] + (size_t)l * 128 * 512;
    const float lng = P.in[I_LNG][l * 512 + tid], lnb = P.in[I_LNB][l * 512 + tid];
    const float mu_v = mu[1024 + tid], mu_g = tid < 128 ? mu[1792 + tid] : 0.f;
    for (int t = blockIdx.x; t < T_; t += gridDim.x) {
        const int s = t & 2047; const bf16* pc = PR + (size_t)t * 2048;
        if (tid < 128) { const int col = 1792 + tid; const float c = bf2f(pc[col]), p = s > 0 ? bf2f(pc[col - 2048]) : 0.f, n = s < S_ - 1 ? bf2f(pc[col + 2048]) : 0.f;
            const float x = c + mu_g * (0.5f * (p + n) - c); sg[tid] = 1.0f / (1.0f + expf(-x)); }
        __syncthreads();
        float gate = 0.f;
#pragma unroll 8
        for (int m = 0; m < 128; ++m) gate += sg[m] * g2[m * 512 + tid];
        const float wkv = bf2f(WF[(size_t)t * 512 + tid]) + bf2f(WBk[(size_t)t * 512 + tid]);
        const float mean = wave_sum(wkv) * (1.0f / 64.0f); const float dv = wkv - mean; const float var = wave_sum(dv * dv) * (1.0f / 64.0f);
        float y = dv * (1.0f / sqrtf(var + 64e-5f)) * lng + lnb;
        { const int col = 1024 + tid; const float c = bf2f(pc[col]), p = s > 0 ? bf2f(pc[col - 2048]) : 0.f, n = s < S_ - 1 ? bf2f(pc[col + 2048]) : 0.f;
          const float vs = c + mu_v * (0.5f * (p + n) - c); const int h = tid >> 6;
          const int b = t >> 11; y += (BONUS[((size_t)(b * 8 + h)) * S_ + s] + BONUS[((size_t)((NB + b) * 8 + h)) * S_ + s]) * vs; }
        YA[(size_t)t * 512 + tid] = (bf16)f2bf(y * gate);
        __syncthreads();
    }
}

#ifndef DBG_NL
#define DBG_NL NL
#endif
#ifndef DBG_BR
#define DBG_BR 7
#endif
#ifndef DBG_STOP
#define DBG_STOP 0
#endif
#define L1_INVALIDATE() do { asm volatile("s_waitcnt vmcnt(0)" ::: "memory"); __builtin_amdgcn_fence(__ATOMIC_ACQUIRE, "agent"); asm volatile("s_waitcnt vmcnt(0)" ::: "memory"); } while (0)
#define GRID_SYNC() do { asm volatile("s_waitcnt vmcnt(0) lgkmcnt(0)" ::: "memory"); grid.sync(); __builtin_amdgcn_fence(__ATOMIC_ACQUIRE, "agent"); asm volatile("s_waitcnt vmcnt(0)" ::: "memory"); } while (0)
#define GEMM_PHASE(EPI, A_, Bt_, M_, N_, K_, E_) do { pg8::Gemm g_{(const pg8::bf16_t*)(A_), (const pg8::bf16_t*)(Bt_), (M_), (N_), (K_)}; pg8::StaticOrder S_o; S_o.init((M_), (N_), (int)gridDim.x, (int)blockIdx.x); \
    pg8::gemm_phase<EPI, pg8::StaticOrder, true, true>((PG8_LAS unsigned char*)lds, g_, S_o, (E_)); } while (0)

#ifdef TPROBE
#define TP_DECL unsigned long long tp_acc[4] = {0, 0, 0, 0}, tp_t0 = 0;
#define TP_BEGIN() do { tp_t0 = __builtin_amdgcn_s_memrealtime(); } while (0)
#define TP_END(k) do { tp_acc[k] += __builtin_amdgcn_s_memrealtime() - tp_t0; } while (0)
#else
#define TP_DECL
#define TP_BEGIN() do {} while (0)
#define TP_END(k) do {} while (0)
#endif
__global__ void __launch_bounds__(NTHREADS, 2) fwd_kernel(Params P) {
    extern __shared__ __attribute__((aligned(16))) unsigned char lds[];
    cg::grid_group grid = cg::this_grid();
    unsigned char* ws = P.ws;
    bf16* H = (bf16*)(ws + WS_H); bf16* ACT = (bf16*)(ws + WS_ACT);
    TP_DECL
#ifdef DBG_HA
    bf16* HA = (bf16*)(ws + WS_QC);
#else
    bf16* HA = H;
#endif
#pragma unroll 1
    for (int l = 0; l < DBG_NL; ++l) {
        const float* xin = (l == 0) ? P.in[I_X] : P.out;
        cvt_layer(P, l, lds);
        __syncthreads();
        rms_rows_bf16(xin, P.in[I_F1N] + l * DM, HA);
        GRID_SYNC();
        { pg8::EpiSwiglu E{(pg8::bf16_t*)ACT, FF}; GEMM_PHASE(pg8::EpiSwiglu, HA, ws + WS_WUP1, T_, 2 * FF, DM, E); }
        GRID_SYNC();
        { pg8::EpiResid E{xin, P.out, DM, 0.5f}; GEMM_PHASE(pg8::EpiResid, ACT, ws + WS_WDN1, T_, DM, FF, E); }
        GRID_SYNC();
#if DBG_STOP == 1
        break;
#endif
        rms_rows_bf16(P.out, P.in[I_MIXN] + l * DM, H);
        GRID_SYNC();
        { pg8::EpiWin E{(pg8::bf16_t*)(ws + WS_PR), (pg8::bf16_t*)(ws + WS_QB), (pg8::bf16_t*)(ws + WS_KVB), (pg8::bf16_t*)(ws + WS_QC), (pg8::bf16_t*)(ws + WS_KVC)};
          GEMM_PHASE(pg8::EpiWin, H, ws + WS_WIN, T_, 3584, DM, E); }
        GRID_SYNC();
#ifndef NO_QKPREP
        TP_BEGIN();
        qkprep(P, l);
        vt_prep(P, lds);
        __syncthreads();
        TP_END(0);
        TP_BEGIN();
#endif
#ifdef NAIVE_SCAN
        scan_naive(P, l, lds);
#else
        scan_fast(P, l, lds);
#ifdef DUP_SCAN
        __syncthreads();
        scan_fast(P, l, lds);
#endif
#endif
        TP_END(1);
        GRID_SYNC();
#ifndef NO_ATTN
        TP_BEGIN();
        attn_mfma<false>((bf16*)(ws + WS_QB), (const bf16*)(ws + WS_KG), (const bf16*)(ws + WS_VG), nullptr, lds);
        attn_mfma<true>((bf16*)(ws + WS_QC), (const bf16*)(ws + WS_KW), (const bf16*)(ws + WS_VW), P.in[I_SINK] + l * 8, lds);
#endif
        __syncthreads();
        TP_END(2);
        TP_BEGIN();
#ifdef NAIVE_FIN
        finalize_naive(P, l, lds);
#else
        finalize_fast(P, l, lds);
#endif
        TP_END(3);
        GRID_SYNC();
#pragma unroll 1
        for (int i = 0; i < 3; ++i) {
            { pg8::EpiGate E{(pg8::bf16_t*)(ws + WS_GATE)};
#ifdef DBG_GW
              GEMM_PHASE(pg8::EpiGate, H, ws + WS_WOUT, T_, DM, DM, E); }
#else
              GEMM_PHASE(pg8::EpiGate, H, ws + WS_WG + (size_t)i * DM * DM * 2, T_, DM, DM, E); }
#endif
            L1_INVALIDATE();
#ifdef DBG_YSRC
            const unsigned char* yi = ws + WS_H;
#else
            const unsigned char* yi = ws + (i == 0 ? WS_YA : (i == 1 ? WS_QB : WS_QC));
#endif
            { pg8::EpiMerge E{(const pg8::bf16_t*)(ws + WS_GATE), (pg8::bf16_t*)(ws + WS_MERGED), i == 0 ? 1 : 0}; GEMM_PHASE(pg8::EpiMerge, yi, ws + WS_WO + (size_t)i * DM * 512 * 2, T_, DM, 512, E); }
            if (i < 2) L1_INVALIDATE();
        }
        GRID_SYNC();
        { pg8::EpiResid E{P.out, P.out, DM, 1.0f}; GEMM_PHASE(pg8::EpiResid, ws + WS_MERGED, ws + WS_WOUT, T_, DM, DM, E); }
        GRID_SYNC();
#if DBG_STOP == 2
        break;
#endif
        rms_rows_bf16(P.out, P.in[I_F2N] + l * DM, H);
        GRID_SYNC();
        { pg8::EpiSwiglu E{(pg8::bf16_t*)ACT, FF}; GEMM_PHASE(pg8::EpiSwiglu, H, ws + WS_WUP2, T_, 2 * FF, DM, E); }
        GRID_SYNC();
        { pg8::EpiResid E{P.out, P.out, DM, 0.5f}; GEMM_PHASE(pg8::EpiResid, ACT, ws + WS_WDN2, T_, DM, FF, E); }
        GRID_SYNC();
    }
    rms_rows_f32_inplace(P.out, P.in[I_FINN]);
#ifdef TPROBE
    {
        float* tpw = (float*)(ws + WS_SCR);
        GRID_SYNC();
        if (blockIdx.x == 0 && threadIdx.x == 0) { tpw[0] = (float)tp_acc[TPROBE_A] * 0.01f; tpw[1] = (float)tp_acc[TPROBE_B] * 0.01f; }
        GRID_SYNC();
        const float ta = tpw[0], tb = tpw[1];
        const int gt = blockIdx.x * NTHREADS + threadIdx.x;
        for (int i = gt; i < (1 << 20); i += gridDim.x * NTHREADS) P.out[i] = tb * 0.01f;
        if (gt == 0) P.out[1 << 21] = ta * 0.1f;
    }
#endif
}

extern "C" void kernel_launch(void* const* d_in, const int* in_sizes, int n_in, void* d_out, int out_size, void* d_ws, size_t ws_size, hipStream_t stream) {
    static int grid_blocks = 0;
    if (grid_blocks == 0) {
        if (n_in != N_IN || out_size != T_ * DM || ws_size < WS_END) { fprintf(stderr, "kernel_launch: unexpected shapes (n_in %d, out %d, ws %zu < %zu)\n", n_in, out_size, ws_size, (size_t)WS_END); grid_blocks = -1; return; }
        int dev = 0, cus = 0, per_cu = 0;
        hipGetDevice(&dev);
        hipDeviceGetAttribute(&cus, hipDeviceAttributeMultiprocessorCount, dev);
        hipFuncSetAttribute((const void*)fwd_kernel, hipFuncAttributeMaxDynamicSharedMemorySize, LDS_BYTES);
        hipOccupancyMaxActiveBlocksPerMultiprocessor(&per_cu, (const void*)fwd_kernel, NTHREADS, LDS_BYTES);
        if (per_cu < 1) per_cu = 1;
        grid_blocks = cus * per_cu;
    }
    if (grid_blocks < 0) return;
    Params p{};
    for (int i = 0; i < N_IN; ++i) p.in[i] = (const float*)d_in[i];
    p.out = (float*)d_out; p.ws = (unsigned char*)d_ws;
    void* args[] = {&p};
    hipError_t e = hipLaunchCooperativeKernel((const void*)fwd_kernel, dim3(grid_blocks), dim3(NTHREADS), args, LDS_BYTES, stream);
    if (e != hipSuccess) fprintf(stderr, "cooperative launch failed: %s (grid %d)\n", hipGetErrorString(e), grid_blocks);
}
```

```cpp
#include <hip/hip_runtime.h>
#include <hip/hip_cooperative_groups.h>
#include <cstdio>
#include <cstdint>
namespace cg = cooperative_groups;
namespace pg8 {
#define PG8_LAS __attribute__((address_space(3)))
typedef unsigned short bf16_t;
typedef short bf16x8 __attribute__((ext_vector_type(8)));
typedef float f32x4 __attribute__((ext_vector_type(4)));
typedef unsigned u32x4 __attribute__((ext_vector_type(4)));
constexpr int BM = 256, BK = 64, HALF = 128, HTB = HALF * BK * 2  , STAGE_BYTES = 8 * HTB, NXCD = 8, WGM = 8;

__host__ __device__ __forceinline__ int lds_byte(int r, int c) { const int st = (r >> 4) * 2 + (c >> 5), rr = r & 15, cc = c & 31, ob = rr * 64 + cc * 2; return st * 1024 + (ob ^ (((ob >> 9) & 1) << 5)); }
__host__ __device__ __forceinline__ void stage_rc(int b, int& R, int& C) { const int st = b / 1024, sb = b % 1024, swz = sb ^ (((sb >> 9) & 1) << 5); R = (st >> 1) * 16 + swz / 64; C = (st & 1) * 32 + (swz % 64) / 2; }
__host__ __device__ __forceinline__ int perm32(int rho) { const int n = rho >> 4, i = rho & 15; return 8 * (i >> 2) + 4 * n + (i & 3); }

struct Unit { int pm, pn; };
struct Gemm { const bf16_t* A; const bf16_t* Bt; int M, N, K; };

struct StaticOrder {
    int nM, nN, nwg, G, c;
    __host__ __device__ void init(int M, int N, int G_, int c_) { nM = M / BM; nN = N / BM; nwg = nM * nN; G = G_; c = c_; }
    __host__ __device__ bool next(int i, Unit& u) const {
        const long L = (long)i * G + c; if (L >= nwg) return false;
        int wgid = (int)L; { const int q = nwg / NXCD, r = nwg % NXCD, xcd = wgid % NXCD, off = wgid / NXCD; wgid = (xcd < r ? xcd * (q + 1) : r * (q + 1) + (xcd - r) * q) + off; }
        const int nig = WGM * nN, gid = wgid / nig, fm = gid * WGM, gsz = (nM - fm) < WGM ? (nM - fm) : WGM;
        u.pm = fm + ((wgid % nig) % gsz); u.pn = (wgid % nig) / gsz; return true;
    }
    __device__ __forceinline__ void a_ready(const Unit&) const {}
    __device__ __forceinline__ void done(const Unit&) const {}
};
typedef float f32x2_t __attribute__((ext_vector_type(2))); typedef __bf16 bf16x2_t __attribute__((ext_vector_type(2)));
__device__ __forceinline__ unsigned cvt_pk_bf16(float lo, float hi) { f32x2_t v = {lo, hi}; bf16x2_t b = __builtin_convertvector(v, bf16x2_t); return __builtin_bit_cast(unsigned, b); }
typedef float f32x2 __attribute__((ext_vector_type(2)));
__device__ __forceinline__ float fast_sigmoid(float x) { return __builtin_amdgcn_rcpf(1.0f + __builtin_amdgcn_exp2f(-1.4426950408889634f * x)); }
__device__ __forceinline__ u32x4 ld16_agent(const bf16_t* p) { const unsigned long long a = __hip_atomic_load((const unsigned long long*)p, __ATOMIC_RELAXED, __HIP_MEMORY_SCOPE_AGENT), b = __hip_atomic_load((const unsigned long long*)p + 1, __ATOMIC_RELAXED, __HIP_MEMORY_SCOPE_AGENT); u32x4 r; r.x = (unsigned)a; r.y = (unsigned)(a >> 32); r.z = (unsigned)b; r.w = (unsigned)(b >> 32); return r; }
__device__ __forceinline__ float bf_lo(unsigned w) { return __uint_as_float(w << 16); }
__device__ __forceinline__ float bf_hi(unsigned w) { return __uint_as_float(w & 0xffff0000u); }

__device__ __forceinline__ float row_rs(const float* SS, int row) { const f32x4 a = *(const f32x4*)(SS + (size_t)row * 16), b2 = *(const f32x4*)(SS + (size_t)row * 16 + 4), c2 = *(const f32x4*)(SS + (size_t)row * 16 + 8), d = *(const f32x4*)(SS + (size_t)row * 16 + 12);
    const float s = ((a[0] + a[1]) + (a[2] + a[3])) + ((b2[0] + b2[1]) + (b2[2] + b2[3])) + ((c2[0] + c2[1]) + (c2[2] + c2[3])) + ((d[0] + d[1]) + (d[2] + d[3]));
    return 1.0f / sqrtf(s * (1.0f / 1024.0f) + 1e-6f); }
struct EpiSwiglu {
    static constexpr bool PERM = true, AFTER_DRAIN = false;
    bf16_t* O; int ldc; const float* SS;
    __device__ __forceinline__ void operator()(const f32x4 (&acc)[2][2][4][2], const Unit& u, int wr, int wc, int fr, int fq) const {
        const int row0 = u.pm * BM + wr * 64 + fr, col0 = u.pn * HALF + wc * 32 + 8 * fq;
#pragma unroll
        for (int ai = 0; ai < 2; ++ai)
#pragma unroll
            for (int m = 0; m < 4; ++m) {
                bf16_t* rowp = O + (size_t)(row0 + ai * HALF + m * 16) * ldc + col0;
                const float rs = row_rs(SS, row0 + ai * HALF + m * 16);
                float v[8];
#pragma unroll
                for (int n = 0; n < 2; ++n)
#pragma unroll
                    for (int j = 0; j < 4; ++j) { const float g = acc[ai][0][m][n][j] * rs, up = acc[ai][1][m][n][j] * rs; v[n * 4 + j] = g * fast_sigmoid(g) * up; }
                u32x4 w; w.x = cvt_pk_bf16(v[0], v[1]); w.y = cvt_pk_bf16(v[2], v[3]); w.z = cvt_pk_bf16(v[4], v[5]); w.w = cvt_pk_bf16(v[6], v[7]);
                *(u32x4*)rowp = w;
            }
    }
};
struct EpiResid {
    static constexpr bool PERM = false, AFTER_DRAIN = false;
    const float* src; float* dst; int ldc; float scale; bf16_t* XB; float* SS;
    __device__ __forceinline__ void operator()(const f32x4 (&acc)[2][2][4][2], const Unit& u, int wr, int wc, int fr, int fq) const {
        const int col0 = u.pn * BM + wc * 32 + 4 * fq;
#pragma unroll
        for (int ai = 0; ai < 2; ++ai)
#pragma unroll
            for (int m = 0; m < 4; ++m) {
                const int row = u.pm * BM + ai * HALF + wr * 64 + m * 16 + fr;
                const size_t off = (size_t)row * ldc + col0; float sq = 0.f;
#pragma unroll
                for (int bj = 0; bj < 2; ++bj)
#pragma unroll
                    for (int n = 0; n < 2; ++n) { const f32x4 b = *(const f32x4*)(src + off + bj * HALF + n * 16); const f32x4 x = b + acc[ai][bj][m][n] * scale;
                        *(f32x4*)(dst + off + bj * HALF + n * 16) = x; sq += (x[0] * x[0] + x[1] * x[1]) + (x[2] * x[2] + x[3] * x[3]);
                        typedef unsigned u32x2 __attribute__((ext_vector_type(2)));
                        *(u32x2*)(XB + off + bj * HALF + n * 16) = (u32x2){cvt_pk_bf16(x[0], x[1]), cvt_pk_bf16(x[2], x[3])}; }
                sq += __shfl_xor(sq, 16); sq += __shfl_xor(sq, 32);
                if (fq == 0) SS[(size_t)row * 16 + u.pn * 4 + wc] = sq;
            }
    }
};
struct EpiWin {
    static constexpr bool PERM = true, AFTER_DRAIN = false;
    bf16_t *PR, *QB, *KVB, *QC, *KVC; const float* SS;
    __device__ __forceinline__ void operator()(const f32x4 (&acc)[2][2][4][2], const Unit& u, int wr, int wc, int fr, int fq) const {
        bf16_t* base; int ldc, colt;
        const int pn = u.pn;
        if (pn < 8) { base = PR; ldc = 2048; colt = pn * 256; }
        else if (pn < 10) { base = QB; ldc = 512; colt = (pn - 8) * 256; }
        else if (pn == 10) { base = KVB; ldc = 256; colt = 0; }
        else if (pn < 13) { base = QC; ldc = 512; colt = (pn - 11) * 256; }
        else { base = KVC; ldc = 256; colt = 0; }
        const int row0 = u.pm * BM + wr * 64 + fr, col0 = colt + wc * 32 + 8 * fq;
#pragma unroll
        for (int ai = 0; ai < 2; ++ai)
#pragma unroll
            for (int m = 0; m < 4; ++m) {
                bf16_t* rowp = base + (size_t)(row0 + ai * HALF + m * 16) * ldc + col0;
                const float rs = row_rs(SS, row0 + ai * HALF + m * 16);
#pragma unroll
                for (int bj = 0; bj < 2; ++bj) { const f32x4 v0 = acc[ai][bj][m][0] * rs, v1 = acc[ai][bj][m][1] * rs;
                    u32x4 w; w.x = cvt_pk_bf16(v0[0], v0[1]); w.y = cvt_pk_bf16(v0[2], v0[3]); w.z = cvt_pk_bf16(v1[0], v1[1]); w.w = cvt_pk_bf16(v1[2], v1[3]);
                    *(u32x4*)(rowp + bj * HALF) = w; }
            }
    }
};
struct EpiGate {
    static constexpr bool PERM = true, AFTER_DRAIN = false;
    bf16_t* G; const float* SS;
    __device__ __forceinline__ void operator()(const f32x4 (&acc)[2][2][4][2], const Unit& u, int wr, int wc, int fr, int fq) const {
        const int row0 = u.pm * BM + wr * 64 + fr, col0 = u.pn * BM + wc * 32 + 8 * fq;
#pragma unroll
        for (int ai = 0; ai < 2; ++ai)
#pragma unroll
            for (int m = 0; m < 4; ++m) {
                bf16_t* rowp = G + (size_t)(row0 + ai * HALF + m * 16) * 1024 + col0;
                const float rs = row_rs(SS, row0 + ai * HALF + m * 16);
#pragma unroll
                for (int bj = 0; bj < 2; ++bj) { const f32x4 v0 = acc[ai][bj][m][0] * rs, v1 = acc[ai][bj][m][1] * rs;
                    u32x4 w; w.x = cvt_pk_bf16(fast_sigmoid(v0[0]), fast_sigmoid(v0[1])); w.y = cvt_pk_bf16(fast_sigmoid(v0[2]), fast_sigmoid(v0[3]));
                    w.z = cvt_pk_bf16(fast_sigmoid(v1[0]), fast_sigmoid(v1[1])); w.w = cvt_pk_bf16(fast_sigmoid(v1[2]), fast_sigmoid(v1[3]));
#ifdef DBG_GCONST
                    w = (u32x4){0x3f003f00u, 0x3f003f00u, 0x3f003f00u, 0x3f003f00u};
#endif
                    *(u32x4*)(rowp + bj * HALF) = w; }
            }
    }
};
struct EpiMerge {
    static constexpr bool PERM = true, AFTER_DRAIN = false;
    const bf16_t* G; bf16_t* Mg; int first;
    __device__ __forceinline__ void operator()(const f32x4 (&acc)[2][2][4][2], const Unit& u, int wr, int wc, int fr, int fq) const {
        const int row0 = u.pm * BM + wr * 64 + fr, col0 = u.pn * BM + wc * 32 + 8 * fq;
#pragma unroll
        for (int ai = 0; ai < 2; ++ai)
#pragma unroll
            for (int m = 0; m < 4; ++m) {
                const size_t off = (size_t)(row0 + ai * HALF + m * 16) * 1024 + col0;
#pragma unroll
                for (int bj = 0; bj < 2; ++bj) { const f32x4 v0 = acc[ai][bj][m][0], v1 = acc[ai][bj][m][1];
#ifdef DBG_NOG
                    const u32x4 g = (u32x4){0x3f803f80u, 0x3f803f80u, 0x3f803f80u, 0x3f803f80u};
#else
                    const u32x4 g = *(const u32x4*)(G + off + bj * HALF);
#endif
                    float r[8];
                    r[0] = bf_lo(g.x) * v0[0]; r[1] = bf_hi(g.x) * v0[1]; r[2] = bf_lo(g.y) * v0[2]; r[3] = bf_hi(g.y) * v0[3];
                    r[4] = bf_lo(g.z) * v1[0]; r[5] = bf_hi(g.z) * v1[1]; r[6] = bf_lo(g.w) * v1[2]; r[7] = bf_hi(g.w) * v1[3];
#ifdef DBG_NOG
                    if (false) { const u32x4 p = *(const u32x4*)(Mg + off + bj * HALF);
#else
                    if (!first) { const u32x4 p = *(const u32x4*)(Mg + off + bj * HALF);
#endif
                        r[0] += bf_lo(p.x); r[1] += bf_hi(p.x); r[2] += bf_lo(p.y); r[3] += bf_hi(p.y); r[4] += bf_lo(p.z); r[5] += bf_hi(p.z); r[6] += bf_lo(p.w); r[7] += bf_hi(p.w); }
                    u32x4 w; w.x = cvt_pk_bf16(r[0], r[1]); w.y = cvt_pk_bf16(r[2], r[3]); w.z = cvt_pk_bf16(r[4], r[5]); w.w = cvt_pk_bf16(r[6], r[7]);
                    *(u32x4*)(Mg + off + bj * HALF) = w; }
            }
    }
};
template <class Epi, class Sched, bool ALIGN_EPI = false, bool SP2 = false>
__device__ __forceinline__ void gemm_phase(PG8_LAS unsigned char* lds, const Gemm g, const Sched& S, const Epi& E) {
    int tid_o = threadIdx.x; asm volatile("" : "+v"(tid_o));
    const int tid = tid_o, wid = __builtin_amdgcn_readfirstlane(tid >> 6), lane = tid & 63, wr = wid >> 2, wc = wid & 3, fr = lane & 15, fq = lane >> 4;
    const int K = g.K, nt = K / BK;
    unsigned voffA[2], voffB[2];
#pragma unroll
    for (int i = 0; i < 2; ++i) { int R, C; stage_rc(tid * 16 + i * 8192, R, C); const int Rb = Epi::PERM ? ((R & ~31) + perm32(R & 31)) : R;
        voffA[i] = (unsigned)(R * K + C) * 2u; voffB[i] = (unsigned)(Rb * K + C) * 2u; }
    const size_t kstep = (size_t)(BK * 2);
    const size_t hstep = (size_t)HALF * K * 2;
    const size_t tstep = 2 * hstep;
    const unsigned ldsw = (unsigned)wid * 1024u;
    const int aoff = lds_byte(wr * 64 + fr, fq * 8), boff = lds_byte(wc * 32 + fr, fq * 8);
#define PG8_SA(b, h) (((b) * 2 + (h)) * HTB)
#define PG8_SB(b, h) ((4 + (b) * 2 + (h)) * HTB)
#define PG8_STAGE(bufoff, gbase, voff) do { _Pragma("unroll") for (int _i = 0; _i < 2; ++_i) \
        __builtin_amdgcn_global_load_lds((const unsigned*)((const char*)(gbase) + (voff)[_i]), (PG8_LAS unsigned*)(lds + (bufoff) + ldsw + _i * 8192), 16, 0, 0); } while (0)
#define PG8_LDA(dst, b, h) do { _Pragma("unroll") for (int m = 0; m < 4; ++m) _Pragma("unroll") for (int k = 0; k < 2; ++k) dst[m][k] = *(const PG8_LAS bf16x8*)(lds + PG8_SA(b, h) + aoff + m * 2048 + k * 1024); } while (0)
#define PG8_LDB(dst, b, h) do { _Pragma("unroll") for (int n = 0; n < 2; ++n) _Pragma("unroll") for (int k = 0; k < 2; ++k) dst[n][k] = *(const PG8_LAS bf16x8*)(lds + PG8_SB(b, h) + boff + n * 2048 + k * 1024); } while (0)
#define PG8_MMA(ai, bj, At, Bt) do { __builtin_amdgcn_s_setprio(1); _Pragma("unroll") for (int m = 0; m < 4; ++m) _Pragma("unroll") for (int n = 0; n < 2; ++n) _Pragma("unroll") for (int k = 0; k < 2; ++k) \
        acc[ai][bj][m][n] = __builtin_amdgcn_mfma_f32_16x16x32_bf16(Bt[n][k], At[m][k], acc[ai][bj][m][n], 0, 0, 0); __builtin_amdgcn_s_setprio(0); } while (0)
#define PG8_WAIT_V(n) asm volatile("s_waitcnt vmcnt(" #n ")" ::: "memory")
#define PG8_WAIT_L(n) asm volatile("s_waitcnt lgkmcnt(" #n ")" ::: "memory")
#define PG8_BAR __builtin_amdgcn_s_barrier()
#define PG8_SCHED __builtin_amdgcn_sched_barrier(0)
    Unit cur, nxt; int ui = 0;
    if (!S.next(0, cur)) return;
    f32x4 acc[2][2][4][2];
#pragma unroll
    for (int a = 0; a < 2; ++a)
#pragma unroll
        for (int b = 0; b < 2; ++b)
#pragma unroll
            for (int m = 0; m < 4; ++m)
#pragma unroll
                for (int n = 0; n < 2; ++n) acc[a][b][m][n] = (f32x4){0.f, 0.f, 0.f, 0.f};
    bf16x8 At[4][2], B0[2][2], B1[2][2];
    const char* cA = (const char*)g.A + (size_t)cur.pm * tstep; const char* cB = (const char*)g.Bt + (size_t)cur.pn * tstep;
    S.a_ready(cur);
    if constexpr (SP2) {
        PG8_STAGE(PG8_SB(0, 0), cB, voffB); PG8_STAGE(PG8_SB(0, 1), cB + hstep, voffB); PG8_STAGE(PG8_SA(0, 0), cA, voffA); PG8_STAGE(PG8_SA(0, 1), cA + hstep, voffA);
        if (wr == 1) PG8_BAR;
        PG8_WAIT_V(2); PG8_BAR;
        PG8_STAGE(PG8_SB(1, 0), cB + kstep, voffB); PG8_STAGE(PG8_SA(1, 0), cA + kstep, voffA); PG8_STAGE(PG8_SB(1, 1), cB + hstep + kstep, voffB);
        PG8_WAIT_V(6); PG8_BAR;
    } else {
        PG8_STAGE(PG8_SB(0, 0), cB, voffB); PG8_STAGE(PG8_SA(0, 0), cA, voffA); PG8_STAGE(PG8_SB(0, 1), cB + hstep, voffB); PG8_STAGE(PG8_SA(0, 1), cA + hstep, voffA);
        if (wr == 1) PG8_BAR;
        PG8_WAIT_V(4); PG8_BAR;
        PG8_STAGE(PG8_SB(1, 0), cB + kstep, voffB); PG8_STAGE(PG8_SA(1, 0), cA + kstep, voffA); PG8_STAGE(PG8_SB(1, 1), cB + hstep + kstep, voffB);
        PG8_WAIT_V(6); PG8_BAR;
    }
    for (;;) {
        const bool has_next = S.next(ui + 1, nxt);
        const char* nA = has_next ? (const char*)g.A + (size_t)nxt.pm * tstep : cA; const char* nB = has_next ? (const char*)g.Bt + (size_t)nxt.pn * tstep : cB;
        for (int t = 0; t < nt; t += 2) {
            const bool last = (t == nt - 2);
            const char* a1 = cA + (size_t)(t + 1) * kstep;
            const char* a2 = last ? nA : cA + (size_t)(t + 2) * kstep; const char* b2 = last ? nB : cB + (size_t)(t + 2) * kstep;
            const char* a3 = a2 + kstep; const char* b3 = b2 + kstep;
            if (last && has_next) S.a_ready(nxt);
            if constexpr (SP2) {
            PG8_LDB(B0, 0, 0); PG8_LDB(B1, 0, 1); PG8_SCHED; PG8_LDA(At, 0, 0); PG8_STAGE(PG8_SA(1, 1), a1 + hstep, voffA);
            PG8_WAIT_V(8); PG8_WAIT_L(0); PG8_BAR; PG8_MMA(0, 0, At, B0); PG8_MMA(0, 1, At, B1); PG8_BAR; PG8_SCHED;
            PG8_LDA(At, 0, 1); PG8_STAGE(PG8_SB(0, 0), b2, voffB); PG8_STAGE(PG8_SB(0, 1), b2 + hstep, voffB); PG8_STAGE(PG8_SA(0, 0), a2, voffA);
            PG8_WAIT_V(8); PG8_WAIT_L(0); PG8_BAR; PG8_MMA(1, 0, At, B0); PG8_MMA(1, 1, At, B1); PG8_BAR; PG8_SCHED;
            PG8_LDB(B0, 1, 0); PG8_LDB(B1, 1, 1); PG8_SCHED; PG8_LDA(At, 1, 0); PG8_STAGE(PG8_SA(0, 1), a2 + hstep, voffA);
            PG8_WAIT_V(8); PG8_WAIT_L(0); PG8_BAR; PG8_MMA(0, 0, At, B0); PG8_MMA(0, 1, At, B1); PG8_BAR; PG8_SCHED;
            PG8_LDA(At, 1, 1); PG8_STAGE(PG8_SB(1, 0), b3, voffB); PG8_STAGE(PG8_SB(1, 1), b3 + hstep, voffB); PG8_STAGE(PG8_SA(1, 0), a3, voffA);
            PG8_WAIT_V(8); PG8_WAIT_L(0); PG8_BAR; PG8_MMA(1, 0, At, B0); PG8_MMA(1, 1, At, B1); PG8_BAR; PG8_SCHED;
            } else {
            PG8_LDB(B0, 0, 0); PG8_SCHED; PG8_LDA(At, 0, 0); PG8_STAGE(PG8_SA(1, 1), a1 + hstep, voffA);
            PG8_WAIT_L(8); PG8_BAR; PG8_WAIT_L(0); PG8_MMA(0, 0, At, B0); PG8_BAR; PG8_SCHED;
            PG8_LDB(B1, 0, 1); PG8_STAGE(PG8_SB(0, 0), b2, voffB);
            PG8_BAR; PG8_WAIT_L(0); PG8_MMA(0, 1, At, B1); PG8_BAR;
            PG8_LDA(At, 0, 1); PG8_STAGE(PG8_SA(0, 0), a2, voffA);
            PG8_BAR; PG8_WAIT_L(0); PG8_MMA(1, 0, At, B0); PG8_BAR; PG8_SCHED;
            PG8_STAGE(PG8_SB(0, 1), b2 + hstep, voffB);
            PG8_WAIT_V(6); PG8_BAR; PG8_MMA(1, 1, At, B1); PG8_BAR;
            PG8_LDB(B0, 1, 0); PG8_SCHED; PG8_LDA(At, 1, 0); PG8_STAGE(PG8_SA(0, 1), a2 + hstep, voffA);
            PG8_WAIT_L(8); PG8_BAR; PG8_WAIT_L(0); PG8_MMA(0, 0, At, B0); PG8_BAR; PG8_SCHED;
            PG8_LDB(B1, 1, 1); PG8_STAGE(PG8_SB(1, 0), b3, voffB);
            PG8_BAR; PG8_WAIT_L(0); PG8_MMA(0, 1, At, B1); PG8_BAR;
            PG8_LDA(At, 1, 1); PG8_STAGE(PG8_SA(1, 0), a3, voffA);
            PG8_BAR; PG8_WAIT_L(0); PG8_MMA(1, 0, At, B0); PG8_BAR; PG8_SCHED;
            PG8_STAGE(PG8_SB(1, 1), b3 + hstep, voffB);
            PG8_WAIT_V(6); PG8_BAR; PG8_MMA(1, 1, At, B1); PG8_BAR;
            }
        }
        if constexpr (ALIGN_EPI) { if (wr == 0) PG8_BAR; }
        if constexpr (!Epi::AFTER_DRAIN) { E(acc, cur, wr, wc, fr, fq); S.done(cur); }
        if (!has_next) break;
#pragma unroll
        for (int a = 0; a < 2; ++a)
#pragma unroll
            for (int b = 0; b < 2; ++b)
#pragma unroll
                for (int m = 0; m < 4; ++m)
#pragma unroll
                    for (int n = 0; n < 2; ++n) acc[a][b][m][n] = (f32x4){0.f, 0.f, 0.f, 0.f};
        cur = nxt; cA = nA; cB = nB; ++ui;
        if constexpr (ALIGN_EPI) { if (wr == 1) PG8_BAR; }
    }
    PG8_WAIT_V(0);
    if constexpr (!ALIGN_EPI) { if (wr == 0) PG8_BAR; }
    PG8_BAR;
    if constexpr (Epi::AFTER_DRAIN) { E.fused(acc, cur, wr, wc, fr, fq, lds, wid, lane); S.done(cur); }
#undef PG8_SA
#undef PG8_SB
#undef PG8_STAGE
#undef PG8_LDA
#undef PG8_LDB
#undef PG8_MMA
#undef PG8_WAIT_V
#undef PG8_WAIT_L
#undef PG8_BAR
#undef PG8_SCHED
}
}
#define LAS __attribute__((address_space(3)))
typedef unsigned short bf16;
typedef unsigned v4u __attribute__((ext_vector_type(4)));
typedef unsigned v2u __attribute__((ext_vector_type(2)));
typedef float f4 __attribute__((ext_vector_type(4)));
constexpr int T_ = 32768, S_ = 2048, NB = 16, DM = 1024, FF = 2816, NL = 4;
constexpr int NWAVES = 8, NTHREADS = 512;
constexpr int LDS_BYTES = 163840;
constexpr float LOG2E = 1.4426950408889634f;
constexpr float C2 = 0.125f * LOG2E;
constexpr float LOG2_THETA = 13.287712379549449f;

enum { I_X = 0, I_F1N, I_F1UP, I_F1DN, I_MIXN, I_WIN, I_MU, I_W0, I_W2, I_A0, I_A2, I_G2, I_KK, I_KA, I_RK, I_LNG, I_LNB, I_QN, I_KN, I_SINK,
       I_WOA, I_WOB, I_WOC, I_WOUT, I_F2N, I_F2UP, I_F2DN, I_FINN, N_IN };

constexpr size_t SZ_WUP = (size_t)2 * FF * DM * 2, SZ_WDN = (size_t)DM * FF * 2, SZ_WIN = (size_t)3584 * DM * 2, SZ_WG = (size_t)3072 * DM * 2,
                 SZ_WO = (size_t)3 * DM * 512 * 2, SZ_WOUT = (size_t)DM * DM * 2;
constexpr size_t WS_WUP1 = 0, WS_WDN1 = WS_WUP1 + SZ_WUP, WS_WIN = WS_WDN1 + SZ_WDN, WS_WG = WS_WIN + SZ_WIN, WS_WO = WS_WG + SZ_WG, WS_WOUT = WS_WO + SZ_WO,
                 WS_WUP2 = WS_WOUT + SZ_WOUT, WS_WDN2 = WS_WUP2 + SZ_WUP, WS_H = WS_WDN2 + SZ_WDN;
constexpr size_t WS_R = WS_H + (size_t)T_ * DM * 2;
constexpr size_t WS_ACT = WS_R;
constexpr size_t WS_PR = WS_R, WS_QB = WS_PR + (size_t)T_ * 2048 * 2, WS_KVB = WS_QB + (size_t)T_ * 512 * 2, WS_QC = WS_KVB + (size_t)T_ * 256 * 2, WS_KVC = WS_QC + (size_t)T_ * 512 * 2,
                 WS_KG = WS_KVC + (size_t)T_ * 256 * 2, WS_VG = WS_KG + (size_t)NB * 2 * S_ * 64 * 2, WS_KW = WS_VG + (size_t)NB * 2 * S_ * 64 * 2, WS_VW = WS_KW + (size_t)NB * 2 * S_ * 64 * 2,
                 WS_YA = WS_VW + (size_t)NB * 2 * S_ * 64 * 2, WS_WKVF = WS_YA + (size_t)T_ * 512 * 2, WS_WKVB = WS_WKVF + (size_t)T_ * 512 * 2, WS_BONUS = WS_WKVB + (size_t)T_ * 512 * 2,
                 WS_SCR = WS_BONUS + (size_t)T_ * 16 * 4, WS_SS = WS_SCR, WS_WUP1B = WS_SS + (size_t)T_ * 16 * 4, WS_END = WS_WUP1B + SZ_WUP;
#ifdef DBG_GATE_ALT
constexpr size_t WS_GATE = WS_WKVF, WS_MERGED = WS_PR + (size_t)T_ * DM * 2;
#else
constexpr size_t WS_GATE = WS_PR, WS_MERGED = WS_PR + (size_t)T_ * DM * 2;
#endif
static_assert(WS_ACT + (size_t)T_ * FF * 2 <= WS_END, "map");
static_assert(WS_END < 536000000ull, "workspace budget");

struct Params { const float* in[N_IN]; float* out; unsigned char* ws; };

__device__ __forceinline__ unsigned f2bf(float f) { unsigned u = __float_as_uint(f); return (u + 0x7fffu + ((u >> 16) & 1u)) >> 16; }
__device__ __forceinline__ unsigned pk2(float lo, float hi) { return f2bf(lo) | (f2bf(hi) << 16); }
__device__ __forceinline__ float bf2f(bf16 h) { return __uint_as_float((unsigned)h << 16); }
__device__ __forceinline__ int opaque_tid() { int t = threadIdx.x; asm volatile("" : "+v"(t)); return t; }
#define STAGE_IDS const int tid = opaque_tid(), lane = tid & 63, wave = __builtin_amdgcn_readfirstlane(tid >> 6); const int gw = blockIdx.x * NWAVES + wave, ngw = gridDim.x * NWAVES, gtid = blockIdx.x * NTHREADS + tid, gthreads = gridDim.x * NTHREADS; (void)lane; (void)gw; (void)ngw; (void)gtid; (void)gthreads;
__device__ __forceinline__ float wave_sum(float v) {
#pragma unroll
    for (int o = 1; o < 64; o <<= 1) v += __shfl_xor(v, o);
    return v;
}

__device__ __forceinline__ void cvt_wt(const float* W, int K, int ld, bf16* Wt, int nrows, int mode, int gw, int ngw, int lane, float* scr, const float* gain = nullptr) {
    const int nblk = nrows >> 5, nitems = (K >> 6) * nblk;
    for (int it = gw; it < nitems; it += ngw) {
        const int kb = it / nblk, nb = it % nblk, k0 = kb * 64, n0 = nb * 32;
        int col0;
        if (mode == 0) col0 = n0;
        else if (mode == 1) { const int t = n0 >> 8, r = n0 & 255; col0 = (r < 128) ? t * 128 + r : FF + t * 128 + (r - 128); }
        else if (mode == 2) col0 = n0 < 1920 ? n0 : (n0 < 2048 ? -1 : n0 - 128);
        else col0 = 3456 + n0;
        if (col0 >= 0) {
#pragma unroll 8
            for (int i = 0; i < 32; ++i) { const int kk = 2 * i + (lane >> 5); scr[kk * 33 + (lane & 31)] = W[(size_t)(k0 + kk) * ld + col0 + (lane & 31)] * (gain ? gain[k0 + kk] : 1.0f); }
        }
        asm volatile("s_waitcnt lgkmcnt(0)" ::: "memory");
        const int c = lane & 7;
#pragma unroll
        for (int j = 0; j < 4; ++j) { const int n = (lane >> 3) + 8 * j; const float* sp = scr + (8 * c) * 33 + n;
            v4u o = (v4u){0u, 0u, 0u, 0u};
            if (col0 >= 0) { o.x = pk2(sp[0 * 33], sp[1 * 33]); o.y = pk2(sp[2 * 33], sp[3 * 33]); o.z = pk2(sp[4 * 33], sp[5 * 33]); o.w = pk2(sp[6 * 33], sp[7 * 33]); }
            *(v4u*)(Wt + (size_t)(n0 + n) * K + k0 + 8 * c) = o; }
        asm volatile("s_waitcnt lgkmcnt(0)" ::: "memory");
    }
}
__device__ __forceinline__ void cvt_up1(const Params& P, int l, unsigned char* ldsg) {
    STAGE_IDS
    unsigned char* ws = P.ws; float* scr = (float*)(ldsg + wave * 8448);
    cvt_wt(P.in[I_F1UP] + (size_t)l * DM * 2 * FF, DM, 2 * FF, (bf16*)(ws + ((l & 1) ? WS_WUP1B : WS_WUP1)), 2 * FF, 1, gw, ngw, lane, scr, P.in[I_F1N] + l * DM);
}
__device__ __forceinline__ void cvt_rest(const Params& P, int l, unsigned char* ldsg) {
    STAGE_IDS
    unsigned char* ws = P.ws; float* scr = (float*)(ldsg + wave * 8448);
    cvt_wt(P.in[I_F1DN] + (size_t)l * FF * DM, FF, DM, (bf16*)(ws + WS_WDN1), DM, 0, gw, ngw, lane, scr);
    cvt_wt(P.in[I_WIN] + (size_t)l * DM * 6528, DM, 6528, (bf16*)(ws + WS_WIN), 3584, 2, gw, ngw, lane, scr, P.in[I_MIXN] + l * DM);
    cvt_wt(P.in[I_WIN] + (size_t)l * DM * 6528, DM, 6528, (bf16*)(ws + WS_WG), 3072, 3, gw, ngw, lane, scr, P.in[I_MIXN] + l * DM);
    cvt_wt(P.in[I_WOA] + (size_t)l * 512 * DM, 512, DM, (bf16*)(ws + WS_WO), DM, 0, gw, ngw, lane, scr);
    cvt_wt(P.in[I_WOB] + (size_t)l * 512 * DM, 512, DM, (bf16*)(ws + WS_WO) + (size_t)DM * 512, DM, 0, gw, ngw, lane, scr);
    cvt_wt(P.in[I_WOC] + (size_t)l * 512 * DM, 512, DM, (bf16*)(ws + WS_WO) + (size_t)2 * DM * 512, DM, 0, gw, ngw, lane, scr);
    cvt_wt(P.in[I_WOUT] + (size_t)l * DM * DM, DM, DM, (bf16*)(ws + WS_WOUT), DM, 0, gw, ngw, lane, scr);
    cvt_wt(P.in[I_F2UP] + (size_t)l * DM * 2 * FF, DM, 2 * FF, (bf16*)(ws + WS_WUP2), 2 * FF, 1, gw, ngw, lane, scr, P.in[I_F2N] + l * DM);
    cvt_wt(P.in[I_F2DN] + (size_t)l * FF * DM, FF, DM, (bf16*)(ws + WS_WDN2), DM, 0, gw, ngw, lane, scr);
}
__device__ __forceinline__ void x_to_bf16_ss(const float* x, bf16* o, float* SS) {
    STAGE_IDS
    for (int m = gw; m < T_; m += ngw) {
        const f4* xr = (const f4*)(x + (size_t)m * DM) + lane; f4 v[4]; float s = 0.f;
#pragma unroll
        for (int j = 0; j < 4; ++j) { v[j] = xr[64 * j]; s += (v[j].x * v[j].x + v[j].y * v[j].y) + (v[j].z * v[j].z + v[j].w * v[j].w); }
        s = wave_sum(s);
        v2u* op = (v2u*)(o + (size_t)m * DM) + lane;
#pragma unroll
        for (int j = 0; j < 4; ++j) { v2u w; w.x = pk2(v[j].x, v[j].y); w.y = pk2(v[j].z, v[j].w); op[64 * j] = w; }
        if (lane < 16) SS[(size_t)m * 16 + lane] = lane == 0 ? s : 0.f;
    }
}

__device__ __forceinline__ void rms_rows_bf16(const float* x, const float* g, bf16* o) {
    STAGE_IDS
    const f4* gr = (const f4*)g + lane; f4 gv[4];
#pragma unroll
    for (int j = 0; j < 4; ++j) gv[j] = gr[64 * j];
    for (int m = gw; m < T_; m += ngw) {
        const f4* xr = (const f4*)(x + (size_t)m * DM) + lane; f4 v[4]; float s = 0.f;
#pragma unroll
        for (int j = 0; j < 4; ++j) { v[j] = xr[64 * j]; s += (v[j].x * v[j].x + v[j].y * v[j].y) + (v[j].z * v[j].z + v[j].w * v[j].w); }
        const float rs = 1.0f / sqrtf(wave_sum(s) * (1.0f / DM) + 1e-6f);
        v2u* op = (v2u*)(o + (size_t)m * DM) + lane;
#pragma unroll
        for (int j = 0; j < 4; ++j) { v2u w; w.x = pk2(v[j].x * rs * gv[j].x, v[j].y * rs * gv[j].y); w.y = pk2(v[j].z * rs * gv[j].z, v[j].w * rs * gv[j].w); op[64 * j] = w; }
    }
}
__device__ __forceinline__ void rms_rows_f32_inplace(float* x, const float* g) {
    STAGE_IDS
    const f4* gr = (const f4*)g + lane; f4 gv[4];
#pragma unroll
    for (int j = 0; j < 4; ++j) gv[j] = gr[64 * j];
    for (int m = gw; m < T_; m += ngw) {
        f4* xr = (f4*)(x + (size_t)m * DM) + lane; f4 v[4]; float s = 0.f;
#pragma unroll
        for (int j = 0; j < 4; ++j) { v[j] = xr[64 * j]; s += (v[j].x * v[j].x + v[j].y * v[j].y) + (v[j].z * v[j].z + v[j].w * v[j].w); }
        const float rs = 1.0f / sqrtf(wave_sum(s) * (1.0f / DM) + 1e-6f);
#pragma unroll
        for (int j = 0; j < 4; ++j) xr[64 * j] = v[j] * rs * gv[j];
    }
}

__device__ __forceinline__ float fast_sin_rev(float rev) { return __builtin_amdgcn_sinf(__builtin_amdgcn_fractf(rev)); }
__device__ __forceinline__ float fast_cos_rev(float rev) { return __builtin_amdgcn_cosf(__builtin_amdgcn_fractf(rev)); }
__device__ __forceinline__ void qkprep(const Params& P, int l) {
    STAGE_IDS
    unsigned char* ws = P.ws;
    bf16* QB = (bf16*)(ws + WS_QB); const bf16* KVB = (const bf16*)(ws + WS_KVB); bf16* QC = (bf16*)(ws + WS_QC); const bf16* KVC = (const bf16*)(ws + WS_KVC);
    bf16* KG = (bf16*)(ws + WS_KG); bf16* KW = (bf16*)(ws + WS_KW);
    const float qg = P.in[I_QN][l * 64 + lane], kg = P.in[I_KN][l * 64 + lane];
    const float inv_ax = exp2f(-(float)(lane & 15) * (LOG2_THETA / 16.0f)), inv_1d = exp2f(-(float)(lane & 31) * (LOG2_THETA / 32.0f));
    const float INV2PI = 0.15915494309189535f;
    for (int t = gw; t < T_; t += ngw) {
        const int b = t >> 11, s = t & 2047;
        const float pos = lane < 32 ? (float)(s >> 6) : (float)(s & 63);
        const float ra = (pos * inv_ax) * INV2PI, r1 = ((float)s * inv_1d) * INV2PI;
        const float csa = fast_cos_rev(ra), sna = (lane & 16) ? fast_sin_rev(ra) : -fast_sin_rev(ra);
        const float cs1 = fast_cos_rev(r1), sn1 = (lane & 32) ? fast_sin_rev(r1) : -fast_sin_rev(r1);
#pragma unroll
        for (int slot = 0; slot < 10; ++slot) {
            bf16* src = slot < 8 ? QB + (size_t)t * 512 + slot * 64 : (bf16*)KVB + (size_t)t * 256 + (slot - 8) * 64;
            const float x = bf2f(src[lane]);
            const float ss = wave_sum(x * x) * (1.0f / 64.0f);
            const float y = x * (1.0f / sqrtf(ss + 1e-6f)) * (slot < 8 ? qg : kg);
            const float r = y * csa + __shfl_xor(y, 16) * sna;
            if (slot < 8) src[lane] = (bf16)f2bf(r * C2);
            else KG[((size_t)(b * 2 + (slot - 8)) * S_ + s) * 64 + lane] = (bf16)f2bf(r);
        }
#pragma unroll
        for (int slot = 0; slot < 10; ++slot) {
            bf16* src = slot < 8 ? QC + (size_t)t * 512 + slot * 64 : (bf16*)KVC + (size_t)t * 256 + (slot - 8) * 64;
            const float x = bf2f(src[lane]);
            const float r = x * cs1 + __shfl_xor(x, 32) * sn1;
            if (slot < 8) src[lane] = (bf16)f2bf(r * C2);
            else KW[((size_t)(b * 2 + (slot - 8)) * S_ + s) * 64 + lane] = (bf16)f2bf(r);
        }
    }
}

__device__ __forceinline__ void vt_prep(const Params& P, unsigned char* ldsg) {
    STAGE_IDS
    unsigned char* ws = P.ws;
    bf16* tile = (bf16*)(ldsg + wave * 8448);
    for (int it = gw; it < 2 * NB * 2 * 32; it += ngw) {
        const int tb = it & 31, kvh = (it >> 5) & 1, b = (it >> 6) & 15, att = it >> 10;
        const bf16* src = (const bf16*)(ws + (att ? WS_KVC : WS_KVB)) + (size_t)(b * S_ + tb * 64) * 256 + 128 + kvh * 64;
        bf16* dst = (bf16*)(ws + (att ? WS_VW : WS_VG)) + (size_t)(b * 2 + kvh) * 64 * S_ + tb * 64;
#pragma unroll 8
        for (int r = 0; r < 64; ++r) tile[r * 66 + lane] = src[(size_t)r * 256 + lane];
        asm volatile("s_waitcnt lgkmcnt(0)" ::: "memory");
#pragma unroll 8
        for (int d = 0; d < 64; ++d) dst[(size_t)d * S_ + lane] = tile[lane * 66 + d];
        asm volatile("s_waitcnt lgkmcnt(0)" ::: "memory");
    }
}

typedef short bf16x8_t __attribute__((ext_vector_type(8)));
typedef short s16x4_t __attribute__((ext_vector_type(4)));
typedef float f32x16 __attribute__((ext_vector_type(16)));
typedef float f32x2a __attribute__((ext_vector_type(2))); typedef __bf16 bf16x2a __attribute__((ext_vector_type(2)));
__device__ __forceinline__ unsigned cvtpk(float lo, float hi) { f32x2a v = {lo, hi}; bf16x2a b = __builtin_convertvector(v, bf16x2a); return __builtin_bit_cast(unsigned, b); }
__device__ __forceinline__ int crow(int r, int hi) { return (r & 3) + 8 * (r >> 2) + 4 * hi; }
template <bool WINDOW>
__device__ __forceinline__ void attn_mfma(bf16* Q, const bf16* Kx, const bf16* VTx, const float* sink, unsigned char* ldsg) {
    STAGE_IDS
    const int r32 = lane & 31, hi = lane >> 5, g = wave >> 1, qs = wave & 1;
    const int srow = tid >> 3, sch = tid & 7;
    for (int unit = blockIdx.x; unit < 1024; unit += gridDim.x) {
        const int qb = unit & 31, kvh = (unit >> 5) & 1, b = unit >> 6, h = kvh * 4 + g, q0 = qb * 64 + qs * 32;
        bf16* qp = Q + ((size_t)(b * S_ + q0 + r32)) * 512 + h * 64;
        bf16x8_t qr[4];
#pragma unroll
        for (int d0 = 0; d0 < 4; ++d0) qr[d0] = *(const bf16x8_t*)(qp + 16 * d0 + 8 * hi);
        f32x16 o0, o1;
#pragma unroll
        for (int r = 0; r < 16; ++r) { o0[r] = 0.f; o1[r] = 0.f; }
        float m, l;
        if (WINDOW) { m = sink[h] * LOG2E; l = hi == 0 ? 1.0f : 0.f; } else { m = -1e30f; l = 0.f; }
        const int t0 = WINDOW ? (qb - 2 > 0 ? qb - 2 : 0) : 0, t1 = WINDOW ? (qb + 2 < 31 ? qb + 2 : 31) : 31;
        const bf16* kbase = Kx + (size_t)(b * 2 + kvh) * S_ * 64 + (size_t)srow * 64 + sch * 8;
        const bf16* vbase = VTx + (size_t)(b * 2 + kvh) * 64 * S_ + (size_t)srow * S_ + sch * 8;
        v4u kreg = *(const v4u*)(kbase + (size_t)t0 * 64 * 64);
        v4u vreg = *(const v4u*)(vbase + t0 * 64);
        __syncthreads();
        *(v4u*)(ldsg + srow * 144 + sch * 16) = kreg;
        *(v4u*)(ldsg + 9216 + srow * 144 + sch * 16) = vreg;
        __syncthreads();
        for (int t = t0; t <= t1; ++t) {
            const int buf = (t - t0) & 1;
            if (t < t1) { kreg = *(const v4u*)(kbase + (size_t)(t + 1) * 64 * 64); vreg = *(const v4u*)(vbase + (t + 1) * 64); }
            const unsigned char* Kb = ldsg + buf * 18432; const unsigned char* Vb = Kb + 9216;
            f32x16 p0, p1;
#pragma unroll
            for (int r = 0; r < 16; ++r) { p0[r] = 0.f; p1[r] = 0.f; }
#pragma unroll
            for (int d0 = 0; d0 < 4; ++d0) {
                const bf16x8_t a0 = *(const bf16x8_t*)(Kb + r32 * 144 + (16 * d0 + 8 * hi) * 2);
                const bf16x8_t a1 = *(const bf16x8_t*)(Kb + (32 + r32) * 144 + (16 * d0 + 8 * hi) * 2);
                p0 = __builtin_amdgcn_mfma_f32_32x32x16_bf16(a0, qr[d0], p0, 0, 0, 0);
                p1 = __builtin_amdgcn_mfma_f32_32x32x16_bf16(a1, qr[d0], p1, 0, 0, 0);
            }
            if (WINDOW) {
                const int qpos = q0 + r32;
#pragma unroll
                for (int r = 0; r < 16; ++r) { const int kv = t * 64 + crow(r, hi); int dlt = qpos - kv; dlt = dlt < 0 ? -dlt : dlt; if (dlt > 128) p0[r] = -1e30f;
                    int dl2 = qpos - (kv + 32); dl2 = dl2 < 0 ? -dl2 : dl2; if (dl2 > 128) p1[r] = -1e30f; }
            }
            float mt = fmaxf(p0[0], p1[0]);
#pragma unroll
            for (int r = 1; r < 16; ++r) mt = fmaxf(mt, fmaxf(p0[r], p1[r]));
            mt = fmaxf(mt, __shfl_xor(mt, 32));
            const float mn = fmaxf(m, mt), corr = __builtin_amdgcn_exp2f(m - mn); m = mn;
            float ps = 0.f;
#pragma unroll
            for (int r = 0; r < 16; ++r) { p0[r] = __builtin_amdgcn_exp2f(p0[r] - mn); p1[r] = __builtin_amdgcn_exp2f(p1[r] - mn); ps += p0[r] + p1[r]; }
            l = l * corr + ps;
#pragma unroll
            for (int r = 0; r < 16; ++r) { o0[r] *= corr; o1[r] *= corr; }
            v4u pw[4];
            pw[0] = (v4u){cvtpk(p0[0], p0[1]), cvtpk(p0[2], p0[3]), cvtpk(p0[4], p0[5]), cvtpk(p0[6], p0[7])};
            pw[1] = (v4u){cvtpk(p0[8], p0[9]), cvtpk(p0[10], p0[11]), cvtpk(p0[12], p0[13]), cvtpk(p0[14], p0[15])};
            pw[2] = (v4u){cvtpk(p1[0], p1[1]), cvtpk(p1[2], p1[3]), cvtpk(p1[4], p1[5]), cvtpk(p1[6], p1[7])};
            pw[3] = (v4u){cvtpk(p1[8], p1[9]), cvtpk(p1[10], p1[11]), cvtpk(p1[12], p1[13]), cvtpk(p1[14], p1[15])};
#pragma unroll
            for (int kb = 0; kb < 4; ++kb) {
                const bf16x8_t pb = __builtin_bit_cast(bf16x8_t, pw[kb]);
                { const unsigned char* vp = Vb + r32 * 144 + (16 * kb + 4 * hi) * 2; const s16x4_t lo = *(const s16x4_t*)vp, hh = *(const s16x4_t*)(vp + 16);
                  const bf16x8_t a = (bf16x8_t){lo[0], lo[1], lo[2], lo[3], hh[0], hh[1], hh[2], hh[3]};
                  o0 = __builtin_amdgcn_mfma_f32_32x32x16_bf16(a, pb, o0, 0, 0, 0); }
                { const unsigned char* vp = Vb + (32 + r32) * 144 + (16 * kb + 4 * hi) * 2; const s16x4_t lo = *(const s16x4_t*)vp, hh = *(const s16x4_t*)(vp + 16);
                  const bf16x8_t a = (bf16x8_t){lo[0], lo[1], lo[2], lo[3], hh[0], hh[1], hh[2], hh[3]};
                  o1 = __builtin_amdgcn_mfma_f32_32x32x16_bf16(a, pb, o1, 0, 0, 0); }
            }
            if (t < t1) { unsigned char* nb = ldsg + (buf ^ 1) * 18432; *(v4u*)(nb + srow * 144 + sch * 16) = kreg; *(v4u*)(nb + 9216 + srow * 144 + sch * 16) = vreg; }
            __syncthreads();
        }
        l += __shfl_xor(l, 32);
        const float inv = 1.0f / l;
#pragma unroll
        for (int g4 = 0; g4 < 4; ++g4) {
            v2u w0, w1;
            w0.x = cvtpk(o0[4 * g4 + 0] * inv, o0[4 * g4 + 1] * inv); w0.y = cvtpk(o0[4 * g4 + 2] * inv, o0[4 * g4 + 3] * inv);
            w1.x = cvtpk(o1[4 * g4 + 0] * inv, o1[4 * g4 + 1] * inv); w1.y = cvtpk(o1[4 * g4 + 2] * inv, o1[4 * g4 + 3] * inv);
            *(v2u*)(qp + 8 * g4 + 4 * hi) = w0;
            *(v2u*)(qp + 32 + 8 * g4 + 4 * hi) = w1;
        }
    }
}

__device__ __forceinline__ void attn_naive(bf16* Q, const bf16* Kx, const bf16* Vx, const float* sink, int window) {
    STAGE_IDS
    for (int it = gtid; it < T_ * 8; it += gthreads) {
        const int q = it & 2047, h = (it >> 11) & 7, b = it >> 14, kvh = h >> 2;
        bf16* qp = Q + ((size_t)(b * S_ + q)) * 512 + h * 64;
        float qf[64], o[64];
#pragma unroll
        for (int c = 0; c < 8; ++c) { const v4u w = ((const v4u*)qp)[c];
            qf[c * 8 + 0] = __uint_as_float(w.x << 16); qf[c * 8 + 1] = __uint_as_float(w.x & 0xffff0000u); qf[c * 8 + 2] = __uint_as_float(w.y << 16); qf[c * 8 + 3] = __uint_as_float(w.y & 0xffff0000u);
            qf[c * 8 + 4] = __uint_as_float(w.z << 16); qf[c * 8 + 5] = __uint_as_float(w.z & 0xffff0000u); qf[c * 8 + 6] = __uint_as_float(w.w << 16); qf[c * 8 + 7] = __uint_as_float(w.w & 0xffff0000u); }
#pragma unroll
        for (int d = 0; d < 64; ++d) o[d] = 0.f;
        float m, lsum;
        if (sink) { m = sink[h] * LOG2E; lsum = 1.0f; } else { m = -1e30f; lsum = 0.f; }
        const int k0 = window ? (q - 128 > 0 ? q - 128 : 0) : 0, k1 = window ? (q + 128 < S_ - 1 ? q + 128 : S_ - 1) : S_ - 1;
        const bf16* kp = Kx + (size_t)(b * 2 + kvh) * S_ * 64; const bf16* vp = Vx + (size_t)(b * 2 + kvh) * S_ * 64;
        for (int k = k0; k <= k1; ++k) {
            const v4u* kr = (const v4u*)(kp + (size_t)k * 64); float s = 0.f;
#pragma unroll
            for (int c = 0; c < 8; ++c) { const v4u w = kr[c];
                s += qf[c * 8 + 0] * __uint_as_float(w.x << 16) + qf[c * 8 + 1] * __uint_as_float(w.x & 0xffff0000u) + qf[c * 8 + 2] * __uint_as_float(w.y << 16) + qf[c * 8 + 3] * __uint_as_float(w.y & 0xffff0000u)
                   + qf[c * 8 + 4] * __uint_as_float(w.z << 16) + qf[c * 8 + 5] * __uint_as_float(w.z & 0xffff0000u) + qf[c * 8 + 6] * __uint_as_float(w.w << 16) + qf[c * 8 + 7] * __uint_as_float(w.w & 0xffff0000u); }
            const float mn = fmaxf(m, s), corr = exp2f(m - mn), p = exp2f(s - mn);
            lsum = lsum * corr + p; m = mn;
            const v4u* vr = (const v4u*)(vp + (size_t)k * 64);
#pragma unroll
            for (int c = 0; c < 8; ++c) { const v4u w = vr[c];
                o[c * 8 + 0] = o[c * 8 + 0] * corr + p * __uint_as_float(w.x << 16); o[c * 8 + 1] = o[c * 8 + 1] * corr + p * __uint_as_float(w.x & 0xffff0000u);
                o[c * 8 + 2] = o[c * 8 + 2] * corr + p * __uint_as_float(w.y << 16); o[c * 8 + 3] = o[c * 8 + 3] * corr + p * __uint_as_float(w.y & 0xffff0000u);
                o[c * 8 + 4] = o[c * 8 + 4] * corr + p * __uint_as_float(w.z << 16); o[c * 8 + 5] = o[c * 8 + 5] * corr + p * __uint_as_float(w.z & 0xffff0000u);
                o[c * 8 + 6] = o[c * 8 + 6] * corr + p * __uint_as_float(w.w << 16); o[c * 8 + 7] = o[c * 8 + 7] * corr + p * __uint_as_float(w.w & 0xffff0000u); }
        }
        const float inv = 1.0f / lsum;
#pragma unroll
        for (int c = 0; c < 8; ++c) { v4u w; w.x = pk2(o[c * 8 + 0] * inv, o[c * 8 + 1] * inv); w.y = pk2(o[c * 8 + 2] * inv, o[c * 8 + 3] * inv); w.z = pk2(o[c * 8 + 4] * inv, o[c * 8 + 5] * inv); w.w = pk2(o[c * 8 + 6] * inv, o[c * 8 + 7] * inv);
            ((v4u*)qp)[c] = w; }
    }
}


typedef float f8s __attribute__((ext_vector_type(8)));
typedef float f32x4m __attribute__((ext_vector_type(4)));
constexpr int SC_VEC = 0, SC_VS = 81920, SC_W2T = 98304, SC_A2T = 107520, SC_XCH = 116736, SC_YP = 120832, SC_A1 = SC_YP, SC_A2 = SC_YP + 9216, SC_AL = SC_YP + 18432, SC_END = SC_AL + 16640;
static_assert(SC_END <= LDS_BYTES, "scan LDS");
__device__ __forceinline__ void ld8bf(const bf16* p, float (&f)[8]) { const v4u w = *(const v4u*)p;
    f[0] = __uint_as_float(w.x << 16); f[1] = __uint_as_float(w.x & 0xffff0000u); f[2] = __uint_as_float(w.y << 16); f[3] = __uint_as_float(w.y & 0xffff0000u);
    f[4] = __uint_as_float(w.z << 16); f[5] = __uint_as_float(w.z & 0xffff0000u); f[6] = __uint_as_float(w.w << 16); f[7] = __uint_as_float(w.w & 0xffff0000u); }
__device__ __forceinline__ void shifted8(const bf16* pc, int col, bool hasp, bool hasn, const float* mu, float (&o)[8]) {
    float c[8], p[8], n[8];
    ld8bf(pc + col, c);
    if (hasp) ld8bf(pc + col - 2048, p); else { for (int e = 0; e < 8; ++e) p[e] = 0.f; }
    if (hasn) ld8bf(pc + col + 2048, n); else { for (int e = 0; e < 8; ++e) n[e] = 0.f; }
    const f4 m0 = *(const f4*)(mu + col), m1 = *(const f4*)(mu + col + 4);
    const float mm[8] = {m0.x, m0.y, m0.z, m0.w, m1.x, m1.y, m1.z, m1.w};
#pragma unroll
    for (int e = 0; e < 8; ++e) o[e] = c[e] + mm[e] * (0.5f * (p[e] + n[e]) - c[e]);
}
__device__ __forceinline__ void scan_fast(const Params& P, int l, unsigned char* ldsg) {
    STAGE_IDS
    unsigned char* ws = P.ws;
    const bf16* PR = (const bf16*)(ws + WS_PR); float* BONUS = (float*)(ws + WS_BONUS);
    float* VEC = (float*)(ldsg + SC_VEC);
    const int fr = lane & 15, fq = lane >> 4, ps = tid >> 3, pcg = tid & 7;
    float* XCH = (float*)(ldsg + SC_XCH); float* YP = (float*)(ldsg + SC_YP); float* VS = (float*)(ldsg + SC_VS); float* AL = (float*)(ldsg + SC_AL);
    for (int sid = blockIdx.x; sid < 256; sid += gridDim.x) {
        const int dir = sid & 1, h = (sid >> 1) & 7, b = sid >> 4, hc0 = h * 64;
        bf16* WKV = (bf16*)(ws + (dir ? WS_WKVB : WS_WKVF));
        const float* mu = P.in[I_MU] + (size_t)l * 1920;
        __syncthreads();
        {
            const float* w2b = P.in[I_W2] + (size_t)(l * 2 + dir) * 64 * 512 + (size_t)ps * 512 + hc0 + 8 * pcg;
            const float* a2b = P.in[I_A2] + (size_t)(l * 2 + dir) * 64 * 512 + (size_t)ps * 512 + hc0 + 8 * pcg;
#pragma unroll
            for (int e = 0; e < 8; ++e) { ((bf16*)(ldsg + SC_W2T))[(8 * pcg + e) * 72 + ps] = (bf16)f2bf(w2b[e]); ((bf16*)(ldsg + SC_A2T))[(8 * pcg + e) * 72 + ps] = (bf16)f2bf(a2b[e]); }
        }
        float S[8];
#pragma unroll
        for (int j = 0; j < 8; ++j) S[j] = 0.f;
#pragma unroll 1
        for (int ch = 0; ch < S_ / 64; ++ch) {
            const int step0 = ch * 64;
            const int tp = dir ? S_ - 1 - (step0 + ps) : step0 + ps;
            const bf16* pc = PR + ((size_t)(b * S_ + tp)) * 2048;
            const bool hasp = tp > 0, hasn = tp < S_ - 1;
            float r8[8], k8[8], v8[8];
            shifted8(pc, hc0 + 8 * pcg, hasp, hasn, mu, r8);
            shifted8(pc, 512 + hc0 + 8 * pcg, hasp, hasn, mu, k8);
            shifted8(pc, 1024 + hc0 + 8 * pcg, hasp, hasn, mu, v8);
            { float wl[8], al[8];
              shifted8(pc, 1536 + 64 * dir + 8 * pcg, hasp, hasn, mu, wl);
              shifted8(pc, 1664 + 64 * dir + 8 * pcg, hasp, hasn, mu, al);
#pragma unroll
              for (int e = 0; e < 8; ++e) { const float t2 = __builtin_amdgcn_exp2f(2.0f * LOG2E * wl[e]); wl[e] = (t2 - 1.0f) * __builtin_amdgcn_rcpf(t2 + 1.0f); }
              v4u w1, w2v; w1.x = cvtpk(wl[0], wl[1]); w1.y = cvtpk(wl[2], wl[3]); w1.z = cvtpk(wl[4], wl[5]); w1.w = cvtpk(wl[6], wl[7]);
              w2v.x = cvtpk(al[0], al[1]); w2v.y = cvtpk(al[2], al[3]); w2v.z = cvtpk(al[4], al[5]); w2v.w = cvtpk(al[6], al[7]);
              *(v4u*)(ldsg + SC_A1 + ps * 144 + pcg * 16) = w1; *(v4u*)(ldsg + SC_A2 + ps * 144 + pcg * 16) = w2v; }
            *(f4*)(VS + ps * 64 + 8 * pcg) = (f4){v8[0], v8[1], v8[2], v8[3]}; *(f4*)(VS + ps * 64 + 8 * pcg + 4) = (f4){v8[4], v8[5], v8[6], v8[7]};
            __syncthreads();
            {
                const int wq = wave & 3; const bool isw = wave < 4;
                const unsigned char* Ab = ldsg + (isw ? SC_A1 : SC_A2) + (16 * wq + fr) * 144 + 16 * fq;
                const unsigned char* Bb = ldsg + (isw ? SC_W2T : SC_A2T) + fr * 144 + 16 * fq;
                const bf16x8_t a0 = *(const bf16x8_t*)Ab, a1 = *(const bf16x8_t*)(Ab + 64);
                const float* bias = P.in[isw ? I_W0 : I_A0] + (size_t)(l * 2 + dir) * 512 + hc0;
#pragma unroll
                for (int n = 0; n < 4; ++n) {
                    const bf16x8_t b0 = *(const bf16x8_t*)(Bb + n * 16 * 144), b1 = *(const bf16x8_t*)(Bb + n * 16 * 144 + 64);
                    f32x4m acc = (f32x4m){0.f, 0.f, 0.f, 0.f};
                    acc = __builtin_amdgcn_mfma_f32_16x16x32_bf16(a0, b0, acc, 0, 0, 0);
                    acc = __builtin_amdgcn_mfma_f32_16x16x32_bf16(a1, b1, acc, 0, 0, 0);
                    const float bz = bias[16 * n + fr];
#pragma unroll
                    for (int v = 0; v < 4; ++v) {
                        const int st = 16 * wq + 4 * fq + v; const float x = acc[v] + bz;
                        if (isw) { const float sp = __builtin_amdgcn_logf(1.0f + __builtin_amdgcn_exp2f(-x * LOG2E)) * 0.6931471805599453f;
                                   const float wlog = -sp - 0.5f; VEC[st * 320 + (2 * n + (fr >> 3)) * 40 + (fr & 7)] = __builtin_amdgcn_exp2f(-__builtin_amdgcn_exp2f(wlog * LOG2E) * LOG2E); }
                        else AL[st * 65 + 16 * n + fr] = __builtin_amdgcn_rcpf(1.0f + __builtin_amdgcn_exp2f(-x * LOG2E));
                    }
                }
            }
            __syncthreads();
            {
                const float* kkp = P.in[I_KK] + l * 512 + hc0 + 8 * pcg; const float* kap = P.in[I_KA] + l * 512 + hc0 + 8 * pcg; const float* rkp = P.in[I_RK] + l * 512 + hc0 + 8 * pcg;
                float a8[8], kk[8], kd[8]; float ss = 0.f, bon = 0.f;
#pragma unroll
                for (int e = 0; e < 8; ++e) { a8[e] = AL[ps * 65 + 8 * pcg + e]; kk[e] = k8[e] * kkp[e]; ss += kk[e] * kk[e]; kd[e] = k8[e] * (1.0f + (a8[e] - 1.0f) * kap[e]); bon += r8[e] * kd[e] * rkp[e]; }
                ss += __shfl_xor(ss, 1); ss += __shfl_xor(ss, 2); ss += __shfl_xor(ss, 4);
                bon += __shfl_xor(bon, 1); bon += __shfl_xor(bon, 2); bon += __shfl_xor(bon, 4);
                const float rn = 1.0f / fmaxf(sqrtf(ss), 1e-12f);
                float* sp = VEC + ps * 320 + 40 * pcg;
                *(f4*)(sp + 8) = (f4){kd[0], kd[1], kd[2], kd[3]}; *(f4*)(sp + 12) = (f4){kd[4], kd[5], kd[6], kd[7]};
                *(f4*)(sp + 16) = (f4){-kk[0] * rn, -kk[1] * rn, -kk[2] * rn, -kk[3] * rn}; *(f4*)(sp + 20) = (f4){-kk[4] * rn, -kk[5] * rn, -kk[6] * rn, -kk[7] * rn};
                *(f4*)(sp + 24) = (f4){kk[0] * rn * a8[0], kk[1] * rn * a8[1], kk[2] * rn * a8[2], kk[3] * rn * a8[3]}; *(f4*)(sp + 28) = (f4){kk[4] * rn * a8[4], kk[5] * rn * a8[5], kk[6] * rn * a8[6], kk[7] * rn * a8[7]};
                *(f4*)(sp + 32) = (f4){r8[0], r8[1], r8[2], r8[3]}; *(f4*)(sp + 36) = (f4){r8[4], r8[5], r8[6], r8[7]};
                if (pcg == 0) BONUS[((size_t)((dir * NB + b) * 8 + h)) * S_ + tp] = bon;
            }
            asm volatile("s_waitcnt vmcnt(0) lgkmcnt(0)" ::: "memory");
            __syncthreads();
#define DPP_FMAC(acc, xs, val, N) asm("v_fmac_f32_dpp %0, %1, %2 row_newbcast:" #N " row_mask:0xf bank_mask:0xf" : "+v"(acc) : "v"(xs), "v"(val))
#define DPP_MUL(dst, xs, val, N) asm("v_mul_f32_dpp %0, %1, %2 row_newbcast:" #N " row_mask:0xf bank_mask:0xf" : "=v"(dst) : "v"(xs), "v"(val))
            const float* vecb = VEC + wave * 40 + (lane & 15);
            const int o2 = 32 + (lane & 7) - (lane & 15);
            float x0 = vecb[0], x1 = vecb[16], x2 = vecb[o2];
#pragma unroll 1
            for (int s = 0; s < 64; ++s) {
                const float* np_ = vecb + ((s + 1) & 63) * 320;
                const float n0 = np_[0], n1 = np_[16], n2 = np_[o2];
                const float v = VS[s * 64 + lane];
                asm volatile("s_nop 1" : "+v"(x0), "+v"(x1), "+v"(x2));
                float pa = 0.f, pb = 0.f;
                DPP_FMAC(pa, x1, S[0], 0); DPP_FMAC(pb, x1, S[1], 1); DPP_FMAC(pa, x1, S[2], 2); DPP_FMAC(pb, x1, S[3], 3);
                DPP_FMAC(pa, x1, S[4], 4); DPP_FMAC(pb, x1, S[5], 5); DPP_FMAC(pa, x1, S[6], 6); DPP_FMAC(pb, x1, S[7], 7);
                XCH[(s & 1) * 512 + wave * 64 + lane] = pa + pb;
                float Tt[8];
                DPP_MUL(Tt[0], x0, S[0], 0); DPP_MUL(Tt[1], x0, S[1], 1); DPP_MUL(Tt[2], x0, S[2], 2); DPP_MUL(Tt[3], x0, S[3], 3);
                DPP_MUL(Tt[4], x0, S[4], 4); DPP_MUL(Tt[5], x0, S[5], 5); DPP_MUL(Tt[6], x0, S[6], 6); DPP_MUL(Tt[7], x0, S[7], 7);
                DPP_FMAC(Tt[0], x0, v, 8); DPP_FMAC(Tt[1], x0, v, 9); DPP_FMAC(Tt[2], x0, v, 10); DPP_FMAC(Tt[3], x0, v, 11);
                DPP_FMAC(Tt[4], x0, v, 12); DPP_FMAC(Tt[5], x0, v, 13); DPP_FMAC(Tt[6], x0, v, 14); DPP_FMAC(Tt[7], x0, v, 15);
                asm volatile("s_waitcnt lgkmcnt(0)\n\ts_barrier" ::: "memory");
                const float* xp = XCH + (s & 1) * 512 + lane;
                const float sa = ((xp[0] + xp[64]) + (xp[128] + xp[192])) + ((xp[256] + xp[320]) + (xp[384] + xp[448]));
                DPP_FMAC(Tt[0], x1, sa, 8); DPP_FMAC(Tt[1], x1, sa, 9); DPP_FMAC(Tt[2], x1, sa, 10); DPP_FMAC(Tt[3], x1, sa, 11);
                DPP_FMAC(Tt[4], x1, sa, 12); DPP_FMAC(Tt[5], x1, sa, 13); DPP_FMAC(Tt[6], x1, sa, 14); DPP_FMAC(Tt[7], x1, sa, 15);
#pragma unroll
                for (int j = 0; j < 8; ++j) S[j] = Tt[j];
                float ya = 0.f, yb = 0.f;
                DPP_FMAC(ya, x2, S[0], 0); DPP_FMAC(yb, x2, S[1], 1); DPP_FMAC(ya, x2, S[2], 2); DPP_FMAC(yb, x2, S[3], 3);
                DPP_FMAC(ya, x2, S[4], 4); DPP_FMAC(yb, x2, S[5], 5); DPP_FMAC(ya, x2, S[6], 6); DPP_FMAC(yb, x2, S[7], 7);
                YP[(s & 15) * 512 + wave * 64 + lane] = ya + yb;
                x0 = n0; x1 = n1; x2 = n2;
                if ((s & 7) == 7) {
                    asm volatile("s_waitcnt lgkmcnt(0)\n\ts_barrier" ::: "memory");
                    const int sl = (s - 7) + wave;
                    const float* yp = YP + (sl & 15) * 512 + lane;
                    const float y0 = ((yp[0] + yp[64]) + (yp[128] + yp[192])) + ((yp[256] + yp[320]) + (yp[384] + yp[448]));
                    const int tt = dir ? S_ - 1 - (step0 + sl) : step0 + sl;
                    WKV[((size_t)(b * S_ + tt)) * 512 + hc0 + lane] = (bf16)f2bf(y0);
                }
            }
#undef DPP_FMAC
#undef DPP_MUL
            __syncthreads();
        }
    }
}

struct ScanRaw { float c[5], p[5], n[5]; };
__device__ __forceinline__ void scan_load(ScanRaw& R, const bf16* PR, int b, int t, const int (&cols)[5]) {
    const bf16* pc = PR + ((size_t)(b * S_ + t)) * 2048;
#pragma unroll
    for (int i = 0; i < 5; ++i) { R.c[i] = bf2f(pc[cols[i]]); R.p[i] = t > 0 ? bf2f(pc[cols[i] - 2048]) : 0.f; R.n[i] = t < S_ - 1 ? bf2f(pc[cols[i] + 2048]) : 0.f; }
}
__device__ __forceinline__ void scan_naive(const Params& P, int l, unsigned char* ldsg) {
    STAGE_IDS
    if (wave != 0) return;
    unsigned char* ws = P.ws;
    const bf16* PR = (const bf16*)(ws + WS_PR); float* BONUS = (float*)(ws + WS_BONUS);
    float* sW2 = (float*)ldsg; float* sA2 = sW2 + 4096; float* sh = sA2 + 4096; float* sv = sh + 128;
    for (int sid = blockIdx.x; sid < 256; sid += gridDim.x) {
        const int dir = sid & 1, h = (sid >> 1) & 7, b = sid >> 4, hc = h * 64 + lane;
        bf16* WKV = (bf16*)(ws + (dir ? WS_WKVB : WS_WKVF));
        const float* w2b = P.in[I_W2] + (size_t)(l * 2 + dir) * 64 * 512; const float* a2b = P.in[I_A2] + (size_t)(l * 2 + dir) * 64 * 512;
        for (int m = 0; m < 64; ++m) { sW2[m * 64 + lane] = w2b[m * 512 + hc]; sA2[m * 64 + lane] = a2b[m * 512 + hc]; }
        const float* mu = P.in[I_MU] + (size_t)l * 1920;
        const int cols[5] = {hc, 512 + hc, 1024 + hc, 1536 + 64 * dir + lane, 1664 + 64 * dir + lane};
        float mus[5];
#pragma unroll
        for (int i = 0; i < 5; ++i) mus[i] = mu[cols[i]];
        const float w0c = P.in[I_W0][(size_t)(l * 2 + dir) * 512 + hc], a0c = P.in[I_A0][(size_t)(l * 2 + dir) * 512 + hc];
        const float kkc = P.in[I_KK][l * 512 + hc], kac = P.in[I_KA][l * 512 + hc], rkc = P.in[I_RK][l * 512 + hc];
        float S[64];
#pragma unroll
        for (int j = 0; j < 64; ++j) S[j] = 0.f;
        ScanRaw cur, nxt;
        scan_load(cur, PR, b, dir ? S_ - 1 : 0, cols);
        for (int step = 0; step < S_; ++step) {
            const int t = dir ? S_ - 1 - step : step;
            if (step + 1 < S_) scan_load(nxt, PR, b, dir ? t - 1 : t + 1, cols); else nxt = cur;
            float sx[5];
#pragma unroll
            for (int i = 0; i < 5; ++i) sx[i] = cur.c[i] + mus[i] * (0.5f * (cur.p[i] + cur.n[i]) - cur.c[i]);
            const float r = sx[0], k = sx[1], v = sx[2];
            sh[lane] = tanhf(sx[3]); sh[64 + lane] = sx[4];
            float wlin = w0c, alin = a0c;
#pragma unroll 8
            for (int m = 0; m < 64; ++m) { wlin += sh[m] * sW2[m * 64 + lane]; alin += sh[64 + m] * sA2[m * 64 + lane]; }
            const float wlog = -log1pf(expf(-wlin)) - 0.5f;
            const float decay = expf(-expf(wlog));
            const float a = 1.0f / (1.0f + expf(-alin));
            float kkv = k * kkc; const float nrm = sqrtf(wave_sum(kkv * kkv)); kkv = kkv / fmaxf(nrm, 1e-12f);
            const float kd = k * (1.0f + (a - 1.0f) * kac);
            const float bon = wave_sum(r * kd * rkc);
            if (lane == 0) BONUS[((size_t)((dir * NB + b) * 8 + h)) * S_ + t] = bon;
            sv[lane] = decay; sv[64 + lane] = kd; sv[128 + lane] = -kkv; sv[192 + lane] = kkv * a; sv[256 + lane] = r;
            float sa = 0.f;
#pragma unroll
            for (int j = 0; j < 64; ++j) sa += S[j] * sv[128 + j];
            float y = 0.f;
#pragma unroll
            for (int j = 0; j < 64; ++j) { S[j] = S[j] * sv[j] + sa * sv[192 + j] + v * sv[64 + j]; y += S[j] * sv[256 + j]; }
            WKV[((size_t)(b * S_ + t)) * 512 + hc] = (bf16)f2bf(y);
            cur = nxt;
        }
    }
}


__device__ __forceinline__ void finalize_fast(const Params& P, int l, unsigned char* ldsg) {
    STAGE_IDS
    unsigned char* ws = P.ws;
    const bf16* PR = (const bf16*)(ws + WS_PR); const bf16* WF = (const bf16*)(ws + WS_WKVF); const bf16* WBk = (const bf16*)(ws + WS_WKVB); const float* BONUS = (const float*)(ws + WS_BONUS);
    bf16* YA = (bf16*)(ws + WS_YA);
    const int fr = lane & 15, fq = lane >> 4;
    const float* mu = P.in[I_MU] + (size_t)l * 1920; const float* g2 = P.in[I_G2] + (size_t)l * 128 * 512;
    const float* lngp = P.in[I_LNG] + l * 512; const float* lnbp = P.in[I_LNB] + l * 512;
    bf16x8_t gf[4][4];
#pragma unroll
    for (int n = 0; n < 4; ++n)
#pragma unroll
        for (int ks = 0; ks < 4; ++ks) { float gv[8];
#pragma unroll
            for (int e = 0; e < 8; ++e) gv[e] = g2[(size_t)(32 * ks + 8 * fq + e) * 512 + 64 * wave + 16 * n + fr];
            const v4u w = (v4u){cvtpk(gv[0], gv[1]), cvtpk(gv[2], gv[3]), cvtpk(gv[4], gv[5]), cvtpk(gv[6], gv[7])};
            gf[n][ks] = __builtin_bit_cast(bf16x8_t, w); }
    for (int tile = blockIdx.x; tile < T_ / 32; tile += gridDim.x) {
        const int t0 = tile * 32;
        __syncthreads();
        { const int tok = tid >> 4, mg = tid & 15, t = t0 + tok, s = t & 2047; float x[8];
          shifted8(PR + (size_t)t * 2048, 1792 + 8 * mg, s > 0, s < S_ - 1, mu, x);
#pragma unroll
          for (int e = 0; e < 8; ++e) x[e] = __builtin_amdgcn_rcpf(1.0f + __builtin_amdgcn_exp2f(-x[e] * LOG2E));
          *(v4u*)(ldsg + tok * 272 + mg * 16) = (v4u){cvtpk(x[0], x[1]), cvtpk(x[2], x[3]), cvtpk(x[4], x[5]), cvtpk(x[6], x[7])}; }
        __syncthreads();
#pragma unroll
        for (int mt = 0; mt < 2; ++mt) {
            f32x4m acc[4];
#pragma unroll
            for (int n = 0; n < 4; ++n) acc[n] = (f32x4m){0.f, 0.f, 0.f, 0.f};
#pragma unroll
            for (int ks = 0; ks < 4; ++ks) { const bf16x8_t bb = *(const bf16x8_t*)(ldsg + (16 * mt + fr) * 272 + (32 * ks + 8 * fq) * 2);
#pragma unroll
                for (int n = 0; n < 4; ++n) acc[n] = __builtin_amdgcn_mfma_f32_16x16x32_bf16(gf[n][ks], bb, acc[n], 0, 0, 0); }
            const int t = t0 + 16 * mt + fr, s = t & 2047, bb_ = t >> 11;
            float wk[4][4]; float sm = 0.f;
#pragma unroll
            for (int n = 0; n < 4; ++n) { const int c0 = 64 * wave + 16 * n + 4 * fq;
                const v2u a = *(const v2u*)(WF + (size_t)t * 512 + c0), b2 = *(const v2u*)(WBk + (size_t)t * 512 + c0);
                wk[n][0] = __uint_as_float(a.x << 16) + __uint_as_float(b2.x << 16); wk[n][1] = __uint_as_float(a.x & 0xffff0000u) + __uint_as_float(b2.x & 0xffff0000u);
                wk[n][2] = __uint_as_float(a.y << 16) + __uint_as_float(b2.y << 16); wk[n][3] = __uint_as_float(a.y & 0xffff0000u) + __uint_as_float(b2.y & 0xffff0000u);
                sm += (wk[n][0] + wk[n][1]) + (wk[n][2] + wk[n][3]); }
            sm += __shfl_xor(sm, 16); sm += __shfl_xor(sm, 32);
            const float mean = sm * (1.0f / 64.0f); float sq = 0.f;
#pragma unroll
            for (int n = 0; n < 4; ++n)
#pragma unroll
                for (int v = 0; v < 4; ++v) { wk[n][v] -= mean; sq += wk[n][v] * wk[n][v]; }
            sq += __shfl_xor(sq, 16); sq += __shfl_xor(sq, 32);
            const float rstd = 1.0f / sqrtf(sq * (1.0f / 64.0f) + 64e-5f);
            const float bon = BONUS[((size_t)(bb_ * 8 + wave)) * S_ + s] + BONUS[((size_t)((NB + bb_) * 8 + wave)) * S_ + s];
            const bf16* pc = PR + (size_t)t * 2048;
#pragma unroll
            for (int n = 0; n < 4; ++n) { const int c0 = 64 * wave + 16 * n + 4 * fq;
                const f4 lg = *(const f4*)(lngp + c0), lb = *(const f4*)(lnbp + c0), mv = *(const f4*)(mu + 1024 + c0);
                const v2u vc = *(const v2u*)(pc + 1024 + c0);
                v2u vp = (v2u){0u, 0u}, vn = (v2u){0u, 0u};
                if (s > 0) vp = *(const v2u*)(pc + 1024 + c0 - 2048);
                if (s < S_ - 1) vn = *(const v2u*)(pc + 1024 + c0 + 2048);
                const float cc[4] = {__uint_as_float(vc.x << 16), __uint_as_float(vc.x & 0xffff0000u), __uint_as_float(vc.y << 16), __uint_as_float(vc.y & 0xffff0000u)};
                const float pp[4] = {__uint_as_float(vp.x << 16), __uint_as_float(vp.x & 0xffff0000u), __uint_as_float(vp.y << 16), __uint_as_float(vp.y & 0xffff0000u)};
                const float nn[4] = {__uint_as_float(vn.x << 16), __uint_as_float(vn.x & 0xffff0000u), __uint_as_float(vn.y << 16), __uint_as_float(vn.y & 0xffff0000u)};
                float yv[4];
#pragma unroll
                for (int v = 0; v < 4; ++v) { const float vs = cc[v] + mv[v] * (0.5f * (pp[v] + nn[v]) - cc[v]);
                    yv[v] = (wk[n][v] * rstd * lg[v] + lb[v] + bon * vs) * acc[n][v]; }
                *(v2u*)(YA + (size_t)t * 512 + c0) = (v2u){cvtpk(yv[0], yv[1]), cvtpk(yv[2], yv[3])}; }
        }
    }
}

__device__ __forceinline__ void finalize_naive(const Params& P, int l, unsigned char* ldsg) {
    STAGE_IDS
    unsigned char* ws = P.ws;
    const bf16* PR = (const bf16*)(ws + WS_PR); const bf16* WF = (const bf16*)(ws + WS_WKVF); const bf16* WBk = (const bf16*)(ws + WS_WKVB); const float* BONUS = (const float*)(ws + WS_BONUS);
    bf16* YA = (bf16*)(ws + WS_YA);
    float* sg = (float*)ldsg;
    const float* mu = P.in[I_MU] + (size_t)l * 1920; const float* g2 = P.in[I_G2] + (size_t)l * 128 * 512;
    const float lng = P.in[I_LNG][l * 512 + tid], lnb = P.in[I_LNB][l * 512 + tid];
    const float mu_v = mu[1024 + tid], mu_g = tid < 128 ? mu[1792 + tid] : 0.f;
    for (int t = blockIdx.x; t < T_; t += gridDim.x) {
        const int s = t & 2047; const bf16* pc = PR + (size_t)t * 2048;
        if (tid < 128) { const int col = 1792 + tid; const float c = bf2f(pc[col]), p = s > 0 ? bf2f(pc[col - 2048]) : 0.f, n = s < S_ - 1 ? bf2f(pc[col + 2048]) : 0.f;
            const float x = c + mu_g * (0.5f * (p + n) - c); sg[tid] = 1.0f / (1.0f + expf(-x)); }
        __syncthreads();
        float gate = 0.f;
#pragma unroll 8
        for (int m = 0; m < 128; ++m) gate += sg[m] * g2[m * 512 + tid];
        const float wkv = bf2f(WF[(size_t)t * 512 + tid]) + bf2f(WBk[(size_t)t * 512 + tid]);
        const float mean = wave_sum(wkv) * (1.0f / 64.0f); const float dv = wkv - mean; const float var = wave_sum(dv * dv) * (1.0f / 64.0f);
        float y = dv * (1.0f / sqrtf(var + 64e-5f)) * lng + lnb;
        { const int col = 1024 + tid; const float c = bf2f(pc[col]), p = s > 0 ? bf2f(pc[col - 2048]) : 0.f, n = s < S_ - 1 ? bf2f(pc[col + 2048]) : 0.f;
          const float vs = c + mu_v * (0.5f * (p + n) - c); const int h = tid >> 6;
          const int b = t >> 11; y += (BONUS[((size_t)(b * 8 + h)) * S_ + s] + BONUS[((size_t)((NB + b) * 8 + h)) * S_ + s]) * vs; }
        YA[(size_t)t * 512 + tid] = (bf16)f2bf(y * gate);
        __syncthreads();
    }
}

#ifndef DBG_NL
#define DBG_NL NL
#endif
#ifndef DBG_BR
#define DBG_BR 7
#endif
#ifndef DBG_STOP
#define DBG_STOP 0
#endif
#define L1_INVALIDATE() do { asm volatile("s_waitcnt vmcnt(0)" ::: "memory"); __builtin_amdgcn_fence(__ATOMIC_ACQUIRE, "agent"); asm volatile("s_waitcnt vmcnt(0)" ::: "memory"); } while (0)
#define GRID_SYNC() do { asm volatile("s_waitcnt vmcnt(0) lgkmcnt(0)" ::: "memory"); grid.sync(); __builtin_amdgcn_fence(__ATOMIC_ACQUIRE, "agent"); asm volatile("s_waitcnt vmcnt(0)" ::: "memory"); } while (0)
#define GEMM_PHASE(EPI, A_, Bt_, M_, N_, K_, E_) do { pg8::Gemm g_{(const pg8::bf16_t*)(A_), (const pg8::bf16_t*)(Bt_), (M_), (N_), (K_)}; pg8::StaticOrder S_o; S_o.init((M_), (N_), (int)gridDim.x, (int)blockIdx.x); \
    pg8::gemm_phase<EPI, pg8::StaticOrder, true, true>((PG8_LAS unsigned char*)lds, g_, S_o, (E_)); } while (0)

#ifdef TPROBE
#define TP_DECL unsigned long long tp_acc[4] = {0, 0, 0, 0}, tp_t0 = 0;
#define TP_BEGIN() do { tp_t0 = __builtin_amdgcn_s_memrealtime(); } while (0)
#define TP_END(k) do { tp_acc[k] += __builtin_amdgcn_s_memrealtime() - tp_t0; } while (0)
#else
#define TP_DECL
#define TP_BEGIN() do {} while (0)
#define TP_END(k) do {} while (0)
#endif
__global__ void __launch_bounds__(NTHREADS, 2) fwd_kernel(Params P) {
    extern __shared__ __attribute__((aligned(16))) unsigned char lds[];
    cg::grid_group grid = cg::this_grid();
    unsigned char* ws = P.ws;
    bf16* H = (bf16*)(ws + WS_H); bf16* ACT = (bf16*)(ws + WS_ACT);
    TP_DECL
#ifdef DBG_HA
    bf16* HA = (bf16*)(ws + WS_QC);
#else
    bf16* HA = H;
#endif
    float* SSB = (float*)(ws + WS_SS);
    cvt_up1(P, 0, lds);
    x_to_bf16_ss(P.in[I_X], H, SSB);
    GRID_SYNC();
#pragma unroll 1
    for (int l = 0; l < DBG_NL; ++l) {
        const float* xin = (l == 0) ? P.in[I_X] : P.out;
        cvt_rest(P, l, lds);
        __syncthreads();
        { pg8::EpiSwiglu E{(pg8::bf16_t*)ACT, FF, SSB}; GEMM_PHASE(pg8::EpiSwiglu, H, ws + ((l & 1) ? WS_WUP1B : WS_WUP1), T_, 2 * FF, DM, E); }
        GRID_SYNC();
        { pg8::EpiResid E{xin, P.out, DM, 0.5f, (pg8::bf16_t*)H, SSB}; GEMM_PHASE(pg8::EpiResid, ACT, ws + WS_WDN1, T_, DM, FF, E); }
        GRID_SYNC();
        { pg8::EpiWin E{(pg8::bf16_t*)(ws + WS_PR), (pg8::bf16_t*)(ws + WS_QB), (pg8::bf16_t*)(ws + WS_KVB), (pg8::bf16_t*)(ws + WS_QC), (pg8::bf16_t*)(ws + WS_KVC), SSB};
          GEMM_PHASE(pg8::EpiWin, H, ws + WS_WIN, T_, 3584, DM, E); }
        GRID_SYNC();
        qkprep(P, l);
        vt_prep(P, lds);
        __syncthreads();
        scan_fast(P, l, lds);
#ifdef DUP_SCAN
        __syncthreads();
        scan_fast(P, l, lds);
#endif
#ifdef DUP_PREP
        __syncthreads();
        vt_prep(P, lds);
#endif
        GRID_SYNC();
        attn_mfma<false>((bf16*)(ws + WS_QB), (const bf16*)(ws + WS_KG), (const bf16*)(ws + WS_VG), nullptr, lds);
        attn_mfma<true>((bf16*)(ws + WS_QC), (const bf16*)(ws + WS_KW), (const bf16*)(ws + WS_VW), P.in[I_SINK] + l * 8, lds);
        __syncthreads();
        finalize_fast(P, l, lds);
#ifdef DUP_FIN
        finalize_fast(P, l, lds);
#endif
        GRID_SYNC();
#pragma unroll 1
        for (int i = 0; i < 3; ++i) {
            { pg8::EpiGate E{(pg8::bf16_t*)(ws + WS_GATE), SSB}; GEMM_PHASE(pg8::EpiGate, H, ws + WS_WG + (size_t)i * DM * DM * 2, T_, DM, DM, E); }
            L1_INVALIDATE();
            const unsigned char* yi = ws + (i == 0 ? WS_YA : (i == 1 ? WS_QB : WS_QC));
            { pg8::EpiMerge E{(const pg8::bf16_t*)(ws + WS_GATE), (pg8::bf16_t*)(ws + WS_MERGED), i == 0 ? 1 : 0}; GEMM_PHASE(pg8::EpiMerge, yi, ws + WS_WO + (size_t)i * DM * 512 * 2, T_, DM, 512, E); }
            if (i < 2) L1_INVALIDATE();
        }
        GRID_SYNC();
        { pg8::EpiResid E{P.out, P.out, DM, 1.0f, (pg8::bf16_t*)H, SSB}; GEMM_PHASE(pg8::EpiResid, ws + WS_MERGED, ws + WS_WOUT, T_, DM, DM, E); }
        GRID_SYNC();
        { pg8::EpiSwiglu E{(pg8::bf16_t*)ACT, FF, SSB}; GEMM_PHASE(pg8::EpiSwiglu, H, ws + WS_WUP2, T_, 2 * FF, DM, E); }
#ifdef DUP_UP
        { pg8::EpiSwiglu E{(pg8::bf16_t*)ACT, FF, SSB}; GEMM_PHASE(pg8::EpiSwiglu, H, ws + WS_WUP2, T_, 2 * FF, DM, E); }
#endif
        GRID_SYNC();
        if (l + 1 < NL) { cvt_up1(P, l + 1, lds); __syncthreads(); }
        { pg8::EpiResid E{P.out, P.out, DM, 0.5f, (pg8::bf16_t*)H, SSB}; GEMM_PHASE(pg8::EpiResid, ACT, ws + WS_WDN2, T_, DM, FF, E); }
        GRID_SYNC();
    }
    rms_rows_f32_inplace(P.out, P.in[I_FINN]);
#ifdef TPROBE
    {
        float* tpw = (float*)(ws + WS_SCR);
        GRID_SYNC();
        if (blockIdx.x == 0 && threadIdx.x == 0) { tpw[0] = (float)tp_acc[TPROBE_A] * 0.01f; tpw[1] = (float)tp_acc[TPROBE_B] * 0.01f; }
        GRID_SYNC();
        const float ta = tpw[0], tb = tpw[1];
        const int gt = blockIdx.x * NTHREADS + threadIdx.x;
        for (int i = gt; i < (1 << 20); i += gridDim.x * NTHREADS) P.out[i] = tb * 0.01f;
        if (gt == 0) P.out[1 << 21] = ta * 0.1f;
    }
#endif
}

extern "C" void kernel_launch(void* const* d_in, const int* in_sizes, int n_in, void* d_out, int out_size, void* d_ws, size_t ws_size, hipStream_t stream) {
    static int grid_blocks = 0;
    if (grid_blocks == 0) {
        if (n_in != N_IN || out_size != T_ * DM || ws_size < WS_END) { fprintf(stderr, "kernel_launch: unexpected shapes (n_in %d, out %d, ws %zu < %zu)\n", n_in, out_size, ws_size, (size_t)WS_END); grid_blocks = -1; return; }
        int dev = 0, cus = 0, per_cu = 0;
        hipGetDevice(&dev);
        hipDeviceGetAttribute(&cus, hipDeviceAttributeMultiprocessorCount, dev);
        hipFuncSetAttribute((const void*)fwd_kernel, hipFuncAttributeMaxDynamicSharedMemorySize, LDS_BYTES);
        hipOccupancyMaxActiveBlocksPerMultiprocessor(&per_cu, (const void*)fwd_kernel, NTHREADS, LDS_BYTES);
        if (per_cu < 1) per_cu = 1;
        grid_blocks = cus * per_cu;
    }
    if (grid_blocks < 0) return;
    Params p{};
    for (int i = 0; i < N_IN; ++i) p.in[i] = (const float*)d_in[i];
    p.out = (float*)d_out; p.ws = (unsigned char*)d_ws;
    void* args[] = {&p};
    hipError_t e = hipLaunchCooperativeKernel((const void*)fwd_kernel, dim3(grid_blocks), dim3(NTHREADS), args, LDS_BYTES, stream);
    if (e != hipSuccess) fprintf(stderr, "cooperative launch failed: %s (grid %d)\n", hipGetErrorString(e), grid_blocks);
}
```

```cpp
#include <hip/hip_runtime.h>
#include <hip/hip_cooperative_groups.h>
#include <cstdio>
#include <cstdint>
namespace cg = cooperative_groups;
namespace pg8 {
#define PG8_LAS __attribute__((address_space(3)))
typedef unsigned short bf16_t;
typedef short bf16x8 __attribute__((ext_vector_type(8)));
typedef float f32x4 __attribute__((ext_vector_type(4)));
typedef unsigned u32x4 __attribute__((ext_vector_type(4)));
constexpr int BM = 256, BK = 64, HALF = 128, HTB = HALF * BK * 2  , STAGE_BYTES = 8 * HTB, NXCD = 8, WGM = 8;

__host__ __device__ __forceinline__ int lds_byte(int r, int c) { const int st = (r >> 4) * 2 + (c >> 5), rr = r & 15, cc = c & 31, ob = rr * 64 + cc * 2; return st * 1024 + (ob ^ (((ob >> 9) & 1) << 5)); }
__host__ __device__ __forceinline__ void stage_rc(int b, int& R, int& C) { const int st = b / 1024, sb = b % 1024, swz = sb ^ (((sb >> 9) & 1) << 5); R = (st >> 1) * 16 + swz / 64; C = (st & 1) * 32 + (swz % 64) / 2; }
__host__ __device__ __forceinline__ int perm32(int rho) { const int n = rho >> 4, i = rho & 15; return 8 * (i >> 2) + 4 * n + (i & 3); }

struct Unit { int pm, pn; };
struct Gemm { const bf16_t* A; const bf16_t* Bt; int M, N, K; };

struct StaticOrder {
    int nM, nN, nwg, G, c;
    __host__ __device__ void init(int M, int N, int G_, int c_) { nM = M / BM; nN = N / BM; nwg = nM * nN; G = G_; c = c_; }
    __host__ __device__ bool next(int i, Unit& u) const {
        const long L = (long)i * G + c; if (L >= nwg) return false;
        int wgid = (int)L; { const int q = nwg / NXCD, r = nwg % NXCD, xcd = wgid % NXCD, off = wgid / NXCD; wgid = (xcd < r ? xcd * (q + 1) : r * (q + 1) + (xcd - r) * q) + off; }
        const int nig = WGM * nN, gid = wgid / nig, fm = gid * WGM, gsz = (nM - fm) < WGM ? (nM - fm) : WGM;
        u.pm = fm + ((wgid % nig) % gsz); u.pn = (wgid % nig) / gsz; return true;
    }
    __device__ __forceinline__ void a_ready(const Unit&) const {}
    __device__ __forceinline__ void done(const Unit&) const {}
};
typedef float f32x2_t __attribute__((ext_vector_type(2))); typedef __bf16 bf16x2_t __attribute__((ext_vector_type(2)));
__device__ __forceinline__ unsigned cvt_pk_bf16(float lo, float hi) { f32x2_t v = {lo, hi}; bf16x2_t b = __builtin_convertvector(v, bf16x2_t); return __builtin_bit_cast(unsigned, b); }
typedef float f32x2 __attribute__((ext_vector_type(2)));
__device__ __forceinline__ float fast_sigmoid(float x) { return __builtin_amdgcn_rcpf(1.0f + __builtin_amdgcn_exp2f(-1.4426950408889634f * x)); }
__device__ __forceinline__ u32x4 ld16_agent(const bf16_t* p) { const unsigned long long a = __hip_atomic_load((const unsigned long long*)p, __ATOMIC_RELAXED, __HIP_MEMORY_SCOPE_AGENT), b = __hip_atomic_load((const unsigned long long*)p + 1, __ATOMIC_RELAXED, __HIP_MEMORY_SCOPE_AGENT); u32x4 r; r.x = (unsigned)a; r.y = (unsigned)(a >> 32); r.z = (unsigned)b; r.w = (unsigned)(b >> 32); return r; }
__device__ __forceinline__ float bf_lo(unsigned w) { return __uint_as_float(w << 16); }
__device__ __forceinline__ float bf_hi(unsigned w) { return __uint_as_float(w & 0xffff0000u); }

__device__ __forceinline__ float row_rs(const float* SS, int row) { const f32x4 a = *(const f32x4*)(SS + (size_t)row * 16), b2 = *(const f32x4*)(SS + (size_t)row * 16 + 4), c2 = *(const f32x4*)(SS + (size_t)row * 16 + 8), d = *(const f32x4*)(SS + (size_t)row * 16 + 12);
    const float s = ((a[0] + a[1]) + (a[2] + a[3])) + ((b2[0] + b2[1]) + (b2[2] + b2[3])) + ((c2[0] + c2[1]) + (c2[2] + c2[3])) + ((d[0] + d[1]) + (d[2] + d[3]));
    return 1.0f / sqrtf(s * (1.0f / 1024.0f) + 1e-6f); }
struct EpiSwiglu {
    static constexpr bool PERM = true, AFTER_DRAIN = false;
    bf16_t* O; int ldc; const float* SS;
    __device__ __forceinline__ void operator()(const f32x4 (&acc)[2][2][4][2], const Unit& u, int wr, int wc, int fr, int fq) const {
        const int row0 = u.pm * BM + wr * 64 + fr, col0 = u.pn * HALF + wc * 32 + 8 * fq;
#pragma unroll
        for (int ai = 0; ai < 2; ++ai)
#pragma unroll
            for (int m = 0; m < 4; ++m) {
                bf16_t* rowp = O + (size_t)(row0 + ai * HALF + m * 16) * ldc + col0;
                const float rs = row_rs(SS, row0 + ai * HALF + m * 16);
                float v[8];
#pragma unroll
                for (int n = 0; n < 2; ++n)
#pragma unroll
                    for (int j = 0; j < 4; ++j) { const float g = acc[ai][0][m][n][j] * rs, up = acc[ai][1][m][n][j] * rs; v[n * 4 + j] = g * fast_sigmoid(g) * up; }
                u32x4 w; w.x = cvt_pk_bf16(v[0], v[1]); w.y = cvt_pk_bf16(v[2], v[3]); w.z = cvt_pk_bf16(v[4], v[5]); w.w = cvt_pk_bf16(v[6], v[7]);
                *(u32x4*)rowp = w;
            }
    }
};
struct EpiResid {
    static constexpr bool PERM = false, AFTER_DRAIN = false;
    const float* src; float* dst; int ldc; float scale; bf16_t* XB; float* SS;
    __device__ __forceinline__ void operator()(const f32x4 (&acc)[2][2][4][2], const Unit& u, int wr, int wc, int fr, int fq) const {
        const int col0 = u.pn * BM + wc * 32 + 4 * fq;
#pragma unroll
        for (int ai = 0; ai < 2; ++ai)
#pragma unroll
            for (int m = 0; m < 4; ++m) {
                const int row = u.pm * BM + ai * HALF + wr * 64 + m * 16 + fr;
                const size_t off = (size_t)row * ldc + col0; float sq = 0.f;
#pragma unroll
                for (int bj = 0; bj < 2; ++bj)
#pragma unroll
                    for (int n = 0; n < 2; ++n) { const f32x4 b = *(const f32x4*)(src + off + bj * HALF + n * 16); const f32x4 x = b + acc[ai][bj][m][n] * scale;
                        *(f32x4*)(dst + off + bj * HALF + n * 16) = x; sq += (x[0] * x[0] + x[1] * x[1]) + (x[2] * x[2] + x[3] * x[3]);
                        typedef unsigned u32x2 __attribute__((ext_vector_type(2)));
                        *(u32x2*)(XB + off + bj * HALF + n * 16) = (u32x2){cvt_pk_bf16(x[0], x[1]), cvt_pk_bf16(x[2], x[3])}; }
                sq += __shfl_xor(sq, 16); sq += __shfl_xor(sq, 32);
                if (fq == 0) SS[(size_t)row * 16 + u.pn * 4 + wc] = sq;
            }
    }
};
struct EpiWin {
    static constexpr bool PERM = true, AFTER_DRAIN = false;
    bf16_t *PR, *QB, *KVB, *QC, *KVC; const float* SS;
    __device__ __forceinline__ void operator()(const f32x4 (&acc)[2][2][4][2], const Unit& u, int wr, int wc, int fr, int fq) const {
        bf16_t* base; int ldc, colt;
        const int pn = u.pn;
        if (pn < 8) { base = PR; ldc = 2048; colt = pn * 256; }
        else if (pn < 10) { base = QB; ldc = 512; colt = (pn - 8) * 256; }
        else if (pn == 10) { base = KVB; ldc = 256; colt = 0; }
        else if (pn < 13) { base = QC; ldc = 512; colt = (pn - 11) * 256; }
        else { base = KVC; ldc = 256; colt = 0; }
        const int row0 = u.pm * BM + wr * 64 + fr, col0 = colt + wc * 32 + 8 * fq;
#pragma unroll
        for (int ai = 0; ai < 2; ++ai)
#pragma unroll
            for (int m = 0; m < 4; ++m) {
                bf16_t* rowp = base + (size_t)(row0 + ai * HALF + m * 16) * ldc + col0;
                const float rs = row_rs(SS, row0 + ai * HALF + m * 16);
#pragma unroll
                for (int bj = 0; bj < 2; ++bj) { const f32x4 v0 = acc[ai][bj][m][0] * rs, v1 = acc[ai][bj][m][1] * rs;
                    u32x4 w; w.x = cvt_pk_bf16(v0[0], v0[1]); w.y = cvt_pk_bf16(v0[2], v0[3]); w.z = cvt_pk_bf16(v1[0], v1[1]); w.w = cvt_pk_bf16(v1[2], v1[3]);
                    *(u32x4*)(rowp + bj * HALF) = w; }
            }
    }
};
struct EpiGate {
    static constexpr bool PERM = true, AFTER_DRAIN = false;
    bf16_t* G; const float* SS;
    __device__ __forceinline__ void operator()(const f32x4 (&acc)[2][2][4][2], const Unit& u, int wr, int wc, int fr, int fq) const {
        const int row0 = u.pm * BM + wr * 64 + fr, col0 = u.pn * BM + wc * 32 + 8 * fq;
#pragma unroll
        for (int ai = 0; ai < 2; ++ai)
#pragma unroll
            for (int m = 0; m < 4; ++m) {
                bf16_t* rowp = G + (size_t)(row0 + ai * HALF + m * 16) * 1024 + col0;
                const float rs = row_rs(SS, row0 + ai * HALF + m * 16);
#pragma unroll
                for (int bj = 0; bj < 2; ++bj) { const f32x4 v0 = acc[ai][bj][m][0] * rs, v1 = acc[ai][bj][m][1] * rs;
                    u32x4 w; w.x = cvt_pk_bf16(fast_sigmoid(v0[0]), fast_sigmoid(v0[1])); w.y = cvt_pk_bf16(fast_sigmoid(v0[2]), fast_sigmoid(v0[3]));
                    w.z = cvt_pk_bf16(fast_sigmoid(v1[0]), fast_sigmoid(v1[1])); w.w = cvt_pk_bf16(fast_sigmoid(v1[2]), fast_sigmoid(v1[3]));
#ifdef DBG_GCONST
                    w = (u32x4){0x3f003f00u, 0x3f003f00u, 0x3f003f00u, 0x3f003f00u};
#endif
                    *(u32x4*)(rowp + bj * HALF) = w; }
            }
    }
};
struct EpiMerge {
    static constexpr bool PERM = true, AFTER_DRAIN = false;
    const bf16_t* G; bf16_t* Mg; int first;
    __device__ __forceinline__ void operator()(const f32x4 (&acc)[2][2][4][2], const Unit& u, int wr, int wc, int fr, int fq) const {
        const int row0 = u.pm * BM + wr * 64 + fr, col0 = u.pn * BM + wc * 32 + 8 * fq;
#pragma unroll
        for (int ai = 0; ai < 2; ++ai)
#pragma unroll
            for (int m = 0; m < 4; ++m) {
                const size_t off = (size_t)(row0 + ai * HALF + m * 16) * 1024 + col0;
#pragma unroll
                for (int bj = 0; bj < 2; ++bj) { const f32x4 v0 = acc[ai][bj][m][0], v1 = acc[ai][bj][m][1];
#ifdef DBG_NOG
                    const u32x4 g = (u32x4){0x3f803f80u, 0x3f803f80u, 0x3f803f80u, 0x3f803f80u};
#else
                    const u32x4 g = *(const u32x4*)(G + off + bj * HALF);
#endif
                    float r[8];
                    r[0] = bf_lo(g.x) * v0[0]; r[1] = bf_hi(g.x) * v0[1]; r[2] = bf_lo(g.y) * v0[2]; r[3] = bf_hi(g.y) * v0[3];
                    r[4] = bf_lo(g.z) * v1[0]; r[5] = bf_hi(g.z) * v1[1]; r[6] = bf_lo(g.w) * v1[2]; r[7] = bf_hi(g.w) * v1[3];
#ifdef DBG_NOG
                    if (false) { const u32x4 p = *(const u32x4*)(Mg + off + bj * HALF);
#else
                    if (!first) { const u32x4 p = *(const u32x4*)(Mg + off + bj * HALF);
#endif
                        r[0] += bf_lo(p.x); r[1] += bf_hi(p.x); r[2] += bf_lo(p.y); r[3] += bf_hi(p.y); r[4] += bf_lo(p.z); r[5] += bf_hi(p.z); r[6] += bf_lo(p.w); r[7] += bf_hi(p.w); }
                    u32x4 w; w.x = cvt_pk_bf16(r[0], r[1]); w.y = cvt_pk_bf16(r[2], r[3]); w.z = cvt_pk_bf16(r[4], r[5]); w.w = cvt_pk_bf16(r[6], r[7]);
                    *(u32x4*)(Mg + off + bj * HALF) = w; }
            }
    }
};
template <class Epi, class Sched, bool ALIGN_EPI = false, bool SP2 = false>
__device__ __forceinline__ void gemm_phase(PG8_LAS unsigned char* lds, const Gemm g, const Sched& S, const Epi& E) {
    int tid_o = threadIdx.x; asm volatile("" : "+v"(tid_o));
    const int tid = tid_o, wid = __builtin_amdgcn_readfirstlane(tid >> 6), lane = tid & 63, wr = wid >> 2, wc = wid & 3, fr = lane & 15, fq = lane >> 4;
    const int K = g.K, nt = K / BK;
    unsigned voffA[2], voffB[2];
#pragma unroll
    for (int i = 0; i < 2; ++i) { int R, C; stage_rc(tid * 16 + i * 8192, R, C); const int Rb = Epi::PERM ? ((R & ~31) + perm32(R & 31)) : R;
        voffA[i] = (unsigned)(R * K + C) * 2u; voffB[i] = (unsigned)(Rb * K + C) * 2u; }
    const size_t kstep = (size_t)(BK * 2);
    const size_t hstep = (size_t)HALF * K * 2;
    const size_t tstep = 2 * hstep;
    const unsigned ldsw = (unsigned)wid * 1024u;
    const int aoff = lds_byte(wr * 64 + fr, fq * 8), boff = lds_byte(wc * 32 + fr, fq * 8);
#define PG8_SA(b, h) (((b) * 2 + (h)) * HTB)
#define PG8_SB(b, h) ((4 + (b) * 2 + (h)) * HTB)
#define PG8_STAGE(bufoff, gbase, voff) do { _Pragma("unroll") for (int _i = 0; _i < 2; ++_i) \
        __builtin_amdgcn_global_load_lds((const unsigned*)((const char*)(gbase) + (voff)[_i]), (PG8_LAS unsigned*)(lds + (bufoff) + ldsw + _i * 8192), 16, 0, 0); } while (0)
#define PG8_LDA(dst, b, h) do { _Pragma("unroll") for (int m = 0; m < 4; ++m) _Pragma("unroll") for (int k = 0; k < 2; ++k) dst[m][k] = *(const PG8_LAS bf16x8*)(lds + PG8_SA(b, h) + aoff + m * 2048 + k * 1024); } while (0)
#define PG8_LDB(dst, b, h) do { _Pragma("unroll") for (int n = 0; n < 2; ++n) _Pragma("unroll") for (int k = 0; k < 2; ++k) dst[n][k] = *(const PG8_LAS bf16x8*)(lds + PG8_SB(b, h) + boff + n * 2048 + k * 1024); } while (0)
#define PG8_MMA(ai, bj, At, Bt) do { __builtin_amdgcn_s_setprio(1); _Pragma("unroll") for (int m = 0; m < 4; ++m) _Pragma("unroll") for (int n = 0; n < 2; ++n) _Pragma("unroll") for (int k = 0; k < 2; ++k) \
        acc[ai][bj][m][n] = __builtin_amdgcn_mfma_f32_16x16x32_bf16(Bt[n][k], At[m][k], acc[ai][bj][m][n], 0, 0, 0); __builtin_amdgcn_s_setprio(0); } while (0)
#define PG8_WAIT_V(n) asm volatile("s_waitcnt vmcnt(" #n ")" ::: "memory")
#define PG8_WAIT_L(n) asm volatile("s_waitcnt lgkmcnt(" #n ")" ::: "memory")
#define PG8_BAR __builtin_amdgcn_s_barrier()
#define PG8_SCHED __builtin_amdgcn_sched_barrier(0)
    Unit cur, nxt; int ui = 0;
    if (!S.next(0, cur)) return;
    f32x4 acc[2][2][4][2];
#pragma unroll
    for (int a = 0; a < 2; ++a)
#pragma unroll
        for (int b = 0; b < 2; ++b)
#pragma unroll
            for (int m = 0; m < 4; ++m)
#pragma unroll
                for (int n = 0; n < 2; ++n) acc[a][b][m][n] = (f32x4){0.f, 0.f, 0.f, 0.f};
    bf16x8 At[4][2], B0[2][2], B1[2][2];
    const char* cA = (const char*)g.A + (size_t)cur.pm * tstep; const char* cB = (const char*)g.Bt + (size_t)cur.pn * tstep;
    S.a_ready(cur);
    if constexpr (SP2) {
        PG8_STAGE(PG8_SB(0, 0), cB, voffB); PG8_STAGE(PG8_SB(0, 1), cB + hstep, voffB); PG8_STAGE(PG8_SA(0, 0), cA, voffA); PG8_STAGE(PG8_SA(0, 1), cA + hstep, voffA);
        if (wr == 1) PG8_BAR;
        PG8_WAIT_V(2); PG8_BAR;
        PG8_STAGE(PG8_SB(1, 0), cB + kstep, voffB); PG8_STAGE(PG8_SA(1, 0), cA + kstep, voffA); PG8_STAGE(PG8_SB(1, 1), cB + hstep + kstep, voffB);
        PG8_WAIT_V(6); PG8_BAR;
    } else {
        PG8_STAGE(PG8_SB(0, 0), cB, voffB); PG8_STAGE(PG8_SA(0, 0), cA, voffA); PG8_STAGE(PG8_SB(0, 1), cB + hstep, voffB); PG8_STAGE(PG8_SA(0, 1), cA + hstep, voffA);
        if (wr == 1) PG8_BAR;
        PG8_WAIT_V(4); PG8_BAR;
        PG8_STAGE(PG8_SB(1, 0), cB + kstep, voffB); PG8_STAGE(PG8_SA(1, 0), cA + kstep, voffA); PG8_STAGE(PG8_SB(1, 1), cB + hstep + kstep, voffB);
        PG8_WAIT_V(6); PG8_BAR;
    }
    for (;;) {
        const bool has_next = S.next(ui + 1, nxt);
        const char* nA = has_next ? (const char*)g.A + (size_t)nxt.pm * tstep : cA; const char* nB = has_next ? (const char*)g.Bt + (size_t)nxt.pn * tstep : cB;
        for (int t = 0; t < nt; t += 2) {
            const bool last = (t == nt - 2);
            const char* a1 = cA + (size_t)(t + 1) * kstep;
            const char* a2 = last ? nA : cA + (size_t)(t + 2) * kstep; const char* b2 = last ? nB : cB + (size_t)(t + 2) * kstep;
            const char* a3 = a2 + kstep; const char* b3 = b2 + kstep;
            if (last && has_next) S.a_ready(nxt);
            if constexpr (SP2) {
            PG8_LDB(B0, 0, 0); PG8_LDB(B1, 0, 1); PG8_SCHED; PG8_LDA(At, 0, 0); PG8_STAGE(PG8_SA(1, 1), a1 + hstep, voffA);
            PG8_WAIT_V(8); PG8_WAIT_L(0); PG8_BAR; PG8_MMA(0, 0, At, B0); PG8_MMA(0, 1, At, B1); PG8_BAR; PG8_SCHED;
            PG8_LDA(At, 0, 1); PG8_STAGE(PG8_SB(0, 0), b2, voffB); PG8_STAGE(PG8_SB(0, 1), b2 + hstep, voffB); PG8_STAGE(PG8_SA(0, 0), a2, voffA);
            PG8_WAIT_V(8); PG8_WAIT_L(0); PG8_BAR; PG8_MMA(1, 0, At, B0); PG8_MMA(1, 1, At, B1); PG8_BAR; PG8_SCHED;
            PG8_LDB(B0, 1, 0); PG8_LDB(B1, 1, 1); PG8_SCHED; PG8_LDA(At, 1, 0); PG8_STAGE(PG8_SA(0, 1), a2 + hstep, voffA);
            PG8_WAIT_V(8); PG8_WAIT_L(0); PG8_BAR; PG8_MMA(0, 0, At, B0); PG8_MMA(0, 1, At, B1); PG8_BAR; PG8_SCHED;
            PG8_LDA(At, 1, 1); PG8_STAGE(PG8_SB(1, 0), b3, voffB); PG8_STAGE(PG8_SB(1, 1), b3 + hstep, voffB); PG8_STAGE(PG8_SA(1, 0), a3, voffA);
            PG8_WAIT_V(8); PG8_WAIT_L(0); PG8_BAR; PG8_MMA(1, 0, At, B0); PG8_MMA(1, 1, At, B1); PG8_BAR; PG8_SCHED;
            } else {
            PG8_LDB(B0, 0, 0); PG8_SCHED; PG8_LDA(At, 0, 0); PG8_STAGE(PG8_SA(1, 1), a1 + hstep, voffA);
            PG8_WAIT_L(8); PG8_BAR; PG8_WAIT_L(0); PG8_MMA(0, 0, At, B0); PG8_BAR; PG8_SCHED;
            PG8_LDB(B1, 0, 1); PG8_STAGE(PG8_SB(0, 0), b2, voffB);
            PG8_BAR; PG8_WAIT_L(0); PG8_MMA(0, 1, At, B1); PG8_BAR;
            PG8_LDA(At, 0, 1); PG8_STAGE(PG8_SA(0, 0), a2, voffA);
            PG8_BAR; PG8_WAIT_L(0); PG8_MMA(1, 0, At, B0); PG8_BAR; PG8_SCHED;
            PG8_STAGE(PG8_SB(0, 1), b2 + hstep, voffB);
            PG8_WAIT_V(6); PG8_BAR; PG8_MMA(1, 1, At, B1); PG8_BAR;
            PG8_LDB(B0, 1, 0); PG8_SCHED; PG8_LDA(At, 1, 0); PG8_STAGE(PG8_SA(0, 1), a2 + hstep, voffA);
            PG8_WAIT_L(8); PG8_BAR; PG8_WAIT_L(0); PG8_MMA(0, 0, At, B0); PG8_BAR; PG8_SCHED;
            PG8_LDB(B1, 1, 1); PG8_STAGE(PG8_SB(1, 0), b3, voffB);
            PG8_BAR; PG8_WAIT_L(0); PG8_MMA(0, 1, At, B1); PG8_BAR;
            PG8_LDA(At, 1, 1); PG8_STAGE(PG8_SA(1, 0), a3, voffA);
            PG8_BAR; PG8_WAIT_L(0); PG8_MMA(1, 0, At, B0); PG8_BAR; PG8_SCHED;
            PG8_STAGE(PG8_SB(1, 1), b3 + hstep, voffB);
            PG8_WAIT_V(6); PG8_BAR; PG8_MMA(1, 1, At, B1); PG8_BAR;
            }
        }
        if constexpr (ALIGN_EPI) { if (wr == 0) PG8_BAR; }
        if constexpr (!Epi::AFTER_DRAIN) { E(acc, cur, wr, wc, fr, fq); S.done(cur); }
        if (!has_next) break;
#pragma unroll
        for (int a = 0; a < 2; ++a)
#pragma unroll
            for (int b = 0; b < 2; ++b)
#pragma unroll
                for (int m = 0; m < 4; ++m)
#pragma unroll
                    for (int n = 0; n < 2; ++n) acc[a][b][m][n] = (f32x4){0.f, 0.f, 0.f, 0.f};
        cur = nxt; cA = nA; cB = nB; ++ui;
        if constexpr (ALIGN_EPI) { if (wr == 1) PG8_BAR; }
    }
    PG8_WAIT_V(0);
    if constexpr (!ALIGN_EPI) { if (wr == 0) PG8_BAR; }
    PG8_BAR;
    if constexpr (Epi::AFTER_DRAIN) { E.fused(acc, cur, wr, wc, fr, fq, lds, wid, lane); S.done(cur); }
#undef PG8_SA
#undef PG8_SB
#undef PG8_STAGE
#undef PG8_LDA
#undef PG8_LDB
#undef PG8_MMA
#undef PG8_WAIT_V
#undef PG8_WAIT_L
#undef PG8_BAR
#undef PG8_SCHED
}
}
#define LAS __attribute__((address_space(3)))
typedef unsigned short bf16;
typedef unsigned v4u __attribute__((ext_vector_type(4)));
typedef unsigned v2u __attribute__((ext_vector_type(2)));
typedef float f4 __attribute__((ext_vector_type(4)));
constexpr int T_ = 32768, S_ = 2048, NB = 16, DM = 1024, FF = 2816, NL = 4;
constexpr int NWAVES = 8, NTHREADS = 512;
constexpr int LDS_BYTES = 163840;
constexpr float LOG2E = 1.4426950408889634f;
constexpr float C2 = 0.125f * LOG2E;
constexpr float LOG2_THETA = 13.287712379549449f;

enum { I_X = 0, I_F1N, I_F1UP, I_F1DN, I_MIXN, I_WIN, I_MU, I_W0, I_W2, I_A0, I_A2, I_G2, I_KK, I_KA, I_RK, I_LNG, I_LNB, I_QN, I_KN, I_SINK,
       I_WOA, I_WOB, I_WOC, I_WOUT, I_F2N, I_F2UP, I_F2DN, I_FINN, N_IN };

constexpr size_t SZ_WUP = (size_t)2 * FF * DM * 2, SZ_WDN = (size_t)DM * FF * 2, SZ_WIN = (size_t)3584 * DM * 2, SZ_WG = (size_t)3072 * DM * 2,
                 SZ_WO = (size_t)3 * DM * 512 * 2, SZ_WOUT = (size_t)DM * DM * 2;
constexpr size_t WS_WUP1 = 0, WS_WDN1 = WS_WUP1 + SZ_WUP, WS_WIN = WS_WDN1 + SZ_WDN, WS_WG = WS_WIN + SZ_WIN, WS_WO = WS_WG + SZ_WG, WS_WOUT = WS_WO + SZ_WO,
                 WS_WUP2 = WS_WOUT + SZ_WOUT, WS_WDN2 = WS_WUP2 + SZ_WUP, WS_H = WS_WDN2 + SZ_WDN;
constexpr size_t WS_R = WS_H + (size_t)T_ * DM * 2;
constexpr size_t WS_ACT = WS_R;
constexpr size_t WS_PR = WS_R, WS_QB = WS_PR + (size_t)T_ * 2048 * 2, WS_KVB = WS_QB + (size_t)T_ * 512 * 2, WS_QC = WS_KVB + (size_t)T_ * 256 * 2, WS_KVC = WS_QC + (size_t)T_ * 512 * 2,
                 WS_KG = WS_KVC + (size_t)T_ * 256 * 2, WS_VG = WS_KG + (size_t)NB * 2 * S_ * 64 * 2, WS_KW = WS_VG + (size_t)NB * 2 * S_ * 64 * 2, WS_VW = WS_KW + (size_t)NB * 2 * S_ * 64 * 2,
                 WS_YA = WS_VW + (size_t)NB * 2 * S_ * 64 * 2, WS_WKVF = WS_YA + (size_t)T_ * 512 * 2, WS_WKVB = WS_WKVF + (size_t)T_ * 512 * 2, WS_BONUS = WS_WKVB + (size_t)T_ * 512 * 2,
                 WS_SCR = WS_BONUS + (size_t)T_ * 16 * 4, WS_SS = WS_SCR, WS_WUP1B = WS_SS + (size_t)T_ * 16 * 4, WS_END = WS_WUP1B + SZ_WUP;
#ifdef DBG_GATE_ALT
constexpr size_t WS_GATE = WS_WKVF, WS_MERGED = WS_PR + (size_t)T_ * DM * 2;
#else
constexpr size_t WS_GATE = WS_PR, WS_MERGED = WS_PR + (size_t)T_ * DM * 2;
#endif
static_assert(WS_ACT + (size_t)T_ * FF * 2 <= WS_END, "map");
static_assert(WS_END < 536000000ull, "workspace budget");

struct Params { const float* in[N_IN]; float* out; unsigned char* ws; };

__device__ __forceinline__ unsigned f2bf(float f) { unsigned u = __float_as_uint(f); return (u + 0x7fffu + ((u >> 16) & 1u)) >> 16; }
__device__ __forceinline__ unsigned pk2(float lo, float hi) { return f2bf(lo) | (f2bf(hi) << 16); }
__device__ __forceinline__ float bf2f(bf16 h) { return __uint_as_float((unsigned)h << 16); }
__device__ __forceinline__ int opaque_tid() { int t = threadIdx.x; asm volatile("" : "+v"(t)); return t; }
#define STAGE_IDS const int tid = opaque_tid(), lane = tid & 63, wave = __builtin_amdgcn_readfirstlane(tid >> 6); const int gw = blockIdx.x * NWAVES + wave, ngw = gridDim.x * NWAVES, gtid = blockIdx.x * NTHREADS + tid, gthreads = gridDim.x * NTHREADS; (void)lane; (void)gw; (void)ngw; (void)gtid; (void)gthreads;
__device__ __forceinline__ float wave_sum(float v) {
#pragma unroll
    for (int o = 1; o < 64; o <<= 1) v += __shfl_xor(v, o);
    return v;
}

__device__ __forceinline__ void cvt_wt(const float* W, int K, int ld, bf16* Wt, int nrows, int mode, int gw, int ngw, int lane, float* scr, const float* gain = nullptr) {
    const int nblk = nrows >> 5, nitems = (K >> 6) * nblk;
    for (int it = gw; it < nitems; it += ngw) {
        const int kb = it / nblk, nb = it % nblk, k0 = kb * 64, n0 = nb * 32;
        int col0;
        if (mode == 0) col0 = n0;
        else if (mode == 1) { const int t = n0 >> 8, r = n0 & 255; col0 = (r < 128) ? t * 128 + r : FF + t * 128 + (r - 128); }
        else if (mode == 2) col0 = n0 < 1920 ? n0 : (n0 < 2048 ? -1 : n0 - 128);
        else col0 = 3456 + n0;
        if (col0 >= 0) {
#pragma unroll 8
            for (int i = 0; i < 32; ++i) { const int kk = 2 * i + (lane >> 5); scr[kk * 33 + (lane & 31)] = W[(size_t)(k0 + kk) * ld + col0 + (lane & 31)] * (gain ? gain[k0 + kk] : 1.0f); }
        }
        asm volatile("s_waitcnt lgkmcnt(0)" ::: "memory");
        const int c = lane & 7;
#pragma unroll
        for (int j = 0; j < 4; ++j) { const int n = (lane >> 3) + 8 * j; const float* sp = scr + (8 * c) * 33 + n;
            v4u o = (v4u){0u, 0u, 0u, 0u};
            if (col0 >= 0) { o.x = pk2(sp[0 * 33], sp[1 * 33]); o.y = pk2(sp[2 * 33], sp[3 * 33]); o.z = pk2(sp[4 * 33], sp[5 * 33]); o.w = pk2(sp[6 * 33], sp[7 * 33]); }
            *(v4u*)(Wt + (size_t)(n0 + n) * K + k0 + 8 * c) = o; }
        asm volatile("s_waitcnt lgkmcnt(0)" ::: "memory");
    }
}
__device__ __forceinline__ void cvt_up1(const Params& P, int l, unsigned char* ldsg) {
    STAGE_IDS
    unsigned char* ws = P.ws; float* scr = (float*)(ldsg + wave * 8448);
    cvt_wt(P.in[I_F1UP] + (size_t)l * DM * 2 * FF, DM, 2 * FF, (bf16*)(ws + ((l & 1) ? WS_WUP1B : WS_WUP1)), 2 * FF, 1, gw, ngw, lane, scr, P.in[I_F1N] + l * DM);
}
__device__ __forceinline__ void cvt_rest(const Params& P, int l, unsigned char* ldsg) {
    STAGE_IDS
    unsigned char* ws = P.ws; float* scr = (float*)(ldsg + wave * 8448);
    cvt_wt(P.in[I_F1DN] + (size_t)l * FF * DM, FF, DM, (bf16*)(ws + WS_WDN1), DM, 0, gw, ngw, lane, scr);
    cvt_wt(P.in[I_WIN] + (size_t)l * DM * 6528, DM, 6528, (bf16*)(ws + WS_WIN), 3584, 2, gw, ngw, lane, scr, P.in[I_MIXN] + l * DM);
    cvt_wt(P.in[I_WIN] + (size_t)l * DM * 6528, DM, 6528, (bf16*)(ws + WS_WG), 3072, 3, gw, ngw, lane, scr, P.in[I_MIXN] + l * DM);
    cvt_wt(P.in[I_WOA] + (size_t)l * 512 * DM, 512, DM, (bf16*)(ws + WS_WO), DM, 0, gw, ngw, lane, scr);
    cvt_wt(P.in[I_WOB] + (size_t)l * 512 * DM, 512, DM, (bf16*)(ws + WS_WO) + (size_t)DM * 512, DM, 0, gw, ngw, lane, scr);
    cvt_wt(P.in[I_WOC] + (size_t)l * 512 * DM, 512, DM, (bf16*)(ws + WS_WO) + (size_t)2 * DM * 512, DM, 0, gw, ngw, lane, scr);
    cvt_wt(P.in[I_WOUT] + (size_t)l * DM * DM, DM, DM, (bf16*)(ws + WS_WOUT), DM, 0, gw, ngw, lane, scr);
    cvt_wt(P.in[I_F2UP] + (size_t)l * DM * 2 * FF, DM, 2 * FF, (bf16*)(ws + WS_WUP2), 2 * FF, 1, gw, ngw, lane, scr, P.in[I_F2N] + l * DM);
    cvt_wt(P.in[I_F2DN] + (size_t)l * FF * DM, FF, DM, (bf16*)(ws + WS_WDN2), DM, 0, gw, ngw, lane, scr);
}
__device__ __forceinline__ void x_to_bf16_ss(const float* x, bf16* o, float* SS) {
    STAGE_IDS
    for (int m = gw; m < T_; m += ngw) {
        const f4* xr = (const f4*)(x + (size_t)m * DM) + lane; f4 v[4]; float s = 0.f;
#pragma unroll
        for (int j = 0; j < 4; ++j) { v[j] = xr[64 * j]; s += (v[j].x * v[j].x + v[j].y * v[j].y) + (v[j].z * v[j].z + v[j].w * v[j].w); }
        s = wave_sum(s);
        v2u* op = (v2u*)(o + (size_t)m * DM) + lane;
#pragma unroll
        for (int j = 0; j < 4; ++j) { v2u w; w.x = pk2(v[j].x, v[j].y); w.y = pk2(v[j].z, v[j].w); op[64 * j] = w; }
        if (lane < 16) SS[(size_t)m * 16 + lane] = lane == 0 ? s : 0.f;
    }
}

__device__ __forceinline__ void rms_rows_bf16(const float* x, const float* g, bf16* o) {
    STAGE_IDS
    const f4* gr = (const f4*)g + lane; f4 gv[4];
#pragma unroll
    for (int j = 0; j < 4; ++j) gv[j] = gr[64 * j];
    for (int m = gw; m < T_; m += ngw) {
        const f4* xr = (const f4*)(x + (size_t)m * DM) + lane; f4 v[4]; float s = 0.f;
#pragma unroll
        for (int j = 0; j < 4; ++j) { v[j] = xr[64 * j]; s += (v[j].x * v[j].x + v[j].y * v[j].y) + (v[j].z * v[j].z + v[j].w * v[j].w); }
        const float rs = 1.0f / sqrtf(wave_sum(s) * (1.0f / DM) + 1e-6f);
        v2u* op = (v2u*)(o + (size_t)m * DM) + lane;
#pragma unroll
        for (int j = 0; j < 4; ++j) { v2u w; w.x = pk2(v[j].x * rs * gv[j].x, v[j].y * rs * gv[j].y); w.y = pk2(v[j].z * rs * gv[j].z, v[j].w * rs * gv[j].w); op[64 * j] = w; }
    }
}
__device__ __forceinline__ void rms_rows_f32_inplace(float* x, const float* g) {
    STAGE_IDS
    const f4* gr = (const f4*)g + lane; f4 gv[4];
#pragma unroll
    for (int j = 0; j < 4; ++j) gv[j] = gr[64 * j];
    for (int m = gw; m < T_; m += ngw) {
        f4* xr = (f4*)(x + (size_t)m * DM) + lane; f4 v[4]; float s = 0.f;
#pragma unroll
        for (int j = 0; j < 4; ++j) { v[j] = xr[64 * j]; s += (v[j].x * v[j].x + v[j].y * v[j].y) + (v[j].z * v[j].z + v[j].w * v[j].w); }
        const float rs = 1.0f / sqrtf(wave_sum(s) * (1.0f / DM) + 1e-6f);
#pragma unroll
        for (int j = 0; j < 4; ++j) xr[64 * j] = v[j] * rs * gv[j];
    }
}

__device__ __forceinline__ float fast_sin_rev(float rev) { return __builtin_amdgcn_sinf(__builtin_amdgcn_fractf(rev)); }
__device__ __forceinline__ float fast_cos_rev(float rev) { return __builtin_amdgcn_cosf(__builtin_amdgcn_fractf(rev)); }
__device__ __forceinline__ void qkprep(const Params& P, int l) {
    STAGE_IDS
    unsigned char* ws = P.ws;
    bf16* QB = (bf16*)(ws + WS_QB); const bf16* KVB = (const bf16*)(ws + WS_KVB); bf16* QC = (bf16*)(ws + WS_QC); const bf16* KVC = (const bf16*)(ws + WS_KVC);
    bf16* KG = (bf16*)(ws + WS_KG); bf16* KW = (bf16*)(ws + WS_KW);
    const float qg = P.in[I_QN][l * 64 + lane], kg = P.in[I_KN][l * 64 + lane];
    const float inv_ax = exp2f(-(float)(lane & 15) * (LOG2_THETA / 16.0f)), inv_1d = exp2f(-(float)(lane & 31) * (LOG2_THETA / 32.0f));
    const float INV2PI = 0.15915494309189535f;
    for (int t = gw; t < T_; t += ngw) {
        const int b = t >> 11, s = t & 2047;
        const float pos = lane < 32 ? (float)(s >> 6) : (float)(s & 63);
        const float ra = (pos * inv_ax) * INV2PI, r1 = ((float)s * inv_1d) * INV2PI;
        const float csa = fast_cos_rev(ra), sna = (lane & 16) ? fast_sin_rev(ra) : -fast_sin_rev(ra);
        const float cs1 = fast_cos_rev(r1), sn1 = (lane & 32) ? fast_sin_rev(r1) : -fast_sin_rev(r1);
#pragma unroll
        for (int slot = 0; slot < 10; ++slot) {
            bf16* src = slot < 8 ? QB + (size_t)t * 512 + slot * 64 : (bf16*)KVB + (size_t)t * 256 + (slot - 8) * 64;
            const float x = bf2f(src[lane]);
            const float ss = wave_sum(x * x) * (1.0f / 64.0f);
            const float y = x * (1.0f / sqrtf(ss + 1e-6f)) * (slot < 8 ? qg : kg);
            const float r = y * csa + __shfl_xor(y, 16) * sna;
            if (slot < 8) src[lane] = (bf16)f2bf(r * C2);
            else KG[((size_t)(b * 2 + (slot - 8)) * S_ + s) * 64 + lane] = (bf16)f2bf(r);
        }
#pragma unroll
        for (int slot = 0; slot < 10; ++slot) {
            bf16* src = slot < 8 ? QC + (size_t)t * 512 + slot * 64 : (bf16*)KVC + (size_t)t * 256 + (slot - 8) * 64;
            const float x = bf2f(src[lane]);
            const float r = x * cs1 + __shfl_xor(x, 32) * sn1;
            if (slot < 8) src[lane] = (bf16)f2bf(r * C2);
            else KW[((size_t)(b * 2 + (slot - 8)) * S_ + s) * 64 + lane] = (bf16)f2bf(r);
        }
    }
}

__device__ __forceinline__ void vt_prep(const Params& P, unsigned char* ldsg) {
    STAGE_IDS
    unsigned char* ws = P.ws;
    bf16* tile = (bf16*)(ldsg + wave * 8448);
    for (int it = gw; it < 2 * NB * 2 * 32; it += ngw) {
        const int tb = it & 31, kvh = (it >> 5) & 1, b = (it >> 6) & 15, att = it >> 10;
        const bf16* src = (const bf16*)(ws + (att ? WS_KVC : WS_KVB)) + (size_t)(b * S_ + tb * 64) * 256 + 128 + kvh * 64;
        bf16* dst = (bf16*)(ws + (att ? WS_VW : WS_VG)) + (size_t)(b * 2 + kvh) * 64 * S_ + tb * 64;
#pragma unroll 8
        for (int r = 0; r < 64; ++r) tile[r * 66 + lane] = src[(size_t)r * 256 + lane];
        asm volatile("s_waitcnt lgkmcnt(0)" ::: "memory");
#pragma unroll 8
        for (int d = 0; d < 64; ++d) dst[(size_t)d * S_ + lane] = tile[lane * 66 + d];
        asm volatile("s_waitcnt lgkmcnt(0)" ::: "memory");
    }
}

typedef short bf16x8_t __attribute__((ext_vector_type(8)));
typedef short s16x4_t __attribute__((ext_vector_type(4)));
typedef float f32x16 __attribute__((ext_vector_type(16)));
typedef float f32x2a __attribute__((ext_vector_type(2))); typedef __bf16 bf16x2a __attribute__((ext_vector_type(2)));
__device__ __forceinline__ unsigned cvtpk(float lo, float hi) { f32x2a v = {lo, hi}; bf16x2a b = __builtin_convertvector(v, bf16x2a); return __builtin_bit_cast(unsigned, b); }
__device__ __forceinline__ int crow(int r, int hi) { return (r & 3) + 8 * (r >> 2) + 4 * hi; }
template <bool WINDOW>
__device__ __forceinline__ void attn_mfma(bf16* Q, const bf16* Kx, const bf16* VTx, const float* sink, unsigned char* ldsg) {
    STAGE_IDS
    const int r32 = lane & 31, hi = lane >> 5, g = wave >> 1, qs = wave & 1;
    const int srow = tid >> 3, sch = tid & 7;
    for (int unit = blockIdx.x; unit < 1024; unit += gridDim.x) {
        const int qb = unit & 31, kvh = (unit >> 5) & 1, b = unit >> 6, h = kvh * 4 + g, q0 = qb * 64 + qs * 32;
        bf16* qp = Q + ((size_t)(b * S_ + q0 + r32)) * 512 + h * 64;
        bf16x8_t qr[4];
#pragma unroll
        for (int d0 = 0; d0 < 4; ++d0) qr[d0] = *(const bf16x8_t*)(qp + 16 * d0 + 8 * hi);
        f32x16 o0, o1;
#pragma unroll
        for (int r = 0; r < 16; ++r) { o0[r] = 0.f; o1[r] = 0.f; }
        float m, l;
        if (WINDOW) { m = sink[h] * LOG2E; l = hi == 0 ? 1.0f : 0.f; } else { m = -1e30f; l = 0.f; }
        const int t0 = WINDOW ? (qb - 2 > 0 ? qb - 2 : 0) : 0, t1 = WINDOW ? (qb + 2 < 31 ? qb + 2 : 31) : 31;
        const bf16* kbase = Kx + (size_t)(b * 2 + kvh) * S_ * 64 + (size_t)srow * 64 + sch * 8;
        const bf16* vbase = VTx + (size_t)(b * 2 + kvh) * 64 * S_ + (size_t)srow * S_ + sch * 8;
        v4u kreg = *(const v4u*)(kbase + (size_t)t0 * 64 * 64);
        v4u vreg = *(const v4u*)(vbase + t0 * 64);
        __syncthreads();
        *(v4u*)(ldsg + srow * 144 + sch * 16) = kreg;
        *(v4u*)(ldsg + 9216 + srow * 144 + sch * 16) = vreg;
        __syncthreads();
        for (int t = t0; t <= t1; ++t) {
            const int buf = (t - t0) & 1;
            if (t < t1) { kreg = *(const v4u*)(kbase + (size_t)(t + 1) * 64 * 64); vreg = *(const v4u*)(vbase + (t + 1) * 64); }
            const unsigned char* Kb = ldsg + buf * 18432; const unsigned char* Vb = Kb + 9216;
            f32x16 p0, p1;
#pragma unroll
            for (int r = 0; r < 16; ++r) { p0[r] = 0.f; p1[r] = 0.f; }
#pragma unroll
            for (int d0 = 0; d0 < 4; ++d0) {
                const bf16x8_t a0 = *(const bf16x8_t*)(Kb + r32 * 144 + (16 * d0 + 8 * hi) * 2);
                const bf16x8_t a1 = *(const bf16x8_t*)(Kb + (32 + r32) * 144 + (16 * d0 + 8 * hi) * 2);
                p0 = __builtin_amdgcn_mfma_f32_32x32x16_bf16(a0, qr[d0], p0, 0, 0, 0);
                p1 = __builtin_amdgcn_mfma_f32_32x32x16_bf16(a1, qr[d0], p1, 0, 0, 0);
            }
            if (WINDOW) {
                const int qpos = q0 + r32;
#pragma unroll
                for (int r = 0; r < 16; ++r) { const int kv = t * 64 + crow(r, hi); int dlt = qpos - kv; dlt = dlt < 0 ? -dlt : dlt; if (dlt > 128) p0[r] = -1e30f;
                    int dl2 = qpos - (kv + 32); dl2 = dl2 < 0 ? -dl2 : dl2; if (dl2 > 128) p1[r] = -1e30f; }
            }
            float mt = fmaxf(p0[0], p1[0]);
#pragma unroll
            for (int r = 1; r < 16; ++r) mt = fmaxf(mt, fmaxf(p0[r], p1[r]));
            mt = fmaxf(mt, __shfl_xor(mt, 32));
            const float mn = fmaxf(m, mt), corr = __builtin_amdgcn_exp2f(m - mn); m = mn;
            float ps = 0.f;
#pragma unroll
            for (int r = 0; r < 16; ++r) { p0[r] = __builtin_amdgcn_exp2f(p0[r] - mn); p1[r] = __builtin_amdgcn_exp2f(p1[r] - mn); ps += p0[r] + p1[r]; }
            l = l * corr + ps;
#pragma unroll
            for (int r = 0; r < 16; ++r) { o0[r] *= corr; o1[r] *= corr; }
            v4u pw[4];
            pw[0] = (v4u){cvtpk(p0[0], p0[1]), cvtpk(p0[2], p0[3]), cvtpk(p0[4], p0[5]), cvtpk(p0[6], p0[7])};
            pw[1] = (v4u){cvtpk(p0[8], p0[9]), cvtpk(p0[10], p0[11]), cvtpk(p0[12], p0[13]), cvtpk(p0[14], p0[15])};
            pw[2] = (v4u){cvtpk(p1[0], p1[1]), cvtpk(p1[2], p1[3]), cvtpk(p1[4], p1[5]), cvtpk(p1[6], p1[7])};
            pw[3] = (v4u){cvtpk(p1[8], p1[9]), cvtpk(p1[10], p1[11]), cvtpk(p1[12], p1[13]), cvtpk(p1[14], p1[15])};
#pragma unroll
            for (int kb = 0; kb < 4; ++kb) {
                const bf16x8_t pb = __builtin_bit_cast(bf16x8_t, pw[kb]);
                { const unsigned char* vp = Vb + r32 * 144 + (16 * kb + 4 * hi) * 2; const s16x4_t lo = *(const s16x4_t*)vp, hh = *(const s16x4_t*)(vp + 16);
                  const bf16x8_t a = (bf16x8_t){lo[0], lo[1], lo[2], lo[3], hh[0], hh[1], hh[2], hh[3]};
                  o0 = __builtin_amdgcn_mfma_f32_32x32x16_bf16(a, pb, o0, 0, 0, 0); }
                { const unsigned char* vp = Vb + (32 + r32) * 144 + (16 * kb + 4 * hi) * 2; const s16x4_t lo = *(const s16x4_t*)vp, hh = *(const s16x4_t*)(vp + 16);
                  const bf16x8_t a = (bf16x8_t){lo[0], lo[1], lo[2], lo[3], hh[0], hh[1], hh[2], hh[3]};
                  o1 = __builtin_amdgcn_mfma_f32_32x32x16_bf16(a, pb, o1, 0, 0, 0); }
            }
            if (t < t1) { unsigned char* nb = ldsg + (buf ^ 1) * 18432; *(v4u*)(nb + srow * 144 + sch * 16) = kreg; *(v4u*)(nb + 9216 + srow * 144 + sch * 16) = vreg; }
            __syncthreads();
        }
        l += __shfl_xor(l, 32);
        const float inv = 1.0f / l;
#pragma unroll
        for (int g4 = 0; g4 < 4; ++g4) {
            v2u w0, w1;
            w0.x = cvtpk(o0[4 * g4 + 0] * inv, o0[4 * g4 + 1] * inv); w0.y = cvtpk(o0[4 * g4 + 2] * inv, o0[4 * g4 + 3] * inv);
            w1.x = cvtpk(o1[4 * g4 + 0] * inv, o1[4 * g4 + 1] * inv); w1.y = cvtpk(o1[4 * g4 + 2] * inv, o1[4 * g4 + 3] * inv);
            *(v2u*)(qp + 8 * g4 + 4 * hi) = w0;
            *(v2u*)(qp + 32 + 8 * g4 + 4 * hi) = w1;
        }
    }
}

__device__ __forceinline__ void attn_naive(bf16* Q, const bf16* Kx, const bf16* Vx, const float* sink, int window) {
    STAGE_IDS
    for (int it = gtid; it < T_ * 8; it += gthreads) {
        const int q = it & 2047, h = (it >> 11) & 7, b = it >> 14, kvh = h >> 2;
        bf16* qp = Q + ((size_t)(b * S_ + q)) * 512 + h * 64;
        float qf[64], o[64];
#pragma unroll
        for (int c = 0; c < 8; ++c) { const v4u w = ((const v4u*)qp)[c];
            qf[c * 8 + 0] = __uint_as_float(w.x << 16); qf[c * 8 + 1] = __uint_as_float(w.x & 0xffff0000u); qf[c * 8 + 2] = __uint_as_float(w.y << 16); qf[c * 8 + 3] = __uint_as_float(w.y & 0xffff0000u);
            qf[c * 8 + 4] = __uint_as_float(w.z << 16); qf[c * 8 + 5] = __uint_as_float(w.z & 0xffff0000u); qf[c * 8 + 6] = __uint_as_float(w.w << 16); qf[c * 8 + 7] = __uint_as_float(w.w & 0xffff0000u); }
#pragma unroll
        for (int d = 0; d < 64; ++d) o[d] = 0.f;
        float m, lsum;
        if (sink) { m = sink[h] * LOG2E; lsum = 1.0f; } else { m = -1e30f; lsum = 0.f; }
        const int k0 = window ? (q - 128 > 0 ? q - 128 : 0) : 0, k1 = window ? (q + 128 < S_ - 1 ? q + 128 : S_ - 1) : S_ - 1;
        const bf16* kp = Kx + (size_t)(b * 2 + kvh) * S_ * 64; const bf16* vp = Vx + (size_t)(b * 2 + kvh) * S_ * 64;
        for (int k = k0; k <= k1; ++k) {
            const v4u* kr = (const v4u*)(kp + (size_t)k * 64); float s = 0.f;
#pragma unroll
            for (int c = 0; c < 8; ++c) { const v4u w = kr[c];
                s += qf[c * 8 + 0] * __uint_as_float(w.x << 16) + qf[c * 8 + 1] * __uint_as_float(w.x & 0xffff0000u) + qf[c * 8 + 2] * __uint_as_float(w.y << 16) + qf[c * 8 + 3] * __uint_as_float(w.y & 0xffff0000u)
                   + qf[c * 8 + 4] * __uint_as_float(w.z << 16) + qf[c * 8 + 5] * __uint_as_float(w.z & 0xffff0000u) + qf[c * 8 + 6] * __uint_as_float(w.w << 16) + qf[c * 8 + 7] * __uint_as_float(w.w & 0xffff0000u); }
            const float mn = fmaxf(m, s), corr = exp2f(m - mn), p = exp2f(s - mn);
            lsum = lsum * corr + p; m = mn;
            const v4u* vr = (const v4u*)(vp + (size_t)k * 64);
#pragma unroll
            for (int c = 0; c < 8; ++c) { const v4u w = vr[c];
                o[c * 8 + 0] = o[c * 8 + 0] * corr + p * __uint_as_float(w.x << 16); o[c * 8 + 1] = o[c * 8 + 1] * corr + p * __uint_as_float(w.x & 0xffff0000u);
                o[c * 8 + 2] = o[c * 8 + 2] * corr + p * __uint_as_float(w.y << 16); o[c * 8 + 3] = o[c * 8 + 3] * corr + p * __uint_as_float(w.y & 0xffff0000u);
                o[c * 8 + 4] = o[c * 8 + 4] * corr + p * __uint_as_float(w.z << 16); o[c * 8 + 5] = o[c * 8 + 5] * corr + p * __uint_as_float(w.z & 0xffff0000u);
                o[c * 8 + 6] = o[c * 8 + 6] * corr + p * __uint_as_float(w.w << 16); o[c * 8 + 7] = o[c * 8 + 7] * corr + p * __uint_as_float(w.w & 0xffff0000u); }
        }
        const float inv = 1.0f / lsum;
#pragma unroll
        for (int c = 0; c < 8; ++c) { v4u w; w.x = pk2(o[c * 8 + 0] * inv, o[c * 8 + 1] * inv); w.y = pk2(o[c * 8 + 2] * inv, o[c * 8 + 3] * inv); w.z = pk2(o[c * 8 + 4] * inv, o[c * 8 + 5] * inv); w.w = pk2(o[c * 8 + 6] * inv, o[c * 8 + 7] * inv);
            ((v4u*)qp)[c] = w; }
    }
}


typedef float f8s __attribute__((ext_vector_type(8)));
typedef float f32x4m __attribute__((ext_vector_type(4)));
constexpr int SC_VEC = 0, SC_VS = 81920, SC_W2T = 98304, SC_A2T = 107520, SC_XCH = 116736, SC_YP = 120832, SC_A1 = SC_YP, SC_A2 = SC_YP + 9216, SC_AL = SC_YP + 18432, SC_END = SC_AL + 16640;
static_assert(SC_END <= LDS_BYTES, "scan LDS");
__device__ __forceinline__ void ld8bf(const bf16* p, float (&f)[8]) { const v4u w = *(const v4u*)p;
    f[0] = __uint_as_float(w.x << 16); f[1] = __uint_as_float(w.x & 0xffff0000u); f[2] = __uint_as_float(w.y << 16); f[3] = __uint_as_float(w.y & 0xffff0000u);
    f[4] = __uint_as_float(w.z << 16); f[5] = __uint_as_float(w.z & 0xffff0000u); f[6] = __uint_as_float(w.w << 16); f[7] = __uint_as_float(w.w & 0xffff0000u); }
__device__ __forceinline__ void shifted8(const bf16* pc, int col, bool hasp, bool hasn, const float* mu, float (&o)[8]) {
    float c[8], p[8], n[8];
    ld8bf(pc + col, c);
    if (hasp) ld8bf(pc + col - 2048, p); else { for (int e = 0; e < 8; ++e) p[e] = 0.f; }
    if (hasn) ld8bf(pc + col + 2048, n); else { for (int e = 0; e < 8; ++e) n[e] = 0.f; }
    const f4 m0 = *(const f4*)(mu + col), m1 = *(const f4*)(mu + col + 4);
    const float mm[8] = {m0.x, m0.y, m0.z, m0.w, m1.x, m1.y, m1.z, m1.w};
#pragma unroll
    for (int e = 0; e < 8; ++e) o[e] = c[e] + mm[e] * (0.5f * (p[e] + n[e]) - c[e]);
}
struct Raw3 { v4u c, p, n; };
__device__ __forceinline__ void raw_load(Raw3& r, const bf16* pc, int col, bool hasp, bool hasn) {
    r.c = *(const v4u*)(pc + col);
    r.p = hasp ? *(const v4u*)(pc + col - 2048) : (v4u){0u, 0u, 0u, 0u};
    r.n = hasn ? *(const v4u*)(pc + col + 2048) : (v4u){0u, 0u, 0u, 0u};
}
__device__ __forceinline__ void un8(const v4u w, float (&f)[8]) {
    f[0] = __uint_as_float(w.x << 16); f[1] = __uint_as_float(w.x & 0xffff0000u); f[2] = __uint_as_float(w.y << 16); f[3] = __uint_as_float(w.y & 0xffff0000u);
    f[4] = __uint_as_float(w.z << 16); f[5] = __uint_as_float(w.z & 0xffff0000u); f[6] = __uint_as_float(w.w << 16); f[7] = __uint_as_float(w.w & 0xffff0000u); }
__device__ __forceinline__ void shift_raw(const Raw3& r, const float* mu, int col, float (&o)[8]) {
    float c[8], p[8], n[8]; un8(r.c, c); un8(r.p, p); un8(r.n, n);
    const f4 m0 = *(const f4*)(mu + col), m1 = *(const f4*)(mu + col + 4);
    const float mm[8] = {m0.x, m0.y, m0.z, m0.w, m1.x, m1.y, m1.z, m1.w};
#pragma unroll
    for (int e = 0; e < 8; ++e) o[e] = c[e] + mm[e] * (0.5f * (p[e] + n[e]) - c[e]);
}
__device__ __forceinline__ void scan_fast(const Params& P, int l, unsigned char* ldsg) {
    STAGE_IDS
    unsigned char* ws = P.ws;
    const bf16* PR = (const bf16*)(ws + WS_PR); float* BONUS = (float*)(ws + WS_BONUS);
    float* VEC = (float*)(ldsg + SC_VEC);
    const int fr = lane & 15, fq = lane >> 4, ps = tid >> 3, pcg = tid & 7;
    float* XCH = (float*)(ldsg + SC_XCH); float* YP = (float*)(ldsg + SC_YP); float* VS = (float*)(ldsg + SC_VS); float* AL = (float*)(ldsg + SC_AL);
    for (int sid = blockIdx.x; sid < 256; sid += gridDim.x) {
        const int dir = sid & 1, h = (sid >> 1) & 7, b = sid >> 4, hc0 = h * 64;
        bf16* WKV = (bf16*)(ws + (dir ? WS_WKVB : WS_WKVF));
        const float* mu = P.in[I_MU] + (size_t)l * 1920;
        __syncthreads();
        {
            const float* w2b = P.in[I_W2] + (size_t)(l * 2 + dir) * 64 * 512 + (size_t)ps * 512 + hc0 + 8 * pcg;
            const float* a2b = P.in[I_A2] + (size_t)(l * 2 + dir) * 64 * 512 + (size_t)ps * 512 + hc0 + 8 * pcg;
#pragma unroll
            for (int e = 0; e < 8; ++e) { ((bf16*)(ldsg + SC_W2T))[(8 * pcg + e) * 72 + ps] = (bf16)f2bf(w2b[e]); ((bf16*)(ldsg + SC_A2T))[(8 * pcg + e) * 72 + ps] = (bf16)f2bf(a2b[e]); }
        }
        float S[8];
#pragma unroll
        for (int j = 0; j < 8; ++j) S[j] = 0.f;
        Raw3 pre[5];
#pragma unroll 1
        for (int ch = 0; ch < S_ / 64; ++ch) {
            const int step0 = ch * 64;
            const int tp = dir ? S_ - 1 - (step0 + ps) : step0 + ps;
            const int cR = hc0 + 8 * pcg, cK = 512 + hc0 + 8 * pcg, cV = 1024 + hc0 + 8 * pcg, cW = 1536 + 64 * dir + 8 * pcg, cA = 1664 + 64 * dir + 8 * pcg;
            if (ch == 0) { const bf16* pc = PR + ((size_t)(b * S_ + tp)) * 2048; const bool hasp = tp > 0, hasn = tp < S_ - 1;
                raw_load(pre[0], pc, cR, hasp, hasn); raw_load(pre[1], pc, cK, hasp, hasn); raw_load(pre[2], pc, cV, hasp, hasn); raw_load(pre[3], pc, cW, hasp, hasn); raw_load(pre[4], pc, cA, hasp, hasn); }
            float r8[8], k8[8], v8[8];
            shift_raw(pre[0], mu, cR, r8);
            shift_raw(pre[1], mu, cK, k8);
            shift_raw(pre[2], mu, cV, v8);
            { float wl[8], al[8];
              shift_raw(pre[3], mu, cW, wl);
              shift_raw(pre[4], mu, cA, al);
#pragma unroll
              for (int e = 0; e < 8; ++e) { const float t2 = __builtin_amdgcn_exp2f(2.0f * LOG2E * wl[e]); wl[e] = (t2 - 1.0f) * __builtin_amdgcn_rcpf(t2 + 1.0f); }
              v4u w1, w2v; w1.x = cvtpk(wl[0], wl[1]); w1.y = cvtpk(wl[2], wl[3]); w1.z = cvtpk(wl[4], wl[5]); w1.w = cvtpk(wl[6], wl[7]);
              w2v.x = cvtpk(al[0], al[1]); w2v.y = cvtpk(al[2], al[3]); w2v.z = cvtpk(al[4], al[5]); w2v.w = cvtpk(al[6], al[7]);
              *(v4u*)(ldsg + SC_A1 + ps * 144 + pcg * 16) = w1; *(v4u*)(ldsg + SC_A2 + ps * 144 + pcg * 16) = w2v; }
            *(f4*)(VS + ps * 64 + 8 * pcg) = (f4){v8[0], v8[1], v8[2], v8[3]}; *(f4*)(VS + ps * 64 + 8 * pcg + 4) = (f4){v8[4], v8[5], v8[6], v8[7]};
            __syncthreads();
            {
                const int wq = wave & 3; const bool isw = wave < 4;
                const unsigned char* Ab = ldsg + (isw ? SC_A1 : SC_A2) + (16 * wq + fr) * 144 + 16 * fq;
                const unsigned char* Bb = ldsg + (isw ? SC_W2T : SC_A2T) + fr * 144 + 16 * fq;
                const bf16x8_t a0 = *(const bf16x8_t*)Ab, a1 = *(const bf16x8_t*)(Ab + 64);
                const float* bias = P.in[isw ? I_W0 : I_A0] + (size_t)(l * 2 + dir) * 512 + hc0;
#pragma unroll
                for (int n = 0; n < 4; ++n) {
                    const bf16x8_t b0 = *(const bf16x8_t*)(Bb + n * 16 * 144), b1 = *(const bf16x8_t*)(Bb + n * 16 * 144 + 64);
                    f32x4m acc = (f32x4m){0.f, 0.f, 0.f, 0.f};
                    acc = __builtin_amdgcn_mfma_f32_16x16x32_bf16(a0, b0, acc, 0, 0, 0);
                    acc = __builtin_amdgcn_mfma_f32_16x16x32_bf16(a1, b1, acc, 0, 0, 0);
                    const float bz = bias[16 * n + fr];
#pragma unroll
                    for (int v = 0; v < 4; ++v) {
                        const int st = 16 * wq + 4 * fq + v; const float x = acc[v] + bz;
                        if (isw) { const float sp = __builtin_amdgcn_logf(1.0f + __builtin_amdgcn_exp2f(-x * LOG2E)) * 0.6931471805599453f;
                                   const float wlog = -sp - 0.5f; VEC[st * 320 + (2 * n + (fr >> 3)) * 40 + (fr & 7)] = __builtin_amdgcn_exp2f(-__builtin_amdgcn_exp2f(wlog * LOG2E) * LOG2E); }
                        else AL[st * 65 + 16 * n + fr] = __builtin_amdgcn_rcpf(1.0f + __builtin_amdgcn_exp2f(-x * LOG2E));
                    }
                }
            }
            __syncthreads();
            {
                const float* kkp = P.in[I_KK] + l * 512 + hc0 + 8 * pcg; const float* kap = P.in[I_KA] + l * 512 + hc0 + 8 * pcg; const float* rkp = P.in[I_RK] + l * 512 + hc0 + 8 * pcg;
                float a8[8], kk[8], kd[8]; float ss = 0.f, bon = 0.f;
#pragma unroll
                for (int e = 0; e < 8; ++e) { a8[e] = AL[ps * 65 + 8 * pcg + e]; kk[e] = k8[e] * kkp[e]; ss += kk[e] * kk[e]; kd[e] = k8[e] * (1.0f + (a8[e] - 1.0f) * kap[e]); bon += r8[e] * kd[e] * rkp[e]; }
                ss += __shfl_xor(ss, 1); ss += __shfl_xor(ss, 2); ss += __shfl_xor(ss, 4);
                bon += __shfl_xor(bon, 1); bon += __shfl_xor(bon, 2); bon += __shfl_xor(bon, 4);
                const float rn = 1.0f / fmaxf(sqrtf(ss), 1e-12f);
                float* sp = VEC + ps * 320 + 40 * pcg;
                *(f4*)(sp + 8) = (f4){kd[0], kd[1], kd[2], kd[3]}; *(f4*)(sp + 12) = (f4){kd[4], kd[5], kd[6], kd[7]};
                *(f4*)(sp + 16) = (f4){-kk[0] * rn, -kk[1] * rn, -kk[2] * rn, -kk[3] * rn}; *(f4*)(sp + 20) = (f4){-kk[4] * rn, -kk[5] * rn, -kk[6] * rn, -kk[7] * rn};
                *(f4*)(sp + 24) = (f4){kk[0] * rn * a8[0], kk[1] * rn * a8[1], kk[2] * rn * a8[2], kk[3] * rn * a8[3]}; *(f4*)(sp + 28) = (f4){kk[4] * rn * a8[4], kk[5] * rn * a8[5], kk[6] * rn * a8[6], kk[7] * rn * a8[7]};
                *(f4*)(sp + 32) = (f4){r8[0], r8[1], r8[2], r8[3]}; *(f4*)(sp + 36) = (f4){r8[4], r8[5], r8[6], r8[7]};
                if (pcg == 0) BONUS[((size_t)((dir * NB + b) * 8 + h)) * S_ + tp] = bon;
            }
            asm volatile("s_waitcnt vmcnt(0) lgkmcnt(0)" ::: "memory");
            __syncthreads();
#define DPP_FMAC(acc, xs, val, N) asm("v_fmac_f32_dpp %0, %1, %2 row_newbcast:" #N " row_mask:0xf bank_mask:0xf" : "+v"(acc) : "v"(xs), "v"(val))
#define DPP_MUL(dst, xs, val, N) asm("v_mul_f32_dpp %0, %1, %2 row_newbcast:" #N " row_mask:0xf bank_mask:0xf" : "=v"(dst) : "v"(xs), "v"(val))
            if (ch + 1 < S_ / 64) { const int tn = dir ? S_ - 1 - (step0 + 64 + ps) : step0 + 64 + ps; const bf16* pc = PR + ((size_t)(b * S_ + tn)) * 2048; const bool hasp = tn > 0, hasn = tn < S_ - 1;
                raw_load(pre[0], pc, cR, hasp, hasn); raw_load(pre[1], pc, cK, hasp, hasn); raw_load(pre[2], pc, cV, hasp, hasn); raw_load(pre[3], pc, cW, hasp, hasn); raw_load(pre[4], pc, cA, hasp, hasn); }
            const float* vecb = VEC + wave * 40 + (lane & 15);
            const int o2 = 32 + (lane & 7) - (lane & 15);
            float x0 = vecb[0], x1 = vecb[16], x2 = vecb[o2];
#pragma unroll 1
            for (int s = 0; s < 64; ++s) {
                const float* np_ = vecb + ((s + 1) & 63) * 320;
                const float n0 = np_[0], n1 = np_[16], n2 = np_[o2];
                const float v = VS[s * 64 + lane];
                asm volatile("s_nop 1" : "+v"(x0), "+v"(x1), "+v"(x2));
                float pa = 0.f, pb = 0.f;
                DPP_FMAC(pa, x1, S[0], 0); DPP_FMAC(pb, x1, S[1], 1); DPP_FMAC(pa, x1, S[2], 2); DPP_FMAC(pb, x1, S[3], 3);
                DPP_FMAC(pa, x1, S[4], 4); DPP_FMAC(pb, x1, S[5], 5); DPP_FMAC(pa, x1, S[6], 6); DPP_FMAC(pb, x1, S[7], 7);
                XCH[(s & 1) * 512 + wave * 64 + lane] = pa + pb;
                float Tt[8];
                DPP_MUL(Tt[0], x0, S[0], 0); DPP_MUL(Tt[1], x0, S[1], 1); DPP_MUL(Tt[2], x0, S[2], 2); DPP_MUL(Tt[3], x0, S[3], 3);
                DPP_MUL(Tt[4], x0, S[4], 4); DPP_MUL(Tt[5], x0, S[5], 5); DPP_MUL(Tt[6], x0, S[6], 6); DPP_MUL(Tt[7], x0, S[7], 7);
                DPP_FMAC(Tt[0], x0, v, 8); DPP_FMAC(Tt[1], x0, v, 9); DPP_FMAC(Tt[2], x0, v, 10); DPP_FMAC(Tt[3], x0, v, 11);
                DPP_FMAC(Tt[4], x0, v, 12); DPP_FMAC(Tt[5], x0, v, 13); DPP_FMAC(Tt[6], x0, v, 14); DPP_FMAC(Tt[7], x0, v, 15);
                asm volatile("s_waitcnt lgkmcnt(0)\n\ts_barrier" ::: "memory");
                const float* xp = XCH + (s & 1) * 512 + lane;
                const float sa = ((xp[0] + xp[64]) + (xp[128] + xp[192])) + ((xp[256] + xp[320]) + (xp[384] + xp[448]));
                DPP_FMAC(Tt[0], x1, sa, 8); DPP_FMAC(Tt[1], x1, sa, 9); DPP_FMAC(Tt[2], x1, sa, 10); DPP_FMAC(Tt[3], x1, sa, 11);
                DPP_FMAC(Tt[4], x1, sa, 12); DPP_FMAC(Tt[5], x1, sa, 13); DPP_FMAC(Tt[6], x1, sa, 14); DPP_FMAC(Tt[7], x1, sa, 15);
#pragma unroll
                for (int j = 0; j < 8; ++j) S[j] = Tt[j];
                float ya = 0.f, yb = 0.f;
                DPP_FMAC(ya, x2, S[0], 0); DPP_FMAC(yb, x2, S[1], 1); DPP_FMAC(ya, x2, S[2], 2); DPP_FMAC(yb, x2, S[3], 3);
                DPP_FMAC(ya, x2, S[4], 4); DPP_FMAC(yb, x2, S[5], 5); DPP_FMAC(ya, x2, S[6], 6); DPP_FMAC(yb, x2, S[7], 7);
                YP[(s & 15) * 512 + wave * 64 + lane] = ya + yb;
                x0 = n0; x1 = n1; x2 = n2;
                if ((s & 7) == 7) {
                    asm volatile("s_waitcnt lgkmcnt(0)\n\ts_barrier" ::: "memory");
                    const int sl = (s - 7) + wave;
                    const float* yp = YP + (sl & 15) * 512 + lane;
                    const float y0 = ((yp[0] + yp[64]) + (yp[128] + yp[192])) + ((yp[256] + yp[320]) + (yp[384] + yp[448]));
                    const int tt = dir ? S_ - 1 - (step0 + sl) : step0 + sl;
                    WKV[((size_t)(b * S_ + tt)) * 512 + hc0 + lane] = (bf16)f2bf(y0);
                }
            }
#undef DPP_FMAC
#undef DPP_MUL
            __syncthreads();
        }
    }
}

struct ScanRaw { float c[5], p[5], n[5]; };
__device__ __forceinline__ void scan_load(ScanRaw& R, const bf16* PR, int b, int t, const int (&cols)[5]) {
    const bf16* pc = PR + ((size_t)(b * S_ + t)) * 2048;
#pragma unroll
    for (int i = 0; i < 5; ++i) { R.c[i] = bf2f(pc[cols[i]]); R.p[i] = t > 0 ? bf2f(pc[cols[i] - 2048]) : 0.f; R.n[i] = t < S_ - 1 ? bf2f(pc[cols[i] + 2048]) : 0.f; }
}
__device__ __forceinline__ void scan_naive(const Params& P, int l, unsigned char* ldsg) {
    STAGE_IDS
    if (wave != 0) return;
    unsigned char* ws = P.ws;
    const bf16* PR = (const bf16*)(ws + WS_PR); float* BONUS = (float*)(ws + WS_BONUS);
    float* sW2 = (float*)ldsg; float* sA2 = sW2 + 4096; float* sh = sA2 + 4096; float* sv = sh + 128;
    for (int sid = blockIdx.x; sid < 256; sid += gridDim.x) {
        const int dir = sid & 1, h = (sid >> 1) & 7, b = sid >> 4, hc = h * 64 + lane;
        bf16* WKV = (bf16*)(ws + (dir ? WS_WKVB : WS_WKVF));
        const float* w2b = P.in[I_W2] + (size_t)(l * 2 + dir) * 64 * 512; const float* a2b = P.in[I_A2] + (size_t)(l * 2 + dir) * 64 * 512;
        for (int m = 0; m < 64; ++m) { sW2[m * 64 + lane] = w2b[m * 512 + hc]; sA2[m * 64 + lane] = a2b[m * 512 + hc]; }
        const float* mu = P.in[I_MU] + (size_t)l * 1920;
        const int cols[5] = {hc, 512 + hc, 1024 + hc, 1536 + 64 * dir + lane, 1664 + 64 * dir + lane};
        float mus[5];
#pragma unroll
        for (int i = 0; i < 5; ++i) mus[i] = mu[cols[i]];
        const float w0c = P.in[I_W0][(size_t)(l * 2 + dir) * 512 + hc], a0c = P.in[I_A0][(size_t)(l * 2 + dir) * 512 + hc];
        const float kkc = P.in[I_KK][l * 512 + hc], kac = P.in[I_KA][l * 512 + hc], rkc = P.in[I_RK][l * 512 + hc];
        float S[64];
#pragma unroll
        for (int j = 0; j < 64; ++j) S[j] = 0.f;
        ScanRaw cur, nxt;
        scan_load(cur, PR, b, dir ? S_ - 1 : 0, cols);
        for (int step = 0; step < S_; ++step) {
            const int t = dir ? S_ - 1 - step : step;
            if (step + 1 < S_) scan_load(nxt, PR, b, dir ? t - 1 : t + 1, cols); else nxt = cur;
            float sx[5];
#pragma unroll
            for (int i = 0; i < 5; ++i) sx[i] = cur.c[i] + mus[i] * (0.5f * (cur.p[i] + cur.n[i]) - cur.c[i]);
            const float r = sx[0], k = sx[1], v = sx[2];
            sh[lane] = tanhf(sx[3]); sh[64 + lane] = sx[4];
            float wlin = w0c, alin = a0c;
#pragma unroll 8
            for (int m = 0; m < 64; ++m) { wlin += sh[m] * sW2[m * 64 + lane]; alin += sh[64 + m] * sA2[m * 64 + lane]; }
            const float wlog = -log1pf(expf(-wlin)) - 0.5f;
            const float decay = expf(-expf(wlog));
            const float a = 1.0f / (1.0f + expf(-alin));
            float kkv = k * kkc; const float nrm = sqrtf(wave_sum(kkv * kkv)); kkv = kkv / fmaxf(nrm, 1e-12f);
            const float kd = k * (1.0f + (a - 1.0f) * kac);
            const float bon = wave_sum(r * kd * rkc);
            if (lane == 0) BONUS[((size_t)((dir * NB + b) * 8 + h)) * S_ + t] = bon;
            sv[lane] = decay; sv[64 + lane] = kd; sv[128 + lane] = -kkv; sv[192 + lane] = kkv * a; sv[256 + lane] = r;
            float sa = 0.f;
#pragma unroll
            for (int j = 0; j < 64; ++j) sa += S[j] * sv[128 + j];
            float y = 0.f;
#pragma unroll
            for (int j = 0; j < 64; ++j) { S[j] = S[j] * sv[j] + sa * sv[192 + j] + v * sv[64 + j]; y += S[j] * sv[256 + j]; }
            WKV[((size_t)(b * S_ + t)) * 512 + hc] = (bf16)f2bf(y);
            cur = nxt;
        }
    }
}


__device__ __forceinline__ void finalize_fast(const Params& P, int l, unsigned char* ldsg) {
    STAGE_IDS
    unsigned char* ws = P.ws;
    const bf16* PR = (const bf16*)(ws + WS_PR); const bf16* WF = (const bf16*)(ws + WS_WKVF); const bf16* WBk = (const bf16*)(ws + WS_WKVB); const float* BONUS = (const float*)(ws + WS_BONUS);
    bf16* YA = (bf16*)(ws + WS_YA);
    const int fr = lane & 15, fq = lane >> 4;
    const float* mu = P.in[I_MU] + (size_t)l * 1920; const float* g2 = P.in[I_G2] + (size_t)l * 128 * 512;
    const float* lngp = P.in[I_LNG] + l * 512; const float* lnbp = P.in[I_LNB] + l * 512;
    bf16x8_t gf[4][4];
#pragma unroll
    for (int n = 0; n < 4; ++n)
#pragma unroll
        for (int ks = 0; ks < 4; ++ks) { float gv[8];
#pragma unroll
            for (int e = 0; e < 8; ++e) gv[e] = g2[(size_t)(32 * ks + 8 * fq + e) * 512 + 64 * wave + 16 * n + fr];
            const v4u w = (v4u){cvtpk(gv[0], gv[1]), cvtpk(gv[2], gv[3]), cvtpk(gv[4], gv[5]), cvtpk(gv[6], gv[7])};
            gf[n][ks] = __builtin_bit_cast(bf16x8_t, w); }
    for (int tile = blockIdx.x; tile < T_ / 32; tile += gridDim.x) {
        const int t0 = tile * 32;
        __syncthreads();
        { const int tok = tid >> 4, mg = tid & 15, t = t0 + tok, s = t & 2047; float x[8];
          shifted8(PR + (size_t)t * 2048, 1792 + 8 * mg, s > 0, s < S_ - 1, mu, x);
#pragma unroll
          for (int e = 0; e < 8; ++e) x[e] = __builtin_amdgcn_rcpf(1.0f + __builtin_amdgcn_exp2f(-x[e] * LOG2E));
          *(v4u*)(ldsg + tok * 272 + mg * 16) = (v4u){cvtpk(x[0], x[1]), cvtpk(x[2], x[3]), cvtpk(x[4], x[5]), cvtpk(x[6], x[7])}; }
        __syncthreads();
#pragma unroll
        for (int mt = 0; mt < 2; ++mt) {
            f32x4m acc[4];
#pragma unroll
            for (int n = 0; n < 4; ++n) acc[n] = (f32x4m){0.f, 0.f, 0.f, 0.f};
#pragma unroll
            for (int ks = 0; ks < 4; ++ks) { const bf16x8_t bb = *(const bf16x8_t*)(ldsg + (16 * mt + fr) * 272 + (32 * ks + 8 * fq) * 2);
#pragma unroll
                for (int n = 0; n < 4; ++n) acc[n] = __builtin_amdgcn_mfma_f32_16x16x32_bf16(gf[n][ks], bb, acc[n], 0, 0, 0); }
            const int t = t0 + 16 * mt + fr, s = t & 2047, bb_ = t >> 11;
            float wk[4][4]; float sm = 0.f;
#pragma unroll
            for (int n = 0; n < 4; ++n) { const int c0 = 64 * wave + 16 * n + 4 * fq;
                const v2u a = *(const v2u*)(WF + (size_t)t * 512 + c0), b2 = *(const v2u*)(WBk + (size_t)t * 512 + c0);
                wk[n][0] = __uint_as_float(a.x << 16) + __uint_as_float(b2.x << 16); wk[n][1] = __uint_as_float(a.x & 0xffff0000u) + __uint_as_float(b2.x & 0xffff0000u);
                wk[n][2] = __uint_as_float(a.y << 16) + __uint_as_float(b2.y << 16); wk[n][3] = __uint_as_float(a.y & 0xffff0000u) + __uint_as_float(b2.y & 0xffff0000u);
                sm += (wk[n][0] + wk[n][1]) + (wk[n][2] + wk[n][3]); }
            sm += __shfl_xor(sm, 16); sm += __shfl_xor(sm, 32);
            const float mean = sm * (1.0f / 64.0f); float sq = 0.f;
#pragma unroll
            for (int n = 0; n < 4; ++n)
#pragma unroll
                for (int v = 0; v < 4; ++v) { wk[n][v] -= mean; sq += wk[n][v] * wk[n][v]; }
            sq += __shfl_xor(sq, 16); sq += __shfl_xor(sq, 32);
            const float rstd = 1.0f / sqrtf(sq * (1.0f / 64.0f) + 64e-5f);
            const float bon = BONUS[((size_t)(bb_ * 8 + wave)) * S_ + s] + BONUS[((size_t)((NB + bb_) * 8 + wave)) * S_ + s];
            const bf16* pc = PR + (size_t)t * 2048;
#pragma unroll
            for (int n = 0; n < 4; ++n) { const int c0 = 64 * wave + 16 * n + 4 * fq;
                const f4 lg = *(const f4*)(lngp + c0), lb = *(const f4*)(lnbp + c0), mv = *(const f4*)(mu + 1024 + c0);
                const v2u vc = *(const v2u*)(pc + 1024 + c0);
                v2u vp = (v2u){0u, 0u}, vn = (v2u){0u, 0u};
                if (s > 0) vp = *(const v2u*)(pc + 1024 + c0 - 2048);
                if (s < S_ - 1) vn = *(const v2u*)(pc + 1024 + c0 + 2048);
                const float cc[4] = {__uint_as_float(vc.x << 16), __uint_as_float(vc.x & 0xffff0000u), __uint_as_float(vc.y << 16), __uint_as_float(vc.y & 0xffff0000u)};
                const float pp[4] = {__uint_as_float(vp.x << 16), __uint_as_float(vp.x & 0xffff0000u), __uint_as_float(vp.y << 16), __uint_as_float(vp.y & 0xffff0000u)};
                const float nn[4] = {__uint_as_float(vn.x << 16), __uint_as_float(vn.x & 0xffff0000u), __uint_as_float(vn.y << 16), __uint_as_float(vn.y & 0xffff0000u)};
                float yv[4];
#pragma unroll
                for (int v = 0; v < 4; ++v) { const float vs = cc[v] + mv[v] * (0.5f * (pp[v] + nn[v]) - cc[v]);
                    yv[v] = (wk[n][v] * rstd * lg[v] + lb[v] + bon * vs) * acc[n][v]; }
                *(v2u*)(YA + (size_t)t * 512 + c0) = (v2u){cvtpk(yv[0], yv[1]), cvtpk(yv[2], yv[3])}; }
        }
    }
}

__device__ __forceinline__ void finalize_naive(const Params& P, int l, unsigned char* ldsg) {
    STAGE_IDS
    unsigned char* ws = P.ws;
    const bf16* PR = (const bf16*)(ws + WS_PR); const bf16* WF = (const bf16*)(ws + WS_WKVF); const bf16* WBk = (const bf16*)(ws + WS_WKVB); const float* BONUS = (const float*)(ws + WS_BONUS);
    bf16* YA = (bf16*)(ws + WS_YA);
    float* sg = (float*)ldsg;
    const float* mu = P.in[I_MU] + (size_t)l * 1920; const float* g2 = P.in[I_G2] + (size_t)l * 128 * 512;
    const float lng = P.in[I_LNG][l * 512 + tid], lnb = P.in[I_LNB][l * 512 + tid];
    const float mu_v = mu[1024 + tid], mu_g = tid < 128 ? mu[1792 + tid] : 0.f;
    for (int t = blockIdx.x; t < T_; t += gridDim.x) {
        const int s = t & 2047; const bf16* pc = PR + (size_t)t * 2048;
        if (tid < 128) { const int col = 1792 + tid; const float c = bf2f(pc[col]), p = s > 0 ? bf2f(pc[col - 2048]) : 0.f, n = s < S_ - 1 ? bf2f(pc[col + 2048]) : 0.f;
            const float x = c + mu_g * (0.5f * (p + n) - c); sg[tid] = 1.0f / (1.0f + expf(-x)); }
        __syncthreads();
        float gate = 0.f;
#pragma unroll 8
        for (int m = 0; m < 128; ++m) gate += sg[m] * g2[m * 512 + tid];
        const float wkv = bf2f(WF[(size_t)t * 512 + tid]) + bf2f(WBk[(size_t)t * 512 + tid]);
        const float mean = wave_sum(wkv) * (1.0f / 64.0f); const float dv = wkv - mean; const float var = wave_sum(dv * dv) * (1.0f / 64.0f);
        float y = dv * (1.0f / sqrtf(var + 64e-5f)) * lng + lnb;
        { const int col = 1024 + tid; const float c = bf2f(pc[col]), p = s > 0 ? bf2f(pc[col - 2048]) : 0.f, n = s < S_ - 1 ? bf2f(pc[col + 2048]) : 0.f;
          const float vs = c + mu_v * (0.5f * (p + n) - c); const int h = tid >> 6;
          const int b = t >> 11; y += (BONUS[((size_t)(b * 8 + h)) * S_ + s] + BONUS[((size_t)((NB + b) * 8 + h)) * S_ + s]) * vs; }
        YA[(size_t)t * 512 + tid] = (bf16)f2bf(y * gate);
        __syncthreads();
    }
}

#ifndef DBG_NL
#define DBG_NL NL
#endif
#ifndef DBG_BR
#define DBG_BR 7
#endif
#ifndef DBG_STOP
#define DBG_STOP 0
#endif
#define L1_INVALIDATE() do { asm volatile("s_waitcnt vmcnt(0)" ::: "memory"); __builtin_amdgcn_fence(__ATOMIC_ACQUIRE, "agent"); asm volatile("s_waitcnt vmcnt(0)" ::: "memory"); } while (0)
#define GRID_SYNC() do { asm volatile("s_waitcnt vmcnt(0) lgkmcnt(0)" ::: "memory"); grid.sync(); __builtin_amdgcn_fence(__ATOMIC_ACQUIRE, "agent"); asm volatile("s_waitcnt vmcnt(0)" ::: "memory"); } while (0)
#define GEMM_PHASE(EPI, A_, Bt_, M_, N_, K_, E_) do { pg8::Gemm g_{(const pg8::bf16_t*)(A_), (const pg8::bf16_t*)(Bt_), (M_), (N_), (K_)}; pg8::StaticOrder S_o; S_o.init((M_), (N_), (int)gridDim.x, (int)blockIdx.x); \
    pg8::gemm_phase<EPI, pg8::StaticOrder, true, true>((PG8_LAS unsigned char*)lds, g_, S_o, (E_)); } while (0)

#ifdef TPROBE
#define TP_DECL unsigned long long tp_acc[4] = {0, 0, 0, 0}, tp_t0 = 0;
#define TP_BEGIN() do { tp_t0 = __builtin_amdgcn_s_memrealtime(); } while (0)
#define TP_END(k) do { tp_acc[k] += __builtin_amdgcn_s_memrealtime() - tp_t0; } while (0)
#else
#define TP_DECL
#define TP_BEGIN() do {} while (0)
#define TP_END(k) do {} while (0)
#endif
__global__ void __launch_bounds__(NTHREADS, 2) fwd_kernel(Params P) {
    extern __shared__ __attribute__((aligned(16))) unsigned char lds[];
    cg::grid_group grid = cg::this_grid();
    unsigned char* ws = P.ws;
    bf16* H = (bf16*)(ws + WS_H); bf16* ACT = (bf16*)(ws + WS_ACT);
    TP_DECL
#ifdef DBG_HA
    bf16* HA = (bf16*)(ws + WS_QC);
#else
    bf16* HA = H;
#endif
    float* SSB = (float*)(ws + WS_SS);
    cvt_up1(P, 0, lds);
    x_to_bf16_ss(P.in[I_X], H, SSB);
    GRID_SYNC();
#pragma unroll 1
    for (int l = 0; l < DBG_NL; ++l) {
        const float* xin = (l == 0) ? P.in[I_X] : P.out;
        cvt_rest(P, l, lds);
        __syncthreads();
        { pg8::EpiSwiglu E{(pg8::bf16_t*)ACT, FF, SSB}; GEMM_PHASE(pg8::EpiSwiglu, H, ws + ((l & 1) ? WS_WUP1B : WS_WUP1), T_, 2 * FF, DM, E); }
        GRID_SYNC();
        { pg8::EpiResid E{xin, P.out, DM, 0.5f, (pg8::bf16_t*)H, SSB}; GEMM_PHASE(pg8::EpiResid, ACT, ws + WS_WDN1, T_, DM, FF, E); }
        GRID_SYNC();
        { pg8::EpiWin E{(pg8::bf16_t*)(ws + WS_PR), (pg8::bf16_t*)(ws + WS_QB), (pg8::bf16_t*)(ws + WS_KVB), (pg8::bf16_t*)(ws + WS_QC), (pg8::bf16_t*)(ws + WS_KVC), SSB};
          GEMM_PHASE(pg8::EpiWin, H, ws + WS_WIN, T_, 3584, DM, E); }
        GRID_SYNC();
        qkprep(P, l);
        vt_prep(P, lds);
        __syncthreads();
        scan_fast(P, l, lds);
#ifdef DUP_SCAN
        __syncthreads();
        scan_fast(P, l, lds);
#endif
#ifdef DUP_PREP
        __syncthreads();
        vt_prep(P, lds);
#endif
        GRID_SYNC();
        attn_mfma<false>((bf16*)(ws + WS_QB), (const bf16*)(ws + WS_KG), (const bf16*)(ws + WS_VG), nullptr, lds);
        attn_mfma<true>((bf16*)(ws + WS_QC), (const bf16*)(ws + WS_KW), (const bf16*)(ws + WS_VW), P.in[I_SINK] + l * 8, lds);
        __syncthreads();
        finalize_fast(P, l, lds);
#ifdef DUP_FIN
        finalize_fast(P, l, lds);
#endif
        GRID_SYNC();
#pragma unroll 1
        for (int i = 0; i < 3; ++i) {
            { pg8::EpiGate E{(pg8::bf16_t*)(ws + WS_GATE), SSB}; GEMM_PHASE(pg8::EpiGate, H, ws + WS_WG + (size_t)i * DM * DM * 2, T_, DM, DM, E); }
            L1_INVALIDATE();
            const unsigned char* yi = ws + (i == 0 ? WS_YA : (i == 1 ? WS_QB : WS_QC));
            { pg8::EpiMerge E{(const pg8::bf16_t*)(ws + WS_GATE), (pg8::bf16_t*)(ws + WS_MERGED), i == 0 ? 1 : 0}; GEMM_PHASE(pg8::EpiMerge, yi, ws + WS_WO + (size_t)i * DM * 512 * 2, T_, DM, 512, E); }
            if (i < 2) L1_INVALIDATE();
        }
        GRID_SYNC();
        { pg8::EpiResid E{P.out, P.out, DM, 1.0f, (pg8::bf16_t*)H, SSB}; GEMM_PHASE(pg8::EpiResid, ws + WS_MERGED, ws + WS_WOUT, T_, DM, DM, E); }
        GRID_SYNC();
        { pg8::EpiSwiglu E{(pg8::bf16_t*)ACT, FF, SSB}; GEMM_PHASE(pg8::EpiSwiglu, H, ws + WS_WUP2, T_, 2 * FF, DM, E); }
#ifdef DUP_UP
        { pg8::EpiSwiglu E{(pg8::bf16_t*)ACT, FF, SSB}; GEMM_PHASE(pg8::EpiSwiglu, H, ws + WS_WUP2, T_, 2 * FF, DM, E); }
#endif
        GRID_SYNC();
        if (l + 1 < NL) { cvt_up1(P, l + 1, lds); __syncthreads(); }
        { pg8::EpiResid E{P.out, P.out, DM, 0.5f, (pg8::bf16_t*)H, SSB}; GEMM_PHASE(pg8::EpiResid, ACT, ws + WS_WDN2, T_, DM, FF, E); }
        GRID_SYNC();
    }
    rms_rows_f32_inplace(P.out, P.in[I_FINN]);
#ifdef TPROBE
    {
        float* tpw = (float*)(ws + WS_SCR);
        GRID_SYNC();
        if (blockIdx.x == 0 && threadIdx.x == 0) { tpw[0] = (float)tp_acc[TPROBE_A] * 0.01f; tpw[1] = (float)tp_acc[TPROBE_B] * 0.01f; }
        GRID_SYNC();
        const float ta = tpw[0], tb = tpw[1];
        const int gt = blockIdx.x * NTHREADS + threadIdx.x;
        for (int i = gt; i < (1 << 20); i += gridDim.x * NTHREADS) P.out[i] = tb * 0.01f;
        if (gt == 0) P.out[1 << 21] = ta * 0.1f;
    }
#endif
}

extern "C" void kernel_launch(void* const* d_in, const int* in_sizes, int n_in, void* d_out, int out_size, void* d_ws, size_t ws_size, hipStream_t stream) {
    static int grid_blocks = 0;
    if (grid_blocks == 0) {
        if (n_in != N_IN || out_size != T_ * DM || ws_size < WS_END) { fprintf(stderr, "kernel_launch: unexpected shapes (n_in %d, out %d, ws %zu < %zu)\n", n_in, out_size, ws_size, (size_t)WS_END); grid_blocks = -1; return; }
        int dev = 0, cus = 0, per_cu = 0;
        hipGetDevice(&dev);
        hipDeviceGetAttribute(&cus, hipDeviceAttributeMultiprocessorCount, dev);
        hipFuncSetAttribute((const void*)fwd_kernel, hipFuncAttributeMaxDynamicSharedMemorySize, LDS_BYTES);
        hipOccupancyMaxActiveBlocksPerMultiprocessor(&per_cu, (const void*)fwd_kernel, NTHREADS, LDS_BYTES);
        if (per_cu < 1) per_cu = 1;
        grid_blocks = cus * per_cu;
    }
    if (grid_blocks < 0) return;
    Params p{};
    for (int i = 0; i < N_IN; ++i) p.in[i] = (const float*)d_in[i];
    p.out = (float*)d_out; p.ws = (unsigned char*)d_ws;
    void* args[] = {&p};
    hipError_t e = hipLaunchCooperativeKernel((const void*)fwd_kernel, dim3(grid_blocks), dim3(NTHREADS), args, LDS_BYTES, stream);
    if (e != hipSuccess) fprintf(stderr, "cooperative launch failed: %s (grid %d)\n", hipGetErrorString(e), grid_blocks);
}
```

```cpp
#include <hip/hip_runtime.h>
#include <hip/hip_cooperative_groups.h>
#include <cstdio>
#include <cstdint>
namespace cg = cooperative_groups;
namespace pg8 {
#define PG8_LAS __attribute__((address_space(3)))
typedef unsigned short bf16_t;
typedef short bf16x8 __attribute__((ext_vector_type(8)));
typedef float f32x4 __attribute__((ext_vector_type(4)));
typedef unsigned u32x4 __attribute__((ext_vector_type(4)));
constexpr int BM = 256, BK = 64, HALF = 128, HTB = HALF * BK * 2  , STAGE_BYTES = 8 * HTB, NXCD = 8, WGM = 8;

__host__ __device__ __forceinline__ int lds_byte(int r, int c) { const int st = (r >> 4) * 2 + (c >> 5), rr = r & 15, cc = c & 31, ob = rr * 64 + cc * 2; return st * 1024 + (ob ^ (((ob >> 9) & 1) << 5)); }
__host__ __device__ __forceinline__ void stage_rc(int b, int& R, int& C) { const int st = b / 1024, sb = b % 1024, swz = sb ^ (((sb >> 9) & 1) << 5); R = (st >> 1) * 16 + swz / 64; C = (st & 1) * 32 + (swz % 64) / 2; }
__host__ __device__ __forceinline__ int perm32(int rho) { const int n = rho >> 4, i = rho & 15; return 8 * (i >> 2) + 4 * n + (i & 3); }

struct Unit { int pm, pn; };
struct Gemm { const bf16_t* A; const bf16_t* Bt; int M, N, K; };

struct StaticOrder {
    int nM, nN, nwg, G, c;
    __host__ __device__ void init(int M, int N, int G_, int c_) { nM = M / BM; nN = N / BM; nwg = nM * nN; G = G_; c = c_; }
    __host__ __device__ bool next(int i, Unit& u) const {
        const long L = (long)i * G + c; if (L >= nwg) return false;
        int wgid = (int)L; { const int q = nwg / NXCD, r = nwg % NXCD, xcd = wgid % NXCD, off = wgid / NXCD; wgid = (xcd < r ? xcd * (q + 1) : r * (q + 1) + (xcd - r) * q) + off; }
        const int nig = WGM * nN, gid = wgid / nig, fm = gid * WGM, gsz = (nM - fm) < WGM ? (nM - fm) : WGM;
        u.pm = fm + ((wgid % nig) % gsz); u.pn = (wgid % nig) / gsz; return true;
    }
    __device__ __forceinline__ void a_ready(const Unit&) const {}
    __device__ __forceinline__ void done(const Unit&) const {}
};
typedef float f32x2_t __attribute__((ext_vector_type(2))); typedef __bf16 bf16x2_t __attribute__((ext_vector_type(2)));
__device__ __forceinline__ unsigned cvt_pk_bf16(float lo, float hi) { f32x2_t v = {lo, hi}; bf16x2_t b = __builtin_convertvector(v, bf16x2_t); return __builtin_bit_cast(unsigned, b); }
typedef float f32x2 __attribute__((ext_vector_type(2)));
__device__ __forceinline__ float fast_sigmoid(float x) { return __builtin_amdgcn_rcpf(1.0f + __builtin_amdgcn_exp2f(-1.4426950408889634f * x)); }
__device__ __forceinline__ u32x4 ld16_agent(const bf16_t* p) { const unsigned long long a = __hip_atomic_load((const unsigned long long*)p, __ATOMIC_RELAXED, __HIP_MEMORY_SCOPE_AGENT), b = __hip_atomic_load((const unsigned long long*)p + 1, __ATOMIC_RELAXED, __HIP_MEMORY_SCOPE_AGENT); u32x4 r; r.x = (unsigned)a; r.y = (unsigned)(a >> 32); r.z = (unsigned)b; r.w = (unsigned)(b >> 32); return r; }
__device__ __forceinline__ float bf_lo(unsigned w) { return __uint_as_float(w << 16); }
__device__ __forceinline__ float bf_hi(unsigned w) { return __uint_as_float(w & 0xffff0000u); }

__device__ __forceinline__ float row_rs(const float* SS, int row) { const f32x4 a = *(const f32x4*)(SS + (size_t)row * 16), b2 = *(const f32x4*)(SS + (size_t)row * 16 + 4), c2 = *(const f32x4*)(SS + (size_t)row * 16 + 8), d = *(const f32x4*)(SS + (size_t)row * 16 + 12);
    const float s = ((a[0] + a[1]) + (a[2] + a[3])) + ((b2[0] + b2[1]) + (b2[2] + b2[3])) + ((c2[0] + c2[1]) + (c2[2] + c2[3])) + ((d[0] + d[1]) + (d[2] + d[3]));
    return 1.0f / sqrtf(s * (1.0f / 1024.0f) + 1e-6f); }
struct EpiSwiglu {
    static constexpr bool PERM = true, AFTER_DRAIN = false;
    bf16_t* O; int ldc; const float* SS;
    __device__ __forceinline__ void operator()(const f32x4 (&acc)[2][2][4][2], const Unit& u, int wr, int wc, int fr, int fq) const {
        const int row0 = u.pm * BM + wr * 64 + fr, col0 = u.pn * HALF + wc * 32 + 8 * fq;
#pragma unroll
        for (int ai = 0; ai < 2; ++ai)
#pragma unroll
            for (int m = 0; m < 4; ++m) {
                bf16_t* rowp = O + (size_t)(row0 + ai * HALF + m * 16) * ldc + col0;
                const float rs = row_rs(SS, row0 + ai * HALF + m * 16);
                float v[8];
#pragma unroll
                for (int n = 0; n < 2; ++n)
#pragma unroll
                    for (int j = 0; j < 4; ++j) { const float g = acc[ai][0][m][n][j] * rs, up = acc[ai][1][m][n][j] * rs; v[n * 4 + j] = g * fast_sigmoid(g) * up; }
                u32x4 w; w.x = cvt_pk_bf16(v[0], v[1]); w.y = cvt_pk_bf16(v[2], v[3]); w.z = cvt_pk_bf16(v[4], v[5]); w.w = cvt_pk_bf16(v[6], v[7]);
                *(u32x4*)rowp = w;
            }
    }
};
struct EpiResid {
    static constexpr bool PERM = false, AFTER_DRAIN = false;
    const float* src; float* dst; int ldc; float scale; bf16_t* XB; float* SS;
    __device__ __forceinline__ void operator()(const f32x4 (&acc)[2][2][4][2], const Unit& u, int wr, int wc, int fr, int fq) const {
        const int col0 = u.pn * BM + wc * 32 + 4 * fq;
#pragma unroll
        for (int ai = 0; ai < 2; ++ai)
#pragma unroll
            for (int m = 0; m < 4; ++m) {
                const int row = u.pm * BM + ai * HALF + wr * 64 + m * 16 + fr;
                const size_t off = (size_t)row * ldc + col0; float sq = 0.f;
#pragma unroll
                for (int bj = 0; bj < 2; ++bj)
#pragma unroll
                    for (int n = 0; n < 2; ++n) { const f32x4 b = *(const f32x4*)(src + off + bj * HALF + n * 16); const f32x4 x = b + acc[ai][bj][m][n] * scale;
                        *(f32x4*)(dst + off + bj * HALF + n * 16) = x; sq += (x[0] * x[0] + x[1] * x[1]) + (x[2] * x[2] + x[3] * x[3]);
                        typedef unsigned u32x2 __attribute__((ext_vector_type(2)));
                        *(u32x2*)(XB + off + bj * HALF + n * 16) = (u32x2){cvt_pk_bf16(x[0], x[1]), cvt_pk_bf16(x[2], x[3])}; }
                sq += __shfl_xor(sq, 16); sq += __shfl_xor(sq, 32);
                if (fq == 0) SS[(size_t)row * 16 + u.pn * 4 + wc] = sq;
            }
    }
};
struct EpiWin {
    static constexpr bool PERM = true, AFTER_DRAIN = false;
    bf16_t *PR, *QB, *KVB, *QC, *KVC; const float* SS;
    __device__ __forceinline__ void operator()(const f32x4 (&acc)[2][2][4][2], const Unit& u, int wr, int wc, int fr, int fq) const {
        bf16_t* base; int ldc, colt;
        const int pn = u.pn;
        if (pn < 8) { base = PR; ldc = 2048; colt = pn * 256; }
        else if (pn < 10) { base = QB; ldc = 512; colt = (pn - 8) * 256; }
        else if (pn == 10) { base = KVB; ldc = 256; colt = 0; }
        else if (pn < 13) { base = QC; ldc = 512; colt = (pn - 11) * 256; }
        else { base = KVC; ldc = 256; colt = 0; }
        const int row0 = u.pm * BM + wr * 64 + fr, col0 = colt + wc * 32 + 8 * fq;
#pragma unroll
        for (int ai = 0; ai < 2; ++ai)
#pragma unroll
            for (int m = 0; m < 4; ++m) {
                bf16_t* rowp = base + (size_t)(row0 + ai * HALF + m * 16) * ldc + col0;
                const float rs = row_rs(SS, row0 + ai * HALF + m * 16);
#pragma unroll
                for (int bj = 0; bj < 2; ++bj) { const f32x4 v0 = acc[ai][bj][m][0] * rs, v1 = acc[ai][bj][m][1] * rs;
                    u32x4 w; w.x = cvt_pk_bf16(v0[0], v0[1]); w.y = cvt_pk_bf16(v0[2], v0[3]); w.z = cvt_pk_bf16(v1[0], v1[1]); w.w = cvt_pk_bf16(v1[2], v1[3]);
                    *(u32x4*)(rowp + bj * HALF) = w; }
            }
    }
};
struct EpiGate {
    static constexpr bool PERM = true, AFTER_DRAIN = false;
    bf16_t* G; const float* SS;
    __device__ __forceinline__ void operator()(const f32x4 (&acc)[2][2][4][2], const Unit& u, int wr, int wc, int fr, int fq) const {
        const int row0 = u.pm * BM + wr * 64 + fr, col0 = u.pn * BM + wc * 32 + 8 * fq;
#pragma unroll
        for (int ai = 0; ai < 2; ++ai)
#pragma unroll
            for (int m = 0; m < 4; ++m) {
                bf16_t* rowp = G + (size_t)(row0 + ai * HALF + m * 16) * 1024 + col0;
                const float rs = row_rs(SS, row0 + ai * HALF + m * 16);
#pragma unroll
                for (int bj = 0; bj < 2; ++bj) { const f32x4 v0 = acc[ai][bj][m][0] * rs, v1 = acc[ai][bj][m][1] * rs;
                    u32x4 w; w.x = cvt_pk_bf16(fast_sigmoid(v0[0]), fast_sigmoid(v0[1])); w.y = cvt_pk_bf16(fast_sigmoid(v0[2]), fast_sigmoid(v0[3]));
                    w.z = cvt_pk_bf16(fast_sigmoid(v1[0]), fast_sigmoid(v1[1])); w.w = cvt_pk_bf16(fast_sigmoid(v1[2]), fast_sigmoid(v1[3]));
#ifdef DBG_GCONST
                    w = (u32x4){0x3f003f00u, 0x3f003f00u, 0x3f003f00u, 0x3f003f00u};
#endif
                    *(u32x4*)(rowp + bj * HALF) = w; }
            }
    }
};
struct EpiMerge {
    static constexpr bool PERM = true, AFTER_DRAIN = false;
    const bf16_t* G; bf16_t* Mg; int first;
    __device__ __forceinline__ void operator()(const f32x4 (&acc)[2][2][4][2], const Unit& u, int wr, int wc, int fr, int fq) const {
        const int row0 = u.pm * BM + wr * 64 + fr, col0 = u.pn * BM + wc * 32 + 8 * fq;
#pragma unroll
        for (int ai = 0; ai < 2; ++ai)
#pragma unroll
            for (int m = 0; m < 4; ++m) {
                const size_t off = (size_t)(row0 + ai * HALF + m * 16) * 1024 + col0;
#pragma unroll
                for (int bj = 0; bj < 2; ++bj) { const f32x4 v0 = acc[ai][bj][m][0], v1 = acc[ai][bj][m][1];
#ifdef DBG_NOG
                    const u32x4 g = (u32x4){0x3f803f80u, 0x3f803f80u, 0x3f803f80u, 0x3f803f80u};
#else
                    const u32x4 g = __builtin_nontemporal_load((const u32x4*)(G + off + bj * HALF));
#endif
                    float r[8];
                    r[0] = bf_lo(g.x) * v0[0]; r[1] = bf_hi(g.x) * v0[1]; r[2] = bf_lo(g.y) * v0[2]; r[3] = bf_hi(g.y) * v0[3];
                    r[4] = bf_lo(g.z) * v1[0]; r[5] = bf_hi(g.z) * v1[1]; r[6] = bf_lo(g.w) * v1[2]; r[7] = bf_hi(g.w) * v1[3];
#ifdef DBG_NOG
                    if (false) { const u32x4 p = __builtin_nontemporal_load((const u32x4*)(Mg + off + bj * HALF));
#else
                    if (!first) { const u32x4 p = __builtin_nontemporal_load((const u32x4*)(Mg + off + bj * HALF));
#endif
                        r[0] += bf_lo(p.x); r[1] += bf_hi(p.x); r[2] += bf_lo(p.y); r[3] += bf_hi(p.y); r[4] += bf_lo(p.z); r[5] += bf_hi(p.z); r[6] += bf_lo(p.w); r[7] += bf_hi(p.w); }
                    u32x4 w; w.x = cvt_pk_bf16(r[0], r[1]); w.y = cvt_pk_bf16(r[2], r[3]); w.z = cvt_pk_bf16(r[4], r[5]); w.w = cvt_pk_bf16(r[6], r[7]);
                    *(u32x4*)(Mg + off + bj * HALF) = w; }
            }
    }
};
template <class Epi, class Sched, bool ALIGN_EPI = false, bool SP2 = false>
__device__ __forceinline__ void gemm_phase(PG8_LAS unsigned char* lds, const Gemm g, const Sched& S, const Epi& E) {
    int tid_o = threadIdx.x; asm volatile("" : "+v"(tid_o));
    const int tid = tid_o, wid = __builtin_amdgcn_readfirstlane(tid >> 6), lane = tid & 63, wr = wid >> 2, wc = wid & 3, fr = lane & 15, fq = lane >> 4;
    const int K = g.K, nt = K / BK;
    unsigned voffA[2], voffB[2];
#pragma unroll
    for (int i = 0; i < 2; ++i) { int R, C; stage_rc(tid * 16 + i * 8192, R, C); const int Rb = Epi::PERM ? ((R & ~31) + perm32(R & 31)) : R;
        voffA[i] = (unsigned)(R * K + C) * 2u; voffB[i] = (unsigned)(Rb * K + C) * 2u; }
    const size_t kstep = (size_t)(BK * 2);
    const size_t hstep = (size_t)HALF * K * 2;
    const size_t tstep = 2 * hstep;
    const unsigned ldsw = (unsigned)wid * 1024u;
    const int aoff = lds_byte(wr * 64 + fr, fq * 8), boff = lds_byte(wc * 32 + fr, fq * 8);
#define PG8_SA(b, h) (((b) * 2 + (h)) * HTB)
#define PG8_SB(b, h) ((4 + (b) * 2 + (h)) * HTB)
#define PG8_STAGE(bufoff, gbase, voff) do { _Pragma("unroll") for (int _i = 0; _i < 2; ++_i) \
        __builtin_amdgcn_global_load_lds((const unsigned*)((const char*)(gbase) + (voff)[_i]), (PG8_LAS unsigned*)(lds + (bufoff) + ldsw + _i * 8192), 16, 0, 0); } while (0)
#define PG8_LDA(dst, b, h) do { _Pragma("unroll") for (int m = 0; m < 4; ++m) _Pragma("unroll") for (int k = 0; k < 2; ++k) dst[m][k] = *(const PG8_LAS bf16x8*)(lds + PG8_SA(b, h) + aoff + m * 2048 + k * 1024); } while (0)
#define PG8_LDB(dst, b, h) do { _Pragma("unroll") for (int n = 0; n < 2; ++n) _Pragma("unroll") for (int k = 0; k < 2; ++k) dst[n][k] = *(const PG8_LAS bf16x8*)(lds + PG8_SB(b, h) + boff + n * 2048 + k * 1024); } while (0)
#define PG8_MMA(ai, bj, At, Bt) do { __builtin_amdgcn_s_setprio(1); _Pragma("unroll") for (int m = 0; m < 4; ++m) _Pragma("unroll") for (int n = 0; n < 2; ++n) _Pragma("unroll") for (int k = 0; k < 2; ++k) \
        acc[ai][bj][m][n] = __builtin_amdgcn_mfma_f32_16x16x32_bf16(Bt[n][k], At[m][k], acc[ai][bj][m][n], 0, 0, 0); __builtin_amdgcn_s_setprio(0); } while (0)
#define PG8_WAIT_V(n) asm volatile("s_waitcnt vmcnt(" #n ")" ::: "memory")
#define PG8_WAIT_L(n) asm volatile("s_waitcnt lgkmcnt(" #n ")" ::: "memory")
#define PG8_BAR __builtin_amdgcn_s_barrier()
#define PG8_SCHED __builtin_amdgcn_sched_barrier(0)
    Unit cur, nxt; int ui = 0;
    if (!S.next(0, cur)) return;
    f32x4 acc[2][2][4][2];
#pragma unroll
    for (int a = 0; a < 2; ++a)
#pragma unroll
        for (int b = 0; b < 2; ++b)
#pragma unroll
            for (int m = 0; m < 4; ++m)
#pragma unroll
                for (int n = 0; n < 2; ++n) acc[a][b][m][n] = (f32x4){0.f, 0.f, 0.f, 0.f};
    bf16x8 At[4][2], B0[2][2], B1[2][2];
    const char* cA = (const char*)g.A + (size_t)cur.pm * tstep; const char* cB = (const char*)g.Bt + (size_t)cur.pn * tstep;
    S.a_ready(cur);
    if constexpr (SP2) {
        PG8_STAGE(PG8_SB(0, 0), cB, voffB); PG8_STAGE(PG8_SB(0, 1), cB + hstep, voffB); PG8_STAGE(PG8_SA(0, 0), cA, voffA); PG8_STAGE(PG8_SA(0, 1), cA + hstep, voffA);
        if (wr == 1) PG8_BAR;
        PG8_WAIT_V(2); PG8_BAR;
        PG8_STAGE(PG8_SB(1, 0), cB + kstep, voffB); PG8_STAGE(PG8_SA(1, 0), cA + kstep, voffA); PG8_STAGE(PG8_SB(1, 1), cB + hstep + kstep, voffB);
        PG8_WAIT_V(6); PG8_BAR;
    } else {
        PG8_STAGE(PG8_SB(0, 0), cB, voffB); PG8_STAGE(PG8_SA(0, 0), cA, voffA); PG8_STAGE(PG8_SB(0, 1), cB + hstep, voffB); PG8_STAGE(PG8_SA(0, 1), cA + hstep, voffA);
        if (wr == 1) PG8_BAR;
        PG8_WAIT_V(4); PG8_BAR;
        PG8_STAGE(PG8_SB(1, 0), cB + kstep, voffB); PG8_STAGE(PG8_SA(1, 0), cA + kstep, voffA); PG8_STAGE(PG8_SB(1, 1), cB + hstep + kstep, voffB);
        PG8_WAIT_V(6); PG8_BAR;
    }
    for (;;) {
        const bool has_next = S.next(ui + 1, nxt);
        const char* nA = has_next ? (const char*)g.A + (size_t)nxt.pm * tstep : cA; const char* nB = has_next ? (const char*)g.Bt + (size_t)nxt.pn * tstep : cB;
        for (int t = 0; t < nt; t += 2) {
            const bool last = (t == nt - 2);
            const char* a1 = cA + (size_t)(t + 1) * kstep;
            const char* a2 = last ? nA : cA + (size_t)(t + 2) * kstep; const char* b2 = last ? nB : cB + (size_t)(t + 2) * kstep;
            const char* a3 = a2 + kstep; const char* b3 = b2 + kstep;
            if (last && has_next) S.a_ready(nxt);
            if constexpr (SP2) {
            PG8_LDB(B0, 0, 0); PG8_LDB(B1, 0, 1); PG8_SCHED; PG8_LDA(At, 0, 0); PG8_STAGE(PG8_SA(1, 1), a1 + hstep, voffA);
            PG8_WAIT_V(8); PG8_WAIT_L(0); PG8_BAR; PG8_MMA(0, 0, At, B0); PG8_MMA(0, 1, At, B1); PG8_BAR; PG8_SCHED;
            PG8_LDA(At, 0, 1); PG8_STAGE(PG8_SB(0, 0), b2, voffB); PG8_STAGE(PG8_SB(0, 1), b2 + hstep, voffB); PG8_STAGE(PG8_SA(0, 0), a2, voffA);
            PG8_WAIT_V(8); PG8_WAIT_L(0); PG8_BAR; PG8_MMA(1, 0, At, B0); PG8_MMA(1, 1, At, B1); PG8_BAR; PG8_SCHED;
            PG8_LDB(B0, 1, 0); PG8_LDB(B1, 1, 1); PG8_SCHED; PG8_LDA(At, 1, 0); PG8_STAGE(PG8_SA(0, 1), a2 + hstep, voffA);
            PG8_WAIT_V(8); PG8_WAIT_L(0); PG8_BAR; PG8_MMA(0, 0, At, B0); PG8_MMA(0, 1, At, B1); PG8_BAR; PG8_SCHED;
            PG8_LDA(At, 1, 1); PG8_STAGE(PG8_SB(1, 0), b3, voffB); PG8_STAGE(PG8_SB(1, 1), b3 + hstep, voffB); PG8_STAGE(PG8_SA(1, 0), a3, voffA);
            PG8_WAIT_V(8); PG8_WAIT_L(0); PG8_BAR; PG8_MMA(1, 0, At, B0); PG8_MMA(1, 1, At, B1); PG8_BAR; PG8_SCHED;
            } else {
            PG8_LDB(B0, 0, 0); PG8_SCHED; PG8_LDA(At, 0, 0); PG8_STAGE(PG8_SA(1, 1), a1 + hstep, voffA);
            PG8_WAIT_L(8); PG8_BAR; PG8_WAIT_L(0); PG8_MMA(0, 0, At, B0); PG8_BAR; PG8_SCHED;
            PG8_LDB(B1, 0, 1); PG8_STAGE(PG8_SB(0, 0), b2, voffB);
            PG8_BAR; PG8_WAIT_L(0); PG8_MMA(0, 1, At, B1); PG8_BAR;
            PG8_LDA(At, 0, 1); PG8_STAGE(PG8_SA(0, 0), a2, voffA);
            PG8_BAR; PG8_WAIT_L(0); PG8_MMA(1, 0, At, B0); PG8_BAR; PG8_SCHED;
            PG8_STAGE(PG8_SB(0, 1), b2 + hstep, voffB);
            PG8_WAIT_V(6); PG8_BAR; PG8_MMA(1, 1, At, B1); PG8_BAR;
            PG8_LDB(B0, 1, 0); PG8_SCHED; PG8_LDA(At, 1, 0); PG8_STAGE(PG8_SA(0, 1), a2 + hstep, voffA);
            PG8_WAIT_L(8); PG8_BAR; PG8_WAIT_L(0); PG8_MMA(0, 0, At, B0); PG8_BAR; PG8_SCHED;
            PG8_LDB(B1, 1, 1); PG8_STAGE(PG8_SB(1, 0), b3, voffB);
            PG8_BAR; PG8_WAIT_L(0); PG8_MMA(0, 1, At, B1); PG8_BAR;
            PG8_LDA(At, 1, 1); PG8_STAGE(PG8_SA(1, 0), a3, voffA);
            PG8_BAR; PG8_WAIT_L(0); PG8_MMA(1, 0, At, B0); PG8_BAR; PG8_SCHED;
            PG8_STAGE(PG8_SB(1, 1), b3 + hstep, voffB);
            PG8_WAIT_V(6); PG8_BAR; PG8_MMA(1, 1, At, B1); PG8_BAR;
            }
        }
        if constexpr (ALIGN_EPI) { if (wr == 0) PG8_BAR; }
        if constexpr (!Epi::AFTER_DRAIN) { E(acc, cur, wr, wc, fr, fq); S.done(cur); }
        if (!has_next) break;
#pragma unroll
        for (int a = 0; a < 2; ++a)
#pragma unroll
            for (int b = 0; b < 2; ++b)
#pragma unroll
                for (int m = 0; m < 4; ++m)
#pragma unroll
                    for (int n = 0; n < 2; ++n) acc[a][b][m][n] = (f32x4){0.f, 0.f, 0.f, 0.f};
        cur = nxt; cA = nA; cB = nB; ++ui;
        if constexpr (ALIGN_EPI) { if (wr == 1) PG8_BAR; }
    }
    PG8_WAIT_V(0);
    if constexpr (!ALIGN_EPI) { if (wr == 0) PG8_BAR; }
    PG8_BAR;
    if constexpr (Epi::AFTER_DRAIN) { E.fused(acc, cur, wr, wc, fr, fq, lds, wid, lane); S.done(cur); }
#undef PG8_SA
#undef PG8_SB
#undef PG8_STAGE
#undef PG8_LDA
#undef PG8_LDB
#undef PG8_MMA
#undef PG8_WAIT_V
#undef PG8_WAIT_L
#undef PG8_BAR
#undef PG8_SCHED
}
}
#define LAS __attribute__((address_space(3)))
typedef unsigned short bf16;
typedef unsigned v4u __attribute__((ext_vector_type(4)));
typedef unsigned v2u __attribute__((ext_vector_type(2)));
typedef float f4 __attribute__((ext_vector_type(4)));
constexpr int T_ = 32768, S_ = 2048, NB = 16, DM = 1024, FF = 2816, NL = 4;
constexpr int NWAVES = 8, NTHREADS = 512;
constexpr int LDS_BYTES = 163840;
constexpr float LOG2E = 1.4426950408889634f;
constexpr float C2 = 0.125f * LOG2E;
constexpr float LOG2_THETA = 13.287712379549449f;

enum { I_X = 0, I_F1N, I_F1UP, I_F1DN, I_MIXN, I_WIN, I_MU, I_W0, I_W2, I_A0, I_A2, I_G2, I_KK, I_KA, I_RK, I_LNG, I_LNB, I_QN, I_KN, I_SINK,
       I_WOA, I_WOB, I_WOC, I_WOUT, I_F2N, I_F2UP, I_F2DN, I_FINN, N_IN };

constexpr size_t SZ_WUP = (size_t)2 * FF * DM * 2, SZ_WDN = (size_t)DM * FF * 2, SZ_WIN = (size_t)3584 * DM * 2, SZ_WG = (size_t)3072 * DM * 2,
                 SZ_WO = (size_t)3 * DM * 512 * 2, SZ_WOUT = (size_t)DM * DM * 2;
constexpr size_t WS_WUP1 = 0, WS_WDN1 = WS_WUP1 + SZ_WUP, WS_WIN = WS_WDN1 + SZ_WDN, WS_WG = WS_WIN + SZ_WIN, WS_WO = WS_WG + SZ_WG, WS_WOUT = WS_WO + SZ_WO,
                 WS_WUP2 = WS_WOUT + SZ_WOUT, WS_WDN2 = WS_WUP2 + SZ_WUP, WS_H = WS_WDN2 + SZ_WDN;
constexpr size_t WS_R = WS_H + (size_t)T_ * DM * 2;
constexpr size_t WS_ACT = WS_R;
constexpr size_t WS_PR = WS_R, WS_QB = WS_PR + (size_t)T_ * 2048 * 2, WS_KVB = WS_QB + (size_t)T_ * 512 * 2, WS_QC = WS_KVB + (size_t)T_ * 256 * 2, WS_KVC = WS_QC + (size_t)T_ * 512 * 2,
                 WS_KG = WS_KVC + (size_t)T_ * 256 * 2, WS_VG = WS_KG + (size_t)NB * 2 * S_ * 64 * 2, WS_KW = WS_VG + (size_t)NB * 2 * S_ * 64 * 2, WS_VW = WS_KW + (size_t)NB * 2 * S_ * 64 * 2,
                 WS_YA = WS_VW + (size_t)NB * 2 * S_ * 64 * 2, WS_WKVF = WS_YA + (size_t)T_ * 512 * 2, WS_WKVB = WS_WKVF + (size_t)T_ * 512 * 2, WS_BONUS = WS_WKVB + (size_t)T_ * 512 * 2,
                 WS_SCR = WS_BONUS + (size_t)T_ * 16 * 4, WS_SS = WS_SCR, WS_WUP1B = WS_SS + (size_t)T_ * 16 * 4, WS_BAR = WS_WUP1B + SZ_WUP, WS_END = WS_BAR + 4096;
#ifdef DBG_GATE_ALT
constexpr size_t WS_GATE = WS_WKVF, WS_MERGED = WS_PR + (size_t)T_ * DM * 2;
#else
constexpr size_t WS_GATE = WS_PR, WS_MERGED = WS_PR + (size_t)T_ * DM * 2;
#endif
static_assert(WS_ACT + (size_t)T_ * FF * 2 <= WS_END, "map");
static_assert(WS_END < 536000000ull, "workspace budget");

struct Params { const float* in[N_IN]; float* out; unsigned char* ws; };

__device__ __forceinline__ unsigned f2bf(float f) { unsigned u = __float_as_uint(f); return (u + 0x7fffu + ((u >> 16) & 1u)) >> 16; }
__device__ __forceinline__ unsigned pk2(float lo, float hi) { return f2bf(lo) | (f2bf(hi) << 16); }
__device__ __forceinline__ float bf2f(bf16 h) { return __uint_as_float((unsigned)h << 16); }
__device__ __forceinline__ int opaque_tid() { int t = threadIdx.x; asm volatile("" : "+v"(t)); return t; }
#define STAGE_IDS const int tid = opaque_tid(), lane = tid & 63, wave = __builtin_amdgcn_readfirstlane(tid >> 6); const int gw = blockIdx.x * NWAVES + wave, ngw = gridDim.x * NWAVES, gtid = blockIdx.x * NTHREADS + tid, gthreads = gridDim.x * NTHREADS; (void)lane; (void)gw; (void)ngw; (void)gtid; (void)gthreads;
__device__ __forceinline__ float wave_sum(float v) {
#pragma unroll
    for (int o = 1; o < 64; o <<= 1) v += __shfl_xor(v, o);
    return v;
}

__device__ __forceinline__ void cvt_wt(const float* W, int K, int ld, bf16* Wt, int nrows, int mode, int gw, int ngw, int lane, float* scr, const float* gain = nullptr) {
    const int nblk = nrows >> 5, nitems = (K >> 6) * nblk;
    for (int it = gw; it < nitems; it += ngw) {
        const int kb = it / nblk, nb = it % nblk, k0 = kb * 64, n0 = nb * 32;
        int col0;
        if (mode == 0) col0 = n0;
        else if (mode == 1) { const int t = n0 >> 8, r = n0 & 255; col0 = (r < 128) ? t * 128 + r : FF + t * 128 + (r - 128); }
        else if (mode == 2) col0 = n0 < 1920 ? n0 : (n0 < 2048 ? -1 : n0 - 128);
        else col0 = 3456 + n0;
        if (col0 >= 0) {
#pragma unroll 8
            for (int i = 0; i < 32; ++i) { const int kk = 2 * i + (lane >> 5); scr[kk * 33 + (lane & 31)] = W[(size_t)(k0 + kk) * ld + col0 + (lane & 31)] * (gain ? gain[k0 + kk] : 1.0f); }
        }
        asm volatile("s_waitcnt lgkmcnt(0)" ::: "memory");
        const int c = lane & 7;
#pragma unroll
        for (int j = 0; j < 4; ++j) { const int n = (lane >> 3) + 8 * j; const float* sp = scr + (8 * c) * 33 + n;
            v4u o = (v4u){0u, 0u, 0u, 0u};
            if (col0 >= 0) { o.x = pk2(sp[0 * 33], sp[1 * 33]); o.y = pk2(sp[2 * 33], sp[3 * 33]); o.z = pk2(sp[4 * 33], sp[5 * 33]); o.w = pk2(sp[6 * 33], sp[7 * 33]); }
            *(v4u*)(Wt + (size_t)(n0 + n) * K + k0 + 8 * c) = o; }
        asm volatile("s_waitcnt lgkmcnt(0)" ::: "memory");
    }
}
__device__ __forceinline__ void cvt_up1(const Params& P, int l, unsigned char* ldsg) {
    STAGE_IDS
    unsigned char* ws = P.ws; float* scr = (float*)(ldsg + wave * 8448);
    cvt_wt(P.in[I_F1UP] + (size_t)l * DM * 2 * FF, DM, 2 * FF, (bf16*)(ws + ((l & 1) ? WS_WUP1B : WS_WUP1)), 2 * FF, 1, gw, ngw, lane, scr, P.in[I_F1N] + l * DM);
}
__device__ __forceinline__ void cvt_rest(const Params& P, int l, unsigned char* ldsg) {
    STAGE_IDS
    unsigned char* ws = P.ws; float* scr = (float*)(ldsg + wave * 8448);
    cvt_wt(P.in[I_F1DN] + (size_t)l * FF * DM, FF, DM, (bf16*)(ws + WS_WDN1), DM, 0, gw, ngw, lane, scr);
    cvt_wt(P.in[I_WIN] + (size_t)l * DM * 6528, DM, 6528, (bf16*)(ws + WS_WIN), 3584, 2, gw, ngw, lane, scr, P.in[I_MIXN] + l * DM);
    cvt_wt(P.in[I_WIN] + (size_t)l * DM * 6528, DM, 6528, (bf16*)(ws + WS_WG), 3072, 3, gw, ngw, lane, scr, P.in[I_MIXN] + l * DM);
    cvt_wt(P.in[I_WOA] + (size_t)l * 512 * DM, 512, DM, (bf16*)(ws + WS_WO), DM, 0, gw, ngw, lane, scr);
    cvt_wt(P.in[I_WOB] + (size_t)l * 512 * DM, 512, DM, (bf16*)(ws + WS_WO) + (size_t)DM * 512, DM, 0, gw, ngw, lane, scr);
    cvt_wt(P.in[I_WOC] + (size_t)l * 512 * DM, 512, DM, (bf16*)(ws + WS_WO) + (size_t)2 * DM * 512, DM, 0, gw, ngw, lane, scr);
    cvt_wt(P.in[I_WOUT] + (size_t)l * DM * DM, DM, DM, (bf16*)(ws + WS_WOUT), DM, 0, gw, ngw, lane, scr);
    cvt_wt(P.in[I_F2UP] + (size_t)l * DM * 2 * FF, DM, 2 * FF, (bf16*)(ws + WS_WUP2), 2 * FF, 1, gw, ngw, lane, scr, P.in[I_F2N] + l * DM);
    cvt_wt(P.in[I_F2DN] + (size_t)l * FF * DM, FF, DM, (bf16*)(ws + WS_WDN2), DM, 0, gw, ngw, lane, scr);
}
__device__ __forceinline__ void x_to_bf16_ss(const float* x, bf16* o, float* SS) {
    STAGE_IDS
    for (int m = gw; m < T_; m += ngw) {
        const f4* xr = (const f4*)(x + (size_t)m * DM) + lane; f4 v[4]; float s = 0.f;
#pragma unroll
        for (int j = 0; j < 4; ++j) { v[j] = xr[64 * j]; s += (v[j].x * v[j].x + v[j].y * v[j].y) + (v[j].z * v[j].z + v[j].w * v[j].w); }
        s = wave_sum(s);
        v2u* op = (v2u*)(o + (size_t)m * DM) + lane;
#pragma unroll
        for (int j = 0; j < 4; ++j) { v2u w; w.x = pk2(v[j].x, v[j].y); w.y = pk2(v[j].z, v[j].w); op[64 * j] = w; }
        if (lane < 16) SS[(size_t)m * 16 + lane] = lane == 0 ? s : 0.f;
    }
}

__device__ __forceinline__ void rms_rows_bf16(const float* x, const float* g, bf16* o) {
    STAGE_IDS
    const f4* gr = (const f4*)g + lane; f4 gv[4];
#pragma unroll
    for (int j = 0; j < 4; ++j) gv[j] = gr[64 * j];
    for (int m = gw; m < T_; m += ngw) {
        const f4* xr = (const f4*)(x + (size_t)m * DM) + lane; f4 v[4]; float s = 0.f;
#pragma unroll
        for (int j = 0; j < 4; ++j) { v[j] = xr[64 * j]; s += (v[j].x * v[j].x + v[j].y * v[j].y) + (v[j].z * v[j].z + v[j].w * v[j].w); }
        const float rs = 1.0f / sqrtf(wave_sum(s) * (1.0f / DM) + 1e-6f);
        v2u* op = (v2u*)(o + (size_t)m * DM) + lane;
#pragma unroll
        for (int j = 0; j < 4; ++j) { v2u w; w.x = pk2(v[j].x * rs * gv[j].x, v[j].y * rs * gv[j].y); w.y = pk2(v[j].z * rs * gv[j].z, v[j].w * rs * gv[j].w); op[64 * j] = w; }
    }
}
__device__ __forceinline__ void rms_rows_f32_inplace(float* x, const float* g) {
    STAGE_IDS
    const f4* gr = (const f4*)g + lane; f4 gv[4];
#pragma unroll
    for (int j = 0; j < 4; ++j) gv[j] = gr[64 * j];
    for (int m = gw; m < T_; m += ngw) {
        f4* xr = (f4*)(x + (size_t)m * DM) + lane; f4 v[4]; float s = 0.f;
#pragma unroll
        for (int j = 0; j < 4; ++j) { v[j] = xr[64 * j]; s += (v[j].x * v[j].x + v[j].y * v[j].y) + (v[j].z * v[j].z + v[j].w * v[j].w); }
        const float rs = 1.0f / sqrtf(wave_sum(s) * (1.0f / DM) + 1e-6f);
#pragma unroll
        for (int j = 0; j < 4; ++j) xr[64 * j] = v[j] * rs * gv[j];
    }
}

__device__ __forceinline__ float fast_sin_rev(float rev) { return __builtin_amdgcn_sinf(__builtin_amdgcn_fractf(rev)); }
__device__ __forceinline__ float fast_cos_rev(float rev) { return __builtin_amdgcn_cosf(__builtin_amdgcn_fractf(rev)); }
__device__ __forceinline__ void qkprep(const Params& P, int l) {
    STAGE_IDS
    unsigned char* ws = P.ws;
    bf16* QB = (bf16*)(ws + WS_QB); const bf16* KVB = (const bf16*)(ws + WS_KVB); bf16* QC = (bf16*)(ws + WS_QC); const bf16* KVC = (const bf16*)(ws + WS_KVC);
    bf16* KG = (bf16*)(ws + WS_KG); bf16* KW = (bf16*)(ws + WS_KW);
    const float qg = P.in[I_QN][l * 64 + lane], kg = P.in[I_KN][l * 64 + lane];
    const float inv_ax = exp2f(-(float)(lane & 15) * (LOG2_THETA / 16.0f)), inv_1d = exp2f(-(float)(lane & 31) * (LOG2_THETA / 32.0f));
    const float INV2PI = 0.15915494309189535f;
    for (int t = gw; t < T_; t += ngw) {
        const int b = t >> 11, s = t & 2047;
        const float pos = lane < 32 ? (float)(s >> 6) : (float)(s & 63);
        const float ra = (pos * inv_ax) * INV2PI, r1 = ((float)s * inv_1d) * INV2PI;
        const float csa = fast_cos_rev(ra), sna = (lane & 16) ? fast_sin_rev(ra) : -fast_sin_rev(ra);
        const float cs1 = fast_cos_rev(r1), sn1 = (lane & 32) ? fast_sin_rev(r1) : -fast_sin_rev(r1);
#pragma unroll
        for (int slot = 0; slot < 10; ++slot) {
            bf16* src = slot < 8 ? QB + (size_t)t * 512 + slot * 64 : (bf16*)KVB + (size_t)t * 256 + (slot - 8) * 64;
            const float x = bf2f(src[lane]);
            const float ss = wave_sum(x * x) * (1.0f / 64.0f);
            const float y = x * (1.0f / sqrtf(ss + 1e-6f)) * (slot < 8 ? qg : kg);
            const float r = y * csa + __shfl_xor(y, 16) * sna;
            if (slot < 8) src[lane] = (bf16)f2bf(r * C2);
            else KG[((size_t)(b * 2 + (slot - 8)) * S_ + s) * 64 + lane] = (bf16)f2bf(r);
        }
#pragma unroll
        for (int slot = 0; slot < 10; ++slot) {
            bf16* src = slot < 8 ? QC + (size_t)t * 512 + slot * 64 : (bf16*)KVC + (size_t)t * 256 + (slot - 8) * 64;
            const float x = bf2f(src[lane]);
            const float r = x * cs1 + __shfl_xor(x, 32) * sn1;
            if (slot < 8) src[lane] = (bf16)f2bf(r * C2);
            else KW[((size_t)(b * 2 + (slot - 8)) * S_ + s) * 64 + lane] = (bf16)f2bf(r);
        }
    }
}

__device__ __forceinline__ void vt_prep(const Params& P, unsigned char* ldsg) {
    STAGE_IDS
    unsigned char* ws = P.ws;
    bf16* tile = (bf16*)(ldsg + wave * 8448);
    for (int it = gw; it < 2 * NB * 2 * 32; it += ngw) {
        const int tb = it & 31, kvh = (it >> 5) & 1, b = (it >> 6) & 15, att = it >> 10;
        const bf16* src = (const bf16*)(ws + (att ? WS_KVC : WS_KVB)) + (size_t)(b * S_ + tb * 64) * 256 + 128 + kvh * 64;
        bf16* dst = (bf16*)(ws + (att ? WS_VW : WS_VG)) + (size_t)(b * 2 + kvh) * 64 * S_ + tb * 64;
#pragma unroll 8
        for (int r = 0; r < 64; ++r) tile[r * 66 + lane] = src[(size_t)r * 256 + lane];
        asm volatile("s_waitcnt lgkmcnt(0)" ::: "memory");
#pragma unroll 8
        for (int d = 0; d < 64; ++d) dst[(size_t)d * S_ + lane] = tile[lane * 66 + d];
        asm volatile("s_waitcnt lgkmcnt(0)" ::: "memory");
    }
}

typedef short bf16x8_t __attribute__((ext_vector_type(8)));
typedef short s16x4_t __attribute__((ext_vector_type(4)));
typedef float f32x16 __attribute__((ext_vector_type(16)));
typedef float f32x2a __attribute__((ext_vector_type(2))); typedef __bf16 bf16x2a __attribute__((ext_vector_type(2)));
__device__ __forceinline__ unsigned cvtpk(float lo, float hi) { f32x2a v = {lo, hi}; bf16x2a b = __builtin_convertvector(v, bf16x2a); return __builtin_bit_cast(unsigned, b); }
__device__ __forceinline__ int crow(int r, int hi) { return (r & 3) + 8 * (r >> 2) + 4 * hi; }
template <bool WINDOW>
__device__ __forceinline__ void attn_mfma(bf16* Q, const bf16* Kx, const bf16* VTx, const float* sink, unsigned char* ldsg, bf16* Oalt = nullptr) {
    STAGE_IDS
    const int r32 = lane & 31, hi = lane >> 5, g = wave >> 1, qs = wave & 1;
    const int srow = tid >> 3, sch = tid & 7;
    for (int unit = blockIdx.x; unit < 1024; unit += gridDim.x) {
        const int qb = unit & 31, kvh = (unit >> 5) & 1, b = unit >> 6, h = kvh * 4 + g, q0 = qb * 64 + qs * 32;
        bf16* qp = Q + ((size_t)(b * S_ + q0 + r32)) * 512 + h * 64;
        bf16x8_t qr[4];
#pragma unroll
        for (int d0 = 0; d0 < 4; ++d0) qr[d0] = *(const bf16x8_t*)(qp + 16 * d0 + 8 * hi);
        f32x16 o0, o1;
#pragma unroll
        for (int r = 0; r < 16; ++r) { o0[r] = 0.f; o1[r] = 0.f; }
        float m, l;
        if (WINDOW) { m = sink[h] * LOG2E; l = hi == 0 ? 1.0f : 0.f; } else { m = -1e30f; l = 0.f; }
        const int t0 = WINDOW ? (qb - 2 > 0 ? qb - 2 : 0) : 0, t1 = WINDOW ? (qb + 2 < 31 ? qb + 2 : 31) : 31;
        const bf16* kbase = Kx + (size_t)(b * 2 + kvh) * S_ * 64 + (size_t)srow * 64 + sch * 8;
        const bf16* vbase = VTx + (size_t)(b * 2 + kvh) * 64 * S_ + (size_t)srow * S_ + sch * 8;
        v4u kreg = *(const v4u*)(kbase + (size_t)t0 * 64 * 64);
        v4u vreg = *(const v4u*)(vbase + t0 * 64);
        __syncthreads();
        *(v4u*)(ldsg + srow * 144 + sch * 16) = kreg;
        *(v4u*)(ldsg + 9216 + srow * 144 + sch * 16) = vreg;
        __syncthreads();
        for (int t = t0; t <= t1; ++t) {
            const int buf = (t - t0) & 1;
            if (t < t1) { kreg = *(const v4u*)(kbase + (size_t)(t + 1) * 64 * 64); vreg = *(const v4u*)(vbase + (t + 1) * 64); }
            const unsigned char* Kb = ldsg + buf * 18432; const unsigned char* Vb = Kb + 9216;
            f32x16 p0, p1;
#pragma unroll
            for (int r = 0; r < 16; ++r) { p0[r] = 0.f; p1[r] = 0.f; }
#pragma unroll
            for (int d0 = 0; d0 < 4; ++d0) {
                const bf16x8_t a0 = *(const bf16x8_t*)(Kb + r32 * 144 + (16 * d0 + 8 * hi) * 2);
                const bf16x8_t a1 = *(const bf16x8_t*)(Kb + (32 + r32) * 144 + (16 * d0 + 8 * hi) * 2);
                p0 = __builtin_amdgcn_mfma_f32_32x32x16_bf16(a0, qr[d0], p0, 0, 0, 0);
                p1 = __builtin_amdgcn_mfma_f32_32x32x16_bf16(a1, qr[d0], p1, 0, 0, 0);
            }
            if (WINDOW) {
                const int qpos = q0 + r32;
#pragma unroll
                for (int r = 0; r < 16; ++r) { const int kv = t * 64 + crow(r, hi); int dlt = qpos - kv; dlt = dlt < 0 ? -dlt : dlt; if (dlt > 128) p0[r] = -1e30f;
                    int dl2 = qpos - (kv + 32); dl2 = dl2 < 0 ? -dl2 : dl2; if (dl2 > 128) p1[r] = -1e30f; }
            }
            float mt = fmaxf(p0[0], p1[0]);
#pragma unroll
            for (int r = 1; r < 16; ++r) mt = fmaxf(mt, fmaxf(p0[r], p1[r]));
            mt = fmaxf(mt, __shfl_xor(mt, 32));
            const float mn = fmaxf(m, mt), corr = __builtin_amdgcn_exp2f(m - mn); m = mn;
            float ps = 0.f;
#pragma unroll
            for (int r = 0; r < 16; ++r) { p0[r] = __builtin_amdgcn_exp2f(p0[r] - mn); p1[r] = __builtin_amdgcn_exp2f(p1[r] - mn); ps += p0[r] + p1[r]; }
            l = l * corr + ps;
#pragma unroll
            for (int r = 0; r < 16; ++r) { o0[r] *= corr; o1[r] *= corr; }
            v4u pw[4];
            pw[0] = (v4u){cvtpk(p0[0], p0[1]), cvtpk(p0[2], p0[3]), cvtpk(p0[4], p0[5]), cvtpk(p0[6], p0[7])};
            pw[1] = (v4u){cvtpk(p0[8], p0[9]), cvtpk(p0[10], p0[11]), cvtpk(p0[12], p0[13]), cvtpk(p0[14], p0[15])};
            pw[2] = (v4u){cvtpk(p1[0], p1[1]), cvtpk(p1[2], p1[3]), cvtpk(p1[4], p1[5]), cvtpk(p1[6], p1[7])};
            pw[3] = (v4u){cvtpk(p1[8], p1[9]), cvtpk(p1[10], p1[11]), cvtpk(p1[12], p1[13]), cvtpk(p1[14], p1[15])};
#pragma unroll
            for (int kb = 0; kb < 4; ++kb) {
                const bf16x8_t pb = __builtin_bit_cast(bf16x8_t, pw[kb]);
                { const unsigned char* vp = Vb + r32 * 144 + (16 * kb + 4 * hi) * 2; const s16x4_t lo = *(const s16x4_t*)vp, hh = *(const s16x4_t*)(vp + 16);
                  const bf16x8_t a = (bf16x8_t){lo[0], lo[1], lo[2], lo[3], hh[0], hh[1], hh[2], hh[3]};
                  o0 = __builtin_amdgcn_mfma_f32_32x32x16_bf16(a, pb, o0, 0, 0, 0); }
                { const unsigned char* vp = Vb + (32 + r32) * 144 + (16 * kb + 4 * hi) * 2; const s16x4_t lo = *(const s16x4_t*)vp, hh = *(const s16x4_t*)(vp + 16);
                  const bf16x8_t a = (bf16x8_t){lo[0], lo[1], lo[2], lo[3], hh[0], hh[1], hh[2], hh[3]};
                  o1 = __builtin_amdgcn_mfma_f32_32x32x16_bf16(a, pb, o1, 0, 0, 0); }
            }
            if (t < t1) { unsigned char* nb = ldsg + (buf ^ 1) * 18432; *(v4u*)(nb + srow * 144 + sch * 16) = kreg; *(v4u*)(nb + 9216 + srow * 144 + sch * 16) = vreg; }
            __syncthreads();
        }
        l += __shfl_xor(l, 32);
        const float inv = 1.0f / l;
        if (Oalt) qp = Oalt + ((size_t)(b * S_ + q0 + r32)) * 512 + h * 64;
#pragma unroll
        for (int g4 = 0; g4 < 4; ++g4) {
            v2u w0, w1;
            w0.x = cvtpk(o0[4 * g4 + 0] * inv, o0[4 * g4 + 1] * inv); w0.y = cvtpk(o0[4 * g4 + 2] * inv, o0[4 * g4 + 3] * inv);
            w1.x = cvtpk(o1[4 * g4 + 0] * inv, o1[4 * g4 + 1] * inv); w1.y = cvtpk(o1[4 * g4 + 2] * inv, o1[4 * g4 + 3] * inv);
            *(v2u*)(qp + 8 * g4 + 4 * hi) = w0;
            *(v2u*)(qp + 32 + 8 * g4 + 4 * hi) = w1;
        }
    }
}

__device__ __forceinline__ void attn_naive(bf16* Q, const bf16* Kx, const bf16* Vx, const float* sink, int window) {
    STAGE_IDS
    for (int it = gtid; it < T_ * 8; it += gthreads) {
        const int q = it & 2047, h = (it >> 11) & 7, b = it >> 14, kvh = h >> 2;
        bf16* qp = Q + ((size_t)(b * S_ + q)) * 512 + h * 64;
        float qf[64], o[64];
#pragma unroll
        for (int c = 0; c < 8; ++c) { const v4u w = ((const v4u*)qp)[c];
            qf[c * 8 + 0] = __uint_as_float(w.x << 16); qf[c * 8 + 1] = __uint_as_float(w.x & 0xffff0000u); qf[c * 8 + 2] = __uint_as_float(w.y << 16); qf[c * 8 + 3] = __uint_as_float(w.y & 0xffff0000u);
            qf[c * 8 + 4] = __uint_as_float(w.z << 16); qf[c * 8 + 5] = __uint_as_float(w.z & 0xffff0000u); qf[c * 8 + 6] = __uint_as_float(w.w << 16); qf[c * 8 + 7] = __uint_as_float(w.w & 0xffff0000u); }
#pragma unroll
        for (int d = 0; d < 64; ++d) o[d] = 0.f;
        float m, lsum;
        if (sink) { m = sink[h] * LOG2E; lsum = 1.0f; } else { m = -1e30f; lsum = 0.f; }
        const int k0 = window ? (q - 128 > 0 ? q - 128 : 0) : 0, k1 = window ? (q + 128 < S_ - 1 ? q + 128 : S_ - 1) : S_ - 1;
        const bf16* kp = Kx + (size_t)(b * 2 + kvh) * S_ * 64; const bf16* vp = Vx + (size_t)(b * 2 + kvh) * S_ * 64;
        for (int k = k0; k <= k1; ++k) {
            const v4u* kr = (const v4u*)(kp + (size_t)k * 64); float s = 0.f;
#pragma unroll
            for (int c = 0; c < 8; ++c) { const v4u w = kr[c];
                s += qf[c * 8 + 0] * __uint_as_float(w.x << 16) + qf[c * 8 + 1] * __uint_as_float(w.x & 0xffff0000u) + qf[c * 8 + 2] * __uint_as_float(w.y << 16) + qf[c * 8 + 3] * __uint_as_float(w.y & 0xffff0000u)
                   + qf[c * 8 + 4] * __uint_as_float(w.z << 16) + qf[c * 8 + 5] * __uint_as_float(w.z & 0xffff0000u) + qf[c * 8 + 6] * __uint_as_float(w.w << 16) + qf[c * 8 + 7] * __uint_as_float(w.w & 0xffff0000u); }
            const float mn = fmaxf(m, s), corr = exp2f(m - mn), p = exp2f(s - mn);
            lsum = lsum * corr + p; m = mn;
            const v4u* vr = (const v4u*)(vp + (size_t)k * 64);
#pragma unroll
            for (int c = 0; c < 8; ++c) { const v4u w = vr[c];
                o[c * 8 + 0] = o[c * 8 + 0] * corr + p * __uint_as_float(w.x << 16); o[c * 8 + 1] = o[c * 8 + 1] * corr + p * __uint_as_float(w.x & 0xffff0000u);
                o[c * 8 + 2] = o[c * 8 + 2] * corr + p * __uint_as_float(w.y << 16); o[c * 8 + 3] = o[c * 8 + 3] * corr + p * __uint_as_float(w.y & 0xffff0000u);
                o[c * 8 + 4] = o[c * 8 + 4] * corr + p * __uint_as_float(w.z << 16); o[c * 8 + 5] = o[c * 8 + 5] * corr + p * __uint_as_float(w.z & 0xffff0000u);
                o[c * 8 + 6] = o[c * 8 + 6] * corr + p * __uint_as_float(w.w << 16); o[c * 8 + 7] = o[c * 8 + 7] * corr + p * __uint_as_float(w.w & 0xffff0000u); }
        }
        const float inv = 1.0f / lsum;
#pragma unroll
        for (int c = 0; c < 8; ++c) { v4u w; w.x = pk2(o[c * 8 + 0] * inv, o[c * 8 + 1] * inv); w.y = pk2(o[c * 8 + 2] * inv, o[c * 8 + 3] * inv); w.z = pk2(o[c * 8 + 4] * inv, o[c * 8 + 5] * inv); w.w = pk2(o[c * 8 + 6] * inv, o[c * 8 + 7] * inv);
            ((v4u*)qp)[c] = w; }
    }
}


typedef float f8s __attribute__((ext_vector_type(8)));
typedef float f32x4m __attribute__((ext_vector_type(4)));
constexpr int SC_VEC = 0, SC_VS = 81920, SC_W2T = 98304, SC_A2T = 107520, SC_XCH = 116736, SC_YP = 120832, SC_A1 = SC_YP, SC_A2 = SC_YP + 9216, SC_AL = SC_YP + 18432, SC_END = SC_AL + 16640;
static_assert(SC_END <= LDS_BYTES, "scan LDS");
__device__ __forceinline__ void ld8bf(const bf16* p, float (&f)[8]) { const v4u w = *(const v4u*)p;
    f[0] = __uint_as_float(w.x << 16); f[1] = __uint_as_float(w.x & 0xffff0000u); f[2] = __uint_as_float(w.y << 16); f[3] = __uint_as_float(w.y & 0xffff0000u);
    f[4] = __uint_as_float(w.z << 16); f[5] = __uint_as_float(w.z & 0xffff0000u); f[6] = __uint_as_float(w.w << 16); f[7] = __uint_as_float(w.w & 0xffff0000u); }
__device__ __forceinline__ void shifted8(const bf16* pc, int col, bool hasp, bool hasn, const float* mu, float (&o)[8]) {
    float c[8], p[8], n[8];
    ld8bf(pc + col, c);
    if (hasp) ld8bf(pc + col - 2048, p); else { for (int e = 0; e < 8; ++e) p[e] = 0.f; }
    if (hasn) ld8bf(pc + col + 2048, n); else { for (int e = 0; e < 8; ++e) n[e] = 0.f; }
    const f4 m0 = *(const f4*)(mu + col), m1 = *(const f4*)(mu + col + 4);
    const float mm[8] = {m0.x, m0.y, m0.z, m0.w, m1.x, m1.y, m1.z, m1.w};
#pragma unroll
    for (int e = 0; e < 8; ++e) o[e] = c[e] + mm[e] * (0.5f * (p[e] + n[e]) - c[e]);
}
struct Raw3 { v4u c, p, n; };
__device__ __forceinline__ void raw_load(Raw3& r, const bf16* pc, int col, bool hasp, bool hasn) {
    r.c = *(const v4u*)(pc + col);
    r.p = hasp ? *(const v4u*)(pc + col - 2048) : (v4u){0u, 0u, 0u, 0u};
    r.n = hasn ? *(const v4u*)(pc + col + 2048) : (v4u){0u, 0u, 0u, 0u};
}
__device__ __forceinline__ void un8(const v4u w, float (&f)[8]) {
    f[0] = __uint_as_float(w.x << 16); f[1] = __uint_as_float(w.x & 0xffff0000u); f[2] = __uint_as_float(w.y << 16); f[3] = __uint_as_float(w.y & 0xffff0000u);
    f[4] = __uint_as_float(w.z << 16); f[5] = __uint_as_float(w.z & 0xffff0000u); f[6] = __uint_as_float(w.w << 16); f[7] = __uint_as_float(w.w & 0xffff0000u); }
__device__ __forceinline__ void shift_raw(const Raw3& r, const float* mu, int col, float (&o)[8]) {
    float c[8], p[8], n[8]; un8(r.c, c); un8(r.p, p); un8(r.n, n);
    const f4 m0 = *(const f4*)(mu + col), m1 = *(const f4*)(mu + col + 4);
    const float mm[8] = {m0.x, m0.y, m0.z, m0.w, m1.x, m1.y, m1.z, m1.w};
#pragma unroll
    for (int e = 0; e < 8; ++e) o[e] = c[e] + mm[e] * (0.5f * (p[e] + n[e]) - c[e]);
}
__device__ __forceinline__ void scan_fast(const Params& P, int l, unsigned char* ldsg) {
    STAGE_IDS
    unsigned char* ws = P.ws;
    const bf16* PR = (const bf16*)(ws + WS_PR); float* BONUS = (float*)(ws + WS_BONUS);
    float* VEC = (float*)(ldsg + SC_VEC);
    const int fr = lane & 15, fq = lane >> 4, ps = tid >> 3, pcg = tid & 7;
    float* XCH = (float*)(ldsg + SC_XCH); float* YP = (float*)(ldsg + SC_YP); float* VS = (float*)(ldsg + SC_VS); float* AL = (float*)(ldsg + SC_AL);
    for (int sid = blockIdx.x; sid < 256; sid += gridDim.x) {
        const int dir = sid & 1, h = (sid >> 1) & 7, b = sid >> 4, hc0 = h * 64;
        bf16* WKV = (bf16*)(ws + (dir ? WS_WKVB : WS_WKVF));
        const float* mu = P.in[I_MU] + (size_t)l * 1920;
        __syncthreads();
        {
            const float* w2b = P.in[I_W2] + (size_t)(l * 2 + dir) * 64 * 512 + (size_t)ps * 512 + hc0 + 8 * pcg;
            const float* a2b = P.in[I_A2] + (size_t)(l * 2 + dir) * 64 * 512 + (size_t)ps * 512 + hc0 + 8 * pcg;
#pragma unroll
            for (int e = 0; e < 8; ++e) { ((bf16*)(ldsg + SC_W2T))[(8 * pcg + e) * 72 + ps] = (bf16)f2bf(w2b[e]); ((bf16*)(ldsg + SC_A2T))[(8 * pcg + e) * 72 + ps] = (bf16)f2bf(a2b[e]); }
        }
        float S[8];
#pragma unroll
        for (int j = 0; j < 8; ++j) S[j] = 0.f;
        Raw3 pre[5];
#pragma unroll 1
        for (int ch = 0; ch < S_ / 64; ++ch) {
            const int step0 = ch * 64;
            const int tp = dir ? S_ - 1 - (step0 + ps) : step0 + ps;
            const int cR = hc0 + 8 * pcg, cK = 512 + hc0 + 8 * pcg, cV = 1024 + hc0 + 8 * pcg, cW = 1536 + 64 * dir + 8 * pcg, cA = 1664 + 64 * dir + 8 * pcg;
            if (ch == 0) { const bf16* pc = PR + ((size_t)(b * S_ + tp)) * 2048; const bool hasp = tp > 0, hasn = tp < S_ - 1;
                raw_load(pre[0], pc, cR, hasp, hasn); raw_load(pre[1], pc, cK, hasp, hasn); raw_load(pre[2], pc, cV, hasp, hasn); raw_load(pre[3], pc, cW, hasp, hasn); raw_load(pre[4], pc, cA, hasp, hasn); }
            float r8[8], k8[8], v8[8];
            shift_raw(pre[0], mu, cR, r8);
            shift_raw(pre[1], mu, cK, k8);
            shift_raw(pre[2], mu, cV, v8);
            { float wl[8], al[8];
              shift_raw(pre[3], mu, cW, wl);
              shift_raw(pre[4], mu, cA, al);
#pragma unroll
              for (int e = 0; e < 8; ++e) { const float t2 = __builtin_amdgcn_exp2f(2.0f * LOG2E * wl[e]); wl[e] = (t2 - 1.0f) * __builtin_amdgcn_rcpf(t2 + 1.0f); }
              v4u w1, w2v; w1.x = cvtpk(wl[0], wl[1]); w1.y = cvtpk(wl[2], wl[3]); w1.z = cvtpk(wl[4], wl[5]); w1.w = cvtpk(wl[6], wl[7]);
              w2v.x = cvtpk(al[0], al[1]); w2v.y = cvtpk(al[2], al[3]); w2v.z = cvtpk(al[4], al[5]); w2v.w = cvtpk(al[6], al[7]);
              *(v4u*)(ldsg + SC_A1 + ps * 144 + pcg * 16) = w1; *(v4u*)(ldsg + SC_A2 + ps * 144 + pcg * 16) = w2v; }
            *(f4*)(VS + ps * 64 + 8 * pcg) = (f4){v8[0], v8[1], v8[2], v8[3]}; *(f4*)(VS + ps * 64 + 8 * pcg + 4) = (f4){v8[4], v8[5], v8[6], v8[7]};
            __syncthreads();
            {
                const int wq = wave & 3; const bool isw = wave < 4;
                const unsigned char* Ab = ldsg + (isw ? SC_A1 : SC_A2) + (16 * wq + fr) * 144 + 16 * fq;
                const unsigned char* Bb = ldsg + (isw ? SC_W2T : SC_A2T) + fr * 144 + 16 * fq;
                const bf16x8_t a0 = *(const bf16x8_t*)Ab, a1 = *(const bf16x8_t*)(Ab + 64);
                const float* bias = P.in[isw ? I_W0 : I_A0] + (size_t)(l * 2 + dir) * 512 + hc0;
#pragma unroll
                for (int n = 0; n < 4; ++n) {
                    const bf16x8_t b0 = *(const bf16x8_t*)(Bb + n * 16 * 144), b1 = *(const bf16x8_t*)(Bb + n * 16 * 144 + 64);
                    f32x4m acc = (f32x4m){0.f, 0.f, 0.f, 0.f};
                    acc = __builtin_amdgcn_mfma_f32_16x16x32_bf16(a0, b0, acc, 0, 0, 0);
                    acc = __builtin_amdgcn_mfma_f32_16x16x32_bf16(a1, b1, acc, 0, 0, 0);
                    const float bz = bias[16 * n + fr];
#pragma unroll
                    for (int v = 0; v < 4; ++v) {
                        const int st = 16 * wq + 4 * fq + v; const float x = acc[v] + bz;
                        if (isw) { const float sp = __builtin_amdgcn_logf(1.0f + __builtin_amdgcn_exp2f(-x * LOG2E)) * 0.6931471805599453f;
                                   const float wlog = -sp - 0.5f; VEC[st * 320 + (2 * n + (fr >> 3)) * 40 + (fr & 7)] = __builtin_amdgcn_exp2f(-__builtin_amdgcn_exp2f(wlog * LOG2E) * LOG2E); }
                        else AL[st * 65 + 16 * n + fr] = __builtin_amdgcn_rcpf(1.0f + __builtin_amdgcn_exp2f(-x * LOG2E));
                    }
                }
            }
            __syncthreads();
            {
                const float* kkp = P.in[I_KK] + l * 512 + hc0 + 8 * pcg; const float* kap = P.in[I_KA] + l * 512 + hc0 + 8 * pcg; const float* rkp = P.in[I_RK] + l * 512 + hc0 + 8 * pcg;
                float a8[8], kk[8], kd[8]; float ss = 0.f, bon = 0.f;
#pragma unroll
                for (int e = 0; e < 8; ++e) { a8[e] = AL[ps * 65 + 8 * pcg + e]; kk[e] = k8[e] * kkp[e]; ss += kk[e] * kk[e]; kd[e] = k8[e] * (1.0f + (a8[e] - 1.0f) * kap[e]); bon += r8[e] * kd[e] * rkp[e]; }
                ss += __shfl_xor(ss, 1); ss += __shfl_xor(ss, 2); ss += __shfl_xor(ss, 4);
                bon += __shfl_xor(bon, 1); bon += __shfl_xor(bon, 2); bon += __shfl_xor(bon, 4);
                const float rn = 1.0f / fmaxf(sqrtf(ss), 1e-12f);
                float* sp = VEC + ps * 320 + 40 * pcg;
                *(f4*)(sp + 8) = (f4){kd[0], kd[1], kd[2], kd[3]}; *(f4*)(sp + 12) = (f4){kd[4], kd[5], kd[6], kd[7]};
                *(f4*)(sp + 16) = (f4){-kk[0] * rn, -kk[1] * rn, -kk[2] * rn, -kk[3] * rn}; *(f4*)(sp + 20) = (f4){-kk[4] * rn, -kk[5] * rn, -kk[6] * rn, -kk[7] * rn};
                *(f4*)(sp + 24) = (f4){kk[0] * rn * a8[0], kk[1] * rn * a8[1], kk[2] * rn * a8[2], kk[3] * rn * a8[3]}; *(f4*)(sp + 28) = (f4){kk[4] * rn * a8[4], kk[5] * rn * a8[5], kk[6] * rn * a8[6], kk[7] * rn * a8[7]};
                *(f4*)(sp + 32) = (f4){r8[0], r8[1], r8[2], r8[3]}; *(f4*)(sp + 36) = (f4){r8[4], r8[5], r8[6], r8[7]};
                if (pcg == 0) BONUS[((size_t)((dir * NB + b) * 8 + h)) * S_ + tp] = bon;
            }
            asm volatile("s_waitcnt vmcnt(0) lgkmcnt(0)" ::: "memory");
            __syncthreads();
#define DPP_FMAC(acc, xs, val, N) asm("v_fmac_f32_dpp %0, %1, %2 row_newbcast:" #N " row_mask:0xf bank_mask:0xf" : "+v"(acc) : "v"(xs), "v"(val))
#define DPP_MUL(dst, xs, val, N) asm("v_mul_f32_dpp %0, %1, %2 row_newbcast:" #N " row_mask:0xf bank_mask:0xf" : "=v"(dst) : "v"(xs), "v"(val))
            if (ch + 1 < S_ / 64) { const int tn = dir ? S_ - 1 - (step0 + 64 + ps) : step0 + 64 + ps; const bf16* pc = PR + ((size_t)(b * S_ + tn)) * 2048; const bool hasp = tn > 0, hasn = tn < S_ - 1;
                raw_load(pre[0], pc, cR, hasp, hasn); raw_load(pre[1], pc, cK, hasp, hasn); raw_load(pre[2], pc, cV, hasp, hasn); raw_load(pre[3], pc, cW, hasp, hasn); raw_load(pre[4], pc, cA, hasp, hasn); }
            const float* vecb = VEC + wave * 40 + (lane & 15);
            const int o2 = 32 + (lane & 7) - (lane & 15);
            float x0 = vecb[0], x1 = vecb[16], x2 = vecb[o2];
#pragma unroll 1
            for (int s = 0; s < 64; ++s) {
                const float* np_ = vecb + ((s + 1) & 63) * 320;
                const float n0 = np_[0], n1 = np_[16], n2 = np_[o2];
                const float v = VS[s * 64 + lane];
                asm volatile("s_nop 1" : "+v"(x0), "+v"(x1), "+v"(x2));
                float pa = 0.f, pb = 0.f;
                DPP_FMAC(pa, x1, S[0], 0); DPP_FMAC(pb, x1, S[1], 1); DPP_FMAC(pa, x1, S[2], 2); DPP_FMAC(pb, x1, S[3], 3);
                DPP_FMAC(pa, x1, S[4], 4); DPP_FMAC(pb, x1, S[5], 5); DPP_FMAC(pa, x1, S[6], 6); DPP_FMAC(pb, x1, S[7], 7);
                XCH[(s & 1) * 512 + wave * 64 + lane] = pa + pb;
                float Tt[8];
                DPP_MUL(Tt[0], x0, S[0], 0); DPP_MUL(Tt[1], x0, S[1], 1); DPP_MUL(Tt[2], x0, S[2], 2); DPP_MUL(Tt[3], x0, S[3], 3);
                DPP_MUL(Tt[4], x0, S[4], 4); DPP_MUL(Tt[5], x0, S[5], 5); DPP_MUL(Tt[6], x0, S[6], 6); DPP_MUL(Tt[7], x0, S[7], 7);
                DPP_FMAC(Tt[0], x0, v, 8); DPP_FMAC(Tt[1], x0, v, 9); DPP_FMAC(Tt[2], x0, v, 10); DPP_FMAC(Tt[3], x0, v, 11);
                DPP_FMAC(Tt[4], x0, v, 12); DPP_FMAC(Tt[5], x0, v, 13); DPP_FMAC(Tt[6], x0, v, 14); DPP_FMAC(Tt[7], x0, v, 15);
                asm volatile("s_waitcnt lgkmcnt(0)\n\ts_barrier" ::: "memory");
                const float* xp = XCH + (s & 1) * 512 + lane;
                const float sa = ((xp[0] + xp[64]) + (xp[128] + xp[192])) + ((xp[256] + xp[320]) + (xp[384] + xp[448]));
                DPP_FMAC(Tt[0], x1, sa, 8); DPP_FMAC(Tt[1], x1, sa, 9); DPP_FMAC(Tt[2], x1, sa, 10); DPP_FMAC(Tt[3], x1, sa, 11);
                DPP_FMAC(Tt[4], x1, sa, 12); DPP_FMAC(Tt[5], x1, sa, 13); DPP_FMAC(Tt[6], x1, sa, 14); DPP_FMAC(Tt[7], x1, sa, 15);
#pragma unroll
                for (int j = 0; j < 8; ++j) S[j] = Tt[j];
                float ya = 0.f, yb = 0.f;
                DPP_FMAC(ya, x2, S[0], 0); DPP_FMAC(yb, x2, S[1], 1); DPP_FMAC(ya, x2, S[2], 2); DPP_FMAC(yb, x2, S[3], 3);
                DPP_FMAC(ya, x2, S[4], 4); DPP_FMAC(yb, x2, S[5], 5); DPP_FMAC(ya, x2, S[6], 6); DPP_FMAC(yb, x2, S[7], 7);
                YP[(s & 15) * 512 + wave * 64 + lane] = ya + yb;
                x0 = n0; x1 = n1; x2 = n2;
                if ((s & 7) == 7) {
                    asm volatile("s_waitcnt lgkmcnt(0)\n\ts_barrier" ::: "memory");
                    const int sl = (s - 7) + wave;
                    const float* yp = YP + (sl & 15) * 512 + lane;
                    const float y0 = ((yp[0] + yp[64]) + (yp[128] + yp[192])) + ((yp[256] + yp[320]) + (yp[384] + yp[448]));
                    const int tt = dir ? S_ - 1 - (step0 + sl) : step0 + sl;
                    WKV[((size_t)(b * S_ + tt)) * 512 + hc0 + lane] = (bf16)f2bf(y0);
                }
            }
#undef DPP_FMAC
#undef DPP_MUL
            __syncthreads();
        }
    }
}

struct ScanRaw { float c[5], p[5], n[5]; };
__device__ __forceinline__ void scan_load(ScanRaw& R, const bf16* PR, int b, int t, const int (&cols)[5]) {
    const bf16* pc = PR + ((size_t)(b * S_ + t)) * 2048;
#pragma unroll
    for (int i = 0; i < 5; ++i) { R.c[i] = bf2f(pc[cols[i]]); R.p[i] = t > 0 ? bf2f(pc[cols[i] - 2048]) : 0.f; R.n[i] = t < S_ - 1 ? bf2f(pc[cols[i] + 2048]) : 0.f; }
}
__device__ __forceinline__ void scan_naive(const Params& P, int l, unsigned char* ldsg) {
    STAGE_IDS
    if (wave != 0) return;
    unsigned char* ws = P.ws;
    const bf16* PR = (const bf16*)(ws + WS_PR); float* BONUS = (float*)(ws + WS_BONUS);
    float* sW2 = (float*)ldsg; float* sA2 = sW2 + 4096; float* sh = sA2 + 4096; float* sv = sh + 128;
    for (int sid = blockIdx.x; sid < 256; sid += gridDim.x) {
        const int dir = sid & 1, h = (sid >> 1) & 7, b = sid >> 4, hc = h * 64 + lane;
        bf16* WKV = (bf16*)(ws + (dir ? WS_WKVB : WS_WKVF));
        const float* w2b = P.in[I_W2] + (size_t)(l * 2 + dir) * 64 * 512; const float* a2b = P.in[I_A2] + (size_t)(l * 2 + dir) * 64 * 512;
        for (int m = 0; m < 64; ++m) { sW2[m * 64 + lane] = w2b[m * 512 + hc]; sA2[m * 64 + lane] = a2b[m * 512 + hc]; }
        const float* mu = P.in[I_MU] + (size_t)l * 1920;
        const int cols[5] = {hc, 512 + hc, 1024 + hc, 1536 + 64 * dir + lane, 1664 + 64 * dir + lane};
        float mus[5];
#pragma unroll
        for (int i = 0; i < 5; ++i) mus[i] = mu[cols[i]];
        const float w0c = P.in[I_W0][(size_t)(l * 2 + dir) * 512 + hc], a0c = P.in[I_A0][(size_t)(l * 2 + dir) * 512 + hc];
        const float kkc = P.in[I_KK][l * 512 + hc], kac = P.in[I_KA][l * 512 + hc], rkc = P.in[I_RK][l * 512 + hc];
        float S[64];
#pragma unroll
        for (int j = 0; j < 64; ++j) S[j] = 0.f;
        ScanRaw cur, nxt;
        scan_load(cur, PR, b, dir ? S_ - 1 : 0, cols);
        for (int step = 0; step < S_; ++step) {
            const int t = dir ? S_ - 1 - step : step;
            if (step + 1 < S_) scan_load(nxt, PR, b, dir ? t - 1 : t + 1, cols); else nxt = cur;
            float sx[5];
#pragma unroll
            for (int i = 0; i < 5; ++i) sx[i] = cur.c[i] + mus[i] * (0.5f * (cur.p[i] + cur.n[i]) - cur.c[i]);
            const float r = sx[0], k = sx[1], v = sx[2];
            sh[lane] = tanhf(sx[3]); sh[64 + lane] = sx[4];
            float wlin = w0c, alin = a0c;
#pragma unroll 8
            for (int m = 0; m < 64; ++m) { wlin += sh[m] * sW2[m * 64 + lane]; alin += sh[64 + m] * sA2[m * 64 + lane]; }
            const float wlog = -log1pf(expf(-wlin)) - 0.5f;
            const float decay = expf(-expf(wlog));
            const float a = 1.0f / (1.0f + expf(-alin));
            float kkv = k * kkc; const float nrm = sqrtf(wave_sum(kkv * kkv)); kkv = kkv / fmaxf(nrm, 1e-12f);
            const float kd = k * (1.0f + (a - 1.0f) * kac);
            const float bon = wave_sum(r * kd * rkc);
            if (lane == 0) BONUS[((size_t)((dir * NB + b) * 8 + h)) * S_ + t] = bon;
            sv[lane] = decay; sv[64 + lane] = kd; sv[128 + lane] = -kkv; sv[192 + lane] = kkv * a; sv[256 + lane] = r;
            float sa = 0.f;
#pragma unroll
            for (int j = 0; j < 64; ++j) sa += S[j] * sv[128 + j];
            float y = 0.f;
#pragma unroll
            for (int j = 0; j < 64; ++j) { S[j] = S[j] * sv[j] + sa * sv[192 + j] + v * sv[64 + j]; y += S[j] * sv[256 + j]; }
            WKV[((size_t)(b * S_ + t)) * 512 + hc] = (bf16)f2bf(y);
            cur = nxt;
        }
    }
}


__device__ __forceinline__ void finalize_fast(const Params& P, int l, unsigned char* ldsg) {
    STAGE_IDS
    unsigned char* ws = P.ws;
    const bf16* PR = (const bf16*)(ws + WS_PR); const bf16* WF = (const bf16*)(ws + WS_WKVF); const bf16* WBk = (const bf16*)(ws + WS_WKVB); const float* BONUS = (const float*)(ws + WS_BONUS);
    bf16* YA = (bf16*)(ws + WS_YA);
    const int fr = lane & 15, fq = lane >> 4;
    const float* mu = P.in[I_MU] + (size_t)l * 1920; const float* g2 = P.in[I_G2] + (size_t)l * 128 * 512;
    const float* lngp = P.in[I_LNG] + l * 512; const float* lnbp = P.in[I_LNB] + l * 512;
    bf16x8_t gf[4][4];
#pragma unroll
    for (int n = 0; n < 4; ++n)
#pragma unroll
        for (int ks = 0; ks < 4; ++ks) { float gv[8];
#pragma unroll
            for (int e = 0; e < 8; ++e) gv[e] = g2[(size_t)(32 * ks + 8 * fq + e) * 512 + 64 * wave + 16 * n + fr];
            const v4u w = (v4u){cvtpk(gv[0], gv[1]), cvtpk(gv[2], gv[3]), cvtpk(gv[4], gv[5]), cvtpk(gv[6], gv[7])};
            gf[n][ks] = __builtin_bit_cast(bf16x8_t, w); }
    for (int tile = blockIdx.x; tile < T_ / 32; tile += gridDim.x) {
        const int t0 = tile * 32;
        __syncthreads();
        { const int tok = tid >> 4, mg = tid & 15, t = t0 + tok, s = t & 2047; float x[8];
          shifted8(PR + (size_t)t * 2048, 1792 + 8 * mg, s > 0, s < S_ - 1, mu, x);
#pragma unroll
          for (int e = 0; e < 8; ++e) x[e] = __builtin_amdgcn_rcpf(1.0f + __builtin_amdgcn_exp2f(-x[e] * LOG2E));
          *(v4u*)(ldsg + tok * 272 + mg * 16) = (v4u){cvtpk(x[0], x[1]), cvtpk(x[2], x[3]), cvtpk(x[4], x[5]), cvtpk(x[6], x[7])}; }
        __syncthreads();
#pragma unroll
        for (int mt = 0; mt < 2; ++mt) {
            f32x4m acc[4];
#pragma unroll
            for (int n = 0; n < 4; ++n) acc[n] = (f32x4m){0.f, 0.f, 0.f, 0.f};
#pragma unroll
            for (int ks = 0; ks < 4; ++ks) { const bf16x8_t bb = *(const bf16x8_t*)(ldsg + (16 * mt + fr) * 272 + (32 * ks + 8 * fq) * 2);
#pragma unroll
                for (int n = 0; n < 4; ++n) acc[n] = __builtin_amdgcn_mfma_f32_16x16x32_bf16(gf[n][ks], bb, acc[n], 0, 0, 0); }
            const int t = t0 + 16 * mt + fr, s = t & 2047, bb_ = t >> 11;
            float wk[4][4]; float sm = 0.f;
#pragma unroll
            for (int n = 0; n < 4; ++n) { const int c0 = 64 * wave + 16 * n + 4 * fq;
                const v2u a = *(const v2u*)(WF + (size_t)t * 512 + c0), b2 = *(const v2u*)(WBk + (size_t)t * 512 + c0);
                wk[n][0] = __uint_as_float(a.x << 16) + __uint_as_float(b2.x << 16); wk[n][1] = __uint_as_float(a.x & 0xffff0000u) + __uint_as_float(b2.x & 0xffff0000u);
                wk[n][2] = __uint_as_float(a.y << 16) + __uint_as_float(b2.y << 16); wk[n][3] = __uint_as_float(a.y & 0xffff0000u) + __uint_as_float(b2.y & 0xffff0000u);
                sm += (wk[n][0] + wk[n][1]) + (wk[n][2] + wk[n][3]); }
            sm += __shfl_xor(sm, 16); sm += __shfl_xor(sm, 32);
            const float mean = sm * (1.0f / 64.0f); float sq = 0.f;
#pragma unroll
            for (int n = 0; n < 4; ++n)
#pragma unroll
                for (int v = 0; v < 4; ++v) { wk[n][v] -= mean; sq += wk[n][v] * wk[n][v]; }
            sq += __shfl_xor(sq, 16); sq += __shfl_xor(sq, 32);
            const float rstd = 1.0f / sqrtf(sq * (1.0f / 64.0f) + 64e-5f);
            const float bon = BONUS[((size_t)(bb_ * 8 + wave)) * S_ + s] + BONUS[((size_t)((NB + bb_) * 8 + wave)) * S_ + s];
            const bf16* pc = PR + (size_t)t * 2048;
#pragma unroll
            for (int n = 0; n < 4; ++n) { const int c0 = 64 * wave + 16 * n + 4 * fq;
                const f4 lg = *(const f4*)(lngp + c0), lb = *(const f4*)(lnbp + c0), mv = *(const f4*)(mu + 1024 + c0);
                const v2u vc = *(const v2u*)(pc + 1024 + c0);
                v2u vp = (v2u){0u, 0u}, vn = (v2u){0u, 0u};
                if (s > 0) vp = *(const v2u*)(pc + 1024 + c0 - 2048);
                if (s < S_ - 1) vn = *(const v2u*)(pc + 1024 + c0 + 2048);
                const float cc[4] = {__uint_as_float(vc.x << 16), __uint_as_float(vc.x & 0xffff0000u), __uint_as_float(vc.y << 16), __uint_as_float(vc.y & 0xffff0000u)};
                const float pp[4] = {__uint_as_float(vp.x << 16), __uint_as_float(vp.x & 0xffff0000u), __uint_as_float(vp.y << 16), __uint_as_float(vp.y & 0xffff0000u)};
                const float nn[4] = {__uint_as_float(vn.x << 16), __uint_as_float(vn.x & 0xffff0000u), __uint_as_float(vn.y << 16), __uint_as_float(vn.y & 0xffff0000u)};
                float yv[4];
#pragma unroll
                for (int v = 0; v < 4; ++v) { const float vs = cc[v] + mv[v] * (0.5f * (pp[v] + nn[v]) - cc[v]);
                    yv[v] = (wk[n][v] * rstd * lg[v] + lb[v] + bon * vs) * acc[n][v]; }
                *(v2u*)(YA + (size_t)t * 512 + c0) = (v2u){cvtpk(yv[0], yv[1]), cvtpk(yv[2], yv[3])}; }
        }
    }
}

__device__ __forceinline__ void finalize_naive(const Params& P, int l, unsigned char* ldsg) {
    STAGE_IDS
    unsigned char* ws = P.ws;
    const bf16* PR = (const bf16*)(ws + WS_PR); const bf16* WF = (const bf16*)(ws + WS_WKVF); const bf16* WBk = (const bf16*)(ws + WS_WKVB); const float* BONUS = (const float*)(ws + WS_BONUS);
    bf16* YA = (bf16*)(ws + WS_YA);
    float* sg = (float*)ldsg;
    const float* mu = P.in[I_MU] + (size_t)l * 1920; const float* g2 = P.in[I_G2] + (size_t)l * 128 * 512;
    const float lng = P.in[I_LNG][l * 512 + tid], lnb = P.in[I_LNB][l * 512 + tid];
    const float mu_v = mu[1024 + tid], mu_g = tid < 128 ? mu[1792 + tid] : 0.f;
    for (int t = blockIdx.x; t < T_; t += gridDim.x) {
        const int s = t & 2047; const bf16* pc = PR + (size_t)t * 2048;
        if (tid < 128) { const int col = 1792 + tid; const float c = bf2f(pc[col]), p = s > 0 ? bf2f(pc[col - 2048]) : 0.f, n = s < S_ - 1 ? bf2f(pc[col + 2048]) : 0.f;
            const float x = c + mu_g * (0.5f * (p + n) - c); sg[tid] = 1.0f / (1.0f + expf(-x)); }
        __syncthreads();
        float gate = 0.f;
#pragma unroll 8
        for (int m = 0; m < 128; ++m) gate += sg[m] * g2[m * 512 + tid];
        const float wkv = bf2f(WF[(size_t)t * 512 + tid]) + bf2f(WBk[(size_t)t * 512 + tid]);
        const float mean = wave_sum(wkv) * (1.0f / 64.0f); const float dv = wkv - mean; const float var = wave_sum(dv * dv) * (1.0f / 64.0f);
        float y = dv * (1.0f / sqrtf(var + 64e-5f)) * lng + lnb;
        { const int col = 1024 + tid; const float c = bf2f(pc[col]), p = s > 0 ? bf2f(pc[col - 2048]) : 0.f, n = s < S_ - 1 ? bf2f(pc[col + 2048]) : 0.f;
          const float vs = c + mu_v * (0.5f * (p + n) - c); const int h = tid >> 6;
          const int b = t >> 11; y += (BONUS[((size_t)(b * 8 + h)) * S_ + s] + BONUS[((size_t)((NB + b) * 8 + h)) * S_ + s]) * vs; }
        YA[(size_t)t * 512 + tid] = (bf16)f2bf(y * gate);
        __syncthreads();
    }
}

#ifndef DBG_NL
#define DBG_NL NL
#endif
#ifndef DBG_BR
#define DBG_BR 7
#endif
#ifndef DBG_STOP
#define DBG_STOP 0
#endif
#define L1_INVALIDATE() do { asm volatile("s_waitcnt vmcnt(0)" ::: "memory"); __builtin_amdgcn_fence(__ATOMIC_ACQUIRE, "agent"); asm volatile("s_waitcnt vmcnt(0)" ::: "memory"); } while (0)
#define GRID_SYNC_CG() do { asm volatile("s_waitcnt vmcnt(0) lgkmcnt(0)" ::: "memory"); grid.sync(); __builtin_amdgcn_fence(__ATOMIC_ACQUIRE, "agent"); asm volatile("s_waitcnt vmcnt(0)" ::: "memory"); } while (0)
#define GRID_SYNC() grid_barrier(gbar, ground)
#define GEMM_PHASE(EPI, A_, Bt_, M_, N_, K_, E_) do { pg8::Gemm g_{(const pg8::bf16_t*)(A_), (const pg8::bf16_t*)(Bt_), (M_), (N_), (K_)}; pg8::StaticOrder S_o; S_o.init((M_), (N_), (int)gridDim.x, (int)blockIdx.x); \
    pg8::gemm_phase<EPI, pg8::StaticOrder, true, true>((PG8_LAS unsigned char*)lds, g_, S_o, (E_)); } while (0)

__device__ __forceinline__ void grid_barrier(unsigned* bar, unsigned& round) {
    asm volatile("s_waitcnt vmcnt(0) lgkmcnt(0)" ::: "memory");
    __syncthreads();
    ++round;
    if (threadIdx.x == 0) {
        __builtin_amdgcn_fence(__ATOMIC_RELEASE, "agent");
        asm volatile("s_waitcnt vmcnt(0)" ::: "memory");
        const unsigned g = blockIdx.x & 7u, G = gridDim.x, ng = (G + 7u - g) >> 3, ngroups = G < 8u ? G : 8u;
        const unsigned old = __hip_atomic_fetch_add(bar + 64 * (1 + g), 1u, __ATOMIC_RELAXED, __HIP_MEMORY_SCOPE_AGENT);
        if (old + 1u == round * ng) {
            const unsigned old2 = __hip_atomic_fetch_add(bar + 64 * 9, 1u, __ATOMIC_RELAXED, __HIP_MEMORY_SCOPE_AGENT);
            if (old2 + 1u == round * ngroups) __hip_atomic_store(bar, round, __ATOMIC_RELAXED, __HIP_MEMORY_SCOPE_AGENT);
        }
        unsigned spins = 0;
        while (__hip_atomic_load(bar, __ATOMIC_RELAXED, __HIP_MEMORY_SCOPE_AGENT) < round) { __builtin_amdgcn_s_sleep(1); if (++spins > (1u << 24)) break; }
        __builtin_amdgcn_fence(__ATOMIC_ACQUIRE, "agent");
        asm volatile("s_waitcnt vmcnt(0)" ::: "memory");
    }
    __syncthreads();
}
#ifdef TPROBE
#define TP_DECL unsigned long long tp_acc[4] = {0, 0, 0, 0}, tp_t0 = 0;
#define TP_BEGIN() do { tp_t0 = __builtin_amdgcn_s_memrealtime(); } while (0)
#define TP_END(k) do { tp_acc[k] += __builtin_amdgcn_s_memrealtime() - tp_t0; } while (0)
#else
#define TP_DECL
#define TP_BEGIN() do {} while (0)
#define TP_END(k) do {} while (0)
#endif
__global__ void __launch_bounds__(NTHREADS, 2) fwd_kernel(Params P) {
    extern __shared__ __attribute__((aligned(16))) unsigned char lds[];
    cg::grid_group grid = cg::this_grid();
    unsigned char* ws = P.ws;
    bf16* H = (bf16*)(ws + WS_H); bf16* ACT = (bf16*)(ws + WS_ACT);
    TP_DECL
#ifdef DBG_HA
    bf16* HA = (bf16*)(ws + WS_QC);
#else
    bf16* HA = H;
#endif
    float* SSB = (float*)(ws + WS_SS);
    unsigned* gbar = (unsigned*)(ws + WS_BAR); unsigned ground = 0;
    cvt_up1(P, 0, lds);
    x_to_bf16_ss(P.in[I_X], H, SSB);
    GRID_SYNC_CG();
#pragma unroll 1
    for (int l = 0; l < DBG_NL; ++l) {
        const float* xin = (l == 0) ? P.in[I_X] : P.out;
        cvt_rest(P, l, lds);
        __syncthreads();
        { pg8::EpiSwiglu E{(pg8::bf16_t*)ACT, FF, SSB}; GEMM_PHASE(pg8::EpiSwiglu, H, ws + ((l & 1) ? WS_WUP1B : WS_WUP1), T_, 2 * FF, DM, E); }
        GRID_SYNC();
        { pg8::EpiResid E{xin, P.out, DM, 0.5f, (pg8::bf16_t*)H, SSB}; GEMM_PHASE(pg8::EpiResid, ACT, ws + WS_WDN1, T_, DM, FF, E); }
        GRID_SYNC();
        { pg8::EpiWin E{(pg8::bf16_t*)(ws + WS_PR), (pg8::bf16_t*)(ws + WS_QB), (pg8::bf16_t*)(ws + WS_KVB), (pg8::bf16_t*)(ws + WS_QC), (pg8::bf16_t*)(ws + WS_KVC), SSB};
          GEMM_PHASE(pg8::EpiWin, H, ws + WS_WIN, T_, 3584, DM, E); }
        GRID_SYNC();
#ifdef DUP_SYNC
        GRID_SYNC(); GRID_SYNC(); GRID_SYNC(); GRID_SYNC(); GRID_SYNC(); GRID_SYNC(); GRID_SYNC(); GRID_SYNC();
#endif
        qkprep(P, l);
        vt_prep(P, lds);
        __syncthreads();
        scan_fast(P, l, lds);
#ifdef DUP_SCAN
        __syncthreads();
        scan_fast(P, l, lds);
#endif
#ifdef DUP_PREP
        __syncthreads();
        vt_prep(P, lds);
#endif
        GRID_SYNC();
#ifdef DUP_ATTN
        attn_mfma<false>((bf16*)(ws + WS_QB), (const bf16*)(ws + WS_KG), (const bf16*)(ws + WS_VG), nullptr, lds, (bf16*)(ws + WS_YA));
        attn_mfma<true>((bf16*)(ws + WS_QC), (const bf16*)(ws + WS_KW), (const bf16*)(ws + WS_VW), P.in[I_SINK] + l * 8, lds, (bf16*)(ws + WS_YA));
#endif
        attn_mfma<false>((bf16*)(ws + WS_QB), (const bf16*)(ws + WS_KG), (const bf16*)(ws + WS_VG), nullptr, lds);
        attn_mfma<true>((bf16*)(ws + WS_QC), (const bf16*)(ws + WS_KW), (const bf16*)(ws + WS_VW), P.in[I_SINK] + l * 8, lds);
        __syncthreads();
        finalize_fast(P, l, lds);
#ifdef DUP_FIN
        finalize_fast(P, l, lds);
#endif
        GRID_SYNC();
#pragma unroll 1
        for (int i = 0; i < 3; ++i) {
            { pg8::EpiGate E{(pg8::bf16_t*)(ws + WS_GATE), SSB}; GEMM_PHASE(pg8::EpiGate, H, ws + WS_WG + (size_t)i * DM * DM * 2, T_, DM, DM, E); }
            const unsigned char* yi = ws + (i == 0 ? WS_YA : (i == 1 ? WS_QB : WS_QC));
            { pg8::EpiMerge E{(const pg8::bf16_t*)(ws + WS_GATE), (pg8::bf16_t*)(ws + WS_MERGED), i == 0 ? 1 : 0}; GEMM_PHASE(pg8::EpiMerge, yi, ws + WS_WO + (size_t)i * DM * 512 * 2, T_, DM, 512, E); }
        }
        GRID_SYNC();
        { pg8::EpiResid E{P.out, P.out, DM, 1.0f, (pg8::bf16_t*)H, SSB}; GEMM_PHASE(pg8::EpiResid, ws + WS_MERGED, ws + WS_WOUT, T_, DM, DM, E); }
        GRID_SYNC();
        { pg8::EpiSwiglu E{(pg8::bf16_t*)ACT, FF, SSB}; GEMM_PHASE(pg8::EpiSwiglu, H, ws + WS_WUP2, T_, 2 * FF, DM, E); }
#ifdef DUP_UP
        { pg8::EpiSwiglu E{(pg8::bf16_t*)ACT, FF, SSB}; GEMM_PHASE(pg8::EpiSwiglu, H, ws + WS_WUP2, T_, 2 * FF, DM, E); }
#endif
        GRID_SYNC();
        if (l + 1 < NL) { cvt_up1(P, l + 1, lds); __syncthreads(); }
        { pg8::EpiResid E{P.out, P.out, DM, 0.5f, (pg8::bf16_t*)H, SSB}; GEMM_PHASE(pg8::EpiResid, ACT, ws + WS_WDN2, T_, DM, FF, E); }
        GRID_SYNC();
    }
    rms_rows_f32_inplace(P.out, P.in[I_FINN]);
#ifdef TPROBE
    {
        float* tpw = (float*)(ws + WS_SCR);
        GRID_SYNC();
        if (blockIdx.x == 0 && threadIdx.x == 0) { tpw[0] = (float)tp_acc[TPROBE_A] * 0.01f; tpw[1] = (float)tp_acc[TPROBE_B] * 0.01f; }
        GRID_SYNC();
        const float ta = tpw[0], tb = tpw[1];
        const int gt = blockIdx.x * NTHREADS + threadIdx.x;
        for (int i = gt; i < (1 << 20); i += gridDim.x * NTHREADS) P.out[i] = tb * 0.01f;
        if (gt == 0) P.out[1 << 21] = ta * 0.1f;
    }
#endif
}

extern "C" void kernel_launch(void* const* d_in, const int* in_sizes, int n_in, void* d_out, int out_size, void* d_ws, size_t ws_size, hipStream_t stream) {
    static int grid_blocks = 0;
    if (grid_blocks == 0) {
        if (n_in != N_IN || out_size != T_ * DM || ws_size < WS_END) { fprintf(stderr, "kernel_launch: unexpected shapes (n_in %d, out %d, ws %zu < %zu)\n", n_in, out_size, ws_size, (size_t)WS_END); grid_blocks = -1; return; }
        int dev = 0, cus = 0, per_cu = 0;
        hipGetDevice(&dev);
        hipDeviceGetAttribute(&cus, hipDeviceAttributeMultiprocessorCount, dev);
        hipFuncSetAttribute((const void*)fwd_kernel, hipFuncAttributeMaxDynamicSharedMemorySize, LDS_BYTES);
        hipOccupancyMaxActiveBlocksPerMultiprocessor(&per_cu, (const void*)fwd_kernel, NTHREADS, LDS_BYTES);
        if (per_cu < 1) per_cu = 1;
        grid_blocks = cus * per_cu;
    }
    if (grid_blocks < 0) return;
    Params p{};
    for (int i = 0; i < N_IN; ++i) p.in[i] = (const float*)d_in[i];
    p.out = (float*)d_out; p.ws = (unsigned char*)d_ws;
    if (hipMemsetAsync((char*)d_ws + WS_BAR, 0, 4096, stream) != hipSuccess) { fprintf(stderr, "kernel_launch: hipMemsetAsync failed\n"); return; }
    void* args[] = {&p};
    hipError_t e = hipLaunchCooperativeKernel((const void*)fwd_kernel, dim3(grid_blocks), dim3(NTHREADS), args, LDS_BYTES, stream);
    if (e != hipSuccess) fprintf(stderr, "cooperative launch failed: %s (grid %d)\n", hipGetErrorString(e), grid_blocks);
}
```

```cpp
#include <hip/hip_runtime.h>
#include <hip/hip_cooperative_groups.h>
#include <cstdio>
#include <cstdint>
namespace cg = cooperative_groups;
namespace pg8 {
#define PG8_LAS __attribute__((address_space(3)))
typedef unsigned short bf16_t;
typedef short bf16x8 __attribute__((ext_vector_type(8)));
typedef float f32x4 __attribute__((ext_vector_type(4)));
typedef unsigned u32x4 __attribute__((ext_vector_type(4)));
constexpr int BM = 256, BK = 64, HALF = 128, HTB = HALF * BK * 2  , STAGE_BYTES = 8 * HTB, NXCD = 8, WGM = 8;

__host__ __device__ __forceinline__ int lds_byte(int r, int c) { const int st = (r >> 4) * 2 + (c >> 5), rr = r & 15, cc = c & 31, ob = rr * 64 + cc * 2; return st * 1024 + (ob ^ (((ob >> 9) & 1) << 5)); }
__host__ __device__ __forceinline__ void stage_rc(int b, int& R, int& C) { const int st = b / 1024, sb = b % 1024, swz = sb ^ (((sb >> 9) & 1) << 5); R = (st >> 1) * 16 + swz / 64; C = (st & 1) * 32 + (swz % 64) / 2; }
__host__ __device__ __forceinline__ int perm32(int rho) { const int n = rho >> 4, i = rho & 15; return 8 * (i >> 2) + 4 * n + (i & 3); }

struct Unit { int pm, pn; };
struct Gemm { const bf16_t* A; const bf16_t* Bt; int M, N, K; };

struct StaticOrder {
    int nM, nN, nwg, G, c;
    __host__ __device__ void init(int M, int N, int G_, int c_) { nM = M / BM; nN = N / BM; nwg = nM * nN; G = G_; c = c_; }
    __host__ __device__ bool next(int i, Unit& u) const {
        const long L = (long)i * G + c; if (L >= nwg) return false;
        int wgid = (int)L; { const int q = nwg / NXCD, r = nwg % NXCD, xcd = wgid % NXCD, off = wgid / NXCD; wgid = (xcd < r ? xcd * (q + 1) : r * (q + 1) + (xcd - r) * q) + off; }
        const int nig = WGM * nN, gid = wgid / nig, fm = gid * WGM, gsz = (nM - fm) < WGM ? (nM - fm) : WGM;
        u.pm = fm + ((wgid % nig) % gsz); u.pn = (wgid % nig) / gsz; return true;
    }
    __device__ __forceinline__ void a_ready(const Unit&) const {}
    __device__ __forceinline__ void done(const Unit&) const {}
};
typedef float f32x2_t __attribute__((ext_vector_type(2))); typedef __bf16 bf16x2_t __attribute__((ext_vector_type(2)));
__device__ __forceinline__ unsigned cvt_pk_bf16(float lo, float hi) { f32x2_t v = {lo, hi}; bf16x2_t b = __builtin_convertvector(v, bf16x2_t); return __builtin_bit_cast(unsigned, b); }
typedef float f32x2 __attribute__((ext_vector_type(2)));
__device__ __forceinline__ float fast_sigmoid(float x) { return __builtin_amdgcn_rcpf(1.0f + __builtin_amdgcn_exp2f(-1.4426950408889634f * x)); }
__device__ __forceinline__ u32x4 ld16_agent(const bf16_t* p) { const unsigned long long a = __hip_atomic_load((const unsigned long long*)p, __ATOMIC_RELAXED, __HIP_MEMORY_SCOPE_AGENT), b = __hip_atomic_load((const unsigned long long*)p + 1, __ATOMIC_RELAXED, __HIP_MEMORY_SCOPE_AGENT); u32x4 r; r.x = (unsigned)a; r.y = (unsigned)(a >> 32); r.z = (unsigned)b; r.w = (unsigned)(b >> 32); return r; }
__device__ __forceinline__ float bf_lo(unsigned w) { return __uint_as_float(w << 16); }
__device__ __forceinline__ float bf_hi(unsigned w) { return __uint_as_float(w & 0xffff0000u); }

__device__ __forceinline__ float row_rs(const float* SS, int row) { const f32x4 a = *(const f32x4*)(SS + (size_t)row * 16), b2 = *(const f32x4*)(SS + (size_t)row * 16 + 4), c2 = *(const f32x4*)(SS + (size_t)row * 16 + 8), d = *(const f32x4*)(SS + (size_t)row * 16 + 12);
    const float s = ((a[0] + a[1]) + (a[2] + a[3])) + ((b2[0] + b2[1]) + (b2[2] + b2[3])) + ((c2[0] + c2[1]) + (c2[2] + c2[3])) + ((d[0] + d[1]) + (d[2] + d[3]));
    return 1.0f / sqrtf(s * (1.0f / 1024.0f) + 1e-6f); }
struct EpiSwiglu {
    static constexpr bool PERM = true, AFTER_DRAIN = false;
    bf16_t* O; int ldc; const float* SS;
    __device__ __forceinline__ void operator()(const f32x4 (&acc)[2][2][4][2], const Unit& u, int wr, int wc, int fr, int fq) const {
        const int row0 = u.pm * BM + wr * 64 + fr, col0 = u.pn * HALF + wc * 32 + 8 * fq;
#pragma unroll
        for (int ai = 0; ai < 2; ++ai)
#pragma unroll
            for (int m = 0; m < 4; ++m) {
                bf16_t* rowp = O + (size_t)(row0 + ai * HALF + m * 16) * ldc + col0;
                const float rs = row_rs(SS, row0 + ai * HALF + m * 16);
                float v[8];
#pragma unroll
                for (int n = 0; n < 2; ++n)
#pragma unroll
                    for (int j = 0; j < 4; ++j) { const float g = acc[ai][0][m][n][j] * rs, up = acc[ai][1][m][n][j] * rs; v[n * 4 + j] = g * fast_sigmoid(g) * up; }
                u32x4 w; w.x = cvt_pk_bf16(v[0], v[1]); w.y = cvt_pk_bf16(v[2], v[3]); w.z = cvt_pk_bf16(v[4], v[5]); w.w = cvt_pk_bf16(v[6], v[7]);
                *(u32x4*)rowp = w;
            }
    }
};
struct EpiResid {
    static constexpr bool PERM = false, AFTER_DRAIN = false;
    const float* src; float* dst; int ldc; float scale; bf16_t* XB; float* SS;
    __device__ __forceinline__ void operator()(const f32x4 (&acc)[2][2][4][2], const Unit& u, int wr, int wc, int fr, int fq) const {
        const int col0 = u.pn * BM + wc * 32 + 4 * fq;
#pragma unroll
        for (int ai = 0; ai < 2; ++ai)
#pragma unroll
            for (int m = 0; m < 4; ++m) {
                const int row = u.pm * BM + ai * HALF + wr * 64 + m * 16 + fr;
                const size_t off = (size_t)row * ldc + col0; float sq = 0.f;
#pragma unroll
                for (int bj = 0; bj < 2; ++bj)
#pragma unroll
                    for (int n = 0; n < 2; ++n) { const f32x4 b = *(const f32x4*)(src + off + bj * HALF + n * 16); const f32x4 x = b + acc[ai][bj][m][n] * scale;
                        *(f32x4*)(dst + off + bj * HALF + n * 16) = x; sq += (x[0] * x[0] + x[1] * x[1]) + (x[2] * x[2] + x[3] * x[3]);
                        typedef unsigned u32x2 __attribute__((ext_vector_type(2)));
                        *(u32x2*)(XB + off + bj * HALF + n * 16) = (u32x2){cvt_pk_bf16(x[0], x[1]), cvt_pk_bf16(x[2], x[3])}; }
                sq += __shfl_xor(sq, 16); sq += __shfl_xor(sq, 32);
                if (fq == 0) SS[(size_t)row * 16 + u.pn * 4 + wc] = sq;
            }
    }
};
struct EpiWin {
    static constexpr bool PERM = true, AFTER_DRAIN = false;
    bf16_t *PR, *QB, *KVB, *QC, *KVC; const float* SS;
    __device__ __forceinline__ void operator()(const f32x4 (&acc)[2][2][4][2], const Unit& u, int wr, int wc, int fr, int fq) const {
        bf16_t* base; int ldc, colt;
        const int pn = u.pn;
        if (pn < 8) { base = PR; ldc = 2048; colt = pn * 256; }
        else if (pn < 10) { base = QB; ldc = 512; colt = (pn - 8) * 256; }
        else if (pn == 10) { base = KVB; ldc = 256; colt = 0; }
        else if (pn < 13) { base = QC; ldc = 512; colt = (pn - 11) * 256; }
        else { base = KVC; ldc = 256; colt = 0; }
        const int row0 = u.pm * BM + wr * 64 + fr, col0 = colt + wc * 32 + 8 * fq;
#pragma unroll
        for (int ai = 0; ai < 2; ++ai)
#pragma unroll
            for (int m = 0; m < 4; ++m) {
                bf16_t* rowp = base + (size_t)(row0 + ai * HALF + m * 16) * ldc + col0;
                const float rs = row_rs(SS, row0 + ai * HALF + m * 16);
#pragma unroll
                for (int bj = 0; bj < 2; ++bj) { const f32x4 v0 = acc[ai][bj][m][0] * rs, v1 = acc[ai][bj][m][1] * rs;
                    u32x4 w; w.x = cvt_pk_bf16(v0[0], v0[1]); w.y = cvt_pk_bf16(v0[2], v0[3]); w.z = cvt_pk_bf16(v1[0], v1[1]); w.w = cvt_pk_bf16(v1[2], v1[3]);
                    *(u32x4*)(rowp + bj * HALF) = w; }
            }
    }
};
struct EpiGate {
    static constexpr bool PERM = true, AFTER_DRAIN = false;
    bf16_t* G; const float* SS;
    __device__ __forceinline__ void operator()(const f32x4 (&acc)[2][2][4][2], const Unit& u, int wr, int wc, int fr, int fq) const {
        const int row0 = u.pm * BM + wr * 64 + fr, col0 = u.pn * BM + wc * 32 + 8 * fq;
#pragma unroll
        for (int ai = 0; ai < 2; ++ai)
#pragma unroll
            for (int m = 0; m < 4; ++m) {
                bf16_t* rowp = G + (size_t)(row0 + ai * HALF + m * 16) * 1024 + col0;
                const float rs = row_rs(SS, row0 + ai * HALF + m * 16);
#pragma unroll
                for (int bj = 0; bj < 2; ++bj) { const f32x4 v0 = acc[ai][bj][m][0] * rs, v1 = acc[ai][bj][m][1] * rs;
                    u32x4 w; w.x = cvt_pk_bf16(fast_sigmoid(v0[0]), fast_sigmoid(v0[1])); w.y = cvt_pk_bf16(fast_sigmoid(v0[2]), fast_sigmoid(v0[3]));
                    w.z = cvt_pk_bf16(fast_sigmoid(v1[0]), fast_sigmoid(v1[1])); w.w = cvt_pk_bf16(fast_sigmoid(v1[2]), fast_sigmoid(v1[3]));
#ifdef DBG_GCONST
                    w = (u32x4){0x3f003f00u, 0x3f003f00u, 0x3f003f00u, 0x3f003f00u};
#endif
                    *(u32x4*)(rowp + bj * HALF) = w; }
            }
    }
};
struct EpiMerge {
    static constexpr bool PERM = true, AFTER_DRAIN = false;
    const bf16_t* G; bf16_t* Mg; int first;
    __device__ __forceinline__ void operator()(const f32x4 (&acc)[2][2][4][2], const Unit& u, int wr, int wc, int fr, int fq) const {
        const int row0 = u.pm * BM + wr * 64 + fr, col0 = u.pn * BM + wc * 32 + 8 * fq;
#pragma unroll
        for (int ai = 0; ai < 2; ++ai)
#pragma unroll
            for (int m = 0; m < 4; ++m) {
                const size_t off = (size_t)(row0 + ai * HALF + m * 16) * 1024 + col0;
#pragma unroll
                for (int bj = 0; bj < 2; ++bj) { const f32x4 v0 = acc[ai][bj][m][0], v1 = acc[ai][bj][m][1];
#ifdef DBG_NOG
                    const u32x4 g = (u32x4){0x3f803f80u, 0x3f803f80u, 0x3f803f80u, 0x3f803f80u};
#else
                    const u32x4 g = __builtin_nontemporal_load((const u32x4*)(G + off + bj * HALF));
#endif
                    float r[8];
                    r[0] = bf_lo(g.x) * v0[0]; r[1] = bf_hi(g.x) * v0[1]; r[2] = bf_lo(g.y) * v0[2]; r[3] = bf_hi(g.y) * v0[3];
                    r[4] = bf_lo(g.z) * v1[0]; r[5] = bf_hi(g.z) * v1[1]; r[6] = bf_lo(g.w) * v1[2]; r[7] = bf_hi(g.w) * v1[3];
#ifdef DBG_NOG
                    if (false) { const u32x4 p = __builtin_nontemporal_load((const u32x4*)(Mg + off + bj * HALF));
#else
                    if (!first) { const u32x4 p = __builtin_nontemporal_load((const u32x4*)(Mg + off + bj * HALF));
#endif
                        r[0] += bf_lo(p.x); r[1] += bf_hi(p.x); r[2] += bf_lo(p.y); r[3] += bf_hi(p.y); r[4] += bf_lo(p.z); r[5] += bf_hi(p.z); r[6] += bf_lo(p.w); r[7] += bf_hi(p.w); }
                    u32x4 w; w.x = cvt_pk_bf16(r[0], r[1]); w.y = cvt_pk_bf16(r[2], r[3]); w.z = cvt_pk_bf16(r[4], r[5]); w.w = cvt_pk_bf16(r[6], r[7]);
                    *(u32x4*)(Mg + off + bj * HALF) = w; }
            }
    }
};
template <class Epi, class Sched, bool ALIGN_EPI = false, bool SP2 = false>
__device__ __forceinline__ void gemm_phase(PG8_LAS unsigned char* lds, const Gemm g, const Sched& S, const Epi& E) {
    int tid_o = threadIdx.x; asm volatile("" : "+v"(tid_o));
    const int tid = tid_o, wid = __builtin_amdgcn_readfirstlane(tid >> 6), lane = tid & 63, wr = wid >> 2, wc = wid & 3, fr = lane & 15, fq = lane >> 4;
    const int K = g.K, nt = K / BK;
    unsigned voffA[2], voffB[2];
#pragma unroll
    for (int i = 0; i < 2; ++i) { int R, C; stage_rc(tid * 16 + i * 8192, R, C); const int Rb = Epi::PERM ? ((R & ~31) + perm32(R & 31)) : R;
        voffA[i] = (unsigned)(R * K + C) * 2u; voffB[i] = (unsigned)(Rb * K + C) * 2u; }
    const size_t kstep = (size_t)(BK * 2);
    const size_t hstep = (size_t)HALF * K * 2;
    const size_t tstep = 2 * hstep;
    const unsigned ldsw = (unsigned)wid * 1024u;
    const int aoff = lds_byte(wr * 64 + fr, fq * 8), boff = lds_byte(wc * 32 + fr, fq * 8);
#define PG8_SA(b, h) (((b) * 2 + (h)) * HTB)
#define PG8_SB(b, h) ((4 + (b) * 2 + (h)) * HTB)
#define PG8_STAGE(bufoff, gbase, voff) do { _Pragma("unroll") for (int _i = 0; _i < 2; ++_i) \
        __builtin_amdgcn_global_load_lds((const unsigned*)((const char*)(gbase) + (voff)[_i]), (PG8_LAS unsigned*)(lds + (bufoff) + ldsw + _i * 8192), 16, 0, 0); } while (0)
#define PG8_LDA(dst, b, h) do { _Pragma("unroll") for (int m = 0; m < 4; ++m) _Pragma("unroll") for (int k = 0; k < 2; ++k) dst[m][k] = *(const PG8_LAS bf16x8*)(lds + PG8_SA(b, h) + aoff + m * 2048 + k * 1024); } while (0)
#define PG8_LDB(dst, b, h) do { _Pragma("unroll") for (int n = 0; n < 2; ++n) _Pragma("unroll") for (int k = 0; k < 2; ++k) dst[n][k] = *(const PG8_LAS bf16x8*)(lds + PG8_SB(b, h) + boff + n * 2048 + k * 1024); } while (0)
#define PG8_MMA(ai, bj, At, Bt) do { __builtin_amdgcn_s_setprio(1); _Pragma("unroll") for (int m = 0; m < 4; ++m) _Pragma("unroll") for (int n = 0; n < 2; ++n) _Pragma("unroll") for (int k = 0; k < 2; ++k) \
        acc[ai][bj][m][n] = __builtin_amdgcn_mfma_f32_16x16x32_bf16(Bt[n][k], At[m][k], acc[ai][bj][m][n], 0, 0, 0); __builtin_amdgcn_s_setprio(0); } while (0)
#define PG8_WAIT_V(n) asm volatile("s_waitcnt vmcnt(" #n ")" ::: "memory")
#define PG8_WAIT_L(n) asm volatile("s_waitcnt lgkmcnt(" #n ")" ::: "memory")
#define PG8_BAR __builtin_amdgcn_s_barrier()
#define PG8_SCHED __builtin_amdgcn_sched_barrier(0)
    Unit cur, nxt; int ui = 0;
    if (!S.next(0, cur)) return;
    f32x4 acc[2][2][4][2];
#pragma unroll
    for (int a = 0; a < 2; ++a)
#pragma unroll
        for (int b = 0; b < 2; ++b)
#pragma unroll
            for (int m = 0; m < 4; ++m)
#pragma unroll
                for (int n = 0; n < 2; ++n) acc[a][b][m][n] = (f32x4){0.f, 0.f, 0.f, 0.f};
    bf16x8 At[4][2], B0[2][2], B1[2][2];
    const char* cA = (const char*)g.A + (size_t)cur.pm * tstep; const char* cB = (const char*)g.Bt + (size_t)cur.pn * tstep;
    S.a_ready(cur);
    if constexpr (SP2) {
        PG8_STAGE(PG8_SB(0, 0), cB, voffB); PG8_STAGE(PG8_SB(0, 1), cB + hstep, voffB); PG8_STAGE(PG8_SA(0, 0), cA, voffA); PG8_STAGE(PG8_SA(0, 1), cA + hstep, voffA);
        if (wr == 1) PG8_BAR;
        PG8_WAIT_V(2); PG8_BAR;
        PG8_STAGE(PG8_SB(1, 0), cB + kstep, voffB); PG8_STAGE(PG8_SA(1, 0), cA + kstep, voffA); PG8_STAGE(PG8_SB(1, 1), cB + hstep + kstep, voffB);
        PG8_WAIT_V(6); PG8_BAR;
    } else {
        PG8_STAGE(PG8_SB(0, 0), cB, voffB); PG8_STAGE(PG8_SA(0, 0), cA, voffA); PG8_STAGE(PG8_SB(0, 1), cB + hstep, voffB); PG8_STAGE(PG8_SA(0, 1), cA + hstep, voffA);
        if (wr == 1) PG8_BAR;
        PG8_WAIT_V(4); PG8_BAR;
        PG8_STAGE(PG8_SB(1, 0), cB + kstep, voffB); PG8_STAGE(PG8_SA(1, 0), cA + kstep, voffA); PG8_STAGE(PG8_SB(1, 1), cB + hstep + kstep, voffB);
        PG8_WAIT_V(6); PG8_BAR;
    }
    for (;;) {
        const bool has_next = S.next(ui + 1, nxt);
        const char* nA = has_next ? (const char*)g.A + (size_t)nxt.pm * tstep : cA; const char* nB = has_next ? (const char*)g.Bt + (size_t)nxt.pn * tstep : cB;
        for (int t = 0; t < nt; t += 2) {
            const bool last = (t == nt - 2);
            const char* a1 = cA + (size_t)(t + 1) * kstep;
            const char* a2 = last ? nA : cA + (size_t)(t + 2) * kstep; const char* b2 = last ? nB : cB + (size_t)(t + 2) * kstep;
            const char* a3 = a2 + kstep; const char* b3 = b2 + kstep;
            if (last && has_next) S.a_ready(nxt);
            if constexpr (SP2) {
            PG8_LDB(B0, 0, 0); PG8_LDB(B1, 0, 1); PG8_SCHED; PG8_LDA(At, 0, 0); PG8_STAGE(PG8_SA(1, 1), a1 + hstep, voffA);
            PG8_WAIT_V(8); PG8_WAIT_L(0); PG8_BAR; PG8_MMA(0, 0, At, B0); PG8_MMA(0, 1, At, B1); PG8_BAR; PG8_SCHED;
            PG8_LDA(At, 0, 1); PG8_STAGE(PG8_SB(0, 0), b2, voffB); PG8_STAGE(PG8_SB(0, 1), b2 + hstep, voffB); PG8_STAGE(PG8_SA(0, 0), a2, voffA);
            PG8_WAIT_V(8); PG8_WAIT_L(0); PG8_BAR; PG8_MMA(1, 0, At, B0); PG8_MMA(1, 1, At, B1); PG8_BAR; PG8_SCHED;
            PG8_LDB(B0, 1, 0); PG8_LDB(B1, 1, 1); PG8_SCHED; PG8_LDA(At, 1, 0); PG8_STAGE(PG8_SA(0, 1), a2 + hstep, voffA);
            PG8_WAIT_V(8); PG8_WAIT_L(0); PG8_BAR; PG8_MMA(0, 0, At, B0); PG8_MMA(0, 1, At, B1); PG8_BAR; PG8_SCHED;
            PG8_LDA(At, 1, 1); PG8_STAGE(PG8_SB(1, 0), b3, voffB); PG8_STAGE(PG8_SB(1, 1), b3 + hstep, voffB); PG8_STAGE(PG8_SA(1, 0), a3, voffA);
            PG8_WAIT_V(8); PG8_WAIT_L(0); PG8_BAR; PG8_MMA(1, 0, At, B0); PG8_MMA(1, 1, At, B1); PG8_BAR; PG8_SCHED;
            } else {
            PG8_LDB(B0, 0, 0); PG8_SCHED; PG8_LDA(At, 0, 0); PG8_STAGE(PG8_SA(1, 1), a1 + hstep, voffA);
            PG8_WAIT_L(8); PG8_BAR; PG8_WAIT_L(0); PG8_MMA(0, 0, At, B0); PG8_BAR; PG8_SCHED;
            PG8_LDB(B1, 0, 1); PG8_STAGE(PG8_SB(0, 0), b2, voffB);
            PG8_BAR; PG8_WAIT_L(0); PG8_MMA(0, 1, At, B1); PG8_BAR;
            PG8_LDA(At, 0, 1); PG8_STAGE(PG8_SA(0, 0), a2, voffA);
            PG8_BAR; PG8_WAIT_L(0); PG8_MMA(1, 0, At, B0); PG8_BAR; PG8_SCHED;
            PG8_STAGE(PG8_SB(0, 1), b2 + hstep, voffB);
            PG8_WAIT_V(6); PG8_BAR; PG8_MMA(1, 1, At, B1); PG8_BAR;
            PG8_LDB(B0, 1, 0); PG8_SCHED; PG8_LDA(At, 1, 0); PG8_STAGE(PG8_SA(0, 1), a2 + hstep, voffA);
            PG8_WAIT_L(8); PG8_BAR; PG8_WAIT_L(0); PG8_MMA(0, 0, At, B0); PG8_BAR; PG8_SCHED;
            PG8_LDB(B1, 1, 1); PG8_STAGE(PG8_SB(1, 0), b3, voffB);
            PG8_BAR; PG8_WAIT_L(0); PG8_MMA(0, 1, At, B1); PG8_BAR;
            PG8_LDA(At, 1, 1); PG8_STAGE(PG8_SA(1, 0), a3, voffA);
            PG8_BAR; PG8_WAIT_L(0); PG8_MMA(1, 0, At, B0); PG8_BAR; PG8_SCHED;
            PG8_STAGE(PG8_SB(1, 1), b3 + hstep, voffB);
            PG8_WAIT_V(6); PG8_BAR; PG8_MMA(1, 1, At, B1); PG8_BAR;
            }
        }
        if constexpr (ALIGN_EPI) { if (wr == 0) PG8_BAR; }
        if constexpr (!Epi::AFTER_DRAIN) { E(acc, cur, wr, wc, fr, fq); S.done(cur); }
        if (!has_next) break;
#pragma unroll
        for (int a = 0; a < 2; ++a)
#pragma unroll
            for (int b = 0; b < 2; ++b)
#pragma unroll
                for (int m = 0; m < 4; ++m)
#pragma unroll
                    for (int n = 0; n < 2; ++n) acc[a][b][m][n] = (f32x4){0.f, 0.f, 0.f, 0.f};
        cur = nxt; cA = nA; cB = nB; ++ui;
        if constexpr (ALIGN_EPI) { if (wr == 1) PG8_BAR; }
    }
    PG8_WAIT_V(0);
    if constexpr (!ALIGN_EPI) { if (wr == 0) PG8_BAR; }
    PG8_BAR;
    if constexpr (Epi::AFTER_DRAIN) { E.fused(acc, cur, wr, wc, fr, fq, lds, wid, lane); S.done(cur); }
#undef PG8_SA
#undef PG8_SB
#undef PG8_STAGE
#undef PG8_LDA
#undef PG8_LDB
#undef PG8_MMA
#undef PG8_WAIT_V
#undef PG8_WAIT_L
#undef PG8_BAR
#undef PG8_SCHED
}
}
#define LAS __attribute__((address_space(3)))
typedef unsigned short bf16;
typedef unsigned v4u __attribute__((ext_vector_type(4)));
typedef unsigned v2u __attribute__((ext_vector_type(2)));
typedef float f4 __attribute__((ext_vector_type(4)));
constexpr int T_ = 32768, S_ = 2048, NB = 16, DM = 1024, FF = 2816, NL = 4;
constexpr int NWAVES = 8, NTHREADS = 512;
constexpr int LDS_BYTES = 163840;
constexpr float LOG2E = 1.4426950408889634f;
constexpr float C2 = 0.125f * LOG2E;
constexpr float LOG2_THETA = 13.287712379549449f;

enum { I_X = 0, I_F1N, I_F1UP, I_F1DN, I_MIXN, I_WIN, I_MU, I_W0, I_W2, I_A0, I_A2, I_G2, I_KK, I_KA, I_RK, I_LNG, I_LNB, I_QN, I_KN, I_SINK,
       I_WOA, I_WOB, I_WOC, I_WOUT, I_F2N, I_F2UP, I_F2DN, I_FINN, N_IN };

constexpr size_t SZ_WUP = (size_t)2 * FF * DM * 2, SZ_WDN = (size_t)DM * FF * 2, SZ_WIN = (size_t)3584 * DM * 2, SZ_WG = (size_t)3072 * DM * 2,
                 SZ_WO = (size_t)3 * DM * 512 * 2, SZ_WOUT = (size_t)DM * DM * 2;
constexpr size_t WS_WUP1 = 0, WS_WDN1 = WS_WUP1 + SZ_WUP, WS_WIN = WS_WDN1 + SZ_WDN, WS_WG = WS_WIN + SZ_WIN, WS_WO = WS_WG + SZ_WG, WS_WOUT = WS_WO + SZ_WO,
                 WS_WUP2 = WS_WOUT + SZ_WOUT, WS_WDN2 = WS_WUP2 + SZ_WUP, WS_H = WS_WDN2 + SZ_WDN;
constexpr size_t WS_R = WS_H + (size_t)T_ * DM * 2;
constexpr size_t WS_ACT = WS_R;
constexpr size_t WS_PR = WS_R, WS_QB = WS_PR + (size_t)T_ * 2048 * 2, WS_KVB = WS_QB + (size_t)T_ * 512 * 2, WS_QC = WS_KVB + (size_t)T_ * 256 * 2, WS_KVC = WS_QC + (size_t)T_ * 512 * 2,
                 WS_KG = WS_KVC + (size_t)T_ * 256 * 2, WS_VG = WS_KG + (size_t)NB * 2 * S_ * 64 * 2, WS_KW = WS_VG + (size_t)NB * 2 * S_ * 64 * 2, WS_VW = WS_KW + (size_t)NB * 2 * S_ * 64 * 2,
                 WS_YA = WS_VW + (size_t)NB * 2 * S_ * 64 * 2, WS_WKVF = WS_YA + (size_t)T_ * 512 * 2, WS_WKVB = WS_WKVF + (size_t)T_ * 512 * 2, WS_BONUS = WS_WKVB + (size_t)T_ * 512 * 2,
                 WS_SCR = WS_BONUS + (size_t)T_ * 16 * 4, WS_SS = WS_SCR, WS_WUP1B = WS_SS + (size_t)T_ * 16 * 4, WS_BAR = WS_WUP1B + SZ_WUP, WS_END = WS_BAR + 4096;
#ifdef DBG_GATE_ALT
constexpr size_t WS_GATE = WS_WKVF, WS_MERGED = WS_PR + (size_t)T_ * DM * 2;
#else
constexpr size_t WS_GATE = WS_PR, WS_MERGED = WS_PR + (size_t)T_ * DM * 2;
#endif
static_assert(WS_ACT + (size_t)T_ * FF * 2 <= WS_END, "map");
static_assert(WS_END < 536000000ull, "workspace budget");

struct Params { const float* in[N_IN]; float* out; unsigned char* ws; };

__device__ __forceinline__ unsigned f2bf(float f) { unsigned u = __float_as_uint(f); return (u + 0x7fffu + ((u >> 16) & 1u)) >> 16; }
__device__ __forceinline__ unsigned pk2(float lo, float hi) { return f2bf(lo) | (f2bf(hi) << 16); }
__device__ __forceinline__ float bf2f(bf16 h) { return __uint_as_float((unsigned)h << 16); }
__device__ __forceinline__ int opaque_tid() { int t = threadIdx.x; asm volatile("" : "+v"(t)); return t; }
#define STAGE_IDS const int tid = opaque_tid(), lane = tid & 63, wave = __builtin_amdgcn_readfirstlane(tid >> 6); const int gw = blockIdx.x * NWAVES + wave, ngw = gridDim.x * NWAVES, gtid = blockIdx.x * NTHREADS + tid, gthreads = gridDim.x * NTHREADS; (void)lane; (void)gw; (void)ngw; (void)gtid; (void)gthreads;
__device__ __forceinline__ float wave_sum(float v) {
#pragma unroll
    for (int o = 1; o < 64; o <<= 1) v += __shfl_xor(v, o);
    return v;
}

__device__ __forceinline__ void cvt_wt(const float* W, int K, int ld, bf16* Wt, int nrows, int mode, int gw, int ngw, int lane, float* scr, const float* gain = nullptr) {
    const int nblk = nrows >> 5, nitems = (K >> 6) * nblk;
    for (int it = gw; it < nitems; it += ngw) {
        const int kb = it / nblk, nb = it % nblk, k0 = kb * 64, n0 = nb * 32;
        int col0;
        if (mode == 0) col0 = n0;
        else if (mode == 1) { const int t = n0 >> 8, r = n0 & 255; col0 = (r < 128) ? t * 128 + r : FF + t * 128 + (r - 128); }
        else if (mode == 2) col0 = n0 < 1920 ? n0 : (n0 < 2048 ? -1 : n0 - 128);
        else col0 = 3456 + n0;
        if (col0 >= 0) {
#pragma unroll 8
            for (int i = 0; i < 32; ++i) { const int kk = 2 * i + (lane >> 5); scr[kk * 33 + (lane & 31)] = W[(size_t)(k0 + kk) * ld + col0 + (lane & 31)] * (gain ? gain[k0 + kk] : 1.0f); }
        }
        asm volatile("s_waitcnt lgkmcnt(0)" ::: "memory");
        const int c = lane & 7;
#pragma unroll
        for (int j = 0; j < 4; ++j) { const int n = (lane >> 3) + 8 * j; const float* sp = scr + (8 * c) * 33 + n;
            v4u o = (v4u){0u, 0u, 0u, 0u};
            if (col0 >= 0) { o.x = pk2(sp[0 * 33], sp[1 * 33]); o.y = pk2(sp[2 * 33], sp[3 * 33]); o.z = pk2(sp[4 * 33], sp[5 * 33]); o.w = pk2(sp[6 * 33], sp[7 * 33]); }
            *(v4u*)(Wt + (size_t)(n0 + n) * K + k0 + 8 * c) = o; }
        asm volatile("s_waitcnt lgkmcnt(0)" ::: "memory");
    }
}
__device__ __forceinline__ void cvt_up1(const Params& P, int l, unsigned char* ldsg) {
    STAGE_IDS
    unsigned char* ws = P.ws; float* scr = (float*)(ldsg + wave * 8448);
    cvt_wt(P.in[I_F1UP] + (size_t)l * DM * 2 * FF, DM, 2 * FF, (bf16*)(ws + ((l & 1) ? WS_WUP1B : WS_WUP1)), 2 * FF, 1, gw, ngw, lane, scr, P.in[I_F1N] + l * DM);
}
__device__ __forceinline__ void cvt_rest(const Params& P, int l, unsigned char* ldsg) {
    STAGE_IDS
    unsigned char* ws = P.ws; float* scr = (float*)(ldsg + wave * 8448);
    cvt_wt(P.in[I_F1DN] + (size_t)l * FF * DM, FF, DM, (bf16*)(ws + WS_WDN1), DM, 0, gw, ngw, lane, scr);
    cvt_wt(P.in[I_WIN] + (size_t)l * DM * 6528, DM, 6528, (bf16*)(ws + WS_WIN), 3584, 2, gw, ngw, lane, scr, P.in[I_MIXN] + l * DM);
    cvt_wt(P.in[I_WIN] + (size_t)l * DM * 6528, DM, 6528, (bf16*)(ws + WS_WG), 3072, 3, gw, ngw, lane, scr, P.in[I_MIXN] + l * DM);
    cvt_wt(P.in[I_WOA] + (size_t)l * 512 * DM, 512, DM, (bf16*)(ws + WS_WO), DM, 0, gw, ngw, lane, scr);
    cvt_wt(P.in[I_WOB] + (size_t)l * 512 * DM, 512, DM, (bf16*)(ws + WS_WO) + (size_t)DM * 512, DM, 0, gw, ngw, lane, scr);
    cvt_wt(P.in[I_WOC] + (size_t)l * 512 * DM, 512, DM, (bf16*)(ws + WS_WO) + (size_t)2 * DM * 512, DM, 0, gw, ngw, lane, scr);
    cvt_wt(P.in[I_WOUT] + (size_t)l * DM * DM, DM, DM, (bf16*)(ws + WS_WOUT), DM, 0, gw, ngw, lane, scr);
    cvt_wt(P.in[I_F2UP] + (size_t)l * DM * 2 * FF, DM, 2 * FF, (bf16*)(ws + WS_WUP2), 2 * FF, 1, gw, ngw, lane, scr, P.in[I_F2N] + l * DM);
    cvt_wt(P.in[I_F2DN] + (size_t)l * FF * DM, FF, DM, (bf16*)(ws + WS_WDN2), DM, 0, gw, ngw, lane, scr);
}
__device__ __forceinline__ void x_to_bf16_ss(const float* x, bf16* o, float* SS) {
    STAGE_IDS
    for (int m = gw; m < T_; m += ngw) {
        const f4* xr = (const f4*)(x + (size_t)m * DM) + lane; f4 v[4]; float s = 0.f;
#pragma unroll
        for (int j = 0; j < 4; ++j) { v[j] = xr[64 * j]; s += (v[j].x * v[j].x + v[j].y * v[j].y) + (v[j].z * v[j].z + v[j].w * v[j].w); }
        s = wave_sum(s);
        v2u* op = (v2u*)(o + (size_t)m * DM) + lane;
#pragma unroll
        for (int j = 0; j < 4; ++j) { v2u w; w.x = pk2(v[j].x, v[j].y); w.y = pk2(v[j].z, v[j].w); op[64 * j] = w; }
        if (lane < 16) SS[(size_t)m * 16 + lane] = lane == 0 ? s : 0.f;
    }
}

__device__ __forceinline__ void rms_rows_bf16(const float* x, const float* g, bf16* o) {
    STAGE_IDS
    const f4* gr = (const f4*)g + lane; f4 gv[4];
#pragma unroll
    for (int j = 0; j < 4; ++j) gv[j] = gr[64 * j];
    for (int m = gw; m < T_; m += ngw) {
        const f4* xr = (const f4*)(x + (size_t)m * DM) + lane; f4 v[4]; float s = 0.f;
#pragma unroll
        for (int j = 0; j < 4; ++j) { v[j] = xr[64 * j]; s += (v[j].x * v[j].x + v[j].y * v[j].y) + (v[j].z * v[j].z + v[j].w * v[j].w); }
        const float rs = 1.0f / sqrtf(wave_sum(s) * (1.0f / DM) + 1e-6f);
        v2u* op = (v2u*)(o + (size_t)m * DM) + lane;
#pragma unroll
        for (int j = 0; j < 4; ++j) { v2u w; w.x = pk2(v[j].x * rs * gv[j].x, v[j].y * rs * gv[j].y); w.y = pk2(v[j].z * rs * gv[j].z, v[j].w * rs * gv[j].w); op[64 * j] = w; }
    }
}
__device__ __forceinline__ void rms_rows_f32_inplace(float* x, const float* g) {
    STAGE_IDS
    const f4* gr = (const f4*)g + lane; f4 gv[4];
#pragma unroll
    for (int j = 0; j < 4; ++j) gv[j] = gr[64 * j];
    for (int m = gw; m < T_; m += ngw) {
        f4* xr = (f4*)(x + (size_t)m * DM) + lane; f4 v[4]; float s = 0.f;
#pragma unroll
        for (int j = 0; j < 4; ++j) { v[j] = xr[64 * j]; s += (v[j].x * v[j].x + v[j].y * v[j].y) + (v[j].z * v[j].z + v[j].w * v[j].w); }
        const float rs = 1.0f / sqrtf(wave_sum(s) * (1.0f / DM) + 1e-6f);
#pragma unroll
        for (int j = 0; j < 4; ++j) xr[64 * j] = v[j] * rs * gv[j];
    }
}

__device__ __forceinline__ float fast_sin_rev(float rev) { return __builtin_amdgcn_sinf(__builtin_amdgcn_fractf(rev)); }
__device__ __forceinline__ float fast_cos_rev(float rev) { return __builtin_amdgcn_cosf(__builtin_amdgcn_fractf(rev)); }
__device__ __forceinline__ void qkprep(const Params& P, int l, bool dummy = false) {
    STAGE_IDS
    unsigned char* ws = P.ws;
    bf16* QB = (bf16*)(ws + WS_QB); const bf16* KVB = (const bf16*)(ws + WS_KVB); bf16* QC = (bf16*)(ws + WS_QC); const bf16* KVC = (const bf16*)(ws + WS_KVC);
    bf16* KG = (bf16*)(ws + WS_KG); bf16* KW = (bf16*)(ws + WS_KW);
    const float qg = P.in[I_QN][l * 64 + lane], kg = P.in[I_KN][l * 64 + lane];
    const float inv_ax = exp2f(-(float)(lane & 15) * (LOG2_THETA / 16.0f)), inv_1d = exp2f(-(float)(lane & 31) * (LOG2_THETA / 32.0f));
    const float INV2PI = 0.15915494309189535f;
    for (int t = gw; t < T_; t += ngw) {
        const int b = t >> 11, s = t & 2047;
        const float pos = lane < 32 ? (float)(s >> 6) : (float)(s & 63);
        const float ra = (pos * inv_ax) * INV2PI, r1 = ((float)s * inv_1d) * INV2PI;
        const float csa = fast_cos_rev(ra), sna = (lane & 16) ? fast_sin_rev(ra) : -fast_sin_rev(ra);
        const float cs1 = fast_cos_rev(r1), sn1 = (lane & 32) ? fast_sin_rev(r1) : -fast_sin_rev(r1);
#pragma unroll
        for (int slot = 0; slot < 10; ++slot) {
            bf16* src = slot < 8 ? QB + (size_t)t * 512 + slot * 64 : (bf16*)KVB + (size_t)t * 256 + (slot - 8) * 64;
            const float x = bf2f(src[lane]);
            const float ss = wave_sum(x * x) * (1.0f / 64.0f);
            const float y = x * (1.0f / sqrtf(ss + 1e-6f)) * (slot < 8 ? qg : kg);
            const float r = y * csa + __shfl_xor(y, 16) * sna;
            if (slot < 8) (dummy ? (bf16*)(ws + WS_YA) + (size_t)t * 512 + slot * 64 : src)[lane] = (bf16)f2bf(r * C2);
            else KG[((size_t)(b * 2 + (slot - 8)) * S_ + s) * 64 + lane] = (bf16)f2bf(r);
        }
#pragma unroll
        for (int slot = 0; slot < 10; ++slot) {
            bf16* src = slot < 8 ? QC + (size_t)t * 512 + slot * 64 : (bf16*)KVC + (size_t)t * 256 + (slot - 8) * 64;
            const float x = bf2f(src[lane]);
            const float r = x * cs1 + __shfl_xor(x, 32) * sn1;
            if (slot < 8) (dummy ? (bf16*)(ws + WS_YA) + (size_t)t * 512 + slot * 64 : src)[lane] = (bf16)f2bf(r * C2);
            else KW[((size_t)(b * 2 + (slot - 8)) * S_ + s) * 64 + lane] = (bf16)f2bf(r);
        }
    }
}

__device__ __forceinline__ void vt_prep(const Params& P, unsigned char* ldsg) {
    STAGE_IDS
    unsigned char* ws = P.ws;
    bf16* tile = (bf16*)(ldsg + wave * 8448);
    for (int it = gw; it < 2 * NB * 2 * 32; it += ngw) {
        const int tb = it & 31, kvh = (it >> 5) & 1, b = (it >> 6) & 15, att = it >> 10;
        const bf16* src = (const bf16*)(ws + (att ? WS_KVC : WS_KVB)) + (size_t)(b * S_ + tb * 64) * 256 + 128 + kvh * 64;
        bf16* dst = (bf16*)(ws + (att ? WS_VW : WS_VG)) + (size_t)(b * 2 + kvh) * 64 * S_ + tb * 64;
#pragma unroll 8
        for (int r = 0; r < 64; ++r) tile[r * 66 + lane] = src[(size_t)r * 256 + lane];
        asm volatile("s_waitcnt lgkmcnt(0)" ::: "memory");
#pragma unroll 8
        for (int d = 0; d < 64; ++d) dst[(size_t)d * S_ + lane] = tile[lane * 66 + d];
        asm volatile("s_waitcnt lgkmcnt(0)" ::: "memory");
    }
}

typedef short bf16x8_t __attribute__((ext_vector_type(8)));
typedef short s16x4_t __attribute__((ext_vector_type(4)));
typedef float f32x16 __attribute__((ext_vector_type(16)));
typedef float f32x2a __attribute__((ext_vector_type(2))); typedef __bf16 bf16x2a __attribute__((ext_vector_type(2)));
__device__ __forceinline__ unsigned cvtpk(float lo, float hi) { f32x2a v = {lo, hi}; bf16x2a b = __builtin_convertvector(v, bf16x2a); return __builtin_bit_cast(unsigned, b); }
__device__ __forceinline__ int crow(int r, int hi) { return (r & 3) + 8 * (r >> 2) + 4 * hi; }
template <bool WINDOW>
__device__ __forceinline__ void attn_mfma(bf16* Q, const bf16* Kx, const bf16* VTx, const float* sink, unsigned char* ldsg, bf16* Oalt = nullptr) {
    STAGE_IDS
    const int r32 = lane & 31, hi = lane >> 5, g = wave >> 1, qs = wave & 1;
    const int srow = tid >> 3, sch = tid & 7;
    for (int unit = blockIdx.x; unit < 1024; unit += gridDim.x) {
        const int qb = unit & 31, kvh = (unit >> 5) & 1, b = unit >> 6, h = kvh * 4 + g, q0 = qb * 64 + qs * 32;
        bf16* qp = Q + ((size_t)(b * S_ + q0 + r32)) * 512 + h * 64;
        bf16x8_t qr[4];
#pragma unroll
        for (int d0 = 0; d0 < 4; ++d0) qr[d0] = *(const bf16x8_t*)(qp + 16 * d0 + 8 * hi);
        f32x16 o0, o1;
#pragma unroll
        for (int r = 0; r < 16; ++r) { o0[r] = 0.f; o1[r] = 0.f; }
        float m, l;
        if (WINDOW) { m = sink[h] * LOG2E; l = hi == 0 ? 1.0f : 0.f; } else { m = -1e30f; l = 0.f; }
        const int t0 = WINDOW ? (qb - 2 > 0 ? qb - 2 : 0) : 0, t1 = WINDOW ? (qb + 2 < 31 ? qb + 2 : 31) : 31;
        const bf16* kbase = Kx + (size_t)(b * 2 + kvh) * S_ * 64 + (size_t)srow * 64 + sch * 8;
        const bf16* vbase = VTx + (size_t)(b * 2 + kvh) * 64 * S_ + (size_t)srow * S_ + sch * 8;
        v4u kreg = *(const v4u*)(kbase + (size_t)t0 * 64 * 64);
        v4u vreg = *(const v4u*)(vbase + t0 * 64);
        __syncthreads();
        *(v4u*)(ldsg + srow * 144 + sch * 16) = kreg;
        *(v4u*)(ldsg + 9216 + srow * 144 + sch * 16) = vreg;
        __syncthreads();
        for (int t = t0; t <= t1; ++t) {
            const int buf = (t - t0) & 1;
            if (t < t1) { kreg = *(const v4u*)(kbase + (size_t)(t + 1) * 64 * 64); vreg = *(const v4u*)(vbase + (t + 1) * 64); }
            const unsigned char* Kb = ldsg + buf * 18432; const unsigned char* Vb = Kb + 9216;
            f32x16 p0, p1;
#pragma unroll
            for (int r = 0; r < 16; ++r) { p0[r] = 0.f; p1[r] = 0.f; }
#pragma unroll
            for (int d0 = 0; d0 < 4; ++d0) {
                const bf16x8_t a0 = *(const bf16x8_t*)(Kb + r32 * 144 + (16 * d0 + 8 * hi) * 2);
                const bf16x8_t a1 = *(const bf16x8_t*)(Kb + (32 + r32) * 144 + (16 * d0 + 8 * hi) * 2);
                p0 = __builtin_amdgcn_mfma_f32_32x32x16_bf16(a0, qr[d0], p0, 0, 0, 0);
                p1 = __builtin_amdgcn_mfma_f32_32x32x16_bf16(a1, qr[d0], p1, 0, 0, 0);
            }
            if (WINDOW) {
                const int qpos = q0 + r32;
#pragma unroll
                for (int r = 0; r < 16; ++r) { const int kv = t * 64 + crow(r, hi); int dlt = qpos - kv; dlt = dlt < 0 ? -dlt : dlt; if (dlt > 128) p0[r] = -1e30f;
                    int dl2 = qpos - (kv + 32); dl2 = dl2 < 0 ? -dl2 : dl2; if (dl2 > 128) p1[r] = -1e30f; }
            }
            float mt = fmaxf(p0[0], p1[0]);
#pragma unroll
            for (int r = 1; r < 16; ++r) mt = fmaxf(mt, fmaxf(p0[r], p1[r]));
            mt = fmaxf(mt, __shfl_xor(mt, 32));
            const float mn = fmaxf(m, mt), corr = __builtin_amdgcn_exp2f(m - mn); m = mn;
            float ps = 0.f;
#pragma unroll
            for (int r = 0; r < 16; ++r) { p0[r] = __builtin_amdgcn_exp2f(p0[r] - mn); p1[r] = __builtin_amdgcn_exp2f(p1[r] - mn); ps += p0[r] + p1[r]; }
            l = l * corr + ps;
#pragma unroll
            for (int r = 0; r < 16; ++r) { o0[r] *= corr; o1[r] *= corr; }
            v4u pw[4];
            pw[0] = (v4u){cvtpk(p0[0], p0[1]), cvtpk(p0[2], p0[3]), cvtpk(p0[4], p0[5]), cvtpk(p0[6], p0[7])};
            pw[1] = (v4u){cvtpk(p0[8], p0[9]), cvtpk(p0[10], p0[11]), cvtpk(p0[12], p0[13]), cvtpk(p0[14], p0[15])};
            pw[2] = (v4u){cvtpk(p1[0], p1[1]), cvtpk(p1[2], p1[3]), cvtpk(p1[4], p1[5]), cvtpk(p1[6], p1[7])};
            pw[3] = (v4u){cvtpk(p1[8], p1[9]), cvtpk(p1[10], p1[11]), cvtpk(p1[12], p1[13]), cvtpk(p1[14], p1[15])};
#pragma unroll
            for (int kb = 0; kb < 4; ++kb) {
                const bf16x8_t pb = __builtin_bit_cast(bf16x8_t, pw[kb]);
                { const unsigned char* vp = Vb + r32 * 144 + (16 * kb + 4 * hi) * 2; const s16x4_t lo = *(const s16x4_t*)vp, hh = *(const s16x4_t*)(vp + 16);
                  const bf16x8_t a = (bf16x8_t){lo[0], lo[1], lo[2], lo[3], hh[0], hh[1], hh[2], hh[3]};
                  o0 = __builtin_amdgcn_mfma_f32_32x32x16_bf16(a, pb, o0, 0, 0, 0); }
                { const unsigned char* vp = Vb + (32 + r32) * 144 + (16 * kb + 4 * hi) * 2; const s16x4_t lo = *(const s16x4_t*)vp, hh = *(const s16x4_t*)(vp + 16);
                  const bf16x8_t a = (bf16x8_t){lo[0], lo[1], lo[2], lo[3], hh[0], hh[1], hh[2], hh[3]};
                  o1 = __builtin_amdgcn_mfma_f32_32x32x16_bf16(a, pb, o1, 0, 0, 0); }
            }
            if (t < t1) { unsigned char* nb = ldsg + (buf ^ 1) * 18432; *(v4u*)(nb + srow * 144 + sch * 16) = kreg; *(v4u*)(nb + 9216 + srow * 144 + sch * 16) = vreg; }
            __syncthreads();
        }
        l += __shfl_xor(l, 32);
        const float inv = 1.0f / l;
        if (Oalt) qp = Oalt + ((size_t)(b * S_ + q0 + r32)) * 512 + h * 64;
#pragma unroll
        for (int g4 = 0; g4 < 4; ++g4) {
            v2u w0, w1;
            w0.x = cvtpk(o0[4 * g4 + 0] * inv, o0[4 * g4 + 1] * inv); w0.y = cvtpk(o0[4 * g4 + 2] * inv, o0[4 * g4 + 3] * inv);
            w1.x = cvtpk(o1[4 * g4 + 0] * inv, o1[4 * g4 + 1] * inv); w1.y = cvtpk(o1[4 * g4 + 2] * inv, o1[4 * g4 + 3] * inv);
            *(v2u*)(qp + 8 * g4 + 4 * hi) = w0;
            *(v2u*)(qp + 32 + 8 * g4 + 4 * hi) = w1;
        }
    }
}

__device__ __forceinline__ void attn_naive(bf16* Q, const bf16* Kx, const bf16* Vx, const float* sink, int window) {
    STAGE_IDS
    for (int it = gtid; it < T_ * 8; it += gthreads) {
        const int q = it & 2047, h = (it >> 11) & 7, b = it >> 14, kvh = h >> 2;
        bf16* qp = Q + ((size_t)(b * S_ + q)) * 512 + h * 64;
        float qf[64], o[64];
#pragma unroll
        for (int c = 0; c < 8; ++c) { const v4u w = ((const v4u*)qp)[c];
            qf[c * 8 + 0] = __uint_as_float(w.x << 16); qf[c * 8 + 1] = __uint_as_float(w.x & 0xffff0000u); qf[c * 8 + 2] = __uint_as_float(w.y << 16); qf[c * 8 + 3] = __uint_as_float(w.y & 0xffff0000u);
            qf[c * 8 + 4] = __uint_as_float(w.z << 16); qf[c * 8 + 5] = __uint_as_float(w.z & 0xffff0000u); qf[c * 8 + 6] = __uint_as_float(w.w << 16); qf[c * 8 + 7] = __uint_as_float(w.w & 0xffff0000u); }
#pragma unroll
        for (int d = 0; d < 64; ++d) o[d] = 0.f;
        float m, lsum;
        if (sink) { m = sink[h] * LOG2E; lsum = 1.0f; } else { m = -1e30f; lsum = 0.f; }
        const int k0 = window ? (q - 128 > 0 ? q - 128 : 0) : 0, k1 = window ? (q + 128 < S_ - 1 ? q + 128 : S_ - 1) : S_ - 1;
        const bf16* kp = Kx + (size_t)(b * 2 + kvh) * S_ * 64; const bf16* vp = Vx + (size_t)(b * 2 + kvh) * S_ * 64;
        for (int k = k0; k <= k1; ++k) {
            const v4u* kr = (const v4u*)(kp + (size_t)k * 64); float s = 0.f;
#pragma unroll
            for (int c = 0; c < 8; ++c) { const v4u w = kr[c];
                s += qf[c * 8 + 0] * __uint_as_float(w.x << 16) + qf[c * 8 + 1] * __uint_as_float(w.x & 0xffff0000u) + qf[c * 8 + 2] * __uint_as_float(w.y << 16) + qf[c * 8 + 3] * __uint_as_float(w.y & 0xffff0000u)
                   + qf[c * 8 + 4] * __uint_as_float(w.z << 16) + qf[c * 8 + 5] * __uint_as_float(w.z & 0xffff0000u) + qf[c * 8 + 6] * __uint_as_float(w.w << 16) + qf[c * 8 + 7] * __uint_as_float(w.w & 0xffff0000u); }
            const float mn = fmaxf(m, s), corr = exp2f(m - mn), p = exp2f(s - mn);
            lsum = lsum * corr + p; m = mn;
            const v4u* vr = (const v4u*)(vp + (size_t)k * 64);
#pragma unroll
            for (int c = 0; c < 8; ++c) { const v4u w = vr[c];
                o[c * 8 + 0] = o[c * 8 + 0] * corr + p * __uint_as_float(w.x << 16); o[c * 8 + 1] = o[c * 8 + 1] * corr + p * __uint_as_float(w.x & 0xffff0000u);
                o[c * 8 + 2] = o[c * 8 + 2] * corr + p * __uint_as_float(w.y << 16); o[c * 8 + 3] = o[c * 8 + 3] * corr + p * __uint_as_float(w.y & 0xffff0000u);
                o[c * 8 + 4] = o[c * 8 + 4] * corr + p * __uint_as_float(w.z << 16); o[c * 8 + 5] = o[c * 8 + 5] * corr + p * __uint_as_float(w.z & 0xffff0000u);
                o[c * 8 + 6] = o[c * 8 + 6] * corr + p * __uint_as_float(w.w << 16); o[c * 8 + 7] = o[c * 8 + 7] * corr + p * __uint_as_float(w.w & 0xffff0000u); }
        }
        const float inv = 1.0f / lsum;
#pragma unroll
        for (int c = 0; c < 8; ++c) { v4u w; w.x = pk2(o[c * 8 + 0] * inv, o[c * 8 + 1] * inv); w.y = pk2(o[c * 8 + 2] * inv, o[c * 8 + 3] * inv); w.z = pk2(o[c * 8 + 4] * inv, o[c * 8 + 5] * inv); w.w = pk2(o[c * 8 + 6] * inv, o[c * 8 + 7] * inv);
            ((v4u*)qp)[c] = w; }
    }
}


typedef float f8s __attribute__((ext_vector_type(8)));
typedef float f32x4m __attribute__((ext_vector_type(4)));
constexpr int SC_VEC = 0, SC_VS = 81920, SC_W2T = 98304, SC_A2T = 107520, SC_XCH = 116736, SC_YP = 124928, SC_A1 = SC_YP, SC_A2 = SC_YP + 9216, SC_AL = SC_YP + 18432, SC_CS = SC_AL + 16640, SC_END = SC_CS + 128;
static_assert(SC_END <= LDS_BYTES, "scan LDS");
__device__ __forceinline__ void ld8bf(const bf16* p, float (&f)[8]) { const v4u w = *(const v4u*)p;
    f[0] = __uint_as_float(w.x << 16); f[1] = __uint_as_float(w.x & 0xffff0000u); f[2] = __uint_as_float(w.y << 16); f[3] = __uint_as_float(w.y & 0xffff0000u);
    f[4] = __uint_as_float(w.z << 16); f[5] = __uint_as_float(w.z & 0xffff0000u); f[6] = __uint_as_float(w.w << 16); f[7] = __uint_as_float(w.w & 0xffff0000u); }
__device__ __forceinline__ void shifted8(const bf16* pc, int col, bool hasp, bool hasn, const float* mu, float (&o)[8]) {
    float c[8], p[8], n[8];
    ld8bf(pc + col, c);
    if (hasp) ld8bf(pc + col - 2048, p); else { for (int e = 0; e < 8; ++e) p[e] = 0.f; }
    if (hasn) ld8bf(pc + col + 2048, n); else { for (int e = 0; e < 8; ++e) n[e] = 0.f; }
    const f4 m0 = *(const f4*)(mu + col), m1 = *(const f4*)(mu + col + 4);
    const float mm[8] = {m0.x, m0.y, m0.z, m0.w, m1.x, m1.y, m1.z, m1.w};
#pragma unroll
    for (int e = 0; e < 8; ++e) o[e] = c[e] + mm[e] * (0.5f * (p[e] + n[e]) - c[e]);
}
struct Raw3 { v4u c, p, n; };
__device__ __forceinline__ void raw_load(Raw3& r, const bf16* pc, int col, bool hasp, bool hasn) {
    r.c = *(const v4u*)(pc + col);
    r.p = hasp ? *(const v4u*)(pc + col - 2048) : (v4u){0u, 0u, 0u, 0u};
    r.n = hasn ? *(const v4u*)(pc + col + 2048) : (v4u){0u, 0u, 0u, 0u};
}
__device__ __forceinline__ void un8(const v4u w, float (&f)[8]) {
    f[0] = __uint_as_float(w.x << 16); f[1] = __uint_as_float(w.x & 0xffff0000u); f[2] = __uint_as_float(w.y << 16); f[3] = __uint_as_float(w.y & 0xffff0000u);
    f[4] = __uint_as_float(w.z << 16); f[5] = __uint_as_float(w.z & 0xffff0000u); f[6] = __uint_as_float(w.w << 16); f[7] = __uint_as_float(w.w & 0xffff0000u); }
__device__ __forceinline__ void shift_raw(const Raw3& r, const float* mu, int col, float (&o)[8]) {
    float c[8], p[8], n[8]; un8(r.c, c); un8(r.p, p); un8(r.n, n);
    const f4 m0 = *(const f4*)(mu + col), m1 = *(const f4*)(mu + col + 4);
    const float mm[8] = {m0.x, m0.y, m0.z, m0.w, m1.x, m1.y, m1.z, m1.w};
#pragma unroll
    for (int e = 0; e < 8; ++e) o[e] = c[e] + mm[e] * (0.5f * (p[e] + n[e]) - c[e]);
}
__device__ __forceinline__ void scan_fast(const Params& P, int l, unsigned char* ldsg) {
    STAGE_IDS
    unsigned char* ws = P.ws;
    const bf16* PR = (const bf16*)(ws + WS_PR); float* BONUS = (float*)(ws + WS_BONUS);
    float* VEC = (float*)(ldsg + SC_VEC);
    const int fr = lane & 15, fq = lane >> 4, ps = tid >> 3, pcg = tid & 7;
    float* XCH = (float*)(ldsg + SC_XCH); float* YP = (float*)(ldsg + SC_YP); float* VS = (float*)(ldsg + SC_VS); float* AL = (float*)(ldsg + SC_AL);
    for (int sid = blockIdx.x; sid < 256; sid += gridDim.x) {
        const int dir = sid & 1, h = (sid >> 1) & 7, b = sid >> 4, hc0 = h * 64;
        bf16* WKV = (bf16*)(ws + (dir ? WS_WKVB : WS_WKVF));
        const float* mu = P.in[I_MU] + (size_t)l * 1920;
        __syncthreads();
        {
            const float* w2b = P.in[I_W2] + (size_t)(l * 2 + dir) * 64 * 512 + (size_t)ps * 512 + hc0 + 8 * pcg;
            const float* a2b = P.in[I_A2] + (size_t)(l * 2 + dir) * 64 * 512 + (size_t)ps * 512 + hc0 + 8 * pcg;
#pragma unroll
            for (int e = 0; e < 8; ++e) { ((bf16*)(ldsg + SC_W2T))[(8 * pcg + e) * 72 + ps] = (bf16)f2bf(w2b[e]); ((bf16*)(ldsg + SC_A2T))[(8 * pcg + e) * 72 + ps] = (bf16)f2bf(a2b[e]); }
        }
        float S[8];
#pragma unroll
        for (int j = 0; j < 8; ++j) S[j] = 0.f;
        Raw3 pre[5];
#pragma unroll 1
        for (int ch = 0; ch < S_ / 64; ++ch) {
            const int step0 = ch * 64;
            const int tp = dir ? S_ - 1 - (step0 + ps) : step0 + ps;
            const int cR = hc0 + 8 * pcg, cK = 512 + hc0 + 8 * pcg, cV = 1024 + hc0 + 8 * pcg, cW = 1536 + 64 * dir + 8 * pcg, cA = 1664 + 64 * dir + 8 * pcg;
            if (ch == 0) { const bf16* pc = PR + ((size_t)(b * S_ + tp)) * 2048; const bool hasp = tp > 0, hasn = tp < S_ - 1;
                raw_load(pre[0], pc, cR, hasp, hasn); raw_load(pre[1], pc, cK, hasp, hasn); raw_load(pre[2], pc, cV, hasp, hasn); raw_load(pre[3], pc, cW, hasp, hasn); raw_load(pre[4], pc, cA, hasp, hasn); }
            float r8[8], k8[8], v8[8];
            shift_raw(pre[0], mu, cR, r8);
            shift_raw(pre[1], mu, cK, k8);
            shift_raw(pre[2], mu, cV, v8);
            { float wl[8], al[8];
              shift_raw(pre[3], mu, cW, wl);
              shift_raw(pre[4], mu, cA, al);
#pragma unroll
              for (int e = 0; e < 8; ++e) { const float t2 = __builtin_amdgcn_exp2f(2.0f * LOG2E * wl[e]); wl[e] = (t2 - 1.0f) * __builtin_amdgcn_rcpf(t2 + 1.0f); }
              v4u w1, w2v; w1.x = cvtpk(wl[0], wl[1]); w1.y = cvtpk(wl[2], wl[3]); w1.z = cvtpk(wl[4], wl[5]); w1.w = cvtpk(wl[6], wl[7]);
              w2v.x = cvtpk(al[0], al[1]); w2v.y = cvtpk(al[2], al[3]); w2v.z = cvtpk(al[4], al[5]); w2v.w = cvtpk(al[6], al[7]);
              *(v4u*)(ldsg + SC_A1 + ps * 144 + pcg * 16) = w1; *(v4u*)(ldsg + SC_A2 + ps * 144 + pcg * 16) = w2v; }
            *(f4*)(VS + ps * 64 + 8 * pcg) = (f4){v8[0], v8[1], v8[2], v8[3]}; *(f4*)(VS + ps * 64 + 8 * pcg + 4) = (f4){v8[4], v8[5], v8[6], v8[7]};
            __syncthreads();
            {
                const int wq = wave & 3; const bool isw = wave < 4;
                const unsigned char* Ab = ldsg + (isw ? SC_A1 : SC_A2) + (16 * wq + fr) * 144 + 16 * fq;
                const unsigned char* Bb = ldsg + (isw ? SC_W2T : SC_A2T) + fr * 144 + 16 * fq;
                const bf16x8_t a0 = *(const bf16x8_t*)Ab, a1 = *(const bf16x8_t*)(Ab + 64);
                const float* bias = P.in[isw ? I_W0 : I_A0] + (size_t)(l * 2 + dir) * 512 + hc0;
#pragma unroll
                for (int n = 0; n < 4; ++n) {
                    const bf16x8_t b0 = *(const bf16x8_t*)(Bb + n * 16 * 144), b1 = *(const bf16x8_t*)(Bb + n * 16 * 144 + 64);
                    f32x4m acc = (f32x4m){0.f, 0.f, 0.f, 0.f};
                    acc = __builtin_amdgcn_mfma_f32_16x16x32_bf16(a0, b0, acc, 0, 0, 0);
                    acc = __builtin_amdgcn_mfma_f32_16x16x32_bf16(a1, b1, acc, 0, 0, 0);
                    const float bz = bias[16 * n + fr];
#pragma unroll
                    for (int v = 0; v < 4; ++v) {
                        const int st = 16 * wq + 4 * fq + v; const float x = acc[v] + bz;
                        if (isw) { const float sp = __builtin_amdgcn_logf(1.0f + __builtin_amdgcn_exp2f(-x * LOG2E)) * 0.6931471805599453f;
                                   const float wlog = -sp - 0.5f; VEC[st * 320 + (2 * n + (fr >> 3)) * 40 + (fr & 7)] = __builtin_amdgcn_exp2f(-__builtin_amdgcn_exp2f(wlog * LOG2E) * LOG2E); }
                        else AL[st * 65 + 16 * n + fr] = __builtin_amdgcn_rcpf(1.0f + __builtin_amdgcn_exp2f(-x * LOG2E));
                    }
                }
            }
            __syncthreads();
            {
                const float* kkp = P.in[I_KK] + l * 512 + hc0 + 8 * pcg; const float* kap = P.in[I_KA] + l * 512 + hc0 + 8 * pcg; const float* rkp = P.in[I_RK] + l * 512 + hc0 + 8 * pcg;
                float a8[8], kk[8], kd[8]; float ss = 0.f, bon = 0.f;
#pragma unroll
                for (int e = 0; e < 8; ++e) { a8[e] = AL[ps * 65 + 8 * pcg + e]; kk[e] = k8[e] * kkp[e]; ss += kk[e] * kk[e]; kd[e] = k8[e] * (1.0f + (a8[e] - 1.0f) * kap[e]); bon += r8[e] * kd[e] * rkp[e]; }
                ss += __shfl_xor(ss, 1); ss += __shfl_xor(ss, 2); ss += __shfl_xor(ss, 4);
                bon += __shfl_xor(bon, 1); bon += __shfl_xor(bon, 2); bon += __shfl_xor(bon, 4);
                const float rn = 1.0f / fmaxf(sqrtf(ss), 1e-12f);
                float* sp = VEC + ps * 320 + 40 * pcg;
                *(f4*)(sp + 8) = (f4){kd[0], kd[1], kd[2], kd[3]}; *(f4*)(sp + 12) = (f4){kd[4], kd[5], kd[6], kd[7]};
                *(f4*)(sp + 16) = (f4){-kk[0] * rn, -kk[1] * rn, -kk[2] * rn, -kk[3] * rn}; *(f4*)(sp + 20) = (f4){-kk[4] * rn, -kk[5] * rn, -kk[6] * rn, -kk[7] * rn};
                *(f4*)(sp + 24) = (f4){kk[0] * rn * a8[0], kk[1] * rn * a8[1], kk[2] * rn * a8[2], kk[3] * rn * a8[3]}; *(f4*)(sp + 28) = (f4){kk[4] * rn * a8[4], kk[5] * rn * a8[5], kk[6] * rn * a8[6], kk[7] * rn * a8[7]};
                *(f4*)(sp + 32) = (f4){r8[0], r8[1], r8[2], r8[3]}; *(f4*)(sp + 36) = (f4){r8[4], r8[5], r8[6], r8[7]};
                if (pcg == 0) BONUS[((size_t)((dir * NB + b) * 8 + h)) * S_ + tp] = bon;
            }
            asm volatile("s_waitcnt vmcnt(0) lgkmcnt(0)" ::: "memory");
            __syncthreads();
            {
                float* CS = (float*)(ldsg + SC_CS);
                const int p = tid >> 4, q = tid & 15;
                const float* b0 = VEC + (2 * p) * 320 + (q >> 1) * 40 + 24 + (q & 1) * 4; const float* n1 = VEC + (2 * p + 1) * 320 + (q >> 1) * 40 + 16 + (q & 1) * 4;
                float d = (b0[0] * n1[0] + b0[1] * n1[1]) + (b0[2] * n1[2] + b0[3] * n1[3]);
                d += __shfl_xor(d, 1); d += __shfl_xor(d, 2); d += __shfl_xor(d, 4); d += __shfl_xor(d, 8);
                if (q == 0) CS[p] = d;
            }
            asm volatile("s_waitcnt lgkmcnt(0)" ::: "memory");
            __syncthreads();
#define DPP_FMAC(acc, xs, val, N) asm("v_fmac_f32_dpp %0, %1, %2 row_newbcast:" #N " row_mask:0xf bank_mask:0xf" : "+v"(acc) : "v"(xs), "v"(val))
#define DPP_MUL(dst, xs, val, N) asm("v_mul_f32_dpp %0, %1, %2 row_newbcast:" #N " row_mask:0xf bank_mask:0xf" : "=v"(dst) : "v"(xs), "v"(val))
            if (ch + 1 < S_ / 64) { const int tn = dir ? S_ - 1 - (step0 + 64 + ps) : step0 + 64 + ps; const bf16* pc = PR + ((size_t)(b * S_ + tn)) * 2048; const bool hasp = tn > 0, hasn = tn < S_ - 1;
                raw_load(pre[0], pc, cR, hasp, hasn); raw_load(pre[1], pc, cK, hasp, hasn); raw_load(pre[2], pc, cV, hasp, hasn); raw_load(pre[3], pc, cW, hasp, hasn); raw_load(pre[4], pc, cA, hasp, hasn); }
            const float* vecb = VEC + wave * 40 + (lane & 15);
            const int o2 = 32 + (lane & 7) - (lane & 15);
            const float* CSr = (const float*)(ldsg + SC_CS);
            float x0 = vecb[0], x1 = vecb[16], x2 = vecb[o2], m0 = vecb[320], m1 = vecb[336], m2 = vecb[320 + o2];
            float va = VS[lane], vb = VS[64 + lane];
#define R8(M) M(0) M(1) M(2) M(3) M(4) M(5) M(6) M(7)
#pragma unroll 1
            for (int t = 0; t < 64; t += 2) {
                const float* np_ = vecb + ((t + 2) & 63) * 320; const float* nq_ = vecb + ((t + 3) & 63) * 320;
                const float nx0 = np_[0], nx1 = np_[16], nx2 = np_[o2], nm0 = nq_[0], nm1 = nq_[16], nm2 = nq_[o2];
                const float nva = VS[((t + 2) & 63) * 64 + lane], nvb = VS[((t + 3) & 63) * 64 + lane];
                const float Cc = CSr[t >> 1];
                asm volatile("s_nop 1" : "+v"(x0), "+v"(x1), "+v"(x2), "+v"(m0), "+v"(m1), "+v"(m2));
                float pa = 0.f, pb = 0.f, qa = 0.f, qb = 0.f, Tt[8];
#define M_P(j) if ((j) & 1) DPP_FMAC(pb, x1, S[j], j); else DPP_FMAC(pa, x1, S[j], j);
                R8(M_P)
#define M_T0(j) DPP_MUL(Tt[j], x0, S[j], j);
                R8(M_T0)
                DPP_FMAC(Tt[0], x0, va, 8); DPP_FMAC(Tt[1], x0, va, 9); DPP_FMAC(Tt[2], x0, va, 10); DPP_FMAC(Tt[3], x0, va, 11);
                DPP_FMAC(Tt[4], x0, va, 12); DPP_FMAC(Tt[5], x0, va, 13); DPP_FMAC(Tt[6], x0, va, 14); DPP_FMAC(Tt[7], x0, va, 15);
#define M_Q(j) if ((j) & 1) DPP_FMAC(qb, m1, Tt[j], j); else DPP_FMAC(qa, m1, Tt[j], j);
                R8(M_Q)
                const int par = (t >> 1) & 1;
                XCH[par * 1024 + wave * 64 + lane] = pa + pb; XCH[par * 1024 + 512 + wave * 64 + lane] = qa + qb;
                asm volatile("s_waitcnt lgkmcnt(0)\n\ts_barrier" ::: "memory");
                const float* xp = XCH + par * 1024 + lane;
                const float sa0 = ((xp[0] + xp[64]) + (xp[128] + xp[192])) + ((xp[256] + xp[320]) + (xp[384] + xp[448]));
                const float p1s = ((xp[512] + xp[576]) + (xp[640] + xp[704])) + ((xp[768] + xp[832]) + (xp[896] + xp[960]));
                float sa1 = p1s + sa0 * Cc;
                DPP_FMAC(Tt[0], x1, sa0, 8); DPP_FMAC(Tt[1], x1, sa0, 9); DPP_FMAC(Tt[2], x1, sa0, 10); DPP_FMAC(Tt[3], x1, sa0, 11);
                DPP_FMAC(Tt[4], x1, sa0, 12); DPP_FMAC(Tt[5], x1, sa0, 13); DPP_FMAC(Tt[6], x1, sa0, 14); DPP_FMAC(Tt[7], x1, sa0, 15);
                float ya = 0.f, yb = 0.f;
#define M_Y0(j) if ((j) & 1) DPP_FMAC(yb, x2, Tt[j], j); else DPP_FMAC(ya, x2, Tt[j], j);
                R8(M_Y0)
                YP[(t & 15) * 512 + wave * 64 + lane] = ya + yb;
#define M_T1(j) DPP_MUL(S[j], m0, Tt[j], j);
                R8(M_T1)
                DPP_FMAC(S[0], m0, vb, 8); DPP_FMAC(S[1], m0, vb, 9); DPP_FMAC(S[2], m0, vb, 10); DPP_FMAC(S[3], m0, vb, 11);
                DPP_FMAC(S[4], m0, vb, 12); DPP_FMAC(S[5], m0, vb, 13); DPP_FMAC(S[6], m0, vb, 14); DPP_FMAC(S[7], m0, vb, 15);
                DPP_FMAC(S[0], m1, sa1, 8); DPP_FMAC(S[1], m1, sa1, 9); DPP_FMAC(S[2], m1, sa1, 10); DPP_FMAC(S[3], m1, sa1, 11);
                DPP_FMAC(S[4], m1, sa1, 12); DPP_FMAC(S[5], m1, sa1, 13); DPP_FMAC(S[6], m1, sa1, 14); DPP_FMAC(S[7], m1, sa1, 15);
                float yc = 0.f, yd = 0.f;
#define M_Y1(j) if ((j) & 1) DPP_FMAC(yd, m2, S[j], j); else DPP_FMAC(yc, m2, S[j], j);
                R8(M_Y1)
                YP[((t + 1) & 15) * 512 + wave * 64 + lane] = yc + yd;
                x0 = nx0; x1 = nx1; x2 = nx2; m0 = nm0; m1 = nm1; m2 = nm2; va = nva; vb = nvb;
                if (((t + 1) & 7) == 7) {
                    asm volatile("s_waitcnt lgkmcnt(0)\n\ts_barrier" ::: "memory");
                    const int sl = (t - 6) + wave;
                    const float* yp = YP + (sl & 15) * 512 + lane;
                    const float y0 = ((yp[0] + yp[64]) + (yp[128] + yp[192])) + ((yp[256] + yp[320]) + (yp[384] + yp[448]));
                    const int tt = dir ? S_ - 1 - (step0 + sl) : step0 + sl;
                    WKV[((size_t)(b * S_ + tt)) * 512 + hc0 + lane] = (bf16)f2bf(y0);
                }
            }
#undef M_P
#undef M_T0
#undef M_Q
#undef M_Y0
#undef M_T1
#undef M_Y1
#undef R8
#undef DPP_FMAC
#undef DPP_MUL
            __syncthreads();
        }
    }
}

struct ScanRaw { float c[5], p[5], n[5]; };
__device__ __forceinline__ void scan_load(ScanRaw& R, const bf16* PR, int b, int t, const int (&cols)[5]) {
    const bf16* pc = PR + ((size_t)(b * S_ + t)) * 2048;
#pragma unroll
    for (int i = 0; i < 5; ++i) { R.c[i] = bf2f(pc[cols[i]]); R.p[i] = t > 0 ? bf2f(pc[cols[i] - 2048]) : 0.f; R.n[i] = t < S_ - 1 ? bf2f(pc[cols[i] + 2048]) : 0.f; }
}
__device__ __forceinline__ void scan_naive(const Params& P, int l, unsigned char* ldsg) {
    STAGE_IDS
    if (wave != 0) return;
    unsigned char* ws = P.ws;
    const bf16* PR = (const bf16*)(ws + WS_PR); float* BONUS = (float*)(ws + WS_BONUS);
    float* sW2 = (float*)ldsg; float* sA2 = sW2 + 4096; float* sh = sA2 + 4096; float* sv = sh + 128;
    for (int sid = blockIdx.x; sid < 256; sid += gridDim.x) {
        const int dir = sid & 1, h = (sid >> 1) & 7, b = sid >> 4, hc = h * 64 + lane;
        bf16* WKV = (bf16*)(ws + (dir ? WS_WKVB : WS_WKVF));
        const float* w2b = P.in[I_W2] + (size_t)(l * 2 + dir) * 64 * 512; const float* a2b = P.in[I_A2] + (size_t)(l * 2 + dir) * 64 * 512;
        for (int m = 0; m < 64; ++m) { sW2[m * 64 + lane] = w2b[m * 512 + hc]; sA2[m * 64 + lane] = a2b[m * 512 + hc]; }
        const float* mu = P.in[I_MU] + (size_t)l * 1920;
        const int cols[5] = {hc, 512 + hc, 1024 + hc, 1536 + 64 * dir + lane, 1664 + 64 * dir + lane};
        float mus[5];
#pragma unroll
        for (int i = 0; i < 5; ++i) mus[i] = mu[cols[i]];
        const float w0c = P.in[I_W0][(size_t)(l * 2 + dir) * 512 + hc], a0c = P.in[I_A0][(size_t)(l * 2 + dir) * 512 + hc];
        const float kkc = P.in[I_KK][l * 512 + hc], kac = P.in[I_KA][l * 512 + hc], rkc = P.in[I_RK][l * 512 + hc];
        float S[64];
#pragma unroll
        for (int j = 0; j < 64; ++j) S[j] = 0.f;
        ScanRaw cur, nxt;
        scan_load(cur, PR, b, dir ? S_ - 1 : 0, cols);
        for (int step = 0; step < S_; ++step) {
            const int t = dir ? S_ - 1 - step : step;
            if (step + 1 < S_) scan_load(nxt, PR, b, dir ? t - 1 : t + 1, cols); else nxt = cur;
            float sx[5];
#pragma unroll
            for (int i = 0; i < 5; ++i) sx[i] = cur.c[i] + mus[i] * (0.5f * (cur.p[i] + cur.n[i]) - cur.c[i]);
            const float r = sx[0], k = sx[1], v = sx[2];
            sh[lane] = tanhf(sx[3]); sh[64 + lane] = sx[4];
            float wlin = w0c, alin = a0c;
#pragma unroll 8
            for (int m = 0; m < 64; ++m) { wlin += sh[m] * sW2[m * 64 + lane]; alin += sh[64 + m] * sA2[m * 64 + lane]; }
            const float wlog = -log1pf(expf(-wlin)) - 0.5f;
            const float decay = expf(-expf(wlog));
            const float a = 1.0f / (1.0f + expf(-alin));
            float kkv = k * kkc; const float nrm = sqrtf(wave_sum(kkv * kkv)); kkv = kkv / fmaxf(nrm, 1e-12f);
            const float kd = k * (1.0f + (a - 1.0f) * kac);
            const float bon = wave_sum(r * kd * rkc);
            if (lane == 0) BONUS[((size_t)((dir * NB + b) * 8 + h)) * S_ + t] = bon;
            sv[lane] = decay; sv[64 + lane] = kd; sv[128 + lane] = -kkv; sv[192 + lane] = kkv * a; sv[256 + lane] = r;
            float sa = 0.f;
#pragma unroll
            for (int j = 0; j < 64; ++j) sa += S[j] * sv[128 + j];
            float y = 0.f;
#pragma unroll
            for (int j = 0; j < 64; ++j) { S[j] = S[j] * sv[j] + sa * sv[192 + j] + v * sv[64 + j]; y += S[j] * sv[256 + j]; }
            WKV[((size_t)(b * S_ + t)) * 512 + hc] = (bf16)f2bf(y);
            cur = nxt;
        }
    }
}


__device__ __forceinline__ void finalize_fast(const Params& P, int l, unsigned char* ldsg) {
    STAGE_IDS
    unsigned char* ws = P.ws;
    const bf16* PR = (const bf16*)(ws + WS_PR); const bf16* WF = (const bf16*)(ws + WS_WKVF); const bf16* WBk = (const bf16*)(ws + WS_WKVB); const float* BONUS = (const float*)(ws + WS_BONUS);
    bf16* YA = (bf16*)(ws + WS_YA);
    const int fr = lane & 15, fq = lane >> 4;
    const float* mu = P.in[I_MU] + (size_t)l * 1920; const float* g2 = P.in[I_G2] + (size_t)l * 128 * 512;
    const float* lngp = P.in[I_LNG] + l * 512; const float* lnbp = P.in[I_LNB] + l * 512;
    bf16x8_t gf[4][4];
#pragma unroll
    for (int n = 0; n < 4; ++n)
#pragma unroll
        for (int ks = 0; ks < 4; ++ks) { float gv[8];
#pragma unroll
            for (int e = 0; e < 8; ++e) gv[e] = g2[(size_t)(32 * ks + 8 * fq + e) * 512 + 64 * wave + 16 * n + fr];
            const v4u w = (v4u){cvtpk(gv[0], gv[1]), cvtpk(gv[2], gv[3]), cvtpk(gv[4], gv[5]), cvtpk(gv[6], gv[7])};
            gf[n][ks] = __builtin_bit_cast(bf16x8_t, w); }
    for (int tile = blockIdx.x; tile < T_ / 32; tile += gridDim.x) {
        const int t0 = tile * 32;
        __syncthreads();
        { const int tok = tid >> 4, mg = tid & 15, t = t0 + tok, s = t & 2047; float x[8];
          shifted8(PR + (size_t)t * 2048, 1792 + 8 * mg, s > 0, s < S_ - 1, mu, x);
#pragma unroll
          for (int e = 0; e < 8; ++e) x[e] = __builtin_amdgcn_rcpf(1.0f + __builtin_amdgcn_exp2f(-x[e] * LOG2E));
          *(v4u*)(ldsg + tok * 272 + mg * 16) = (v4u){cvtpk(x[0], x[1]), cvtpk(x[2], x[3]), cvtpk(x[4], x[5]), cvtpk(x[6], x[7])}; }
        __syncthreads();
#pragma unroll
        for (int mt = 0; mt < 2; ++mt) {
            f32x4m acc[4];
#pragma unroll
            for (int n = 0; n < 4; ++n) acc[n] = (f32x4m){0.f, 0.f, 0.f, 0.f};
#pragma unroll
            for (int ks = 0; ks < 4; ++ks) { const bf16x8_t bb = *(const bf16x8_t*)(ldsg + (16 * mt + fr) * 272 + (32 * ks + 8 * fq) * 2);
#pragma unroll
                for (int n = 0; n < 4; ++n) acc[n] = __builtin_amdgcn_mfma_f32_16x16x32_bf16(gf[n][ks], bb, acc[n], 0, 0, 0); }
            const int t = t0 + 16 * mt + fr, s = t & 2047, bb_ = t >> 11;
            float wk[4][4]; float sm = 0.f;
#pragma unroll
            for (int n = 0; n < 4; ++n) { const int c0 = 64 * wave + 16 * n + 4 * fq;
                const v2u a = *(const v2u*)(WF + (size_t)t * 512 + c0), b2 = *(const v2u*)(WBk + (size_t)t * 512 + c0);
                wk[n][0] = __uint_as_float(a.x << 16) + __uint_as_float(b2.x << 16); wk[n][1] = __uint_as_float(a.x & 0xffff0000u) + __uint_as_float(b2.x & 0xffff0000u);
                wk[n][2] = __uint_as_float(a.y << 16) + __uint_as_float(b2.y << 16); wk[n][3] = __uint_as_float(a.y & 0xffff0000u) + __uint_as_float(b2.y & 0xffff0000u);
                sm += (wk[n][0] + wk[n][1]) + (wk[n][2] + wk[n][3]); }
            sm += __shfl_xor(sm, 16); sm += __shfl_xor(sm, 32);
            const float mean = sm * (1.0f / 64.0f); float sq = 0.f;
#pragma unroll
            for (int n = 0; n < 4; ++n)
#pragma unroll
                for (int v = 0; v < 4; ++v) { wk[n][v] -= mean; sq += wk[n][v] * wk[n][v]; }
            sq += __shfl_xor(sq, 16); sq += __shfl_xor(sq, 32);
            const float rstd = 1.0f / sqrtf(sq * (1.0f / 64.0f) + 64e-5f);
            const float bon = BONUS[((size_t)(bb_ * 8 + wave)) * S_ + s] + BONUS[((size_t)((NB + bb_) * 8 + wave)) * S_ + s];
            const bf16* pc = PR + (size_t)t * 2048;
#pragma unroll
            for (int n = 0; n < 4; ++n) { const int c0 = 64 * wave + 16 * n + 4 * fq;
                const f4 lg = *(const f4*)(lngp + c0), lb = *(const f4*)(lnbp + c0), mv = *(const f4*)(mu + 1024 + c0);
                const v2u vc = *(const v2u*)(pc + 1024 + c0);
                v2u vp = (v2u){0u, 0u}, vn = (v2u){0u, 0u};
                if (s > 0) vp = *(const v2u*)(pc + 1024 + c0 - 2048);
                if (s < S_ - 1) vn = *(const v2u*)(pc + 1024 + c0 + 2048);
                const float cc[4] = {__uint_as_float(vc.x << 16), __uint_as_float(vc.x & 0xffff0000u), __uint_as_float(vc.y << 16), __uint_as_float(vc.y & 0xffff0000u)};
                const float pp[4] = {__uint_as_float(vp.x << 16), __uint_as_float(vp.x & 0xffff0000u), __uint_as_float(vp.y << 16), __uint_as_float(vp.y & 0xffff0000u)};
                const float nn[4] = {__uint_as_float(vn.x << 16), __uint_as_float(vn.x & 0xffff0000u), __uint_as_float(vn.y << 16), __uint_as_float(vn.y & 0xffff0000u)};
                float yv[4];
#pragma unroll
                for (int v = 0; v < 4; ++v) { const float vs = cc[v] + mv[v] * (0.5f * (pp[v] + nn[v]) - cc[v]);
                    yv[v] = (wk[n][v] * rstd * lg[v] + lb[v] + bon * vs) * acc[n][v]; }
                *(v2u*)(YA + (size_t)t * 512 + c0) = (v2u){cvtpk(yv[0], yv[1]), cvtpk(yv[2], yv[3])}; }
        }
    }
}

__device__ __forceinline__ void finalize_naive(const Params& P, int l, unsigned char* ldsg) {
    STAGE_IDS
    unsigned char* ws = P.ws;
    const bf16* PR = (const bf16*)(ws + WS_PR); const bf16* WF = (const bf16*)(ws + WS_WKVF); const bf16* WBk = (const bf16*)(ws + WS_WKVB); const float* BONUS = (const float*)(ws + WS_BONUS);
    bf16* YA = (bf16*)(ws + WS_YA);
    float* sg = (float*)ldsg;
    const float* mu = P.in[I_MU] + (size_t)l * 1920; const float* g2 = P.in[I_G2] + (size_t)l * 128 * 512;
    const float lng = P.in[I_LNG][l * 512 + tid], lnb = P.in[I_LNB][l * 512 + tid];
    const float mu_v = mu[1024 + tid], mu_g = tid < 128 ? mu[1792 + tid] : 0.f;
    for (int t = blockIdx.x; t < T_; t += gridDim.x) {
        const int s = t & 2047; const bf16* pc = PR + (size_t)t * 2048;
        if (tid < 128) { const int col = 1792 + tid; const float c = bf2f(pc[col]), p = s > 0 ? bf2f(pc[col - 2048]) : 0.f, n = s < S_ - 1 ? bf2f(pc[col + 2048]) : 0.f;
            const float x = c + mu_g * (0.5f * (p + n) - c); sg[tid] = 1.0f / (1.0f + expf(-x)); }
        __syncthreads();
        float gate = 0.f;
#pragma unroll 8
        for (int m = 0; m < 128; ++m) gate += sg[m] * g2[m * 512 + tid];
        const float wkv = bf2f(WF[(size_t)t * 512 + tid]) + bf2f(WBk[(size_t)t * 512 + tid]);
        const float mean = wave_sum(wkv) * (1.0f / 64.0f); const float dv = wkv - mean; const float var = wave_sum(dv * dv) * (1.0f / 64.0f);
        float y = dv * (1.0f / sqrtf(var + 64e-5f)) * lng + lnb;
        { const int col = 1024 + tid; const float c = bf2f(pc[col]), p = s > 0 ? bf2f(pc[col - 2048]) : 0.f, n = s < S_ - 1 ? bf2f(pc[col + 2048]) : 0.f;
          const float vs = c + mu_v * (0.5f * (p + n) - c); const int h = tid >> 6;
          const int b = t >> 11; y += (BONUS[((size_t)(b * 8 + h)) * S_ + s] + BONUS[((size_t)((NB + b) * 8 + h)) * S_ + s]) * vs; }
        YA[(size_t)t * 512 + tid] = (bf16)f2bf(y * gate);
        __syncthreads();
    }
}

#ifndef DBG_NL
#define DBG_NL NL
#endif
#ifndef DBG_BR
#define DBG_BR 7
#endif
#ifndef DBG_STOP
#define DBG_STOP 0
#endif
#define L1_INVALIDATE() do { asm volatile("s_waitcnt vmcnt(0)" ::: "memory"); __builtin_amdgcn_fence(__ATOMIC_ACQUIRE, "agent"); asm volatile("s_waitcnt vmcnt(0)" ::: "memory"); } while (0)
#define GRID_SYNC_CG() do { asm volatile("s_waitcnt vmcnt(0) lgkmcnt(0)" ::: "memory"); grid.sync(); __builtin_amdgcn_fence(__ATOMIC_ACQUIRE, "agent"); asm volatile("s_waitcnt vmcnt(0)" ::: "memory"); } while (0)
#define GRID_SYNC() grid_barrier(gbar, ground)
#define GEMM_PHASE(EPI, A_, Bt_, M_, N_, K_, E_) do { pg8::Gemm g_{(const pg8::bf16_t*)(A_), (const pg8::bf16_t*)(Bt_), (M_), (N_), (K_)}; pg8::StaticOrder S_o; S_o.init((M_), (N_), (int)gridDim.x, (int)blockIdx.x); \
    pg8::gemm_phase<EPI, pg8::StaticOrder, true, true>((PG8_LAS unsigned char*)lds, g_, S_o, (E_)); } while (0)

__device__ __forceinline__ void grid_barrier(unsigned* bar, unsigned& round) {
    asm volatile("s_waitcnt vmcnt(0) lgkmcnt(0)" ::: "memory");
    __syncthreads();
    ++round;
    if (threadIdx.x == 0) {
        __builtin_amdgcn_fence(__ATOMIC_RELEASE, "agent");
        asm volatile("s_waitcnt vmcnt(0)" ::: "memory");
        const unsigned g = blockIdx.x & 7u, G = gridDim.x, ng = (G + 7u - g) >> 3, ngroups = G < 8u ? G : 8u;
        const unsigned old = __hip_atomic_fetch_add(bar + 64 * (1 + g), 1u, __ATOMIC_RELAXED, __HIP_MEMORY_SCOPE_AGENT);
        if (old + 1u == round * ng) {
            const unsigned old2 = __hip_atomic_fetch_add(bar + 64 * 9, 1u, __ATOMIC_RELAXED, __HIP_MEMORY_SCOPE_AGENT);
            if (old2 + 1u == round * ngroups) __hip_atomic_store(bar, round, __ATOMIC_RELAXED, __HIP_MEMORY_SCOPE_AGENT);
        }
        unsigned spins = 0;
        while (__hip_atomic_load(bar, __ATOMIC_RELAXED, __HIP_MEMORY_SCOPE_AGENT) < round) { __builtin_amdgcn_s_sleep(1); if (++spins > (1u << 24)) break; }
        __builtin_amdgcn_fence(__ATOMIC_ACQUIRE, "agent");
        asm volatile("s_waitcnt vmcnt(0)" ::: "memory");
    }
    __syncthreads();
}
#ifdef TPROBE
#define TP_DECL unsigned long long tp_acc[4] = {0, 0, 0, 0}, tp_t0 = 0;
#define TP_BEGIN() do { tp_t0 = __builtin_amdgcn_s_memrealtime(); } while (0)
#define TP_END(k) do { tp_acc[k] += __builtin_amdgcn_s_memrealtime() - tp_t0; } while (0)
#else
#define TP_DECL
#define TP_BEGIN() do {} while (0)
#define TP_END(k) do {} while (0)
#endif
__global__ void __launch_bounds__(NTHREADS, 2) fwd_kernel(Params P) {
    extern __shared__ __attribute__((aligned(16))) unsigned char lds[];
    cg::grid_group grid = cg::this_grid();
    unsigned char* ws = P.ws;
    bf16* H = (bf16*)(ws + WS_H); bf16* ACT = (bf16*)(ws + WS_ACT);
    TP_DECL
#ifdef DBG_HA
    bf16* HA = (bf16*)(ws + WS_QC);
#else
    bf16* HA = H;
#endif
    float* SSB = (float*)(ws + WS_SS);
    unsigned* gbar = (unsigned*)(ws + WS_BAR); unsigned ground = 0;
    cvt_up1(P, 0, lds);
    x_to_bf16_ss(P.in[I_X], H, SSB);
    GRID_SYNC_CG();
#pragma unroll 1
    for (int l = 0; l < DBG_NL; ++l) {
        const float* xin = (l == 0) ? P.in[I_X] : P.out;
        cvt_rest(P, l, lds);
        __syncthreads();
#ifdef DUP_CVT
        cvt_rest(P, l, lds);
        __syncthreads();
#endif
        { pg8::EpiSwiglu E{(pg8::bf16_t*)ACT, FF, SSB}; GEMM_PHASE(pg8::EpiSwiglu, H, ws + ((l & 1) ? WS_WUP1B : WS_WUP1), T_, 2 * FF, DM, E); }
        GRID_SYNC();
        { pg8::EpiResid E{xin, P.out, DM, 0.5f, (pg8::bf16_t*)H, SSB}; GEMM_PHASE(pg8::EpiResid, ACT, ws + WS_WDN1, T_, DM, FF, E); }
        GRID_SYNC();
        { pg8::EpiWin E{(pg8::bf16_t*)(ws + WS_PR), (pg8::bf16_t*)(ws + WS_QB), (pg8::bf16_t*)(ws + WS_KVB), (pg8::bf16_t*)(ws + WS_QC), (pg8::bf16_t*)(ws + WS_KVC), SSB};
          GEMM_PHASE(pg8::EpiWin, H, ws + WS_WIN, T_, 3584, DM, E); }
        GRID_SYNC();
#ifdef DUP_SYNC
        GRID_SYNC(); GRID_SYNC(); GRID_SYNC(); GRID_SYNC(); GRID_SYNC(); GRID_SYNC(); GRID_SYNC(); GRID_SYNC();
#endif
#ifdef DUP_QK
        qkprep(P, l, true);
#endif
        qkprep(P, l);
        vt_prep(P, lds);
        __syncthreads();
        scan_fast(P, l, lds);
#ifdef DUP_SCAN
        __syncthreads();
        scan_fast(P, l, lds);
#endif
#ifdef DUP_PREP
        __syncthreads();
        vt_prep(P, lds);
#endif
        GRID_SYNC();
#ifdef DUP_ATTN
        attn_mfma<false>((bf16*)(ws + WS_QB), (const bf16*)(ws + WS_KG), (const bf16*)(ws + WS_VG), nullptr, lds, (bf16*)(ws + WS_YA));
        attn_mfma<true>((bf16*)(ws + WS_QC), (const bf16*)(ws + WS_KW), (const bf16*)(ws + WS_VW), P.in[I_SINK] + l * 8, lds, (bf16*)(ws + WS_YA));
#endif
        attn_mfma<false>((bf16*)(ws + WS_QB), (const bf16*)(ws + WS_KG), (const bf16*)(ws + WS_VG), nullptr, lds);
        attn_mfma<true>((bf16*)(ws + WS_QC), (const bf16*)(ws + WS_KW), (const bf16*)(ws + WS_VW), P.in[I_SINK] + l * 8, lds);
        __syncthreads();
        finalize_fast(P, l, lds);
#ifdef DUP_FIN
        finalize_fast(P, l, lds);
#endif
        GRID_SYNC();
#pragma unroll 1
        for (int i = 0; i < 3; ++i) {
            { pg8::EpiGate E{(pg8::bf16_t*)(ws + WS_GATE), SSB}; GEMM_PHASE(pg8::EpiGate, H, ws + WS_WG + (size_t)i * DM * DM * 2, T_, DM, DM, E); }
            const unsigned char* yi = ws + (i == 0 ? WS_YA : (i == 1 ? WS_QB : WS_QC));
            { pg8::EpiMerge E{(const pg8::bf16_t*)(ws + WS_GATE), (pg8::bf16_t*)(ws + WS_MERGED), i == 0 ? 1 : 0}; GEMM_PHASE(pg8::EpiMerge, yi, ws + WS_WO + (size_t)i * DM * 512 * 2, T_, DM, 512, E); }
        }
        GRID_SYNC();
        { pg8::EpiResid E{P.out, P.out, DM, 1.0f, (pg8::bf16_t*)H, SSB}; GEMM_PHASE(pg8::EpiResid, ws + WS_MERGED, ws + WS_WOUT, T_, DM, DM, E); }
        GRID_SYNC();
        { pg8::EpiSwiglu E{(pg8::bf16_t*)ACT, FF, SSB}; GEMM_PHASE(pg8::EpiSwiglu, H, ws + WS_WUP2, T_, 2 * FF, DM, E); }
#ifdef DUP_UP
        { pg8::EpiSwiglu E{(pg8::bf16_t*)ACT, FF, SSB}; GEMM_PHASE(pg8::EpiSwiglu, H, ws + WS_WUP2, T_, 2 * FF, DM, E); }
#endif
        GRID_SYNC();
        if (l + 1 < NL) { cvt_up1(P, l + 1, lds); __syncthreads(); }
        { pg8::EpiResid E{P.out, P.out, DM, 0.5f, (pg8::bf16_t*)H, SSB}; GEMM_PHASE(pg8::EpiResid, ACT, ws + WS_WDN2, T_, DM, FF, E); }
        GRID_SYNC();
    }
    rms_rows_f32_inplace(P.out, P.in[I_FINN]);
#ifdef TPROBE
    {
        float* tpw = (float*)(ws + WS_SCR);
        GRID_SYNC();
        if (blockIdx.x == 0 && threadIdx.x == 0) { tpw[0] = (float)tp_acc[TPROBE_A] * 0.01f; tpw[1] = (float)tp_acc[TPROBE_B] * 0.01f; }
        GRID_SYNC();
        const float ta = tpw[0], tb = tpw[1];
        const int gt = blockIdx.x * NTHREADS + threadIdx.x;
        for (int i = gt; i < (1 << 20); i += gridDim.x * NTHREADS) P.out[i] = tb * 0.01f;
        if (gt == 0) P.out[1 << 21] = ta * 0.1f;
    }
#endif
}

extern "C" void kernel_launch(void* const* d_in, const int* in_sizes, int n_in, void* d_out, int out_size, void* d_ws, size_t ws_size, hipStream_t stream) {
    static int grid_blocks = 0;
    if (grid_blocks == 0) {
        if (n_in != N_IN || out_size != T_ * DM || ws_size < WS_END) { fprintf(stderr, "kernel_launch: unexpected shapes (n_in %d, out %d, ws %zu < %zu)\n", n_in, out_size, ws_size, (size_t)WS_END); grid_blocks = -1; return; }
        int dev = 0, cus = 0, per_cu = 0;
        hipGetDevice(&dev);
        hipDeviceGetAttribute(&cus, hipDeviceAttributeMultiprocessorCount, dev);
        hipFuncSetAttribute((const void*)fwd_kernel, hipFuncAttributeMaxDynamicSharedMemorySize, LDS_BYTES);
        hipOccupancyMaxActiveBlocksPerMultiprocessor(&per_cu, (const void*)fwd_kernel, NTHREADS, LDS_BYTES);
        if (per_cu < 1) per_cu = 1;
        grid_blocks = cus * per_cu;
    }
    if (grid_blocks < 0) return;
    Params p{};
    for (int i = 0; i < N_IN; ++i) p.in[i] = (const float*)d_in[i];
    p.out = (float*)d_out; p.ws = (unsigned char*)d_ws;
    if (hipMemsetAsync((char*)d_ws + WS_BAR, 0, 4096, stream) != hipSuccess) { fprintf(stderr, "kernel_launch: hipMemsetAsync failed\n"); return; }
    void* args[] = {&p};
    hipError_t e = hipLaunchCooperativeKernel((const void*)fwd_kernel, dim3(grid_blocks), dim3(NTHREADS), args, LDS_BYTES, stream);
    if (e != hipSuccess) fprintf(stderr, "cooperative launch failed: %s (grid %d)\n", hipGetErrorString(e), grid_blocks);
}
```

```cpp
#include <hip/hip_runtime.h>
#include <hip/hip_cooperative_groups.h>
#include <cstdio>
#include <cstdint>
namespace cg = cooperative_groups;
namespace pg8 {
#define PG8_LAS __attribute__((address_space(3)))
typedef unsigned short bf16_t;
typedef short bf16x8 __attribute__((ext_vector_type(8)));
typedef float f32x4 __attribute__((ext_vector_type(4)));
typedef unsigned u32x4 __attribute__((ext_vector_type(4)));
constexpr int BM = 256, BK = 64, HALF = 128, HTB = HALF * BK * 2  , STAGE_BYTES = 8 * HTB, NXCD = 8, WGM = 8;

__host__ __device__ __forceinline__ int lds_byte(int r, int c) { const int st = (r >> 4) * 2 + (c >> 5), rr = r & 15, cc = c & 31, ob = rr * 64 + cc * 2; return st * 1024 + (ob ^ (((ob >> 9) & 1) << 5)); }
__host__ __device__ __forceinline__ void stage_rc(int b, int& R, int& C) { const int st = b / 1024, sb = b % 1024, swz = sb ^ (((sb >> 9) & 1) << 5); R = (st >> 1) * 16 + swz / 64; C = (st & 1) * 32 + (swz % 64) / 2; }
__host__ __device__ __forceinline__ int perm32(int rho) { const int n = rho >> 4, i = rho & 15; return 8 * (i >> 2) + 4 * n + (i & 3); }

struct Unit { int pm, pn; };
struct Gemm { const bf16_t* A; const bf16_t* Bt; int M, N, K; };

struct StaticOrder {
    int nM, nN, nwg, G, c;
    __host__ __device__ void init(int M, int N, int G_, int c_) { nM = M / BM; nN = N / BM; nwg = nM * nN; G = G_; c = c_; }
    __host__ __device__ bool next(int i, Unit& u) const {
        const long L = (long)i * G + c; if (L >= nwg) return false;
        int wgid = (int)L; { const int q = nwg / NXCD, r = nwg % NXCD, xcd = wgid % NXCD, off = wgid / NXCD; wgid = (xcd < r ? xcd * (q + 1) : r * (q + 1) + (xcd - r) * q) + off; }
        const int nig = WGM * nN, gid = wgid / nig, fm = gid * WGM, gsz = (nM - fm) < WGM ? (nM - fm) : WGM;
        u.pm = fm + ((wgid % nig) % gsz); u.pn = (wgid % nig) / gsz; return true;
    }
    __device__ __forceinline__ void a_ready(const Unit&) const {}
    __device__ __forceinline__ void done(const Unit&) const {}
};
typedef float f32x2_t __attribute__((ext_vector_type(2))); typedef __bf16 bf16x2_t __attribute__((ext_vector_type(2)));
__device__ __forceinline__ unsigned cvt_pk_bf16(float lo, float hi) { f32x2_t v = {lo, hi}; bf16x2_t b = __builtin_convertvector(v, bf16x2_t); return __builtin_bit_cast(unsigned, b); }
typedef float f32x2 __attribute__((ext_vector_type(2)));
__device__ __forceinline__ float fast_sigmoid(float x) { return __builtin_amdgcn_rcpf(1.0f + __builtin_amdgcn_exp2f(-1.4426950408889634f * x)); }
__device__ __forceinline__ u32x4 ld16_agent(const bf16_t* p) { const unsigned long long a = __hip_atomic_load((const unsigned long long*)p, __ATOMIC_RELAXED, __HIP_MEMORY_SCOPE_AGENT), b = __hip_atomic_load((const unsigned long long*)p + 1, __ATOMIC_RELAXED, __HIP_MEMORY_SCOPE_AGENT); u32x4 r; r.x = (unsigned)a; r.y = (unsigned)(a >> 32); r.z = (unsigned)b; r.w = (unsigned)(b >> 32); return r; }
__device__ __forceinline__ float bf_lo(unsigned w) { return __uint_as_float(w << 16); }
__device__ __forceinline__ float bf_hi(unsigned w) { return __uint_as_float(w & 0xffff0000u); }

__device__ __forceinline__ float row_rs(const float* SS, int row) { const f32x4 a = *(const f32x4*)(SS + (size_t)row * 16), b2 = *(const f32x4*)(SS + (size_t)row * 16 + 4), c2 = *(const f32x4*)(SS + (size_t)row * 16 + 8), d = *(const f32x4*)(SS + (size_t)row * 16 + 12);
    const float s = ((a[0] + a[1]) + (a[2] + a[3])) + ((b2[0] + b2[1]) + (b2[2] + b2[3])) + ((c2[0] + c2[1]) + (c2[2] + c2[3])) + ((d[0] + d[1]) + (d[2] + d[3]));
    return 1.0f / sqrtf(s * (1.0f / 1024.0f) + 1e-6f); }
struct EpiSwiglu {
    static constexpr bool PERM = true, AFTER_DRAIN = false;
    bf16_t* O; int ldc; const float* SS;
    __device__ __forceinline__ void operator()(const f32x4 (&acc)[2][2][4][2], const Unit& u, int wr, int wc, int fr, int fq) const {
        const int row0 = u.pm * BM + wr * 64 + fr, col0 = u.pn * HALF + wc * 32 + 8 * fq;
#pragma unroll
        for (int ai = 0; ai < 2; ++ai)
#pragma unroll
            for (int m = 0; m < 4; ++m) {
                bf16_t* rowp = O + (size_t)(row0 + ai * HALF + m * 16) * ldc + col0;
                const float rs = row_rs(SS, row0 + ai * HALF + m * 16);
                float v[8];
#pragma unroll
                for (int n = 0; n < 2; ++n)
#pragma unroll
                    for (int j = 0; j < 4; ++j) { const float g = acc[ai][0][m][n][j] * rs, up = acc[ai][1][m][n][j] * rs; v[n * 4 + j] = g * fast_sigmoid(g) * up; }
                u32x4 w; w.x = cvt_pk_bf16(v[0], v[1]); w.y = cvt_pk_bf16(v[2], v[3]); w.z = cvt_pk_bf16(v[4], v[5]); w.w = cvt_pk_bf16(v[6], v[7]);
                *(u32x4*)rowp = w;
            }
    }
};
struct EpiResid {
    static constexpr bool PERM = false, AFTER_DRAIN = false;
    const float* src; float* dst; int ldc; float scale; bf16_t* XB; float* SS;
    __device__ __forceinline__ void operator()(const f32x4 (&acc)[2][2][4][2], const Unit& u, int wr, int wc, int fr, int fq) const {
        const int col0 = u.pn * BM + wc * 32 + 4 * fq;
#pragma unroll
        for (int ai = 0; ai < 2; ++ai)
#pragma unroll
            for (int m = 0; m < 4; ++m) {
                const int row = u.pm * BM + ai * HALF + wr * 64 + m * 16 + fr;
                const size_t off = (size_t)row * ldc + col0; float sq = 0.f;
#pragma unroll
                for (int bj = 0; bj < 2; ++bj)
#pragma unroll
                    for (int n = 0; n < 2; ++n) { const f32x4 b = *(const f32x4*)(src + off + bj * HALF + n * 16); const f32x4 x = b + acc[ai][bj][m][n] * scale;
                        *(f32x4*)(dst + off + bj * HALF + n * 16) = x; sq += (x[0] * x[0] + x[1] * x[1]) + (x[2] * x[2] + x[3] * x[3]);
                        typedef unsigned u32x2 __attribute__((ext_vector_type(2)));
                        *(u32x2*)(XB + off + bj * HALF + n * 16) = (u32x2){cvt_pk_bf16(x[0], x[1]), cvt_pk_bf16(x[2], x[3])}; }
                sq += __shfl_xor(sq, 16); sq += __shfl_xor(sq, 32);
                if (fq == 0) SS[(size_t)row * 16 + u.pn * 4 + wc] = sq;
            }
    }
};
struct EpiWin {
    static constexpr bool PERM = true, AFTER_DRAIN = false;
    bf16_t *PR, *QB, *KVB, *QC, *KVC; const float* SS;
    __device__ __forceinline__ void operator()(const f32x4 (&acc)[2][2][4][2], const Unit& u, int wr, int wc, int fr, int fq) const {
        bf16_t* base; int ldc, colt;
        const int pn = u.pn;
        if (pn < 8) { base = PR; ldc = 2048; colt = pn * 256; }
        else if (pn < 10) { base = QB; ldc = 512; colt = (pn - 8) * 256; }
        else if (pn == 10) { base = KVB; ldc = 256; colt = 0; }
        else if (pn < 13) { base = QC; ldc = 512; colt = (pn - 11) * 256; }
        else { base = KVC; ldc = 256; colt = 0; }
        const int row0 = u.pm * BM + wr * 64 + fr, col0 = colt + wc * 32 + 8 * fq;
#pragma unroll
        for (int ai = 0; ai < 2; ++ai)
#pragma unroll
            for (int m = 0; m < 4; ++m) {
                bf16_t* rowp = base + (size_t)(row0 + ai * HALF + m * 16) * ldc + col0;
                const float rs = row_rs(SS, row0 + ai * HALF + m * 16);
#pragma unroll
                for (int bj = 0; bj < 2; ++bj) { const f32x4 v0 = acc[ai][bj][m][0] * rs, v1 = acc[ai][bj][m][1] * rs;
                    u32x4 w; w.x = cvt_pk_bf16(v0[0], v0[1]); w.y = cvt_pk_bf16(v0[2], v0[3]); w.z = cvt_pk_bf16(v1[0], v1[1]); w.w = cvt_pk_bf16(v1[2], v1[3]);
                    *(u32x4*)(rowp + bj * HALF) = w; }
            }
    }
};
struct EpiGate {
    static constexpr bool PERM = true, AFTER_DRAIN = false;
    bf16_t* G; const float* SS;
    __device__ __forceinline__ void operator()(const f32x4 (&acc)[2][2][4][2], const Unit& u, int wr, int wc, int fr, int fq) const {
        const int row0 = u.pm * BM + wr * 64 + fr, col0 = u.pn * BM + wc * 32 + 8 * fq;
#pragma unroll
        for (int ai = 0; ai < 2; ++ai)
#pragma unroll
            for (int m = 0; m < 4; ++m) {
                bf16_t* rowp = G + (size_t)(row0 + ai * HALF + m * 16) * 1024 + col0;
                const float rs = row_rs(SS, row0 + ai * HALF + m * 16);
#pragma unroll
                for (int bj = 0; bj < 2; ++bj) { const f32x4 v0 = acc[ai][bj][m][0] * rs, v1 = acc[ai][bj][m][1] * rs;
                    u32x4 w; w.x = cvt_pk_bf16(fast_sigmoid(v0[0]), fast_sigmoid(v0[1])); w.y = cvt_pk_bf16(fast_sigmoid(v0[2]), fast_sigmoid(v0[3]));
                    w.z = cvt_pk_bf16(fast_sigmoid(v1[0]), fast_sigmoid(v1[1])); w.w = cvt_pk_bf16(fast_sigmoid(v1[2]), fast_sigmoid(v1[3]));
#ifdef DBG_GCONST
                    w = (u32x4){0x3f003f00u, 0x3f003f00u, 0x3f003f00u, 0x3f003f00u};
#endif
                    *(u32x4*)(rowp + bj * HALF) = w; }
            }
    }
};
struct EpiMerge {
    static constexpr bool PERM = true, AFTER_DRAIN = false;
    const bf16_t* G; bf16_t* Mg; int first;
    __device__ __forceinline__ void operator()(const f32x4 (&acc)[2][2][4][2], const Unit& u, int wr, int wc, int fr, int fq) const {
        const int row0 = u.pm * BM + wr * 64 + fr, col0 = u.pn * BM + wc * 32 + 8 * fq;
#pragma unroll
        for (int ai = 0; ai < 2; ++ai)
#pragma unroll
            for (int m = 0; m < 4; ++m) {
                const size_t off = (size_t)(row0 + ai * HALF + m * 16) * 1024 + col0;
#pragma unroll
                for (int bj = 0; bj < 2; ++bj) { const f32x4 v0 = acc[ai][bj][m][0], v1 = acc[ai][bj][m][1];
#ifdef DBG_NOG
                    const u32x4 g = (u32x4){0x3f803f80u, 0x3f803f80u, 0x3f803f80u, 0x3f803f80u};
#else
                    const u32x4 g = __builtin_nontemporal_load((const u32x4*)(G + off + bj * HALF));
#endif
                    float r[8];
                    r[0] = bf_lo(g.x) * v0[0]; r[1] = bf_hi(g.x) * v0[1]; r[2] = bf_lo(g.y) * v0[2]; r[3] = bf_hi(g.y) * v0[3];
                    r[4] = bf_lo(g.z) * v1[0]; r[5] = bf_hi(g.z) * v1[1]; r[6] = bf_lo(g.w) * v1[2]; r[7] = bf_hi(g.w) * v1[3];
#ifdef DBG_NOG
                    if (false) { const u32x4 p = __builtin_nontemporal_load((const u32x4*)(Mg + off + bj * HALF));
#else
                    if (!first) { const u32x4 p = __builtin_nontemporal_load((const u32x4*)(Mg + off + bj * HALF));
#endif
                        r[0] += bf_lo(p.x); r[1] += bf_hi(p.x); r[2] += bf_lo(p.y); r[3] += bf_hi(p.y); r[4] += bf_lo(p.z); r[5] += bf_hi(p.z); r[6] += bf_lo(p.w); r[7] += bf_hi(p.w); }
                    u32x4 w; w.x = cvt_pk_bf16(r[0], r[1]); w.y = cvt_pk_bf16(r[2], r[3]); w.z = cvt_pk_bf16(r[4], r[5]); w.w = cvt_pk_bf16(r[6], r[7]);
                    *(u32x4*)(Mg + off + bj * HALF) = w; }
            }
    }
};
template <class Epi, class Sched, bool ALIGN_EPI = false, bool SP2 = false>
__device__ __forceinline__ void gemm_phase(PG8_LAS unsigned char* lds, const Gemm g, const Sched& S, const Epi& E) {
    int tid_o = threadIdx.x; asm volatile("" : "+v"(tid_o));
    const int tid = tid_o, wid = __builtin_amdgcn_readfirstlane(tid >> 6), lane = tid & 63, wr = wid >> 2, wc = wid & 3, fr = lane & 15, fq = lane >> 4;
    const int K = g.K, nt = K / BK;
    unsigned voffA[2], voffB[2];
#pragma unroll
    for (int i = 0; i < 2; ++i) { int R, C; stage_rc(tid * 16 + i * 8192, R, C); const int Rb = Epi::PERM ? ((R & ~31) + perm32(R & 31)) : R;
        voffA[i] = (unsigned)(R * K + C) * 2u; voffB[i] = (unsigned)(Rb * K + C) * 2u; }
    const size_t kstep = (size_t)(BK * 2);
    const size_t hstep = (size_t)HALF * K * 2;
    const size_t tstep = 2 * hstep;
    const unsigned ldsw = (unsigned)wid * 1024u;
    const int aoff = lds_byte(wr * 64 + fr, fq * 8), boff = lds_byte(wc * 32 + fr, fq * 8);
#define PG8_SA(b, h) (((b) * 2 + (h)) * HTB)
#define PG8_SB(b, h) ((4 + (b) * 2 + (h)) * HTB)
#define PG8_STAGE(bufoff, gbase, voff) do { _Pragma("unroll") for (int _i = 0; _i < 2; ++_i) \
        __builtin_amdgcn_global_load_lds((const unsigned*)((const char*)(gbase) + (voff)[_i]), (PG8_LAS unsigned*)(lds + (bufoff) + ldsw + _i * 8192), 16, 0, 0); } while (0)
#define PG8_LDA(dst, b, h) do { _Pragma("unroll") for (int m = 0; m < 4; ++m) _Pragma("unroll") for (int k = 0; k < 2; ++k) dst[m][k] = *(const PG8_LAS bf16x8*)(lds + PG8_SA(b, h) + aoff + m * 2048 + k * 1024); } while (0)
#define PG8_LDB(dst, b, h) do { _Pragma("unroll") for (int n = 0; n < 2; ++n) _Pragma("unroll") for (int k = 0; k < 2; ++k) dst[n][k] = *(const PG8_LAS bf16x8*)(lds + PG8_SB(b, h) + boff + n * 2048 + k * 1024); } while (0)
#define PG8_MMA(ai, bj, At, Bt) do { __builtin_amdgcn_s_setprio(1); _Pragma("unroll") for (int m = 0; m < 4; ++m) _Pragma("unroll") for (int n = 0; n < 2; ++n) _Pragma("unroll") for (int k = 0; k < 2; ++k) \
        acc[ai][bj][m][n] = __builtin_amdgcn_mfma_f32_16x16x32_bf16(Bt[n][k], At[m][k], acc[ai][bj][m][n], 0, 0, 0); __builtin_amdgcn_s_setprio(0); } while (0)
#define PG8_WAIT_V(n) asm volatile("s_waitcnt vmcnt(" #n ")" ::: "memory")
#define PG8_WAIT_L(n) asm volatile("s_waitcnt lgkmcnt(" #n ")" ::: "memory")
#define PG8_BAR __builtin_amdgcn_s_barrier()
#define PG8_SCHED __builtin_amdgcn_sched_barrier(0)
    Unit cur, nxt; int ui = 0;
    if (!S.next(0, cur)) return;
    f32x4 acc[2][2][4][2];
#pragma unroll
    for (int a = 0; a < 2; ++a)
#pragma unroll
        for (int b = 0; b < 2; ++b)
#pragma unroll
            for (int m = 0; m < 4; ++m)
#pragma unroll
                for (int n = 0; n < 2; ++n) acc[a][b][m][n] = (f32x4){0.f, 0.f, 0.f, 0.f};
    bf16x8 At[4][2], B0[2][2], B1[2][2];
    const char* cA = (const char*)g.A + (size_t)cur.pm * tstep; const char* cB = (const char*)g.Bt + (size_t)cur.pn * tstep;
    S.a_ready(cur);
    if constexpr (SP2) {
        PG8_STAGE(PG8_SB(0, 0), cB, voffB); PG8_STAGE(PG8_SB(0, 1), cB + hstep, voffB); PG8_STAGE(PG8_SA(0, 0), cA, voffA); PG8_STAGE(PG8_SA(0, 1), cA + hstep, voffA);
        if (wr == 1) PG8_BAR;
        PG8_WAIT_V(2); PG8_BAR;
        PG8_STAGE(PG8_SB(1, 0), cB + kstep, voffB); PG8_STAGE(PG8_SA(1, 0), cA + kstep, voffA); PG8_STAGE(PG8_SB(1, 1), cB + hstep + kstep, voffB);
        PG8_WAIT_V(6); PG8_BAR;
    } else {
        PG8_STAGE(PG8_SB(0, 0), cB, voffB); PG8_STAGE(PG8_SA(0, 0), cA, voffA); PG8_STAGE(PG8_SB(0, 1), cB + hstep, voffB); PG8_STAGE(PG8_SA(0, 1), cA + hstep, voffA);
        if (wr == 1) PG8_BAR;
        PG8_WAIT_V(4); PG8_BAR;
        PG8_STAGE(PG8_SB(1, 0), cB + kstep, voffB); PG8_STAGE(PG8_SA(1, 0), cA + kstep, voffA); PG8_STAGE(PG8_SB(1, 1), cB + hstep + kstep, voffB);
        PG8_WAIT_V(6); PG8_BAR;
    }
    for (;;) {
        const bool has_next = S.next(ui + 1, nxt);
        const char* nA = has_next ? (const char*)g.A + (size_t)nxt.pm * tstep : cA; const char* nB = has_next ? (const char*)g.Bt + (size_t)nxt.pn * tstep : cB;
        for (int t = 0; t < nt; t += 2) {
            const bool last = (t == nt - 2);
            const char* a1 = cA + (size_t)(t + 1) * kstep;
            const char* a2 = last ? nA : cA + (size_t)(t + 2) * kstep; const char* b2 = last ? nB : cB + (size_t)(t + 2) * kstep;
            const char* a3 = a2 + kstep; const char* b3 = b2 + kstep;
            if (last && has_next) S.a_ready(nxt);
            if constexpr (SP2) {
            PG8_LDB(B0, 0, 0); PG8_LDB(B1, 0, 1); PG8_SCHED; PG8_LDA(At, 0, 0); PG8_STAGE(PG8_SA(1, 1), a1 + hstep, voffA);
            PG8_WAIT_V(8); PG8_WAIT_L(0); PG8_BAR; PG8_MMA(0, 0, At, B0); PG8_MMA(0, 1, At, B1); PG8_BAR; PG8_SCHED;
            PG8_LDA(At, 0, 1); PG8_STAGE(PG8_SB(0, 0), b2, voffB); PG8_STAGE(PG8_SB(0, 1), b2 + hstep, voffB); PG8_STAGE(PG8_SA(0, 0), a2, voffA);
            PG8_WAIT_V(8); PG8_WAIT_L(0); PG8_BAR; PG8_MMA(1, 0, At, B0); PG8_MMA(1, 1, At, B1); PG8_BAR; PG8_SCHED;
            PG8_LDB(B0, 1, 0); PG8_LDB(B1, 1, 1); PG8_SCHED; PG8_LDA(At, 1, 0); PG8_STAGE(PG8_SA(0, 1), a2 + hstep, voffA);
            PG8_WAIT_V(8); PG8_WAIT_L(0); PG8_BAR; PG8_MMA(0, 0, At, B0); PG8_MMA(0, 1, At, B1); PG8_BAR; PG8_SCHED;
            PG8_LDA(At, 1, 1); PG8_STAGE(PG8_SB(1, 0), b3, voffB); PG8_STAGE(PG8_SB(1, 1), b3 + hstep, voffB); PG8_STAGE(PG8_SA(1, 0), a3, voffA);
            PG8_WAIT_V(8); PG8_WAIT_L(0); PG8_BAR; PG8_MMA(1, 0, At, B0); PG8_MMA(1, 1, At, B1); PG8_BAR; PG8_SCHED;
            } else {
            PG8_LDB(B0, 0, 0); PG8_SCHED; PG8_LDA(At, 0, 0); PG8_STAGE(PG8_SA(1, 1), a1 + hstep, voffA);
            PG8_WAIT_L(8); PG8_BAR; PG8_WAIT_L(0); PG8_MMA(0, 0, At, B0); PG8_BAR; PG8_SCHED;
            PG8_LDB(B1, 0, 1); PG8_STAGE(PG8_SB(0, 0), b2, voffB);
            PG8_BAR; PG8_WAIT_L(0); PG8_MMA(0, 1, At, B1); PG8_BAR;
            PG8_LDA(At, 0, 1); PG8_STAGE(PG8_SA(0, 0), a2, voffA);
            PG8_BAR; PG8_WAIT_L(0); PG8_MMA(1, 0, At, B0); PG8_BAR; PG8_SCHED;
            PG8_STAGE(PG8_SB(0, 1), b2 + hstep, voffB);
            PG8_WAIT_V(6); PG8_BAR; PG8_MMA(1, 1, At, B1); PG8_BAR;
            PG8_LDB(B0, 1, 0); PG8_SCHED; PG8_LDA(At, 1, 0); PG8_STAGE(PG8_SA(0, 1), a2 + hstep, voffA);
            PG8_WAIT_L(8); PG8_BAR; PG8_WAIT_L(0); PG8_MMA(0, 0, At, B0); PG8_BAR; PG8_SCHED;
            PG8_LDB(B1, 1, 1); PG8_STAGE(PG8_SB(1, 0), b3, voffB);
            PG8_BAR; PG8_WAIT_L(0); PG8_MMA(0, 1, At, B1); PG8_BAR;
            PG8_LDA(At, 1, 1); PG8_STAGE(PG8_SA(1, 0), a3, voffA);
            PG8_BAR; PG8_WAIT_L(0); PG8_MMA(1, 0, At, B0); PG8_BAR; PG8_SCHED;
            PG8_STAGE(PG8_SB(1, 1), b3 + hstep, voffB);
            PG8_WAIT_V(6); PG8_BAR; PG8_MMA(1, 1, At, B1); PG8_BAR;
            }
        }
        if constexpr (ALIGN_EPI) { if (wr == 0) PG8_BAR; }
        if constexpr (!Epi::AFTER_DRAIN) { E(acc, cur, wr, wc, fr, fq); S.done(cur); }
        if (!has_next) break;
#pragma unroll
        for (int a = 0; a < 2; ++a)
#pragma unroll
            for (int b = 0; b < 2; ++b)
#pragma unroll
                for (int m = 0; m < 4; ++m)
#pragma unroll
                    for (int n = 0; n < 2; ++n) acc[a][b][m][n] = (f32x4){0.f, 0.f, 0.f, 0.f};
        cur = nxt; cA = nA; cB = nB; ++ui;
        if constexpr (ALIGN_EPI) { if (wr == 1) PG8_BAR; }
    }
    PG8_WAIT_V(0);
    if constexpr (!ALIGN_EPI) { if (wr == 0) PG8_BAR; }
    PG8_BAR;
    if constexpr (Epi::AFTER_DRAIN) { E.fused(acc, cur, wr, wc, fr, fq, lds, wid, lane); S.done(cur); }
#undef PG8_SA
#undef PG8_SB
#undef PG8_STAGE
#undef PG8_LDA
#undef PG8_LDB
#undef PG8_MMA
#undef PG8_WAIT_V
#undef PG8_WAIT_L
#undef PG8_BAR
#undef PG8_SCHED
}
}
#define LAS __attribute__((address_space(3)))
typedef unsigned short bf16;
typedef unsigned v4u __attribute__((ext_vector_type(4)));
typedef unsigned v2u __attribute__((ext_vector_type(2)));
typedef float f4 __attribute__((ext_vector_type(4)));
constexpr int T_ = 32768, S_ = 2048, NB = 16, DM = 1024, FF = 2816, NL = 4;
constexpr int NWAVES = 8, NTHREADS = 512;
constexpr int LDS_BYTES = 163840;
constexpr float LOG2E = 1.4426950408889634f;
constexpr float C2 = 0.125f * LOG2E;
constexpr float LOG2_THETA = 13.287712379549449f;

enum { I_X = 0, I_F1N, I_F1UP, I_F1DN, I_MIXN, I_WIN, I_MU, I_W0, I_W2, I_A0, I_A2, I_G2, I_KK, I_KA, I_RK, I_LNG, I_LNB, I_QN, I_KN, I_SINK,
       I_WOA, I_WOB, I_WOC, I_WOUT, I_F2N, I_F2UP, I_F2DN, I_FINN, N_IN };

constexpr size_t SZ_WUP = (size_t)2 * FF * DM * 2, SZ_WDN = (size_t)DM * FF * 2, SZ_WIN = (size_t)3584 * DM * 2, SZ_WG = (size_t)3072 * DM * 2,
                 SZ_WO = (size_t)3 * DM * 512 * 2, SZ_WOUT = (size_t)DM * DM * 2;
constexpr size_t WS_WUP1 = 0, WS_WDN1 = WS_WUP1 + SZ_WUP, WS_WIN = WS_WDN1 + SZ_WDN, WS_WG = WS_WIN + SZ_WIN, WS_WO = WS_WG + SZ_WG, WS_WOUT = WS_WO + SZ_WO,
                 WS_WUP2 = WS_WOUT + SZ_WOUT, WS_WDN2 = WS_WUP2 + SZ_WUP, WS_H = WS_WDN2 + SZ_WDN;
constexpr size_t WS_R = WS_H + (size_t)T_ * DM * 2;
constexpr size_t WS_ACT = WS_R;
constexpr size_t WS_PR = WS_R, WS_QB = WS_PR + (size_t)T_ * 2048 * 2, WS_KVB = WS_QB + (size_t)T_ * 512 * 2, WS_QC = WS_KVB + (size_t)T_ * 256 * 2, WS_KVC = WS_QC + (size_t)T_ * 512 * 2,
                 WS_KG = WS_KVC + (size_t)T_ * 256 * 2, WS_VG = WS_KG + (size_t)NB * 2 * S_ * 64 * 2, WS_KW = WS_VG + (size_t)NB * 2 * S_ * 64 * 2, WS_VW = WS_KW + (size_t)NB * 2 * S_ * 64 * 2,
                 WS_YA = WS_VW + (size_t)NB * 2 * S_ * 64 * 2, WS_WKVF = WS_YA + (size_t)T_ * 512 * 2, WS_WKVB = WS_WKVF + (size_t)T_ * 512 * 2, WS_BONUS = WS_WKVB + (size_t)T_ * 512 * 2,
                 WS_SCR = WS_BONUS + (size_t)T_ * 16 * 4, WS_SS = WS_SCR, WS_WUP1B = WS_SS + (size_t)T_ * 16 * 4, WS_BAR = WS_WUP1B + SZ_WUP, WS_END = WS_BAR + 4096;
#ifdef DBG_GATE_ALT
constexpr size_t WS_GATE = WS_WKVF, WS_MERGED = WS_PR + (size_t)T_ * DM * 2;
#else
constexpr size_t WS_GATE = WS_PR, WS_MERGED = WS_PR + (size_t)T_ * DM * 2;
#endif
static_assert(WS_ACT + (size_t)T_ * FF * 2 <= WS_END, "map");
static_assert(WS_END < 536000000ull, "workspace budget");

struct Params { const float* in[N_IN]; float* out; unsigned char* ws; };

__device__ __forceinline__ unsigned f2bf(float f) { unsigned u = __float_as_uint(f); return (u + 0x7fffu + ((u >> 16) & 1u)) >> 16; }
__device__ __forceinline__ unsigned pk2(float lo, float hi) { return f2bf(lo) | (f2bf(hi) << 16); }
__device__ __forceinline__ float bf2f(bf16 h) { return __uint_as_float((unsigned)h << 16); }
__device__ __forceinline__ int opaque_tid() { int t = threadIdx.x; asm volatile("" : "+v"(t)); return t; }
#define STAGE_IDS const int tid = opaque_tid(), lane = tid & 63, wave = __builtin_amdgcn_readfirstlane(tid >> 6); const int gw = blockIdx.x * NWAVES + wave, ngw = gridDim.x * NWAVES, gtid = blockIdx.x * NTHREADS + tid, gthreads = gridDim.x * NTHREADS; (void)lane; (void)gw; (void)ngw; (void)gtid; (void)gthreads;
__device__ __forceinline__ float wave_sum(float v) {
#pragma unroll
    for (int o = 1; o < 64; o <<= 1) v += __shfl_xor(v, o);
    return v;
}

__device__ __forceinline__ void cvt_wt(const float* W, int K, int ld, bf16* Wt, int nrows, int mode, int gw, int ngw, int lane, float* scr, const float* gain = nullptr) {
    const int nblk = nrows >> 5, nitems = (K >> 6) * nblk;
    for (int it = gw; it < nitems; it += ngw) {
        const int kb = it / nblk, nb = it % nblk, k0 = kb * 64, n0 = nb * 32;
        int col0;
        if (mode == 0) col0 = n0;
        else if (mode == 1) { const int t = n0 >> 8, r = n0 & 255; col0 = (r < 128) ? t * 128 + r : FF + t * 128 + (r - 128); }
        else if (mode == 2) col0 = n0 < 1920 ? n0 : (n0 < 2048 ? -1 : n0 - 128);
        else col0 = 3456 + n0;
        if (col0 >= 0) {
#pragma unroll 8
            for (int i = 0; i < 32; ++i) { const int kk = 2 * i + (lane >> 5); scr[kk * 33 + (lane & 31)] = W[(size_t)(k0 + kk) * ld + col0 + (lane & 31)] * (gain ? gain[k0 + kk] : 1.0f); }
        }
        asm volatile("s_waitcnt lgkmcnt(0)" ::: "memory");
        const int c = lane & 7;
#pragma unroll
        for (int j = 0; j < 4; ++j) { const int n = (lane >> 3) + 8 * j; const float* sp = scr + (8 * c) * 33 + n;
            v4u o = (v4u){0u, 0u, 0u, 0u};
            if (col0 >= 0) { o.x = pk2(sp[0 * 33], sp[1 * 33]); o.y = pk2(sp[2 * 33], sp[3 * 33]); o.z = pk2(sp[4 * 33], sp[5 * 33]); o.w = pk2(sp[6 * 33], sp[7 * 33]); }
            *(v4u*)(Wt + (size_t)(n0 + n) * K + k0 + 8 * c) = o; }
        asm volatile("s_waitcnt lgkmcnt(0)" ::: "memory");
    }
}
__device__ __forceinline__ void cvt_up1(const Params& P, int l, unsigned char* ldsg) {
    STAGE_IDS
    unsigned char* ws = P.ws; float* scr = (float*)(ldsg + wave * 8448);
    cvt_wt(P.in[I_F1UP] + (size_t)l * DM * 2 * FF, DM, 2 * FF, (bf16*)(ws + ((l & 1) ? WS_WUP1B : WS_WUP1)), 2 * FF, 1, gw, ngw, lane, scr, P.in[I_F1N] + l * DM);
}
__device__ __forceinline__ void cvt_rest(const Params& P, int l, unsigned char* ldsg) {
    STAGE_IDS
    unsigned char* ws = P.ws; float* scr = (float*)(ldsg + wave * 8448);
    cvt_wt(P.in[I_F1DN] + (size_t)l * FF * DM, FF, DM, (bf16*)(ws + WS_WDN1), DM, 0, gw, ngw, lane, scr);
    cvt_wt(P.in[I_WIN] + (size_t)l * DM * 6528, DM, 6528, (bf16*)(ws + WS_WIN), 3584, 2, gw, ngw, lane, scr, P.in[I_MIXN] + l * DM);
    cvt_wt(P.in[I_WIN] + (size_t)l * DM * 6528, DM, 6528, (bf16*)(ws + WS_WG), 3072, 3, gw, ngw, lane, scr, P.in[I_MIXN] + l * DM);
    cvt_wt(P.in[I_WOA] + (size_t)l * 512 * DM, 512, DM, (bf16*)(ws + WS_WO), DM, 0, gw, ngw, lane, scr);
    cvt_wt(P.in[I_WOB] + (size_t)l * 512 * DM, 512, DM, (bf16*)(ws + WS_WO) + (size_t)DM * 512, DM, 0, gw, ngw, lane, scr);
    cvt_wt(P.in[I_WOC] + (size_t)l * 512 * DM, 512, DM, (bf16*)(ws + WS_WO) + (size_t)2 * DM * 512, DM, 0, gw, ngw, lane, scr);
    cvt_wt(P.in[I_WOUT] + (size_t)l * DM * DM, DM, DM, (bf16*)(ws + WS_WOUT), DM, 0, gw, ngw, lane, scr);
    cvt_wt(P.in[I_F2UP] + (size_t)l * DM * 2 * FF, DM, 2 * FF, (bf16*)(ws + WS_WUP2), 2 * FF, 1, gw, ngw, lane, scr, P.in[I_F2N] + l * DM);
    cvt_wt(P.in[I_F2DN] + (size_t)l * FF * DM, FF, DM, (bf16*)(ws + WS_WDN2), DM, 0, gw, ngw, lane, scr);
}
__device__ __forceinline__ void x_to_bf16_ss(const float* x, bf16* o, float* SS) {
    STAGE_IDS
    for (int m = gw; m < T_; m += ngw) {
        const f4* xr = (const f4*)(x + (size_t)m * DM) + lane; f4 v[4]; float s = 0.f;
#pragma unroll
        for (int j = 0; j < 4; ++j) { v[j] = xr[64 * j]; s += (v[j].x * v[j].x + v[j].y * v[j].y) + (v[j].z * v[j].z + v[j].w * v[j].w); }
        s = wave_sum(s);
        v2u* op = (v2u*)(o + (size_t)m * DM) + lane;
#pragma unroll
        for (int j = 0; j < 4; ++j) { v2u w; w.x = pk2(v[j].x, v[j].y); w.y = pk2(v[j].z, v[j].w); op[64 * j] = w; }
        if (lane < 16) SS[(size_t)m * 16 + lane] = lane == 0 ? s : 0.f;
    }
}

__device__ __forceinline__ void rms_rows_bf16(const float* x, const float* g, bf16* o) {
    STAGE_IDS
    const f4* gr = (const f4*)g + lane; f4 gv[4];
#pragma unroll
    for (int j = 0; j < 4; ++j) gv[j] = gr[64 * j];
    for (int m = gw; m < T_; m += ngw) {
        const f4* xr = (const f4*)(x + (size_t)m * DM) + lane; f4 v[4]; float s = 0.f;
#pragma unroll
        for (int j = 0; j < 4; ++j) { v[j] = xr[64 * j]; s += (v[j].x * v[j].x + v[j].y * v[j].y) + (v[j].z * v[j].z + v[j].w * v[j].w); }
        const float rs = 1.0f / sqrtf(wave_sum(s) * (1.0f / DM) + 1e-6f);
        v2u* op = (v2u*)(o + (size_t)m * DM) + lane;
#pragma unroll
        for (int j = 0; j < 4; ++j) { v2u w; w.x = pk2(v[j].x * rs * gv[j].x, v[j].y * rs * gv[j].y); w.y = pk2(v[j].z * rs * gv[j].z, v[j].w * rs * gv[j].w); op[64 * j] = w; }
    }
}
__device__ __forceinline__ void rms_rows_f32_inplace(float* x, const float* g) {
    STAGE_IDS
    const f4* gr = (const f4*)g + lane; f4 gv[4];
#pragma unroll
    for (int j = 0; j < 4; ++j) gv[j] = gr[64 * j];
    for (int m = gw; m < T_; m += ngw) {
        f4* xr = (f4*)(x + (size_t)m * DM) + lane; f4 v[4]; float s = 0.f;
#pragma unroll
        for (int j = 0; j < 4; ++j) { v[j] = xr[64 * j]; s += (v[j].x * v[j].x + v[j].y * v[j].y) + (v[j].z * v[j].z + v[j].w * v[j].w); }
        const float rs = 1.0f / sqrtf(wave_sum(s) * (1.0f / DM) + 1e-6f);
#pragma unroll
        for (int j = 0; j < 4; ++j) xr[64 * j] = v[j] * rs * gv[j];
    }
}

__device__ __forceinline__ float fast_sin_rev(float rev) { return __builtin_amdgcn_sinf(__builtin_amdgcn_fractf(rev)); }
__device__ __forceinline__ float fast_cos_rev(float rev) { return __builtin_amdgcn_cosf(__builtin_amdgcn_fractf(rev)); }
__device__ __forceinline__ void qkprep(const Params& P, int l, bool dummy = false) {
    STAGE_IDS
    unsigned char* ws = P.ws;
    bf16* QB = (bf16*)(ws + WS_QB); const bf16* KVB = (const bf16*)(ws + WS_KVB); bf16* QC = (bf16*)(ws + WS_QC); const bf16* KVC = (const bf16*)(ws + WS_KVC);
    bf16* KG = (bf16*)(ws + WS_KG); bf16* KW = (bf16*)(ws + WS_KW);
    const float qg = P.in[I_QN][l * 64 + lane], kg = P.in[I_KN][l * 64 + lane];
    const float inv_ax = exp2f(-(float)(lane & 15) * (LOG2_THETA / 16.0f)), inv_1d = exp2f(-(float)(lane & 31) * (LOG2_THETA / 32.0f));
    const float INV2PI = 0.15915494309189535f;
    for (int t = gw; t < T_; t += ngw) {
        const int b = t >> 11, s = t & 2047;
        const float pos = lane < 32 ? (float)(s >> 6) : (float)(s & 63);
        const float ra = (pos * inv_ax) * INV2PI, r1 = ((float)s * inv_1d) * INV2PI;
        const float csa = fast_cos_rev(ra), sna = (lane & 16) ? fast_sin_rev(ra) : -fast_sin_rev(ra);
        const float cs1 = fast_cos_rev(r1), sn1 = (lane & 32) ? fast_sin_rev(r1) : -fast_sin_rev(r1);
#pragma unroll
        for (int slot = 0; slot < 10; ++slot) {
            bf16* src = slot < 8 ? QB + (size_t)t * 512 + slot * 64 : (bf16*)KVB + (size_t)t * 256 + (slot - 8) * 64;
            const float x = bf2f(src[lane]);
            const float ss = wave_sum(x * x) * (1.0f / 64.0f);
            const float y = x * (1.0f / sqrtf(ss + 1e-6f)) * (slot < 8 ? qg : kg);
            const float r = y * csa + __shfl_xor(y, 16) * sna;
            if (slot < 8) (dummy ? (bf16*)(ws + WS_YA) + (size_t)t * 512 + slot * 64 : src)[lane] = (bf16)f2bf(r * C2);
            else KG[((size_t)(b * 2 + (slot - 8)) * S_ + s) * 64 + lane] = (bf16)f2bf(r);
        }
#pragma unroll
        for (int slot = 0; slot < 10; ++slot) {
            bf16* src = slot < 8 ? QC + (size_t)t * 512 + slot * 64 : (bf16*)KVC + (size_t)t * 256 + (slot - 8) * 64;
            const float x = bf2f(src[lane]);
            const float r = x * cs1 + __shfl_xor(x, 32) * sn1;
            if (slot < 8) (dummy ? (bf16*)(ws + WS_YA) + (size_t)t * 512 + slot * 64 : src)[lane] = (bf16)f2bf(r * C2);
            else KW[((size_t)(b * 2 + (slot - 8)) * S_ + s) * 64 + lane] = (bf16)f2bf(r);
        }
    }
}

__device__ __forceinline__ void vt_prep(const Params& P, unsigned char* ldsg) {
    STAGE_IDS
    unsigned char* ws = P.ws;
    bf16* tile = (bf16*)(ldsg + wave * 8448);
    for (int it = gw; it < 2 * NB * 2 * 32; it += ngw) {
        const int tb = it & 31, kvh = (it >> 5) & 1, b = (it >> 6) & 15, att = it >> 10;
        const bf16* src = (const bf16*)(ws + (att ? WS_KVC : WS_KVB)) + (size_t)(b * S_ + tb * 64) * 256 + 128 + kvh * 64;
        bf16* dst = (bf16*)(ws + (att ? WS_VW : WS_VG)) + (size_t)(b * 2 + kvh) * 64 * S_ + tb * 64;
#pragma unroll 8
        for (int r = 0; r < 64; ++r) tile[r * 66 + lane] = src[(size_t)r * 256 + lane];
        asm volatile("s_waitcnt lgkmcnt(0)" ::: "memory");
#pragma unroll 8
        for (int d = 0; d < 64; ++d) dst[(size_t)d * S_ + lane] = tile[lane * 66 + d];
        asm volatile("s_waitcnt lgkmcnt(0)" ::: "memory");
    }
}

typedef short bf16x8_t __attribute__((ext_vector_type(8)));
typedef short s16x4_t __attribute__((ext_vector_type(4)));
typedef float f32x16 __attribute__((ext_vector_type(16)));
typedef float f32x2a __attribute__((ext_vector_type(2))); typedef __bf16 bf16x2a __attribute__((ext_vector_type(2)));
__device__ __forceinline__ unsigned cvtpk(float lo, float hi) { f32x2a v = {lo, hi}; bf16x2a b = __builtin_convertvector(v, bf16x2a); return __builtin_bit_cast(unsigned, b); }
__device__ __forceinline__ int crow(int r, int hi) { return (r & 3) + 8 * (r >> 2) + 4 * hi; }
template <bool WINDOW>
__device__ __forceinline__ void attn_mfma(bf16* Q, const bf16* Kx, const bf16* VTx, const float* sink, unsigned char* ldsg, bf16* Oalt = nullptr) {
    STAGE_IDS
    const int r32 = lane & 31, hi = lane >> 5, g = wave >> 1, qs = wave & 1;
    const int srow = tid >> 3, sch = tid & 7;
    for (int unit = blockIdx.x; unit < 1024; unit += gridDim.x) {
        const int qb = unit & 31, kvh = (unit >> 5) & 1, b = unit >> 6, h = kvh * 4 + g, q0 = qb * 64 + qs * 32;
        bf16* qp = Q + ((size_t)(b * S_ + q0 + r32)) * 512 + h * 64;
        bf16x8_t qr[4];
#pragma unroll
        for (int d0 = 0; d0 < 4; ++d0) qr[d0] = *(const bf16x8_t*)(qp + 16 * d0 + 8 * hi);
        f32x16 o0, o1;
#pragma unroll
        for (int r = 0; r < 16; ++r) { o0[r] = 0.f; o1[r] = 0.f; }
        float m, l;
        if (WINDOW) { m = sink[h] * LOG2E; l = hi == 0 ? 1.0f : 0.f; } else { m = -1e30f; l = 0.f; }
        const int t0 = WINDOW ? (qb - 2 > 0 ? qb - 2 : 0) : 0, t1 = WINDOW ? (qb + 2 < 31 ? qb + 2 : 31) : 31;
        const bf16* kbase = Kx + (size_t)(b * 2 + kvh) * S_ * 64 + (size_t)srow * 64 + sch * 8;
        const bf16* vbase = VTx + (size_t)(b * 2 + kvh) * 64 * S_ + (size_t)srow * S_ + sch * 8;
        v4u kreg = *(const v4u*)(kbase + (size_t)t0 * 64 * 64);
        v4u vreg = *(const v4u*)(vbase + t0 * 64);
        __syncthreads();
        *(v4u*)(ldsg + srow * 144 + sch * 16) = kreg;
        *(v4u*)(ldsg + 9216 + srow * 144 + sch * 16) = vreg;
        __syncthreads();
        for (int t = t0; t <= t1; ++t) {
            const int buf = (t - t0) & 1;
            if (t < t1) { kreg = *(const v4u*)(kbase + (size_t)(t + 1) * 64 * 64); vreg = *(const v4u*)(vbase + (t + 1) * 64); }
            const unsigned char* Kb = ldsg + buf * 18432; const unsigned char* Vb = Kb + 9216;
            f32x16 p0, p1;
#pragma unroll
            for (int r = 0; r < 16; ++r) { p0[r] = 0.f; p1[r] = 0.f; }
#pragma unroll
            for (int d0 = 0; d0 < 4; ++d0) {
                const bf16x8_t a0 = *(const bf16x8_t*)(Kb + r32 * 144 + (16 * d0 + 8 * hi) * 2);
                const bf16x8_t a1 = *(const bf16x8_t*)(Kb + (32 + r32) * 144 + (16 * d0 + 8 * hi) * 2);
                p0 = __builtin_amdgcn_mfma_f32_32x32x16_bf16(a0, qr[d0], p0, 0, 0, 0);
                p1 = __builtin_amdgcn_mfma_f32_32x32x16_bf16(a1, qr[d0], p1, 0, 0, 0);
            }
            if (WINDOW) {
                const int qpos = q0 + r32;
#pragma unroll
                for (int r = 0; r < 16; ++r) { const int kv = t * 64 + crow(r, hi); int dlt = qpos - kv; dlt = dlt < 0 ? -dlt : dlt; if (dlt > 128) p0[r] = -1e30f;
                    int dl2 = qpos - (kv + 32); dl2 = dl2 < 0 ? -dl2 : dl2; if (dl2 > 128) p1[r] = -1e30f; }
            }
            float mt = fmaxf(p0[0], p1[0]);
#pragma unroll
            for (int r = 1; r < 16; ++r) mt = fmaxf(mt, fmaxf(p0[r], p1[r]));
            mt = fmaxf(mt, __shfl_xor(mt, 32));
            if (__any(mt > m)) {
                const float mn = fmaxf(m, mt), corr = __builtin_amdgcn_exp2f(m - mn); m = mn;
                l *= corr;
#pragma unroll
                for (int r = 0; r < 16; ++r) { o0[r] *= corr; o1[r] *= corr; }
            }
            float ps0 = 0.f, ps1 = 0.f;
#pragma unroll
            for (int r = 0; r < 16; ++r) { p0[r] = __builtin_amdgcn_exp2f(p0[r] - m); p1[r] = __builtin_amdgcn_exp2f(p1[r] - m); ps0 += p0[r]; ps1 += p1[r]; }
            l += ps0 + ps1;
            v4u pw[4];
            pw[0] = (v4u){cvtpk(p0[0], p0[1]), cvtpk(p0[2], p0[3]), cvtpk(p0[4], p0[5]), cvtpk(p0[6], p0[7])};
            pw[1] = (v4u){cvtpk(p0[8], p0[9]), cvtpk(p0[10], p0[11]), cvtpk(p0[12], p0[13]), cvtpk(p0[14], p0[15])};
            pw[2] = (v4u){cvtpk(p1[0], p1[1]), cvtpk(p1[2], p1[3]), cvtpk(p1[4], p1[5]), cvtpk(p1[6], p1[7])};
            pw[3] = (v4u){cvtpk(p1[8], p1[9]), cvtpk(p1[10], p1[11]), cvtpk(p1[12], p1[13]), cvtpk(p1[14], p1[15])};
#pragma unroll
            for (int kb = 0; kb < 4; ++kb) {
                const bf16x8_t pb = __builtin_bit_cast(bf16x8_t, pw[kb]);
                { const unsigned char* vp = Vb + r32 * 144 + (16 * kb + 4 * hi) * 2; const s16x4_t lo = *(const s16x4_t*)vp, hh = *(const s16x4_t*)(vp + 16);
                  const bf16x8_t a = (bf16x8_t){lo[0], lo[1], lo[2], lo[3], hh[0], hh[1], hh[2], hh[3]};
                  o0 = __builtin_amdgcn_mfma_f32_32x32x16_bf16(a, pb, o0, 0, 0, 0); }
                { const unsigned char* vp = Vb + (32 + r32) * 144 + (16 * kb + 4 * hi) * 2; const s16x4_t lo = *(const s16x4_t*)vp, hh = *(const s16x4_t*)(vp + 16);
                  const bf16x8_t a = (bf16x8_t){lo[0], lo[1], lo[2], lo[3], hh[0], hh[1], hh[2], hh[3]};
                  o1 = __builtin_amdgcn_mfma_f32_32x32x16_bf16(a, pb, o1, 0, 0, 0); }
            }
            if (t < t1) { unsigned char* nb = ldsg + (buf ^ 1) * 18432; *(v4u*)(nb + srow * 144 + sch * 16) = kreg; *(v4u*)(nb + 9216 + srow * 144 + sch * 16) = vreg; }
            __syncthreads();
        }
        l += __shfl_xor(l, 32);
        const float inv = 1.0f / l;
        if (Oalt) qp = Oalt + ((size_t)(b * S_ + q0 + r32)) * 512 + h * 64;
#pragma unroll
        for (int g4 = 0; g4 < 4; ++g4) {
            v2u w0, w1;
            w0.x = cvtpk(o0[4 * g4 + 0] * inv, o0[4 * g4 + 1] * inv); w0.y = cvtpk(o0[4 * g4 + 2] * inv, o0[4 * g4 + 3] * inv);
            w1.x = cvtpk(o1[4 * g4 + 0] * inv, o1[4 * g4 + 1] * inv); w1.y = cvtpk(o1[4 * g4 + 2] * inv, o1[4 * g4 + 3] * inv);
            *(v2u*)(qp + 8 * g4 + 4 * hi) = w0;
            *(v2u*)(qp + 32 + 8 * g4 + 4 * hi) = w1;
        }
    }
}

__device__ __forceinline__ void attn_naive(bf16* Q, const bf16* Kx, const bf16* Vx, const float* sink, int window) {
    STAGE_IDS
    for (int it = gtid; it < T_ * 8; it += gthreads) {
        const int q = it & 2047, h = (it >> 11) & 7, b = it >> 14, kvh = h >> 2;
        bf16* qp = Q + ((size_t)(b * S_ + q)) * 512 + h * 64;
        float qf[64], o[64];
#pragma unroll
        for (int c = 0; c < 8; ++c) { const v4u w = ((const v4u*)qp)[c];
            qf[c * 8 + 0] = __uint_as_float(w.x << 16); qf[c * 8 + 1] = __uint_as_float(w.x & 0xffff0000u); qf[c * 8 + 2] = __uint_as_float(w.y << 16); qf[c * 8 + 3] = __uint_as_float(w.y & 0xffff0000u);
            qf[c * 8 + 4] = __uint_as_float(w.z << 16); qf[c * 8 + 5] = __uint_as_float(w.z & 0xffff0000u); qf[c * 8 + 6] = __uint_as_float(w.w << 16); qf[c * 8 + 7] = __uint_as_float(w.w & 0xffff0000u); }
#pragma unroll
        for (int d = 0; d < 64; ++d) o[d] = 0.f;
        float m, lsum;
        if (sink) { m = sink[h] * LOG2E; lsum = 1.0f; } else { m = -1e30f; lsum = 0.f; }
        const int k0 = window ? (q - 128 > 0 ? q - 128 : 0) : 0, k1 = window ? (q + 128 < S_ - 1 ? q + 128 : S_ - 1) : S_ - 1;
        const bf16* kp = Kx + (size_t)(b * 2 + kvh) * S_ * 64; const bf16* vp = Vx + (size_t)(b * 2 + kvh) * S_ * 64;
        for (int k = k0; k <= k1; ++k) {
            const v4u* kr = (const v4u*)(kp + (size_t)k * 64); float s = 0.f;
#pragma unroll
            for (int c = 0; c < 8; ++c) { const v4u w = kr[c];
                s += qf[c * 8 + 0] * __uint_as_float(w.x << 16) + qf[c * 8 + 1] * __uint_as_float(w.x & 0xffff0000u) + qf[c * 8 + 2] * __uint_as_float(w.y << 16) + qf[c * 8 + 3] * __uint_as_float(w.y & 0xffff0000u)
                   + qf[c * 8 + 4] * __uint_as_float(w.z << 16) + qf[c * 8 + 5] * __uint_as_float(w.z & 0xffff0000u) + qf[c * 8 + 6] * __uint_as_float(w.w << 16) + qf[c * 8 + 7] * __uint_as_float(w.w & 0xffff0000u); }
            const float mn = fmaxf(m, s), corr = exp2f(m - mn), p = exp2f(s - mn);
            lsum = lsum * corr + p; m = mn;
            const v4u* vr = (const v4u*)(vp + (size_t)k * 64);
#pragma unroll
            for (int c = 0; c < 8; ++c) { const v4u w = vr[c];
                o[c * 8 + 0] = o[c * 8 + 0] * corr + p * __uint_as_float(w.x << 16); o[c * 8 + 1] = o[c * 8 + 1] * corr + p * __uint_as_float(w.x & 0xffff0000u);
                o[c * 8 + 2] = o[c * 8 + 2] * corr + p * __uint_as_float(w.y << 16); o[c * 8 + 3] = o[c * 8 + 3] * corr + p * __uint_as_float(w.y & 0xffff0000u);
                o[c * 8 + 4] = o[c * 8 + 4] * corr + p * __uint_as_float(w.z << 16); o[c * 8 + 5] = o[c * 8 + 5] * corr + p * __uint_as_float(w.z & 0xffff0000u);
                o[c * 8 + 6] = o[c * 8 + 6] * corr + p * __uint_as_float(w.w << 16); o[c * 8 + 7] = o[c * 8 + 7] * corr + p * __uint_as_float(w.w & 0xffff0000u); }
        }
        const float inv = 1.0f / lsum;
#pragma unroll
        for (int c = 0; c < 8; ++c) { v4u w; w.x = pk2(o[c * 8 + 0] * inv, o[c * 8 + 1] * inv); w.y = pk2(o[c * 8 + 2] * inv, o[c * 8 + 3] * inv); w.z = pk2(o[c * 8 + 4] * inv, o[c * 8 + 5] * inv); w.w = pk2(o[c * 8 + 6] * inv, o[c * 8 + 7] * inv);
            ((v4u*)qp)[c] = w; }
    }
}


typedef float f8s __attribute__((ext_vector_type(8)));
typedef float f32x4m __attribute__((ext_vector_type(4)));
constexpr int SC_VEC = 0, SC_VS = 81920, SC_W2T = 98304, SC_A2T = 107520, SC_XCH = 116736, SC_YP = 124928, SC_A1 = SC_YP, SC_A2 = SC_YP + 9216, SC_AL = SC_YP + 18432, SC_CS = SC_AL + 16640, SC_END = SC_CS + 128;
static_assert(SC_END <= LDS_BYTES, "scan LDS");
__device__ __forceinline__ void ld8bf(const bf16* p, float (&f)[8]) { const v4u w = *(const v4u*)p;
    f[0] = __uint_as_float(w.x << 16); f[1] = __uint_as_float(w.x & 0xffff0000u); f[2] = __uint_as_float(w.y << 16); f[3] = __uint_as_float(w.y & 0xffff0000u);
    f[4] = __uint_as_float(w.z << 16); f[5] = __uint_as_float(w.z & 0xffff0000u); f[6] = __uint_as_float(w.w << 16); f[7] = __uint_as_float(w.w & 0xffff0000u); }
__device__ __forceinline__ void shifted8(const bf16* pc, int col, bool hasp, bool hasn, const float* mu, float (&o)[8]) {
    float c[8], p[8], n[8];
    ld8bf(pc + col, c);
    if (hasp) ld8bf(pc + col - 2048, p); else { for (int e = 0; e < 8; ++e) p[e] = 0.f; }
    if (hasn) ld8bf(pc + col + 2048, n); else { for (int e = 0; e < 8; ++e) n[e] = 0.f; }
    const f4 m0 = *(const f4*)(mu + col), m1 = *(const f4*)(mu + col + 4);
    const float mm[8] = {m0.x, m0.y, m0.z, m0.w, m1.x, m1.y, m1.z, m1.w};
#pragma unroll
    for (int e = 0; e < 8; ++e) o[e] = c[e] + mm[e] * (0.5f * (p[e] + n[e]) - c[e]);
}
struct Raw3 { v4u c, p, n; };
__device__ __forceinline__ void raw_load(Raw3& r, const bf16* pc, int col, bool hasp, bool hasn) {
    r.c = *(const v4u*)(pc + col);
    r.p = hasp ? *(const v4u*)(pc + col - 2048) : (v4u){0u, 0u, 0u, 0u};
    r.n = hasn ? *(const v4u*)(pc + col + 2048) : (v4u){0u, 0u, 0u, 0u};
}
__device__ __forceinline__ void un8(const v4u w, float (&f)[8]) {
    f[0] = __uint_as_float(w.x << 16); f[1] = __uint_as_float(w.x & 0xffff0000u); f[2] = __uint_as_float(w.y << 16); f[3] = __uint_as_float(w.y & 0xffff0000u);
    f[4] = __uint_as_float(w.z << 16); f[5] = __uint_as_float(w.z & 0xffff0000u); f[6] = __uint_as_float(w.w << 16); f[7] = __uint_as_float(w.w & 0xffff0000u); }
__device__ __forceinline__ void shift_raw(const Raw3& r, const float* mu, int col, float (&o)[8]) {
    float c[8], p[8], n[8]; un8(r.c, c); un8(r.p, p); un8(r.n, n);
    const f4 m0 = *(const f4*)(mu + col), m1 = *(const f4*)(mu + col + 4);
    const float mm[8] = {m0.x, m0.y, m0.z, m0.w, m1.x, m1.y, m1.z, m1.w};
#pragma unroll
    for (int e = 0; e < 8; ++e) o[e] = c[e] + mm[e] * (0.5f * (p[e] + n[e]) - c[e]);
}
__device__ __forceinline__ void scan_fast(const Params& P, int l, unsigned char* ldsg) {
    STAGE_IDS
    unsigned char* ws = P.ws;
    const bf16* PR = (const bf16*)(ws + WS_PR); float* BONUS = (float*)(ws + WS_BONUS);
    float* VEC = (float*)(ldsg + SC_VEC);
    const int fr = lane & 15, fq = lane >> 4, ps = tid >> 3, pcg = tid & 7;
    float* XCH = (float*)(ldsg + SC_XCH); float* YP = (float*)(ldsg + SC_YP); float* VS = (float*)(ldsg + SC_VS); float* AL = (float*)(ldsg + SC_AL);
    for (int sid = blockIdx.x; sid < 256; sid += gridDim.x) {
        const int dir = sid & 1, h = (sid >> 1) & 7, b = sid >> 4, hc0 = h * 64;
        bf16* WKV = (bf16*)(ws + (dir ? WS_WKVB : WS_WKVF));
        const float* mu = P.in[I_MU] + (size_t)l * 1920;
        __syncthreads();
        {
            const float* w2b = P.in[I_W2] + (size_t)(l * 2 + dir) * 64 * 512 + (size_t)ps * 512 + hc0 + 8 * pcg;
            const float* a2b = P.in[I_A2] + (size_t)(l * 2 + dir) * 64 * 512 + (size_t)ps * 512 + hc0 + 8 * pcg;
#pragma unroll
            for (int e = 0; e < 8; ++e) { ((bf16*)(ldsg + SC_W2T))[(8 * pcg + e) * 72 + ps] = (bf16)f2bf(w2b[e]); ((bf16*)(ldsg + SC_A2T))[(8 * pcg + e) * 72 + ps] = (bf16)f2bf(a2b[e]); }
        }
        float S[8];
#pragma unroll
        for (int j = 0; j < 8; ++j) S[j] = 0.f;
        Raw3 pre[5];
#pragma unroll 1
        for (int ch = 0; ch < S_ / 64; ++ch) {
            const int step0 = ch * 64;
            const int tp = dir ? S_ - 1 - (step0 + ps) : step0 + ps;
            const int cR = hc0 + 8 * pcg, cK = 512 + hc0 + 8 * pcg, cV = 1024 + hc0 + 8 * pcg, cW = 1536 + 64 * dir + 8 * pcg, cA = 1664 + 64 * dir + 8 * pcg;
            if (ch == 0) { const bf16* pc = PR + ((size_t)(b * S_ + tp)) * 2048; const bool hasp = tp > 0, hasn = tp < S_ - 1;
                raw_load(pre[0], pc, cR, hasp, hasn); raw_load(pre[1], pc, cK, hasp, hasn); raw_load(pre[2], pc, cV, hasp, hasn); raw_load(pre[3], pc, cW, hasp, hasn); raw_load(pre[4], pc, cA, hasp, hasn); }
            float r8[8], k8[8], v8[8];
            shift_raw(pre[0], mu, cR, r8);
            shift_raw(pre[1], mu, cK, k8);
            shift_raw(pre[2], mu, cV, v8);
            { float wl[8], al[8];
              shift_raw(pre[3], mu, cW, wl);
              shift_raw(pre[4], mu, cA, al);
#pragma unroll
              for (int e = 0; e < 8; ++e) { const float t2 = __builtin_amdgcn_exp2f(2.0f * LOG2E * wl[e]); wl[e] = (t2 - 1.0f) * __builtin_amdgcn_rcpf(t2 + 1.0f); }
              v4u w1, w2v; w1.x = cvtpk(wl[0], wl[1]); w1.y = cvtpk(wl[2], wl[3]); w1.z = cvtpk(wl[4], wl[5]); w1.w = cvtpk(wl[6], wl[7]);
              w2v.x = cvtpk(al[0], al[1]); w2v.y = cvtpk(al[2], al[3]); w2v.z = cvtpk(al[4], al[5]); w2v.w = cvtpk(al[6], al[7]);
              *(v4u*)(ldsg + SC_A1 + ps * 144 + pcg * 16) = w1; *(v4u*)(ldsg + SC_A2 + ps * 144 + pcg * 16) = w2v; }
            *(f4*)(VS + ps * 64 + 8 * pcg) = (f4){v8[0], v8[1], v8[2], v8[3]}; *(f4*)(VS + ps * 64 + 8 * pcg + 4) = (f4){v8[4], v8[5], v8[6], v8[7]};
            __syncthreads();
            {
                const int wq = wave & 3; const bool isw = wave < 4;
                const unsigned char* Ab = ldsg + (isw ? SC_A1 : SC_A2) + (16 * wq + fr) * 144 + 16 * fq;
                const unsigned char* Bb = ldsg + (isw ? SC_W2T : SC_A2T) + fr * 144 + 16 * fq;
                const bf16x8_t a0 = *(const bf16x8_t*)Ab, a1 = *(const bf16x8_t*)(Ab + 64);
                const float* bias = P.in[isw ? I_W0 : I_A0] + (size_t)(l * 2 + dir) * 512 + hc0;
#pragma unroll
                for (int n = 0; n < 4; ++n) {
                    const bf16x8_t b0 = *(const bf16x8_t*)(Bb + n * 16 * 144), b1 = *(const bf16x8_t*)(Bb + n * 16 * 144 + 64);
                    f32x4m acc = (f32x4m){0.f, 0.f, 0.f, 0.f};
                    acc = __builtin_amdgcn_mfma_f32_16x16x32_bf16(a0, b0, acc, 0, 0, 0);
                    acc = __builtin_amdgcn_mfma_f32_16x16x32_bf16(a1, b1, acc, 0, 0, 0);
                    const float bz = bias[16 * n + fr];
#pragma unroll
                    for (int v = 0; v < 4; ++v) {
                        const int st = 16 * wq + 4 * fq + v; const float x = acc[v] + bz;
                        if (isw) { const float sp = __builtin_amdgcn_logf(1.0f + __builtin_amdgcn_exp2f(-x * LOG2E)) * 0.6931471805599453f;
                                   const float wlog = -sp - 0.5f; VEC[st * 320 + (2 * n + (fr >> 3)) * 40 + (fr & 7)] = __builtin_amdgcn_exp2f(-__builtin_amdgcn_exp2f(wlog * LOG2E) * LOG2E); }
                        else AL[st * 65 + 16 * n + fr] = __builtin_amdgcn_rcpf(1.0f + __builtin_amdgcn_exp2f(-x * LOG2E));
                    }
                }
            }
            __syncthreads();
            {
                const float* kkp = P.in[I_KK] + l * 512 + hc0 + 8 * pcg; const float* kap = P.in[I_KA] + l * 512 + hc0 + 8 * pcg; const float* rkp = P.in[I_RK] + l * 512 + hc0 + 8 * pcg;
                float a8[8], kk[8], kd[8]; float ss = 0.f, bon = 0.f;
#pragma unroll
                for (int e = 0; e < 8; ++e) { a8[e] = AL[ps * 65 + 8 * pcg + e]; kk[e] = k8[e] * kkp[e]; ss += kk[e] * kk[e]; kd[e] = k8[e] * (1.0f + (a8[e] - 1.0f) * kap[e]); bon += r8[e] * kd[e] * rkp[e]; }
                ss += __shfl_xor(ss, 1); ss += __shfl_xor(ss, 2); ss += __shfl_xor(ss, 4);
                bon += __shfl_xor(bon, 1); bon += __shfl_xor(bon, 2); bon += __shfl_xor(bon, 4);
                const float rn = 1.0f / fmaxf(sqrtf(ss), 1e-12f);
                float* sp = VEC + ps * 320 + 40 * pcg;
                *(f4*)(sp + 8) = (f4){kd[0], kd[1], kd[2], kd[3]}; *(f4*)(sp + 12) = (f4){kd[4], kd[5], kd[6], kd[7]};
                *(f4*)(sp + 16) = (f4){-kk[0] * rn, -kk[1] * rn, -kk[2] * rn, -kk[3] * rn}; *(f4*)(sp + 20) = (f4){-kk[4] * rn, -kk[5] * rn, -kk[6] * rn, -kk[7] * rn};
                *(f4*)(sp + 24) = (f4){kk[0] * rn * a8[0], kk[1] * rn * a8[1], kk[2] * rn * a8[2], kk[3] * rn * a8[3]}; *(f4*)(sp + 28) = (f4){kk[4] * rn * a8[4], kk[5] * rn * a8[5], kk[6] * rn * a8[6], kk[7] * rn * a8[7]};
                *(f4*)(sp + 32) = (f4){r8[0], r8[1], r8[2], r8[3]}; *(f4*)(sp + 36) = (f4){r8[4], r8[5], r8[6], r8[7]};
                if (pcg == 0) BONUS[((size_t)((dir * NB + b) * 8 + h)) * S_ + tp] = bon;
            }
            asm volatile("s_waitcnt vmcnt(0) lgkmcnt(0)" ::: "memory");
            __syncthreads();
            {
                float* CS = (float*)(ldsg + SC_CS);
                const int p = tid >> 4, q = tid & 15;
                const float* b0 = VEC + (2 * p) * 320 + (q >> 1) * 40 + 24 + (q & 1) * 4; const float* n1 = VEC + (2 * p + 1) * 320 + (q >> 1) * 40 + 16 + (q & 1) * 4;
                float d = (b0[0] * n1[0] + b0[1] * n1[1]) + (b0[2] * n1[2] + b0[3] * n1[3]);
                d += __shfl_xor(d, 1); d += __shfl_xor(d, 2); d += __shfl_xor(d, 4); d += __shfl_xor(d, 8);
                if (q == 0) CS[p] = d;
            }
            asm volatile("s_waitcnt lgkmcnt(0)" ::: "memory");
            __syncthreads();
#define DPP_FMAC(acc, xs, val, N) asm("v_fmac_f32_dpp %0, %1, %2 row_newbcast:" #N " row_mask:0xf bank_mask:0xf" : "+v"(acc) : "v"(xs), "v"(val))
#define DPP_MUL(dst, xs, val, N) asm("v_mul_f32_dpp %0, %1, %2 row_newbcast:" #N " row_mask:0xf bank_mask:0xf" : "=v"(dst) : "v"(xs), "v"(val))
            if (ch + 1 < S_ / 64) { const int tn = dir ? S_ - 1 - (step0 + 64 + ps) : step0 + 64 + ps; const bf16* pc = PR + ((size_t)(b * S_ + tn)) * 2048; const bool hasp = tn > 0, hasn = tn < S_ - 1;
                raw_load(pre[0], pc, cR, hasp, hasn); raw_load(pre[1], pc, cK, hasp, hasn); raw_load(pre[2], pc, cV, hasp, hasn); raw_load(pre[3], pc, cW, hasp, hasn); raw_load(pre[4], pc, cA, hasp, hasn); }
            const float* vecb = VEC + wave * 40 + (lane & 15);
            const int o2 = 32 + (lane & 7) - (lane & 15);
            const float* CSr = (const float*)(ldsg + SC_CS);
#define R8(M) M(0) M(1) M(2) M(3) M(4) M(5) M(6) M(7)
#define R7(M) M(1) M(2) M(3) M(4) M(5) M(6) M(7)
            const int xslot = lane * 8 + ((wave + (lane >> 2)) & 7);
            auto pair_steps = [&](const int t, float& x0, float& x1, float& x2, float& m0, float& m1, float& m2, const float va, const float vb) __attribute__((always_inline)) {
                const float Cc = CSr[t >> 1];
                asm volatile("s_nop 1" : "+v"(x0), "+v"(x1), "+v"(x2), "+v"(m0), "+v"(m1), "+v"(m2));
                float pa, pb, qa, qb, Tt[8];
                DPP_MUL(pa, x1, S[0], 0); DPP_MUL(pb, x1, S[1], 1);
                DPP_FMAC(pa, x1, S[2], 2); DPP_FMAC(pb, x1, S[3], 3); DPP_FMAC(pa, x1, S[4], 4); DPP_FMAC(pb, x1, S[5], 5); DPP_FMAC(pa, x1, S[6], 6); DPP_FMAC(pb, x1, S[7], 7);
#define M_T0(j) DPP_MUL(Tt[j], x0, S[j], j);
                R8(M_T0)
                DPP_FMAC(Tt[0], x0, va, 8); DPP_FMAC(Tt[1], x0, va, 9); DPP_FMAC(Tt[2], x0, va, 10); DPP_FMAC(Tt[3], x0, va, 11);
                DPP_FMAC(Tt[4], x0, va, 12); DPP_FMAC(Tt[5], x0, va, 13); DPP_FMAC(Tt[6], x0, va, 14); DPP_FMAC(Tt[7], x0, va, 15);
                DPP_MUL(qa, m1, Tt[0], 0); DPP_MUL(qb, m1, Tt[1], 1);
                DPP_FMAC(qa, m1, Tt[2], 2); DPP_FMAC(qb, m1, Tt[3], 3); DPP_FMAC(qa, m1, Tt[4], 4); DPP_FMAC(qb, m1, Tt[5], 5); DPP_FMAC(qa, m1, Tt[6], 6); DPP_FMAC(qb, m1, Tt[7], 7);
                const int par = (t >> 1) & 1;
                XCH[par * 1024 + xslot] = pa + pb; XCH[par * 1024 + 512 + xslot] = qa + qb;
                asm volatile("s_waitcnt lgkmcnt(0)\n\ts_barrier" ::: "memory");
                const f4* xp = (const f4*)(XCH + par * 1024 + lane * 8);
                const f4 e0 = xp[0], e1 = xp[1], g0 = xp[128], g1 = xp[129];
                const f4 es = e0 + e1, gs = g0 + g1;
                float sa0 = (es.x + es.y) + (es.z + es.w);
                asm volatile("" : "+v"(sa0));
                const float p1s = (gs.x + gs.y) + (gs.z + gs.w);
                float sa1 = p1s + sa0 * Cc;
                DPP_FMAC(Tt[0], x1, sa0, 8); DPP_FMAC(Tt[1], x1, sa0, 9); DPP_FMAC(Tt[2], x1, sa0, 10); DPP_FMAC(Tt[3], x1, sa0, 11);
                DPP_FMAC(Tt[4], x1, sa0, 12); DPP_FMAC(Tt[5], x1, sa0, 13); DPP_FMAC(Tt[6], x1, sa0, 14); DPP_FMAC(Tt[7], x1, sa0, 15);
                float ya, yb;
                DPP_MUL(ya, x2, Tt[0], 0); DPP_MUL(yb, x2, Tt[1], 1);
                DPP_FMAC(ya, x2, Tt[2], 2); DPP_FMAC(yb, x2, Tt[3], 3); DPP_FMAC(ya, x2, Tt[4], 4); DPP_FMAC(yb, x2, Tt[5], 5); DPP_FMAC(ya, x2, Tt[6], 6); DPP_FMAC(yb, x2, Tt[7], 7);
                YP[(t & 15) * 512 + wave * 64 + lane] = ya + yb;
#define M_T1(j) DPP_MUL(S[j], m0, Tt[j], j);
                R8(M_T1)
                DPP_FMAC(S[0], m0, vb, 8); DPP_FMAC(S[1], m0, vb, 9); DPP_FMAC(S[2], m0, vb, 10); DPP_FMAC(S[3], m0, vb, 11);
                DPP_FMAC(S[4], m0, vb, 12); DPP_FMAC(S[5], m0, vb, 13); DPP_FMAC(S[6], m0, vb, 14); DPP_FMAC(S[7], m0, vb, 15);
                DPP_FMAC(S[0], m1, sa1, 8); DPP_FMAC(S[1], m1, sa1, 9); DPP_FMAC(S[2], m1, sa1, 10); DPP_FMAC(S[3], m1, sa1, 11);
                DPP_FMAC(S[4], m1, sa1, 12); DPP_FMAC(S[5], m1, sa1, 13); DPP_FMAC(S[6], m1, sa1, 14); DPP_FMAC(S[7], m1, sa1, 15);
                float yc, yd;
                DPP_MUL(yc, m2, S[0], 0); DPP_MUL(yd, m2, S[1], 1);
                DPP_FMAC(yc, m2, S[2], 2); DPP_FMAC(yd, m2, S[3], 3); DPP_FMAC(yc, m2, S[4], 4); DPP_FMAC(yd, m2, S[5], 5); DPP_FMAC(yc, m2, S[6], 6); DPP_FMAC(yd, m2, S[7], 7);
                YP[((t + 1) & 15) * 512 + wave * 64 + lane] = yc + yd;
                if (((t + 1) & 7) == 7) {
                    asm volatile("s_waitcnt lgkmcnt(0)\n\ts_barrier" ::: "memory");
                    const int sl = (t - 6) + wave;
                    const float* yp = YP + (sl & 15) * 512 + lane;
                    const float y0 = ((yp[0] + yp[64]) + (yp[128] + yp[192])) + ((yp[256] + yp[320]) + (yp[384] + yp[448]));
                    const int tt = dir ? S_ - 1 - (step0 + sl) : step0 + sl;
                    WKV[((size_t)(b * S_ + tt)) * 512 + hc0 + lane] = (bf16)f2bf(y0);
                }
            };
            float ax0 = vecb[0], ax1 = vecb[16], ax2 = vecb[o2], am0 = vecb[320], am1 = vecb[336], am2 = vecb[320 + o2], ava = VS[lane], avb = VS[64 + lane];
            float bx0, bx1, bx2, bm0, bm1, bm2, bva, bvb;
#pragma unroll 1
            for (int t = 0; t < 64; t += 4) {
                { const float* np_ = vecb + (t + 2) * 320; const float* nq_ = vecb + (t + 3) * 320;
                  bx0 = np_[0]; bx1 = np_[16]; bx2 = np_[o2]; bm0 = nq_[0]; bm1 = nq_[16]; bm2 = nq_[o2]; bva = VS[(t + 2) * 64 + lane]; bvb = VS[(t + 3) * 64 + lane]; }
                pair_steps(t, ax0, ax1, ax2, am0, am1, am2, ava, avb);
                { const float* np_ = vecb + ((t + 4) & 63) * 320; const float* nq_ = vecb + ((t + 5) & 63) * 320;
                  ax0 = np_[0]; ax1 = np_[16]; ax2 = np_[o2]; am0 = nq_[0]; am1 = nq_[16]; am2 = nq_[o2]; ava = VS[((t + 4) & 63) * 64 + lane]; avb = VS[((t + 5) & 63) * 64 + lane]; }
                pair_steps(t + 2, bx0, bx1, bx2, bm0, bm1, bm2, bva, bvb);
            }
#undef R7
#undef M_T0
#undef M_T1
#undef R8
#undef DPP_FMAC
#undef DPP_MUL
            __syncthreads();
        }
    }
}

struct ScanRaw { float c[5], p[5], n[5]; };
__device__ __forceinline__ void scan_load(ScanRaw& R, const bf16* PR, int b, int t, const int (&cols)[5]) {
    const bf16* pc = PR + ((size_t)(b * S_ + t)) * 2048;
#pragma unroll
    for (int i = 0; i < 5; ++i) { R.c[i] = bf2f(pc[cols[i]]); R.p[i] = t > 0 ? bf2f(pc[cols[i] - 2048]) : 0.f; R.n[i] = t < S_ - 1 ? bf2f(pc[cols[i] + 2048]) : 0.f; }
}
__device__ __forceinline__ void scan_naive(const Params& P, int l, unsigned char* ldsg) {
    STAGE_IDS
    if (wave != 0) return;
    unsigned char* ws = P.ws;
    const bf16* PR = (const bf16*)(ws + WS_PR); float* BONUS = (float*)(ws + WS_BONUS);
    float* sW2 = (float*)ldsg; float* sA2 = sW2 + 4096; float* sh = sA2 + 4096; float* sv = sh + 128;
    for (int sid = blockIdx.x; sid < 256; sid += gridDim.x) {
        const int dir = sid & 1, h = (sid >> 1) & 7, b = sid >> 4, hc = h * 64 + lane;
        bf16* WKV = (bf16*)(ws + (dir ? WS_WKVB : WS_WKVF));
        const float* w2b = P.in[I_W2] + (size_t)(l * 2 + dir) * 64 * 512; const float* a2b = P.in[I_A2] + (size_t)(l * 2 + dir) * 64 * 512;
        for (int m = 0; m < 64; ++m) { sW2[m * 64 + lane] = w2b[m * 512 + hc]; sA2[m * 64 + lane] = a2b[m * 512 + hc]; }
        const float* mu = P.in[I_MU] + (size_t)l * 1920;
        const int cols[5] = {hc, 512 + hc, 1024 + hc, 1536 + 64 * dir + lane, 1664 + 64 * dir + lane};
        float mus[5];
#pragma unroll
        for (int i = 0; i < 5; ++i) mus[i] = mu[cols[i]];
        const float w0c = P.in[I_W0][(size_t)(l * 2 + dir) * 512 + hc], a0c = P.in[I_A0][(size_t)(l * 2 + dir) * 512 + hc];
        const float kkc = P.in[I_KK][l * 512 + hc], kac = P.in[I_KA][l * 512 + hc], rkc = P.in[I_RK][l * 512 + hc];
        float S[64];
#pragma unroll
        for (int j = 0; j < 64; ++j) S[j] = 0.f;
        ScanRaw cur, nxt;
        scan_load(cur, PR, b, dir ? S_ - 1 : 0, cols);
        for (int step = 0; step < S_; ++step) {
            const int t = dir ? S_ - 1 - step : step;
            if (step + 1 < S_) scan_load(nxt, PR, b, dir ? t - 1 : t + 1, cols); else nxt = cur;
            float sx[5];
#pragma unroll
            for (int i = 0; i < 5; ++i) sx[i] = cur.c[i] + mus[i] * (0.5f * (cur.p[i] + cur.n[i]) - cur.c[i]);
            const float r = sx[0], k = sx[1], v = sx[2];
            sh[lane] = tanhf(sx[3]); sh[64 + lane] = sx[4];
            float wlin = w0c, alin = a0c;
#pragma unroll 8
            for (int m = 0; m < 64; ++m) { wlin += sh[m] * sW2[m * 64 + lane]; alin += sh[64 + m] * sA2[m * 64 + lane]; }
            const float wlog = -log1pf(expf(-wlin)) - 0.5f;
            const float decay = expf(-expf(wlog));
            const float a = 1.0f / (1.0f + expf(-alin));
            float kkv = k * kkc; const float nrm = sqrtf(wave_sum(kkv * kkv)); kkv = kkv / fmaxf(nrm, 1e-12f);
            const float kd = k * (1.0f + (a - 1.0f) * kac);
            const float bon = wave_sum(r * kd * rkc);
            if (lane == 0) BONUS[((size_t)((dir * NB + b) * 8 + h)) * S_ + t] = bon;
            sv[lane] = decay; sv[64 + lane] = kd; sv[128 + lane] = -kkv; sv[192 + lane] = kkv * a; sv[256 + lane] = r;
            float sa = 0.f;
#pragma unroll
            for (int j = 0; j < 64; ++j) sa += S[j] * sv[128 + j];
            float y = 0.f;
#pragma unroll
            for (int j = 0; j < 64; ++j) { S[j] = S[j] * sv[j] + sa * sv[192 + j] + v * sv[64 + j]; y += S[j] * sv[256 + j]; }
            WKV[((size_t)(b * S_ + t)) * 512 + hc] = (bf16)f2bf(y);
            cur = nxt;
        }
    }
}


__device__ __forceinline__ void finalize_fast(const Params& P, int l, unsigned char* ldsg) {
    STAGE_IDS
    unsigned char* ws = P.ws;
    const bf16* PR = (const bf16*)(ws + WS_PR); const bf16* WF = (const bf16*)(ws + WS_WKVF); const bf16* WBk = (const bf16*)(ws + WS_WKVB); const float* BONUS = (const float*)(ws + WS_BONUS);
    bf16* YA = (bf16*)(ws + WS_YA);
    const int fr = lane & 15, fq = lane >> 4;
    const float* mu = P.in[I_MU] + (size_t)l * 1920; const float* g2 = P.in[I_G2] + (size_t)l * 128 * 512;
    const float* lngp = P.in[I_LNG] + l * 512; const float* lnbp = P.in[I_LNB] + l * 512;
    bf16x8_t gf[4][4];
#pragma unroll
    for (int n = 0; n < 4; ++n)
#pragma unroll
        for (int ks = 0; ks < 4; ++ks) { float gv[8];
#pragma unroll
            for (int e = 0; e < 8; ++e) gv[e] = g2[(size_t)(32 * ks + 8 * fq + e) * 512 + 64 * wave + 16 * n + fr];
            const v4u w = (v4u){cvtpk(gv[0], gv[1]), cvtpk(gv[2], gv[3]), cvtpk(gv[4], gv[5]), cvtpk(gv[6], gv[7])};
            gf[n][ks] = __builtin_bit_cast(bf16x8_t, w); }
    for (int tile = blockIdx.x; tile < T_ / 32; tile += gridDim.x) {
        const int t0 = tile * 32;
        __syncthreads();
        { const int tok = tid >> 4, mg = tid & 15, t = t0 + tok, s = t & 2047; float x[8];
          shifted8(PR + (size_t)t * 2048, 1792 + 8 * mg, s > 0, s < S_ - 1, mu, x);
#pragma unroll
          for (int e = 0; e < 8; ++e) x[e] = __builtin_amdgcn_rcpf(1.0f + __builtin_amdgcn_exp2f(-x[e] * LOG2E));
          *(v4u*)(ldsg + tok * 272 + mg * 16) = (v4u){cvtpk(x[0], x[1]), cvtpk(x[2], x[3]), cvtpk(x[4], x[5]), cvtpk(x[6], x[7])}; }
        __syncthreads();
#pragma unroll
        for (int mt = 0; mt < 2; ++mt) {
            f32x4m acc[4];
#pragma unroll
            for (int n = 0; n < 4; ++n) acc[n] = (f32x4m){0.f, 0.f, 0.f, 0.f};
#pragma unroll
            for (int ks = 0; ks < 4; ++ks) { const bf16x8_t bb = *(const bf16x8_t*)(ldsg + (16 * mt + fr) * 272 + (32 * ks + 8 * fq) * 2);
#pragma unroll
                for (int n = 0; n < 4; ++n) acc[n] = __builtin_amdgcn_mfma_f32_16x16x32_bf16(gf[n][ks], bb, acc[n], 0, 0, 0); }
            const int t = t0 + 16 * mt + fr, s = t & 2047, bb_ = t >> 11;
            float wk[4][4]; float sm = 0.f;
#pragma unroll
            for (int n = 0; n < 4; ++n) { const int c0 = 64 * wave + 16 * n + 4 * fq;
                const v2u a = *(const v2u*)(WF + (size_t)t * 512 + c0), b2 = *(const v2u*)(WBk + (size_t)t * 512 + c0);
                wk[n][0] = __uint_as_float(a.x << 16) + __uint_as_float(b2.x << 16); wk[n][1] = __uint_as_float(a.x & 0xffff0000u) + __uint_as_float(b2.x & 0xffff0000u);
                wk[n][2] = __uint_as_float(a.y << 16) + __uint_as_float(b2.y << 16); wk[n][3] = __uint_as_float(a.y & 0xffff0000u) + __uint_as_float(b2.y & 0xffff0000u);
                sm += (wk[n][0] + wk[n][1]) + (wk[n][2] + wk[n][3]); }
            sm += __shfl_xor(sm, 16); sm += __shfl_xor(sm, 32);
            const float mean = sm * (1.0f / 64.0f); float sq = 0.f;
#pragma unroll
            for (int n = 0; n < 4; ++n)
#pragma unroll
                for (int v = 0; v < 4; ++v) { wk[n][v] -= mean; sq += wk[n][v] * wk[n][v]; }
            sq += __shfl_xor(sq, 16); sq += __shfl_xor(sq, 32);
            const float rstd = 1.0f / sqrtf(sq * (1.0f / 64.0f) + 64e-5f);
            const float bon = BONUS[((size_t)(bb_ * 8 + wave)) * S_ + s] + BONUS[((size_t)((NB + bb_) * 8 + wave)) * S_ + s];
            const bf16* pc = PR + (size_t)t * 2048;
#pragma unroll
            for (int n = 0; n < 4; ++n) { const int c0 = 64 * wave + 16 * n + 4 * fq;
                const f4 lg = *(const f4*)(lngp + c0), lb = *(const f4*)(lnbp + c0), mv = *(const f4*)(mu + 1024 + c0);
                const v2u vc = *(const v2u*)(pc + 1024 + c0);
                v2u vp = (v2u){0u, 0u}, vn = (v2u){0u, 0u};
                if (s > 0) vp = *(const v2u*)(pc + 1024 + c0 - 2048);
                if (s < S_ - 1) vn = *(const v2u*)(pc + 1024 + c0 + 2048);
                const float cc[4] = {__uint_as_float(vc.x << 16), __uint_as_float(vc.x & 0xffff0000u), __uint_as_float(vc.y << 16), __uint_as_float(vc.y & 0xffff0000u)};
                const float pp[4] = {__uint_as_float(vp.x << 16), __uint_as_float(vp.x & 0xffff0000u), __uint_as_float(vp.y << 16), __uint_as_float(vp.y & 0xffff0000u)};
                const float nn[4] = {__uint_as_float(vn.x << 16), __uint_as_float(vn.x & 0xffff0000u), __uint_as_float(vn.y << 16), __uint_as_float(vn.y & 0xffff0000u)};
                float yv[4];
#pragma unroll
                for (int v = 0; v < 4; ++v) { const float vs = cc[v] + mv[v] * (0.5f * (pp[v] + nn[v]) - cc[v]);
                    yv[v] = (wk[n][v] * rstd * lg[v] + lb[v] + bon * vs) * acc[n][v]; }
                *(v2u*)(YA + (size_t)t * 512 + c0) = (v2u){cvtpk(yv[0], yv[1]), cvtpk(yv[2], yv[3])}; }
        }
    }
}

__device__ __forceinline__ void finalize_naive(const Params& P, int l, unsigned char* ldsg) {
    STAGE_IDS
    unsigned char* ws = P.ws;
    const bf16* PR = (const bf16*)(ws + WS_PR); const bf16* WF = (const bf16*)(ws + WS_WKVF); const bf16* WBk = (const bf16*)(ws + WS_WKVB); const float* BONUS = (const float*)(ws + WS_BONUS);
    bf16* YA = (bf16*)(ws + WS_YA);
    float* sg = (float*)ldsg;
    const float* mu = P.in[I_MU] + (size_t)l * 1920; const float* g2 = P.in[I_G2] + (size_t)l * 128 * 512;
    const float lng = P.in[I_LNG][l * 512 + tid], lnb = P.in[I_LNB][l * 512 + tid];
    const float mu_v = mu[1024 + tid], mu_g = tid < 128 ? mu[1792 + tid] : 0.f;
    for (int t = blockIdx.x; t < T_; t += gridDim.x) {
        const int s = t & 2047; const bf16* pc = PR + (size_t)t * 2048;
        if (tid < 128) { const int col = 1792 + tid; const float c = bf2f(pc[col]), p = s > 0 ? bf2f(pc[col - 2048]) : 0.f, n = s < S_ - 1 ? bf2f(pc[col + 2048]) : 0.f;
            const float x = c + mu_g * (0.5f * (p + n) - c); sg[tid] = 1.0f / (1.0f + expf(-x)); }
        __syncthreads();
        float gate = 0.f;
#pragma unroll 8
        for (int m = 0; m < 128; ++m) gate += sg[m] * g2[m * 512 + tid];
        const float wkv = bf2f(WF[(size_t)t * 512 + tid]) + bf2f(WBk[(size_t)t * 512 + tid]);
        const float mean = wave_sum(wkv) * (1.0f / 64.0f); const float dv = wkv - mean; const float var = wave_sum(dv * dv) * (1.0f / 64.0f);
        float y = dv * (1.0f / sqrtf(var + 64e-5f)) * lng + lnb;
        { const int col = 1024 + tid; const float c = bf2f(pc[col]), p = s > 0 ? bf2f(pc[col - 2048]) : 0.f, n = s < S_ - 1 ? bf2f(pc[col + 2048]) : 0.f;
          const float vs = c + mu_v * (0.5f * (p + n) - c); const int h = tid >> 6;
          const int b = t >> 11; y += (BONUS[((size_t)(b * 8 + h)) * S_ + s] + BONUS[((size_t)((NB + b) * 8 + h)) * S_ + s]) * vs; }
        YA[(size_t)t * 512 + tid] = (bf16)f2bf(y * gate);
        __syncthreads();
    }
}

#ifndef DBG_NL
#define DBG_NL NL
#endif
#ifndef DBG_BR
#define DBG_BR 7
#endif
#ifndef DBG_STOP
#define DBG_STOP 0
#endif
#define L1_INVALIDATE() do { asm volatile("s_waitcnt vmcnt(0)" ::: "memory"); __builtin_amdgcn_fence(__ATOMIC_ACQUIRE, "agent"); asm volatile("s_waitcnt vmcnt(0)" ::: "memory"); } while (0)
#define GRID_SYNC_CG() do { asm volatile("s_waitcnt vmcnt(0) lgkmcnt(0)" ::: "memory"); grid.sync(); __builtin_amdgcn_fence(__ATOMIC_ACQUIRE, "agent"); asm volatile("s_waitcnt vmcnt(0)" ::: "memory"); } while (0)
#define GRID_SYNC() grid_barrier(gbar, ground)
#define GEMM_PHASE(EPI, A_, Bt_, M_, N_, K_, E_) do { pg8::Gemm g_{(const pg8::bf16_t*)(A_), (const pg8::bf16_t*)(Bt_), (M_), (N_), (K_)}; pg8::StaticOrder S_o; S_o.init((M_), (N_), (int)gridDim.x, (int)blockIdx.x); \
    pg8::gemm_phase<EPI, pg8::StaticOrder, true, true>((PG8_LAS unsigned char*)lds, g_, S_o, (E_)); } while (0)

__device__ __forceinline__ void grid_barrier(unsigned* bar, unsigned& round) {
    asm volatile("s_waitcnt vmcnt(0) lgkmcnt(0)" ::: "memory");
    __syncthreads();
    ++round;
    if (threadIdx.x == 0) {
        __builtin_amdgcn_fence(__ATOMIC_RELEASE, "agent");
        asm volatile("s_waitcnt vmcnt(0)" ::: "memory");
        const unsigned g = blockIdx.x & 7u, G = gridDim.x, ng = (G + 7u - g) >> 3, ngroups = G < 8u ? G : 8u;
        const unsigned old = __hip_atomic_fetch_add(bar + 64 * (1 + g), 1u, __ATOMIC_RELAXED, __HIP_MEMORY_SCOPE_AGENT);
        if (old + 1u == round * ng) {
            const unsigned old2 = __hip_atomic_fetch_add(bar + 64 * 9, 1u, __ATOMIC_RELAXED, __HIP_MEMORY_SCOPE_AGENT);
            if (old2 + 1u == round * ngroups) __hip_atomic_store(bar, round, __ATOMIC_RELAXED, __HIP_MEMORY_SCOPE_AGENT);
        }
        unsigned spins = 0;
        while (__hip_atomic_load(bar, __ATOMIC_RELAXED, __HIP_MEMORY_SCOPE_AGENT) < round) { __builtin_amdgcn_s_sleep(1); if (++spins > (1u << 24)) break; }
        __builtin_amdgcn_fence(__ATOMIC_ACQUIRE, "agent");
        asm volatile("s_waitcnt vmcnt(0)" ::: "memory");
    }
    __syncthreads();
}
#ifdef TPROBE
#define TP_DECL unsigned long long tp_acc[4] = {0, 0, 0, 0}, tp_t0 = 0;
#define TP_BEGIN() do { tp_t0 = __builtin_amdgcn_s_memrealtime(); } while (0)
#define TP_END(k) do { tp_acc[k] += __builtin_amdgcn_s_memrealtime() - tp_t0; } while (0)
#else
#define TP_DECL
#define TP_BEGIN() do {} while (0)
#define TP_END(k) do {} while (0)
#endif
__global__ void __launch_bounds__(NTHREADS, 2) fwd_kernel(Params P) {
    extern __shared__ __attribute__((aligned(16))) unsigned char lds[];
    cg::grid_group grid = cg::this_grid();
    unsigned char* ws = P.ws;
    bf16* H = (bf16*)(ws + WS_H); bf16* ACT = (bf16*)(ws + WS_ACT);
    TP_DECL
#ifdef DBG_HA
    bf16* HA = (bf16*)(ws + WS_QC);
#else
    bf16* HA = H;
#endif
    float* SSB = (float*)(ws + WS_SS);
    unsigned* gbar = (unsigned*)(ws + WS_BAR); unsigned ground = 0;
    cvt_up1(P, 0, lds);
    x_to_bf16_ss(P.in[I_X], H, SSB);
    GRID_SYNC_CG();
#pragma unroll 1
    for (int l = 0; l < DBG_NL; ++l) {
        const float* xin = (l == 0) ? P.in[I_X] : P.out;
        cvt_rest(P, l, lds);
        __syncthreads();
#ifdef DUP_CVT
        cvt_rest(P, l, lds);
        __syncthreads();
#endif
        { pg8::EpiSwiglu E{(pg8::bf16_t*)ACT, FF, SSB}; GEMM_PHASE(pg8::EpiSwiglu, H, ws + ((l & 1) ? WS_WUP1B : WS_WUP1), T_, 2 * FF, DM, E); }
        GRID_SYNC();
        { pg8::EpiResid E{xin, P.out, DM, 0.5f, (pg8::bf16_t*)H, SSB}; GEMM_PHASE(pg8::EpiResid, ACT, ws + WS_WDN1, T_, DM, FF, E); }
        GRID_SYNC();
        { pg8::EpiWin E{(pg8::bf16_t*)(ws + WS_PR), (pg8::bf16_t*)(ws + WS_QB), (pg8::bf16_t*)(ws + WS_KVB), (pg8::bf16_t*)(ws + WS_QC), (pg8::bf16_t*)(ws + WS_KVC), SSB};
          GEMM_PHASE(pg8::EpiWin, H, ws + WS_WIN, T_, 3584, DM, E); }
        GRID_SYNC();
#ifdef DUP_SYNC
        GRID_SYNC(); GRID_SYNC(); GRID_SYNC(); GRID_SYNC(); GRID_SYNC(); GRID_SYNC(); GRID_SYNC(); GRID_SYNC();
#endif
#ifdef DUP_QK
        qkprep(P, l, true);
#endif
        qkprep(P, l);
        vt_prep(P, lds);
        __syncthreads();
        scan_fast(P, l, lds);
#ifdef DUP_SCAN
        __syncthreads();
        scan_fast(P, l, lds);
#endif
#ifdef DUP_PREP
        __syncthreads();
        vt_prep(P, lds);
#endif
        GRID_SYNC();
#ifdef DUP_ATTN
        attn_mfma<false>((bf16*)(ws + WS_QB), (const bf16*)(ws + WS_KG), (const bf16*)(ws + WS_VG), nullptr, lds, (bf16*)(ws + WS_YA));
        attn_mfma<true>((bf16*)(ws + WS_QC), (const bf16*)(ws + WS_KW), (const bf16*)(ws + WS_VW), P.in[I_SINK] + l * 8, lds, (bf16*)(ws + WS_YA));
#endif
        attn_mfma<false>((bf16*)(ws + WS_QB), (const bf16*)(ws + WS_KG), (const bf16*)(ws + WS_VG), nullptr, lds);
        attn_mfma<true>((bf16*)(ws + WS_QC), (const bf16*)(ws + WS_KW), (const bf16*)(ws + WS_VW), P.in[I_SINK] + l * 8, lds);
        __syncthreads();
        finalize_fast(P, l, lds);
#ifdef DUP_FIN
        finalize_fast(P, l, lds);
#endif
        GRID_SYNC();
#pragma unroll 1
        for (int i = 0; i < 3; ++i) {
            { pg8::EpiGate E{(pg8::bf16_t*)(ws + WS_GATE), SSB}; GEMM_PHASE(pg8::EpiGate, H, ws + WS_WG + (size_t)i * DM * DM * 2, T_, DM, DM, E); }
            const unsigned char* yi = ws + (i == 0 ? WS_YA : (i == 1 ? WS_QB : WS_QC));
            { pg8::EpiMerge E{(const pg8::bf16_t*)(ws + WS_GATE), (pg8::bf16_t*)(ws + WS_MERGED), i == 0 ? 1 : 0}; GEMM_PHASE(pg8::EpiMerge, yi, ws + WS_WO + (size_t)i * DM * 512 * 2, T_, DM, 512, E); }
        }
        GRID_SYNC();
        { pg8::EpiResid E{P.out, P.out, DM, 1.0f, (pg8::bf16_t*)H, SSB}; GEMM_PHASE(pg8::EpiResid, ws + WS_MERGED, ws + WS_WOUT, T_, DM, DM, E); }
        GRID_SYNC();
        { pg8::EpiSwiglu E{(pg8::bf16_t*)ACT, FF, SSB}; GEMM_PHASE(pg8::EpiSwiglu, H, ws + WS_WUP2, T_, 2 * FF, DM, E); }
#ifdef DUP_UP
        { pg8::EpiSwiglu E{(pg8::bf16_t*)ACT, FF, SSB}; GEMM_PHASE(pg8::EpiSwiglu, H, ws + WS_WUP2, T_, 2 * FF, DM, E); }
#endif
        GRID_SYNC();
        if (l + 1 < NL) { cvt_up1(P, l + 1, lds); __syncthreads(); }
        { pg8::EpiResid E{P.out, P.out, DM, 0.5f, (pg8::bf16_t*)H, SSB}; GEMM_PHASE(pg8::EpiResid, ACT, ws + WS_WDN2, T_, DM, FF, E); }
        GRID_SYNC();
    }
    rms_rows_f32_inplace(P.out, P.in[I_FINN]);
#ifdef TPROBE
    {
        float* tpw = (float*)(ws + WS_SCR);
        GRID_SYNC();
        if (blockIdx.x == 0 && threadIdx.x == 0) { tpw[0] = (float)tp_acc[TPROBE_A] * 0.01f; tpw[1] = (float)tp_acc[TPROBE_B] * 0.01f; }
        GRID_SYNC();
        const float ta = tpw[0], tb = tpw[1];
        const int gt = blockIdx.x * NTHREADS + threadIdx.x;
        for (int i = gt; i < (1 << 20); i += gridDim.x * NTHREADS) P.out[i] = tb * 0.01f;
        if (gt == 0) P.out[1 << 21] = ta * 0.1f;
    }
#endif
}

extern "C" void kernel_launch(void* const* d_in, const int* in_sizes, int n_in, void* d_out, int out_size, void* d_ws, size_t ws_size, hipStream_t stream) {
    static int grid_blocks = 0;
    if (grid_blocks == 0) {
        if (n_in != N_IN || out_size != T_ * DM || ws_size < WS_END) { fprintf(stderr, "kernel_launch: unexpected shapes (n_in %d, out %d, ws %zu < %zu)\n", n_in, out_size, ws_size, (size_t)WS_END); grid_blocks = -1; return; }
        int dev = 0, cus = 0, per_cu = 0;
        hipGetDevice(&dev);
        hipDeviceGetAttribute(&cus, hipDeviceAttributeMultiprocessorCount, dev);
        hipFuncSetAttribute((const void*)fwd_kernel, hipFuncAttributeMaxDynamicSharedMemorySize, LDS_BYTES);
        hipOccupancyMaxActiveBlocksPerMultiprocessor(&per_cu, (const void*)fwd_kernel, NTHREADS, LDS_BYTES);
        if (per_cu < 1) per_cu = 1;
        grid_blocks = cus * per_cu;
    }
    if (grid_blocks < 0) return;
    Params p{};
    for (int i = 0; i < N_IN; ++i) p.in[i] = (const float*)d_in[i];
    p.out = (float*)d_out; p.ws = (unsigned char*)d_ws;
    if (hipMemsetAsync((char*)d_ws + WS_BAR, 0, 4096, stream) != hipSuccess) { fprintf(stderr, "kernel_launch: hipMemsetAsync failed\n"); return; }
    void* args[] = {&p};
    hipError_t e = hipLaunchCooperativeKernel((const void*)fwd_kernel, dim3(grid_blocks), dim3(NTHREADS), args, LDS_BYTES, stream);
    if (e != hipSuccess) fprintf(stderr, "cooperative launch failed: %s (grid %d)\n", hipGetErrorString(e), grid_blocks);
}
```

```cpp
#include <hip/hip_runtime.h>
#include <hip/hip_cooperative_groups.h>
#include <cstdio>
#include <cstdint>
namespace cg = cooperative_groups;
namespace pg8 {
#define PG8_LAS __attribute__((address_space(3)))
typedef unsigned short bf16_t;
typedef short bf16x8 __attribute__((ext_vector_type(8)));
typedef float f32x4 __attribute__((ext_vector_type(4)));
typedef unsigned u32x4 __attribute__((ext_vector_type(4)));
constexpr int BM = 256, BK = 64, HALF = 128, HTB = HALF * BK * 2  , STAGE_BYTES = 8 * HTB, NXCD = 8, WGM = 8;

__host__ __device__ __forceinline__ int lds_byte(int r, int c) { const int st = (r >> 4) * 2 + (c >> 5), rr = r & 15, cc = c & 31, ob = rr * 64 + cc * 2; return st * 1024 + (ob ^ (((ob >> 9) & 1) << 5)); }
__host__ __device__ __forceinline__ void stage_rc(int b, int& R, int& C) { const int st = b / 1024, sb = b % 1024, swz = sb ^ (((sb >> 9) & 1) << 5); R = (st >> 1) * 16 + swz / 64; C = (st & 1) * 32 + (swz % 64) / 2; }
__host__ __device__ __forceinline__ int perm32(int rho) { const int n = rho >> 4, i = rho & 15; return 8 * (i >> 2) + 4 * n + (i & 3); }

struct Unit { int pm, pn; };
struct Gemm { const bf16_t* A; const bf16_t* Bt; int M, N, K; };

struct StaticOrder {
    int nM, nN, nwg, G, c;
    __host__ __device__ void init(int M, int N, int G_, int c_) { nM = M / BM; nN = N / BM; nwg = nM * nN; G = G_; c = c_; }
    __host__ __device__ bool next(int i, Unit& u) const {
        const long L = (long)i * G + c; if (L >= nwg) return false;
        int wgid = (int)L; { const int q = nwg / NXCD, r = nwg % NXCD, xcd = wgid % NXCD, off = wgid / NXCD; wgid = (xcd < r ? xcd * (q + 1) : r * (q + 1) + (xcd - r) * q) + off; }
        const int nig = WGM * nN, gid = wgid / nig, fm = gid * WGM, gsz = (nM - fm) < WGM ? (nM - fm) : WGM;
        u.pm = fm + ((wgid % nig) % gsz); u.pn = (wgid % nig) / gsz; return true;
    }
    __device__ __forceinline__ void a_ready(const Unit&) const {}
    __device__ __forceinline__ void done(const Unit&) const {}
};
typedef float f32x2_t __attribute__((ext_vector_type(2))); typedef __bf16 bf16x2_t __attribute__((ext_vector_type(2)));
__device__ __forceinline__ unsigned cvt_pk_bf16(float lo, float hi) { f32x2_t v = {lo, hi}; bf16x2_t b = __builtin_convertvector(v, bf16x2_t); return __builtin_bit_cast(unsigned, b); }
typedef float f32x2 __attribute__((ext_vector_type(2)));
__device__ __forceinline__ float fast_sigmoid(float x) { return __builtin_amdgcn_rcpf(1.0f + __builtin_amdgcn_exp2f(-1.4426950408889634f * x)); }
__device__ __forceinline__ float bf_lo(unsigned w) { return __uint_as_float(w << 16); }
__device__ __forceinline__ float bf_hi(unsigned w) { return __uint_as_float(w & 0xffff0000u); }

__device__ __forceinline__ float row_rs(const float* SS, int row) { const f32x4 a = *(const f32x4*)(SS + (size_t)row * 16), b2 = *(const f32x4*)(SS + (size_t)row * 16 + 4), c2 = *(const f32x4*)(SS + (size_t)row * 16 + 8), d = *(const f32x4*)(SS + (size_t)row * 16 + 12);
    const float s = ((a[0] + a[1]) + (a[2] + a[3])) + ((b2[0] + b2[1]) + (b2[2] + b2[3])) + ((c2[0] + c2[1]) + (c2[2] + c2[3])) + ((d[0] + d[1]) + (d[2] + d[3]));
    return 1.0f / sqrtf(s * (1.0f / 1024.0f) + 1e-6f); }
struct EpiSwiglu {
    static constexpr bool PERM = true, AFTER_DRAIN = false;
    bf16_t* O; int ldc; const float* SS;
    __device__ __forceinline__ void operator()(const f32x4 (&acc)[2][2][4][2], const Unit& u, int wr, int wc, int fr, int fq) const {
        const int row0 = u.pm * BM + wr * 64 + fr, col0 = u.pn * HALF + wc * 32 + 8 * fq;
#pragma unroll
        for (int ai = 0; ai < 2; ++ai)
#pragma unroll
            for (int m = 0; m < 4; ++m) {
                bf16_t* rowp = O + (size_t)(row0 + ai * HALF + m * 16) * ldc + col0;
                const float rs = row_rs(SS, row0 + ai * HALF + m * 16);
                float v[8];
#pragma unroll
                for (int n = 0; n < 2; ++n)
#pragma unroll
                    for (int j = 0; j < 4; ++j) { const float g = acc[ai][0][m][n][j] * rs, up = acc[ai][1][m][n][j] * rs; v[n * 4 + j] = g * fast_sigmoid(g) * up; }
                u32x4 w; w.x = cvt_pk_bf16(v[0], v[1]); w.y = cvt_pk_bf16(v[2], v[3]); w.z = cvt_pk_bf16(v[4], v[5]); w.w = cvt_pk_bf16(v[6], v[7]);
                *(u32x4*)rowp = w;
            }
    }
};
struct EpiResid {
    static constexpr bool PERM = false, AFTER_DRAIN = false;
    const float* src; float* dst; int ldc; float scale; bf16_t* XB; float* SS;
    __device__ __forceinline__ void operator()(const f32x4 (&acc)[2][2][4][2], const Unit& u, int wr, int wc, int fr, int fq) const {
        const int col0 = u.pn * BM + wc * 32 + 4 * fq;
#pragma unroll
        for (int ai = 0; ai < 2; ++ai)
#pragma unroll
            for (int m = 0; m < 4; ++m) {
                const int row = u.pm * BM + ai * HALF + wr * 64 + m * 16 + fr;
                const size_t off = (size_t)row * ldc + col0; float sq = 0.f;
#pragma unroll
                for (int bj = 0; bj < 2; ++bj)
#pragma unroll
                    for (int n = 0; n < 2; ++n) { const f32x4 b = *(const f32x4*)(src + off + bj * HALF + n * 16); const f32x4 x = b + acc[ai][bj][m][n] * scale;
                        *(f32x4*)(dst + off + bj * HALF + n * 16) = x; sq += (x[0] * x[0] + x[1] * x[1]) + (x[2] * x[2] + x[3] * x[3]);
                        typedef unsigned u32x2 __attribute__((ext_vector_type(2)));
                        *(u32x2*)(XB + off + bj * HALF + n * 16) = (u32x2){cvt_pk_bf16(x[0], x[1]), cvt_pk_bf16(x[2], x[3])}; }
                sq += __shfl_xor(sq, 16); sq += __shfl_xor(sq, 32);
                if (fq == 0) SS[(size_t)row * 16 + u.pn * 4 + wc] = sq;
            }
    }
};
struct EpiWin {
    static constexpr bool PERM = true, AFTER_DRAIN = false;
    bf16_t *PR, *QB, *KVB, *QC, *KVC; const float* SS;
    __device__ __forceinline__ void operator()(const f32x4 (&acc)[2][2][4][2], const Unit& u, int wr, int wc, int fr, int fq) const {
        bf16_t* base; int ldc, colt;
        const int pn = u.pn;
        if (pn < 8) { base = PR; ldc = 2048; colt = pn * 256; }
        else if (pn < 10) { base = QB; ldc = 512; colt = (pn - 8) * 256; }
        else if (pn == 10) { base = KVB; ldc = 256; colt = 0; }
        else if (pn < 13) { base = QC; ldc = 512; colt = (pn - 11) * 256; }
        else { base = KVC; ldc = 256; colt = 0; }
        const int row0 = u.pm * BM + wr * 64 + fr, col0 = colt + wc * 32 + 8 * fq;
#pragma unroll
        for (int ai = 0; ai < 2; ++ai)
#pragma unroll
            for (int m = 0; m < 4; ++m) {
                bf16_t* rowp = base + (size_t)(row0 + ai * HALF + m * 16) * ldc + col0;
                const float rs = row_rs(SS, row0 + ai * HALF + m * 16);
#pragma unroll
                for (int bj = 0; bj < 2; ++bj) { const f32x4 v0 = acc[ai][bj][m][0] * rs, v1 = acc[ai][bj][m][1] * rs;
                    u32x4 w; w.x = cvt_pk_bf16(v0[0], v0[1]); w.y = cvt_pk_bf16(v0[2], v0[3]); w.z = cvt_pk_bf16(v1[0], v1[1]); w.w = cvt_pk_bf16(v1[2], v1[3]);
                    *(u32x4*)(rowp + bj * HALF) = w; }
            }
    }
};
struct EpiGate {
    static constexpr bool PERM = true, AFTER_DRAIN = false;
    bf16_t* G; const float* SS;
    __device__ __forceinline__ void operator()(const f32x4 (&acc)[2][2][4][2], const Unit& u, int wr, int wc, int fr, int fq) const {
        const int row0 = u.pm * BM + wr * 64 + fr, col0 = u.pn * BM + wc * 32 + 8 * fq;
#pragma unroll
        for (int ai = 0; ai < 2; ++ai)
#pragma unroll
            for (int m = 0; m < 4; ++m) {
                bf16_t* rowp = G + (size_t)(row0 + ai * HALF + m * 16) * 1024 + col0;
                const float rs = row_rs(SS, row0 + ai * HALF + m * 16);
#pragma unroll
                for (int bj = 0; bj < 2; ++bj) { const f32x4 v0 = acc[ai][bj][m][0] * rs, v1 = acc[ai][bj][m][1] * rs;
                    u32x4 w; w.x = cvt_pk_bf16(fast_sigmoid(v0[0]), fast_sigmoid(v0[1])); w.y = cvt_pk_bf16(fast_sigmoid(v0[2]), fast_sigmoid(v0[3]));
                    w.z = cvt_pk_bf16(fast_sigmoid(v1[0]), fast_sigmoid(v1[1])); w.w = cvt_pk_bf16(fast_sigmoid(v1[2]), fast_sigmoid(v1[3]));
                    *(u32x4*)(rowp + bj * HALF) = w; }
            }
    }
};
struct EpiMerge {
    static constexpr bool PERM = true, AFTER_DRAIN = false;
    const bf16_t* G; bf16_t* Mg; int first;
    __device__ __forceinline__ void operator()(const f32x4 (&acc)[2][2][4][2], const Unit& u, int wr, int wc, int fr, int fq) const {
        const int row0 = u.pm * BM + wr * 64 + fr, col0 = u.pn * BM + wc * 32 + 8 * fq;
#pragma unroll
        for (int ai = 0; ai < 2; ++ai)
#pragma unroll
            for (int m = 0; m < 4; ++m) {
                const size_t off = (size_t)(row0 + ai * HALF + m * 16) * 1024 + col0;
#pragma unroll
                for (int bj = 0; bj < 2; ++bj) { const f32x4 v0 = acc[ai][bj][m][0], v1 = acc[ai][bj][m][1];
                    const u32x4 g = __builtin_nontemporal_load((const u32x4*)(G + off + bj * HALF));
                    float r[8];
                    r[0] = bf_lo(g.x) * v0[0]; r[1] = bf_hi(g.x) * v0[1]; r[2] = bf_lo(g.y) * v0[2]; r[3] = bf_hi(g.y) * v0[3];
                    r[4] = bf_lo(g.z) * v1[0]; r[5] = bf_hi(g.z) * v1[1]; r[6] = bf_lo(g.w) * v1[2]; r[7] = bf_hi(g.w) * v1[3];
                    if (!first) { const u32x4 p = __builtin_nontemporal_load((const u32x4*)(Mg + off + bj * HALF));
                        r[0] += bf_lo(p.x); r[1] += bf_hi(p.x); r[2] += bf_lo(p.y); r[3] += bf_hi(p.y); r[4] += bf_lo(p.z); r[5] += bf_hi(p.z); r[6] += bf_lo(p.w); r[7] += bf_hi(p.w); }
                    u32x4 w; w.x = cvt_pk_bf16(r[0], r[1]); w.y = cvt_pk_bf16(r[2], r[3]); w.z = cvt_pk_bf16(r[4], r[5]); w.w = cvt_pk_bf16(r[6], r[7]);
                    *(u32x4*)(Mg + off + bj * HALF) = w; }
            }
    }
};
template <class Epi, class Sched, bool ALIGN_EPI = false, bool SP2 = false>
__device__ __forceinline__ void gemm_phase(PG8_LAS unsigned char* lds, const Gemm g, const Sched& S, const Epi& E) {
    int tid_o = threadIdx.x; asm volatile("" : "+v"(tid_o));
    const int tid = tid_o, wid = __builtin_amdgcn_readfirstlane(tid >> 6), lane = tid & 63, wr = wid >> 2, wc = wid & 3, fr = lane & 15, fq = lane >> 4;
    const int K = g.K, nt = K / BK;
    unsigned voffA[2], voffB[2];
#pragma unroll
    for (int i = 0; i < 2; ++i) { int R, C; stage_rc(tid * 16 + i * 8192, R, C); const int Rb = Epi::PERM ? ((R & ~31) + perm32(R & 31)) : R;
        voffA[i] = (unsigned)(R * K + C) * 2u; voffB[i] = (unsigned)(Rb * K + C) * 2u; }
    const size_t kstep = (size_t)(BK * 2);
    const size_t hstep = (size_t)HALF * K * 2;
    const size_t tstep = 2 * hstep;
    const unsigned ldsw = (unsigned)wid * 1024u;
    const int aoff = lds_byte(wr * 64 + fr, fq * 8), boff = lds_byte(wc * 32 + fr, fq * 8);
#define PG8_SA(b, h) (((b) * 2 + (h)) * HTB)
#define PG8_SB(b, h) ((4 + (b) * 2 + (h)) * HTB)
#define PG8_STAGE(bufoff, gbase, voff) do { _Pragma("unroll") for (int _i = 0; _i < 2; ++_i) \
        __builtin_amdgcn_global_load_lds((const unsigned*)((const char*)(gbase) + (voff)[_i]), (PG8_LAS unsigned*)(lds + (bufoff) + ldsw + _i * 8192), 16, 0, 0); } while (0)
#define PG8_LDA(dst, b, h) do { _Pragma("unroll") for (int m = 0; m < 4; ++m) _Pragma("unroll") for (int k = 0; k < 2; ++k) dst[m][k] = *(const PG8_LAS bf16x8*)(lds + PG8_SA(b, h) + aoff + m * 2048 + k * 1024); } while (0)
#define PG8_LDB(dst, b, h) do { _Pragma("unroll") for (int n = 0; n < 2; ++n) _Pragma("unroll") for (int k = 0; k < 2; ++k) dst[n][k] = *(const PG8_LAS bf16x8*)(lds + PG8_SB(b, h) + boff + n * 2048 + k * 1024); } while (0)
#define PG8_MMA(ai, bj, At, Bt) do { __builtin_amdgcn_s_setprio(1); _Pragma("unroll") for (int m = 0; m < 4; ++m) _Pragma("unroll") for (int n = 0; n < 2; ++n) _Pragma("unroll") for (int k = 0; k < 2; ++k) \
        acc[ai][bj][m][n] = __builtin_amdgcn_mfma_f32_16x16x32_bf16(Bt[n][k], At[m][k], acc[ai][bj][m][n], 0, 0, 0); __builtin_amdgcn_s_setprio(0); } while (0)
#define PG8_WAIT_V(n) asm volatile("s_waitcnt vmcnt(" #n ")" ::: "memory")
#define PG8_WAIT_L(n) asm volatile("s_waitcnt lgkmcnt(" #n ")" ::: "memory")
#define PG8_BAR __builtin_amdgcn_s_barrier()
#define PG8_SCHED __builtin_amdgcn_sched_barrier(0)
    Unit cur, nxt; int ui = 0;
    if (!S.next(0, cur)) return;
    f32x4 acc[2][2][4][2];
#pragma unroll
    for (int a = 0; a < 2; ++a)
#pragma unroll
        for (int b = 0; b < 2; ++b)
#pragma unroll
            for (int m = 0; m < 4; ++m)
#pragma unroll
                for (int n = 0; n < 2; ++n) acc[a][b][m][n] = (f32x4){0.f, 0.f, 0.f, 0.f};
    bf16x8 At[4][2], B0[2][2], B1[2][2];
    const char* cA = (const char*)g.A + (size_t)cur.pm * tstep; const char* cB = (const char*)g.Bt + (size_t)cur.pn * tstep;
    S.a_ready(cur);
    if constexpr (SP2) {
        PG8_STAGE(PG8_SB(0, 0), cB, voffB); PG8_STAGE(PG8_SB(0, 1), cB + hstep, voffB); PG8_STAGE(PG8_SA(0, 0), cA, voffA); PG8_STAGE(PG8_SA(0, 1), cA + hstep, voffA);
        if (wr == 1) PG8_BAR;
        PG8_WAIT_V(2); PG8_BAR;
        PG8_STAGE(PG8_SB(1, 0), cB + kstep, voffB); PG8_STAGE(PG8_SA(1, 0), cA + kstep, voffA); PG8_STAGE(PG8_SB(1, 1), cB + hstep + kstep, voffB);
        PG8_WAIT_V(6); PG8_BAR;
    } else {
        PG8_STAGE(PG8_SB(0, 0), cB, voffB); PG8_STAGE(PG8_SA(0, 0), cA, voffA); PG8_STAGE(PG8_SB(0, 1), cB + hstep, voffB); PG8_STAGE(PG8_SA(0, 1), cA + hstep, voffA);
        if (wr == 1) PG8_BAR;
        PG8_WAIT_V(4); PG8_BAR;
        PG8_STAGE(PG8_SB(1, 0), cB + kstep, voffB); PG8_STAGE(PG8_SA(1, 0), cA + kstep, voffA); PG8_STAGE(PG8_SB(1, 1), cB + hstep + kstep, voffB);
        PG8_WAIT_V(6); PG8_BAR;
    }
    for (;;) {
        const bool has_next = S.next(ui + 1, nxt);
        const char* nA = has_next ? (const char*)g.A + (size_t)nxt.pm * tstep : cA; const char* nB = has_next ? (const char*)g.Bt + (size_t)nxt.pn * tstep : cB;
        for (int t = 0; t < nt; t += 2) {
            const bool last = (t == nt - 2);
            const char* a1 = cA + (size_t)(t + 1) * kstep;
            const char* a2 = last ? nA : cA + (size_t)(t + 2) * kstep; const char* b2 = last ? nB : cB + (size_t)(t + 2) * kstep;
            const char* a3 = a2 + kstep; const char* b3 = b2 + kstep;
            if (last && has_next) S.a_ready(nxt);
            if constexpr (SP2) {
            PG8_LDB(B0, 0, 0); PG8_LDB(B1, 0, 1); PG8_SCHED; PG8_LDA(At, 0, 0); PG8_STAGE(PG8_SA(1, 1), a1 + hstep, voffA);
            PG8_WAIT_V(8); PG8_WAIT_L(0); PG8_BAR; PG8_MMA(0, 0, At, B0); PG8_MMA(0, 1, At, B1); PG8_BAR; PG8_SCHED;
            PG8_LDA(At, 0, 1); PG8_STAGE(PG8_SB(0, 0), b2, voffB); PG8_STAGE(PG8_SB(0, 1), b2 + hstep, voffB); PG8_STAGE(PG8_SA(0, 0), a2, voffA);
            PG8_WAIT_V(8); PG8_WAIT_L(0); PG8_BAR; PG8_MMA(1, 0, At, B0); PG8_MMA(1, 1, At, B1); PG8_BAR; PG8_SCHED;
            PG8_LDB(B0, 1, 0); PG8_LDB(B1, 1, 1); PG8_SCHED; PG8_LDA(At, 1, 0); PG8_STAGE(PG8_SA(0, 1), a2 + hstep, voffA);
            PG8_WAIT_V(8); PG8_WAIT_L(0); PG8_BAR; PG8_MMA(0, 0, At, B0); PG8_MMA(0, 1, At, B1); PG8_BAR; PG8_SCHED;
            PG8_LDA(At, 1, 1); PG8_STAGE(PG8_SB(1, 0), b3, voffB); PG8_STAGE(PG8_SB(1, 1), b3 + hstep, voffB); PG8_STAGE(PG8_SA(1, 0), a3, voffA);
            PG8_WAIT_V(8); PG8_WAIT_L(0); PG8_BAR; PG8_MMA(1, 0, At, B0); PG8_MMA(1, 1, At, B1); PG8_BAR; PG8_SCHED;
            } else {
            PG8_LDB(B0, 0, 0); PG8_SCHED; PG8_LDA(At, 0, 0); PG8_STAGE(PG8_SA(1, 1), a1 + hstep, voffA);
            PG8_WAIT_L(8); PG8_BAR; PG8_WAIT_L(0); PG8_MMA(0, 0, At, B0); PG8_BAR; PG8_SCHED;
            PG8_LDB(B1, 0, 1); PG8_STAGE(PG8_SB(0, 0), b2, voffB);
            PG8_BAR; PG8_WAIT_L(0); PG8_MMA(0, 1, At, B1); PG8_BAR;
            PG8_LDA(At, 0, 1); PG8_STAGE(PG8_SA(0, 0), a2, voffA);
            PG8_BAR; PG8_WAIT_L(0); PG8_MMA(1, 0, At, B0); PG8_BAR; PG8_SCHED;
            PG8_STAGE(PG8_SB(0, 1), b2 + hstep, voffB);
            PG8_WAIT_V(6); PG8_BAR; PG8_MMA(1, 1, At, B1); PG8_BAR;
            PG8_LDB(B0, 1, 0); PG8_SCHED; PG8_LDA(At, 1, 0); PG8_STAGE(PG8_SA(0, 1), a2 + hstep, voffA);
            PG8_WAIT_L(8); PG8_BAR; PG8_WAIT_L(0); PG8_MMA(0, 0, At, B0); PG8_BAR; PG8_SCHED;
            PG8_LDB(B1, 1, 1); PG8_STAGE(PG8_SB(1, 0), b3, voffB);
            PG8_BAR; PG8_WAIT_L(0); PG8_MMA(0, 1, At, B1); PG8_BAR;
            PG8_LDA(At, 1, 1); PG8_STAGE(PG8_SA(1, 0), a3, voffA);
            PG8_BAR; PG8_WAIT_L(0); PG8_MMA(1, 0, At, B0); PG8_BAR; PG8_SCHED;
            PG8_STAGE(PG8_SB(1, 1), b3 + hstep, voffB);
            PG8_WAIT_V(6); PG8_BAR; PG8_MMA(1, 1, At, B1); PG8_BAR;
            }
        }
        if constexpr (ALIGN_EPI) { if (wr == 0) PG8_BAR; }
        if constexpr (!Epi::AFTER_DRAIN) { E(acc, cur, wr, wc, fr, fq); S.done(cur); }
        if (!has_next) break;
#pragma unroll
        for (int a = 0; a < 2; ++a)
#pragma unroll
            for (int b = 0; b < 2; ++b)
#pragma unroll
                for (int m = 0; m < 4; ++m)
#pragma unroll
                    for (int n = 0; n < 2; ++n) acc[a][b][m][n] = (f32x4){0.f, 0.f, 0.f, 0.f};
        cur = nxt; cA = nA; cB = nB; ++ui;
        if constexpr (ALIGN_EPI) { if (wr == 1) PG8_BAR; }
    }
    PG8_WAIT_V(0);
    if constexpr (!ALIGN_EPI) { if (wr == 0) PG8_BAR; }
    PG8_BAR;
    if constexpr (Epi::AFTER_DRAIN) { E.fused(acc, cur, wr, wc, fr, fq, lds, wid, lane); S.done(cur); }
#undef PG8_SA
#undef PG8_SB
#undef PG8_STAGE
#undef PG8_LDA
#undef PG8_LDB
#undef PG8_MMA
#undef PG8_WAIT_V
#undef PG8_WAIT_L
#undef PG8_BAR
#undef PG8_SCHED
}
}
#define LAS __attribute__((address_space(3)))
typedef unsigned short bf16;
typedef unsigned v4u __attribute__((ext_vector_type(4)));
typedef unsigned v2u __attribute__((ext_vector_type(2)));
typedef float f4 __attribute__((ext_vector_type(4)));
constexpr int T_ = 32768, S_ = 2048, NB = 16, DM = 1024, FF = 2816, NL = 4;
constexpr int NWAVES = 8, NTHREADS = 512;
constexpr int LDS_BYTES = 163840;
constexpr float LOG2E = 1.4426950408889634f;
constexpr float C2 = 0.125f * LOG2E;
constexpr float LOG2_THETA = 13.287712379549449f;

enum { I_X = 0, I_F1N, I_F1UP, I_F1DN, I_MIXN, I_WIN, I_MU, I_W0, I_W2, I_A0, I_A2, I_G2, I_KK, I_KA, I_RK, I_LNG, I_LNB, I_QN, I_KN, I_SINK,
       I_WOA, I_WOB, I_WOC, I_WOUT, I_F2N, I_F2UP, I_F2DN, I_FINN, N_IN };

constexpr size_t SZ_WUP = (size_t)2 * FF * DM * 2, SZ_WDN = (size_t)DM * FF * 2, SZ_WIN = (size_t)3584 * DM * 2, SZ_WG = (size_t)3072 * DM * 2,
                 SZ_WO = (size_t)3 * DM * 512 * 2, SZ_WOUT = (size_t)DM * DM * 2;
constexpr size_t WS_WUP1 = 0, WS_WDN1 = WS_WUP1 + SZ_WUP, WS_WIN = WS_WDN1 + SZ_WDN, WS_WG = WS_WIN + SZ_WIN, WS_WO = WS_WG + SZ_WG, WS_WOUT = WS_WO + SZ_WO,
                 WS_WUP2 = WS_WOUT + SZ_WOUT, WS_WDN2 = WS_WUP2 + SZ_WUP, WS_H = WS_WDN2 + SZ_WDN;
constexpr size_t WS_R = WS_H + (size_t)T_ * DM * 2;
constexpr size_t WS_ACT = WS_R;
constexpr size_t WS_PR = WS_R, WS_QB = WS_PR + (size_t)T_ * 2048 * 2, WS_KVB = WS_QB + (size_t)T_ * 512 * 2, WS_QC = WS_KVB + (size_t)T_ * 256 * 2, WS_KVC = WS_QC + (size_t)T_ * 512 * 2,
                 WS_KG = WS_KVC + (size_t)T_ * 256 * 2, WS_VG = WS_KG + (size_t)NB * 2 * S_ * 64 * 2, WS_KW = WS_VG + (size_t)NB * 2 * S_ * 64 * 2, WS_VW = WS_KW + (size_t)NB * 2 * S_ * 64 * 2,
                 WS_YA = WS_VW + (size_t)NB * 2 * S_ * 64 * 2, WS_WKVF = WS_YA + (size_t)T_ * 512 * 2, WS_WKVB = WS_WKVF + (size_t)T_ * 512 * 2, WS_BONUS = WS_WKVB + (size_t)T_ * 512 * 2,
                 WS_SCR = WS_BONUS + (size_t)T_ * 16 * 4, WS_SS = WS_SCR, WS_WUP1B = WS_SS + (size_t)T_ * 16 * 4, WS_BAR = WS_WUP1B + SZ_WUP, WS_END = WS_BAR + 4096;
constexpr size_t WS_GATE = WS_PR, WS_MERGED = WS_PR + (size_t)T_ * DM * 2;
static_assert(WS_ACT + (size_t)T_ * FF * 2 <= WS_END, "map");
static_assert(WS_END < 536000000ull, "workspace budget");

struct Params { const float* in[N_IN]; float* out; unsigned char* ws; };

__device__ __forceinline__ unsigned f2bf(float f) { unsigned u = __float_as_uint(f); return (u + 0x7fffu + ((u >> 16) & 1u)) >> 16; }
__device__ __forceinline__ unsigned pk2(float lo, float hi) { return f2bf(lo) | (f2bf(hi) << 16); }
__device__ __forceinline__ float bf2f(bf16 h) { return __uint_as_float((unsigned)h << 16); }
__device__ __forceinline__ int opaque_tid() { int t = threadIdx.x; asm volatile("" : "+v"(t)); return t; }
#define STAGE_IDS const int tid = opaque_tid(), lane = tid & 63, wave = __builtin_amdgcn_readfirstlane(tid >> 6); const int gw = blockIdx.x * NWAVES + wave, ngw = gridDim.x * NWAVES, gtid = blockIdx.x * NTHREADS + tid, gthreads = gridDim.x * NTHREADS; (void)lane; (void)gw; (void)ngw; (void)gtid; (void)gthreads;
__device__ __forceinline__ float wave_sum(float v) {
#pragma unroll
    for (int o = 1; o < 64; o <<= 1) v += __shfl_xor(v, o);
    return v;
}

__device__ __forceinline__ void cvt_wt(const float* W, int K, int ld, bf16* Wt, int nrows, int mode, int gw, int ngw, int lane, float* scr, const float* gain = nullptr) {
    const int nblk = nrows >> 5, nitems = (K >> 6) * nblk;
    for (int it = gw; it < nitems; it += ngw) {
        const int kb = it / nblk, nb = it % nblk, k0 = kb * 64, n0 = nb * 32;
        int col0;
        if (mode == 0) col0 = n0;
        else if (mode == 1) { const int t = n0 >> 8, r = n0 & 255; col0 = (r < 128) ? t * 128 + r : FF + t * 128 + (r - 128); }
        else if (mode == 2) col0 = n0 < 1920 ? n0 : (n0 < 2048 ? -1 : n0 - 128);
        else col0 = 3456 + n0;
        if (col0 >= 0) {
#pragma unroll 8
            for (int i = 0; i < 32; ++i) { const int kk = 2 * i + (lane >> 5); scr[kk * 33 + (lane & 31)] = W[(size_t)(k0 + kk) * ld + col0 + (lane & 31)] * (gain ? gain[k0 + kk] : 1.0f); }
        }
        asm volatile("s_waitcnt lgkmcnt(0)" ::: "memory");
        const int c = lane & 7;
#pragma unroll
        for (int j = 0; j < 4; ++j) { const int n = (lane >> 3) + 8 * j; const float* sp = scr + (8 * c) * 33 + n;
            v4u o = (v4u){0u, 0u, 0u, 0u};
            if (col0 >= 0) { o.x = pk2(sp[0 * 33], sp[1 * 33]); o.y = pk2(sp[2 * 33], sp[3 * 33]); o.z = pk2(sp[4 * 33], sp[5 * 33]); o.w = pk2(sp[6 * 33], sp[7 * 33]); }
            *(v4u*)(Wt + (size_t)(n0 + n) * K + k0 + 8 * c) = o; }
        asm volatile("s_waitcnt lgkmcnt(0)" ::: "memory");
    }
}
__device__ __forceinline__ void cvt_up1(const Params& P, int l, unsigned char* ldsg) {
    STAGE_IDS
    unsigned char* ws = P.ws; float* scr = (float*)(ldsg + wave * 8448);
    cvt_wt(P.in[I_F1UP] + (size_t)l * DM * 2 * FF, DM, 2 * FF, (bf16*)(ws + ((l & 1) ? WS_WUP1B : WS_WUP1)), 2 * FF, 1, gw, ngw, lane, scr, P.in[I_F1N] + l * DM);
}
__device__ __forceinline__ void cvt_rest(const Params& P, int l, unsigned char* ldsg) {
    STAGE_IDS
    unsigned char* ws = P.ws; float* scr = (float*)(ldsg + wave * 8448);
    cvt_wt(P.in[I_F1DN] + (size_t)l * FF * DM, FF, DM, (bf16*)(ws + WS_WDN1), DM, 0, gw, ngw, lane, scr);
    cvt_wt(P.in[I_WIN] + (size_t)l * DM * 6528, DM, 6528, (bf16*)(ws + WS_WIN), 3584, 2, gw, ngw, lane, scr, P.in[I_MIXN] + l * DM);
    cvt_wt(P.in[I_WIN] + (size_t)l * DM * 6528, DM, 6528, (bf16*)(ws + WS_WG), 3072, 3, gw, ngw, lane, scr, P.in[I_MIXN] + l * DM);
    cvt_wt(P.in[I_WOA] + (size_t)l * 512 * DM, 512, DM, (bf16*)(ws + WS_WO), DM, 0, gw, ngw, lane, scr);
    cvt_wt(P.in[I_WOB] + (size_t)l * 512 * DM, 512, DM, (bf16*)(ws + WS_WO) + (size_t)DM * 512, DM, 0, gw, ngw, lane, scr);
    cvt_wt(P.in[I_WOC] + (size_t)l * 512 * DM, 512, DM, (bf16*)(ws + WS_WO) + (size_t)2 * DM * 512, DM, 0, gw, ngw, lane, scr);
    cvt_wt(P.in[I_WOUT] + (size_t)l * DM * DM, DM, DM, (bf16*)(ws + WS_WOUT), DM, 0, gw, ngw, lane, scr);
    cvt_wt(P.in[I_F2UP] + (size_t)l * DM * 2 * FF, DM, 2 * FF, (bf16*)(ws + WS_WUP2), 2 * FF, 1, gw, ngw, lane, scr, P.in[I_F2N] + l * DM);
    cvt_wt(P.in[I_F2DN] + (size_t)l * FF * DM, FF, DM, (bf16*)(ws + WS_WDN2), DM, 0, gw, ngw, lane, scr);
}
__device__ __forceinline__ void x_to_bf16_ss(const float* x, bf16* o, float* SS) {
    STAGE_IDS
    for (int m = gw; m < T_; m += ngw) {
        const f4* xr = (const f4*)(x + (size_t)m * DM) + lane; f4 v[4]; float s = 0.f;
#pragma unroll
        for (int j = 0; j < 4; ++j) { v[j] = xr[64 * j]; s += (v[j].x * v[j].x + v[j].y * v[j].y) + (v[j].z * v[j].z + v[j].w * v[j].w); }
        s = wave_sum(s);
        v2u* op = (v2u*)(o + (size_t)m * DM) + lane;
#pragma unroll
        for (int j = 0; j < 4; ++j) { v2u w; w.x = pk2(v[j].x, v[j].y); w.y = pk2(v[j].z, v[j].w); op[64 * j] = w; }
        if (lane < 16) SS[(size_t)m * 16 + lane] = lane == 0 ? s : 0.f;
    }
}

__device__ __forceinline__ void rms_rows_f32_inplace(float* x, const float* g) {
    STAGE_IDS
    const f4* gr = (const f4*)g + lane; f4 gv[4];
#pragma unroll
    for (int j = 0; j < 4; ++j) gv[j] = gr[64 * j];
    for (int m = gw; m < T_; m += ngw) {
        f4* xr = (f4*)(x + (size_t)m * DM) + lane; f4 v[4]; float s = 0.f;
#pragma unroll
        for (int j = 0; j < 4; ++j) { v[j] = xr[64 * j]; s += (v[j].x * v[j].x + v[j].y * v[j].y) + (v[j].z * v[j].z + v[j].w * v[j].w); }
        const float rs = 1.0f / sqrtf(wave_sum(s) * (1.0f / DM) + 1e-6f);
#pragma unroll
        for (int j = 0; j < 4; ++j) xr[64 * j] = v[j] * rs * gv[j];
    }
}

__device__ __forceinline__ float fast_sin_rev(float rev) { return __builtin_amdgcn_sinf(__builtin_amdgcn_fractf(rev)); }
__device__ __forceinline__ float fast_cos_rev(float rev) { return __builtin_amdgcn_cosf(__builtin_amdgcn_fractf(rev)); }
__device__ __forceinline__ void qkprep(const Params& P, int l, bool dummy = false) {
    STAGE_IDS
    unsigned char* ws = P.ws;
    bf16* QB = (bf16*)(ws + WS_QB); const bf16* KVB = (const bf16*)(ws + WS_KVB); bf16* QC = (bf16*)(ws + WS_QC); const bf16* KVC = (const bf16*)(ws + WS_KVC);
    bf16* KG = (bf16*)(ws + WS_KG); bf16* KW = (bf16*)(ws + WS_KW);
    const float qg = P.in[I_QN][l * 64 + lane], kg = P.in[I_KN][l * 64 + lane];
    const float inv_ax = exp2f(-(float)(lane & 15) * (LOG2_THETA / 16.0f)), inv_1d = exp2f(-(float)(lane & 31) * (LOG2_THETA / 32.0f));
    const float INV2PI = 0.15915494309189535f;
    for (int t = gw; t < T_; t += ngw) {
        const int b = t >> 11, s = t & 2047;
        const float pos = lane < 32 ? (float)(s >> 6) : (float)(s & 63);
        const float ra = (pos * inv_ax) * INV2PI, r1 = ((float)s * inv_1d) * INV2PI;
        const float csa = fast_cos_rev(ra), sna = (lane & 16) ? fast_sin_rev(ra) : -fast_sin_rev(ra);
        const float cs1 = fast_cos_rev(r1), sn1 = (lane & 32) ? fast_sin_rev(r1) : -fast_sin_rev(r1);
#pragma unroll
        for (int slot = 0; slot < 10; ++slot) {
            bf16* src = slot < 8 ? QB + (size_t)t * 512 + slot * 64 : (bf16*)KVB + (size_t)t * 256 + (slot - 8) * 64;
            const float x = bf2f(src[lane]);
            const float ss = wave_sum(x * x) * (1.0f / 64.0f);
            const float y = x * (1.0f / sqrtf(ss + 1e-6f)) * (slot < 8 ? qg : kg);
            const float r = y * csa + __shfl_xor(y, 16) * sna;
            if (slot < 8) (dummy ? (bf16*)(ws + WS_YA) + (size_t)t * 512 + slot * 64 : src)[lane] = (bf16)f2bf(r * C2);
            else KG[((size_t)(b * 2 + (slot - 8)) * S_ + s) * 64 + lane] = (bf16)f2bf(r);
        }
#pragma unroll
        for (int slot = 0; slot < 10; ++slot) {
            bf16* src = slot < 8 ? QC + (size_t)t * 512 + slot * 64 : (bf16*)KVC + (size_t)t * 256 + (slot - 8) * 64;
            const float x = bf2f(src[lane]);
            const float r = x * cs1 + __shfl_xor(x, 32) * sn1;
            if (slot < 8) (dummy ? (bf16*)(ws + WS_YA) + (size_t)t * 512 + slot * 64 : src)[lane] = (bf16)f2bf(r * C2);
            else KW[((size_t)(b * 2 + (slot - 8)) * S_ + s) * 64 + lane] = (bf16)f2bf(r);
        }
    }
}

__device__ __forceinline__ void vt_prep(const Params& P, unsigned char* ldsg) {
    STAGE_IDS
    unsigned char* ws = P.ws;
    bf16* tile = (bf16*)(ldsg + wave * 8448);
    for (int it = gw; it < 2 * NB * 2 * 32; it += ngw) {
        const int tb = it & 31, kvh = (it >> 5) & 1, b = (it >> 6) & 15, att = it >> 10;
        const bf16* src = (const bf16*)(ws + (att ? WS_KVC : WS_KVB)) + (size_t)(b * S_ + tb * 64) * 256 + 128 + kvh * 64;
        bf16* dst = (bf16*)(ws + (att ? WS_VW : WS_VG)) + (size_t)(b * 2 + kvh) * 64 * S_ + tb * 64;
#pragma unroll 8
        for (int r = 0; r < 64; ++r) tile[r * 66 + lane] = src[(size_t)r * 256 + lane];
        asm volatile("s_waitcnt lgkmcnt(0)" ::: "memory");
#pragma unroll 8
        for (int d = 0; d < 64; ++d) dst[(size_t)d * S_ + lane] = tile[lane * 66 + d];
        asm volatile("s_waitcnt lgkmcnt(0)" ::: "memory");
    }
}

typedef short bf16x8_t __attribute__((ext_vector_type(8)));
typedef short s16x4_t __attribute__((ext_vector_type(4)));
typedef float f32x16 __attribute__((ext_vector_type(16)));
typedef float f32x2a __attribute__((ext_vector_type(2))); typedef __bf16 bf16x2a __attribute__((ext_vector_type(2)));
__device__ __forceinline__ unsigned cvtpk(float lo, float hi) { f32x2a v = {lo, hi}; bf16x2a b = __builtin_convertvector(v, bf16x2a); return __builtin_bit_cast(unsigned, b); }
__device__ __forceinline__ int crow(int r, int hi) { return (r & 3) + 8 * (r >> 2) + 4 * hi; }
template <bool WINDOW>
__device__ __forceinline__ void attn_mfma(bf16* Q, const bf16* Kx, const bf16* VTx, const float* sink, unsigned char* ldsg, bf16* Oalt = nullptr) {
    STAGE_IDS
    const int r32 = lane & 31, hi = lane >> 5, g = wave >> 1, qs = wave & 1;
    const int srow = tid >> 3, sch = tid & 7;
    for (int unit = blockIdx.x; unit < 1024; unit += gridDim.x) {
        const int qb = unit & 31, kvh = (unit >> 5) & 1, b = unit >> 6, h = kvh * 4 + g, q0 = qb * 64 + qs * 32;
        bf16* qp = Q + ((size_t)(b * S_ + q0 + r32)) * 512 + h * 64;
        bf16x8_t qr[4];
#pragma unroll
        for (int d0 = 0; d0 < 4; ++d0) qr[d0] = *(const bf16x8_t*)(qp + 16 * d0 + 8 * hi);
        f32x16 o0, o1;
#pragma unroll
        for (int r = 0; r < 16; ++r) { o0[r] = 0.f; o1[r] = 0.f; }
        float m, l;
        if (WINDOW) { m = sink[h] * LOG2E; l = hi == 0 ? 1.0f : 0.f; } else { m = -1e30f; l = 0.f; }
        const int t0 = WINDOW ? (qb - 2 > 0 ? qb - 2 : 0) : 0, t1 = WINDOW ? (qb + 2 < 31 ? qb + 2 : 31) : 31;
        const bf16* kbase = Kx + (size_t)(b * 2 + kvh) * S_ * 64 + (size_t)srow * 64 + sch * 8;
        const bf16* vbase = VTx + (size_t)(b * 2 + kvh) * 64 * S_ + (size_t)srow * S_ + sch * 8;
        v4u kreg = *(const v4u*)(kbase + (size_t)t0 * 64 * 64);
        v4u vreg = *(const v4u*)(vbase + t0 * 64);
        __syncthreads();
        *(v4u*)(ldsg + srow * 144 + sch * 16) = kreg;
        *(v4u*)(ldsg + 9216 + srow * 144 + sch * 16) = vreg;
        __syncthreads();
        for (int t = t0; t <= t1; ++t) {
            const int buf = (t - t0) & 1;
            if (t < t1) { kreg = *(const v4u*)(kbase + (size_t)(t + 1) * 64 * 64); vreg = *(const v4u*)(vbase + (t + 1) * 64); }
            const unsigned char* Kb = ldsg + buf * 18432; const unsigned char* Vb = Kb + 9216;
            f32x16 p0, p1;
#pragma unroll
            for (int r = 0; r < 16; ++r) { p0[r] = 0.f; p1[r] = 0.f; }
#pragma unroll
            for (int d0 = 0; d0 < 4; ++d0) {
                const bf16x8_t a0 = *(const bf16x8_t*)(Kb + r32 * 144 + (16 * d0 + 8 * hi) * 2);
                const bf16x8_t a1 = *(const bf16x8_t*)(Kb + (32 + r32) * 144 + (16 * d0 + 8 * hi) * 2);
                p0 = __builtin_amdgcn_mfma_f32_32x32x16_bf16(a0, qr[d0], p0, 0, 0, 0);
                p1 = __builtin_amdgcn_mfma_f32_32x32x16_bf16(a1, qr[d0], p1, 0, 0, 0);
            }
            if (WINDOW) {
                const int qpos = q0 + r32;
#pragma unroll
                for (int r = 0; r < 16; ++r) { const int kv = t * 64 + crow(r, hi); int dlt = qpos - kv; dlt = dlt < 0 ? -dlt : dlt; if (dlt > 128) p0[r] = -1e30f;
                    int dl2 = qpos - (kv + 32); dl2 = dl2 < 0 ? -dl2 : dl2; if (dl2 > 128) p1[r] = -1e30f; }
            }
            float mt = fmaxf(p0[0], p1[0]);
#pragma unroll
            for (int r = 1; r < 16; ++r) mt = fmaxf(mt, fmaxf(p0[r], p1[r]));
            mt = fmaxf(mt, __shfl_xor(mt, 32));
            if (__any(mt > m)) {
                const float mn = fmaxf(m, mt), corr = __builtin_amdgcn_exp2f(m - mn); m = mn;
                l *= corr;
#pragma unroll
                for (int r = 0; r < 16; ++r) { o0[r] *= corr; o1[r] *= corr; }
            }
            float ps0 = 0.f, ps1 = 0.f;
#pragma unroll
            for (int r = 0; r < 16; ++r) { p0[r] = __builtin_amdgcn_exp2f(p0[r] - m); p1[r] = __builtin_amdgcn_exp2f(p1[r] - m); ps0 += p0[r]; ps1 += p1[r]; }
            l += ps0 + ps1;
            v4u pw[4];
            pw[0] = (v4u){cvtpk(p0[0], p0[1]), cvtpk(p0[2], p0[3]), cvtpk(p0[4], p0[5]), cvtpk(p0[6], p0[7])};
            pw[1] = (v4u){cvtpk(p0[8], p0[9]), cvtpk(p0[10], p0[11]), cvtpk(p0[12], p0[13]), cvtpk(p0[14], p0[15])};
            pw[2] = (v4u){cvtpk(p1[0], p1[1]), cvtpk(p1[2], p1[3]), cvtpk(p1[4], p1[5]), cvtpk(p1[6], p1[7])};
            pw[3] = (v4u){cvtpk(p1[8], p1[9]), cvtpk(p1[10], p1[11]), cvtpk(p1[12], p1[13]), cvtpk(p1[14], p1[15])};
#pragma unroll
            for (int kb = 0; kb < 4; ++kb) {
                const bf16x8_t pb = __builtin_bit_cast(bf16x8_t, pw[kb]);
                { const unsigned char* vp = Vb + r32 * 144 + (16 * kb + 4 * hi) * 2; const s16x4_t lo = *(const s16x4_t*)vp, hh = *(const s16x4_t*)(vp + 16);
                  const bf16x8_t a = (bf16x8_t){lo[0], lo[1], lo[2], lo[3], hh[0], hh[1], hh[2], hh[3]};
                  o0 = __builtin_amdgcn_mfma_f32_32x32x16_bf16(a, pb, o0, 0, 0, 0); }
                { const unsigned char* vp = Vb + (32 + r32) * 144 + (16 * kb + 4 * hi) * 2; const s16x4_t lo = *(const s16x4_t*)vp, hh = *(const s16x4_t*)(vp + 16);
                  const bf16x8_t a = (bf16x8_t){lo[0], lo[1], lo[2], lo[3], hh[0], hh[1], hh[2], hh[3]};
                  o1 = __builtin_amdgcn_mfma_f32_32x32x16_bf16(a, pb, o1, 0, 0, 0); }
            }
            if (t < t1) { unsigned char* nb = ldsg + (buf ^ 1) * 18432; *(v4u*)(nb + srow * 144 + sch * 16) = kreg; *(v4u*)(nb + 9216 + srow * 144 + sch * 16) = vreg; }
            __syncthreads();
        }
        l += __shfl_xor(l, 32);
        const float inv = 1.0f / l;
        if (Oalt) qp = Oalt + ((size_t)(b * S_ + q0 + r32)) * 512 + h * 64;
#pragma unroll
        for (int g4 = 0; g4 < 4; ++g4) {
            v2u w0, w1;
            w0.x = cvtpk(o0[4 * g4 + 0] * inv, o0[4 * g4 + 1] * inv); w0.y = cvtpk(o0[4 * g4 + 2] * inv, o0[4 * g4 + 3] * inv);
            w1.x = cvtpk(o1[4 * g4 + 0] * inv, o1[4 * g4 + 1] * inv); w1.y = cvtpk(o1[4 * g4 + 2] * inv, o1[4 * g4 + 3] * inv);
            *(v2u*)(qp + 8 * g4 + 4 * hi) = w0;
            *(v2u*)(qp + 32 + 8 * g4 + 4 * hi) = w1;
        }
    }
}

typedef float f8s __attribute__((ext_vector_type(8)));
typedef float f32x4m __attribute__((ext_vector_type(4)));
constexpr int SC_VEC = 0, SC_VS = 81920, SC_W2T = 98304, SC_A2T = 107520, SC_XCH = 116736, SC_YP = 124928, SC_A1 = SC_YP, SC_A2 = SC_YP + 9216, SC_AL = SC_YP + 18432, SC_CS = SC_AL + 16640, SC_END = SC_CS + 128;
static_assert(SC_END <= LDS_BYTES, "scan LDS");
__device__ __forceinline__ void ld8bf(const bf16* p, float (&f)[8]) { const v4u w = *(const v4u*)p;
    f[0] = __uint_as_float(w.x << 16); f[1] = __uint_as_float(w.x & 0xffff0000u); f[2] = __uint_as_float(w.y << 16); f[3] = __uint_as_float(w.y & 0xffff0000u);
    f[4] = __uint_as_float(w.z << 16); f[5] = __uint_as_float(w.z & 0xffff0000u); f[6] = __uint_as_float(w.w << 16); f[7] = __uint_as_float(w.w & 0xffff0000u); }
__device__ __forceinline__ void shifted8(const bf16* pc, int col, bool hasp, bool hasn, const float* mu, float (&o)[8]) {
    float c[8], p[8], n[8];
    ld8bf(pc + col, c);
    if (hasp) ld8bf(pc + col - 2048, p); else { for (int e = 0; e < 8; ++e) p[e] = 0.f; }
    if (hasn) ld8bf(pc + col + 2048, n); else { for (int e = 0; e < 8; ++e) n[e] = 0.f; }
    const f4 m0 = *(const f4*)(mu + col), m1 = *(const f4*)(mu + col + 4);
    const float mm[8] = {m0.x, m0.y, m0.z, m0.w, m1.x, m1.y, m1.z, m1.w};
#pragma unroll
    for (int e = 0; e < 8; ++e) o[e] = c[e] + mm[e] * (0.5f * (p[e] + n[e]) - c[e]);
}
struct Raw3 { v4u c, p, n; };
__device__ __forceinline__ void raw_load(Raw3& r, const bf16* pc, int col, bool hasp, bool hasn) {
    r.c = *(const v4u*)(pc + col);
    r.p = hasp ? *(const v4u*)(pc + col - 2048) : (v4u){0u, 0u, 0u, 0u};
    r.n = hasn ? *(const v4u*)(pc + col + 2048) : (v4u){0u, 0u, 0u, 0u};
}
__device__ __forceinline__ void un8(const v4u w, float (&f)[8]) {
    f[0] = __uint_as_float(w.x << 16); f[1] = __uint_as_float(w.x & 0xffff0000u); f[2] = __uint_as_float(w.y << 16); f[3] = __uint_as_float(w.y & 0xffff0000u);
    f[4] = __uint_as_float(w.z << 16); f[5] = __uint_as_float(w.z & 0xffff0000u); f[6] = __uint_as_float(w.w << 16); f[7] = __uint_as_float(w.w & 0xffff0000u); }
__device__ __forceinline__ void shift_raw(const Raw3& r, const float* mu, int col, float (&o)[8]) {
    float c[8], p[8], n[8]; un8(r.c, c); un8(r.p, p); un8(r.n, n);
    const f4 m0 = *(const f4*)(mu + col), m1 = *(const f4*)(mu + col + 4);
    const float mm[8] = {m0.x, m0.y, m0.z, m0.w, m1.x, m1.y, m1.z, m1.w};
#pragma unroll
    for (int e = 0; e < 8; ++e) o[e] = c[e] + mm[e] * (0.5f * (p[e] + n[e]) - c[e]);
}
__device__ __forceinline__ void scan_fast(const Params& P, int l, unsigned char* ldsg) {
    STAGE_IDS
    unsigned char* ws = P.ws;
    const bf16* PR = (const bf16*)(ws + WS_PR); float* BONUS = (float*)(ws + WS_BONUS);
    float* VEC = (float*)(ldsg + SC_VEC);
    const int fr = lane & 15, fq = lane >> 4, ps = tid >> 3, pcg = tid & 7;
    float* XCH = (float*)(ldsg + SC_XCH); float* YP = (float*)(ldsg + SC_YP); float* VS = (float*)(ldsg + SC_VS); float* AL = (float*)(ldsg + SC_AL);
    for (int sid = blockIdx.x; sid < 256; sid += gridDim.x) {
        const int dir = sid & 1, h = (sid >> 1) & 7, b = sid >> 4, hc0 = h * 64;
        bf16* WKV = (bf16*)(ws + (dir ? WS_WKVB : WS_WKVF));
        const float* mu = P.in[I_MU] + (size_t)l * 1920;
        __syncthreads();
        {
            const float* w2b = P.in[I_W2] + (size_t)(l * 2 + dir) * 64 * 512 + (size_t)ps * 512 + hc0 + 8 * pcg;
            const float* a2b = P.in[I_A2] + (size_t)(l * 2 + dir) * 64 * 512 + (size_t)ps * 512 + hc0 + 8 * pcg;
#pragma unroll
            for (int e = 0; e < 8; ++e) { ((bf16*)(ldsg + SC_W2T))[(8 * pcg + e) * 72 + ps] = (bf16)f2bf(w2b[e]); ((bf16*)(ldsg + SC_A2T))[(8 * pcg + e) * 72 + ps] = (bf16)f2bf(a2b[e]); }
        }
        float S[8];
#pragma unroll
        for (int j = 0; j < 8; ++j) S[j] = 0.f;
        Raw3 pre[5];
#pragma unroll 1
        for (int ch = 0; ch < S_ / 64; ++ch) {
            const int step0 = ch * 64;
            const int tp = dir ? S_ - 1 - (step0 + ps) : step0 + ps;
            const int cR = hc0 + 8 * pcg, cK = 512 + hc0 + 8 * pcg, cV = 1024 + hc0 + 8 * pcg, cW = 1536 + 64 * dir + 8 * pcg, cA = 1664 + 64 * dir + 8 * pcg;
            if (ch == 0) { const bf16* pc = PR + ((size_t)(b * S_ + tp)) * 2048; const bool hasp = tp > 0, hasn = tp < S_ - 1;
                raw_load(pre[0], pc, cR, hasp, hasn); raw_load(pre[1], pc, cK, hasp, hasn); raw_load(pre[2], pc, cV, hasp, hasn); raw_load(pre[3], pc, cW, hasp, hasn); raw_load(pre[4], pc, cA, hasp, hasn); }
            float r8[8], k8[8], v8[8];
            shift_raw(pre[0], mu, cR, r8);
            shift_raw(pre[1], mu, cK, k8);
            shift_raw(pre[2], mu, cV, v8);
            { float wl[8], al[8];
              shift_raw(pre[3], mu, cW, wl);
              shift_raw(pre[4], mu, cA, al);
#pragma unroll
              for (int e = 0; e < 8; ++e) { const float t2 = __builtin_amdgcn_exp2f(2.0f * LOG2E * wl[e]); wl[e] = (t2 - 1.0f) * __builtin_amdgcn_rcpf(t2 + 1.0f); }
              v4u w1, w2v; w1.x = cvtpk(wl[0], wl[1]); w1.y = cvtpk(wl[2], wl[3]); w1.z = cvtpk(wl[4], wl[5]); w1.w = cvtpk(wl[6], wl[7]);
              w2v.x = cvtpk(al[0], al[1]); w2v.y = cvtpk(al[2], al[3]); w2v.z = cvtpk(al[4], al[5]); w2v.w = cvtpk(al[6], al[7]);
              *(v4u*)(ldsg + SC_A1 + ps * 144 + pcg * 16) = w1; *(v4u*)(ldsg + SC_A2 + ps * 144 + pcg * 16) = w2v; }
            *(f4*)(VS + ps * 64 + 8 * pcg) = (f4){v8[0], v8[1], v8[2], v8[3]}; *(f4*)(VS + ps * 64 + 8 * pcg + 4) = (f4){v8[4], v8[5], v8[6], v8[7]};
            __syncthreads();
            {
                const int wq = wave & 3; const bool isw = wave < 4;
                const unsigned char* Ab = ldsg + (isw ? SC_A1 : SC_A2) + (16 * wq + fr) * 144 + 16 * fq;
                const unsigned char* Bb = ldsg + (isw ? SC_W2T : SC_A2T) + fr * 144 + 16 * fq;
                const bf16x8_t a0 = *(const bf16x8_t*)Ab, a1 = *(const bf16x8_t*)(Ab + 64);
                const float* bias = P.in[isw ? I_W0 : I_A0] + (size_t)(l * 2 + dir) * 512 + hc0;
#pragma unroll
                for (int n = 0; n < 4; ++n) {
                    const bf16x8_t b0 = *(const bf16x8_t*)(Bb + n * 16 * 144), b1 = *(const bf16x8_t*)(Bb + n * 16 * 144 + 64);
                    f32x4m acc = (f32x4m){0.f, 0.f, 0.f, 0.f};
                    acc = __builtin_amdgcn_mfma_f32_16x16x32_bf16(a0, b0, acc, 0, 0, 0);
                    acc = __builtin_amdgcn_mfma_f32_16x16x32_bf16(a1, b1, acc, 0, 0, 0);
                    const float bz = bias[16 * n + fr];
#pragma unroll
                    for (int v = 0; v < 4; ++v) {
                        const int st = 16 * wq + 4 * fq + v; const float x = acc[v] + bz;
                        if (isw) { const float sp = __builtin_amdgcn_logf(1.0f + __builtin_amdgcn_exp2f(-x * LOG2E)) * 0.6931471805599453f;
                                   const float wlog = -sp - 0.5f; VEC[st * 320 + (2 * n + (fr >> 3)) * 40 + (fr & 7)] = __builtin_amdgcn_exp2f(-__builtin_amdgcn_exp2f(wlog * LOG2E) * LOG2E); }
                        else AL[st * 65 + 16 * n + fr] = __builtin_amdgcn_rcpf(1.0f + __builtin_amdgcn_exp2f(-x * LOG2E));
                    }
                }
            }
            __syncthreads();
            {
                const float* kkp = P.in[I_KK] + l * 512 + hc0 + 8 * pcg; const float* kap = P.in[I_KA] + l * 512 + hc0 + 8 * pcg; const float* rkp = P.in[I_RK] + l * 512 + hc0 + 8 * pcg;
                float a8[8], kk[8], kd[8]; float ss = 0.f, bon = 0.f;
#pragma unroll
                for (int e = 0; e < 8; ++e) { a8[e] = AL[ps * 65 + 8 * pcg + e]; kk[e] = k8[e] * kkp[e]; ss += kk[e] * kk[e]; kd[e] = k8[e] * (1.0f + (a8[e] - 1.0f) * kap[e]); bon += r8[e] * kd[e] * rkp[e]; }
                ss += __shfl_xor(ss, 1); ss += __shfl_xor(ss, 2); ss += __shfl_xor(ss, 4);
                bon += __shfl_xor(bon, 1); bon += __shfl_xor(bon, 2); bon += __shfl_xor(bon, 4);
                const float rn = 1.0f / fmaxf(sqrtf(ss), 1e-12f);
                float* sp = VEC + ps * 320 + 40 * pcg;
                *(f4*)(sp + 8) = (f4){kd[0], kd[1], kd[2], kd[3]}; *(f4*)(sp + 12) = (f4){kd[4], kd[5], kd[6], kd[7]};
                *(f4*)(sp + 16) = (f4){-kk[0] * rn, -kk[1] * rn, -kk[2] * rn, -kk[3] * rn}; *(f4*)(sp + 20) = (f4){-kk[4] * rn, -kk[5] * rn, -kk[6] * rn, -kk[7] * rn};
                *(f4*)(sp + 24) = (f4){kk[0] * rn * a8[0], kk[1] * rn * a8[1], kk[2] * rn * a8[2], kk[3] * rn * a8[3]}; *(f4*)(sp + 28) = (f4){kk[4] * rn * a8[4], kk[5] * rn * a8[5], kk[6] * rn * a8[6], kk[7] * rn * a8[7]};
                *(f4*)(sp + 32) = (f4){r8[0], r8[1], r8[2], r8[3]}; *(f4*)(sp + 36) = (f4){r8[4], r8[5], r8[6], r8[7]};
                if (pcg == 0) BONUS[((size_t)((dir * NB + b) * 8 + h)) * S_ + tp] = bon;
            }
            asm volatile("s_waitcnt vmcnt(0) lgkmcnt(0)" ::: "memory");
            __syncthreads();
            {
                float* CS = (float*)(ldsg + SC_CS);
                const int p = tid >> 4, q = tid & 15;
                const float* b0 = VEC + (2 * p) * 320 + (q >> 1) * 40 + 24 + (q & 1) * 4; const float* n1 = VEC + (2 * p + 1) * 320 + (q >> 1) * 40 + 16 + (q & 1) * 4;
                float d = (b0[0] * n1[0] + b0[1] * n1[1]) + (b0[2] * n1[2] + b0[3] * n1[3]);
                d += __shfl_xor(d, 1); d += __shfl_xor(d, 2); d += __shfl_xor(d, 4); d += __shfl_xor(d, 8);
                if (q == 0) CS[p] = d;
            }
            asm volatile("s_waitcnt lgkmcnt(0)" ::: "memory");
            __syncthreads();
#define DPP_FMAC(acc, xs, val, N) asm("v_fmac_f32_dpp %0, %1, %2 row_newbcast:" #N " row_mask:0xf bank_mask:0xf" : "+v"(acc) : "v"(xs), "v"(val))
#define DPP_MUL(dst, xs, val, N) asm("v_mul_f32_dpp %0, %1, %2 row_newbcast:" #N " row_mask:0xf bank_mask:0xf" : "=v"(dst) : "v"(xs), "v"(val))
            if (ch + 1 < S_ / 64) { const int tn = dir ? S_ - 1 - (step0 + 64 + ps) : step0 + 64 + ps; const bf16* pc = PR + ((size_t)(b * S_ + tn)) * 2048; const bool hasp = tn > 0, hasn = tn < S_ - 1;
                raw_load(pre[0], pc, cR, hasp, hasn); raw_load(pre[1], pc, cK, hasp, hasn); raw_load(pre[2], pc, cV, hasp, hasn); raw_load(pre[3], pc, cW, hasp, hasn); raw_load(pre[4], pc, cA, hasp, hasn); }
            const float* vecb = VEC + wave * 40 + (lane & 15);
            const int o2 = 32 + (lane & 7) - (lane & 15);
            const float* CSr = (const float*)(ldsg + SC_CS);
#define R8(M) M(0) M(1) M(2) M(3) M(4) M(5) M(6) M(7)
#define R7(M) M(1) M(2) M(3) M(4) M(5) M(6) M(7)
            const int xslot = lane * 8 + ((wave + (lane >> 2)) & 7);
            auto pair_steps = [&](const int t, float& x0, float& x1, float& x2, float& m0, float& m1, float& m2, const float va, const float vb) __attribute__((always_inline)) {
                const float Cc = CSr[t >> 1];
                asm volatile("s_nop 1" : "+v"(x0), "+v"(x1), "+v"(x2), "+v"(m0), "+v"(m1), "+v"(m2));
                float pa, pb, qa, qb, Tt[8];
                DPP_MUL(pa, x1, S[0], 0); DPP_MUL(pb, x1, S[1], 1);
                DPP_FMAC(pa, x1, S[2], 2); DPP_FMAC(pb, x1, S[3], 3); DPP_FMAC(pa, x1, S[4], 4); DPP_FMAC(pb, x1, S[5], 5); DPP_FMAC(pa, x1, S[6], 6); DPP_FMAC(pb, x1, S[7], 7);
#define M_T0(j) DPP_MUL(Tt[j], x0, S[j], j);
                R8(M_T0)
                DPP_FMAC(Tt[0], x0, va, 8); DPP_FMAC(Tt[1], x0, va, 9); DPP_FMAC(Tt[2], x0, va, 10); DPP_FMAC(Tt[3], x0, va, 11);
                DPP_FMAC(Tt[4], x0, va, 12); DPP_FMAC(Tt[5], x0, va, 13); DPP_FMAC(Tt[6], x0, va, 14); DPP_FMAC(Tt[7], x0, va, 15);
                DPP_MUL(qa, m1, Tt[0], 0); DPP_MUL(qb, m1, Tt[1], 1);
                DPP_FMAC(qa, m1, Tt[2], 2); DPP_FMAC(qb, m1, Tt[3], 3); DPP_FMAC(qa, m1, Tt[4], 4); DPP_FMAC(qb, m1, Tt[5], 5); DPP_FMAC(qa, m1, Tt[6], 6); DPP_FMAC(qb, m1, Tt[7], 7);
                const int par = (t >> 1) & 1;
                XCH[par * 1024 + xslot] = pa + pb; XCH[par * 1024 + 512 + xslot] = qa + qb;
                asm volatile("s_waitcnt lgkmcnt(0)\n\ts_barrier" ::: "memory");
                const f4* xp = (const f4*)(XCH + par * 1024 + lane * 8);
                const f4 e0 = xp[0], e1 = xp[1], g0 = xp[128], g1 = xp[129];
                const f4 es = e0 + e1, gs = g0 + g1;
                float sa0 = (es.x + es.y) + (es.z + es.w);
                asm volatile("" : "+v"(sa0));
                const float p1s = (gs.x + gs.y) + (gs.z + gs.w);
                float sa1 = p1s + sa0 * Cc;
                DPP_FMAC(Tt[0], x1, sa0, 8); DPP_FMAC(Tt[1], x1, sa0, 9); DPP_FMAC(Tt[2], x1, sa0, 10); DPP_FMAC(Tt[3], x1, sa0, 11);
                DPP_FMAC(Tt[4], x1, sa0, 12); DPP_FMAC(Tt[5], x1, sa0, 13); DPP_FMAC(Tt[6], x1, sa0, 14); DPP_FMAC(Tt[7], x1, sa0, 15);
                float ya, yb;
                DPP_MUL(ya, x2, Tt[0], 0); DPP_MUL(yb, x2, Tt[1], 1);
                DPP_FMAC(ya, x2, Tt[2], 2); DPP_FMAC(yb, x2, Tt[3], 3); DPP_FMAC(ya, x2, Tt[4], 4); DPP_FMAC(yb, x2, Tt[5], 5); DPP_FMAC(ya, x2, Tt[6], 6); DPP_FMAC(yb, x2, Tt[7], 7);
                YP[(t & 15) * 512 + wave * 64 + lane] = ya + yb;
#define M_T1(j) DPP_MUL(S[j], m0, Tt[j], j);
                R8(M_T1)
                DPP_FMAC(S[0], m0, vb, 8); DPP_FMAC(S[1], m0, vb, 9); DPP_FMAC(S[2], m0, vb, 10); DPP_FMAC(S[3], m0, vb, 11);
                DPP_FMAC(S[4], m0, vb, 12); DPP_FMAC(S[5], m0, vb, 13); DPP_FMAC(S[6], m0, vb, 14); DPP_FMAC(S[7], m0, vb, 15);
                DPP_FMAC(S[0], m1, sa1, 8); DPP_FMAC(S[1], m1, sa1, 9); DPP_FMAC(S[2], m1, sa1, 10); DPP_FMAC(S[3], m1, sa1, 11);
                DPP_FMAC(S[4], m1, sa1, 12); DPP_FMAC(S[5], m1, sa1, 13); DPP_FMAC(S[6], m1, sa1, 14); DPP_FMAC(S[7], m1, sa1, 15);
                float yc, yd;
                DPP_MUL(yc, m2, S[0], 0); DPP_MUL(yd, m2, S[1], 1);
                DPP_FMAC(yc, m2, S[2], 2); DPP_FMAC(yd, m2, S[3], 3); DPP_FMAC(yc, m2, S[4], 4); DPP_FMAC(yd, m2, S[5], 5); DPP_FMAC(yc, m2, S[6], 6); DPP_FMAC(yd, m2, S[7], 7);
                YP[((t + 1) & 15) * 512 + wave * 64 + lane] = yc + yd;
                if (((t + 1) & 7) == 7) {
                    asm volatile("s_waitcnt lgkmcnt(0)\n\ts_barrier" ::: "memory");
                    const int sl = (t - 6) + wave;
                    const float* yp = YP + (sl & 15) * 512 + lane;
                    const float y0 = ((yp[0] + yp[64]) + (yp[128] + yp[192])) + ((yp[256] + yp[320]) + (yp[384] + yp[448]));
                    const int tt = dir ? S_ - 1 - (step0 + sl) : step0 + sl;
                    WKV[((size_t)(b * S_ + tt)) * 512 + hc0 + lane] = (bf16)f2bf(y0);
                }
            };
            float ax0 = vecb[0], ax1 = vecb[16], ax2 = vecb[o2], am0 = vecb[320], am1 = vecb[336], am2 = vecb[320 + o2], ava = VS[lane], avb = VS[64 + lane];
            float bx0, bx1, bx2, bm0, bm1, bm2, bva, bvb;
#pragma unroll 1
            for (int t = 0; t < 64; t += 4) {
                { const float* np_ = vecb + (t + 2) * 320; const float* nq_ = vecb + (t + 3) * 320;
                  bx0 = np_[0]; bx1 = np_[16]; bx2 = np_[o2]; bm0 = nq_[0]; bm1 = nq_[16]; bm2 = nq_[o2]; bva = VS[(t + 2) * 64 + lane]; bvb = VS[(t + 3) * 64 + lane]; }
                pair_steps(t, ax0, ax1, ax2, am0, am1, am2, ava, avb);
                { const float* np_ = vecb + ((t + 4) & 63) * 320; const float* nq_ = vecb + ((t + 5) & 63) * 320;
                  ax0 = np_[0]; ax1 = np_[16]; ax2 = np_[o2]; am0 = nq_[0]; am1 = nq_[16]; am2 = nq_[o2]; ava = VS[((t + 4) & 63) * 64 + lane]; avb = VS[((t + 5) & 63) * 64 + lane]; }
                pair_steps(t + 2, bx0, bx1, bx2, bm0, bm1, bm2, bva, bvb);
            }
#undef R7
#undef M_T0
#undef M_T1
#undef R8
#undef DPP_FMAC
#undef DPP_MUL
            __syncthreads();
        }
    }
}

__device__ __forceinline__ void finalize_fast(const Params& P, int l, unsigned char* ldsg) {
    STAGE_IDS
    unsigned char* ws = P.ws;
    const bf16* PR = (const bf16*)(ws + WS_PR); const bf16* WF = (const bf16*)(ws + WS_WKVF); const bf16* WBk = (const bf16*)(ws + WS_WKVB); const float* BONUS = (const float*)(ws + WS_BONUS);
    bf16* YA = (bf16*)(ws + WS_YA);
    const int fr = lane & 15, fq = lane >> 4;
    const float* mu = P.in[I_MU] + (size_t)l * 1920; const float* g2 = P.in[I_G2] + (size_t)l * 128 * 512;
    const float* lngp = P.in[I_LNG] + l * 512; const float* lnbp = P.in[I_LNB] + l * 512;
    bf16x8_t gf[4][4];
#pragma unroll
    for (int n = 0; n < 4; ++n)
#pragma unroll
        for (int ks = 0; ks < 4; ++ks) { float gv[8];
#pragma unroll
            for (int e = 0; e < 8; ++e) gv[e] = g2[(size_t)(32 * ks + 8 * fq + e) * 512 + 64 * wave + 16 * n + fr];
            const v4u w = (v4u){cvtpk(gv[0], gv[1]), cvtpk(gv[2], gv[3]), cvtpk(gv[4], gv[5]), cvtpk(gv[6], gv[7])};
            gf[n][ks] = __builtin_bit_cast(bf16x8_t, w); }
    for (int tile = blockIdx.x; tile < T_ / 32; tile += gridDim.x) {
        const int t0 = tile * 32;
        __syncthreads();
        { const int tok = tid >> 4, mg = tid & 15, t = t0 + tok, s = t & 2047; float x[8];
          shifted8(PR + (size_t)t * 2048, 1792 + 8 * mg, s > 0, s < S_ - 1, mu, x);
#pragma unroll
          for (int e = 0; e < 8; ++e) x[e] = __builtin_amdgcn_rcpf(1.0f + __builtin_amdgcn_exp2f(-x[e] * LOG2E));
          *(v4u*)(ldsg + tok * 272 + mg * 16) = (v4u){cvtpk(x[0], x[1]), cvtpk(x[2], x[3]), cvtpk(x[4], x[5]), cvtpk(x[6], x[7])}; }
        __syncthreads();
#pragma unroll
        for (int mt = 0; mt < 2; ++mt) {
            f32x4m acc[4];
#pragma unroll
            for (int n = 0; n < 4; ++n) acc[n] = (f32x4m){0.f, 0.f, 0.f, 0.f};
#pragma unroll
            for (int ks = 0; ks < 4; ++ks) { const bf16x8_t bb = *(const bf16x8_t*)(ldsg + (16 * mt + fr) * 272 + (32 * ks + 8 * fq) * 2);
#pragma unroll
                for (int n = 0; n < 4; ++n) acc[n] = __builtin_amdgcn_mfma_f32_16x16x32_bf16(gf[n][ks], bb, acc[n], 0, 0, 0); }
            const int t = t0 + 16 * mt + fr, s = t & 2047, bb_ = t >> 11;
            float wk[4][4]; float sm = 0.f;
#pragma unroll
            for (int n = 0; n < 4; ++n) { const int c0 = 64 * wave + 16 * n + 4 * fq;
                const v2u a = *(const v2u*)(WF + (size_t)t * 512 + c0), b2 = *(const v2u*)(WBk + (size_t)t * 512 + c0);
                wk[n][0] = __uint_as_float(a.x << 16) + __uint_as_float(b2.x << 16); wk[n][1] = __uint_as_float(a.x & 0xffff0000u) + __uint_as_float(b2.x & 0xffff0000u);
                wk[n][2] = __uint_as_float(a.y << 16) + __uint_as_float(b2.y << 16); wk[n][3] = __uint_as_float(a.y & 0xffff0000u) + __uint_as_float(b2.y & 0xffff0000u);
                sm += (wk[n][0] + wk[n][1]) + (wk[n][2] + wk[n][3]); }
            sm += __shfl_xor(sm, 16); sm += __shfl_xor(sm, 32);
            const float mean = sm * (1.0f / 64.0f); float sq = 0.f;
#pragma unroll
            for (int n = 0; n < 4; ++n)
#pragma unroll
                for (int v = 0; v < 4; ++v) { wk[n][v] -= mean; sq += wk[n][v] * wk[n][v]; }
            sq += __shfl_xor(sq, 16); sq += __shfl_xor(sq, 32);
            const float rstd = 1.0f / sqrtf(sq * (1.0f / 64.0f) + 64e-5f);
            const float bon = BONUS[((size_t)(bb_ * 8 + wave)) * S_ + s] + BONUS[((size_t)((NB + bb_) * 8 + wave)) * S_ + s];
            const bf16* pc = PR + (size_t)t * 2048;
#pragma unroll
            for (int n = 0; n < 4; ++n) { const int c0 = 64 * wave + 16 * n + 4 * fq;
                const f4 lg = *(const f4*)(lngp + c0), lb = *(const f4*)(lnbp + c0), mv = *(const f4*)(mu + 1024 + c0);
                const v2u vc = *(const v2u*)(pc + 1024 + c0);
                v2u vp = (v2u){0u, 0u}, vn = (v2u){0u, 0u};
                if (s > 0) vp = *(const v2u*)(pc + 1024 + c0 - 2048);
                if (s < S_ - 1) vn = *(const v2u*)(pc + 1024 + c0 + 2048);
                const float cc[4] = {__uint_as_float(vc.x << 16), __uint_as_float(vc.x & 0xffff0000u), __uint_as_float(vc.y << 16), __uint_as_float(vc.y & 0xffff0000u)};
                const float pp[4] = {__uint_as_float(vp.x << 16), __uint_as_float(vp.x & 0xffff0000u), __uint_as_float(vp.y << 16), __uint_as_float(vp.y & 0xffff0000u)};
                const float nn[4] = {__uint_as_float(vn.x << 16), __uint_as_float(vn.x & 0xffff0000u), __uint_as_float(vn.y << 16), __uint_as_float(vn.y & 0xffff0000u)};
                float yv[4];
#pragma unroll
                for (int v = 0; v < 4; ++v) { const float vs = cc[v] + mv[v] * (0.5f * (pp[v] + nn[v]) - cc[v]);
                    yv[v] = (wk[n][v] * rstd * lg[v] + lb[v] + bon * vs) * acc[n][v]; }
                *(v2u*)(YA + (size_t)t * 512 + c0) = (v2u){cvtpk(yv[0], yv[1]), cvtpk(yv[2], yv[3])}; }
        }
    }
}

#define GRID_SYNC_CG() do { asm volatile("s_waitcnt vmcnt(0) lgkmcnt(0)" ::: "memory"); grid.sync(); __builtin_amdgcn_fence(__ATOMIC_ACQUIRE, "agent"); asm volatile("s_waitcnt vmcnt(0)" ::: "memory"); } while (0)
#define GRID_SYNC() grid_barrier(gbar, ground)
#define GEMM_PHASE(EPI, A_, Bt_, M_, N_, K_, E_) do { pg8::Gemm g_{(const pg8::bf16_t*)(A_), (const pg8::bf16_t*)(Bt_), (M_), (N_), (K_)}; pg8::StaticOrder S_o; S_o.init((M_), (N_), (int)gridDim.x, (int)blockIdx.x); \
    pg8::gemm_phase<EPI, pg8::StaticOrder, true, true>((PG8_LAS unsigned char*)lds, g_, S_o, (E_)); } while (0)

__device__ __forceinline__ void grid_barrier(unsigned* bar, unsigned& round) {
    asm volatile("s_waitcnt vmcnt(0) lgkmcnt(0)" ::: "memory");
    __syncthreads();
    ++round;
    if (threadIdx.x == 0) {
        __builtin_amdgcn_fence(__ATOMIC_RELEASE, "agent");
        asm volatile("s_waitcnt vmcnt(0)" ::: "memory");
        const unsigned g = blockIdx.x & 7u, G = gridDim.x, ng = (G + 7u - g) >> 3, ngroups = G < 8u ? G : 8u;
        const unsigned old = __hip_atomic_fetch_add(bar + 64 * (1 + g), 1u, __ATOMIC_RELAXED, __HIP_MEMORY_SCOPE_AGENT);
        if (old + 1u == round * ng) {
            const unsigned old2 = __hip_atomic_fetch_add(bar + 64 * 9, 1u, __ATOMIC_RELAXED, __HIP_MEMORY_SCOPE_AGENT);
            if (old2 + 1u == round * ngroups) __hip_atomic_store(bar, round, __ATOMIC_RELAXED, __HIP_MEMORY_SCOPE_AGENT);
        }
        unsigned spins = 0;
        while (__hip_atomic_load(bar, __ATOMIC_RELAXED, __HIP_MEMORY_SCOPE_AGENT) < round) { __builtin_amdgcn_s_sleep(1); if (++spins > (1u << 24)) break; }
        __builtin_amdgcn_fence(__ATOMIC_ACQUIRE, "agent");
        asm volatile("s_waitcnt vmcnt(0)" ::: "memory");
    }
    __syncthreads();
}
__global__ void __launch_bounds__(NTHREADS, 2) fwd_kernel(Params P) {
    extern __shared__ __attribute__((aligned(16))) unsigned char lds[];
    cg::grid_group grid = cg::this_grid();
    unsigned char* ws = P.ws;
    bf16* H = (bf16*)(ws + WS_H); bf16* ACT = (bf16*)(ws + WS_ACT);
    float* SSB = (float*)(ws + WS_SS);
    unsigned* gbar = (unsigned*)(ws + WS_BAR); unsigned ground = 0;
    cvt_up1(P, 0, lds);
    x_to_bf16_ss(P.in[I_X], H, SSB);
    GRID_SYNC_CG();
#pragma unroll 1
    for (int l = 0; l < NL; ++l) {
        const float* xin = (l == 0) ? P.in[I_X] : P.out;
        cvt_rest(P, l, lds);
        __syncthreads();
        { pg8::EpiSwiglu E{(pg8::bf16_t*)ACT, FF, SSB}; GEMM_PHASE(pg8::EpiSwiglu, H, ws + ((l & 1) ? WS_WUP1B : WS_WUP1), T_, 2 * FF, DM, E); }
        GRID_SYNC();
        { pg8::EpiResid E{xin, P.out, DM, 0.5f, (pg8::bf16_t*)H, SSB}; GEMM_PHASE(pg8::EpiResid, ACT, ws + WS_WDN1, T_, DM, FF, E); }
        GRID_SYNC();
        { pg8::EpiWin E{(pg8::bf16_t*)(ws + WS_PR), (pg8::bf16_t*)(ws + WS_QB), (pg8::bf16_t*)(ws + WS_KVB), (pg8::bf16_t*)(ws + WS_QC), (pg8::bf16_t*)(ws + WS_KVC), SSB};
          GEMM_PHASE(pg8::EpiWin, H, ws + WS_WIN, T_, 3584, DM, E); }
        GRID_SYNC();
        qkprep(P, l);
        vt_prep(P, lds);
        __syncthreads();
        scan_fast(P, l, lds);
        GRID_SYNC();
        attn_mfma<false>((bf16*)(ws + WS_QB), (const bf16*)(ws + WS_KG), (const bf16*)(ws + WS_VG), nullptr, lds);
        attn_mfma<true>((bf16*)(ws + WS_QC), (const bf16*)(ws + WS_KW), (const bf16*)(ws + WS_VW), P.in[I_SINK] + l * 8, lds);
        __syncthreads();
        finalize_fast(P, l, lds);
        GRID_SYNC();
#pragma unroll 1
        for (int i = 0; i < 3; ++i) {
            { pg8::EpiGate E{(pg8::bf16_t*)(ws + WS_GATE), SSB}; GEMM_PHASE(pg8::EpiGate, H, ws + WS_WG + (size_t)i * DM * DM * 2, T_, DM, DM, E); }
            const unsigned char* yi = ws + (i == 0 ? WS_YA : (i == 1 ? WS_QB : WS_QC));
            { pg8::EpiMerge E{(const pg8::bf16_t*)(ws + WS_GATE), (pg8::bf16_t*)(ws + WS_MERGED), i == 0 ? 1 : 0}; GEMM_PHASE(pg8::EpiMerge, yi, ws + WS_WO + (size_t)i * DM * 512 * 2, T_, DM, 512, E); }
        }
        GRID_SYNC();
        { pg8::EpiResid E{P.out, P.out, DM, 1.0f, (pg8::bf16_t*)H, SSB}; GEMM_PHASE(pg8::EpiResid, ws + WS_MERGED, ws + WS_WOUT, T_, DM, DM, E); }
        GRID_SYNC();
        { pg8::EpiSwiglu E{(pg8::bf16_t*)ACT, FF, SSB}; GEMM_PHASE(pg8::EpiSwiglu, H, ws + WS_WUP2, T_, 2 * FF, DM, E); }
        GRID_SYNC();
        if (l + 1 < NL) { cvt_up1(P, l + 1, lds); __syncthreads(); }
        { pg8::EpiResid E{P.out, P.out, DM, 0.5f, (pg8::bf16_t*)H, SSB}; GEMM_PHASE(pg8::EpiResid, ACT, ws + WS_WDN2, T_, DM, FF, E); }
        GRID_SYNC();
    }
    rms_rows_f32_inplace(P.out, P.in[I_FINN]);
}

extern "C" void kernel_launch(void* const* d_in, const int* in_sizes, int n_in, void* d_out, int out_size, void* d_ws, size_t ws_size, hipStream_t stream) {
    static int grid_blocks = 0;
    if (grid_blocks == 0) {
        if (n_in != N_IN || out_size != T_ * DM || ws_size < WS_END) { fprintf(stderr, "kernel_launch: unexpected shapes (n_in %d, out %d, ws %zu < %zu)\n", n_in, out_size, ws_size, (size_t)WS_END); grid_blocks = -1; return; }
        int dev = 0, cus = 0, per_cu = 0;
        hipGetDevice(&dev);
        hipDeviceGetAttribute(&cus, hipDeviceAttributeMultiprocessorCount, dev);
        hipFuncSetAttribute((const void*)fwd_kernel, hipFuncAttributeMaxDynamicSharedMemorySize, LDS_BYTES);
        hipOccupancyMaxActiveBlocksPerMultiprocessor(&per_cu, (const void*)fwd_kernel, NTHREADS, LDS_BYTES);
        if (per_cu < 1) per_cu = 1;
        grid_blocks = cus * per_cu;
    }
    if (grid_blocks < 0) return;
    Params p{};
    for (int i = 0; i < N_IN; ++i) p.in[i] = (const float*)d_in[i];
    p.out = (float*)d_out; p.ws = (unsigned char*)d_ws;
    if (hipMemsetAsync((char*)d_ws + WS_BAR, 0, 4096, stream) != hipSuccess) { fprintf(stderr, "kernel_launch: hipMemsetAsync failed\n"); return; }
    void* args[] = {&p};
    hipError_t e = hipLaunchCooperativeKernel((const void*)fwd_kernel, dim3(grid_blocks), dim3(NTHREADS), args, LDS_BYTES, stream);
    if (e != hipSuccess) fprintf(stderr, "cooperative launch failed: %s (grid %d)\n", hipGetErrorString(e), grid_blocks);
}
```

```cpp
#include <hip/hip_runtime.h>
#include <hip/hip_cooperative_groups.h>
#include <cstdio>
#include <cstdint>
namespace cg = cooperative_groups;
namespace pg8 {
#define PG8_LAS __attribute__((address_space(3)))
typedef unsigned short bf16_t;
typedef short bf16x8 __attribute__((ext_vector_type(8)));
typedef float f32x4 __attribute__((ext_vector_type(4)));
typedef unsigned u32x4 __attribute__((ext_vector_type(4)));
constexpr int BM = 256, BK = 64, HALF = 128, HTB = HALF * BK * 2  , STAGE_BYTES = 8 * HTB, NXCD = 8, WGM = 8;

__host__ __device__ __forceinline__ int lds_byte(int r, int c) { const int st = (r >> 4) * 2 + (c >> 5), rr = r & 15, cc = c & 31, ob = rr * 64 + cc * 2; return st * 1024 + (ob ^ (((ob >> 9) & 1) << 5)); }
__host__ __device__ __forceinline__ void stage_rc(int b, int& R, int& C) { const int st = b / 1024, sb = b % 1024, swz = sb ^ (((sb >> 9) & 1) << 5); R = (st >> 1) * 16 + swz / 64; C = (st & 1) * 32 + (swz % 64) / 2; }
__host__ __device__ __forceinline__ int perm32(int rho) { const int n = rho >> 4, i = rho & 15; return 8 * (i >> 2) + 4 * n + (i & 3); }

struct Unit { int pm, pn; };
struct Gemm { const bf16_t* A; const bf16_t* Bt; int M, N, K; };

struct StaticOrder {
    int nM, nN, nwg, G, c;
    __host__ __device__ void init(int M, int N, int G_, int c_) { nM = M / BM; nN = N / BM; nwg = nM * nN; G = G_; c = c_; }
    __host__ __device__ bool next(int i, Unit& u) const {
        const long L = (long)i * G + c; if (L >= nwg) return false;
        int wgid = (int)L; { const int q = nwg / NXCD, r = nwg % NXCD, xcd = wgid % NXCD, off = wgid / NXCD; wgid = (xcd < r ? xcd * (q + 1) : r * (q + 1) + (xcd - r) * q) + off; }
        const int nig = WGM * nN, gid = wgid / nig, fm = gid * WGM, gsz = (nM - fm) < WGM ? (nM - fm) : WGM;
        u.pm = fm + ((wgid % nig) % gsz); u.pn = (wgid % nig) / gsz; return true;
    }
    __device__ __forceinline__ void a_ready(const Unit&) const {}
    __device__ __forceinline__ void done(const Unit&) const {}
};
typedef float f32x2_t __attribute__((ext_vector_type(2))); typedef __bf16 bf16x2_t __attribute__((ext_vector_type(2)));
__device__ __forceinline__ unsigned cvt_pk_bf16(float lo, float hi) { f32x2_t v = {lo, hi}; bf16x2_t b = __builtin_convertvector(v, bf16x2_t); return __builtin_bit_cast(unsigned, b); }
typedef float f32x2 __attribute__((ext_vector_type(2)));
__device__ __forceinline__ float fast_sigmoid(float x) { return __builtin_amdgcn_rcpf(1.0f + __builtin_amdgcn_exp2f(-1.4426950408889634f * x)); }
__device__ __forceinline__ float bf_lo(unsigned w) { return __uint_as_float(w << 16); }
__device__ __forceinline__ float bf_hi(unsigned w) { return __uint_as_float(w & 0xffff0000u); }

__device__ __forceinline__ float row_rs(const float* SS, int row) { const f32x4 a = *(const f32x4*)(SS + (size_t)row * 16), b2 = *(const f32x4*)(SS + (size_t)row * 16 + 4), c2 = *(const f32x4*)(SS + (size_t)row * 16 + 8), d = *(const f32x4*)(SS + (size_t)row * 16 + 12);
    const float s = ((a[0] + a[1]) + (a[2] + a[3])) + ((b2[0] + b2[1]) + (b2[2] + b2[3])) + ((c2[0] + c2[1]) + (c2[2] + c2[3])) + ((d[0] + d[1]) + (d[2] + d[3]));
    return 1.0f / sqrtf(s * (1.0f / 1024.0f) + 1e-6f); }
struct EpiSwiglu {
    static constexpr bool PERM = true, AFTER_DRAIN = false;
    bf16_t* O; int ldc; const float* SS;
    __device__ __forceinline__ void operator()(const f32x4 (&acc)[2][2][4][2], const Unit& u, int wr, int wc, int fr, int fq) const {
        const int row0 = u.pm * BM + wr * 64 + fr, col0 = u.pn * HALF + wc * 32 + 8 * fq;
#pragma unroll
        for (int ai = 0; ai < 2; ++ai)
#pragma unroll
            for (int m = 0; m < 4; ++m) {
                bf16_t* rowp = O + (size_t)(row0 + ai * HALF + m * 16) * ldc + col0;
                const float rs = row_rs(SS, row0 + ai * HALF + m * 16);
                float v[8];
#pragma unroll
                for (int n = 0; n < 2; ++n)
#pragma unroll
                    for (int j = 0; j < 4; ++j) { const float g = acc[ai][0][m][n][j] * rs, up = acc[ai][1][m][n][j] * rs; v[n * 4 + j] = g * fast_sigmoid(g) * up; }
                u32x4 w; w.x = cvt_pk_bf16(v[0], v[1]); w.y = cvt_pk_bf16(v[2], v[3]); w.z = cvt_pk_bf16(v[4], v[5]); w.w = cvt_pk_bf16(v[6], v[7]);
                *(u32x4*)rowp = w;
            }
    }
};
struct EpiResid {
    static constexpr bool PERM = false, AFTER_DRAIN = false;
    const float* src; float* dst; int ldc; float scale; bf16_t* XB; float* SS;
    __device__ __forceinline__ void operator()(const f32x4 (&acc)[2][2][4][2], const Unit& u, int wr, int wc, int fr, int fq) const {
        const int col0 = u.pn * BM + wc * 32 + 4 * fq;
#pragma unroll
        for (int ai = 0; ai < 2; ++ai)
#pragma unroll
            for (int m = 0; m < 4; ++m) {
                const int row = u.pm * BM + ai * HALF + wr * 64 + m * 16 + fr;
                const size_t off = (size_t)row * ldc + col0; float sq = 0.f;
#pragma unroll
                for (int bj = 0; bj < 2; ++bj)
#pragma unroll
                    for (int n = 0; n < 2; ++n) { const f32x4 b = *(const f32x4*)(src + off + bj * HALF + n * 16); const f32x4 x = b + acc[ai][bj][m][n] * scale;
                        *(f32x4*)(dst + off + bj * HALF + n * 16) = x; sq += (x[0] * x[0] + x[1] * x[1]) + (x[2] * x[2] + x[3] * x[3]);
                        typedef unsigned u32x2 __attribute__((ext_vector_type(2)));
                        *(u32x2*)(XB + off + bj * HALF + n * 16) = (u32x2){cvt_pk_bf16(x[0], x[1]), cvt_pk_bf16(x[2], x[3])}; }
                sq += __shfl_xor(sq, 16); sq += __shfl_xor(sq, 32);
                if (fq == 0) SS[(size_t)row * 16 + u.pn * 4 + wc] = sq;
            }
    }
};
struct EpiWin {
    static constexpr bool PERM = true, AFTER_DRAIN = false;
    bf16_t *PR, *QB, *KVB, *QC, *KVC; const float* SS;
    __device__ __forceinline__ void operator()(const f32x4 (&acc)[2][2][4][2], const Unit& u, int wr, int wc, int fr, int fq) const {
        bf16_t* base; int ldc, colt;
        const int pn = u.pn;
        if (pn < 8) { base = PR; ldc = 2048; colt = pn * 256; }
        else if (pn < 10) { base = QB; ldc = 512; colt = (pn - 8) * 256; }
        else if (pn == 10) { base = KVB; ldc = 256; colt = 0; }
        else if (pn < 13) { base = QC; ldc = 512; colt = (pn - 11) * 256; }
        else { base = KVC; ldc = 256; colt = 0; }
        const int row0 = u.pm * BM + wr * 64 + fr, col0 = colt + wc * 32 + 8 * fq;
#pragma unroll
        for (int ai = 0; ai < 2; ++ai)
#pragma unroll
            for (int m = 0; m < 4; ++m) {
                bf16_t* rowp = base + (size_t)(row0 + ai * HALF + m * 16) * ldc + col0;
                const float rs = row_rs(SS, row0 + ai * HALF + m * 16);
#pragma unroll
                for (int bj = 0; bj < 2; ++bj) { const f32x4 v0 = acc[ai][bj][m][0] * rs, v1 = acc[ai][bj][m][1] * rs;
                    u32x4 w; w.x = cvt_pk_bf16(v0[0], v0[1]); w.y = cvt_pk_bf16(v0[2], v0[3]); w.z = cvt_pk_bf16(v1[0], v1[1]); w.w = cvt_pk_bf16(v1[2], v1[3]);
                    *(u32x4*)(rowp + bj * HALF) = w; }
            }
    }
};
struct EpiGate {
    static constexpr bool PERM = true, AFTER_DRAIN = false;
    bf16_t* G; const float* SS;
    __device__ __forceinline__ void operator()(const f32x4 (&acc)[2][2][4][2], const Unit& u, int wr, int wc, int fr, int fq) const {
        const int row0 = u.pm * BM + wr * 64 + fr, col0 = u.pn * BM + wc * 32 + 8 * fq;
#pragma unroll
        for (int ai = 0; ai < 2; ++ai)
#pragma unroll
            for (int m = 0; m < 4; ++m) {
                bf16_t* rowp = G + (size_t)(row0 + ai * HALF + m * 16) * 1024 + col0;
                const float rs = row_rs(SS, row0 + ai * HALF + m * 16);
#pragma unroll
                for (int bj = 0; bj < 2; ++bj) { const f32x4 v0 = acc[ai][bj][m][0] * rs, v1 = acc[ai][bj][m][1] * rs;
                    u32x4 w; w.x = cvt_pk_bf16(fast_sigmoid(v0[0]), fast_sigmoid(v0[1])); w.y = cvt_pk_bf16(fast_sigmoid(v0[2]), fast_sigmoid(v0[3]));
                    w.z = cvt_pk_bf16(fast_sigmoid(v1[0]), fast_sigmoid(v1[1])); w.w = cvt_pk_bf16(fast_sigmoid(v1[2]), fast_sigmoid(v1[3]));
                    *(u32x4*)(rowp + bj * HALF) = w; }
            }
    }
};
struct EpiMerge {
    static constexpr bool PERM = true, AFTER_DRAIN = false;
    const bf16_t* G; bf16_t* Mg; int first;
    __device__ __forceinline__ void operator()(const f32x4 (&acc)[2][2][4][2], const Unit& u, int wr, int wc, int fr, int fq) const {
        const int row0 = u.pm * BM + wr * 64 + fr, col0 = u.pn * BM + wc * 32 + 8 * fq;
#pragma unroll
        for (int ai = 0; ai < 2; ++ai)
#pragma unroll
            for (int m = 0; m < 4; ++m) {
                const size_t off = (size_t)(row0 + ai * HALF + m * 16) * 1024 + col0;
#pragma unroll
                for (int bj = 0; bj < 2; ++bj) { const f32x4 v0 = acc[ai][bj][m][0], v1 = acc[ai][bj][m][1];
                    const u32x4 g = __builtin_nontemporal_load((const u32x4*)(G + off + bj * HALF));
                    float r[8];
                    r[0] = bf_lo(g.x) * v0[0]; r[1] = bf_hi(g.x) * v0[1]; r[2] = bf_lo(g.y) * v0[2]; r[3] = bf_hi(g.y) * v0[3];
                    r[4] = bf_lo(g.z) * v1[0]; r[5] = bf_hi(g.z) * v1[1]; r[6] = bf_lo(g.w) * v1[2]; r[7] = bf_hi(g.w) * v1[3];
                    if (!first) { const u32x4 p = __builtin_nontemporal_load((const u32x4*)(Mg + off + bj * HALF));
                        r[0] += bf_lo(p.x); r[1] += bf_hi(p.x); r[2] += bf_lo(p.y); r[3] += bf_hi(p.y); r[4] += bf_lo(p.z); r[5] += bf_hi(p.z); r[6] += bf_lo(p.w); r[7] += bf_hi(p.w); }
                    u32x4 w; w.x = cvt_pk_bf16(r[0], r[1]); w.y = cvt_pk_bf16(r[2], r[3]); w.z = cvt_pk_bf16(r[4], r[5]); w.w = cvt_pk_bf16(r[6], r[7]);
                    *(u32x4*)(Mg + off + bj * HALF) = w; }
            }
    }
};
template <class Epi, class Sched, bool ALIGN_EPI = false, bool SP2 = false>
__device__ __forceinline__ void gemm_phase(PG8_LAS unsigned char* lds, const Gemm g, const Sched& S, const Epi& E) {
    int tid_o = threadIdx.x; asm volatile("" : "+v"(tid_o));
    const int tid = tid_o, wid = __builtin_amdgcn_readfirstlane(tid >> 6), lane = tid & 63, wr = wid >> 2, wc = wid & 3, fr = lane & 15, fq = lane >> 4;
    const int K = g.K, nt = K / BK;
    unsigned voffA[2], voffB[2];
#pragma unroll
    for (int i = 0; i < 2; ++i) { int R, C; stage_rc(tid * 16 + i * 8192, R, C); const int Rb = Epi::PERM ? ((R & ~31) + perm32(R & 31)) : R;
        voffA[i] = (unsigned)(R * K + C) * 2u; voffB[i] = (unsigned)(Rb * K + C) * 2u; }
    const size_t kstep = (size_t)(BK * 2);
    const size_t hstep = (size_t)HALF * K * 2;
    const size_t tstep = 2 * hstep;
    const unsigned ldsw = (unsigned)wid * 1024u;
    const int aoff = lds_byte(wr * 64 + fr, fq * 8), boff = lds_byte(wc * 32 + fr, fq * 8);
#define PG8_SA(b, h) (((b) * 2 + (h)) * HTB)
#define PG8_SB(b, h) ((4 + (b) * 2 + (h)) * HTB)
#define PG8_STAGE(bufoff, gbase, voff) do { _Pragma("unroll") for (int _i = 0; _i < 2; ++_i) \
        __builtin_amdgcn_global_load_lds((const unsigned*)((const char*)(gbase) + (voff)[_i]), (PG8_LAS unsigned*)(lds + (bufoff) + ldsw + _i * 8192), 16, 0, 0); } while (0)
#define PG8_LDA(dst, b, h) do { _Pragma("unroll") for (int m = 0; m < 4; ++m) _Pragma("unroll") for (int k = 0; k < 2; ++k) dst[m][k] = *(const PG8_LAS bf16x8*)(lds + PG8_SA(b, h) + aoff + m * 2048 + k * 1024); } while (0)
#define PG8_LDB(dst, b, h) do { _Pragma("unroll") for (int n = 0; n < 2; ++n) _Pragma("unroll") for (int k = 0; k < 2; ++k) dst[n][k] = *(const PG8_LAS bf16x8*)(lds + PG8_SB(b, h) + boff + n * 2048 + k * 1024); } while (0)
#define PG8_MMA(ai, bj, At, Bt) do { __builtin_amdgcn_s_setprio(1); _Pragma("unroll") for (int m = 0; m < 4; ++m) _Pragma("unroll") for (int n = 0; n < 2; ++n) _Pragma("unroll") for (int k = 0; k < 2; ++k) \
        acc[ai][bj][m][n] = __builtin_amdgcn_mfma_f32_16x16x32_bf16(Bt[n][k], At[m][k], acc[ai][bj][m][n], 0, 0, 0); __builtin_amdgcn_s_setprio(0); } while (0)
#define PG8_WAIT_V(n) asm volatile("s_waitcnt vmcnt(" #n ")" ::: "memory")
#define PG8_WAIT_L(n) asm volatile("s_waitcnt lgkmcnt(" #n ")" ::: "memory")
#define PG8_BAR __builtin_amdgcn_s_barrier()
#define PG8_SCHED __builtin_amdgcn_sched_barrier(0)
    Unit cur, nxt; int ui = 0;
    if (!S.next(0, cur)) return;
    f32x4 acc[2][2][4][2];
#pragma unroll
    for (int a = 0; a < 2; ++a)
#pragma unroll
        for (int b = 0; b < 2; ++b)
#pragma unroll
            for (int m = 0; m < 4; ++m)
#pragma unroll
                for (int n = 0; n < 2; ++n) acc[a][b][m][n] = (f32x4){0.f, 0.f, 0.f, 0.f};
    bf16x8 At[4][2], B0[2][2], B1[2][2];
    const char* cA = (const char*)g.A + (size_t)cur.pm * tstep; const char* cB = (const char*)g.Bt + (size_t)cur.pn * tstep;
    S.a_ready(cur);
    if constexpr (SP2) {
        PG8_STAGE(PG8_SB(0, 0), cB, voffB); PG8_STAGE(PG8_SB(0, 1), cB + hstep, voffB); PG8_STAGE(PG8_SA(0, 0), cA, voffA); PG8_STAGE(PG8_SA(0, 1), cA + hstep, voffA);
        if (wr == 1) PG8_BAR;
        PG8_WAIT_V(2); PG8_BAR;
        PG8_STAGE(PG8_SB(1, 0), cB + kstep, voffB); PG8_STAGE(PG8_SA(1, 0), cA + kstep, voffA); PG8_STAGE(PG8_SB(1, 1), cB + hstep + kstep, voffB);
        PG8_WAIT_V(6); PG8_BAR;
    } else {
        PG8_STAGE(PG8_SB(0, 0), cB, voffB); PG8_STAGE(PG8_SA(0, 0), cA, voffA); PG8_STAGE(PG8_SB(0, 1), cB + hstep, voffB); PG8_STAGE(PG8_SA(0, 1), cA + hstep, voffA);
        if (wr == 1) PG8_BAR;
        PG8_WAIT_V(4); PG8_BAR;
        PG8_STAGE(PG8_SB(1, 0), cB + kstep, voffB); PG8_STAGE(PG8_SA(1, 0), cA + kstep, voffA); PG8_STAGE(PG8_SB(1, 1), cB + hstep + kstep, voffB);
        PG8_WAIT_V(6); PG8_BAR;
    }
    for (;;) {
        const bool has_next = S.next(ui + 1, nxt);
        const char* nA = has_next ? (const char*)g.A + (size_t)nxt.pm * tstep : cA; const char* nB = has_next ? (const char*)g.Bt + (size_t)nxt.pn * tstep : cB;
        for (int t = 0; t < nt; t += 2) {
            const bool last = (t == nt - 2);
            const char* a1 = cA + (size_t)(t + 1) * kstep;
            const char* a2 = last ? nA : cA + (size_t)(t + 2) * kstep; const char* b2 = last ? nB : cB + (size_t)(t + 2) * kstep;
            const char* a3 = a2 + kstep; const char* b3 = b2 + kstep;
            if (last && has_next) S.a_ready(nxt);
            if constexpr (SP2) {
            PG8_LDB(B0, 0, 0); PG8_LDB(B1, 0, 1); PG8_SCHED; PG8_LDA(At, 0, 0); PG8_STAGE(PG8_SA(1, 1), a1 + hstep, voffA);
            PG8_WAIT_V(8); PG8_WAIT_L(0); PG8_BAR; PG8_MMA(0, 0, At, B0); PG8_MMA(0, 1, At, B1); PG8_BAR; PG8_SCHED;
            PG8_LDA(At, 0, 1); PG8_STAGE(PG8_SB(0, 0), b2, voffB); PG8_STAGE(PG8_SB(0, 1), b2 + hstep, voffB); PG8_STAGE(PG8_SA(0, 0), a2, voffA);
            PG8_WAIT_V(8); PG8_WAIT_L(0); PG8_BAR; PG8_MMA(1, 0, At, B0); PG8_MMA(1, 1, At, B1); PG8_BAR; PG8_SCHED;
            PG8_LDB(B0, 1, 0); PG8_LDB(B1, 1, 1); PG8_SCHED; PG8_LDA(At, 1, 0); PG8_STAGE(PG8_SA(0, 1), a2 + hstep, voffA);
            PG8_WAIT_V(8); PG8_WAIT_L(0); PG8_BAR; PG8_MMA(0, 0, At, B0); PG8_MMA(0, 1, At, B1); PG8_BAR; PG8_SCHED;
            PG8_LDA(At, 1, 1); PG8_STAGE(PG8_SB(1, 0), b3, voffB); PG8_STAGE(PG8_SB(1, 1), b3 + hstep, voffB); PG8_STAGE(PG8_SA(1, 0), a3, voffA);
            PG8_WAIT_V(8); PG8_WAIT_L(0); PG8_BAR; PG8_MMA(1, 0, At, B0); PG8_MMA(1, 1, At, B1); PG8_BAR; PG8_SCHED;
            } else {
            PG8_LDB(B0, 0, 0); PG8_SCHED; PG8_LDA(At, 0, 0); PG8_STAGE(PG8_SA(1, 1), a1 + hstep, voffA);
            PG8_WAIT_L(8); PG8_BAR; PG8_WAIT_L(0); PG8_MMA(0, 0, At, B0); PG8_BAR; PG8_SCHED;
            PG8_LDB(B1, 0, 1); PG8_STAGE(PG8_SB(0, 0), b2, voffB);
            PG8_BAR; PG8_WAIT_L(0); PG8_MMA(0, 1, At, B1); PG8_BAR;
            PG8_LDA(At, 0, 1); PG8_STAGE(PG8_SA(0, 0), a2, voffA);
            PG8_BAR; PG8_WAIT_L(0); PG8_MMA(1, 0, At, B0); PG8_BAR; PG8_SCHED;
            PG8_STAGE(PG8_SB(0, 1), b2 + hstep, voffB);
            PG8_WAIT_V(6); PG8_BAR; PG8_MMA(1, 1, At, B1); PG8_BAR;
            PG8_LDB(B0, 1, 0); PG8_SCHED; PG8_LDA(At, 1, 0); PG8_STAGE(PG8_SA(0, 1), a2 + hstep, voffA);
            PG8_WAIT_L(8); PG8_BAR; PG8_WAIT_L(0); PG8_MMA(0, 0, At, B0); PG8_BAR; PG8_SCHED;
            PG8_LDB(B1, 1, 1); PG8_STAGE(PG8_SB(1, 0), b3, voffB);
            PG8_BAR; PG8_WAIT_L(0); PG8_MMA(0, 1, At, B1); PG8_BAR;
            PG8_LDA(At, 1, 1); PG8_STAGE(PG8_SA(1, 0), a3, voffA);
            PG8_BAR; PG8_WAIT_L(0); PG8_MMA(1, 0, At, B0); PG8_BAR; PG8_SCHED;
            PG8_STAGE(PG8_SB(1, 1), b3 + hstep, voffB);
            PG8_WAIT_V(6); PG8_BAR; PG8_MMA(1, 1, At, B1); PG8_BAR;
            }
        }
        if constexpr (ALIGN_EPI) { if (wr == 0) PG8_BAR; }
        if constexpr (!Epi::AFTER_DRAIN) { E(acc, cur, wr, wc, fr, fq); S.done(cur); }
        if (!has_next) break;
#pragma unroll
        for (int a = 0; a < 2; ++a)
#pragma unroll
            for (int b = 0; b < 2; ++b)
#pragma unroll
                for (int m = 0; m < 4; ++m)
#pragma unroll
                    for (int n = 0; n < 2; ++n) acc[a][b][m][n] = (f32x4){0.f, 0.f, 0.f, 0.f};
        cur = nxt; cA = nA; cB = nB; ++ui;
        if constexpr (ALIGN_EPI) { if (wr == 1) PG8_BAR; }
    }
    PG8_WAIT_V(0);
    if constexpr (!ALIGN_EPI) { if (wr == 0) PG8_BAR; }
    PG8_BAR;
    if constexpr (Epi::AFTER_DRAIN) { E.fused(acc, cur, wr, wc, fr, fq, lds, wid, lane); S.done(cur); }
#undef PG8_SA
#undef PG8_SB
#undef PG8_STAGE
#undef PG8_LDA
#undef PG8_LDB
#undef PG8_MMA
#undef PG8_WAIT_V
#undef PG8_WAIT_L
#undef PG8_BAR
#undef PG8_SCHED
}
}
#define LAS __attribute__((address_space(3)))
typedef unsigned short bf16;
typedef unsigned v4u __attribute__((ext_vector_type(4)));
typedef unsigned v2u __attribute__((ext_vector_type(2)));
typedef float f4 __attribute__((ext_vector_type(4)));
constexpr int T_ = 32768, S_ = 2048, NB = 16, DM = 1024, FF = 2816, NL = 4;
constexpr int NWAVES = 8, NTHREADS = 512;
constexpr int LDS_BYTES = 163840;
constexpr float LOG2E = 1.4426950408889634f;
constexpr float C2 = 0.125f * LOG2E;
constexpr float LOG2_THETA = 13.287712379549449f;

enum { I_X = 0, I_F1N, I_F1UP, I_F1DN, I_MIXN, I_WIN, I_MU, I_W0, I_W2, I_A0, I_A2, I_G2, I_KK, I_KA, I_RK, I_LNG, I_LNB, I_QN, I_KN, I_SINK,
       I_WOA, I_WOB, I_WOC, I_WOUT, I_F2N, I_F2UP, I_F2DN, I_FINN, N_IN };

constexpr size_t SZ_WUP = (size_t)2 * FF * DM * 2, SZ_WDN = (size_t)DM * FF * 2, SZ_WIN = (size_t)3584 * DM * 2, SZ_WG = (size_t)3072 * DM * 2,
                 SZ_WO = (size_t)3 * DM * 512 * 2, SZ_WOUT = (size_t)DM * DM * 2;
constexpr size_t WS_WUP1 = 0, WS_WDN1 = WS_WUP1 + SZ_WUP, WS_WIN = WS_WDN1 + SZ_WDN, WS_WG = WS_WIN + SZ_WIN, WS_WO = WS_WG + SZ_WG, WS_WOUT = WS_WO + SZ_WO,
                 WS_WUP2 = WS_WOUT + SZ_WOUT, WS_WDN2 = WS_WUP2 + SZ_WUP, WS_H = WS_WDN2 + SZ_WDN;
constexpr size_t WS_R = WS_H + (size_t)T_ * DM * 2;
constexpr size_t WS_ACT = WS_R;
constexpr size_t WS_PR = WS_R, WS_QB = WS_PR + (size_t)T_ * 2048 * 2, WS_KVB = WS_QB + (size_t)T_ * 512 * 2, WS_QC = WS_KVB + (size_t)T_ * 256 * 2, WS_KVC = WS_QC + (size_t)T_ * 512 * 2,
                 WS_KG = WS_KVC + (size_t)T_ * 256 * 2, WS_VG = WS_KG + (size_t)NB * 2 * S_ * 64 * 2, WS_KW = WS_VG + (size_t)NB * 2 * S_ * 64 * 2, WS_VW = WS_KW + (size_t)NB * 2 * S_ * 64 * 2,
                 WS_YA = WS_VW + (size_t)NB * 2 * S_ * 64 * 2, WS_WKVF = WS_YA + (size_t)T_ * 512 * 2, WS_WKVB = WS_WKVF + (size_t)T_ * 512 * 2, WS_BONUS = WS_WKVB + (size_t)T_ * 512 * 2,
                 WS_SCR = WS_BONUS + (size_t)T_ * 16 * 4, WS_SS = WS_SCR, WS_WUP1B = WS_SS + (size_t)T_ * 16 * 4, WS_BAR = WS_WUP1B + SZ_WUP, WS_END = WS_BAR + 4096;
constexpr size_t WS_GATE = WS_PR, WS_MERGED = WS_PR + (size_t)T_ * DM * 2;
static_assert(WS_ACT + (size_t)T_ * FF * 2 <= WS_END, "map");
static_assert(WS_END < 536000000ull, "workspace budget");

struct Params { const float* in[N_IN]; float* out; unsigned char* ws; };

__device__ __forceinline__ unsigned f2bf(float f) { unsigned u = __float_as_uint(f); return (u + 0x7fffu + ((u >> 16) & 1u)) >> 16; }
__device__ __forceinline__ unsigned pk2(float lo, float hi) { return f2bf(lo) | (f2bf(hi) << 16); }
__device__ __forceinline__ float bf2f(bf16 h) { return __uint_as_float((unsigned)h << 16); }
__device__ __forceinline__ int opaque_tid() { int t = threadIdx.x; asm volatile("" : "+v"(t)); return t; }
#define STAGE_IDS const int tid = opaque_tid(), lane = tid & 63, wave = __builtin_amdgcn_readfirstlane(tid >> 6); const int gw = blockIdx.x * NWAVES + wave, ngw = gridDim.x * NWAVES, gtid = blockIdx.x * NTHREADS + tid, gthreads = gridDim.x * NTHREADS; (void)lane; (void)gw; (void)ngw; (void)gtid; (void)gthreads;
__device__ __forceinline__ float wave_sum(float v) {
#pragma unroll
    for (int o = 1; o < 64; o <<= 1) v += __shfl_xor(v, o);
    return v;
}

__device__ __forceinline__ void cvt_wt(const float* W, int K, int ld, bf16* Wt, int nrows, int mode, int gw, int ngw, int lane, float* scr, const float* gain = nullptr) {
    const int nblk = nrows >> 5, nitems = (K >> 6) * nblk;
    for (int it = gw; it < nitems; it += ngw) {
        const int kb = it / nblk, nb = it % nblk, k0 = kb * 64, n0 = nb * 32;
        int col0;
        if (mode == 0) col0 = n0;
        else if (mode == 1) { const int t = n0 >> 8, r = n0 & 255; col0 = (r < 128) ? t * 128 + r : FF + t * 128 + (r - 128); }
        else if (mode == 2) col0 = n0 < 1920 ? n0 : (n0 < 2048 ? -1 : n0 - 128);
        else col0 = 3456 + n0;
        if (col0 >= 0) {
#pragma unroll 8
            for (int i = 0; i < 32; ++i) { const int kk = 2 * i + (lane >> 5); scr[kk * 33 + (lane & 31)] = W[(size_t)(k0 + kk) * ld + col0 + (lane & 31)] * (gain ? gain[k0 + kk] : 1.0f); }
        }
        asm volatile("s_waitcnt lgkmcnt(0)" ::: "memory");
        const int c = lane & 7;
#pragma unroll
        for (int j = 0; j < 4; ++j) { const int n = (lane >> 3) + 8 * j; const float* sp = scr + (8 * c) * 33 + n;
            v4u o = (v4u){0u, 0u, 0u, 0u};
            if (col0 >= 0) { o.x = pk2(sp[0 * 33], sp[1 * 33]); o.y = pk2(sp[2 * 33], sp[3 * 33]); o.z = pk2(sp[4 * 33], sp[5 * 33]); o.w = pk2(sp[6 * 33], sp[7 * 33]); }
            *(v4u*)(Wt + (size_t)(n0 + n) * K + k0 + 8 * c) = o; }
        asm volatile("s_waitcnt lgkmcnt(0)" ::: "memory");
    }
}
__device__ __forceinline__ void cvt_up1(const Params& P, int l, unsigned char* ldsg) {
    STAGE_IDS
    unsigned char* ws = P.ws; float* scr = (float*)(ldsg + wave * 8448);
    cvt_wt(P.in[I_F1UP] + (size_t)l * DM * 2 * FF, DM, 2 * FF, (bf16*)(ws + ((l & 1) ? WS_WUP1B : WS_WUP1)), 2 * FF, 1, gw, ngw, lane, scr, P.in[I_F1N] + l * DM);
}
__device__ __forceinline__ void cvt_rest(const Params& P, int l, unsigned char* ldsg) {
    STAGE_IDS
    unsigned char* ws = P.ws; float* scr = (float*)(ldsg + wave * 8448);
    cvt_wt(P.in[I_F1DN] + (size_t)l * FF * DM, FF, DM, (bf16*)(ws + WS_WDN1), DM, 0, gw, ngw, lane, scr);
    cvt_wt(P.in[I_WIN] + (size_t)l * DM * 6528, DM, 6528, (bf16*)(ws + WS_WIN), 3584, 2, gw, ngw, lane, scr, P.in[I_MIXN] + l * DM);
    cvt_wt(P.in[I_WIN] + (size_t)l * DM * 6528, DM, 6528, (bf16*)(ws + WS_WG), 3072, 3, gw, ngw, lane, scr, P.in[I_MIXN] + l * DM);
    cvt_wt(P.in[I_WOA] + (size_t)l * 512 * DM, 512, DM, (bf16*)(ws + WS_WO), DM, 0, gw, ngw, lane, scr);
    cvt_wt(P.in[I_WOB] + (size_t)l * 512 * DM, 512, DM, (bf16*)(ws + WS_WO) + (size_t)DM * 512, DM, 0, gw, ngw, lane, scr);
    cvt_wt(P.in[I_WOC] + (size_t)l * 512 * DM, 512, DM, (bf16*)(ws + WS_WO) + (size_t)2 * DM * 512, DM, 0, gw, ngw, lane, scr);
    cvt_wt(P.in[I_WOUT] + (size_t)l * DM * DM, DM, DM, (bf16*)(ws + WS_WOUT), DM, 0, gw, ngw, lane, scr);
    cvt_wt(P.in[I_F2UP] + (size_t)l * DM * 2 * FF, DM, 2 * FF, (bf16*)(ws + WS_WUP2), 2 * FF, 1, gw, ngw, lane, scr, P.in[I_F2N] + l * DM);
    cvt_wt(P.in[I_F2DN] + (size_t)l * FF * DM, FF, DM, (bf16*)(ws + WS_WDN2), DM, 0, gw, ngw, lane, scr);
}
__device__ __forceinline__ void x_to_bf16_ss(const float* x, bf16* o, float* SS) {
    STAGE_IDS
    for (int m = gw; m < T_; m += ngw) {
        const f4* xr = (const f4*)(x + (size_t)m * DM) + lane; f4 v[4]; float s = 0.f;
#pragma unroll
        for (int j = 0; j < 4; ++j) { v[j] = xr[64 * j]; s += (v[j].x * v[j].x + v[j].y * v[j].y) + (v[j].z * v[j].z + v[j].w * v[j].w); }
        s = wave_sum(s);
        v2u* op = (v2u*)(o + (size_t)m * DM) + lane;
#pragma unroll
        for (int j = 0; j < 4; ++j) { v2u w; w.x = pk2(v[j].x, v[j].y); w.y = pk2(v[j].z, v[j].w); op[64 * j] = w; }
        if (lane < 16) SS[(size_t)m * 16 + lane] = lane == 0 ? s : 0.f;
    }
}

__device__ __forceinline__ void rms_rows_f32_inplace(float* x, const float* g) {
    STAGE_IDS
    const f4* gr = (const f4*)g + lane; f4 gv[4];
#pragma unroll
    for (int j = 0; j < 4; ++j) gv[j] = gr[64 * j];
    for (int m = gw; m < T_; m += ngw) {
        f4* xr = (f4*)(x + (size_t)m * DM) + lane; f4 v[4]; float s = 0.f;
#pragma unroll
        for (int j = 0; j < 4; ++j) { v[j] = xr[64 * j]; s += (v[j].x * v[j].x + v[j].y * v[j].y) + (v[j].z * v[j].z + v[j].w * v[j].w); }
        const float rs = 1.0f / sqrtf(wave_sum(s) * (1.0f / DM) + 1e-6f);
#pragma unroll
        for (int j = 0; j < 4; ++j) xr[64 * j] = v[j] * rs * gv[j];
    }
}

__device__ __forceinline__ float fast_sin_rev(float rev) { return __builtin_amdgcn_sinf(__builtin_amdgcn_fractf(rev)); }
__device__ __forceinline__ float fast_cos_rev(float rev) { return __builtin_amdgcn_cosf(__builtin_amdgcn_fractf(rev)); }
__device__ __forceinline__ void qkprep(const Params& P, int l, bool dummy = false) {
    STAGE_IDS
    unsigned char* ws = P.ws;
    bf16* QB = (bf16*)(ws + WS_QB); const bf16* KVB = (const bf16*)(ws + WS_KVB); bf16* QC = (bf16*)(ws + WS_QC); const bf16* KVC = (const bf16*)(ws + WS_KVC);
    bf16* KG = (bf16*)(ws + WS_KG); bf16* KW = (bf16*)(ws + WS_KW);
    const float qg = P.in[I_QN][l * 64 + lane], kg = P.in[I_KN][l * 64 + lane];
    const float inv_ax = exp2f(-(float)(lane & 15) * (LOG2_THETA / 16.0f)), inv_1d = exp2f(-(float)(lane & 31) * (LOG2_THETA / 32.0f));
    const float INV2PI = 0.15915494309189535f;
    for (int t = gw; t < T_; t += ngw) {
        const int b = t >> 11, s = t & 2047;
        const float pos = lane < 32 ? (float)(s >> 6) : (float)(s & 63);
        const float ra = (pos * inv_ax) * INV2PI, r1 = ((float)s * inv_1d) * INV2PI;
        const float csa = fast_cos_rev(ra), sna = (lane & 16) ? fast_sin_rev(ra) : -fast_sin_rev(ra);
        const float cs1 = fast_cos_rev(r1), sn1 = (lane & 32) ? fast_sin_rev(r1) : -fast_sin_rev(r1);
#pragma unroll
        for (int slot = 0; slot < 10; ++slot) {
            bf16* src = slot < 8 ? QB + (size_t)t * 512 + slot * 64 : (bf16*)KVB + (size_t)t * 256 + (slot - 8) * 64;
            const float x = bf2f(src[lane]);
            const float ss = wave_sum(x * x) * (1.0f / 64.0f);
            const float y = x * (1.0f / sqrtf(ss + 1e-6f)) * (slot < 8 ? qg : kg);
            const float r = y * csa + __shfl_xor(y, 16) * sna;
            if (slot < 8) (dummy ? (bf16*)(ws + WS_YA) + (size_t)t * 512 + slot * 64 : src)[lane] = (bf16)f2bf(r * C2);
            else KG[((size_t)(b * 2 + (slot - 8)) * S_ + s) * 64 + lane] = (bf16)f2bf(r);
        }
#pragma unroll
        for (int slot = 0; slot < 10; ++slot) {
            bf16* src = slot < 8 ? QC + (size_t)t * 512 + slot * 64 : (bf16*)KVC + (size_t)t * 256 + (slot - 8) * 64;
            const float x = bf2f(src[lane]);
            const float r = x * cs1 + __shfl_xor(x, 32) * sn1;
            if (slot < 8) (dummy ? (bf16*)(ws + WS_YA) + (size_t)t * 512 + slot * 64 : src)[lane] = (bf16)f2bf(r * C2);
            else KW[((size_t)(b * 2 + (slot - 8)) * S_ + s) * 64 + lane] = (bf16)f2bf(r);
        }
    }
}

__device__ __forceinline__ void vt_prep(const Params& P, unsigned char* ldsg) {
    STAGE_IDS
    unsigned char* ws = P.ws;
    bf16* tile = (bf16*)(ldsg + wave * 8448);
    for (int it = gw; it < 2 * NB * 2 * 32; it += ngw) {
        const int tb = it & 31, kvh = (it >> 5) & 1, b = (it >> 6) & 15, att = it >> 10;
        const bf16* src = (const bf16*)(ws + (att ? WS_KVC : WS_KVB)) + (size_t)(b * S_ + tb * 64) * 256 + 128 + kvh * 64;
        bf16* dst = (bf16*)(ws + (att ? WS_VW : WS_VG)) + (size_t)(b * 2 + kvh) * 64 * S_ + tb * 64;
#pragma unroll 8
        for (int r = 0; r < 64; ++r) tile[r * 66 + lane] = src[(size_t)r * 256 + lane];
        asm volatile("s_waitcnt lgkmcnt(0)" ::: "memory");
#pragma unroll 8
        for (int d = 0; d < 64; ++d) dst[(size_t)d * S_ + lane] = tile[lane * 66 + d];
        asm volatile("s_waitcnt lgkmcnt(0)" ::: "memory");
    }
}

typedef short bf16x8_t __attribute__((ext_vector_type(8)));
typedef short s16x4_t __attribute__((ext_vector_type(4)));
typedef float f32x16 __attribute__((ext_vector_type(16)));
typedef float f32x2a __attribute__((ext_vector_type(2))); typedef __bf16 bf16x2a __attribute__((ext_vector_type(2)));
__device__ __forceinline__ unsigned cvtpk(float lo, float hi) { f32x2a v = {lo, hi}; bf16x2a b = __builtin_convertvector(v, bf16x2a); return __builtin_bit_cast(unsigned, b); }
__device__ __forceinline__ int crow(int r, int hi) { return (r & 3) + 8 * (r >> 2) + 4 * hi; }
template <bool WINDOW>
__device__ __forceinline__ void attn_mfma(bf16* Q, const bf16* Kx, const bf16* VTx, const float* sink, unsigned char* ldsg, bf16* Oalt = nullptr) {
    STAGE_IDS
    const int r32 = lane & 31, hi = lane >> 5, g = wave >> 1, qs = wave & 1;
    const int srow = tid >> 3, sch = tid & 7;
    for (int unit = blockIdx.x; unit < 1024; unit += gridDim.x) {
        const int qb = unit & 31, kvh = (unit >> 5) & 1, b = unit >> 6, h = kvh * 4 + g, q0 = qb * 64 + qs * 32;
        bf16* qp = Q + ((size_t)(b * S_ + q0 + r32)) * 512 + h * 64;
        bf16x8_t qr[4];
#pragma unroll
        for (int d0 = 0; d0 < 4; ++d0) qr[d0] = *(const bf16x8_t*)(qp + 16 * d0 + 8 * hi);
        f32x16 o0, o1;
#pragma unroll
        for (int r = 0; r < 16; ++r) { o0[r] = 0.f; o1[r] = 0.f; }
        float m, l;
        if (WINDOW) { m = sink[h] * LOG2E; l = hi == 0 ? 1.0f : 0.f; } else { m = -1e30f; l = 0.f; }
        const int t0 = WINDOW ? (qb - 2 > 0 ? qb - 2 : 0) : 0, t1 = WINDOW ? (qb + 2 < 31 ? qb + 2 : 31) : 31;
        const bf16* kbase = Kx + (size_t)(b * 2 + kvh) * S_ * 64 + (size_t)srow * 64 + sch * 8;
        const bf16* vbase = VTx + (size_t)(b * 2 + kvh) * 64 * S_ + (size_t)srow * S_ + sch * 8;
        v4u kreg = *(const v4u*)(kbase + (size_t)t0 * 64 * 64);
        v4u vreg = *(const v4u*)(vbase + t0 * 64);
        __syncthreads();
        *(v4u*)(ldsg + srow * 144 + sch * 16) = kreg;
        *(v4u*)(ldsg + 9216 + srow * 144 + sch * 16) = vreg;
        __syncthreads();
        for (int t = t0; t <= t1; ++t) {
            const int buf = (t - t0) & 1;
            if (t < t1) { kreg = *(const v4u*)(kbase + (size_t)(t + 1) * 64 * 64); vreg = *(const v4u*)(vbase + (t + 1) * 64); }
            const unsigned char* Kb = ldsg + buf * 18432; const unsigned char* Vb = Kb + 9216;
            f32x16 p0, p1;
#pragma unroll
            for (int r = 0; r < 16; ++r) { p0[r] = 0.f; p1[r] = 0.f; }
#pragma unroll
            for (int d0 = 0; d0 < 4; ++d0) {
                const bf16x8_t a0 = *(const bf16x8_t*)(Kb + r32 * 144 + (16 * d0 + 8 * hi) * 2);
                const bf16x8_t a1 = *(const bf16x8_t*)(Kb + (32 + r32) * 144 + (16 * d0 + 8 * hi) * 2);
                p0 = __builtin_amdgcn_mfma_f32_32x32x16_bf16(a0, qr[d0], p0, 0, 0, 0);
                p1 = __builtin_amdgcn_mfma_f32_32x32x16_bf16(a1, qr[d0], p1, 0, 0, 0);
            }
            if (WINDOW) {
                const int qpos = q0 + r32;
#pragma unroll
                for (int r = 0; r < 16; ++r) { const int kv = t * 64 + crow(r, hi); int dlt = qpos - kv; dlt = dlt < 0 ? -dlt : dlt; if (dlt > 128) p0[r] = -1e30f;
                    int dl2 = qpos - (kv + 32); dl2 = dl2 < 0 ? -dl2 : dl2; if (dl2 > 128) p1[r] = -1e30f; }
            }
            float mt = fmaxf(p0[0], p1[0]);
#pragma unroll
            for (int r = 1; r < 16; ++r) mt = fmaxf(mt, fmaxf(p0[r], p1[r]));
            mt = fmaxf(mt, __shfl_xor(mt, 32));
            if (__any(mt > m)) {
                const float mn = fmaxf(m, mt), corr = __builtin_amdgcn_exp2f(m - mn); m = mn;
                l *= corr;
#pragma unroll
                for (int r = 0; r < 16; ++r) { o0[r] *= corr; o1[r] *= corr; }
            }
            float ps0 = 0.f, ps1 = 0.f;
#pragma unroll
            for (int r = 0; r < 16; ++r) { p0[r] = __builtin_amdgcn_exp2f(p0[r] - m); p1[r] = __builtin_amdgcn_exp2f(p1[r] - m); ps0 += p0[r]; ps1 += p1[r]; }
            l += ps0 + ps1;
            v4u pw[4];
            pw[0] = (v4u){cvtpk(p0[0], p0[1]), cvtpk(p0[2], p0[3]), cvtpk(p0[4], p0[5]), cvtpk(p0[6], p0[7])};
            pw[1] = (v4u){cvtpk(p0[8], p0[9]), cvtpk(p0[10], p0[11]), cvtpk(p0[12], p0[13]), cvtpk(p0[14], p0[15])};
            pw[2] = (v4u){cvtpk(p1[0], p1[1]), cvtpk(p1[2], p1[3]), cvtpk(p1[4], p1[5]), cvtpk(p1[6], p1[7])};
            pw[3] = (v4u){cvtpk(p1[8], p1[9]), cvtpk(p1[10], p1[11]), cvtpk(p1[12], p1[13]), cvtpk(p1[14], p1[15])};
#pragma unroll
            for (int kb = 0; kb < 4; ++kb) {
                const bf16x8_t pb = __builtin_bit_cast(bf16x8_t, pw[kb]);
                { const unsigned char* vp = Vb + r32 * 144 + (16 * kb + 4 * hi) * 2; const s16x4_t lo = *(const s16x4_t*)vp, hh = *(const s16x4_t*)(vp + 16);
                  const bf16x8_t a = (bf16x8_t){lo[0], lo[1], lo[2], lo[3], hh[0], hh[1], hh[2], hh[3]};
                  o0 = __builtin_amdgcn_mfma_f32_32x32x16_bf16(a, pb, o0, 0, 0, 0); }
                { const unsigned char* vp = Vb + (32 + r32) * 144 + (16 * kb + 4 * hi) * 2; const s16x4_t lo = *(const s16x4_t*)vp, hh = *(const s16x4_t*)(vp + 16);
                  const bf16x8_t a = (bf16x8_t){lo[0], lo[1], lo[2], lo[3], hh[0], hh[1], hh[2], hh[3]};
                  o1 = __builtin_amdgcn_mfma_f32_32x32x16_bf16(a, pb, o1, 0, 0, 0); }
            }
            if (t < t1) { unsigned char* nb = ldsg + (buf ^ 1) * 18432; *(v4u*)(nb + srow * 144 + sch * 16) = kreg; *(v4u*)(nb + 9216 + srow * 144 + sch * 16) = vreg; }
            __syncthreads();
        }
        l += __shfl_xor(l, 32);
        const float inv = 1.0f / l;
        if (Oalt) qp = Oalt + ((size_t)(b * S_ + q0 + r32)) * 512 + h * 64;
#pragma unroll
        for (int g4 = 0; g4 < 4; ++g4) {
            v2u w0, w1;
            w0.x = cvtpk(o0[4 * g4 + 0] * inv, o0[4 * g4 + 1] * inv); w0.y = cvtpk(o0[4 * g4 + 2] * inv, o0[4 * g4 + 3] * inv);
            w1.x = cvtpk(o1[4 * g4 + 0] * inv, o1[4 * g4 + 1] * inv); w1.y = cvtpk(o1[4 * g4 + 2] * inv, o1[4 * g4 + 3] * inv);
            *(v2u*)(qp + 8 * g4 + 4 * hi) = w0;
            *(v2u*)(qp + 32 + 8 * g4 + 4 * hi) = w1;
        }
    }
}

typedef float f8s __attribute__((ext_vector_type(8)));
typedef float f32x4m __attribute__((ext_vector_type(4)));
constexpr int SC_VEC = 0, SC_VS = 81920, SC_W2T = 98304, SC_A2T = 107520, SC_XCH = 116736, SC_YP = 124928, SC_A1 = SC_YP, SC_A2 = SC_YP + 9216, SC_AL = SC_YP + 18432, SC_CS = SC_AL + 16640, SC_END = SC_CS + 128;
static_assert(SC_END <= LDS_BYTES, "scan LDS");
__device__ __forceinline__ void ld8bf(const bf16* p, float (&f)[8]) { const v4u w = *(const v4u*)p;
    f[0] = __uint_as_float(w.x << 16); f[1] = __uint_as_float(w.x & 0xffff0000u); f[2] = __uint_as_float(w.y << 16); f[3] = __uint_as_float(w.y & 0xffff0000u);
    f[4] = __uint_as_float(w.z << 16); f[5] = __uint_as_float(w.z & 0xffff0000u); f[6] = __uint_as_float(w.w << 16); f[7] = __uint_as_float(w.w & 0xffff0000u); }
__device__ __forceinline__ void shifted8(const bf16* pc, int col, bool hasp, bool hasn, const float* mu, float (&o)[8]) {
    float c[8], p[8], n[8];
    ld8bf(pc + col, c);
    if (hasp) ld8bf(pc + col - 2048, p); else { for (int e = 0; e < 8; ++e) p[e] = 0.f; }
    if (hasn) ld8bf(pc + col + 2048, n); else { for (int e = 0; e < 8; ++e) n[e] = 0.f; }
    const f4 m0 = *(const f4*)(mu + col), m1 = *(const f4*)(mu + col + 4);
    const float mm[8] = {m0.x, m0.y, m0.z, m0.w, m1.x, m1.y, m1.z, m1.w};
#pragma unroll
    for (int e = 0; e < 8; ++e) o[e] = c[e] + mm[e] * (0.5f * (p[e] + n[e]) - c[e]);
}
struct Raw3 { v4u c, p, n; };
__device__ __forceinline__ void raw_load(Raw3& r, const bf16* pc, int col, bool hasp, bool hasn) {
    r.c = *(const v4u*)(pc + col);
    r.p = hasp ? *(const v4u*)(pc + col - 2048) : (v4u){0u, 0u, 0u, 0u};
    r.n = hasn ? *(const v4u*)(pc + col + 2048) : (v4u){0u, 0u, 0u, 0u};
}
__device__ __forceinline__ void un8(const v4u w, float (&f)[8]) {
    f[0] = __uint_as_float(w.x << 16); f[1] = __uint_as_float(w.x & 0xffff0000u); f[2] = __uint_as_float(w.y << 16); f[3] = __uint_as_float(w.y & 0xffff0000u);
    f[4] = __uint_as_float(w.z << 16); f[5] = __uint_as_float(w.z & 0xffff0000u); f[6] = __uint_as_float(w.w << 16); f[7] = __uint_as_float(w.w & 0xffff0000u); }
__device__ __forceinline__ void shift_raw(const Raw3& r, const float* mu, int col, float (&o)[8]) {
    float c[8], p[8], n[8]; un8(r.c, c); un8(r.p, p); un8(r.n, n);
    const f4 m0 = *(const f4*)(mu + col), m1 = *(const f4*)(mu + col + 4);
    const float mm[8] = {m0.x, m0.y, m0.z, m0.w, m1.x, m1.y, m1.z, m1.w};
#pragma unroll
    for (int e = 0; e < 8; ++e) o[e] = c[e] + mm[e] * (0.5f * (p[e] + n[e]) - c[e]);
}
__device__ __forceinline__ void scan_fast(const Params& P, int l, unsigned char* ldsg) {
    STAGE_IDS
    unsigned char* ws = P.ws;
    const bf16* PR = (const bf16*)(ws + WS_PR); float* BONUS = (float*)(ws + WS_BONUS);
    float* VEC = (float*)(ldsg + SC_VEC);
    const int fr = lane & 15, fq = lane >> 4, ps = tid >> 3, pcg = tid & 7;
    float* XCH = (float*)(ldsg + SC_XCH); float* YP = (float*)(ldsg + SC_YP); float* VS = (float*)(ldsg + SC_VS); float* AL = (float*)(ldsg + SC_AL);
    for (int sid = blockIdx.x; sid < 256; sid += gridDim.x) {
        const int dir = sid & 1, h = (sid >> 1) & 7, b = sid >> 4, hc0 = h * 64;
        bf16* WKV = (bf16*)(ws + (dir ? WS_WKVB : WS_WKVF));
        const float* mu = P.in[I_MU] + (size_t)l * 1920;
        __syncthreads();
        {
            const float* w2b = P.in[I_W2] + (size_t)(l * 2 + dir) * 64 * 512 + (size_t)ps * 512 + hc0 + 8 * pcg;
            const float* a2b = P.in[I_A2] + (size_t)(l * 2 + dir) * 64 * 512 + (size_t)ps * 512 + hc0 + 8 * pcg;
#pragma unroll
            for (int e = 0; e < 8; ++e) { ((bf16*)(ldsg + SC_W2T))[(8 * pcg + e) * 72 + ps] = (bf16)f2bf(w2b[e]); ((bf16*)(ldsg + SC_A2T))[(8 * pcg + e) * 72 + ps] = (bf16)f2bf(a2b[e]); }
        }
        float S[8];
#pragma unroll
        for (int j = 0; j < 8; ++j) S[j] = 0.f;
        Raw3 pre[5];
#pragma unroll 1
        for (int ch = 0; ch < S_ / 64; ++ch) {
            const int step0 = ch * 64;
            const int tp = dir ? S_ - 1 - (step0 + ps) : step0 + ps;
            const int cR = hc0 + 8 * pcg, cK = 512 + hc0 + 8 * pcg, cV = 1024 + hc0 + 8 * pcg, cW = 1536 + 64 * dir + 8 * pcg, cA = 1664 + 64 * dir + 8 * pcg;
            if (ch == 0) { const bf16* pc = PR + ((size_t)(b * S_ + tp)) * 2048; const bool hasp = tp > 0, hasn = tp < S_ - 1;
                raw_load(pre[0], pc, cR, hasp, hasn); raw_load(pre[1], pc, cK, hasp, hasn); raw_load(pre[2], pc, cV, hasp, hasn); raw_load(pre[3], pc, cW, hasp, hasn); raw_load(pre[4], pc, cA, hasp, hasn); }
            float r8[8], k8[8], v8[8];
            shift_raw(pre[0], mu, cR, r8);
            shift_raw(pre[1], mu, cK, k8);
            shift_raw(pre[2], mu, cV, v8);
            { float wl[8], al[8];
              shift_raw(pre[3], mu, cW, wl);
              shift_raw(pre[4], mu, cA, al);
#pragma unroll
              for (int e = 0; e < 8; ++e) { const float t2 = __builtin_amdgcn_exp2f(2.0f * LOG2E * wl[e]); wl[e] = (t2 - 1.0f) * __builtin_amdgcn_rcpf(t2 + 1.0f); }
              v4u w1, w2v; w1.x = cvtpk(wl[0], wl[1]); w1.y = cvtpk(wl[2], wl[3]); w1.z = cvtpk(wl[4], wl[5]); w1.w = cvtpk(wl[6], wl[7]);
              w2v.x = cvtpk(al[0], al[1]); w2v.y = cvtpk(al[2], al[3]); w2v.z = cvtpk(al[4], al[5]); w2v.w = cvtpk(al[6], al[7]);
              *(v4u*)(ldsg + SC_A1 + ps * 144 + pcg * 16) = w1; *(v4u*)(ldsg + SC_A2 + ps * 144 + pcg * 16) = w2v; }
            *(f4*)(VS + ps * 64 + 8 * pcg) = (f4){v8[0], v8[1], v8[2], v8[3]}; *(f4*)(VS + ps * 64 + 8 * pcg + 4) = (f4){v8[4], v8[5], v8[6], v8[7]};
            __syncthreads();
            {
                const int wq = wave & 3; const bool isw = wave < 4;
                const unsigned char* Ab = ldsg + (isw ? SC_A1 : SC_A2) + (16 * wq + fr) * 144 + 16 * fq;
                const unsigned char* Bb = ldsg + (isw ? SC_W2T : SC_A2T) + fr * 144 + 16 * fq;
                const bf16x8_t a0 = *(const bf16x8_t*)Ab, a1 = *(const bf16x8_t*)(Ab + 64);
                const float* bias = P.in[isw ? I_W0 : I_A0] + (size_t)(l * 2 + dir) * 512 + hc0;
#pragma unroll
                for (int n = 0; n < 4; ++n) {
                    const bf16x8_t b0 = *(const bf16x8_t*)(Bb + n * 16 * 144), b1 = *(const bf16x8_t*)(Bb + n * 16 * 144 + 64);
                    f32x4m acc = (f32x4m){0.f, 0.f, 0.f, 0.f};
                    acc = __builtin_amdgcn_mfma_f32_16x16x32_bf16(a0, b0, acc, 0, 0, 0);
                    acc = __builtin_amdgcn_mfma_f32_16x16x32_bf16(a1, b1, acc, 0, 0, 0);
                    const float bz = bias[16 * n + fr];
#pragma unroll
                    for (int v = 0; v < 4; ++v) {
                        const int st = 16 * wq + 4 * fq + v; const float x = acc[v] + bz;
                        if (isw) { const float sp = __builtin_amdgcn_logf(1.0f + __builtin_amdgcn_exp2f(-x * LOG2E)) * 0.6931471805599453f;
                                   const float wlog = -sp - 0.5f; VEC[st * 320 + (2 * n + (fr >> 3)) * 40 + (fr & 7)] = __builtin_amdgcn_exp2f(-__builtin_amdgcn_exp2f(wlog * LOG2E) * LOG2E); }
                        else AL[st * 65 + 16 * n + fr] = __builtin_amdgcn_rcpf(1.0f + __builtin_amdgcn_exp2f(-x * LOG2E));
                    }
                }
            }
            __syncthreads();
            {
                const float* kkp = P.in[I_KK] + l * 512 + hc0 + 8 * pcg; const float* kap = P.in[I_KA] + l * 512 + hc0 + 8 * pcg; const float* rkp = P.in[I_RK] + l * 512 + hc0 + 8 * pcg;
                float a8[8], kk[8], kd[8]; float ss = 0.f, bon = 0.f;
#pragma unroll
                for (int e = 0; e < 8; ++e) { a8[e] = AL[ps * 65 + 8 * pcg + e]; kk[e] = k8[e] * kkp[e]; ss += kk[e] * kk[e]; kd[e] = k8[e] * (1.0f + (a8[e] - 1.0f) * kap[e]); bon += r8[e] * kd[e] * rkp[e]; }
                ss += __shfl_xor(ss, 1); ss += __shfl_xor(ss, 2); ss += __shfl_xor(ss, 4);
                bon += __shfl_xor(bon, 1); bon += __shfl_xor(bon, 2); bon += __shfl_xor(bon, 4);
                const float rn = 1.0f / fmaxf(sqrtf(ss), 1e-12f);
                float* sp = VEC + ps * 320 + 40 * pcg;
                *(f4*)(sp + 8) = (f4){kd[0], kd[1], kd[2], kd[3]}; *(f4*)(sp + 12) = (f4){kd[4], kd[5], kd[6], kd[7]};
                *(f4*)(sp + 16) = (f4){-kk[0] * rn, -kk[1] * rn, -kk[2] * rn, -kk[3] * rn}; *(f4*)(sp + 20) = (f4){-kk[4] * rn, -kk[5] * rn, -kk[6] * rn, -kk[7] * rn};
                *(f4*)(sp + 24) = (f4){kk[0] * rn * a8[0], kk[1] * rn * a8[1], kk[2] * rn * a8[2], kk[3] * rn * a8[3]}; *(f4*)(sp + 28) = (f4){kk[4] * rn * a8[4], kk[5] * rn * a8[5], kk[6] * rn * a8[6], kk[7] * rn * a8[7]};
                *(f4*)(sp + 32) = (f4){r8[0], r8[1], r8[2], r8[3]}; *(f4*)(sp + 36) = (f4){r8[4], r8[5], r8[6], r8[7]};
                if (pcg == 0) BONUS[((size_t)((dir * NB + b) * 8 + h)) * S_ + tp] = bon;
            }
            asm volatile("s_waitcnt vmcnt(0) lgkmcnt(0)" ::: "memory");
            __syncthreads();
            {
                float* CS = (float*)(ldsg + SC_CS);
                const int p = tid >> 4, q = tid & 15;
                const float* b0 = VEC + (2 * p) * 320 + (q >> 1) * 40 + 24 + (q & 1) * 4; const float* n1 = VEC + (2 * p + 1) * 320 + (q >> 1) * 40 + 16 + (q & 1) * 4;
                float d = (b0[0] * n1[0] + b0[1] * n1[1]) + (b0[2] * n1[2] + b0[3] * n1[3]);
                d += __shfl_xor(d, 1); d += __shfl_xor(d, 2); d += __shfl_xor(d, 4); d += __shfl_xor(d, 8);
                if (q == 0) CS[p] = d;
            }
            asm volatile("s_waitcnt lgkmcnt(0)" ::: "memory");
            __syncthreads();
#define DPP_FMAC(acc, xs, val, N) asm("v_fmac_f32_dpp %0, %1, %2 row_newbcast:" #N " row_mask:0xf bank_mask:0xf" : "+v"(acc) : "v"(xs), "v"(val))
#define DPP_MUL(dst, xs, val, N) asm("v_mul_f32_dpp %0, %1, %2 row_newbcast:" #N " row_mask:0xf bank_mask:0xf" : "=v"(dst) : "v"(xs), "v"(val))
            if (ch + 1 < S_ / 64) { const int tn = dir ? S_ - 1 - (step0 + 64 + ps) : step0 + 64 + ps; const bf16* pc = PR + ((size_t)(b * S_ + tn)) * 2048; const bool hasp = tn > 0, hasn = tn < S_ - 1;
                raw_load(pre[0], pc, cR, hasp, hasn); raw_load(pre[1], pc, cK, hasp, hasn); raw_load(pre[2], pc, cV, hasp, hasn); raw_load(pre[3], pc, cW, hasp, hasn); raw_load(pre[4], pc, cA, hasp, hasn); }
            const float* vecb = VEC + wave * 40 + (lane & 15);
            const int o2 = 32 + (lane & 7) - (lane & 15);
            const float* CSr = (const float*)(ldsg + SC_CS);
#define R8(M) M(0) M(1) M(2) M(3) M(4) M(5) M(6) M(7)
#define R7(M) M(1) M(2) M(3) M(4) M(5) M(6) M(7)
            const int xslot = lane * 8 + ((wave + (lane >> 2)) & 7);
            auto pair_steps = [&](const int t, float& x0, float& x1, float& x2, float& m0, float& m1, float& m2, const float va, const float vb) __attribute__((always_inline)) {
                const float Cc = CSr[t >> 1];
                asm volatile("s_nop 1" : "+v"(x0), "+v"(x1), "+v"(x2), "+v"(m0), "+v"(m1), "+v"(m2));
                float pa, pb, qa, qb, Tt[8];
                DPP_MUL(pa, x1, S[0], 0); DPP_MUL(pb, x1, S[1], 1);
                DPP_FMAC(pa, x1, S[2], 2); DPP_FMAC(pb, x1, S[3], 3); DPP_FMAC(pa, x1, S[4], 4); DPP_FMAC(pb, x1, S[5], 5); DPP_FMAC(pa, x1, S[6], 6); DPP_FMAC(pb, x1, S[7], 7);
#define M_T0(j) DPP_MUL(Tt[j], x0, S[j], j);
                R8(M_T0)
                DPP_FMAC(Tt[0], x0, va, 8); DPP_FMAC(Tt[1], x0, va, 9); DPP_FMAC(Tt[2], x0, va, 10); DPP_FMAC(Tt[3], x0, va, 11);
                DPP_FMAC(Tt[4], x0, va, 12); DPP_FMAC(Tt[5], x0, va, 13); DPP_FMAC(Tt[6], x0, va, 14); DPP_FMAC(Tt[7], x0, va, 15);
                DPP_MUL(qa, m1, Tt[0], 0); DPP_MUL(qb, m1, Tt[1], 1);
                DPP_FMAC(qa, m1, Tt[2], 2); DPP_FMAC(qb, m1, Tt[3], 3); DPP_FMAC(qa, m1, Tt[4], 4); DPP_FMAC(qb, m1, Tt[5], 5); DPP_FMAC(qa, m1, Tt[6], 6); DPP_FMAC(qb, m1, Tt[7], 7);
                const int par = (t >> 1) & 1;
                XCH[par * 1024 + xslot] = pa + pb; XCH[par * 1024 + 512 + xslot] = qa + qb;
                asm volatile("s_waitcnt lgkmcnt(0)\n\ts_barrier" ::: "memory");
                const f4* xp = (const f4*)(XCH + par * 1024 + lane * 8);
                const f4 e0 = xp[0], e1 = xp[1], g0 = xp[128], g1 = xp[129];
                const f4 es = e0 + e1, gs = g0 + g1;
                float sa0 = (es.x + es.y) + (es.z + es.w);
                asm volatile("" : "+v"(sa0));
                const float p1s = (gs.x + gs.y) + (gs.z + gs.w);
                float sa1 = p1s + sa0 * Cc;
                DPP_FMAC(Tt[0], x1, sa0, 8); DPP_FMAC(Tt[1], x1, sa0, 9); DPP_FMAC(Tt[2], x1, sa0, 10); DPP_FMAC(Tt[3], x1, sa0, 11);
                DPP_FMAC(Tt[4], x1, sa0, 12); DPP_FMAC(Tt[5], x1, sa0, 13); DPP_FMAC(Tt[6], x1, sa0, 14); DPP_FMAC(Tt[7], x1, sa0, 15);
                float ya, yb;
                DPP_MUL(ya, x2, Tt[0], 0); DPP_MUL(yb, x2, Tt[1], 1);
                DPP_FMAC(ya, x2, Tt[2], 2); DPP_FMAC(yb, x2, Tt[3], 3); DPP_FMAC(ya, x2, Tt[4], 4); DPP_FMAC(yb, x2, Tt[5], 5); DPP_FMAC(ya, x2, Tt[6], 6); DPP_FMAC(yb, x2, Tt[7], 7);
                YP[(t & 15) * 512 + wave * 64 + lane] = ya + yb;
#define M_T1(j) DPP_MUL(S[j], m0, Tt[j], j);
                R8(M_T1)
                DPP_FMAC(S[0], m0, vb, 8); DPP_FMAC(S[1], m0, vb, 9); DPP_FMAC(S[2], m0, vb, 10); DPP_FMAC(S[3], m0, vb, 11);
                DPP_FMAC(S[4], m0, vb, 12); DPP_FMAC(S[5], m0, vb, 13); DPP_FMAC(S[6], m0, vb, 14); DPP_FMAC(S[7], m0, vb, 15);
                DPP_FMAC(S[0], m1, sa1, 8); DPP_FMAC(S[1], m1, sa1, 9); DPP_FMAC(S[2], m1, sa1, 10); DPP_FMAC(S[3], m1, sa1, 11);
                DPP_FMAC(S[4], m1, sa1, 12); DPP_FMAC(S[5], m1, sa1, 13); DPP_FMAC(S[6], m1, sa1, 14); DPP_FMAC(S[7], m1, sa1, 15);
                float yc, yd;
                DPP_MUL(yc, m2, S[0], 0); DPP_MUL(yd, m2, S[1], 1);
                DPP_FMAC(yc, m2, S[2], 2); DPP_FMAC(yd, m2, S[3], 3); DPP_FMAC(yc, m2, S[4], 4); DPP_FMAC(yd, m2, S[5], 5); DPP_FMAC(yc, m2, S[6], 6); DPP_FMAC(yd, m2, S[7], 7);
                YP[((t + 1) & 15) * 512 + wave * 64 + lane] = yc + yd;
                if (((t + 1) & 7) == 7) {
                    asm volatile("s_waitcnt lgkmcnt(0)\n\ts_barrier" ::: "memory");
                    const int sl = (t - 6) + wave;
                    const float* yp = YP + (sl & 15) * 512 + lane;
                    const float y0 = ((yp[0] + yp[64]) + (yp[128] + yp[192])) + ((yp[256] + yp[320]) + (yp[384] + yp[448]));
                    const int tt = dir ? S_ - 1 - (step0 + sl) : step0 + sl;
                    WKV[((size_t)(b * S_ + tt)) * 512 + hc0 + lane] = (bf16)f2bf(y0);
                }
            };
            float ax0 = vecb[0], ax1 = vecb[16], ax2 = vecb[o2], am0 = vecb[320], am1 = vecb[336], am2 = vecb[320 + o2], ava = VS[lane], avb = VS[64 + lane];
            float bx0, bx1, bx2, bm0, bm1, bm2, bva, bvb;
#pragma unroll 1
            for (int t = 0; t < 64; t += 4) {
                { const float* np_ = vecb + (t + 2) * 320; const float* nq_ = vecb + (t + 3) * 320;
                  bx0 = np_[0]; bx1 = np_[16]; bx2 = np_[o2]; bm0 = nq_[0]; bm1 = nq_[16]; bm2 = nq_[o2]; bva = VS[(t + 2) * 64 + lane]; bvb = VS[(t + 3) * 64 + lane]; }
                pair_steps(t, ax0, ax1, ax2, am0, am1, am2, ava, avb);
                { const float* np_ = vecb + ((t + 4) & 63) * 320; const float* nq_ = vecb + ((t + 5) & 63) * 320;
                  ax0 = np_[0]; ax1 = np_[16]; ax2 = np_[o2]; am0 = nq_[0]; am1 = nq_[16]; am2 = nq_[o2]; ava = VS[((t + 4) & 63) * 64 + lane]; avb = VS[((t + 5) & 63) * 64 + lane]; }
                pair_steps(t + 2, bx0, bx1, bx2, bm0, bm1, bm2, bva, bvb);
            }
#undef R7
#undef M_T0
#undef M_T1
#undef R8
#undef DPP_FMAC
#undef DPP_MUL
            __syncthreads();
        }
    }
}

__device__ __forceinline__ void finalize_fast(const Params& P, int l, unsigned char* ldsg) {
    STAGE_IDS
    unsigned char* ws = P.ws;
    const bf16* PR = (const bf16*)(ws + WS_PR); const bf16* WF = (const bf16*)(ws + WS_WKVF); const bf16* WBk = (const bf16*)(ws + WS_WKVB); const float* BONUS = (const float*)(ws + WS_BONUS);
    bf16* YA = (bf16*)(ws + WS_YA);
    const int fr = lane & 15, fq = lane >> 4;
    const float* mu = P.in[I_MU] + (size_t)l * 1920; const float* g2 = P.in[I_G2] + (size_t)l * 128 * 512;
    const float* lngp = P.in[I_LNG] + l * 512; const float* lnbp = P.in[I_LNB] + l * 512;
    bf16x8_t gf[4][4];
#pragma unroll
    for (int n = 0; n < 4; ++n)
#pragma unroll
        for (int ks = 0; ks < 4; ++ks) { float gv[8];
#pragma unroll
            for (int e = 0; e < 8; ++e) gv[e] = g2[(size_t)(32 * ks + 8 * fq + e) * 512 + 64 * wave + 16 * n + fr];
            const v4u w = (v4u){cvtpk(gv[0], gv[1]), cvtpk(gv[2], gv[3]), cvtpk(gv[4], gv[5]), cvtpk(gv[6], gv[7])};
            gf[n][ks] = __builtin_bit_cast(bf16x8_t, w); }
    for (int tile = blockIdx.x; tile < T_ / 32; tile += gridDim.x) {
        const int t0 = tile * 32;
        __syncthreads();
        { const int tok = tid >> 4, mg = tid & 15, t = t0 + tok, s = t & 2047; float x[8];
          shifted8(PR + (size_t)t * 2048, 1792 + 8 * mg, s > 0, s < S_ - 1, mu, x);
#pragma unroll
          for (int e = 0; e < 8; ++e) x[e] = __builtin_amdgcn_rcpf(1.0f + __builtin_amdgcn_exp2f(-x[e] * LOG2E));
          *(v4u*)(ldsg + tok * 272 + mg * 16) = (v4u){cvtpk(x[0], x[1]), cvtpk(x[2], x[3]), cvtpk(x[4], x[5]), cvtpk(x[6], x[7])}; }
        __syncthreads();
#pragma unroll
        for (int mt = 0; mt < 2; ++mt) {
            f32x4m acc[4];
#pragma unroll
            for (int n = 0; n < 4; ++n) acc[n] = (f32x4m){0.f, 0.f, 0.f, 0.f};
#pragma unroll
            for (int ks = 0; ks < 4; ++ks) { const bf16x8_t bb = *(const bf16x8_t*)(ldsg + (16 * mt + fr) * 272 + (32 * ks + 8 * fq) * 2);
#pragma unroll
                for (int n = 0; n < 4; ++n) acc[n] = __builtin_amdgcn_mfma_f32_16x16x32_bf16(gf[n][ks], bb, acc[n], 0, 0, 0); }
            const int t = t0 + 16 * mt + fr, s = t & 2047, bb_ = t >> 11;
            float wk[4][4]; float sm = 0.f;
#pragma unroll
            for (int n = 0; n < 4; ++n) { const int c0 = 64 * wave + 16 * n + 4 * fq;
                const v2u a = *(const v2u*)(WF + (size_t)t * 512 + c0), b2 = *(const v2u*)(WBk + (size_t)t * 512 + c0);
                wk[n][0] = __uint_as_float(a.x << 16) + __uint_as_float(b2.x << 16); wk[n][1] = __uint_as_float(a.x & 0xffff0000u) + __uint_as_float(b2.x & 0xffff0000u);
                wk[n][2] = __uint_as_float(a.y << 16) + __uint_as_float(b2.y << 16); wk[n][3] = __uint_as_float(a.y & 0xffff0000u) + __uint_as_float(b2.y & 0xffff0000u);
                sm += (wk[n][0] + wk[n][1]) + (wk[n][2] + wk[n][3]); }
            sm += __shfl_xor(sm, 16); sm += __shfl_xor(sm, 32);
            const float mean = sm * (1.0f / 64.0f); float sq = 0.f;
#pragma unroll
            for (int n = 0; n < 4; ++n)
#pragma unroll
                for (int v = 0; v < 4; ++v) { wk[n][v] -= mean; sq += wk[n][v] * wk[n][v]; }
            sq += __shfl_xor(sq, 16); sq += __shfl_xor(sq, 32);
            const float rstd = 1.0f / sqrtf(sq * (1.0f / 64.0f) + 64e-5f);
            const float bon = BONUS[((size_t)(bb_ * 8 + wave)) * S_ + s] + BONUS[((size_t)((NB + bb_) * 8 + wave)) * S_ + s];
            const bf16* pc = PR + (size_t)t * 2048;
#pragma unroll
            for (int n = 0; n < 4; ++n) { const int c0 = 64 * wave + 16 * n + 4 * fq;
                const f4 lg = *(const f4*)(lngp + c0), lb = *(const f4*)(lnbp + c0), mv = *(const f4*)(mu + 1024 + c0);
                const v2u vc = *(const v2u*)(pc + 1024 + c0);
                v2u vp = (v2u){0u, 0u}, vn = (v2u){0u, 0u};
                if (s > 0) vp = *(const v2u*)(pc + 1024 + c0 - 2048);
                if (s < S_ - 1) vn = *(const v2u*)(pc + 1024 + c0 + 2048);
                const float cc[4] = {__uint_as_float(vc.x << 16), __uint_as_float(vc.x & 0xffff0000u), __uint_as_float(vc.y << 16), __uint_as_float(vc.y & 0xffff0000u)};
                const float pp[4] = {__uint_as_float(vp.x << 16), __uint_as_float(vp.x & 0xffff0000u), __uint_as_float(vp.y << 16), __uint_as_float(vp.y & 0xffff0000u)};
                const float nn[4] = {__uint_as_float(vn.x << 16), __uint_as_float(vn.x & 0xffff0000u), __uint_as_float(vn.y << 16), __uint_as_float(vn.y & 0xffff0000u)};
                float yv[4];
#pragma unroll
                for (int v = 0; v < 4; ++v) { const float vs = cc[v] + mv[v] * (0.5f * (pp[v] + nn[v]) - cc[v]);
                    yv[v] = (wk[n][v] * rstd * lg[v] + lb[v] + bon * vs) * acc[n][v]; }
                *(v2u*)(YA + (size_t)t * 512 + c0) = (v2u){cvtpk(yv[0], yv[1]), cvtpk(yv[2], yv[3])}; }
        }
    }
}

#define GRID_SYNC_CG() do { asm volatile("s_waitcnt vmcnt(0) lgkmcnt(0)" ::: "memory"); grid.sync(); __builtin_amdgcn_fence(__ATOMIC_ACQUIRE, "agent"); asm volatile("s_waitcnt vmcnt(0)" ::: "memory"); } while (0)
#define GRID_SYNC() grid_barrier(gbar, ground)
#define GEMM_PHASE(EPI, A_, Bt_, M_, N_, K_, E_) do { pg8::Gemm g_{(const pg8::bf16_t*)(A_), (const pg8::bf16_t*)(Bt_), (M_), (N_), (K_)}; pg8::StaticOrder S_o; S_o.init((M_), (N_), (int)gridDim.x, (int)blockIdx.x); \
    pg8::gemm_phase<EPI, pg8::StaticOrder, true, true>((PG8_LAS unsigned char*)lds, g_, S_o, (E_)); } while (0)

__device__ __forceinline__ void grid_barrier(unsigned* bar, unsigned& round) {
    asm volatile("s_waitcnt vmcnt(0) lgkmcnt(0)" ::: "memory");
    __syncthreads();
    ++round;
    if (threadIdx.x == 0) {
        __builtin_amdgcn_fence(__ATOMIC_RELEASE, "agent");
        asm volatile("s_waitcnt vmcnt(0)" ::: "memory");
        const unsigned g = blockIdx.x & 7u, G = gridDim.x, ng = (G + 7u - g) >> 3, ngroups = G < 8u ? G : 8u;
        const unsigned old = __hip_atomic_fetch_add(bar + 64 * (1 + g), 1u, __ATOMIC_RELAXED, __HIP_MEMORY_SCOPE_AGENT);
        if (old + 1u == round * ng) {
            const unsigned old2 = __hip_atomic_fetch_add(bar + 64 * 9, 1u, __ATOMIC_RELAXED, __HIP_MEMORY_SCOPE_AGENT);
            if (old2 + 1u == round * ngroups) __hip_atomic_store(bar, round, __ATOMIC_RELAXED, __HIP_MEMORY_SCOPE_AGENT);
        }
        unsigned spins = 0;
        while (__hip_atomic_load(bar, __ATOMIC_RELAXED, __HIP_MEMORY_SCOPE_AGENT) < round) { __builtin_amdgcn_s_sleep(1); if (++spins > (1u << 24)) break; }
        __builtin_amdgcn_fence(__ATOMIC_ACQUIRE, "agent");
        asm volatile("s_waitcnt vmcnt(0)" ::: "memory");
    }
    __syncthreads();
}
__global__ void __launch_bounds__(NTHREADS, 2) fwd_kernel(Params P) {
    extern __shared__ __attribute__((aligned(16))) unsigned char lds[];
    cg::grid_group grid = cg::this_grid();
    unsigned char* ws = P.ws;
    bf16* H = (bf16*)(ws + WS_H); bf16* ACT = (bf16*)(ws + WS_ACT);
    float* SSB = (float*)(ws + WS_SS);
    unsigned* gbar = (unsigned*)(ws + WS_BAR); unsigned ground = 0;
    cvt_up1(P, 0, lds);
    x_to_bf16_ss(P.in[I_X], H, SSB);
    if (P.ws == nullptr) GRID_SYNC_CG();
    GRID_SYNC();
#pragma unroll 1
    for (int l = 0; l < NL; ++l) {
        const float* xin = (l == 0) ? P.in[I_X] : P.out;
        cvt_rest(P, l, lds);
        __syncthreads();
        { pg8::EpiSwiglu E{(pg8::bf16_t*)ACT, FF, SSB}; GEMM_PHASE(pg8::EpiSwiglu, H, ws + ((l & 1) ? WS_WUP1B : WS_WUP1), T_, 2 * FF, DM, E); }
        GRID_SYNC();
        { pg8::EpiResid E{xin, P.out, DM, 0.5f, (pg8::bf16_t*)H, SSB}; GEMM_PHASE(pg8::EpiResid, ACT, ws + WS_WDN1, T_, DM, FF, E); }
        GRID_SYNC();
        { pg8::EpiWin E{(pg8::bf16_t*)(ws + WS_PR), (pg8::bf16_t*)(ws + WS_QB), (pg8::bf16_t*)(ws + WS_KVB), (pg8::bf16_t*)(ws + WS_QC), (pg8::bf16_t*)(ws + WS_KVC), SSB};
          GEMM_PHASE(pg8::EpiWin, H, ws + WS_WIN, T_, 3584, DM, E); }
        GRID_SYNC();
        qkprep(P, l);
        vt_prep(P, lds);
        __syncthreads();
        scan_fast(P, l, lds);
        GRID_SYNC();
        attn_mfma<false>((bf16*)(ws + WS_QB), (const bf16*)(ws + WS_KG), (const bf16*)(ws + WS_VG), nullptr, lds);
        attn_mfma<true>((bf16*)(ws + WS_QC), (const bf16*)(ws + WS_KW), (const bf16*)(ws + WS_VW), P.in[I_SINK] + l * 8, lds);
        __syncthreads();
        finalize_fast(P, l, lds);
        GRID_SYNC();
#pragma unroll 1
        for (int i = 0; i < 3; ++i) {
            { pg8::EpiGate E{(pg8::bf16_t*)(ws + WS_GATE), SSB}; GEMM_PHASE(pg8::EpiGate, H, ws + WS_WG + (size_t)i * DM * DM * 2, T_, DM, DM, E); }
            const unsigned char* yi = ws + (i == 0 ? WS_YA : (i == 1 ? WS_QB : WS_QC));
            { pg8::EpiMerge E{(const pg8::bf16_t*)(ws + WS_GATE), (pg8::bf16_t*)(ws + WS_MERGED), i == 0 ? 1 : 0}; GEMM_PHASE(pg8::EpiMerge, yi, ws + WS_WO + (size_t)i * DM * 512 * 2, T_, DM, 512, E); }
        }
        GRID_SYNC();
        { pg8::EpiResid E{P.out, P.out, DM, 1.0f, (pg8::bf16_t*)H, SSB}; GEMM_PHASE(pg8::EpiResid, ws + WS_MERGED, ws + WS_WOUT, T_, DM, DM, E); }
        GRID_SYNC();
        { pg8::EpiSwiglu E{(pg8::bf16_t*)ACT, FF, SSB}; GEMM_PHASE(pg8::EpiSwiglu, H, ws + WS_WUP2, T_, 2 * FF, DM, E); }
        GRID_SYNC();
        if (l + 1 < NL) { cvt_up1(P, l + 1, lds); __syncthreads(); }
        { pg8::EpiResid E{P.out, P.out, DM, 0.5f, (pg8::bf16_t*)H, SSB}; GEMM_PHASE(pg8::EpiResid, ACT, ws + WS_WDN2, T_, DM, FF, E); }
        GRID_SYNC();
    }
    rms_rows_f32_inplace(P.out, P.in[I_FINN]);
}

extern "C" void kernel_launch(void* const* d_in, const int* in_sizes, int n_in, void* d_out, int out_size, void* d_ws, size_t ws_size, hipStream_t stream) {
    static int grid_blocks = 0;
    if (grid_blocks == 0) {
        if (n_in != N_IN || out_size != T_ * DM || ws_size < WS_END) { fprintf(stderr, "kernel_launch: unexpected shapes (n_in %d, out %d, ws %zu < %zu)\n", n_in, out_size, ws_size, (size_t)WS_END); grid_blocks = -1; return; }
        int dev = 0, cus = 0, per_cu = 0;
        hipGetDevice(&dev);
        hipDeviceGetAttribute(&cus, hipDeviceAttributeMultiprocessorCount, dev);
        hipFuncSetAttribute((const void*)fwd_kernel, hipFuncAttributeMaxDynamicSharedMemorySize, LDS_BYTES);
        hipOccupancyMaxActiveBlocksPerMultiprocessor(&per_cu, (const void*)fwd_kernel, NTHREADS, LDS_BYTES);
        if (per_cu < 1) per_cu = 1;
        grid_blocks = cus * per_cu;
    }
    if (grid_blocks < 0) return;
    Params p{};
    for (int i = 0; i < N_IN; ++i) p.in[i] = (const float*)d_in[i];
    p.out = (float*)d_out; p.ws = (unsigned char*)d_ws;
    if (hipMemsetAsync((char*)d_ws + WS_BAR, 0, 4096, stream) != hipSuccess) { fprintf(stderr, "kernel_launch: hipMemsetAsync failed\n"); return; }
    void* args[] = {&p};
    hipError_t e = hipLaunchCooperativeKernel((const void*)fwd_kernel, dim3(grid_blocks), dim3(NTHREADS), args, LDS_BYTES, stream);
    if (e != hipSuccess) fprintf(stderr, "cooperative launch failed: %s (grid %d)\n", hipGetErrorString(e), grid_blocks);
}
```

```cpp
#include <hip/hip_runtime.h>
#include <hip/hip_cooperative_groups.h>
#include <cstdio>
#include <cstdint>
namespace cg = cooperative_groups;
namespace pg8 {
#define PG8_LAS __attribute__((address_space(3)))
typedef unsigned short bf16_t;
typedef short bf16x8 __attribute__((ext_vector_type(8)));
typedef float f32x4 __attribute__((ext_vector_type(4)));
typedef unsigned u32x4 __attribute__((ext_vector_type(4)));
constexpr int BM = 256, BK = 64, HALF = 128, HTB = HALF * BK * 2  , STAGE_BYTES = 8 * HTB, NXCD = 8, WGM = 8;

__host__ __device__ __forceinline__ int lds_byte(int r, int c) { const int st = (r >> 4) * 2 + (c >> 5), rr = r & 15, cc = c & 31, ob = rr * 64 + cc * 2; return st * 1024 + (ob ^ (((ob >> 9) & 1) << 5)); }
__host__ __device__ __forceinline__ void stage_rc(int b, int& R, int& C) { const int st = b / 1024, sb = b % 1024, swz = sb ^ (((sb >> 9) & 1) << 5); R = (st >> 1) * 16 + swz / 64; C = (st & 1) * 32 + (swz % 64) / 2; }
__host__ __device__ __forceinline__ int perm32(int rho) { const int n = rho >> 4, i = rho & 15; return 8 * (i >> 2) + 4 * n + (i & 3); }

struct Unit { int pm, pn; };
struct Gemm { const bf16_t* A; const bf16_t* Bt; int M, N, K; };

struct StaticOrder {
    int nM, nN, nwg, G, c;
    __host__ __device__ void init(int M, int N, int G_, int c_) { nM = M / BM; nN = N / BM; nwg = nM * nN; G = G_; c = c_; }
    __host__ __device__ bool next(int i, Unit& u) const {
        const long L = (long)i * G + c; if (L >= nwg) return false;
        int wgid = (int)L; { const int q = nwg / NXCD, r = nwg % NXCD, xcd = wgid % NXCD, off = wgid / NXCD; wgid = (xcd < r ? xcd * (q + 1) : r * (q + 1) + (xcd - r) * q) + off; }
        const int nig = WGM * nN, gid = wgid / nig, fm = gid * WGM, gsz = (nM - fm) < WGM ? (nM - fm) : WGM;
        u.pm = fm + ((wgid % nig) % gsz); u.pn = (wgid % nig) / gsz; return true;
    }
    __device__ __forceinline__ void a_ready(const Unit&) const {}
    __device__ __forceinline__ void done(const Unit&) const {}
};
typedef float f32x2_t __attribute__((ext_vector_type(2))); typedef __bf16 bf16x2_t __attribute__((ext_vector_type(2)));
__device__ __forceinline__ unsigned cvt_pk_bf16(float lo, float hi) { f32x2_t v = {lo, hi}; bf16x2_t b = __builtin_convertvector(v, bf16x2_t); return __builtin_bit_cast(unsigned, b); }
typedef float f32x2 __attribute__((ext_vector_type(2)));
__device__ __forceinline__ float fast_sigmoid(float x) { return __builtin_amdgcn_rcpf(1.0f + __builtin_amdgcn_exp2f(-1.4426950408889634f * x)); }
__device__ __forceinline__ float bf_lo(unsigned w) { return __uint_as_float(w << 16); }
__device__ __forceinline__ float bf_hi(unsigned w) { return __uint_as_float(w & 0xffff0000u); }

__device__ __forceinline__ float row_rs(const float* SS, int row) { const f32x4 a = *(const f32x4*)(SS + (size_t)row * 16), b2 = *(const f32x4*)(SS + (size_t)row * 16 + 4), c2 = *(const f32x4*)(SS + (size_t)row * 16 + 8), d = *(const f32x4*)(SS + (size_t)row * 16 + 12);
    const float s = ((a[0] + a[1]) + (a[2] + a[3])) + ((b2[0] + b2[1]) + (b2[2] + b2[3])) + ((c2[0] + c2[1]) + (c2[2] + c2[3])) + ((d[0] + d[1]) + (d[2] + d[3]));
    return 1.0f / sqrtf(s * (1.0f / 1024.0f) + 1e-6f); }
struct EpiSwiglu {
    static constexpr bool PERM = true, AFTER_DRAIN = false;
    bf16_t* O; int ldc; const float* SS;
    __device__ __forceinline__ void operator()(const f32x4 (&acc)[2][2][4][2], const Unit& u, int wr, int wc, int fr, int fq) const {
        const int row0 = u.pm * BM + wr * 64 + fr, col0 = u.pn * HALF + wc * 32 + 8 * fq;
#pragma unroll
        for (int ai = 0; ai < 2; ++ai)
#pragma unroll
            for (int m = 0; m < 4; ++m) {
                bf16_t* rowp = O + (size_t)(row0 + ai * HALF + m * 16) * ldc + col0;
                const float rs = row_rs(SS, row0 + ai * HALF + m * 16);
                float v[8];
#pragma unroll
                for (int n = 0; n < 2; ++n)
#pragma unroll
                    for (int j = 0; j < 4; ++j) { const float g = acc[ai][0][m][n][j] * rs, up = acc[ai][1][m][n][j] * rs; v[n * 4 + j] = g * fast_sigmoid(g) * up; }
                u32x4 w; w.x = cvt_pk_bf16(v[0], v[1]); w.y = cvt_pk_bf16(v[2], v[3]); w.z = cvt_pk_bf16(v[4], v[5]); w.w = cvt_pk_bf16(v[6], v[7]);
                *(u32x4*)rowp = w;
            }
    }
};
struct EpiResid {
    static constexpr bool PERM = false, AFTER_DRAIN = false;
    const float* src; float* dst; int ldc; float scale; bf16_t* XB; float* SS;
    __device__ __forceinline__ void operator()(const f32x4 (&acc)[2][2][4][2], const Unit& u, int wr, int wc, int fr, int fq) const {
        const int col0 = u.pn * BM + wc * 32 + 4 * fq;
#pragma unroll
        for (int ai = 0; ai < 2; ++ai)
#pragma unroll
            for (int m = 0; m < 4; ++m) {
                const int row = u.pm * BM + ai * HALF + wr * 64 + m * 16 + fr;
                const size_t off = (size_t)row * ldc + col0; float sq = 0.f;
#pragma unroll
                for (int bj = 0; bj < 2; ++bj)
#pragma unroll
                    for (int n = 0; n < 2; ++n) { const f32x4 b = *(const f32x4*)(src + off + bj * HALF + n * 16); const f32x4 x = b + acc[ai][bj][m][n] * scale;
                        *(f32x4*)(dst + off + bj * HALF + n * 16) = x; sq += (x[0] * x[0] + x[1] * x[1]) + (x[2] * x[2] + x[3] * x[3]);
                        typedef unsigned u32x2 __attribute__((ext_vector_type(2)));
                        *(u32x2*)(XB + off + bj * HALF + n * 16) = (u32x2){cvt_pk_bf16(x[0], x[1]), cvt_pk_bf16(x[2], x[3])}; }
                sq += __shfl_xor(sq, 16); sq += __shfl_xor(sq, 32);
                if (fq == 0) SS[(size_t)row * 16 + u.pn * 4 + wc] = sq;
            }
    }
};
struct EpiWin {
    static constexpr bool PERM = true, AFTER_DRAIN = false;
    bf16_t *PR, *QB, *KVB, *QC, *KVC; const float* SS;
    __device__ __forceinline__ void operator()(const f32x4 (&acc)[2][2][4][2], const Unit& u, int wr, int wc, int fr, int fq) const {
        bf16_t* base; int ldc, colt;
        const int pn = u.pn;
        if (pn < 8) { base = PR; ldc = 2048; colt = pn * 256; }
        else if (pn < 10) { base = QB; ldc = 512; colt = (pn - 8) * 256; }
        else if (pn == 10) { base = KVB; ldc = 256; colt = 0; }
        else if (pn < 13) { base = QC; ldc = 512; colt = (pn - 11) * 256; }
        else { base = KVC; ldc = 256; colt = 0; }
        const int row0 = u.pm * BM + wr * 64 + fr, col0 = colt + wc * 32 + 8 * fq;
#pragma unroll
        for (int ai = 0; ai < 2; ++ai)
#pragma unroll
            for (int m = 0; m < 4; ++m) {
                bf16_t* rowp = base + (size_t)(row0 + ai * HALF + m * 16) * ldc + col0;
                const float rs = row_rs(SS, row0 + ai * HALF + m * 16);
#pragma unroll
                for (int bj = 0; bj < 2; ++bj) { const f32x4 v0 = acc[ai][bj][m][0] * rs, v1 = acc[ai][bj][m][1] * rs;
                    u32x4 w; w.x = cvt_pk_bf16(v0[0], v0[1]); w.y = cvt_pk_bf16(v0[2], v0[3]); w.z = cvt_pk_bf16(v1[0], v1[1]); w.w = cvt_pk_bf16(v1[2], v1[3]);
                    *(u32x4*)(rowp + bj * HALF) = w; }
            }
    }
};
struct EpiGate {
    static constexpr bool PERM = true, AFTER_DRAIN = false;
    bf16_t* G; const float* SS;
    __device__ __forceinline__ void operator()(const f32x4 (&acc)[2][2][4][2], const Unit& u, int wr, int wc, int fr, int fq) const {
        const int row0 = u.pm * BM + wr * 64 + fr, col0 = u.pn * BM + wc * 32 + 8 * fq;
#pragma unroll
        for (int ai = 0; ai < 2; ++ai)
#pragma unroll
            for (int m = 0; m < 4; ++m) {
                bf16_t* rowp = G + (size_t)(row0 + ai * HALF + m * 16) * 1024 + col0;
                const float rs = row_rs(SS, row0 + ai * HALF + m * 16);
#pragma unroll
                for (int bj = 0; bj < 2; ++bj) { const f32x4 v0 = acc[ai][bj][m][0] * rs, v1 = acc[ai][bj][m][1] * rs;
                    u32x4 w; w.x = cvt_pk_bf16(fast_sigmoid(v0[0]), fast_sigmoid(v0[1])); w.y = cvt_pk_bf16(fast_sigmoid(v0[2]), fast_sigmoid(v0[3]));
                    w.z = cvt_pk_bf16(fast_sigmoid(v1[0]), fast_sigmoid(v1[1])); w.w = cvt_pk_bf16(fast_sigmoid(v1[2]), fast_sigmoid(v1[3]));
                    *(u32x4*)(rowp + bj * HALF) = w; }
            }
    }
};
struct EpiMerge {
    static constexpr bool PERM = true, AFTER_DRAIN = false;
    const bf16_t* G; bf16_t* Mg; int first;
    __device__ __forceinline__ void operator()(const f32x4 (&acc)[2][2][4][2], const Unit& u, int wr, int wc, int fr, int fq) const {
        const int row0 = u.pm * BM + wr * 64 + fr, col0 = u.pn * BM + wc * 32 + 8 * fq;
#pragma unroll
        for (int ai = 0; ai < 2; ++ai)
#pragma unroll
            for (int m = 0; m < 4; ++m) {
                const size_t off = (size_t)(row0 + ai * HALF + m * 16) * 1024 + col0;
#pragma unroll
                for (int bj = 0; bj < 2; ++bj) { const f32x4 v0 = acc[ai][bj][m][0], v1 = acc[ai][bj][m][1];
                    const u32x4 g = __builtin_nontemporal_load((const u32x4*)(G + off + bj * HALF));
                    float r[8];
                    r[0] = bf_lo(g.x) * v0[0]; r[1] = bf_hi(g.x) * v0[1]; r[2] = bf_lo(g.y) * v0[2]; r[3] = bf_hi(g.y) * v0[3];
                    r[4] = bf_lo(g.z) * v1[0]; r[5] = bf_hi(g.z) * v1[1]; r[6] = bf_lo(g.w) * v1[2]; r[7] = bf_hi(g.w) * v1[3];
                    if (!first) { const u32x4 p = __builtin_nontemporal_load((const u32x4*)(Mg + off + bj * HALF));
                        r[0] += bf_lo(p.x); r[1] += bf_hi(p.x); r[2] += bf_lo(p.y); r[3] += bf_hi(p.y); r[4] += bf_lo(p.z); r[5] += bf_hi(p.z); r[6] += bf_lo(p.w); r[7] += bf_hi(p.w); }
                    u32x4 w; w.x = cvt_pk_bf16(r[0], r[1]); w.y = cvt_pk_bf16(r[2], r[3]); w.z = cvt_pk_bf16(r[4], r[5]); w.w = cvt_pk_bf16(r[6], r[7]);
                    *(u32x4*)(Mg + off + bj * HALF) = w; }
            }
    }
};
template <class Epi, class Sched, bool ALIGN_EPI = false, bool SP2 = false>
__device__ __forceinline__ void gemm_phase(PG8_LAS unsigned char* lds, const Gemm g, const Sched& S, const Epi& E) {
    int tid_o = threadIdx.x; asm volatile("" : "+v"(tid_o));
    const int tid = tid_o, wid = __builtin_amdgcn_readfirstlane(tid >> 6), lane = tid & 63, wr = wid >> 2, wc = wid & 3, fr = lane & 15, fq = lane >> 4;
    const int K = g.K, nt = K / BK;
    unsigned voffA[2], voffB[2];
#pragma unroll
    for (int i = 0; i < 2; ++i) { int R, C; stage_rc(tid * 16 + i * 8192, R, C); const int Rb = Epi::PERM ? ((R & ~31) + perm32(R & 31)) : R;
        voffA[i] = (unsigned)(R * K + C) * 2u; voffB[i] = (unsigned)(Rb * K + C) * 2u; }
    const size_t kstep = (size_t)(BK * 2);
    const size_t hstep = (size_t)HALF * K * 2;
    const size_t tstep = 2 * hstep;
    const unsigned ldsw = (unsigned)wid * 1024u;
    const int aoff = lds_byte(wr * 64 + fr, fq * 8), boff = lds_byte(wc * 32 + fr, fq * 8);
#define PG8_SA(b, h) (((b) * 2 + (h)) * HTB)
#define PG8_SB(b, h) ((4 + (b) * 2 + (h)) * HTB)
#define PG8_STAGE(bufoff, gbase, voff) do { _Pragma("unroll") for (int _i = 0; _i < 2; ++_i) \
        __builtin_amdgcn_global_load_lds((const unsigned*)((const char*)(gbase) + (voff)[_i]), (PG8_LAS unsigned*)(lds + (bufoff) + ldsw + _i * 8192), 16, 0, 0); } while (0)
#define PG8_LDA(dst, b, h) do { _Pragma("unroll") for (int m = 0; m < 4; ++m) _Pragma("unroll") for (int k = 0; k < 2; ++k) dst[m][k] = *(const PG8_LAS bf16x8*)(lds + PG8_SA(b, h) + aoff + m * 2048 + k * 1024); } while (0)
#define PG8_LDB(dst, b, h) do { _Pragma("unroll") for (int n = 0; n < 2; ++n) _Pragma("unroll") for (int k = 0; k < 2; ++k) dst[n][k] = *(const PG8_LAS bf16x8*)(lds + PG8_SB(b, h) + boff + n * 2048 + k * 1024); } while (0)
#define PG8_MMA(ai, bj, At, Bt) do { __builtin_amdgcn_s_setprio(1); _Pragma("unroll") for (int m = 0; m < 4; ++m) _Pragma("unroll") for (int n = 0; n < 2; ++n) _Pragma("unroll") for (int k = 0; k < 2; ++k) \
        acc[ai][bj][m][n] = __builtin_amdgcn_mfma_f32_16x16x32_bf16(Bt[n][k], At[m][k], acc[ai][bj][m][n], 0, 0, 0); __builtin_amdgcn_s_setprio(0); } while (0)
#define PG8_WAIT_V(n) asm volatile("s_waitcnt vmcnt(" #n ")" ::: "memory")
#define PG8_WAIT_L(n) asm volatile("s_waitcnt lgkmcnt(" #n ")" ::: "memory")
#define PG8_BAR __builtin_amdgcn_s_barrier()
#define PG8_SCHED __builtin_amdgcn_sched_barrier(0)
    Unit cur, nxt; int ui = 0;
    if (!S.next(0, cur)) return;
    f32x4 acc[2][2][4][2];
#pragma unroll
    for (int a = 0; a < 2; ++a)
#pragma unroll
        for (int b = 0; b < 2; ++b)
#pragma unroll
            for (int m = 0; m < 4; ++m)
#pragma unroll
                for (int n = 0; n < 2; ++n) acc[a][b][m][n] = (f32x4){0.f, 0.f, 0.f, 0.f};
    bf16x8 At[4][2], B0[2][2], B1[2][2];
    const char* cA = (const char*)g.A + (size_t)cur.pm * tstep; const char* cB = (const char*)g.Bt + (size_t)cur.pn * tstep;
    S.a_ready(cur);
    if constexpr (SP2) {
        PG8_STAGE(PG8_SB(0, 0), cB, voffB); PG8_STAGE(PG8_SB(0, 1), cB + hstep, voffB); PG8_STAGE(PG8_SA(0, 0), cA, voffA); PG8_STAGE(PG8_SA(0, 1), cA + hstep, voffA);
        if (wr == 1) PG8_BAR;
        PG8_WAIT_V(2); PG8_BAR;
        PG8_STAGE(PG8_SB(1, 0), cB + kstep, voffB); PG8_STAGE(PG8_SA(1, 0), cA + kstep, voffA); PG8_STAGE(PG8_SB(1, 1), cB + hstep + kstep, voffB);
        PG8_WAIT_V(6); PG8_BAR;
    } else {
        PG8_STAGE(PG8_SB(0, 0), cB, voffB); PG8_STAGE(PG8_SA(0, 0), cA, voffA); PG8_STAGE(PG8_SB(0, 1), cB + hstep, voffB); PG8_STAGE(PG8_SA(0, 1), cA + hstep, voffA);
        if (wr == 1) PG8_BAR;
        PG8_WAIT_V(4); PG8_BAR;
        PG8_STAGE(PG8_SB(1, 0), cB + kstep, voffB); PG8_STAGE(PG8_SA(1, 0), cA + kstep, voffA); PG8_STAGE(PG8_SB(1, 1), cB + hstep + kstep, voffB);
        PG8_WAIT_V(6); PG8_BAR;
    }
    for (;;) {
        const bool has_next = S.next(ui + 1, nxt);
        const char* nA = has_next ? (const char*)g.A + (size_t)nxt.pm * tstep : cA; const char* nB = has_next ? (const char*)g.Bt + (size_t)nxt.pn * tstep : cB;
        for (int t = 0; t < nt; t += 2) {
            const bool last = (t == nt - 2);
            const char* a1 = cA + (size_t)(t + 1) * kstep;
            const char* a2 = last ? nA : cA + (size_t)(t + 2) * kstep; const char* b2 = last ? nB : cB + (size_t)(t + 2) * kstep;
            const char* a3 = a2 + kstep; const char* b3 = b2 + kstep;
            if (last && has_next) S.a_ready(nxt);
            if constexpr (SP2) {
            PG8_LDB(B0, 0, 0); PG8_LDB(B1, 0, 1); PG8_SCHED; PG8_LDA(At, 0, 0); PG8_STAGE(PG8_SA(1, 1), a1 + hstep, voffA);
            PG8_WAIT_V(8); PG8_WAIT_L(0); PG8_BAR; PG8_MMA(0, 0, At, B0); PG8_MMA(0, 1, At, B1); PG8_BAR; PG8_SCHED;
            PG8_LDA(At, 0, 1); PG8_STAGE(PG8_SB(0, 0), b2, voffB); PG8_STAGE(PG8_SB(0, 1), b2 + hstep, voffB); PG8_STAGE(PG8_SA(0, 0), a2, voffA);
            PG8_WAIT_V(8); PG8_WAIT_L(0); PG8_BAR; PG8_MMA(1, 0, At, B0); PG8_MMA(1, 1, At, B1); PG8_BAR; PG8_SCHED;
            PG8_LDB(B0, 1, 0); PG8_LDB(B1, 1, 1); PG8_SCHED; PG8_LDA(At, 1, 0); PG8_STAGE(PG8_SA(0, 1), a2 + hstep, voffA);
            PG8_WAIT_V(8); PG8_WAIT_L(0); PG8_BAR; PG8_MMA(0, 0, At, B0); PG8_MMA(0, 1, At, B1); PG8_BAR; PG8_SCHED;
            PG8_LDA(At, 1, 1); PG8_STAGE(PG8_SB(1, 0), b3, voffB); PG8_STAGE(PG8_SB(1, 1), b3 + hstep, voffB); PG8_STAGE(PG8_SA(1, 0), a3, voffA);
            PG8_WAIT_V(8); PG8_WAIT_L(0); PG8_BAR; PG8_MMA(1, 0, At, B0); PG8_MMA(1, 1, At, B1); PG8_BAR; PG8_SCHED;
            } else {
            PG8_LDB(B0, 0, 0); PG8_SCHED; PG8_LDA(At, 0, 0); PG8_STAGE(PG8_SA(1, 1), a1 + hstep, voffA);
            PG8_WAIT_L(8); PG8_BAR; PG8_WAIT_L(0); PG8_MMA(0, 0, At, B0); PG8_BAR; PG8_SCHED;
            PG8_LDB(B1, 0, 1); PG8_STAGE(PG8_SB(0, 0), b2, voffB);
            PG8_BAR; PG8_WAIT_L(0); PG8_MMA(0, 1, At, B1); PG8_BAR;
            PG8_LDA(At, 0, 1); PG8_STAGE(PG8_SA(0, 0), a2, voffA);
            PG8_BAR; PG8_WAIT_L(0); PG8_MMA(1, 0, At, B0); PG8_BAR; PG8_SCHED;
            PG8_STAGE(PG8_SB(0, 1), b2 + hstep, voffB);
            PG8_WAIT_V(6); PG8_BAR; PG8_MMA(1, 1, At, B1); PG8_BAR;
            PG8_LDB(B0, 1, 0); PG8_SCHED; PG8_LDA(At, 1, 0); PG8_STAGE(PG8_SA(0, 1), a2 + hstep, voffA);
            PG8_WAIT_L(8); PG8_BAR; PG8_WAIT_L(0); PG8_MMA(0, 0, At, B0); PG8_BAR; PG8_SCHED;
            PG8_LDB(B1, 1, 1); PG8_STAGE(PG8_SB(1, 0), b3, voffB);
            PG8_BAR; PG8_WAIT_L(0); PG8_MMA(0, 1, At, B1); PG8_BAR;
            PG8_LDA(At, 1, 1); PG8_STAGE(PG8_SA(1, 0), a3, voffA);
            PG8_BAR; PG8_WAIT_L(0); PG8_MMA(1, 0, At, B0); PG8_BAR; PG8_SCHED;
            PG8_STAGE(PG8_SB(1, 1), b3 + hstep, voffB);
            PG8_WAIT_V(6); PG8_BAR; PG8_MMA(1, 1, At, B1); PG8_BAR;
            }
        }
        if constexpr (ALIGN_EPI) { if (wr == 0) PG8_BAR; }
        if constexpr (!Epi::AFTER_DRAIN) { E(acc, cur, wr, wc, fr, fq); S.done(cur); }
        if (!has_next) break;
#pragma unroll
        for (int a = 0; a < 2; ++a)
#pragma unroll
            for (int b = 0; b < 2; ++b)
#pragma unroll
                for (int m = 0; m < 4; ++m)
#pragma unroll
                    for (int n = 0; n < 2; ++n) acc[a][b][m][n] = (f32x4){0.f, 0.f, 0.f, 0.f};
        cur = nxt; cA = nA; cB = nB; ++ui;
        if constexpr (ALIGN_EPI) { if (wr == 1) PG8_BAR; }
    }
    PG8_WAIT_V(0);
    if constexpr (!ALIGN_EPI) { if (wr == 0) PG8_BAR; }
    PG8_BAR;
    if constexpr (Epi::AFTER_DRAIN) { E.fused(acc, cur, wr, wc, fr, fq, lds, wid, lane); S.done(cur); }
#undef PG8_SA
#undef PG8_SB
#undef PG8_STAGE
#undef PG8_LDA
#undef PG8_LDB
#undef PG8_MMA
#undef PG8_WAIT_V
#undef PG8_WAIT_L
#undef PG8_BAR
#undef PG8_SCHED
}
}
#define LAS __attribute__((address_space(3)))
typedef unsigned short bf16;
typedef unsigned v4u __attribute__((ext_vector_type(4)));
typedef unsigned v2u __attribute__((ext_vector_type(2)));
typedef float f4 __attribute__((ext_vector_type(4)));
constexpr int T_ = 32768, S_ = 2048, NB = 16, DM = 1024, FF = 2816, NL = 4;
constexpr int NWAVES = 8, NTHREADS = 512;
constexpr int LDS_BYTES = 163840;
constexpr float LOG2E = 1.4426950408889634f;
constexpr float C2 = 0.125f * LOG2E;
constexpr float LOG2_THETA = 13.287712379549449f;

enum { I_X = 0, I_F1N, I_F1UP, I_F1DN, I_MIXN, I_WIN, I_MU, I_W0, I_W2, I_A0, I_A2, I_G2, I_KK, I_KA, I_RK, I_LNG, I_LNB, I_QN, I_KN, I_SINK,
       I_WOA, I_WOB, I_WOC, I_WOUT, I_F2N, I_F2UP, I_F2DN, I_FINN, N_IN };

constexpr size_t SZ_WUP = (size_t)2 * FF * DM * 2, SZ_WDN = (size_t)DM * FF * 2, SZ_WIN = (size_t)3584 * DM * 2, SZ_WG = (size_t)3072 * DM * 2,
                 SZ_WO = (size_t)3 * DM * 512 * 2, SZ_WOUT = (size_t)DM * DM * 2;
constexpr size_t WS_WUP1 = 0, WS_WDN1 = WS_WUP1 + SZ_WUP, WS_WIN = WS_WDN1 + SZ_WDN, WS_WG = WS_WIN + SZ_WIN, WS_WO = WS_WG + SZ_WG, WS_WOUT = WS_WO + SZ_WO,
                 WS_WUP2 = WS_WOUT + SZ_WOUT, WS_WDN2 = WS_WUP2 + SZ_WUP, WS_H = WS_WDN2 + SZ_WDN;
constexpr size_t WS_R = WS_H + (size_t)T_ * DM * 2;
constexpr size_t WS_ACT = WS_R;
constexpr size_t WS_PR = WS_R, WS_QB = WS_PR + (size_t)T_ * 2048 * 2, WS_KVB = WS_QB + (size_t)T_ * 512 * 2, WS_QC = WS_KVB + (size_t)T_ * 256 * 2, WS_KVC = WS_QC + (size_t)T_ * 512 * 2,
                 WS_KG = WS_KVC + (size_t)T_ * 256 * 2, WS_VG = WS_KG + (size_t)NB * 2 * S_ * 64 * 2, WS_KW = WS_VG + (size_t)NB * 2 * S_ * 64 * 2, WS_VW = WS_KW + (size_t)NB * 2 * S_ * 64 * 2,
                 WS_YA = WS_VW + (size_t)NB * 2 * S_ * 64 * 2, WS_WKVF = WS_YA + (size_t)T_ * 512 * 2, WS_WKVB = WS_WKVF + (size_t)T_ * 512 * 2, WS_BONUS = WS_WKVB + (size_t)T_ * 512 * 2,
                 WS_SCR = WS_BONUS + (size_t)T_ * 16 * 4, WS_SS = WS_SCR, WS_WUP1B = WS_SS + (size_t)T_ * 16 * 4, WS_BAR = WS_WUP1B + SZ_WUP, WS_END = WS_BAR + 4096;
constexpr size_t WS_GATE = WS_PR, WS_MERGED = WS_PR + (size_t)T_ * DM * 2;
static_assert(WS_ACT + (size_t)T_ * FF * 2 <= WS_END, "map");
static_assert(WS_END < 536000000ull, "workspace budget");

struct Params { const float* in[N_IN]; float* out; unsigned char* ws; };

__device__ __forceinline__ unsigned f2bf(float f) { unsigned u = __float_as_uint(f); return (u + 0x7fffu + ((u >> 16) & 1u)) >> 16; }
__device__ __forceinline__ unsigned pk2(float lo, float hi) { return f2bf(lo) | (f2bf(hi) << 16); }
__device__ __forceinline__ float bf2f(bf16 h) { return __uint_as_float((unsigned)h << 16); }
__device__ __forceinline__ int opaque_tid() { int t = threadIdx.x; asm volatile("" : "+v"(t)); return t; }
#define STAGE_IDS const int tid = opaque_tid(), lane = tid & 63, wave = __builtin_amdgcn_readfirstlane(tid >> 6); const int gw = blockIdx.x * NWAVES + wave, ngw = gridDim.x * NWAVES, gtid = blockIdx.x * NTHREADS + tid, gthreads = gridDim.x * NTHREADS; (void)lane; (void)gw; (void)ngw; (void)gtid; (void)gthreads;
__device__ __forceinline__ float wave_sum(float v) {
#pragma unroll
    for (int o = 1; o < 64; o <<= 1) v += __shfl_xor(v, o);
    return v;
}

__device__ __forceinline__ void cvt_wt(const float* W, int K, int ld, bf16* Wt, int nrows, int mode, int gw, int ngw, int lane, float* scr, const float* gain = nullptr) {
    const int nblk = nrows >> 5, nitems = (K >> 6) * nblk;
    for (int it = gw; it < nitems; it += ngw) {
        const int kb = it / nblk, nb = it % nblk, k0 = kb * 64, n0 = nb * 32;
        int col0;
        if (mode == 0) col0 = n0;
        else if (mode == 1) { const int t = n0 >> 8, r = n0 & 255; col0 = (r < 128) ? t * 128 + r : FF + t * 128 + (r - 128); }
        else if (mode == 2) col0 = n0 < 1920 ? n0 : (n0 < 2048 ? -1 : n0 - 128);
        else col0 = 3456 + n0;
        if (col0 >= 0) {
#pragma unroll 8
            for (int i = 0; i < 32; ++i) { const int kk = 2 * i + (lane >> 5); scr[kk * 33 + (lane & 31)] = W[(size_t)(k0 + kk) * ld + col0 + (lane & 31)] * (gain ? gain[k0 + kk] : 1.0f); }
        }
        asm volatile("s_waitcnt lgkmcnt(0)" ::: "memory");
        const int c = lane & 7;
#pragma unroll
        for (int j = 0; j < 4; ++j) { const int n = (lane >> 3) + 8 * j; const float* sp = scr + (8 * c) * 33 + n;
            v4u o = (v4u){0u, 0u, 0u, 0u};
            if (col0 >= 0) { o.x = pk2(sp[0 * 33], sp[1 * 33]); o.y = pk2(sp[2 * 33], sp[3 * 33]); o.z = pk2(sp[4 * 33], sp[5 * 33]); o.w = pk2(sp[6 * 33], sp[7 * 33]); }
            *(v4u*)(Wt + (size_t)(n0 + n) * K + k0 + 8 * c) = o; }
        asm volatile("s_waitcnt lgkmcnt(0)" ::: "memory");
    }
}
__device__ __forceinline__ void cvt_up1(const Params& P, int l, unsigned char* ldsg) {
    STAGE_IDS
    unsigned char* ws = P.ws; float* scr = (float*)(ldsg + wave * 8448);
    cvt_wt(P.in[I_F1UP] + (size_t)l * DM * 2 * FF, DM, 2 * FF, (bf16*)(ws + ((l & 1) ? WS_WUP1B : WS_WUP1)), 2 * FF, 1, gw, ngw, lane, scr, P.in[I_F1N] + l * DM);
}
__device__ __forceinline__ void cvt_rest(const Params& P, int l, unsigned char* ldsg) {
    STAGE_IDS
    unsigned char* ws = P.ws; float* scr = (float*)(ldsg + wave * 8448);
    cvt_wt(P.in[I_F1DN] + (size_t)l * FF * DM, FF, DM, (bf16*)(ws + WS_WDN1), DM, 0, gw, ngw, lane, scr);
    cvt_wt(P.in[I_WIN] + (size_t)l * DM * 6528, DM, 6528, (bf16*)(ws + WS_WIN), 3584, 2, gw, ngw, lane, scr, P.in[I_MIXN] + l * DM);
    cvt_wt(P.in[I_WIN] + (size_t)l * DM * 6528, DM, 6528, (bf16*)(ws + WS_WG), 3072, 3, gw, ngw, lane, scr, P.in[I_MIXN] + l * DM);
    cvt_wt(P.in[I_WOA] + (size_t)l * 512 * DM, 512, DM, (bf16*)(ws + WS_WO), DM, 0, gw, ngw, lane, scr);
    cvt_wt(P.in[I_WOB] + (size_t)l * 512 * DM, 512, DM, (bf16*)(ws + WS_WO) + (size_t)DM * 512, DM, 0, gw, ngw, lane, scr);
    cvt_wt(P.in[I_WOC] + (size_t)l * 512 * DM, 512, DM, (bf16*)(ws + WS_WO) + (size_t)2 * DM * 512, DM, 0, gw, ngw, lane, scr);
    cvt_wt(P.in[I_WOUT] + (size_t)l * DM * DM, DM, DM, (bf16*)(ws + WS_WOUT), DM, 0, gw, ngw, lane, scr);
    cvt_wt(P.in[I_F2UP] + (size_t)l * DM * 2 * FF, DM, 2 * FF, (bf16*)(ws + WS_WUP2), 2 * FF, 1, gw, ngw, lane, scr, P.in[I_F2N] + l * DM);
    cvt_wt(P.in[I_F2DN] + (size_t)l * FF * DM, FF, DM, (bf16*)(ws + WS_WDN2), DM, 0, gw, ngw, lane, scr);
}
__device__ __forceinline__ void x_to_bf16_ss(const float* x, bf16* o, float* SS) {
    STAGE_IDS
    for (int m = gw; m < T_; m += ngw) {
        const f4* xr = (const f4*)(x + (size_t)m * DM) + lane; f4 v[4]; float s = 0.f;
#pragma unroll
        for (int j = 0; j < 4; ++j) { v[j] = xr[64 * j]; s += (v[j].x * v[j].x + v[j].y * v[j].y) + (v[j].z * v[j].z + v[j].w * v[j].w); }
        s = wave_sum(s);
        v2u* op = (v2u*)(o + (size_t)m * DM) + lane;
#pragma unroll
        for (int j = 0; j < 4; ++j) { v2u w; w.x = pk2(v[j].x, v[j].y); w.y = pk2(v[j].z, v[j].w); op[64 * j] = w; }
        if (lane < 16) SS[(size_t)m * 16 + lane] = lane == 0 ? s : 0.f;
    }
}

__device__ __forceinline__ void rms_rows_f32_inplace(float* x, const float* g) {
    STAGE_IDS
    const f4* gr = (const f4*)g + lane; f4 gv[4];
#pragma unroll
    for (int j = 0; j < 4; ++j) gv[j] = gr[64 * j];
    for (int m = gw; m < T_; m += ngw) {
        f4* xr = (f4*)(x + (size_t)m * DM) + lane; f4 v[4]; float s = 0.f;
#pragma unroll
        for (int j = 0; j < 4; ++j) { v[j] = xr[64 * j]; s += (v[j].x * v[j].x + v[j].y * v[j].y) + (v[j].z * v[j].z + v[j].w * v[j].w); }
        const float rs = 1.0f / sqrtf(wave_sum(s) * (1.0f / DM) + 1e-6f);
#pragma unroll
        for (int j = 0; j < 4; ++j) xr[64 * j] = v[j] * rs * gv[j];
    }
}

__device__ __forceinline__ float fast_sin_rev(float rev) { return __builtin_amdgcn_sinf(__builtin_amdgcn_fractf(rev)); }
__device__ __forceinline__ float fast_cos_rev(float rev) { return __builtin_amdgcn_cosf(__builtin_amdgcn_fractf(rev)); }
__device__ __forceinline__ void qkprep(const Params& P, int l, bool dummy = false) {
    STAGE_IDS
    unsigned char* ws = P.ws;
    bf16* QB = (bf16*)(ws + WS_QB); const bf16* KVB = (const bf16*)(ws + WS_KVB); bf16* QC = (bf16*)(ws + WS_QC); const bf16* KVC = (const bf16*)(ws + WS_KVC);
    bf16* KG = (bf16*)(ws + WS_KG); bf16* KW = (bf16*)(ws + WS_KW);
    const float qg = P.in[I_QN][l * 64 + lane], kg = P.in[I_KN][l * 64 + lane];
    const float inv_ax = exp2f(-(float)(lane & 15) * (LOG2_THETA / 16.0f)), inv_1d = exp2f(-(float)(lane & 31) * (LOG2_THETA / 32.0f));
    const float INV2PI = 0.15915494309189535f;
    for (int t = gw; t < T_; t += ngw) {
        const int b = t >> 11, s = t & 2047;
        const float pos = lane < 32 ? (float)(s >> 6) : (float)(s & 63);
        const float ra = (pos * inv_ax) * INV2PI, r1 = ((float)s * inv_1d) * INV2PI;
        const float csa = fast_cos_rev(ra), sna = (lane & 16) ? fast_sin_rev(ra) : -fast_sin_rev(ra);
        const float cs1 = fast_cos_rev(r1), sn1 = (lane & 32) ? fast_sin_rev(r1) : -fast_sin_rev(r1);
#pragma unroll
        for (int slot = 0; slot < 10; ++slot) {
            bf16* src = slot < 8 ? QB + (size_t)t * 512 + slot * 64 : (bf16*)KVB + (size_t)t * 256 + (slot - 8) * 64;
            const float x = bf2f(src[lane]);
            const float ss = wave_sum(x * x) * (1.0f / 64.0f);
            const float y = x * (1.0f / sqrtf(ss + 1e-6f)) * (slot < 8 ? qg : kg);
            const float r = y * csa + __shfl_xor(y, 16) * sna;
            if (slot < 8) (dummy ? (bf16*)(ws + WS_YA) + (size_t)t * 512 + slot * 64 : src)[lane] = (bf16)f2bf(r * C2);
            else KG[((size_t)(b * 2 + (slot - 8)) * S_ + s) * 64 + lane] = (bf16)f2bf(r);
        }
#pragma unroll
        for (int slot = 0; slot < 10; ++slot) {
            bf16* src = slot < 8 ? QC + (size_t)t * 512 + slot * 64 : (bf16*)KVC + (size_t)t * 256 + (slot - 8) * 64;
            const float x = bf2f(src[lane]);
            const float r = x * cs1 + __shfl_xor(x, 32) * sn1;
            if (slot < 8) (dummy ? (bf16*)(ws + WS_YA) + (size_t)t * 512 + slot * 64 : src)[lane] = (bf16)f2bf(r * C2);
            else KW[((size_t)(b * 2 + (slot - 8)) * S_ + s) * 64 + lane] = (bf16)f2bf(r);
        }
    }
}

__device__ __forceinline__ void vt_prep(const Params& P, unsigned char* ldsg) {
    STAGE_IDS
    unsigned char* ws = P.ws;
    bf16* tile = (bf16*)(ldsg + wave * 8448);
    for (int it = gw; it < 2 * NB * 2 * 32; it += ngw) {
        const int tb = it & 31, kvh = (it >> 5) & 1, b = (it >> 6) & 15, att = it >> 10;
        const bf16* src = (const bf16*)(ws + (att ? WS_KVC : WS_KVB)) + (size_t)(b * S_ + tb * 64) * 256 + 128 + kvh * 64;
        bf16* dst = (bf16*)(ws + (att ? WS_VW : WS_VG)) + (size_t)(b * 2 + kvh) * 64 * S_ + tb * 64;
#pragma unroll 8
        for (int r = 0; r < 64; ++r) tile[r * 66 + lane] = src[(size_t)r * 256 + lane];
        asm volatile("s_waitcnt lgkmcnt(0)" ::: "memory");
#pragma unroll 8
        for (int d = 0; d < 64; ++d) dst[(size_t)d * S_ + lane] = tile[lane * 66 + d];
        asm volatile("s_waitcnt lgkmcnt(0)" ::: "memory");
    }
}

typedef short bf16x8_t __attribute__((ext_vector_type(8)));
typedef short s16x4_t __attribute__((ext_vector_type(4)));
typedef float f32x16 __attribute__((ext_vector_type(16)));
typedef float f32x2a __attribute__((ext_vector_type(2))); typedef __bf16 bf16x2a __attribute__((ext_vector_type(2)));
__device__ __forceinline__ unsigned cvtpk(float lo, float hi) { f32x2a v = {lo, hi}; bf16x2a b = __builtin_convertvector(v, bf16x2a); return __builtin_bit_cast(unsigned, b); }
__device__ __forceinline__ int crow(int r, int hi) { return (r & 3) + 8 * (r >> 2) + 4 * hi; }
template <bool WINDOW>
__device__ __forceinline__ void attn_mfma(bf16* Q, const bf16* Kx, const bf16* VTx, const float* sink, unsigned char* ldsg, bf16* Oalt = nullptr) {
    STAGE_IDS
    const int r32 = lane & 31, hi = lane >> 5, g = wave >> 1, qs = wave & 1;
    const int srow = tid >> 3, sch = tid & 7;
    for (int unit = blockIdx.x; unit < 1024; unit += gridDim.x) {
        const int qb = unit & 31, kvh = (unit >> 5) & 1, b = unit >> 6, h = kvh * 4 + g, q0 = qb * 64 + qs * 32;
        bf16* qp = Q + ((size_t)(b * S_ + q0 + r32)) * 512 + h * 64;
        bf16x8_t qr[4];
#pragma unroll
        for (int d0 = 0; d0 < 4; ++d0) qr[d0] = *(const bf16x8_t*)(qp + 16 * d0 + 8 * hi);
        f32x16 o0, o1;
#pragma unroll
        for (int r = 0; r < 16; ++r) { o0[r] = 0.f; o1[r] = 0.f; }
        float m, l;
        if (WINDOW) { m = sink[h] * LOG2E; l = hi == 0 ? 1.0f : 0.f; } else { m = -1e30f; l = 0.f; }
        const int t0 = WINDOW ? (qb - 2 > 0 ? qb - 2 : 0) : 0, t1 = WINDOW ? (qb + 2 < 31 ? qb + 2 : 31) : 31;
        const bf16* kbase = Kx + (size_t)(b * 2 + kvh) * S_ * 64 + (size_t)srow * 64 + sch * 8;
        const bf16* vbase = VTx + (size_t)(b * 2 + kvh) * 64 * S_ + (size_t)srow * S_ + sch * 8;
        v4u kreg = *(const v4u*)(kbase + (size_t)t0 * 64 * 64);
        v4u vreg = *(const v4u*)(vbase + t0 * 64);
        __syncthreads();
        *(v4u*)(ldsg + srow * 144 + sch * 16) = kreg;
        *(v4u*)(ldsg + 9216 + srow * 144 + sch * 16) = vreg;
        __syncthreads();
        for (int t = t0; t <= t1; ++t) {
            const int buf = (t - t0) & 1;
            if (t < t1) { kreg = *(const v4u*)(kbase + (size_t)(t + 1) * 64 * 64); vreg = *(const v4u*)(vbase + (t + 1) * 64); }
            const unsigned char* Kb = ldsg + buf * 18432; const unsigned char* Vb = Kb + 9216;
            f32x16 p0, p1;
#pragma unroll
            for (int r = 0; r < 16; ++r) { p0[r] = 0.f; p1[r] = 0.f; }
#pragma unroll
            for (int d0 = 0; d0 < 4; ++d0) {
                const bf16x8_t a0 = *(const bf16x8_t*)(Kb + r32 * 144 + (16 * d0 + 8 * hi) * 2);
                const bf16x8_t a1 = *(const bf16x8_t*)(Kb + (32 + r32) * 144 + (16 * d0 + 8 * hi) * 2);
                p0 = __builtin_amdgcn_mfma_f32_32x32x16_bf16(a0, qr[d0], p0, 0, 0, 0);
                p1 = __builtin_amdgcn_mfma_f32_32x32x16_bf16(a1, qr[d0], p1, 0, 0, 0);
            }
            if (WINDOW) {
                const int qpos = q0 + r32;
#pragma unroll
                for (int r = 0; r < 16; ++r) { const int kv = t * 64 + crow(r, hi); int dlt = qpos - kv; dlt = dlt < 0 ? -dlt : dlt; if (dlt > 128) p0[r] = -1e30f;
                    int dl2 = qpos - (kv + 32); dl2 = dl2 < 0 ? -dl2 : dl2; if (dl2 > 128) p1[r] = -1e30f; }
            }
            float mt = fmaxf(p0[0], p1[0]);
#pragma unroll
            for (int r = 1; r < 16; ++r) mt = fmaxf(mt, fmaxf(p0[r], p1[r]));
            mt = fmaxf(mt, __shfl_xor(mt, 32));
            if (__any(mt > m)) {
                const float mn = fmaxf(m, mt), corr = __builtin_amdgcn_exp2f(m - mn); m = mn;
                l *= corr;
#pragma unroll
                for (int r = 0; r < 16; ++r) { o0[r] *= corr; o1[r] *= corr; }
            }
            float ps0 = 0.f, ps1 = 0.f;
#pragma unroll
            for (int r = 0; r < 16; ++r) { p0[r] = __builtin_amdgcn_exp2f(p0[r] - m); p1[r] = __builtin_amdgcn_exp2f(p1[r] - m); ps0 += p0[r]; ps1 += p1[r]; }
            l += ps0 + ps1;
            v4u pw[4];
            pw[0] = (v4u){cvtpk(p0[0], p0[1]), cvtpk(p0[2], p0[3]), cvtpk(p0[4], p0[5]), cvtpk(p0[6], p0[7])};
            pw[1] = (v4u){cvtpk(p0[8], p0[9]), cvtpk(p0[10], p0[11]), cvtpk(p0[12], p0[13]), cvtpk(p0[14], p0[15])};
            pw[2] = (v4u){cvtpk(p1[0], p1[1]), cvtpk(p1[2], p1[3]), cvtpk(p1[4], p1[5]), cvtpk(p1[6], p1[7])};
            pw[3] = (v4u){cvtpk(p1[8], p1[9]), cvtpk(p1[10], p1[11]), cvtpk(p1[12], p1[13]), cvtpk(p1[14], p1[15])};
#pragma unroll
            for (int kb = 0; kb < 4; ++kb) {
                const bf16x8_t pb = __builtin_bit_cast(bf16x8_t, pw[kb]);
                { const unsigned char* vp = Vb + r32 * 144 + (16 * kb + 4 * hi) * 2; const s16x4_t lo = *(const s16x4_t*)vp, hh = *(const s16x4_t*)(vp + 16);
                  const bf16x8_t a = (bf16x8_t){lo[0], lo[1], lo[2], lo[3], hh[0], hh[1], hh[2], hh[3]};
                  o0 = __builtin_amdgcn_mfma_f32_32x32x16_bf16(a, pb, o0, 0, 0, 0); }
                { const unsigned char* vp = Vb + (32 + r32) * 144 + (16 * kb + 4 * hi) * 2; const s16x4_t lo = *(const s16x4_t*)vp, hh = *(const s16x4_t*)(vp + 16);
                  const bf16x8_t a = (bf16x8_t){lo[0], lo[1], lo[2], lo[3], hh[0], hh[1], hh[2], hh[3]};
                  o1 = __builtin_amdgcn_mfma_f32_32x32x16_bf16(a, pb, o1, 0, 0, 0); }
            }
            if (t < t1) { unsigned char* nb = ldsg + (buf ^ 1) * 18432; *(v4u*)(nb + srow * 144 + sch * 16) = kreg; *(v4u*)(nb + 9216 + srow * 144 + sch * 16) = vreg; }
            __syncthreads();
        }
        l += __shfl_xor(l, 32);
        const float inv = 1.0f / l;
        if (Oalt) qp = Oalt + ((size_t)(b * S_ + q0 + r32)) * 512 + h * 64;
#pragma unroll
        for (int g4 = 0; g4 < 4; ++g4) {
            v2u w0, w1;
            w0.x = cvtpk(o0[4 * g4 + 0] * inv, o0[4 * g4 + 1] * inv); w0.y = cvtpk(o0[4 * g4 + 2] * inv, o0[4 * g4 + 3] * inv);
            w1.x = cvtpk(o1[4 * g4 + 0] * inv, o1[4 * g4 + 1] * inv); w1.y = cvtpk(o1[4 * g4 + 2] * inv, o1[4 * g4 + 3] * inv);
            *(v2u*)(qp + 8 * g4 + 4 * hi) = w0;
            *(v2u*)(qp + 32 + 8 * g4 + 4 * hi) = w1;
        }
    }
}

typedef float f8s __attribute__((ext_vector_type(8)));
typedef float f32x4m __attribute__((ext_vector_type(4)));
constexpr int SC_VEC = 0, SC_VS = 81920, SC_W2T = 98304, SC_A2T = 107520, SC_XCH = 116736, SC_YP = 124928, SC_A1 = SC_YP, SC_A2 = SC_YP + 9216, SC_AL = SC_YP + 18432, SC_CS = SC_AL + 16640, SC_END = SC_CS + 128;
static_assert(SC_END <= LDS_BYTES, "scan LDS");
__device__ __forceinline__ void ld8bf(const bf16* p, float (&f)[8]) { const v4u w = *(const v4u*)p;
    f[0] = __uint_as_float(w.x << 16); f[1] = __uint_as_float(w.x & 0xffff0000u); f[2] = __uint_as_float(w.y << 16); f[3] = __uint_as_float(w.y & 0xffff0000u);
    f[4] = __uint_as_float(w.z << 16); f[5] = __uint_as_float(w.z & 0xffff0000u); f[6] = __uint_as_float(w.w << 16); f[7] = __uint_as_float(w.w & 0xffff0000u); }
__device__ __forceinline__ void shifted8(const bf16* pc, int col, bool hasp, bool hasn, const float* mu, float (&o)[8]) {
    float c[8], p[8], n[8];
    ld8bf(pc + col, c);
    if (hasp) ld8bf(pc + col - 2048, p); else { for (int e = 0; e < 8; ++e) p[e] = 0.f; }
    if (hasn) ld8bf(pc + col + 2048, n); else { for (int e = 0; e < 8; ++e) n[e] = 0.f; }
    const f4 m0 = *(const f4*)(mu + col), m1 = *(const f4*)(mu + col + 4);
    const float mm[8] = {m0.x, m0.y, m0.z, m0.w, m1.x, m1.y, m1.z, m1.w};
#pragma unroll
    for (int e = 0; e < 8; ++e) o[e] = c[e] + mm[e] * (0.5f * (p[e] + n[e]) - c[e]);
}
struct Raw3 { v4u c, p, n; };
__device__ __forceinline__ void raw_load(Raw3& r, const bf16* pc, int col, bool hasp, bool hasn) {
    r.c = *(const v4u*)(pc + col);
    r.p = hasp ? *(const v4u*)(pc + col - 2048) : (v4u){0u, 0u, 0u, 0u};
    r.n = hasn ? *(const v4u*)(pc + col + 2048) : (v4u){0u, 0u, 0u, 0u};
}
__device__ __forceinline__ void un8(const v4u w, float (&f)[8]) {
    f[0] = __uint_as_float(w.x << 16); f[1] = __uint_as_float(w.x & 0xffff0000u); f[2] = __uint_as_float(w.y << 16); f[3] = __uint_as_float(w.y & 0xffff0000u);
    f[4] = __uint_as_float(w.z << 16); f[5] = __uint_as_float(w.z & 0xffff0000u); f[6] = __uint_as_float(w.w << 16); f[7] = __uint_as_float(w.w & 0xffff0000u); }
__device__ __forceinline__ void shift_raw(const Raw3& r, const float* mu, int col, float (&o)[8]) {
    float c[8], p[8], n[8]; un8(r.c, c); un8(r.p, p); un8(r.n, n);
    const f4 m0 = *(const f4*)(mu + col), m1 = *(const f4*)(mu + col + 4);
    const float mm[8] = {m0.x, m0.y, m0.z, m0.w, m1.x, m1.y, m1.z, m1.w};
#pragma unroll
    for (int e = 0; e < 8; ++e) o[e] = c[e] + mm[e] * (0.5f * (p[e] + n[e]) - c[e]);
}
__device__ __forceinline__ void scan_fast(const Params& P, int l, unsigned char* ldsg) {
    STAGE_IDS
    unsigned char* ws = P.ws;
    const bf16* PR = (const bf16*)(ws + WS_PR); float* BONUS = (float*)(ws + WS_BONUS);
    float* VEC = (float*)(ldsg + SC_VEC);
    const int fr = lane & 15, fq = lane >> 4, ps = tid >> 3, pcg = tid & 7;
    float* XCH = (float*)(ldsg + SC_XCH); float* YP = (float*)(ldsg + SC_YP); float* VS = (float*)(ldsg + SC_VS); float* AL = (float*)(ldsg + SC_AL);
    for (int sid = blockIdx.x; sid < 256; sid += gridDim.x) {
        const int dir = sid & 1, h = (sid >> 1) & 7, b = sid >> 4, hc0 = h * 64;
        bf16* WKV = (bf16*)(ws + (dir ? WS_WKVB : WS_WKVF));
        const float* mu = P.in[I_MU] + (size_t)l * 1920;
        __syncthreads();
        {
            const float* w2b = P.in[I_W2] + (size_t)(l * 2 + dir) * 64 * 512 + (size_t)ps * 512 + hc0 + 8 * pcg;
            const float* a2b = P.in[I_A2] + (size_t)(l * 2 + dir) * 64 * 512 + (size_t)ps * 512 + hc0 + 8 * pcg;
#pragma unroll
            for (int e = 0; e < 8; ++e) { ((bf16*)(ldsg + SC_W2T))[(8 * pcg + e) * 72 + ps] = (bf16)f2bf(w2b[e]); ((bf16*)(ldsg + SC_A2T))[(8 * pcg + e) * 72 + ps] = (bf16)f2bf(a2b[e]); }
        }
        float S[8];
#pragma unroll
        for (int j = 0; j < 8; ++j) S[j] = 0.f;
        Raw3 pre[5];
#pragma unroll 1
        for (int ch = 0; ch < S_ / 64; ++ch) {
            const int step0 = ch * 64;
            const int tp = dir ? S_ - 1 - (step0 + ps) : step0 + ps;
            const int cR = hc0 + 8 * pcg, cK = 512 + hc0 + 8 * pcg, cV = 1024 + hc0 + 8 * pcg, cW = 1536 + 64 * dir + 8 * pcg, cA = 1664 + 64 * dir + 8 * pcg;
            if (ch == 0) { const bf16* pc = PR + ((size_t)(b * S_ + tp)) * 2048; const bool hasp = tp > 0, hasn = tp < S_ - 1;
                raw_load(pre[0], pc, cR, hasp, hasn); raw_load(pre[1], pc, cK, hasp, hasn); raw_load(pre[2], pc, cV, hasp, hasn); raw_load(pre[3], pc, cW, hasp, hasn); raw_load(pre[4], pc, cA, hasp, hasn); }
            float r8[8], k8[8], v8[8];
            shift_raw(pre[0], mu, cR, r8);
            shift_raw(pre[1], mu, cK, k8);
            shift_raw(pre[2], mu, cV, v8);
            { float wl[8], al[8];
              shift_raw(pre[3], mu, cW, wl);
              shift_raw(pre[4], mu, cA, al);
#pragma unroll
              for (int e = 0; e < 8; ++e) { const float t2 = __builtin_amdgcn_exp2f(2.0f * LOG2E * wl[e]); wl[e] = (t2 - 1.0f) * __builtin_amdgcn_rcpf(t2 + 1.0f); }
              v4u w1, w2v; w1.x = cvtpk(wl[0], wl[1]); w1.y = cvtpk(wl[2], wl[3]); w1.z = cvtpk(wl[4], wl[5]); w1.w = cvtpk(wl[6], wl[7]);
              w2v.x = cvtpk(al[0], al[1]); w2v.y = cvtpk(al[2], al[3]); w2v.z = cvtpk(al[4], al[5]); w2v.w = cvtpk(al[6], al[7]);
              *(v4u*)(ldsg + SC_A1 + ps * 144 + pcg * 16) = w1; *(v4u*)(ldsg + SC_A2 + ps * 144 + pcg * 16) = w2v; }
            *(f4*)(VS + ps * 64 + 8 * pcg) = (f4){v8[0], v8[1], v8[2], v8[3]}; *(f4*)(VS + ps * 64 + 8 * pcg + 4) = (f4){v8[4], v8[5], v8[6], v8[7]};
            __syncthreads();
            {
                const int wq = wave & 3; const bool isw = wave < 4;
                const unsigned char* Ab = ldsg + (isw ? SC_A1 : SC_A2) + (16 * wq + fr) * 144 + 16 * fq;
                const unsigned char* Bb = ldsg + (isw ? SC_W2T : SC_A2T) + fr * 144 + 16 * fq;
                const bf16x8_t a0 = *(const bf16x8_t*)Ab, a1 = *(const bf16x8_t*)(Ab + 64);
                const float* bias = P.in[isw ? I_W0 : I_A0] + (size_t)(l * 2 + dir) * 512 + hc0;
#pragma unroll
                for (int n = 0; n < 4; ++n) {
                    const bf16x8_t b0 = *(const bf16x8_t*)(Bb + n * 16 * 144), b1 = *(const bf16x8_t*)(Bb + n * 16 * 144 + 64);
                    f32x4m acc = (f32x4m){0.f, 0.f, 0.f, 0.f};
                    acc = __builtin_amdgcn_mfma_f32_16x16x32_bf16(a0, b0, acc, 0, 0, 0);
                    acc = __builtin_amdgcn_mfma_f32_16x16x32_bf16(a1, b1, acc, 0, 0, 0);
                    const float bz = bias[16 * n + fr];
#pragma unroll
                    for (int v = 0; v < 4; ++v) {
                        const int st = 16 * wq + 4 * fq + v; const float x = acc[v] + bz;
                        if (isw) { const float sp = __builtin_amdgcn_logf(1.0f + __builtin_amdgcn_exp2f(-x * LOG2E)) * 0.6931471805599453f;
                                   const float wlog = -sp - 0.5f; VEC[st * 320 + (2 * n + (fr >> 3)) * 40 + (fr & 7)] = __builtin_amdgcn_exp2f(-__builtin_amdgcn_exp2f(wlog * LOG2E) * LOG2E); }
                        else AL[st * 65 + 16 * n + fr] = __builtin_amdgcn_rcpf(1.0f + __builtin_amdgcn_exp2f(-x * LOG2E));
                    }
                }
            }
            __syncthreads();
            {
                const float* kkp = P.in[I_KK] + l * 512 + hc0 + 8 * pcg; const float* kap = P.in[I_KA] + l * 512 + hc0 + 8 * pcg; const float* rkp = P.in[I_RK] + l * 512 + hc0 + 8 * pcg;
                float a8[8], kk[8], kd[8]; float ss = 0.f, bon = 0.f;
#pragma unroll
                for (int e = 0; e < 8; ++e) { a8[e] = AL[ps * 65 + 8 * pcg + e]; kk[e] = k8[e] * kkp[e]; ss += kk[e] * kk[e]; kd[e] = k8[e] * (1.0f + (a8[e] - 1.0f) * kap[e]); bon += r8[e] * kd[e] * rkp[e]; }
                ss += __shfl_xor(ss, 1); ss += __shfl_xor(ss, 2); ss += __shfl_xor(ss, 4);
                bon += __shfl_xor(bon, 1); bon += __shfl_xor(bon, 2); bon += __shfl_xor(bon, 4);
                const float rn = 1.0f / fmaxf(sqrtf(ss), 1e-12f);
                float* sp = VEC + ps * 320 + 40 * pcg;
                *(f4*)(sp + 8) = (f4){kd[0], kd[1], kd[2], kd[3]}; *(f4*)(sp + 12) = (f4){kd[4], kd[5], kd[6], kd[7]};
                *(f4*)(sp + 16) = (f4){-kk[0] * rn, -kk[1] * rn, -kk[2] * rn, -kk[3] * rn}; *(f4*)(sp + 20) = (f4){-kk[4] * rn, -kk[5] * rn, -kk[6] * rn, -kk[7] * rn};
                *(f4*)(sp + 24) = (f4){kk[0] * rn * a8[0], kk[1] * rn * a8[1], kk[2] * rn * a8[2], kk[3] * rn * a8[3]}; *(f4*)(sp + 28) = (f4){kk[4] * rn * a8[4], kk[5] * rn * a8[5], kk[6] * rn * a8[6], kk[7] * rn * a8[7]};
                *(f4*)(sp + 32) = (f4){r8[0], r8[1], r8[2], r8[3]}; *(f4*)(sp + 36) = (f4){r8[4], r8[5], r8[6], r8[7]};
                if (pcg == 0) BONUS[((size_t)((dir * NB + b) * 8 + h)) * S_ + tp] = bon;
            }
            asm volatile("s_waitcnt vmcnt(0) lgkmcnt(0)" ::: "memory");
            __syncthreads();
            {
                float* CS = (float*)(ldsg + SC_CS);
                const int p = tid >> 4, q = tid & 15;
                const float* b0 = VEC + (2 * p) * 320 + (q >> 1) * 40 + 24 + (q & 1) * 4; const float* n1 = VEC + (2 * p + 1) * 320 + (q >> 1) * 40 + 16 + (q & 1) * 4;
                float d = (b0[0] * n1[0] + b0[1] * n1[1]) + (b0[2] * n1[2] + b0[3] * n1[3]);
                d += __shfl_xor(d, 1); d += __shfl_xor(d, 2); d += __shfl_xor(d, 4); d += __shfl_xor(d, 8);
                if (q == 0) CS[p] = d;
            }
            asm volatile("s_waitcnt lgkmcnt(0)" ::: "memory");
            __syncthreads();
#define DPP_FMAC(acc, xs, val, N) asm("v_fmac_f32_dpp %0, %1, %2 row_newbcast:" #N " row_mask:0xf bank_mask:0xf" : "+v"(acc) : "v"(xs), "v"(val))
#define DPP_MUL(dst, xs, val, N) asm("v_mul_f32_dpp %0, %1, %2 row_newbcast:" #N " row_mask:0xf bank_mask:0xf" : "=v"(dst) : "v"(xs), "v"(val))
            if (ch + 1 < S_ / 64) { const int tn = dir ? S_ - 1 - (step0 + 64 + ps) : step0 + 64 + ps; const bf16* pc = PR + ((size_t)(b * S_ + tn)) * 2048; const bool hasp = tn > 0, hasn = tn < S_ - 1;
                raw_load(pre[0], pc, cR, hasp, hasn); raw_load(pre[1], pc, cK, hasp, hasn); raw_load(pre[2], pc, cV, hasp, hasn); raw_load(pre[3], pc, cW, hasp, hasn); raw_load(pre[4], pc, cA, hasp, hasn); }
            const float* vecb = VEC + wave * 40 + (lane & 15);
            const int o2 = 32 + (lane & 7) - (lane & 15);
            const float* CSr = (const float*)(ldsg + SC_CS);
#define R8(M) M(0) M(1) M(2) M(3) M(4) M(5) M(6) M(7)
#define R7(M) M(1) M(2) M(3) M(4) M(5) M(6) M(7)
            const int xslot = lane * 8 + ((wave + (lane >> 2)) & 7);
            float pm2 = 0.f;
            auto pair_steps = [&](const int t, float& x0, float& x1, float& x2, float& m0, float& m1, float& m2, const float va, const float vb) __attribute__((always_inline)) {
                const float Cc = CSr[t >> 1];
                asm volatile("s_nop 1" : "+v"(x0), "+v"(x1), "+v"(x2), "+v"(m0), "+v"(m1), "+v"(m2));
                float pa, pb, qa, qb, Tt[8];
                DPP_MUL(pa, x1, S[0], 0); DPP_MUL(pb, x1, S[1], 1);
                DPP_FMAC(pa, x1, S[2], 2); DPP_FMAC(pb, x1, S[3], 3); DPP_FMAC(pa, x1, S[4], 4); DPP_FMAC(pb, x1, S[5], 5); DPP_FMAC(pa, x1, S[6], 6); DPP_FMAC(pb, x1, S[7], 7);
#define M_T0(j) DPP_MUL(Tt[j], x0, S[j], j);
                R8(M_T0)
                DPP_FMAC(Tt[0], x0, va, 8); DPP_FMAC(Tt[1], x0, va, 9); DPP_FMAC(Tt[2], x0, va, 10); DPP_FMAC(Tt[3], x0, va, 11);
                DPP_FMAC(Tt[4], x0, va, 12); DPP_FMAC(Tt[5], x0, va, 13); DPP_FMAC(Tt[6], x0, va, 14); DPP_FMAC(Tt[7], x0, va, 15);
                DPP_MUL(qa, m1, Tt[0], 0); DPP_MUL(qb, m1, Tt[1], 1);
                DPP_FMAC(qa, m1, Tt[2], 2); DPP_FMAC(qb, m1, Tt[3], 3); DPP_FMAC(qa, m1, Tt[4], 4); DPP_FMAC(qb, m1, Tt[5], 5); DPP_FMAC(qa, m1, Tt[6], 6); DPP_FMAC(qb, m1, Tt[7], 7);
                const int par = (t >> 1) & 1;
                XCH[par * 1024 + xslot] = pa + pb; XCH[par * 1024 + 512 + xslot] = qa + qb;
                asm volatile("s_waitcnt lgkmcnt(0)\n\ts_barrier" ::: "memory");
                const f4* xp = (const f4*)(XCH + par * 1024 + lane * 8);
                const f4 e0 = xp[0], e1 = xp[1], g0 = xp[128], g1 = xp[129];
                if (t > 0) {
                    float yc, yd;
                    DPP_MUL(yc, pm2, S[0], 0); DPP_MUL(yd, pm2, S[1], 1);
                    DPP_FMAC(yc, pm2, S[2], 2); DPP_FMAC(yd, pm2, S[3], 3); DPP_FMAC(yc, pm2, S[4], 4); DPP_FMAC(yd, pm2, S[5], 5); DPP_FMAC(yc, pm2, S[6], 6); DPP_FMAC(yd, pm2, S[7], 7);
                    YP[((t - 1) & 15) * 512 + wave * 64 + lane] = yc + yd;
                    if ((t & 7) == 2 && t >= 10) {
                        const int sl = (t - 10) + wave;
                        const float* yp = YP + (sl & 15) * 512 + lane;
                        const float y0 = ((yp[0] + yp[64]) + (yp[128] + yp[192])) + ((yp[256] + yp[320]) + (yp[384] + yp[448]));
                        const int tt = dir ? S_ - 1 - (step0 + sl) : step0 + sl;
                        WKV[((size_t)(b * S_ + tt)) * 512 + hc0 + lane] = (bf16)f2bf(y0);
                    }
                }
                const f4 es = e0 + e1, gs = g0 + g1;
                float sa0 = (es.x + es.y) + (es.z + es.w);
                asm volatile("" : "+v"(sa0));
                const float p1s = (gs.x + gs.y) + (gs.z + gs.w);
                float sa1 = p1s + sa0 * Cc;
                DPP_FMAC(Tt[0], x1, sa0, 8); DPP_FMAC(Tt[1], x1, sa0, 9); DPP_FMAC(Tt[2], x1, sa0, 10); DPP_FMAC(Tt[3], x1, sa0, 11);
                DPP_FMAC(Tt[4], x1, sa0, 12); DPP_FMAC(Tt[5], x1, sa0, 13); DPP_FMAC(Tt[6], x1, sa0, 14); DPP_FMAC(Tt[7], x1, sa0, 15);
                float ya, yb;
                DPP_MUL(ya, x2, Tt[0], 0); DPP_MUL(yb, x2, Tt[1], 1);
                DPP_FMAC(ya, x2, Tt[2], 2); DPP_FMAC(yb, x2, Tt[3], 3); DPP_FMAC(ya, x2, Tt[4], 4); DPP_FMAC(yb, x2, Tt[5], 5); DPP_FMAC(ya, x2, Tt[6], 6); DPP_FMAC(yb, x2, Tt[7], 7);
                YP[(t & 15) * 512 + wave * 64 + lane] = ya + yb;
#define M_T1(j) DPP_MUL(S[j], m0, Tt[j], j);
                R8(M_T1)
                DPP_FMAC(S[0], m0, vb, 8); DPP_FMAC(S[1], m0, vb, 9); DPP_FMAC(S[2], m0, vb, 10); DPP_FMAC(S[3], m0, vb, 11);
                DPP_FMAC(S[4], m0, vb, 12); DPP_FMAC(S[5], m0, vb, 13); DPP_FMAC(S[6], m0, vb, 14); DPP_FMAC(S[7], m0, vb, 15);
                DPP_FMAC(S[0], m1, sa1, 8); DPP_FMAC(S[1], m1, sa1, 9); DPP_FMAC(S[2], m1, sa1, 10); DPP_FMAC(S[3], m1, sa1, 11);
                DPP_FMAC(S[4], m1, sa1, 12); DPP_FMAC(S[5], m1, sa1, 13); DPP_FMAC(S[6], m1, sa1, 14); DPP_FMAC(S[7], m1, sa1, 15);
                pm2 = m2;
            };
            float ax0 = vecb[0], ax1 = vecb[16], ax2 = vecb[o2], am0 = vecb[320], am1 = vecb[336], am2 = vecb[320 + o2], ava = VS[lane], avb = VS[64 + lane];
            float bx0, bx1, bx2, bm0, bm1, bm2, bva, bvb;
#pragma unroll 1
            for (int t = 0; t < 64; t += 4) {
                { const float* np_ = vecb + (t + 2) * 320; const float* nq_ = vecb + (t + 3) * 320;
                  bx0 = np_[0]; bx1 = np_[16]; bx2 = np_[o2]; bm0 = nq_[0]; bm1 = nq_[16]; bm2 = nq_[o2]; bva = VS[(t + 2) * 64 + lane]; bvb = VS[(t + 3) * 64 + lane]; }
                pair_steps(t, ax0, ax1, ax2, am0, am1, am2, ava, avb);
                { const float* np_ = vecb + ((t + 4) & 63) * 320; const float* nq_ = vecb + ((t + 5) & 63) * 320;
                  ax0 = np_[0]; ax1 = np_[16]; ax2 = np_[o2]; am0 = nq_[0]; am1 = nq_[16]; am2 = nq_[o2]; ava = VS[((t + 4) & 63) * 64 + lane]; avb = VS[((t + 5) & 63) * 64 + lane]; }
                pair_steps(t + 2, bx0, bx1, bx2, bm0, bm1, bm2, bva, bvb);
            }
            {
                asm volatile("s_nop 1" : "+v"(pm2));
                float yc, yd;
                DPP_MUL(yc, pm2, S[0], 0); DPP_MUL(yd, pm2, S[1], 1);
                DPP_FMAC(yc, pm2, S[2], 2); DPP_FMAC(yd, pm2, S[3], 3); DPP_FMAC(yc, pm2, S[4], 4); DPP_FMAC(yd, pm2, S[5], 5); DPP_FMAC(yc, pm2, S[6], 6); DPP_FMAC(yd, pm2, S[7], 7);
                YP[(63 & 15) * 512 + wave * 64 + lane] = yc + yd;
                asm volatile("s_waitcnt lgkmcnt(0)\n\ts_barrier" ::: "memory");
                {
                    const int sl = 56 + wave;
                    const float* yp = YP + (sl & 15) * 512 + lane;
                    const float y0 = ((yp[0] + yp[64]) + (yp[128] + yp[192])) + ((yp[256] + yp[320]) + (yp[384] + yp[448]));
                    const int tt = dir ? S_ - 1 - (step0 + sl) : step0 + sl;
                    WKV[((size_t)(b * S_ + tt)) * 512 + hc0 + lane] = (bf16)f2bf(y0);
                }
            }
#undef R7
#undef M_T0
#undef M_T1
#undef R8
#undef DPP_FMAC
#undef DPP_MUL
            __syncthreads();
        }
    }
}

__device__ __forceinline__ void finalize_fast(const Params& P, int l, unsigned char* ldsg) {
    STAGE_IDS
    unsigned char* ws = P.ws;
    const bf16* PR = (const bf16*)(ws + WS_PR); const bf16* WF = (const bf16*)(ws + WS_WKVF); const bf16* WBk = (const bf16*)(ws + WS_WKVB); const float* BONUS = (const float*)(ws + WS_BONUS);
    bf16* YA = (bf16*)(ws + WS_YA);
    const int fr = lane & 15, fq = lane >> 4;
    const float* mu = P.in[I_MU] + (size_t)l * 1920; const float* g2 = P.in[I_G2] + (size_t)l * 128 * 512;
    const float* lngp = P.in[I_LNG] + l * 512; const float* lnbp = P.in[I_LNB] + l * 512;
    bf16x8_t gf[4][4];
#pragma unroll
    for (int n = 0; n < 4; ++n)
#pragma unroll
        for (int ks = 0; ks < 4; ++ks) { float gv[8];
#pragma unroll
            for (int e = 0; e < 8; ++e) gv[e] = g2[(size_t)(32 * ks + 8 * fq + e) * 512 + 64 * wave + 16 * n + fr];
            const v4u w = (v4u){cvtpk(gv[0], gv[1]), cvtpk(gv[2], gv[3]), cvtpk(gv[4], gv[5]), cvtpk(gv[6], gv[7])};
            gf[n][ks] = __builtin_bit_cast(bf16x8_t, w); }
    for (int tile = blockIdx.x; tile < T_ / 32; tile += gridDim.x) {
        const int t0 = tile * 32;
        __syncthreads();
        { const int tok = tid >> 4, mg = tid & 15, t = t0 + tok, s = t & 2047; float x[8];
          shifted8(PR + (size_t)t * 2048, 1792 + 8 * mg, s > 0, s < S_ - 1, mu, x);
#pragma unroll
          for (int e = 0; e < 8; ++e) x[e] = __builtin_amdgcn_rcpf(1.0f + __builtin_amdgcn_exp2f(-x[e] * LOG2E));
          *(v4u*)(ldsg + tok * 272 + mg * 16) = (v4u){cvtpk(x[0], x[1]), cvtpk(x[2], x[3]), cvtpk(x[4], x[5]), cvtpk(x[6], x[7])}; }
        __syncthreads();
#pragma unroll
        for (int mt = 0; mt < 2; ++mt) {
            f32x4m acc[4];
#pragma unroll
            for (int n = 0; n < 4; ++n) acc[n] = (f32x4m){0.f, 0.f, 0.f, 0.f};
#pragma unroll
            for (int ks = 0; ks < 4; ++ks) { const bf16x8_t bb = *(const bf16x8_t*)(ldsg + (16 * mt + fr) * 272 + (32 * ks + 8 * fq) * 2);
#pragma unroll
                for (int n = 0; n < 4; ++n) acc[n] = __builtin_amdgcn_mfma_f32_16x16x32_bf16(gf[n][ks], bb, acc[n], 0, 0, 0); }
            const int t = t0 + 16 * mt + fr, s = t & 2047, bb_ = t >> 11;
            float wk[4][4]; float sm = 0.f;
#pragma unroll
            for (int n = 0; n < 4; ++n) { const int c0 = 64 * wave + 16 * n + 4 * fq;
                const v2u a = *(const v2u*)(WF + (size_t)t * 512 + c0), b2 = *(const v2u*)(WBk + (size_t)t * 512 + c0);
                wk[n][0] = __uint_as_float(a.x << 16) + __uint_as_float(b2.x << 16); wk[n][1] = __uint_as_float(a.x & 0xffff0000u) + __uint_as_float(b2.x & 0xffff0000u);
                wk[n][2] = __uint_as_float(a.y << 16) + __uint_as_float(b2.y << 16); wk[n][3] = __uint_as_float(a.y & 0xffff0000u) + __uint_as_float(b2.y & 0xffff0000u);
                sm += (wk[n][0] + wk[n][1]) + (wk[n][2] + wk[n][3]); }
            sm += __shfl_xor(sm, 16); sm += __shfl_xor(sm, 32);
            const float mean = sm * (1.0f / 64.0f); float sq = 0.f;
#pragma unroll
            for (int n = 0; n < 4; ++n)
#pragma unroll
                for (int v = 0; v < 4; ++v) { wk[n][v] -= mean; sq += wk[n][v] * wk[n][v]; }
            sq += __shfl_xor(sq, 16); sq += __shfl_xor(sq, 32);
            const float rstd = 1.0f / sqrtf(sq * (1.0f / 64.0f) + 64e-5f);
            const float bon = BONUS[((size_t)(bb_ * 8 + wave)) * S_ + s] + BONUS[((size_t)((NB + bb_) * 8 + wave)) * S_ + s];
            const bf16* pc = PR + (size_t)t * 2048;
#pragma unroll
            for (int n = 0; n < 4; ++n) { const int c0 = 64 * wave + 16 * n + 4 * fq;
                const f4 lg = *(const f4*)(lngp + c0), lb = *(const f4*)(lnbp + c0), mv = *(const f4*)(mu + 1024 + c0);
                const v2u vc = *(const v2u*)(pc + 1024 + c0);
                v2u vp = (v2u){0u, 0u}, vn = (v2u){0u, 0u};
                if (s > 0) vp = *(const v2u*)(pc + 1024 + c0 - 2048);
                if (s < S_ - 1) vn = *(const v2u*)(pc + 1024 + c0 + 2048);
                const float cc[4] = {__uint_as_float(vc.x << 16), __uint_as_float(vc.x & 0xffff0000u), __uint_as_float(vc.y << 16), __uint_as_float(vc.y & 0xffff0000u)};
                const float pp[4] = {__uint_as_float(vp.x << 16), __uint_as_float(vp.x & 0xffff0000u), __uint_as_float(vp.y << 16), __uint_as_float(vp.y & 0xffff0000u)};
                const float nn[4] = {__uint_as_float(vn.x << 16), __uint_as_float(vn.x & 0xffff0000u), __uint_as_float(vn.y << 16), __uint_as_float(vn.y & 0xffff0000u)};
                float yv[4];
#pragma unroll
                for (int v = 0; v < 4; ++v) { const float vs = cc[v] + mv[v] * (0.5f * (pp[v] + nn[v]) - cc[v]);
                    yv[v] = (wk[n][v] * rstd * lg[v] + lb[v] + bon * vs) * acc[n][v]; }
                *(v2u*)(YA + (size_t)t * 512 + c0) = (v2u){cvtpk(yv[0], yv[1]), cvtpk(yv[2], yv[3])}; }
        }
    }
}

#define GRID_SYNC_CG() do { asm volatile("s_waitcnt vmcnt(0) lgkmcnt(0)" ::: "memory"); grid.sync(); __builtin_amdgcn_fence(__ATOMIC_ACQUIRE, "agent"); asm volatile("s_waitcnt vmcnt(0)" ::: "memory"); } while (0)
#define GRID_SYNC() grid_barrier(gbar, ground)
#define GEMM_PHASE(EPI, A_, Bt_, M_, N_, K_, E_) do { pg8::Gemm g_{(const pg8::bf16_t*)(A_), (const pg8::bf16_t*)(Bt_), (M_), (N_), (K_)}; pg8::StaticOrder S_o; S_o.init((M_), (N_), (int)gridDim.x, (int)blockIdx.x); \
    pg8::gemm_phase<EPI, pg8::StaticOrder, true, true>((PG8_LAS unsigned char*)lds, g_, S_o, (E_)); } while (0)

__device__ __forceinline__ void grid_barrier(unsigned* bar, unsigned& round) {
    asm volatile("s_waitcnt vmcnt(0) lgkmcnt(0)" ::: "memory");
    __syncthreads();
    ++round;
    if (threadIdx.x == 0) {
        __builtin_amdgcn_fence(__ATOMIC_RELEASE, "agent");
        asm volatile("s_waitcnt vmcnt(0)" ::: "memory");
        const unsigned g = blockIdx.x & 7u, G = gridDim.x, ng = (G + 7u - g) >> 3, ngroups = G < 8u ? G : 8u;
        const unsigned old = __hip_atomic_fetch_add(bar + 64 * (1 + g), 1u, __ATOMIC_RELAXED, __HIP_MEMORY_SCOPE_AGENT);
        if (old + 1u == round * ng) {
            const unsigned old2 = __hip_atomic_fetch_add(bar + 64 * 9, 1u, __ATOMIC_RELAXED, __HIP_MEMORY_SCOPE_AGENT);
            if (old2 + 1u == round * ngroups) __hip_atomic_store(bar, round, __ATOMIC_RELAXED, __HIP_MEMORY_SCOPE_AGENT);
        }
        unsigned spins = 0;
        while (__hip_atomic_load(bar, __ATOMIC_RELAXED, __HIP_MEMORY_SCOPE_AGENT) < round) { __builtin_amdgcn_s_sleep(1); if (++spins > (1u << 24)) break; }
        __builtin_amdgcn_fence(__ATOMIC_ACQUIRE, "agent");
        asm volatile("s_waitcnt vmcnt(0)" ::: "memory");
    }
    __syncthreads();
}
__global__ void __launch_bounds__(NTHREADS, 2) fwd_kernel(Params P) {
    extern __shared__ __attribute__((aligned(16))) unsigned char lds[];
    cg::grid_group grid = cg::this_grid();
    unsigned char* ws = P.ws;
    bf16* H = (bf16*)(ws + WS_H); bf16* ACT = (bf16*)(ws + WS_ACT);
    float* SSB = (float*)(ws + WS_SS);
    unsigned* gbar = (unsigned*)(ws + WS_BAR); unsigned ground = 0;
    cvt_up1(P, 0, lds);
    x_to_bf16_ss(P.in[I_X], H, SSB);
    if (P.ws == nullptr) GRID_SYNC_CG();
    GRID_SYNC();
#pragma unroll 1
    for (int l = 0; l < NL; ++l) {
        const float* xin = (l == 0) ? P.in[I_X] : P.out;
        cvt_rest(P, l, lds);
        __syncthreads();
        { pg8::EpiSwiglu E{(pg8::bf16_t*)ACT, FF, SSB}; GEMM_PHASE(pg8::EpiSwiglu, H, ws + ((l & 1) ? WS_WUP1B : WS_WUP1), T_, 2 * FF, DM, E); }
        GRID_SYNC();
        { pg8::EpiResid E{xin, P.out, DM, 0.5f, (pg8::bf16_t*)H, SSB}; GEMM_PHASE(pg8::EpiResid, ACT, ws + WS_WDN1, T_, DM, FF, E); }
        GRID_SYNC();
        { pg8::EpiWin E{(pg8::bf16_t*)(ws + WS_PR), (pg8::bf16_t*)(ws + WS_QB), (pg8::bf16_t*)(ws + WS_KVB), (pg8::bf16_t*)(ws + WS_QC), (pg8::bf16_t*)(ws + WS_KVC), SSB};
          GEMM_PHASE(pg8::EpiWin, H, ws + WS_WIN, T_, 3584, DM, E); }
        GRID_SYNC();
        qkprep(P, l);
        vt_prep(P, lds);
        __syncthreads();
        scan_fast(P, l, lds);
        GRID_SYNC();
        attn_mfma<false>((bf16*)(ws + WS_QB), (const bf16*)(ws + WS_KG), (const bf16*)(ws + WS_VG), nullptr, lds);
        attn_mfma<true>((bf16*)(ws + WS_QC), (const bf16*)(ws + WS_KW), (const bf16*)(ws + WS_VW), P.in[I_SINK] + l * 8, lds);
        __syncthreads();
        finalize_fast(P, l, lds);
        GRID_SYNC();
#pragma unroll 1
        for (int i = 0; i < 3; ++i) {
            { pg8::EpiGate E{(pg8::bf16_t*)(ws + WS_GATE), SSB}; GEMM_PHASE(pg8::EpiGate, H, ws + WS_WG + (size_t)i * DM * DM * 2, T_, DM, DM, E); }
            const unsigned char* yi = ws + (i == 0 ? WS_YA : (i == 1 ? WS_QB : WS_QC));
            { pg8::EpiMerge E{(const pg8::bf16_t*)(ws + WS_GATE), (pg8::bf16_t*)(ws + WS_MERGED), i == 0 ? 1 : 0}; GEMM_PHASE(pg8::EpiMerge, yi, ws + WS_WO + (size_t)i * DM * 512 * 2, T_, DM, 512, E); }
        }
        GRID_SYNC();
        { pg8::EpiResid E{P.out, P.out, DM, 1.0f, (pg8::bf16_t*)H, SSB}; GEMM_PHASE(pg8::EpiResid, ws + WS_MERGED, ws + WS_WOUT, T_, DM, DM, E); }
        GRID_SYNC();
        { pg8::EpiSwiglu E{(pg8::bf16_t*)ACT, FF, SSB}; GEMM_PHASE(pg8::EpiSwiglu, H, ws + WS_WUP2, T_, 2 * FF, DM, E); }
        GRID_SYNC();
        if (l + 1 < NL) { cvt_up1(P, l + 1, lds); __syncthreads(); }
        { pg8::EpiResid E{P.out, P.out, DM, 0.5f, (pg8::bf16_t*)H, SSB}; GEMM_PHASE(pg8::EpiResid, ACT, ws + WS_WDN2, T_, DM, FF, E); }
        GRID_SYNC();
    }
    rms_rows_f32_inplace(P.out, P.in[I_FINN]);
}

extern "C" void kernel_launch(void* const* d_in, const int* in_sizes, int n_in, void* d_out, int out_size, void* d_ws, size_t ws_size, hipStream_t stream) {
    static int grid_blocks = 0;
    if (grid_blocks == 0) {
        if (n_in != N_IN || out_size != T_ * DM || ws_size < WS_END) { fprintf(stderr, "kernel_launch: unexpected shapes (n_in %d, out %d, ws %zu < %zu)\n", n_in, out_size, ws_size, (size_t)WS_END); grid_blocks = -1; return; }
        int dev = 0, cus = 0, per_cu = 0;
        hipGetDevice(&dev);
        hipDeviceGetAttribute(&cus, hipDeviceAttributeMultiprocessorCount, dev);
        hipFuncSetAttribute((const void*)fwd_kernel, hipFuncAttributeMaxDynamicSharedMemorySize, LDS_BYTES);
        hipOccupancyMaxActiveBlocksPerMultiprocessor(&per_cu, (const void*)fwd_kernel, NTHREADS, LDS_BYTES);
        if (per_cu < 1) per_cu = 1;
        grid_blocks = cus * per_cu;
    }
    if (grid_blocks < 0) return;
    Params p{};
    for (int i = 0; i < N_IN; ++i) p.in[i] = (const float*)d_in[i];
    p.out = (float*)d_out; p.ws = (unsigned char*)d_ws;
    if (hipMemsetAsync((char*)d_ws + WS_BAR, 0, 4096, stream) != hipSuccess) { fprintf(stderr, "kernel_launch: hipMemsetAsync failed\n"); return; }
    void* args[] = {&p};
    hipError_t e = hipLaunchCooperativeKernel((const void*)fwd_kernel, dim3(grid_blocks), dim3(NTHREADS), args, LDS_BYTES, stream);
    if (e != hipSuccess) fprintf(stderr, "cooperative launch failed: %s (grid %d)\n", hipGetErrorString(e), grid_blocks);
}
```

```cpp
#include <hip/hip_runtime.h>
#include <hip/hip_cooperative_groups.h>
#include <cstdio>
#include <cstdint>
namespace cg = cooperative_groups;
namespace pg8 {
#define PG8_LAS __attribute__((address_space(3)))
typedef unsigned short bf16_t;
typedef short bf16x8 __attribute__((ext_vector_type(8)));
typedef float f32x4 __attribute__((ext_vector_type(4)));
typedef unsigned u32x4 __attribute__((ext_vector_type(4)));
constexpr int BM = 256, BK = 64, HALF = 128, HTB = HALF * BK * 2  , STAGE_BYTES = 8 * HTB, NXCD = 8, WGM = 8;

__host__ __device__ __forceinline__ int lds_byte(int r, int c) { const int st = (r >> 4) * 2 + (c >> 5), rr = r & 15, cc = c & 31, ob = rr * 64 + cc * 2; return st * 1024 + (ob ^ (((ob >> 9) & 1) << 5)); }
__host__ __device__ __forceinline__ void stage_rc(int b, int& R, int& C) { const int st = b / 1024, sb = b % 1024, swz = sb ^ (((sb >> 9) & 1) << 5); R = (st >> 1) * 16 + swz / 64; C = (st & 1) * 32 + (swz % 64) / 2; }
__host__ __device__ __forceinline__ int perm32(int rho) { const int n = rho >> 4, i = rho & 15; return 8 * (i >> 2) + 4 * n + (i & 3); }

struct Unit { int pm, pn; };
struct Gemm { const bf16_t* A; const bf16_t* Bt; int M, N, K; };

struct StaticOrder {
    int nM, nN, nwg, G, c;
    __host__ __device__ void init(int M, int N, int G_, int c_) { nM = M / BM; nN = N / BM; nwg = nM * nN; G = G_; c = c_; }
    __host__ __device__ bool next(int i, Unit& u) const {
        const long L = (long)i * G + c; if (L >= nwg) return false;
        int wgid = (int)L; { const int q = nwg / NXCD, r = nwg % NXCD, xcd = wgid % NXCD, off = wgid / NXCD; wgid = (xcd < r ? xcd * (q + 1) : r * (q + 1) + (xcd - r) * q) + off; }
        const int nig = WGM * nN, gid = wgid / nig, fm = gid * WGM, gsz = (nM - fm) < WGM ? (nM - fm) : WGM;
        u.pm = fm + ((wgid % nig) % gsz); u.pn = (wgid % nig) / gsz; return true;
    }
    __device__ __forceinline__ void a_ready(const Unit&) const {}
    __device__ __forceinline__ void done(const Unit&) const {}
};
typedef float f32x2_t __attribute__((ext_vector_type(2))); typedef __bf16 bf16x2_t __attribute__((ext_vector_type(2)));
__device__ __forceinline__ unsigned cvt_pk_bf16(float lo, float hi) { f32x2_t v = {lo, hi}; bf16x2_t b = __builtin_convertvector(v, bf16x2_t); return __builtin_bit_cast(unsigned, b); }
typedef float f32x2 __attribute__((ext_vector_type(2)));
__device__ __forceinline__ float fast_sigmoid(float x) { return __builtin_amdgcn_rcpf(1.0f + __builtin_amdgcn_exp2f(-1.4426950408889634f * x)); }
__device__ __forceinline__ float bf_lo(unsigned w) { return __uint_as_float(w << 16); }
__device__ __forceinline__ float bf_hi(unsigned w) { return __uint_as_float(w & 0xffff0000u); }

__device__ __forceinline__ float row_rs(const float* SS, int row) { const f32x4 a = *(const f32x4*)(SS + (size_t)row * 16), b2 = *(const f32x4*)(SS + (size_t)row * 16 + 4), c2 = *(const f32x4*)(SS + (size_t)row * 16 + 8), d = *(const f32x4*)(SS + (size_t)row * 16 + 12);
    const float s = ((a[0] + a[1]) + (a[2] + a[3])) + ((b2[0] + b2[1]) + (b2[2] + b2[3])) + ((c2[0] + c2[1]) + (c2[2] + c2[3])) + ((d[0] + d[1]) + (d[2] + d[3]));
    return 1.0f / sqrtf(s * (1.0f / 1024.0f) + 1e-6f); }
struct EpiSwiglu {
    static constexpr bool PERM = true, AFTER_DRAIN = false;
    bf16_t* O; int ldc; const float* SS;
    __device__ __forceinline__ void operator()(const f32x4 (&acc)[2][2][4][2], const Unit& u, int wr, int wc, int fr, int fq) const {
        const int row0 = u.pm * BM + wr * 64 + fr, col0 = u.pn * HALF + wc * 32 + 8 * fq;
#pragma unroll
        for (int ai = 0; ai < 2; ++ai)
#pragma unroll
            for (int m = 0; m < 4; ++m) {
                bf16_t* rowp = O + (size_t)(row0 + ai * HALF + m * 16) * ldc + col0;
                const float rs = row_rs(SS, row0 + ai * HALF + m * 16);
                float v[8];
#pragma unroll
                for (int n = 0; n < 2; ++n)
#pragma unroll
                    for (int j = 0; j < 4; ++j) { const float g = acc[ai][0][m][n][j] * rs, up = acc[ai][1][m][n][j] * rs; v[n * 4 + j] = g * fast_sigmoid(g) * up; }
                u32x4 w; w.x = cvt_pk_bf16(v[0], v[1]); w.y = cvt_pk_bf16(v[2], v[3]); w.z = cvt_pk_bf16(v[4], v[5]); w.w = cvt_pk_bf16(v[6], v[7]);
                *(u32x4*)rowp = w;
            }
    }
};
struct EpiResid {
    static constexpr bool PERM = false, AFTER_DRAIN = false;
    const float* src; float* dst; int ldc; float scale; bf16_t* XB; float* SS;
    __device__ __forceinline__ void operator()(const f32x4 (&acc)[2][2][4][2], const Unit& u, int wr, int wc, int fr, int fq) const {
        const int col0 = u.pn * BM + wc * 32 + 4 * fq;
        typedef unsigned u32x2 __attribute__((ext_vector_type(2)));
#pragma unroll
        for (int ai = 0; ai < 2; ++ai) {
#pragma unroll
          for (int mh = 0; mh < 4; mh += 2) {
            f32x4 pre[4][2][2];
#pragma unroll
            for (int m = mh; m < mh + 2; ++m) { const size_t off = (size_t)(u.pm * BM + ai * HALF + wr * 64 + m * 16 + fr) * ldc + col0;
#pragma unroll
                for (int bj = 0; bj < 2; ++bj)
#pragma unroll
                    for (int n = 0; n < 2; ++n) pre[m][bj][n] = *(const f32x4*)(src + off + bj * HALF + n * 16); }
            asm volatile("" ::: "memory");
#pragma unroll
            for (int m = mh; m < mh + 2; ++m) {
                const int row = u.pm * BM + ai * HALF + wr * 64 + m * 16 + fr;
                const size_t off = (size_t)row * ldc + col0; float sq = 0.f;
#pragma unroll
                for (int bj = 0; bj < 2; ++bj)
#pragma unroll
                    for (int n = 0; n < 2; ++n) { const f32x4 x = pre[m][bj][n] + acc[ai][bj][m][n] * scale;
                        *(f32x4*)(dst + off + bj * HALF + n * 16) = x; sq += (x[0] * x[0] + x[1] * x[1]) + (x[2] * x[2] + x[3] * x[3]);
                        *(u32x2*)(XB + off + bj * HALF + n * 16) = (u32x2){cvt_pk_bf16(x[0], x[1]), cvt_pk_bf16(x[2], x[3])}; }
                sq += __shfl_xor(sq, 16); sq += __shfl_xor(sq, 32);
                if (fq == 0) SS[(size_t)row * 16 + u.pn * 4 + wc] = sq;
            }
            asm volatile("" ::: "memory");
          }
        }
    }
};
struct EpiWin {
    static constexpr bool PERM = true, AFTER_DRAIN = false;
    bf16_t *PR, *QB, *KVB, *QC, *KVC; const float* SS;
    __device__ __forceinline__ void operator()(const f32x4 (&acc)[2][2][4][2], const Unit& u, int wr, int wc, int fr, int fq) const {
        bf16_t* base; int ldc, colt;
        const int pn = u.pn;
        if (pn < 8) { base = PR; ldc = 2048; colt = pn * 256; }
        else if (pn < 10) { base = QB; ldc = 512; colt = (pn - 8) * 256; }
        else if (pn == 10) { base = KVB; ldc = 256; colt = 0; }
        else if (pn < 13) { base = QC; ldc = 512; colt = (pn - 11) * 256; }
        else { base = KVC; ldc = 256; colt = 0; }
        const int row0 = u.pm * BM + wr * 64 + fr, col0 = colt + wc * 32 + 8 * fq;
#pragma unroll
        for (int ai = 0; ai < 2; ++ai)
#pragma unroll
            for (int m = 0; m < 4; ++m) {
                bf16_t* rowp = base + (size_t)(row0 + ai * HALF + m * 16) * ldc + col0;
                const float rs = row_rs(SS, row0 + ai * HALF + m * 16);
#pragma unroll
                for (int bj = 0; bj < 2; ++bj) { const f32x4 v0 = acc[ai][bj][m][0] * rs, v1 = acc[ai][bj][m][1] * rs;
                    u32x4 w; w.x = cvt_pk_bf16(v0[0], v0[1]); w.y = cvt_pk_bf16(v0[2], v0[3]); w.z = cvt_pk_bf16(v1[0], v1[1]); w.w = cvt_pk_bf16(v1[2], v1[3]);
                    *(u32x4*)(rowp + bj * HALF) = w; }
            }
    }
};
struct EpiGate {
    static constexpr bool PERM = true, AFTER_DRAIN = false;
    bf16_t* G; const float* SS;
    __device__ __forceinline__ void operator()(const f32x4 (&acc)[2][2][4][2], const Unit& u, int wr, int wc, int fr, int fq) const {
        const int row0 = u.pm * BM + wr * 64 + fr, col0 = u.pn * BM + wc * 32 + 8 * fq;
#pragma unroll
        for (int ai = 0; ai < 2; ++ai)
#pragma unroll
            for (int m = 0; m < 4; ++m) {
                bf16_t* rowp = G + (size_t)(row0 + ai * HALF + m * 16) * 1024 + col0;
                const float rs = row_rs(SS, row0 + ai * HALF + m * 16);
#pragma unroll
                for (int bj = 0; bj < 2; ++bj) { const f32x4 v0 = acc[ai][bj][m][0] * rs, v1 = acc[ai][bj][m][1] * rs;
                    u32x4 w; w.x = cvt_pk_bf16(fast_sigmoid(v0[0]), fast_sigmoid(v0[1])); w.y = cvt_pk_bf16(fast_sigmoid(v0[2]), fast_sigmoid(v0[3]));
                    w.z = cvt_pk_bf16(fast_sigmoid(v1[0]), fast_sigmoid(v1[1])); w.w = cvt_pk_bf16(fast_sigmoid(v1[2]), fast_sigmoid(v1[3]));
                    *(u32x4*)(rowp + bj * HALF) = w; }
            }
    }
};
struct EpiMerge {
    static constexpr bool PERM = true, AFTER_DRAIN = false;
    const bf16_t* G; bf16_t* Mg; int first;
    __device__ __forceinline__ void operator()(const f32x4 (&acc)[2][2][4][2], const Unit& u, int wr, int wc, int fr, int fq) const {
        const int row0 = u.pm * BM + wr * 64 + fr, col0 = u.pn * BM + wc * 32 + 8 * fq;
#pragma unroll
        for (int ai = 0; ai < 2; ++ai) {
#pragma unroll
          for (int mh = 0; mh < 4; mh += 2) {
            u32x4 gq[4][2], pq[4][2];
#pragma unroll
            for (int m = mh; m < mh + 2; ++m) { const size_t off = (size_t)(row0 + ai * HALF + m * 16) * 1024 + col0;
#pragma unroll
                for (int bj = 0; bj < 2; ++bj) { gq[m][bj] = __builtin_nontemporal_load((const u32x4*)(G + off + bj * HALF));
                    pq[m][bj] = first ? (u32x4){0u, 0u, 0u, 0u} : __builtin_nontemporal_load((const u32x4*)(Mg + off + bj * HALF)); } }
            asm volatile("" ::: "memory");
#pragma unroll
            for (int m = mh; m < mh + 2; ++m) {
                const size_t off = (size_t)(row0 + ai * HALF + m * 16) * 1024 + col0;
#pragma unroll
                for (int bj = 0; bj < 2; ++bj) { const f32x4 v0 = acc[ai][bj][m][0], v1 = acc[ai][bj][m][1];
                    const u32x4 g = gq[m][bj], p = pq[m][bj];
                    float r[8];
                    r[0] = bf_lo(g.x) * v0[0] + bf_lo(p.x); r[1] = bf_hi(g.x) * v0[1] + bf_hi(p.x); r[2] = bf_lo(g.y) * v0[2] + bf_lo(p.y); r[3] = bf_hi(g.y) * v0[3] + bf_hi(p.y);
                    r[4] = bf_lo(g.z) * v1[0] + bf_lo(p.z); r[5] = bf_hi(g.z) * v1[1] + bf_hi(p.z); r[6] = bf_lo(g.w) * v1[2] + bf_lo(p.w); r[7] = bf_hi(g.w) * v1[3] + bf_hi(p.w);
                    u32x4 w; w.x = cvt_pk_bf16(r[0], r[1]); w.y = cvt_pk_bf16(r[2], r[3]); w.z = cvt_pk_bf16(r[4], r[5]); w.w = cvt_pk_bf16(r[6], r[7]);
                    *(u32x4*)(Mg + off + bj * HALF) = w; }
            }
            asm volatile("" ::: "memory");
          }
        }
    }
};
template <class Epi, class Sched, bool ALIGN_EPI = false, bool SP2 = false>
__device__ __forceinline__ void gemm_phase(PG8_LAS unsigned char* lds, const Gemm g, const Sched& S, const Epi& E) {
    int tid_o = threadIdx.x; asm volatile("" : "+v"(tid_o));
    const int tid = tid_o, wid = __builtin_amdgcn_readfirstlane(tid >> 6), lane = tid & 63, wr = wid >> 2, wc = wid & 3, fr = lane & 15, fq = lane >> 4;
    const int K = g.K, nt = K / BK;
    unsigned voffA[2], voffB[2];
#pragma unroll
    for (int i = 0; i < 2; ++i) { int R, C; stage_rc(tid * 16 + i * 8192, R, C); const int Rb = Epi::PERM ? ((R & ~31) + perm32(R & 31)) : R;
        voffA[i] = (unsigned)(R * K + C) * 2u; voffB[i] = (unsigned)(Rb * K + C) * 2u; }
    const size_t kstep = (size_t)(BK * 2);
    const size_t hstep = (size_t)HALF * K * 2;
    const size_t tstep = 2 * hstep;
    const unsigned ldsw = (unsigned)wid * 1024u;
    const int aoff = lds_byte(wr * 64 + fr, fq * 8), boff = lds_byte(wc * 32 + fr, fq * 8);
#define PG8_SA(b, h) (((b) * 2 + (h)) * HTB)
#define PG8_SB(b, h) ((4 + (b) * 2 + (h)) * HTB)
#define PG8_STAGE(bufoff, gbase, voff) do { _Pragma("unroll") for (int _i = 0; _i < 2; ++_i) \
        __builtin_amdgcn_global_load_lds((const unsigned*)((const char*)(gbase) + (voff)[_i]), (PG8_LAS unsigned*)(lds + (bufoff) + ldsw + _i * 8192), 16, 0, 0); } while (0)
#define PG8_LDA(dst, b, h) do { _Pragma("unroll") for (int m = 0; m < 4; ++m) _Pragma("unroll") for (int k = 0; k < 2; ++k) dst[m][k] = *(const PG8_LAS bf16x8*)(lds + PG8_SA(b, h) + aoff + m * 2048 + k * 1024); } while (0)
#define PG8_LDB(dst, b, h) do { _Pragma("unroll") for (int n = 0; n < 2; ++n) _Pragma("unroll") for (int k = 0; k < 2; ++k) dst[n][k] = *(const PG8_LAS bf16x8*)(lds + PG8_SB(b, h) + boff + n * 2048 + k * 1024); } while (0)
#define PG8_MMA(ai, bj, At, Bt) do { __builtin_amdgcn_s_setprio(1); _Pragma("unroll") for (int m = 0; m < 4; ++m) _Pragma("unroll") for (int n = 0; n < 2; ++n) _Pragma("unroll") for (int k = 0; k < 2; ++k) \
        acc[ai][bj][m][n] = __builtin_amdgcn_mfma_f32_16x16x32_bf16(Bt[n][k], At[m][k], acc[ai][bj][m][n], 0, 0, 0); __builtin_amdgcn_s_setprio(0); } while (0)
#define PG8_WAIT_V(n) asm volatile("s_waitcnt vmcnt(" #n ")" ::: "memory")
#define PG8_WAIT_L(n) asm volatile("s_waitcnt lgkmcnt(" #n ")" ::: "memory")
#define PG8_BAR __builtin_amdgcn_s_barrier()
#define PG8_SCHED __builtin_amdgcn_sched_barrier(0)
    Unit cur, nxt; int ui = 0;
    if (!S.next(0, cur)) return;
    f32x4 acc[2][2][4][2];
#pragma unroll
    for (int a = 0; a < 2; ++a)
#pragma unroll
        for (int b = 0; b < 2; ++b)
#pragma unroll
            for (int m = 0; m < 4; ++m)
#pragma unroll
                for (int n = 0; n < 2; ++n) acc[a][b][m][n] = (f32x4){0.f, 0.f, 0.f, 0.f};
    bf16x8 At[4][2], B0[2][2], B1[2][2];
    const char* cA = (const char*)g.A + (size_t)cur.pm * tstep; const char* cB = (const char*)g.Bt + (size_t)cur.pn * tstep;
    S.a_ready(cur);
    if constexpr (SP2) {
        PG8_STAGE(PG8_SB(0, 0), cB, voffB); PG8_STAGE(PG8_SB(0, 1), cB + hstep, voffB); PG8_STAGE(PG8_SA(0, 0), cA, voffA); PG8_STAGE(PG8_SA(0, 1), cA + hstep, voffA);
        if (wr == 1) PG8_BAR;
        PG8_WAIT_V(2); PG8_BAR;
        PG8_STAGE(PG8_SB(1, 0), cB + kstep, voffB); PG8_STAGE(PG8_SA(1, 0), cA + kstep, voffA); PG8_STAGE(PG8_SB(1, 1), cB + hstep + kstep, voffB);
        PG8_WAIT_V(6); PG8_BAR;
    } else {
        PG8_STAGE(PG8_SB(0, 0), cB, voffB); PG8_STAGE(PG8_SA(0, 0), cA, voffA); PG8_STAGE(PG8_SB(0, 1), cB + hstep, voffB); PG8_STAGE(PG8_SA(0, 1), cA + hstep, voffA);
        if (wr == 1) PG8_BAR;
        PG8_WAIT_V(4); PG8_BAR;
        PG8_STAGE(PG8_SB(1, 0), cB + kstep, voffB); PG8_STAGE(PG8_SA(1, 0), cA + kstep, voffA); PG8_STAGE(PG8_SB(1, 1), cB + hstep + kstep, voffB);
        PG8_WAIT_V(6); PG8_BAR;
    }
    for (;;) {
        const bool has_next = S.next(ui + 1, nxt);
        const char* nA = has_next ? (const char*)g.A + (size_t)nxt.pm * tstep : cA; const char* nB = has_next ? (const char*)g.Bt + (size_t)nxt.pn * tstep : cB;
        for (int t = 0; t < nt; t += 2) {
            const bool last = (t == nt - 2);
            const char* a1 = cA + (size_t)(t + 1) * kstep;
            const char* a2 = last ? nA : cA + (size_t)(t + 2) * kstep; const char* b2 = last ? nB : cB + (size_t)(t + 2) * kstep;
            const char* a3 = a2 + kstep; const char* b3 = b2 + kstep;
            if (last && has_next) S.a_ready(nxt);
            if constexpr (SP2) {
            PG8_LDB(B0, 0, 0); PG8_LDB(B1, 0, 1); PG8_SCHED; PG8_LDA(At, 0, 0); PG8_STAGE(PG8_SA(1, 1), a1 + hstep, voffA);
            PG8_WAIT_V(8); PG8_WAIT_L(0); PG8_BAR; PG8_MMA(0, 0, At, B0); PG8_MMA(0, 1, At, B1); PG8_BAR; PG8_SCHED;
            PG8_LDA(At, 0, 1); PG8_STAGE(PG8_SB(0, 0), b2, voffB); PG8_STAGE(PG8_SB(0, 1), b2 + hstep, voffB); PG8_STAGE(PG8_SA(0, 0), a2, voffA);
            PG8_WAIT_V(8); PG8_WAIT_L(0); PG8_BAR; PG8_MMA(1, 0, At, B0); PG8_MMA(1, 1, At, B1); PG8_BAR; PG8_SCHED;
            PG8_LDB(B0, 1, 0); PG8_LDB(B1, 1, 1); PG8_SCHED; PG8_LDA(At, 1, 0); PG8_STAGE(PG8_SA(0, 1), a2 + hstep, voffA);
            PG8_WAIT_V(8); PG8_WAIT_L(0); PG8_BAR; PG8_MMA(0, 0, At, B0); PG8_MMA(0, 1, At, B1); PG8_BAR; PG8_SCHED;
            PG8_LDA(At, 1, 1); PG8_STAGE(PG8_SB(1, 0), b3, voffB); PG8_STAGE(PG8_SB(1, 1), b3 + hstep, voffB); PG8_STAGE(PG8_SA(1, 0), a3, voffA);
            PG8_WAIT_V(8); PG8_WAIT_L(0); PG8_BAR; PG8_MMA(1, 0, At, B0); PG8_MMA(1, 1, At, B1); PG8_BAR; PG8_SCHED;
            } else {
            PG8_LDB(B0, 0, 0); PG8_SCHED; PG8_LDA(At, 0, 0); PG8_STAGE(PG8_SA(1, 1), a1 + hstep, voffA);
            PG8_WAIT_L(8); PG8_BAR; PG8_WAIT_L(0); PG8_MMA(0, 0, At, B0); PG8_BAR; PG8_SCHED;
            PG8_LDB(B1, 0, 1); PG8_STAGE(PG8_SB(0, 0), b2, voffB);
            PG8_BAR; PG8_WAIT_L(0); PG8_MMA(0, 1, At, B1); PG8_BAR;
            PG8_LDA(At, 0, 1); PG8_STAGE(PG8_SA(0, 0), a2, voffA);
            PG8_BAR; PG8_WAIT_L(0); PG8_MMA(1, 0, At, B0); PG8_BAR; PG8_SCHED;
            PG8_STAGE(PG8_SB(0, 1), b2 + hstep, voffB);
            PG8_WAIT_V(6); PG8_BAR; PG8_MMA(1, 1, At, B1); PG8_BAR;
            PG8_LDB(B0, 1, 0); PG8_SCHED; PG8_LDA(At, 1, 0); PG8_STAGE(PG8_SA(0, 1), a2 + hstep, voffA);
            PG8_WAIT_L(8); PG8_BAR; PG8_WAIT_L(0); PG8_MMA(0, 0, At, B0); PG8_BAR; PG8_SCHED;
            PG8_LDB(B1, 1, 1); PG8_STAGE(PG8_SB(1, 0), b3, voffB);
            PG8_BAR; PG8_WAIT_L(0); PG8_MMA(0, 1, At, B1); PG8_BAR;
            PG8_LDA(At, 1, 1); PG8_STAGE(PG8_SA(1, 0), a3, voffA);
            PG8_BAR; PG8_WAIT_L(0); PG8_MMA(1, 0, At, B0); PG8_BAR; PG8_SCHED;
            PG8_STAGE(PG8_SB(1, 1), b3 + hstep, voffB);
            PG8_WAIT_V(6); PG8_BAR; PG8_MMA(1, 1, At, B1); PG8_BAR;
            }
        }
        if constexpr (ALIGN_EPI) { if (wr == 0) PG8_BAR; }
        if constexpr (!Epi::AFTER_DRAIN) { E(acc, cur, wr, wc, fr, fq); S.done(cur); }
        if (!has_next) break;
#pragma unroll
        for (int a = 0; a < 2; ++a)
#pragma unroll
            for (int b = 0; b < 2; ++b)
#pragma unroll
                for (int m = 0; m < 4; ++m)
#pragma unroll
                    for (int n = 0; n < 2; ++n) acc[a][b][m][n] = (f32x4){0.f, 0.f, 0.f, 0.f};
        cur = nxt; cA = nA; cB = nB; ++ui;
        if constexpr (ALIGN_EPI) { if (wr == 1) PG8_BAR; }
    }
    PG8_WAIT_V(0);
    if constexpr (!ALIGN_EPI) { if (wr == 0) PG8_BAR; }
    PG8_BAR;
    if constexpr (Epi::AFTER_DRAIN) { E.fused(acc, cur, wr, wc, fr, fq, lds, wid, lane); S.done(cur); }
#undef PG8_SA
#undef PG8_SB
#undef PG8_STAGE
#undef PG8_LDA
#undef PG8_LDB
#undef PG8_MMA
#undef PG8_WAIT_V
#undef PG8_WAIT_L
#undef PG8_BAR
#undef PG8_SCHED
}
}
#define LAS __attribute__((address_space(3)))
typedef unsigned short bf16;
typedef unsigned v4u __attribute__((ext_vector_type(4)));
typedef unsigned v2u __attribute__((ext_vector_type(2)));
typedef float f4 __attribute__((ext_vector_type(4)));
constexpr int T_ = 32768, S_ = 2048, NB = 16, DM = 1024, FF = 2816, NL = 4;
constexpr int NWAVES = 8, NTHREADS = 512;
constexpr int LDS_BYTES = 163840;
constexpr float LOG2E = 1.4426950408889634f;
constexpr float C2 = 0.125f * LOG2E;
constexpr float LOG2_THETA = 13.287712379549449f;

enum { I_X = 0, I_F1N, I_F1UP, I_F1DN, I_MIXN, I_WIN, I_MU, I_W0, I_W2, I_A0, I_A2, I_G2, I_KK, I_KA, I_RK, I_LNG, I_LNB, I_QN, I_KN, I_SINK,
       I_WOA, I_WOB, I_WOC, I_WOUT, I_F2N, I_F2UP, I_F2DN, I_FINN, N_IN };

constexpr size_t SZ_WUP = (size_t)2 * FF * DM * 2, SZ_WDN = (size_t)DM * FF * 2, SZ_WIN = (size_t)3584 * DM * 2, SZ_WG = (size_t)3072 * DM * 2,
                 SZ_WO = (size_t)3 * DM * 512 * 2, SZ_WOUT = (size_t)DM * DM * 2;
constexpr size_t WS_WUP1 = 0, WS_WDN1 = WS_WUP1 + SZ_WUP, WS_WIN = WS_WDN1 + SZ_WDN, WS_WG = WS_WIN + SZ_WIN, WS_WO = WS_WG + SZ_WG, WS_WOUT = WS_WO + SZ_WO,
                 WS_WUP2 = WS_WOUT + SZ_WOUT, WS_WDN2 = WS_WUP2 + SZ_WUP, WS_H = WS_WDN2 + SZ_WDN;
constexpr size_t WS_R = WS_H + (size_t)T_ * DM * 2;
constexpr size_t WS_ACT = WS_R;
constexpr size_t WS_PR = WS_R, WS_QB = WS_PR + (size_t)T_ * 2048 * 2, WS_KVB = WS_QB + (size_t)T_ * 512 * 2, WS_QC = WS_KVB + (size_t)T_ * 256 * 2, WS_KVC = WS_QC + (size_t)T_ * 512 * 2,
                 WS_KG = WS_KVC + (size_t)T_ * 256 * 2, WS_VG = WS_KG + (size_t)NB * 2 * S_ * 64 * 2, WS_KW = WS_VG + (size_t)NB * 2 * S_ * 64 * 2, WS_VW = WS_KW + (size_t)NB * 2 * S_ * 64 * 2,
                 WS_YA = WS_VW + (size_t)NB * 2 * S_ * 64 * 2, WS_WKVF = WS_YA + (size_t)T_ * 512 * 2, WS_WKVB = WS_WKVF + (size_t)T_ * 512 * 2, WS_BONUS = WS_WKVB + (size_t)T_ * 512 * 2,
                 WS_SCR = WS_BONUS + (size_t)T_ * 16 * 4, WS_SS = WS_SCR, WS_WUP1B = WS_SS + (size_t)T_ * 16 * 4, WS_BAR = WS_WUP1B + SZ_WUP, WS_END = WS_BAR + 4096;
constexpr size_t WS_GATE = WS_PR, WS_MERGED = WS_PR + (size_t)T_ * DM * 2;
static_assert(WS_ACT + (size_t)T_ * FF * 2 <= WS_END, "map");
static_assert(WS_END < 536000000ull, "workspace budget");

struct Params { const float* in[N_IN]; float* out; unsigned char* ws; };

__device__ __forceinline__ unsigned f2bf(float f) { unsigned u = __float_as_uint(f); return (u + 0x7fffu + ((u >> 16) & 1u)) >> 16; }
__device__ __forceinline__ unsigned pk2(float lo, float hi) { return f2bf(lo) | (f2bf(hi) << 16); }
__device__ __forceinline__ float bf2f(bf16 h) { return __uint_as_float((unsigned)h << 16); }
__device__ __forceinline__ int opaque_tid() { int t = threadIdx.x; asm volatile("" : "+v"(t)); return t; }
#define STAGE_IDS const int tid = opaque_tid(), lane = tid & 63, wave = __builtin_amdgcn_readfirstlane(tid >> 6); const int gw = blockIdx.x * NWAVES + wave, ngw = gridDim.x * NWAVES, gtid = blockIdx.x * NTHREADS + tid, gthreads = gridDim.x * NTHREADS; (void)lane; (void)gw; (void)ngw; (void)gtid; (void)gthreads;
__device__ __forceinline__ float wave_sum(float v) {
#pragma unroll
    for (int o = 1; o < 64; o <<= 1) v += __shfl_xor(v, o);
    return v;
}

__device__ __forceinline__ void cvt_wt(const float* W, int K, int ld, bf16* Wt, int nrows, int mode, int gw, int ngw, int lane, float* scr, const float* gain = nullptr) {
    const int nblk = nrows >> 5, nitems = (K >> 6) * nblk;
    for (int it = gw; it < nitems; it += ngw) {
        const int kb = it / nblk, nb = it % nblk, k0 = kb * 64, n0 = nb * 32;
        int col0;
        if (mode == 0) col0 = n0;
        else if (mode == 1) { const int t = n0 >> 8, r = n0 & 255; col0 = (r < 128) ? t * 128 + r : FF + t * 128 + (r - 128); }
        else if (mode == 2) col0 = n0 < 1920 ? n0 : (n0 < 2048 ? -1 : n0 - 128);
        else col0 = 3456 + n0;
        if (col0 >= 0) {
#pragma unroll 8
            for (int i = 0; i < 32; ++i) { const int kk = 2 * i + (lane >> 5); scr[kk * 33 + (lane & 31)] = W[(size_t)(k0 + kk) * ld + col0 + (lane & 31)] * (gain ? gain[k0 + kk] : 1.0f); }
        }
        asm volatile("s_waitcnt lgkmcnt(0)" ::: "memory");
        const int c = lane & 7;
#pragma unroll
        for (int j = 0; j < 4; ++j) { const int n = (lane >> 3) + 8 * j; const float* sp = scr + (8 * c) * 33 + n;
            v4u o = (v4u){0u, 0u, 0u, 0u};
            if (col0 >= 0) { o.x = pk2(sp[0 * 33], sp[1 * 33]); o.y = pk2(sp[2 * 33], sp[3 * 33]); o.z = pk2(sp[4 * 33], sp[5 * 33]); o.w = pk2(sp[6 * 33], sp[7 * 33]); }
            *(v4u*)(Wt + (size_t)(n0 + n) * K + k0 + 8 * c) = o; }
        asm volatile("s_waitcnt lgkmcnt(0)" ::: "memory");
    }
}
__device__ __forceinline__ void cvt_up1(const Params& P, int l, unsigned char* ldsg) {
    STAGE_IDS
    unsigned char* ws = P.ws; float* scr = (float*)(ldsg + wave * 8448);
    cvt_wt(P.in[I_F1UP] + (size_t)l * DM * 2 * FF, DM, 2 * FF, (bf16*)(ws + ((l & 1) ? WS_WUP1B : WS_WUP1)), 2 * FF, 1, gw, ngw, lane, scr, P.in[I_F1N] + l * DM);
}
__device__ __forceinline__ void cvt_rest(const Params& P, int l, unsigned char* ldsg) {
    STAGE_IDS
    unsigned char* ws = P.ws; float* scr = (float*)(ldsg + wave * 8448);
    cvt_wt(P.in[I_F1DN] + (size_t)l * FF * DM, FF, DM, (bf16*)(ws + WS_WDN1), DM, 0, gw, ngw, lane, scr);
    cvt_wt(P.in[I_WIN] + (size_t)l * DM * 6528, DM, 6528, (bf16*)(ws + WS_WIN), 3584, 2, gw, ngw, lane, scr, P.in[I_MIXN] + l * DM);
    cvt_wt(P.in[I_WIN] + (size_t)l * DM * 6528, DM, 6528, (bf16*)(ws + WS_WG), 3072, 3, gw, ngw, lane, scr, P.in[I_MIXN] + l * DM);
    cvt_wt(P.in[I_WOA] + (size_t)l * 512 * DM, 512, DM, (bf16*)(ws + WS_WO), DM, 0, gw, ngw, lane, scr);
    cvt_wt(P.in[I_WOB] + (size_t)l * 512 * DM, 512, DM, (bf16*)(ws + WS_WO) + (size_t)DM * 512, DM, 0, gw, ngw, lane, scr);
    cvt_wt(P.in[I_WOC] + (size_t)l * 512 * DM, 512, DM, (bf16*)(ws + WS_WO) + (size_t)2 * DM * 512, DM, 0, gw, ngw, lane, scr);
    cvt_wt(P.in[I_WOUT] + (size_t)l * DM * DM, DM, DM, (bf16*)(ws + WS_WOUT), DM, 0, gw, ngw, lane, scr);
    cvt_wt(P.in[I_F2UP] + (size_t)l * DM * 2 * FF, DM, 2 * FF, (bf16*)(ws + WS_WUP2), 2 * FF, 1, gw, ngw, lane, scr, P.in[I_F2N] + l * DM);
    cvt_wt(P.in[I_F2DN] + (size_t)l * FF * DM, FF, DM, (bf16*)(ws + WS_WDN2), DM, 0, gw, ngw, lane, scr);
}
__device__ __forceinline__ void x_to_bf16_ss(const float* x, bf16* o, float* SS) {
    STAGE_IDS
    for (int m = gw; m < T_; m += ngw) {
        const f4* xr = (const f4*)(x + (size_t)m * DM) + lane; f4 v[4]; float s = 0.f;
#pragma unroll
        for (int j = 0; j < 4; ++j) { v[j] = xr[64 * j]; s += (v[j].x * v[j].x + v[j].y * v[j].y) + (v[j].z * v[j].z + v[j].w * v[j].w); }
        s = wave_sum(s);
        v2u* op = (v2u*)(o + (size_t)m * DM) + lane;
#pragma unroll
        for (int j = 0; j < 4; ++j) { v2u w; w.x = pk2(v[j].x, v[j].y); w.y = pk2(v[j].z, v[j].w); op[64 * j] = w; }
        if (lane < 16) SS[(size_t)m * 16 + lane] = lane == 0 ? s : 0.f;
    }
}

__device__ __forceinline__ void rms_rows_f32_inplace(float* x, const float* g) {
    STAGE_IDS
    const f4* gr = (const f4*)g + lane; f4 gv[4];
#pragma unroll
    for (int j = 0; j < 4; ++j) gv[j] = gr[64 * j];
    for (int m = gw; m < T_; m += ngw) {
        f4* xr = (f4*)(x + (size_t)m * DM) + lane; f4 v[4]; float s = 0.f;
#pragma unroll
        for (int j = 0; j < 4; ++j) { v[j] = xr[64 * j]; s += (v[j].x * v[j].x + v[j].y * v[j].y) + (v[j].z * v[j].z + v[j].w * v[j].w); }
        const float rs = 1.0f / sqrtf(wave_sum(s) * (1.0f / DM) + 1e-6f);
#pragma unroll
        for (int j = 0; j < 4; ++j) xr[64 * j] = v[j] * rs * gv[j];
    }
}

__device__ __forceinline__ float fast_sin_rev(float rev) { return __builtin_amdgcn_sinf(__builtin_amdgcn_fractf(rev)); }
__device__ __forceinline__ float fast_cos_rev(float rev) { return __builtin_amdgcn_cosf(__builtin_amdgcn_fractf(rev)); }
__device__ __forceinline__ void qkprep(const Params& P, int l, bool dummy = false) {
    STAGE_IDS
    unsigned char* ws = P.ws;
    bf16* QB = (bf16*)(ws + WS_QB); const bf16* KVB = (const bf16*)(ws + WS_KVB); bf16* QC = (bf16*)(ws + WS_QC); const bf16* KVC = (const bf16*)(ws + WS_KVC);
    bf16* KG = (bf16*)(ws + WS_KG); bf16* KW = (bf16*)(ws + WS_KW);
    const float qg = P.in[I_QN][l * 64 + lane], kg = P.in[I_KN][l * 64 + lane];
    const float inv_ax = exp2f(-(float)(lane & 15) * (LOG2_THETA / 16.0f)), inv_1d = exp2f(-(float)(lane & 31) * (LOG2_THETA / 32.0f));
    const float INV2PI = 0.15915494309189535f;
    for (int t = gw; t < T_; t += ngw) {
        const int b = t >> 11, s = t & 2047;
        const float pos = lane < 32 ? (float)(s >> 6) : (float)(s & 63);
        const float ra = (pos * inv_ax) * INV2PI, r1 = ((float)s * inv_1d) * INV2PI;
        const float csa = fast_cos_rev(ra), sna = (lane & 16) ? fast_sin_rev(ra) : -fast_sin_rev(ra);
        const float cs1 = fast_cos_rev(r1), sn1 = (lane & 32) ? fast_sin_rev(r1) : -fast_sin_rev(r1);
#pragma unroll
        for (int slot = 0; slot < 10; ++slot) {
            bf16* src = slot < 8 ? QB + (size_t)t * 512 + slot * 64 : (bf16*)KVB + (size_t)t * 256 + (slot - 8) * 64;
            const float x = bf2f(src[lane]);
            const float ss = wave_sum(x * x) * (1.0f / 64.0f);
            const float y = x * (1.0f / sqrtf(ss + 1e-6f)) * (slot < 8 ? qg : kg);
            const float r = y * csa + __shfl_xor(y, 16) * sna;
            if (slot < 8) (dummy ? (bf16*)(ws + WS_YA) + (size_t)t * 512 + slot * 64 : src)[lane] = (bf16)f2bf(r * C2);
            else KG[((size_t)(b * 2 + (slot - 8)) * S_ + s) * 64 + lane] = (bf16)f2bf(r);
        }
#pragma unroll
        for (int slot = 0; slot < 10; ++slot) {
            bf16* src = slot < 8 ? QC + (size_t)t * 512 + slot * 64 : (bf16*)KVC + (size_t)t * 256 + (slot - 8) * 64;
            const float x = bf2f(src[lane]);
            const float r = x * cs1 + __shfl_xor(x, 32) * sn1;
            if (slot < 8) (dummy ? (bf16*)(ws + WS_YA) + (size_t)t * 512 + slot * 64 : src)[lane] = (bf16)f2bf(r * C2);
            else KW[((size_t)(b * 2 + (slot - 8)) * S_ + s) * 64 + lane] = (bf16)f2bf(r);
        }
    }
}

__device__ __forceinline__ void vt_prep(const Params& P, unsigned char* ldsg) {
    STAGE_IDS
    unsigned char* ws = P.ws;
    bf16* tile = (bf16*)(ldsg + wave * 8448);
    for (int it = gw; it < 2 * NB * 2 * 32; it += ngw) {
        const int tb = it & 31, kvh = (it >> 5) & 1, b = (it >> 6) & 15, att = it >> 10;
        const bf16* src = (const bf16*)(ws + (att ? WS_KVC : WS_KVB)) + (size_t)(b * S_ + tb * 64) * 256 + 128 + kvh * 64;
        bf16* dst = (bf16*)(ws + (att ? WS_VW : WS_VG)) + (size_t)(b * 2 + kvh) * 64 * S_ + tb * 64;
#pragma unroll 8
        for (int r = 0; r < 64; ++r) tile[r * 66 + lane] = src[(size_t)r * 256 + lane];
        asm volatile("s_waitcnt lgkmcnt(0)" ::: "memory");
#pragma unroll 8
        for (int d = 0; d < 64; ++d) dst[(size_t)d * S_ + lane] = tile[lane * 66 + d];
        asm volatile("s_waitcnt lgkmcnt(0)" ::: "memory");
    }
}

typedef short bf16x8_t __attribute__((ext_vector_type(8)));
typedef short s16x4_t __attribute__((ext_vector_type(4)));
typedef float f32x16 __attribute__((ext_vector_type(16)));
typedef float f32x2a __attribute__((ext_vector_type(2))); typedef __bf16 bf16x2a __attribute__((ext_vector_type(2)));
__device__ __forceinline__ unsigned cvtpk(float lo, float hi) { f32x2a v = {lo, hi}; bf16x2a b = __builtin_convertvector(v, bf16x2a); return __builtin_bit_cast(unsigned, b); }
__device__ __forceinline__ int crow(int r, int hi) { return (r & 3) + 8 * (r >> 2) + 4 * hi; }
template <bool WINDOW>
__device__ __forceinline__ void attn_mfma(bf16* Q, const bf16* Kx, const bf16* VTx, const float* sink, unsigned char* ldsg, bf16* Oalt = nullptr) {
    STAGE_IDS
    const int r32 = lane & 31, hi = lane >> 5, g = wave >> 1, qs = wave & 1;
    const int srow = tid >> 3, sch = tid & 7;
    for (int unit = blockIdx.x; unit < 1024; unit += gridDim.x) {
        const int qb = unit & 31, kvh = (unit >> 5) & 1, b = unit >> 6, h = kvh * 4 + g, q0 = qb * 64 + qs * 32;
        bf16* qp = Q + ((size_t)(b * S_ + q0 + r32)) * 512 + h * 64;
        bf16x8_t qr[4];
#pragma unroll
        for (int d0 = 0; d0 < 4; ++d0) qr[d0] = *(const bf16x8_t*)(qp + 16 * d0 + 8 * hi);
        f32x16 o0, o1;
#pragma unroll
        for (int r = 0; r < 16; ++r) { o0[r] = 0.f; o1[r] = 0.f; }
        float m, l;
        if (WINDOW) { m = sink[h] * LOG2E; l = hi == 0 ? 1.0f : 0.f; } else { m = -1e30f; l = 0.f; }
        const int t0 = WINDOW ? (qb - 2 > 0 ? qb - 2 : 0) : 0, t1 = WINDOW ? (qb + 2 < 31 ? qb + 2 : 31) : 31;
        const bf16* kbase = Kx + (size_t)(b * 2 + kvh) * S_ * 64 + (size_t)srow * 64 + sch * 8;
        const bf16* vbase = VTx + (size_t)(b * 2 + kvh) * 64 * S_ + (size_t)srow * S_ + sch * 8;
        v4u kreg = *(const v4u*)(kbase + (size_t)t0 * 64 * 64);
        v4u vreg = *(const v4u*)(vbase + t0 * 64);
        __syncthreads();
        *(v4u*)(ldsg + srow * 144 + sch * 16) = kreg;
        *(v4u*)(ldsg + 9216 + srow * 144 + sch * 16) = vreg;
        __syncthreads();
        for (int t = t0; t <= t1; ++t) {
            const int buf = (t - t0) & 1;
            if (t < t1) { kreg = *(const v4u*)(kbase + (size_t)(t + 1) * 64 * 64); vreg = *(const v4u*)(vbase + (t + 1) * 64); }
            const unsigned char* Kb = ldsg + buf * 18432; const unsigned char* Vb = Kb + 9216;
            f32x16 p0, p1;
#pragma unroll
            for (int r = 0; r < 16; ++r) { p0[r] = 0.f; p1[r] = 0.f; }
#pragma unroll
            for (int d0 = 0; d0 < 4; ++d0) {
                const bf16x8_t a0 = *(const bf16x8_t*)(Kb + r32 * 144 + (16 * d0 + 8 * hi) * 2);
                const bf16x8_t a1 = *(const bf16x8_t*)(Kb + (32 + r32) * 144 + (16 * d0 + 8 * hi) * 2);
                p0 = __builtin_amdgcn_mfma_f32_32x32x16_bf16(a0, qr[d0], p0, 0, 0, 0);
                p1 = __builtin_amdgcn_mfma_f32_32x32x16_bf16(a1, qr[d0], p1, 0, 0, 0);
            }
            if (WINDOW) {
                const int qpos = q0 + r32;
#pragma unroll
                for (int r = 0; r < 16; ++r) { const int kv = t * 64 + crow(r, hi); int dlt = qpos - kv; dlt = dlt < 0 ? -dlt : dlt; if (dlt > 128) p0[r] = -1e30f;
                    int dl2 = qpos - (kv + 32); dl2 = dl2 < 0 ? -dl2 : dl2; if (dl2 > 128) p1[r] = -1e30f; }
            }
            float mt = fmaxf(p0[0], p1[0]);
#pragma unroll
            for (int r = 1; r < 16; ++r) mt = fmaxf(mt, fmaxf(p0[r], p1[r]));
            mt = fmaxf(mt, __shfl_xor(mt, 32));
            if (__any(mt > m)) {
                const float mn = fmaxf(m, mt), corr = __builtin_amdgcn_exp2f(m - mn); m = mn;
                l *= corr;
#pragma unroll
                for (int r = 0; r < 16; ++r) { o0[r] *= corr; o1[r] *= corr; }
            }
            float ps0 = 0.f, ps1 = 0.f;
#pragma unroll
            for (int r = 0; r < 16; ++r) { p0[r] = __builtin_amdgcn_exp2f(p0[r] - m); p1[r] = __builtin_amdgcn_exp2f(p1[r] - m); ps0 += p0[r]; ps1 += p1[r]; }
            l += ps0 + ps1;
            v4u pw[4];
            pw[0] = (v4u){cvtpk(p0[0], p0[1]), cvtpk(p0[2], p0[3]), cvtpk(p0[4], p0[5]), cvtpk(p0[6], p0[7])};
            pw[1] = (v4u){cvtpk(p0[8], p0[9]), cvtpk(p0[10], p0[11]), cvtpk(p0[12], p0[13]), cvtpk(p0[14], p0[15])};
            pw[2] = (v4u){cvtpk(p1[0], p1[1]), cvtpk(p1[2], p1[3]), cvtpk(p1[4], p1[5]), cvtpk(p1[6], p1[7])};
            pw[3] = (v4u){cvtpk(p1[8], p1[9]), cvtpk(p1[10], p1[11]), cvtpk(p1[12], p1[13]), cvtpk(p1[14], p1[15])};
#pragma unroll
            for (int kb = 0; kb < 4; ++kb) {
                const bf16x8_t pb = __builtin_bit_cast(bf16x8_t, pw[kb]);
                { const unsigned char* vp = Vb + r32 * 144 + (16 * kb + 4 * hi) * 2; const s16x4_t lo = *(const s16x4_t*)vp, hh = *(const s16x4_t*)(vp + 16);
                  const bf16x8_t a = (bf16x8_t){lo[0], lo[1], lo[2], lo[3], hh[0], hh[1], hh[2], hh[3]};
                  o0 = __builtin_amdgcn_mfma_f32_32x32x16_bf16(a, pb, o0, 0, 0, 0); }
                { const unsigned char* vp = Vb + (32 + r32) * 144 + (16 * kb + 4 * hi) * 2; const s16x4_t lo = *(const s16x4_t*)vp, hh = *(const s16x4_t*)(vp + 16);
                  const bf16x8_t a = (bf16x8_t){lo[0], lo[1], lo[2], lo[3], hh[0], hh[1], hh[2], hh[3]};
                  o1 = __builtin_amdgcn_mfma_f32_32x32x16_bf16(a, pb, o1, 0, 0, 0); }
            }
            if (t < t1) { unsigned char* nb = ldsg + (buf ^ 1) * 18432; *(v4u*)(nb + srow * 144 + sch * 16) = kreg; *(v4u*)(nb + 9216 + srow * 144 + sch * 16) = vreg; }
            __syncthreads();
        }
        l += __shfl_xor(l, 32);
        const float inv = 1.0f / l;
        if (Oalt) qp = Oalt + ((size_t)(b * S_ + q0 + r32)) * 512 + h * 64;
#pragma unroll
        for (int g4 = 0; g4 < 4; ++g4) {
            v2u w0, w1;
            w0.x = cvtpk(o0[4 * g4 + 0] * inv, o0[4 * g4 + 1] * inv); w0.y = cvtpk(o0[4 * g4 + 2] * inv, o0[4 * g4 + 3] * inv);
            w1.x = cvtpk(o1[4 * g4 + 0] * inv, o1[4 * g4 + 1] * inv); w1.y = cvtpk(o1[4 * g4 + 2] * inv, o1[4 * g4 + 3] * inv);
            *(v2u*)(qp + 8 * g4 + 4 * hi) = w0;
            *(v2u*)(qp + 32 + 8 * g4 + 4 * hi) = w1;
        }
    }
}

typedef float f8s __attribute__((ext_vector_type(8)));
typedef float f32x4m __attribute__((ext_vector_type(4)));
constexpr int SC_VEC = 0, SC_VS = 81920, SC_W2T = 98304, SC_A2T = 107520, SC_XCH = 116736, SC_YP = 124928, SC_A1 = SC_YP, SC_A2 = SC_YP + 9216, SC_AL = SC_YP + 18432, SC_CS = SC_AL + 16640, SC_END = SC_CS + 128;
static_assert(SC_END <= LDS_BYTES, "scan LDS");
__device__ __forceinline__ void ld8bf(const bf16* p, float (&f)[8]) { const v4u w = *(const v4u*)p;
    f[0] = __uint_as_float(w.x << 16); f[1] = __uint_as_float(w.x & 0xffff0000u); f[2] = __uint_as_float(w.y << 16); f[3] = __uint_as_float(w.y & 0xffff0000u);
    f[4] = __uint_as_float(w.z << 16); f[5] = __uint_as_float(w.z & 0xffff0000u); f[6] = __uint_as_float(w.w << 16); f[7] = __uint_as_float(w.w & 0xffff0000u); }
__device__ __forceinline__ void shifted8(const bf16* pc, int col, bool hasp, bool hasn, const float* mu, float (&o)[8]) {
    float c[8], p[8], n[8];
    ld8bf(pc + col, c);
    if (hasp) ld8bf(pc + col - 2048, p); else { for (int e = 0; e < 8; ++e) p[e] = 0.f; }
    if (hasn) ld8bf(pc + col + 2048, n); else { for (int e = 0; e < 8; ++e) n[e] = 0.f; }
    const f4 m0 = *(const f4*)(mu + col), m1 = *(const f4*)(mu + col + 4);
    const float mm[8] = {m0.x, m0.y, m0.z, m0.w, m1.x, m1.y, m1.z, m1.w};
#pragma unroll
    for (int e = 0; e < 8; ++e) o[e] = c[e] + mm[e] * (0.5f * (p[e] + n[e]) - c[e]);
}
struct Raw3 { v4u c, p, n; };
__device__ __forceinline__ void raw_load(Raw3& r, const bf16* pc, int col, bool hasp, bool hasn) {
    r.c = *(const v4u*)(pc + col);
    r.p = hasp ? *(const v4u*)(pc + col - 2048) : (v4u){0u, 0u, 0u, 0u};
    r.n = hasn ? *(const v4u*)(pc + col + 2048) : (v4u){0u, 0u, 0u, 0u};
}
__device__ __forceinline__ void un8(const v4u w, float (&f)[8]) {
    f[0] = __uint_as_float(w.x << 16); f[1] = __uint_as_float(w.x & 0xffff0000u); f[2] = __uint_as_float(w.y << 16); f[3] = __uint_as_float(w.y & 0xffff0000u);
    f[4] = __uint_as_float(w.z << 16); f[5] = __uint_as_float(w.z & 0xffff0000u); f[6] = __uint_as_float(w.w << 16); f[7] = __uint_as_float(w.w & 0xffff0000u); }
__device__ __forceinline__ void shift_raw(const Raw3& r, const float* mu, int col, float (&o)[8]) {
    float c[8], p[8], n[8]; un8(r.c, c); un8(r.p, p); un8(r.n, n);
    const f4 m0 = *(const f4*)(mu + col), m1 = *(const f4*)(mu + col + 4);
    const float mm[8] = {m0.x, m0.y, m0.z, m0.w, m1.x, m1.y, m1.z, m1.w};
#pragma unroll
    for (int e = 0; e < 8; ++e) o[e] = c[e] + mm[e] * (0.5f * (p[e] + n[e]) - c[e]);
}
__device__ __forceinline__ void scan_fast(const Params& P, int l, unsigned char* ldsg) {
    STAGE_IDS
    unsigned char* ws = P.ws;
    const bf16* PR = (const bf16*)(ws + WS_PR); float* BONUS = (float*)(ws + WS_BONUS);
    float* VEC = (float*)(ldsg + SC_VEC);
    const int fr = lane & 15, fq = lane >> 4, ps = tid >> 3, pcg = tid & 7;
    float* XCH = (float*)(ldsg + SC_XCH); float* YP = (float*)(ldsg + SC_YP); float* VS = (float*)(ldsg + SC_VS); float* AL = (float*)(ldsg + SC_AL);
    for (int sid = blockIdx.x; sid < 256; sid += gridDim.x) {
        const int dir = sid & 1, h = (sid >> 1) & 7, b = sid >> 4, hc0 = h * 64;
        bf16* WKV = (bf16*)(ws + (dir ? WS_WKVB : WS_WKVF));
        const float* mu = P.in[I_MU] + (size_t)l * 1920;
        __syncthreads();
        {
            const float* w2b = P.in[I_W2] + (size_t)(l * 2 + dir) * 64 * 512 + (size_t)ps * 512 + hc0 + 8 * pcg;
            const float* a2b = P.in[I_A2] + (size_t)(l * 2 + dir) * 64 * 512 + (size_t)ps * 512 + hc0 + 8 * pcg;
#pragma unroll
            for (int e = 0; e < 8; ++e) { ((bf16*)(ldsg + SC_W2T))[(8 * pcg + e) * 72 + ps] = (bf16)f2bf(w2b[e]); ((bf16*)(ldsg + SC_A2T))[(8 * pcg + e) * 72 + ps] = (bf16)f2bf(a2b[e]); }
        }
        float S[8];
#pragma unroll
        for (int j = 0; j < 8; ++j) S[j] = 0.f;
        Raw3 pre[5];
#pragma unroll 1
        for (int ch = 0; ch < S_ / 64; ++ch) {
            const int step0 = ch * 64;
            const int tp = dir ? S_ - 1 - (step0 + ps) : step0 + ps;
            const int cR = hc0 + 8 * pcg, cK = 512 + hc0 + 8 * pcg, cV = 1024 + hc0 + 8 * pcg, cW = 1536 + 64 * dir + 8 * pcg, cA = 1664 + 64 * dir + 8 * pcg;
            if (ch == 0) { const bf16* pc = PR + ((size_t)(b * S_ + tp)) * 2048; const bool hasp = tp > 0, hasn = tp < S_ - 1;
                raw_load(pre[0], pc, cR, hasp, hasn); raw_load(pre[1], pc, cK, hasp, hasn); raw_load(pre[2], pc, cV, hasp, hasn); raw_load(pre[3], pc, cW, hasp, hasn); raw_load(pre[4], pc, cA, hasp, hasn); }
            float r8[8], k8[8], v8[8];
            shift_raw(pre[0], mu, cR, r8);
            shift_raw(pre[1], mu, cK, k8);
            shift_raw(pre[2], mu, cV, v8);
            { float wl[8], al[8];
              shift_raw(pre[3], mu, cW, wl);
              shift_raw(pre[4], mu, cA, al);
#pragma unroll
              for (int e = 0; e < 8; ++e) { const float t2 = __builtin_amdgcn_exp2f(2.0f * LOG2E * wl[e]); wl[e] = (t2 - 1.0f) * __builtin_amdgcn_rcpf(t2 + 1.0f); }
              v4u w1, w2v; w1.x = cvtpk(wl[0], wl[1]); w1.y = cvtpk(wl[2], wl[3]); w1.z = cvtpk(wl[4], wl[5]); w1.w = cvtpk(wl[6], wl[7]);
              w2v.x = cvtpk(al[0], al[1]); w2v.y = cvtpk(al[2], al[3]); w2v.z = cvtpk(al[4], al[5]); w2v.w = cvtpk(al[6], al[7]);
              *(v4u*)(ldsg + SC_A1 + ps * 144 + pcg * 16) = w1; *(v4u*)(ldsg + SC_A2 + ps * 144 + pcg * 16) = w2v; }
            *(f4*)(VS + ps * 64 + 8 * pcg) = (f4){v8[0], v8[1], v8[2], v8[3]}; *(f4*)(VS + ps * 64 + 8 * pcg + 4) = (f4){v8[4], v8[5], v8[6], v8[7]};
            __syncthreads();
            {
                const int wq = wave & 3; const bool isw = wave < 4;
                const unsigned char* Ab = ldsg + (isw ? SC_A1 : SC_A2) + (16 * wq + fr) * 144 + 16 * fq;
                const unsigned char* Bb = ldsg + (isw ? SC_W2T : SC_A2T) + fr * 144 + 16 * fq;
                const bf16x8_t a0 = *(const bf16x8_t*)Ab, a1 = *(const bf16x8_t*)(Ab + 64);
                const float* bias = P.in[isw ? I_W0 : I_A0] + (size_t)(l * 2 + dir) * 512 + hc0;
#pragma unroll
                for (int n = 0; n < 4; ++n) {
                    const bf16x8_t b0 = *(const bf16x8_t*)(Bb + n * 16 * 144), b1 = *(const bf16x8_t*)(Bb + n * 16 * 144 + 64);
                    f32x4m acc = (f32x4m){0.f, 0.f, 0.f, 0.f};
                    acc = __builtin_amdgcn_mfma_f32_16x16x32_bf16(a0, b0, acc, 0, 0, 0);
                    acc = __builtin_amdgcn_mfma_f32_16x16x32_bf16(a1, b1, acc, 0, 0, 0);
                    const float bz = bias[16 * n + fr];
#pragma unroll
                    for (int v = 0; v < 4; ++v) {
                        const int st = 16 * wq + 4 * fq + v; const float x = acc[v] + bz;
                        if (isw) { const float sp = __builtin_amdgcn_logf(1.0f + __builtin_amdgcn_exp2f(-x * LOG2E)) * 0.6931471805599453f;
                                   const float wlog = -sp - 0.5f; VEC[st * 320 + (2 * n + (fr >> 3)) * 40 + (fr & 7)] = __builtin_amdgcn_exp2f(-__builtin_amdgcn_exp2f(wlog * LOG2E) * LOG2E); }
                        else AL[st * 65 + 16 * n + fr] = __builtin_amdgcn_rcpf(1.0f + __builtin_amdgcn_exp2f(-x * LOG2E));
                    }
                }
            }
            __syncthreads();
            {
                const float* kkp = P.in[I_KK] + l * 512 + hc0 + 8 * pcg; const float* kap = P.in[I_KA] + l * 512 + hc0 + 8 * pcg; const float* rkp = P.in[I_RK] + l * 512 + hc0 + 8 * pcg;
                float a8[8], kk[8], kd[8]; float ss = 0.f, bon = 0.f;
#pragma unroll
                for (int e = 0; e < 8; ++e) { a8[e] = AL[ps * 65 + 8 * pcg + e]; kk[e] = k8[e] * kkp[e]; ss += kk[e] * kk[e]; kd[e] = k8[e] * (1.0f + (a8[e] - 1.0f) * kap[e]); bon += r8[e] * kd[e] * rkp[e]; }
                ss += __shfl_xor(ss, 1); ss += __shfl_xor(ss, 2); ss += __shfl_xor(ss, 4);
                bon += __shfl_xor(bon, 1); bon += __shfl_xor(bon, 2); bon += __shfl_xor(bon, 4);
                const float rn = 1.0f / fmaxf(sqrtf(ss), 1e-12f);
                float* sp = VEC + ps * 320 + 40 * pcg;
                *(f4*)(sp + 8) = (f4){kd[0], kd[1], kd[2], kd[3]}; *(f4*)(sp + 12) = (f4){kd[4], kd[5], kd[6], kd[7]};
                *(f4*)(sp + 16) = (f4){-kk[0] * rn, -kk[1] * rn, -kk[2] * rn, -kk[3] * rn}; *(f4*)(sp + 20) = (f4){-kk[4] * rn, -kk[5] * rn, -kk[6] * rn, -kk[7] * rn};
                *(f4*)(sp + 24) = (f4){kk[0] * rn * a8[0], kk[1] * rn * a8[1], kk[2] * rn * a8[2], kk[3] * rn * a8[3]}; *(f4*)(sp + 28) = (f4){kk[4] * rn * a8[4], kk[5] * rn * a8[5], kk[6] * rn * a8[6], kk[7] * rn * a8[7]};
                *(f4*)(sp + 32) = (f4){r8[0], r8[1], r8[2], r8[3]}; *(f4*)(sp + 36) = (f4){r8[4], r8[5], r8[6], r8[7]};
                if (pcg == 0) BONUS[((size_t)((dir * NB + b) * 8 + h)) * S_ + tp] = bon;
            }
            asm volatile("s_waitcnt vmcnt(0) lgkmcnt(0)" ::: "memory");
            __syncthreads();
            {
                float* CS = (float*)(ldsg + SC_CS);
                const int p = tid >> 4, q = tid & 15;
                const float* b0 = VEC + (2 * p) * 320 + (q >> 1) * 40 + 24 + (q & 1) * 4; const float* n1 = VEC + (2 * p + 1) * 320 + (q >> 1) * 40 + 16 + (q & 1) * 4;
                float d = (b0[0] * n1[0] + b0[1] * n1[1]) + (b0[2] * n1[2] + b0[3] * n1[3]);
                d += __shfl_xor(d, 1); d += __shfl_xor(d, 2); d += __shfl_xor(d, 4); d += __shfl_xor(d, 8);
                if (q == 0) CS[p] = d;
            }
            asm volatile("s_waitcnt lgkmcnt(0)" ::: "memory");
            __syncthreads();
#define DPP_FMAC(acc, xs, val, N) asm("v_fmac_f32_dpp %0, %1, %2 row_newbcast:" #N " row_mask:0xf bank_mask:0xf" : "+v"(acc) : "v"(xs), "v"(val))
#define DPP_MUL(dst, xs, val, N) asm("v_mul_f32_dpp %0, %1, %2 row_newbcast:" #N " row_mask:0xf bank_mask:0xf" : "=v"(dst) : "v"(xs), "v"(val))
            if (ch + 1 < S_ / 64) { const int tn = dir ? S_ - 1 - (step0 + 64 + ps) : step0 + 64 + ps; const bf16* pc = PR + ((size_t)(b * S_ + tn)) * 2048; const bool hasp = tn > 0, hasn = tn < S_ - 1;
                raw_load(pre[0], pc, cR, hasp, hasn); raw_load(pre[1], pc, cK, hasp, hasn); raw_load(pre[2], pc, cV, hasp, hasn); raw_load(pre[3], pc, cW, hasp, hasn); raw_load(pre[4], pc, cA, hasp, hasn); }
            const float* vecb = VEC + wave * 40 + (lane & 15);
            const int o2 = 32 + (lane & 7) - (lane & 15);
            const float* CSr = (const float*)(ldsg + SC_CS);
#define R8(M) M(0) M(1) M(2) M(3) M(4) M(5) M(6) M(7)
#define R7(M) M(1) M(2) M(3) M(4) M(5) M(6) M(7)
            const int xslot = lane * 8 + ((wave + (lane >> 2)) & 7);
            float pm2 = 0.f;
            auto pair_steps = [&](const int t, float& x0, float& x1, float& x2, float& m0, float& m1, float& m2, const float va, const float vb) __attribute__((always_inline)) {
                const float Cc = CSr[t >> 1];
                asm volatile("s_nop 1" : "+v"(x0), "+v"(x1), "+v"(x2), "+v"(m0), "+v"(m1), "+v"(m2));
                float pa, pb, qa, qb, Tt[8];
                DPP_MUL(pa, x1, S[0], 0); DPP_MUL(pb, x1, S[1], 1);
                DPP_FMAC(pa, x1, S[2], 2); DPP_FMAC(pb, x1, S[3], 3); DPP_FMAC(pa, x1, S[4], 4); DPP_FMAC(pb, x1, S[5], 5); DPP_FMAC(pa, x1, S[6], 6); DPP_FMAC(pb, x1, S[7], 7);
#define M_T0(j) DPP_MUL(Tt[j], x0, S[j], j);
                R8(M_T0)
                DPP_FMAC(Tt[0], x0, va, 8); DPP_FMAC(Tt[1], x0, va, 9); DPP_FMAC(Tt[2], x0, va, 10); DPP_FMAC(Tt[3], x0, va, 11);
                DPP_FMAC(Tt[4], x0, va, 12); DPP_FMAC(Tt[5], x0, va, 13); DPP_FMAC(Tt[6], x0, va, 14); DPP_FMAC(Tt[7], x0, va, 15);
                DPP_MUL(qa, m1, Tt[0], 0); DPP_MUL(qb, m1, Tt[1], 1);
                DPP_FMAC(qa, m1, Tt[2], 2); DPP_FMAC(qb, m1, Tt[3], 3); DPP_FMAC(qa, m1, Tt[4], 4); DPP_FMAC(qb, m1, Tt[5], 5); DPP_FMAC(qa, m1, Tt[6], 6); DPP_FMAC(qb, m1, Tt[7], 7);
                const int par = (t >> 1) & 1;
                XCH[par * 1024 + xslot] = pa + pb; XCH[par * 1024 + 512 + xslot] = qa + qb;
                asm volatile("s_waitcnt lgkmcnt(0)\n\ts_barrier" ::: "memory");
                const f4* xp = (const f4*)(XCH + par * 1024 + lane * 8);
                const f4 e0 = xp[0], e1 = xp[1], g0 = xp[128], g1 = xp[129];
                if (t > 0) {
                    float yc, yd;
                    DPP_MUL(yc, pm2, S[0], 0); DPP_MUL(yd, pm2, S[1], 1);
                    DPP_FMAC(yc, pm2, S[2], 2); DPP_FMAC(yd, pm2, S[3], 3); DPP_FMAC(yc, pm2, S[4], 4); DPP_FMAC(yd, pm2, S[5], 5); DPP_FMAC(yc, pm2, S[6], 6); DPP_FMAC(yd, pm2, S[7], 7);
                    YP[((t - 1) & 15) * 512 + wave * 64 + lane] = yc + yd;
                    if ((t & 7) == 2 && t >= 10) {
                        const int sl = (t - 10) + wave;
                        const float* yp = YP + (sl & 15) * 512 + lane;
                        const float y0 = ((yp[0] + yp[64]) + (yp[128] + yp[192])) + ((yp[256] + yp[320]) + (yp[384] + yp[448]));
                        const int tt = dir ? S_ - 1 - (step0 + sl) : step0 + sl;
                        WKV[((size_t)(b * S_ + tt)) * 512 + hc0 + lane] = (bf16)f2bf(y0);
                    }
                }
                const f4 es = e0 + e1, gs = g0 + g1;
                float sa0 = (es.x + es.y) + (es.z + es.w);
                asm volatile("" : "+v"(sa0));
                const float p1s = (gs.x + gs.y) + (gs.z + gs.w);
                float sa1 = p1s + sa0 * Cc;
                DPP_FMAC(Tt[0], x1, sa0, 8); DPP_FMAC(Tt[1], x1, sa0, 9); DPP_FMAC(Tt[2], x1, sa0, 10); DPP_FMAC(Tt[3], x1, sa0, 11);
                DPP_FMAC(Tt[4], x1, sa0, 12); DPP_FMAC(Tt[5], x1, sa0, 13); DPP_FMAC(Tt[6], x1, sa0, 14); DPP_FMAC(Tt[7], x1, sa0, 15);
                float ya, yb;
                DPP_MUL(ya, x2, Tt[0], 0); DPP_MUL(yb, x2, Tt[1], 1);
                DPP_FMAC(ya, x2, Tt[2], 2); DPP_FMAC(yb, x2, Tt[3], 3); DPP_FMAC(ya, x2, Tt[4], 4); DPP_FMAC(yb, x2, Tt[5], 5); DPP_FMAC(ya, x2, Tt[6], 6); DPP_FMAC(yb, x2, Tt[7], 7);
                YP[(t & 15) * 512 + wave * 64 + lane] = ya + yb;
#define M_T1(j) DPP_MUL(S[j], m0, Tt[j], j);
                R8(M_T1)
                DPP_FMAC(S[0], m0, vb, 8); DPP_FMAC(S[1], m0, vb, 9); DPP_FMAC(S[2], m0, vb, 10); DPP_FMAC(S[3], m0, vb, 11);
                DPP_FMAC(S[4], m0, vb, 12); DPP_FMAC(S[5], m0, vb, 13); DPP_FMAC(S[6], m0, vb, 14); DPP_FMAC(S[7], m0, vb, 15);
                DPP_FMAC(S[0], m1, sa1, 8); DPP_FMAC(S[1], m1, sa1, 9); DPP_FMAC(S[2], m1, sa1, 10); DPP_FMAC(S[3], m1, sa1, 11);
                DPP_FMAC(S[4], m1, sa1, 12); DPP_FMAC(S[5], m1, sa1, 13); DPP_FMAC(S[6], m1, sa1, 14); DPP_FMAC(S[7], m1, sa1, 15);
                pm2 = m2;
            };
            float ax0 = vecb[0], ax1 = vecb[16], ax2 = vecb[o2], am0 = vecb[320], am1 = vecb[336], am2 = vecb[320 + o2], ava = VS[lane], avb = VS[64 + lane];
            float bx0, bx1, bx2, bm0, bm1, bm2, bva, bvb;
#pragma unroll 1
            for (int t = 0; t < 64; t += 4) {
                { const float* np_ = vecb + (t + 2) * 320; const float* nq_ = vecb + (t + 3) * 320;
                  bx0 = np_[0]; bx1 = np_[16]; bx2 = np_[o2]; bm0 = nq_[0]; bm1 = nq_[16]; bm2 = nq_[o2]; bva = VS[(t + 2) * 64 + lane]; bvb = VS[(t + 3) * 64 + lane]; }
                pair_steps(t, ax0, ax1, ax2, am0, am1, am2, ava, avb);
                { const float* np_ = vecb + ((t + 4) & 63) * 320; const float* nq_ = vecb + ((t + 5) & 63) * 320;
                  ax0 = np_[0]; ax1 = np_[16]; ax2 = np_[o2]; am0 = nq_[0]; am1 = nq_[16]; am2 = nq_[o2]; ava = VS[((t + 4) & 63) * 64 + lane]; avb = VS[((t + 5) & 63) * 64 + lane]; }
                pair_steps(t + 2, bx0, bx1, bx2, bm0, bm1, bm2, bva, bvb);
            }
            {
                asm volatile("s_nop 1" : "+v"(pm2));
                float yc, yd;
                DPP_MUL(yc, pm2, S[0], 0); DPP_MUL(yd, pm2, S[1], 1);
                DPP_FMAC(yc, pm2, S[2], 2); DPP_FMAC(yd, pm2, S[3], 3); DPP_FMAC(yc, pm2, S[4], 4); DPP_FMAC(yd, pm2, S[5], 5); DPP_FMAC(yc, pm2, S[6], 6); DPP_FMAC(yd, pm2, S[7], 7);
                YP[(63 & 15) * 512 + wave * 64 + lane] = yc + yd;
                asm volatile("s_waitcnt lgkmcnt(0)\n\ts_barrier" ::: "memory");
                {
                    const int sl = 56 + wave;
                    const float* yp = YP + (sl & 15) * 512 + lane;
                    const float y0 = ((yp[0] + yp[64]) + (yp[128] + yp[192])) + ((yp[256] + yp[320]) + (yp[384] + yp[448]));
                    const int tt = dir ? S_ - 1 - (step0 + sl) : step0 + sl;
                    WKV[((size_t)(b * S_ + tt)) * 512 + hc0 + lane] = (bf16)f2bf(y0);
                }
            }
#undef R7
#undef M_T0
#undef M_T1
#undef R8
#undef DPP_FMAC
#undef DPP_MUL
            __syncthreads();
        }
    }
}

__device__ __forceinline__ void finalize_fast(const Params& P, int l, unsigned char* ldsg) {
    STAGE_IDS
    unsigned char* ws = P.ws;
    const bf16* PR = (const bf16*)(ws + WS_PR); const bf16* WF = (const bf16*)(ws + WS_WKVF); const bf16* WBk = (const bf16*)(ws + WS_WKVB); const float* BONUS = (const float*)(ws + WS_BONUS);
    bf16* YA = (bf16*)(ws + WS_YA);
    const int fr = lane & 15, fq = lane >> 4;
    const float* mu = P.in[I_MU] + (size_t)l * 1920; const float* g2 = P.in[I_G2] + (size_t)l * 128 * 512;
    const float* lngp = P.in[I_LNG] + l * 512; const float* lnbp = P.in[I_LNB] + l * 512;
    bf16x8_t gf[4][4];
#pragma unroll
    for (int n = 0; n < 4; ++n)
#pragma unroll
        for (int ks = 0; ks < 4; ++ks) { float gv[8];
#pragma unroll
            for (int e = 0; e < 8; ++e) gv[e] = g2[(size_t)(32 * ks + 8 * fq + e) * 512 + 64 * wave + 16 * n + fr];
            const v4u w = (v4u){cvtpk(gv[0], gv[1]), cvtpk(gv[2], gv[3]), cvtpk(gv[4], gv[5]), cvtpk(gv[6], gv[7])};
            gf[n][ks] = __builtin_bit_cast(bf16x8_t, w); }
    for (int tile = blockIdx.x; tile < T_ / 32; tile += gridDim.x) {
        const int t0 = tile * 32;
        __syncthreads();
        { const int tok = tid >> 4, mg = tid & 15, t = t0 + tok, s = t & 2047; float x[8];
          shifted8(PR + (size_t)t * 2048, 1792 + 8 * mg, s > 0, s < S_ - 1, mu, x);
#pragma unroll
          for (int e = 0; e < 8; ++e) x[e] = __builtin_amdgcn_rcpf(1.0f + __builtin_amdgcn_exp2f(-x[e] * LOG2E));
          *(v4u*)(ldsg + tok * 272 + mg * 16) = (v4u){cvtpk(x[0], x[1]), cvtpk(x[2], x[3]), cvtpk(x[4], x[5]), cvtpk(x[6], x[7])}; }
        __syncthreads();
#pragma unroll
        for (int mt = 0; mt < 2; ++mt) {
            f32x4m acc[4];
#pragma unroll
            for (int n = 0; n < 4; ++n) acc[n] = (f32x4m){0.f, 0.f, 0.f, 0.f};
#pragma unroll
            for (int ks = 0; ks < 4; ++ks) { const bf16x8_t bb = *(const bf16x8_t*)(ldsg + (16 * mt + fr) * 272 + (32 * ks + 8 * fq) * 2);
#pragma unroll
                for (int n = 0; n < 4; ++n) acc[n] = __builtin_amdgcn_mfma_f32_16x16x32_bf16(gf[n][ks], bb, acc[n], 0, 0, 0); }
            const int t = t0 + 16 * mt + fr, s = t & 2047, bb_ = t >> 11;
            float wk[4][4]; float sm = 0.f;
#pragma unroll
            for (int n = 0; n < 4; ++n) { const int c0 = 64 * wave + 16 * n + 4 * fq;
                const v2u a = *(const v2u*)(WF + (size_t)t * 512 + c0), b2 = *(const v2u*)(WBk + (size_t)t * 512 + c0);
                wk[n][0] = __uint_as_float(a.x << 16) + __uint_as_float(b2.x << 16); wk[n][1] = __uint_as_float(a.x & 0xffff0000u) + __uint_as_float(b2.x & 0xffff0000u);
                wk[n][2] = __uint_as_float(a.y << 16) + __uint_as_float(b2.y << 16); wk[n][3] = __uint_as_float(a.y & 0xffff0000u) + __uint_as_float(b2.y & 0xffff0000u);
                sm += (wk[n][0] + wk[n][1]) + (wk[n][2] + wk[n][3]); }
            sm += __shfl_xor(sm, 16); sm += __shfl_xor(sm, 32);
            const float mean = sm * (1.0f / 64.0f); float sq = 0.f;
#pragma unroll
            for (int n = 0; n < 4; ++n)
#pragma unroll
                for (int v = 0; v < 4; ++v) { wk[n][v] -= mean; sq += wk[n][v] * wk[n][v]; }
            sq += __shfl_xor(sq, 16); sq += __shfl_xor(sq, 32);
            const float rstd = 1.0f / sqrtf(sq * (1.0f / 64.0f) + 64e-5f);
            const float bon = BONUS[((size_t)(bb_ * 8 + wave)) * S_ + s] + BONUS[((size_t)((NB + bb_) * 8 + wave)) * S_ + s];
            const bf16* pc = PR + (size_t)t * 2048;
#pragma unroll
            for (int n = 0; n < 4; ++n) { const int c0 = 64 * wave + 16 * n + 4 * fq;
                const f4 lg = *(const f4*)(lngp + c0), lb = *(const f4*)(lnbp + c0), mv = *(const f4*)(mu + 1024 + c0);
                const v2u vc = *(const v2u*)(pc + 1024 + c0);
                v2u vp = (v2u){0u, 0u}, vn = (v2u){0u, 0u};
                if (s > 0) vp = *(const v2u*)(pc + 1024 + c0 - 2048);
                if (s < S_ - 1) vn = *(const v2u*)(pc + 1024 + c0 + 2048);
                const float cc[4] = {__uint_as_float(vc.x << 16), __uint_as_float(vc.x & 0xffff0000u), __uint_as_float(vc.y << 16), __uint_as_float(vc.y & 0xffff0000u)};
                const float pp[4] = {__uint_as_float(vp.x << 16), __uint_as_float(vp.x & 0xffff0000u), __uint_as_float(vp.y << 16), __uint_as_float(vp.y & 0xffff0000u)};
                const float nn[4] = {__uint_as_float(vn.x << 16), __uint_as_float(vn.x & 0xffff0000u), __uint_as_float(vn.y << 16), __uint_as_float(vn.y & 0xffff0000u)};
                float yv[4];
#pragma unroll
                for (int v = 0; v < 4; ++v) { const float vs = cc[v] + mv[v] * (0.5f * (pp[v] + nn[v]) - cc[v]);
                    yv[v] = (wk[n][v] * rstd * lg[v] + lb[v] + bon * vs) * acc[n][v]; }
                *(v2u*)(YA + (size_t)t * 512 + c0) = (v2u){cvtpk(yv[0], yv[1]), cvtpk(yv[2], yv[3])}; }
        }
    }
}

#define GRID_SYNC_CG() do { asm volatile("s_waitcnt vmcnt(0) lgkmcnt(0)" ::: "memory"); grid.sync(); __builtin_amdgcn_fence(__ATOMIC_ACQUIRE, "agent"); asm volatile("s_waitcnt vmcnt(0)" ::: "memory"); } while (0)
#define GRID_SYNC() grid_barrier(gbar, ground)
#define GEMM_PHASE(EPI, A_, Bt_, M_, N_, K_, E_) do { pg8::Gemm g_{(const pg8::bf16_t*)(A_), (const pg8::bf16_t*)(Bt_), (M_), (N_), (K_)}; pg8::StaticOrder S_o; S_o.init((M_), (N_), (int)gridDim.x, (int)blockIdx.x); \
    pg8::gemm_phase<EPI, pg8::StaticOrder, true, true>((PG8_LAS unsigned char*)lds, g_, S_o, (E_)); } while (0)

__device__ __forceinline__ void grid_barrier(unsigned* bar, unsigned& round) {
    asm volatile("s_waitcnt vmcnt(0) lgkmcnt(0)" ::: "memory");
    __syncthreads();
    ++round;
    if (threadIdx.x == 0) {
        __builtin_amdgcn_fence(__ATOMIC_RELEASE, "agent");
        asm volatile("s_waitcnt vmcnt(0)" ::: "memory");
        const unsigned g = blockIdx.x & 7u, G = gridDim.x, ng = (G + 7u - g) >> 3, ngroups = G < 8u ? G : 8u;
        const unsigned old = __hip_atomic_fetch_add(bar + 64 * (1 + g), 1u, __ATOMIC_RELAXED, __HIP_MEMORY_SCOPE_AGENT);
        if (old + 1u == round * ng) {
            const unsigned old2 = __hip_atomic_fetch_add(bar + 64 * 9, 1u, __ATOMIC_RELAXED, __HIP_MEMORY_SCOPE_AGENT);
            if (old2 + 1u == round * ngroups) __hip_atomic_store(bar, round, __ATOMIC_RELAXED, __HIP_MEMORY_SCOPE_AGENT);
        }
        unsigned spins = 0;
        while (__hip_atomic_load(bar, __ATOMIC_RELAXED, __HIP_MEMORY_SCOPE_AGENT) < round) { __builtin_amdgcn_s_sleep(1); if (++spins > (1u << 24)) break; }
        __builtin_amdgcn_fence(__ATOMIC_ACQUIRE, "agent");
        asm volatile("s_waitcnt vmcnt(0)" ::: "memory");
    }
    __syncthreads();
}
__global__ void __launch_bounds__(NTHREADS, 2) fwd_kernel(Params P) {
    extern __shared__ __attribute__((aligned(16))) unsigned char lds[];
    cg::grid_group grid = cg::this_grid();
    unsigned char* ws = P.ws;
    bf16* H = (bf16*)(ws + WS_H); bf16* ACT = (bf16*)(ws + WS_ACT);
    float* SSB = (float*)(ws + WS_SS);
    unsigned* gbar = (unsigned*)(ws + WS_BAR); unsigned ground = 0;
    cvt_up1(P, 0, lds);
    x_to_bf16_ss(P.in[I_X], H, SSB);
    if (P.ws == nullptr) GRID_SYNC_CG();
    GRID_SYNC();
#pragma unroll 1
    for (int l = 0; l < NL; ++l) {
        const float* xin = (l == 0) ? P.in[I_X] : P.out;
        cvt_rest(P, l, lds);
        __syncthreads();
        { pg8::EpiSwiglu E{(pg8::bf16_t*)ACT, FF, SSB}; GEMM_PHASE(pg8::EpiSwiglu, H, ws + ((l & 1) ? WS_WUP1B : WS_WUP1), T_, 2 * FF, DM, E); }
        GRID_SYNC();
        { pg8::EpiResid E{xin, P.out, DM, 0.5f, (pg8::bf16_t*)H, SSB}; GEMM_PHASE(pg8::EpiResid, ACT, ws + WS_WDN1, T_, DM, FF, E); }
        GRID_SYNC();
        { pg8::EpiWin E{(pg8::bf16_t*)(ws + WS_PR), (pg8::bf16_t*)(ws + WS_QB), (pg8::bf16_t*)(ws + WS_KVB), (pg8::bf16_t*)(ws + WS_QC), (pg8::bf16_t*)(ws + WS_KVC), SSB};
          GEMM_PHASE(pg8::EpiWin, H, ws + WS_WIN, T_, 3584, DM, E); }
        GRID_SYNC();
        qkprep(P, l);
        vt_prep(P, lds);
        __syncthreads();
        scan_fast(P, l, lds);
        GRID_SYNC();
        attn_mfma<false>((bf16*)(ws + WS_QB), (const bf16*)(ws + WS_KG), (const bf16*)(ws + WS_VG), nullptr, lds);
        attn_mfma<true>((bf16*)(ws + WS_QC), (const bf16*)(ws + WS_KW), (const bf16*)(ws + WS_VW), P.in[I_SINK] + l * 8, lds);
        __syncthreads();
        finalize_fast(P, l, lds);
        GRID_SYNC();
#pragma unroll 1
        for (int i = 0; i < 3; ++i) {
            { pg8::EpiGate E{(pg8::bf16_t*)(ws + WS_GATE), SSB}; GEMM_PHASE(pg8::EpiGate, H, ws + WS_WG + (size_t)i * DM * DM * 2, T_, DM, DM, E); }
            const unsigned char* yi = ws + (i == 0 ? WS_YA : (i == 1 ? WS_QB : WS_QC));
            { pg8::EpiMerge E{(const pg8::bf16_t*)(ws + WS_GATE), (pg8::bf16_t*)(ws + WS_MERGED), i == 0 ? 1 : 0}; GEMM_PHASE(pg8::EpiMerge, yi, ws + WS_WO + (size_t)i * DM * 512 * 2, T_, DM, 512, E); }
        }
        GRID_SYNC();
        { pg8::EpiResid E{P.out, P.out, DM, 1.0f, (pg8::bf16_t*)H, SSB}; GEMM_PHASE(pg8::EpiResid, ws + WS_MERGED, ws + WS_WOUT, T_, DM, DM, E); }
        GRID_SYNC();
        { pg8::EpiSwiglu E{(pg8::bf16_t*)ACT, FF, SSB}; GEMM_PHASE(pg8::EpiSwiglu, H, ws + WS_WUP2, T_, 2 * FF, DM, E); }
        GRID_SYNC();
        if (l + 1 < NL) { cvt_up1(P, l + 1, lds); __syncthreads(); }
        { pg8::EpiResid E{P.out, P.out, DM, 0.5f, (pg8::bf16_t*)H, SSB}; GEMM_PHASE(pg8::EpiResid, ACT, ws + WS_WDN2, T_, DM, FF, E); }
        GRID_SYNC();
    }
    rms_rows_f32_inplace(P.out, P.in[I_FINN]);
}

extern "C" void kernel_launch(void* const* d_in, const int* in_sizes, int n_in, void* d_out, int out_size, void* d_ws, size_t ws_size, hipStream_t stream) {
    static int grid_blocks = 0;
    if (grid_blocks == 0) {
        if (n_in != N_IN || out_size != T_ * DM || ws_size < WS_END) { fprintf(stderr, "kernel_launch: unexpected shapes (n_in %d, out %d, ws %zu < %zu)\n", n_in, out_size, ws_size, (size_t)WS_END); grid_blocks = -1; return; }
        int dev = 0, cus = 0, per_cu = 0;
        hipGetDevice(&dev);
        hipDeviceGetAttribute(&cus, hipDeviceAttributeMultiprocessorCount, dev);
        hipFuncSetAttribute((const void*)fwd_kernel, hipFuncAttributeMaxDynamicSharedMemorySize, LDS_BYTES);
        hipOccupancyMaxActiveBlocksPerMultiprocessor(&per_cu, (const void*)fwd_kernel, NTHREADS, LDS_BYTES);
        if (per_cu < 1) per_cu = 1;
        grid_blocks = cus * per_cu;
    }
    if (grid_blocks < 0) return;
    Params p{};
    for (int i = 0; i < N_IN; ++i) p.in[i] = (const float*)d_in[i];
    p.out = (float*)d_out; p.ws = (unsigned char*)d_ws;
    if (hipMemsetAsync((char*)d_ws + WS_BAR, 0, 4096, stream) != hipSuccess) { fprintf(stderr, "kernel_launch: hipMemsetAsync failed\n"); return; }
    void* args[] = {&p};
    hipError_t e = hipLaunchCooperativeKernel((const void*)fwd_kernel, dim3(grid_blocks), dim3(NTHREADS), args, LDS_BYTES, stream);
    if (e != hipSuccess) fprintf(stderr, "cooperative launch failed: %s (grid %d)\n", hipGetErrorString(e), grid_blocks);
}
```

```cpp
#include <hip/hip_runtime.h>
#include <hip/hip_cooperative_groups.h>
#include <cstdio>
#include <cstdint>
namespace cg = cooperative_groups;
namespace pg8 {
#define PG8_LAS __attribute__((address_space(3)))
typedef unsigned short bf16_t;
typedef short bf16x8 __attribute__((ext_vector_type(8)));
typedef float f32x4 __attribute__((ext_vector_type(4)));
typedef unsigned u32x4 __attribute__((ext_vector_type(4)));
constexpr int BM = 256, BK = 64, HALF = 128, HTB = HALF * BK * 2  , STAGE_BYTES = 8 * HTB, NXCD = 8, WGM = 8;

__host__ __device__ __forceinline__ int lds_byte(int r, int c) { const int st = (r >> 4) * 2 + (c >> 5), rr = r & 15, cc = c & 31, ob = rr * 64 + cc * 2; return st * 1024 + (ob ^ (((ob >> 9) & 1) << 5)); }
__host__ __device__ __forceinline__ void stage_rc(int b, int& R, int& C) { const int st = b / 1024, sb = b % 1024, swz = sb ^ (((sb >> 9) & 1) << 5); R = (st >> 1) * 16 + swz / 64; C = (st & 1) * 32 + (swz % 64) / 2; }
__host__ __device__ __forceinline__ int perm32(int rho) { const int n = rho >> 4, i = rho & 15; return 8 * (i >> 2) + 4 * n + (i & 3); }

struct Unit { int pm, pn; };
struct Gemm { const bf16_t* A; const bf16_t* Bt; int M, N, K; };

struct StaticOrder {
    int nM, nN, nwg, G, c;
    __host__ __device__ void init(int M, int N, int G_, int c_) { nM = M / BM; nN = N / BM; nwg = nM * nN; G = G_; c = c_; }
    __host__ __device__ bool next(int i, Unit& u) const {
        const long L = (long)i * G + c; if (L >= nwg) return false;
        int wgid = (int)L; { const int q = nwg / NXCD, r = nwg % NXCD, xcd = wgid % NXCD, off = wgid / NXCD; wgid = (xcd < r ? xcd * (q + 1) : r * (q + 1) + (xcd - r) * q) + off; }
        const int nig = WGM * nN, gid = wgid / nig, fm = gid * WGM, gsz = (nM - fm) < WGM ? (nM - fm) : WGM;
        u.pm = fm + ((wgid % nig) % gsz); u.pn = (wgid % nig) / gsz; return true;
    }
    __device__ __forceinline__ void a_ready(const Unit&) const {}
    __device__ __forceinline__ void done(const Unit&) const {}
};
typedef float f32x2_t __attribute__((ext_vector_type(2))); typedef __bf16 bf16x2_t __attribute__((ext_vector_type(2)));
__device__ __forceinline__ unsigned cvt_pk_bf16(float lo, float hi) { f32x2_t v = {lo, hi}; bf16x2_t b = __builtin_convertvector(v, bf16x2_t); return __builtin_bit_cast(unsigned, b); }
typedef float f32x2 __attribute__((ext_vector_type(2)));
__device__ __forceinline__ float fast_sigmoid(float x) { return __builtin_amdgcn_rcpf(1.0f + __builtin_amdgcn_exp2f(-1.4426950408889634f * x)); }
__device__ __forceinline__ float bf_lo(unsigned w) { return __uint_as_float(w << 16); }
__device__ __forceinline__ float bf_hi(unsigned w) { return __uint_as_float(w & 0xffff0000u); }

__device__ __forceinline__ float row_rs(const float* SS, int row) { const f32x4 a = *(const f32x4*)(SS + (size_t)row * 16), b2 = *(const f32x4*)(SS + (size_t)row * 16 + 4), c2 = *(const f32x4*)(SS + (size_t)row * 16 + 8), d = *(const f32x4*)(SS + (size_t)row * 16 + 12);
    const float s = ((a[0] + a[1]) + (a[2] + a[3])) + ((b2[0] + b2[1]) + (b2[2] + b2[3])) + ((c2[0] + c2[1]) + (c2[2] + c2[3])) + ((d[0] + d[1]) + (d[2] + d[3]));
    return 1.0f / sqrtf(s * (1.0f / 1024.0f) + 1e-6f); }
struct EpiSwiglu {
    static constexpr bool PERM = true, AFTER_DRAIN = false;
    bf16_t* O; int ldc; const float* RS;
    __device__ __forceinline__ void operator()(const f32x4 (&acc)[2][2][4][2], const Unit& u, int wr, int wc, int fr, int fq) const {
        const int row0 = u.pm * BM + wr * 64 + fr, col0 = u.pn * HALF + wc * 32 + 8 * fq;
        float rsv[2][4];
#pragma unroll
        for (int ai = 0; ai < 2; ++ai)
#pragma unroll
            for (int m = 0; m < 4; ++m) rsv[ai][m] = RS[row0 + ai * HALF + m * 16];
        asm volatile("" ::: "memory");
#pragma unroll
        for (int ai = 0; ai < 2; ++ai)
#pragma unroll
            for (int m = 0; m < 4; ++m) {
                bf16_t* rowp = O + (size_t)(row0 + ai * HALF + m * 16) * ldc + col0;
                const float rs = rsv[ai][m];
                float v[8];
#pragma unroll
                for (int n = 0; n < 2; ++n)
#pragma unroll
                    for (int j = 0; j < 4; ++j) { const float g = acc[ai][0][m][n][j] * rs, up = acc[ai][1][m][n][j] * rs; v[n * 4 + j] = g * fast_sigmoid(g) * up; }
                u32x4 w; w.x = cvt_pk_bf16(v[0], v[1]); w.y = cvt_pk_bf16(v[2], v[3]); w.z = cvt_pk_bf16(v[4], v[5]); w.w = cvt_pk_bf16(v[6], v[7]);
                *(u32x4*)rowp = w;
            }
    }
};
struct EpiResid {
    static constexpr bool PERM = false, AFTER_DRAIN = false;
    const float* src; float* dst; int ldc; float scale; bf16_t* XB; float* SS;
    __device__ __forceinline__ void operator()(const f32x4 (&acc)[2][2][4][2], const Unit& u, int wr, int wc, int fr, int fq) const {
        const int col0 = u.pn * BM + wc * 32 + 4 * fq;
        typedef unsigned u32x2 __attribute__((ext_vector_type(2)));
#pragma unroll
        for (int ai = 0; ai < 2; ++ai) {
#pragma unroll
          for (int mh = 0; mh < 4; mh += 2) {
            f32x4 pre[4][2][2];
#pragma unroll
            for (int m = mh; m < mh + 2; ++m) { const size_t off = (size_t)(u.pm * BM + ai * HALF + wr * 64 + m * 16 + fr) * ldc + col0;
#pragma unroll
                for (int bj = 0; bj < 2; ++bj)
#pragma unroll
                    for (int n = 0; n < 2; ++n) pre[m][bj][n] = *(const f32x4*)(src + off + bj * HALF + n * 16); }
            asm volatile("" ::: "memory");
#pragma unroll
            for (int m = mh; m < mh + 2; ++m) {
                const int row = u.pm * BM + ai * HALF + wr * 64 + m * 16 + fr;
                const size_t off = (size_t)row * ldc + col0; float sq = 0.f;
#pragma unroll
                for (int bj = 0; bj < 2; ++bj)
#pragma unroll
                    for (int n = 0; n < 2; ++n) { const f32x4 x = pre[m][bj][n] + acc[ai][bj][m][n] * scale;
                        *(f32x4*)(dst + off + bj * HALF + n * 16) = x; sq += (x[0] * x[0] + x[1] * x[1]) + (x[2] * x[2] + x[3] * x[3]);
                        *(u32x2*)(XB + off + bj * HALF + n * 16) = (u32x2){cvt_pk_bf16(x[0], x[1]), cvt_pk_bf16(x[2], x[3])}; }
                sq += __shfl_xor(sq, 16); sq += __shfl_xor(sq, 32);
                if (fq == 0) SS[(size_t)row * 16 + u.pn * 4 + wc] = sq;
            }
            asm volatile("" ::: "memory");
          }
        }
    }
};
struct EpiWin {
    static constexpr bool PERM = true, AFTER_DRAIN = false;
    bf16_t *PR, *QB, *KVB, *QC, *KVC; const float* RS;
    __device__ __forceinline__ void operator()(const f32x4 (&acc)[2][2][4][2], const Unit& u, int wr, int wc, int fr, int fq) const {
        bf16_t* base; int ldc, colt;
        const int pn = u.pn;
        if (pn < 8) { base = PR; ldc = 2048; colt = pn * 256; }
        else if (pn < 10) { base = QB; ldc = 512; colt = (pn - 8) * 256; }
        else if (pn == 10) { base = KVB; ldc = 256; colt = 0; }
        else if (pn < 13) { base = QC; ldc = 512; colt = (pn - 11) * 256; }
        else { base = KVC; ldc = 256; colt = 0; }
        const int row0 = u.pm * BM + wr * 64 + fr, col0 = colt + wc * 32 + 8 * fq;
        float rsv[2][4];
#pragma unroll
        for (int ai = 0; ai < 2; ++ai)
#pragma unroll
            for (int m = 0; m < 4; ++m) rsv[ai][m] = RS[row0 + ai * HALF + m * 16];
        asm volatile("" ::: "memory");
#pragma unroll
        for (int ai = 0; ai < 2; ++ai)
#pragma unroll
            for (int m = 0; m < 4; ++m) {
                bf16_t* rowp = base + (size_t)(row0 + ai * HALF + m * 16) * ldc + col0;
                const float rs = rsv[ai][m];
#pragma unroll
                for (int bj = 0; bj < 2; ++bj) { const f32x4 v0 = acc[ai][bj][m][0] * rs, v1 = acc[ai][bj][m][1] * rs;
                    u32x4 w; w.x = cvt_pk_bf16(v0[0], v0[1]); w.y = cvt_pk_bf16(v0[2], v0[3]); w.z = cvt_pk_bf16(v1[0], v1[1]); w.w = cvt_pk_bf16(v1[2], v1[3]);
                    *(u32x4*)(rowp + bj * HALF) = w; }
            }
    }
};
struct EpiGate {
    static constexpr bool PERM = true, AFTER_DRAIN = false;
    bf16_t* G; const float* RS;
    __device__ __forceinline__ void operator()(const f32x4 (&acc)[2][2][4][2], const Unit& u, int wr, int wc, int fr, int fq) const {
        const int row0 = u.pm * BM + wr * 64 + fr, col0 = u.pn * BM + wc * 32 + 8 * fq;
        float rsv[2][4];
#pragma unroll
        for (int ai = 0; ai < 2; ++ai)
#pragma unroll
            for (int m = 0; m < 4; ++m) rsv[ai][m] = RS[row0 + ai * HALF + m * 16];
        asm volatile("" ::: "memory");
#pragma unroll
        for (int ai = 0; ai < 2; ++ai)
#pragma unroll
            for (int m = 0; m < 4; ++m) {
                bf16_t* rowp = G + (size_t)(row0 + ai * HALF + m * 16) * 1024 + col0;
                const float rs = rsv[ai][m];
#pragma unroll
                for (int bj = 0; bj < 2; ++bj) { const f32x4 v0 = acc[ai][bj][m][0] * rs, v1 = acc[ai][bj][m][1] * rs;
                    u32x4 w; w.x = cvt_pk_bf16(fast_sigmoid(v0[0]), fast_sigmoid(v0[1])); w.y = cvt_pk_bf16(fast_sigmoid(v0[2]), fast_sigmoid(v0[3]));
                    w.z = cvt_pk_bf16(fast_sigmoid(v1[0]), fast_sigmoid(v1[1])); w.w = cvt_pk_bf16(fast_sigmoid(v1[2]), fast_sigmoid(v1[3]));
                    *(u32x4*)(rowp + bj * HALF) = w; }
            }
    }
};
struct EpiMerge {
    static constexpr bool PERM = true, AFTER_DRAIN = false;
    const bf16_t* G; bf16_t* Mg; int first;
    __device__ __forceinline__ void operator()(const f32x4 (&acc)[2][2][4][2], const Unit& u, int wr, int wc, int fr, int fq) const {
        const int row0 = u.pm * BM + wr * 64 + fr, col0 = u.pn * BM + wc * 32 + 8 * fq;
#pragma unroll
        for (int ai = 0; ai < 2; ++ai) {
#pragma unroll
          for (int mh = 0; mh < 4; mh += 2) {
            u32x4 gq[4][2], pq[4][2];
#pragma unroll
            for (int m = mh; m < mh + 2; ++m) { const size_t off = (size_t)(row0 + ai * HALF + m * 16) * 1024 + col0;
#pragma unroll
                for (int bj = 0; bj < 2; ++bj) { gq[m][bj] = __builtin_nontemporal_load((const u32x4*)(G + off + bj * HALF));
                    pq[m][bj] = first ? (u32x4){0u, 0u, 0u, 0u} : __builtin_nontemporal_load((const u32x4*)(Mg + off + bj * HALF)); } }
            asm volatile("" ::: "memory");
#pragma unroll
            for (int m = mh; m < mh + 2; ++m) {
                const size_t off = (size_t)(row0 + ai * HALF + m * 16) * 1024 + col0;
#pragma unroll
                for (int bj = 0; bj < 2; ++bj) { const f32x4 v0 = acc[ai][bj][m][0], v1 = acc[ai][bj][m][1];
                    const u32x4 g = gq[m][bj], p = pq[m][bj];
                    float r[8];
                    r[0] = bf_lo(g.x) * v0[0] + bf_lo(p.x); r[1] = bf_hi(g.x) * v0[1] + bf_hi(p.x); r[2] = bf_lo(g.y) * v0[2] + bf_lo(p.y); r[3] = bf_hi(g.y) * v0[3] + bf_hi(p.y);
                    r[4] = bf_lo(g.z) * v1[0] + bf_lo(p.z); r[5] = bf_hi(g.z) * v1[1] + bf_hi(p.z); r[6] = bf_lo(g.w) * v1[2] + bf_lo(p.w); r[7] = bf_hi(g.w) * v1[3] + bf_hi(p.w);
                    u32x4 w; w.x = cvt_pk_bf16(r[0], r[1]); w.y = cvt_pk_bf16(r[2], r[3]); w.z = cvt_pk_bf16(r[4], r[5]); w.w = cvt_pk_bf16(r[6], r[7]);
                    *(u32x4*)(Mg + off + bj * HALF) = w; }
            }
            asm volatile("" ::: "memory");
          }
        }
    }
};
template <class Epi, class Sched, bool ALIGN_EPI = false, bool SP2 = false>
__device__ __forceinline__ void gemm_phase(PG8_LAS unsigned char* lds, const Gemm g, const Sched& S, const Epi& E) {
    int tid_o = threadIdx.x; asm volatile("" : "+v"(tid_o));
    const int tid = tid_o, wid = __builtin_amdgcn_readfirstlane(tid >> 6), lane = tid & 63, wr = wid >> 2, wc = wid & 3, fr = lane & 15, fq = lane >> 4;
    const int K = g.K, nt = K / BK;
    unsigned voffA[2], voffB[2];
#pragma unroll
    for (int i = 0; i < 2; ++i) { int R, C; stage_rc(tid * 16 + i * 8192, R, C); const int Rb = Epi::PERM ? ((R & ~31) + perm32(R & 31)) : R;
        voffA[i] = (unsigned)(R * K + C) * 2u; voffB[i] = (unsigned)(Rb * K + C) * 2u; }
    const size_t kstep = (size_t)(BK * 2);
    const size_t hstep = (size_t)HALF * K * 2;
    const size_t tstep = 2 * hstep;
    const unsigned ldsw = (unsigned)wid * 1024u;
    const int aoff = lds_byte(wr * 64 + fr, fq * 8), boff = lds_byte(wc * 32 + fr, fq * 8);
#define PG8_SA(b, h) (((b) * 2 + (h)) * HTB)
#define PG8_SB(b, h) ((4 + (b) * 2 + (h)) * HTB)
#define PG8_STAGE(bufoff, gbase, voff) do { _Pragma("unroll") for (int _i = 0; _i < 2; ++_i) \
        __builtin_amdgcn_global_load_lds((const unsigned*)((const char*)(gbase) + (voff)[_i]), (PG8_LAS unsigned*)(lds + (bufoff) + ldsw + _i * 8192), 16, 0, 0); } while (0)
#define PG8_LDA(dst, b, h) do { _Pragma("unroll") for (int m = 0; m < 4; ++m) _Pragma("unroll") for (int k = 0; k < 2; ++k) dst[m][k] = *(const PG8_LAS bf16x8*)(lds + PG8_SA(b, h) + aoff + m * 2048 + k * 1024); } while (0)
#define PG8_LDB(dst, b, h) do { _Pragma("unroll") for (int n = 0; n < 2; ++n) _Pragma("unroll") for (int k = 0; k < 2; ++k) dst[n][k] = *(const PG8_LAS bf16x8*)(lds + PG8_SB(b, h) + boff + n * 2048 + k * 1024); } while (0)
#define PG8_MMA(ai, bj, At, Bt) do { __builtin_amdgcn_s_setprio(1); _Pragma("unroll") for (int m = 0; m < 4; ++m) _Pragma("unroll") for (int n = 0; n < 2; ++n) _Pragma("unroll") for (int k = 0; k < 2; ++k) \
        acc[ai][bj][m][n] = __builtin_amdgcn_mfma_f32_16x16x32_bf16(Bt[n][k], At[m][k], acc[ai][bj][m][n], 0, 0, 0); __builtin_amdgcn_s_setprio(0); } while (0)
#define PG8_WAIT_V(n) asm volatile("s_waitcnt vmcnt(" #n ")" ::: "memory")
#define PG8_WAIT_L(n) asm volatile("s_waitcnt lgkmcnt(" #n ")" ::: "memory")
#define PG8_BAR __builtin_amdgcn_s_barrier()
#define PG8_SCHED __builtin_amdgcn_sched_barrier(0)
    Unit cur, nxt; int ui = 0;
    if (!S.next(0, cur)) return;
    f32x4 acc[2][2][4][2];
#pragma unroll
    for (int a = 0; a < 2; ++a)
#pragma unroll
        for (int b = 0; b < 2; ++b)
#pragma unroll
            for (int m = 0; m < 4; ++m)
#pragma unroll
                for (int n = 0; n < 2; ++n) acc[a][b][m][n] = (f32x4){0.f, 0.f, 0.f, 0.f};
    bf16x8 At[4][2], B0[2][2], B1[2][2];
    const char* cA = (const char*)g.A + (size_t)cur.pm * tstep; const char* cB = (const char*)g.Bt + (size_t)cur.pn * tstep;
    S.a_ready(cur);
    if constexpr (SP2) {
        PG8_STAGE(PG8_SB(0, 0), cB, voffB); PG8_STAGE(PG8_SB(0, 1), cB + hstep, voffB); PG8_STAGE(PG8_SA(0, 0), cA, voffA); PG8_STAGE(PG8_SA(0, 1), cA + hstep, voffA);
        if (wr == 1) PG8_BAR;
        PG8_WAIT_V(2); PG8_BAR;
        PG8_STAGE(PG8_SB(1, 0), cB + kstep, voffB); PG8_STAGE(PG8_SA(1, 0), cA + kstep, voffA); PG8_STAGE(PG8_SB(1, 1), cB + hstep + kstep, voffB);
        PG8_WAIT_V(6); PG8_BAR;
    } else {
        PG8_STAGE(PG8_SB(0, 0), cB, voffB); PG8_STAGE(PG8_SA(0, 0), cA, voffA); PG8_STAGE(PG8_SB(0, 1), cB + hstep, voffB); PG8_STAGE(PG8_SA(0, 1), cA + hstep, voffA);
        if (wr == 1) PG8_BAR;
        PG8_WAIT_V(4); PG8_BAR;
        PG8_STAGE(PG8_SB(1, 0), cB + kstep, voffB); PG8_STAGE(PG8_SA(1, 0), cA + kstep, voffA); PG8_STAGE(PG8_SB(1, 1), cB + hstep + kstep, voffB);
        PG8_WAIT_V(6); PG8_BAR;
    }
    for (;;) {
        const bool has_next = S.next(ui + 1, nxt);
        const char* nA = has_next ? (const char*)g.A + (size_t)nxt.pm * tstep : cA; const char* nB = has_next ? (const char*)g.Bt + (size_t)nxt.pn * tstep : cB;
        for (int t = 0; t < nt; t += 2) {
            const bool last = (t == nt - 2);
            const char* a1 = cA + (size_t)(t + 1) * kstep;
            const char* a2 = last ? nA : cA + (size_t)(t + 2) * kstep; const char* b2 = last ? nB : cB + (size_t)(t + 2) * kstep;
            const char* a3 = a2 + kstep; const char* b3 = b2 + kstep;
            if (last && has_next) S.a_ready(nxt);
            if constexpr (SP2) {
            PG8_LDB(B0, 0, 0); PG8_LDB(B1, 0, 1); PG8_SCHED; PG8_LDA(At, 0, 0); PG8_STAGE(PG8_SA(1, 1), a1 + hstep, voffA);
            PG8_WAIT_V(8); PG8_WAIT_L(0); PG8_BAR; PG8_MMA(0, 0, At, B0); PG8_MMA(0, 1, At, B1); PG8_BAR; PG8_SCHED;
            PG8_LDA(At, 0, 1); PG8_STAGE(PG8_SB(0, 0), b2, voffB); PG8_STAGE(PG8_SB(0, 1), b2 + hstep, voffB); PG8_STAGE(PG8_SA(0, 0), a2, voffA);
            PG8_WAIT_V(8); PG8_WAIT_L(0); PG8_BAR; PG8_MMA(1, 0, At, B0); PG8_MMA(1, 1, At, B1); PG8_BAR; PG8_SCHED;
            PG8_LDB(B0, 1, 0); PG8_LDB(B1, 1, 1); PG8_SCHED; PG8_LDA(At, 1, 0); PG8_STAGE(PG8_SA(0, 1), a2 + hstep, voffA);
            PG8_WAIT_V(8); PG8_WAIT_L(0); PG8_BAR; PG8_MMA(0, 0, At, B0); PG8_MMA(0, 1, At, B1); PG8_BAR; PG8_SCHED;
            PG8_LDA(At, 1, 1); PG8_STAGE(PG8_SB(1, 0), b3, voffB); PG8_STAGE(PG8_SB(1, 1), b3 + hstep, voffB); PG8_STAGE(PG8_SA(1, 0), a3, voffA);
            PG8_WAIT_V(8); PG8_WAIT_L(0); PG8_BAR; PG8_MMA(1, 0, At, B0); PG8_MMA(1, 1, At, B1); PG8_BAR; PG8_SCHED;
            } else {
            PG8_LDB(B0, 0, 0); PG8_SCHED; PG8_LDA(At, 0, 0); PG8_STAGE(PG8_SA(1, 1), a1 + hstep, voffA);
            PG8_WAIT_L(8); PG8_BAR; PG8_WAIT_L(0); PG8_MMA(0, 0, At, B0); PG8_BAR; PG8_SCHED;
            PG8_LDB(B1, 0, 1); PG8_STAGE(PG8_SB(0, 0), b2, voffB);
            PG8_BAR; PG8_WAIT_L(0); PG8_MMA(0, 1, At, B1); PG8_BAR;
            PG8_LDA(At, 0, 1); PG8_STAGE(PG8_SA(0, 0), a2, voffA);
            PG8_BAR; PG8_WAIT_L(0); PG8_MMA(1, 0, At, B0); PG8_BAR; PG8_SCHED;
            PG8_STAGE(PG8_SB(0, 1), b2 + hstep, voffB);
            PG8_WAIT_V(6); PG8_BAR; PG8_MMA(1, 1, At, B1); PG8_BAR;
            PG8_LDB(B0, 1, 0); PG8_SCHED; PG8_LDA(At, 1, 0); PG8_STAGE(PG8_SA(0, 1), a2 + hstep, voffA);
            PG8_WAIT_L(8); PG8_BAR; PG8_WAIT_L(0); PG8_MMA(0, 0, At, B0); PG8_BAR; PG8_SCHED;
            PG8_LDB(B1, 1, 1); PG8_STAGE(PG8_SB(1, 0), b3, voffB);
            PG8_BAR; PG8_WAIT_L(0); PG8_MMA(0, 1, At, B1); PG8_BAR;
            PG8_LDA(At, 1, 1); PG8_STAGE(PG8_SA(1, 0), a3, voffA);
            PG8_BAR; PG8_WAIT_L(0); PG8_MMA(1, 0, At, B0); PG8_BAR; PG8_SCHED;
            PG8_STAGE(PG8_SB(1, 1), b3 + hstep, voffB);
            PG8_WAIT_V(6); PG8_BAR; PG8_MMA(1, 1, At, B1); PG8_BAR;
            }
        }
        if constexpr (ALIGN_EPI) { if (wr == 0) PG8_BAR; }
        if constexpr (!Epi::AFTER_DRAIN) { E(acc, cur, wr, wc, fr, fq); S.done(cur); }
        if (!has_next) break;
#pragma unroll
        for (int a = 0; a < 2; ++a)
#pragma unroll
            for (int b = 0; b < 2; ++b)
#pragma unroll
                for (int m = 0; m < 4; ++m)
#pragma unroll
                    for (int n = 0; n < 2; ++n) acc[a][b][m][n] = (f32x4){0.f, 0.f, 0.f, 0.f};
        cur = nxt; cA = nA; cB = nB; ++ui;
        if constexpr (ALIGN_EPI) { if (wr == 1) PG8_BAR; }
    }
    PG8_WAIT_V(0);
    if constexpr (!ALIGN_EPI) { if (wr == 0) PG8_BAR; }
    PG8_BAR;
    if constexpr (Epi::AFTER_DRAIN) { E.fused(acc, cur, wr, wc, fr, fq, lds, wid, lane); S.done(cur); }
#undef PG8_SA
#undef PG8_SB
#undef PG8_STAGE
#undef PG8_LDA
#undef PG8_LDB
#undef PG8_MMA
#undef PG8_WAIT_V
#undef PG8_WAIT_L
#undef PG8_BAR
#undef PG8_SCHED
}
}
#define LAS __attribute__((address_space(3)))
typedef unsigned short bf16;
typedef unsigned v4u __attribute__((ext_vector_type(4)));
typedef unsigned v2u __attribute__((ext_vector_type(2)));
typedef float f4 __attribute__((ext_vector_type(4)));
constexpr int T_ = 32768, S_ = 2048, NB = 16, DM = 1024, FF = 2816, NL = 4;
constexpr int NWAVES = 8, NTHREADS = 512;
constexpr int LDS_BYTES = 163840;
constexpr float LOG2E = 1.4426950408889634f;
constexpr float C2 = 0.125f * LOG2E;
constexpr float LOG2_THETA = 13.287712379549449f;

enum { I_X = 0, I_F1N, I_F1UP, I_F1DN, I_MIXN, I_WIN, I_MU, I_W0, I_W2, I_A0, I_A2, I_G2, I_KK, I_KA, I_RK, I_LNG, I_LNB, I_QN, I_KN, I_SINK,
       I_WOA, I_WOB, I_WOC, I_WOUT, I_F2N, I_F2UP, I_F2DN, I_FINN, N_IN };

constexpr size_t SZ_WUP = (size_t)2 * FF * DM * 2, SZ_WDN = (size_t)DM * FF * 2, SZ_WIN = (size_t)3584 * DM * 2, SZ_WG = (size_t)3072 * DM * 2,
                 SZ_WO = (size_t)3 * DM * 512 * 2, SZ_WOUT = (size_t)DM * DM * 2;
constexpr size_t WS_WUP1 = 0, WS_WDN1 = WS_WUP1 + SZ_WUP, WS_WIN = WS_WDN1 + SZ_WDN, WS_WG = WS_WIN + SZ_WIN, WS_WO = WS_WG + SZ_WG, WS_WOUT = WS_WO + SZ_WO,
                 WS_WUP2 = WS_WOUT + SZ_WOUT, WS_WDN2 = WS_WUP2 + SZ_WUP, WS_H = WS_WDN2 + SZ_WDN;
constexpr size_t WS_R = WS_H + (size_t)T_ * DM * 2;
constexpr size_t WS_ACT = WS_R;
constexpr size_t WS_PR = WS_R, WS_QB = WS_PR + (size_t)T_ * 2048 * 2, WS_KVB = WS_QB + (size_t)T_ * 512 * 2, WS_QC = WS_KVB + (size_t)T_ * 256 * 2, WS_KVC = WS_QC + (size_t)T_ * 512 * 2,
                 WS_KG = WS_KVC + (size_t)T_ * 256 * 2, WS_VG = WS_KG + (size_t)NB * 2 * S_ * 64 * 2, WS_KW = WS_VG + (size_t)NB * 2 * S_ * 64 * 2, WS_VW = WS_KW + (size_t)NB * 2 * S_ * 64 * 2,
                 WS_YA = WS_VW + (size_t)NB * 2 * S_ * 64 * 2, WS_WKVF = WS_YA + (size_t)T_ * 512 * 2, WS_WKVB = WS_WKVF + (size_t)T_ * 512 * 2, WS_BONUS = WS_WKVB + (size_t)T_ * 512 * 2,
                 WS_SCR = WS_BONUS + (size_t)T_ * 16 * 4, WS_SS = WS_SCR, WS_RS = WS_SS + (size_t)T_ * 16 * 4, WS_WUP1B = WS_RS + (size_t)T_ * 4, WS_BAR = WS_WUP1B + SZ_WUP, WS_END = WS_BAR + 4096;
constexpr size_t WS_GATE = WS_PR, WS_MERGED = WS_PR + (size_t)T_ * DM * 2;
static_assert(WS_ACT + (size_t)T_ * FF * 2 <= WS_END, "map");
static_assert(WS_END < 536000000ull, "workspace budget");

struct Params { const float* in[N_IN]; float* out; unsigned char* ws; };

__device__ __forceinline__ unsigned f2bf(float f) { unsigned u = __float_as_uint(f); return (u + 0x7fffu + ((u >> 16) & 1u)) >> 16; }
__device__ __forceinline__ unsigned pk2(float lo, float hi) { return f2bf(lo) | (f2bf(hi) << 16); }
__device__ __forceinline__ float bf2f(bf16 h) { return __uint_as_float((unsigned)h << 16); }
__device__ __forceinline__ int opaque_tid() { int t = threadIdx.x; asm volatile("" : "+v"(t)); return t; }
#define STAGE_IDS const int tid = opaque_tid(), lane = tid & 63, wave = __builtin_amdgcn_readfirstlane(tid >> 6); const int gw = blockIdx.x * NWAVES + wave, ngw = gridDim.x * NWAVES, gtid = blockIdx.x * NTHREADS + tid, gthreads = gridDim.x * NTHREADS; (void)lane; (void)gw; (void)ngw; (void)gtid; (void)gthreads;
__device__ __forceinline__ float wave_sum(float v) {
#pragma unroll
    for (int o = 1; o < 64; o <<= 1) v += __shfl_xor(v, o);
    return v;
}

__device__ __forceinline__ void cvt_wt(const float* W, int K, int ld, bf16* Wt, int nrows, int mode, int gw, int ngw, int lane, float* scr, const float* gain = nullptr) {
    const int nblk = nrows >> 5, nitems = (K >> 6) * nblk;
    for (int it = gw; it < nitems; it += ngw) {
        const int kb = it / nblk, nb = it % nblk, k0 = kb * 64, n0 = nb * 32;
        int col0;
        if (mode == 0) col0 = n0;
        else if (mode == 1) { const int t = n0 >> 8, r = n0 & 255; col0 = (r < 128) ? t * 128 + r : FF + t * 128 + (r - 128); }
        else if (mode == 2) col0 = n0 < 1920 ? n0 : (n0 < 2048 ? -1 : n0 - 128);
        else col0 = 3456 + n0;
        if (col0 >= 0) {
#pragma unroll 8
            for (int i = 0; i < 32; ++i) { const int kk = 2 * i + (lane >> 5); scr[kk * 33 + (lane & 31)] = W[(size_t)(k0 + kk) * ld + col0 + (lane & 31)] * (gain ? gain[k0 + kk] : 1.0f); }
        }
        asm volatile("s_waitcnt lgkmcnt(0)" ::: "memory");
        const int c = lane & 7;
#pragma unroll
        for (int j = 0; j < 4; ++j) { const int n = (lane >> 3) + 8 * j; const float* sp = scr + (8 * c) * 33 + n;
            v4u o = (v4u){0u, 0u, 0u, 0u};
            if (col0 >= 0) { o.x = pk2(sp[0 * 33], sp[1 * 33]); o.y = pk2(sp[2 * 33], sp[3 * 33]); o.z = pk2(sp[4 * 33], sp[5 * 33]); o.w = pk2(sp[6 * 33], sp[7 * 33]); }
            *(v4u*)(Wt + (size_t)(n0 + n) * K + k0 + 8 * c) = o; }
        asm volatile("s_waitcnt lgkmcnt(0)" ::: "memory");
    }
}
__device__ __forceinline__ void cvt_up1(const Params& P, int l, unsigned char* ldsg) {
    STAGE_IDS
    unsigned char* ws = P.ws; float* scr = (float*)(ldsg + wave * 8448);
    cvt_wt(P.in[I_F1UP] + (size_t)l * DM * 2 * FF, DM, 2 * FF, (bf16*)(ws + ((l & 1) ? WS_WUP1B : WS_WUP1)), 2 * FF, 1, gw, ngw, lane, scr, P.in[I_F1N] + l * DM);
}
__device__ __forceinline__ void cvt_rest(const Params& P, int l, unsigned char* ldsg) {
    STAGE_IDS
    unsigned char* ws = P.ws; float* scr = (float*)(ldsg + wave * 8448);
    cvt_wt(P.in[I_F1DN] + (size_t)l * FF * DM, FF, DM, (bf16*)(ws + WS_WDN1), DM, 0, gw, ngw, lane, scr);
    cvt_wt(P.in[I_WIN] + (size_t)l * DM * 6528, DM, 6528, (bf16*)(ws + WS_WIN), 3584, 2, gw, ngw, lane, scr, P.in[I_MIXN] + l * DM);
    cvt_wt(P.in[I_WIN] + (size_t)l * DM * 6528, DM, 6528, (bf16*)(ws + WS_WG), 3072, 3, gw, ngw, lane, scr, P.in[I_MIXN] + l * DM);
    cvt_wt(P.in[I_WOA] + (size_t)l * 512 * DM, 512, DM, (bf16*)(ws + WS_WO), DM, 0, gw, ngw, lane, scr);
    cvt_wt(P.in[I_WOB] + (size_t)l * 512 * DM, 512, DM, (bf16*)(ws + WS_WO) + (size_t)DM * 512, DM, 0, gw, ngw, lane, scr);
    cvt_wt(P.in[I_WOC] + (size_t)l * 512 * DM, 512, DM, (bf16*)(ws + WS_WO) + (size_t)2 * DM * 512, DM, 0, gw, ngw, lane, scr);
    cvt_wt(P.in[I_WOUT] + (size_t)l * DM * DM, DM, DM, (bf16*)(ws + WS_WOUT), DM, 0, gw, ngw, lane, scr);
    cvt_wt(P.in[I_F2UP] + (size_t)l * DM * 2 * FF, DM, 2 * FF, (bf16*)(ws + WS_WUP2), 2 * FF, 1, gw, ngw, lane, scr, P.in[I_F2N] + l * DM);
    cvt_wt(P.in[I_F2DN] + (size_t)l * FF * DM, FF, DM, (bf16*)(ws + WS_WDN2), DM, 0, gw, ngw, lane, scr);
}
__device__ __forceinline__ void x_to_bf16_ss(const float* x, bf16* o, float* SS) {
    STAGE_IDS
    for (int m = gw; m < T_; m += ngw) {
        const f4* xr = (const f4*)(x + (size_t)m * DM) + lane; f4 v[4]; float s = 0.f;
#pragma unroll
        for (int j = 0; j < 4; ++j) { v[j] = xr[64 * j]; s += (v[j].x * v[j].x + v[j].y * v[j].y) + (v[j].z * v[j].z + v[j].w * v[j].w); }
        s = wave_sum(s);
        v2u* op = (v2u*)(o + (size_t)m * DM) + lane;
#pragma unroll
        for (int j = 0; j < 4; ++j) { v2u w; w.x = pk2(v[j].x, v[j].y); w.y = pk2(v[j].z, v[j].w); op[64 * j] = w; }
        if (lane < 16) SS[(size_t)m * 16 + lane] = lane == 0 ? s : 0.f;
    }
}

__device__ __forceinline__ void rms_rows_f32_inplace(float* x, const float* g) {
    STAGE_IDS
    const f4* gr = (const f4*)g + lane; f4 gv[4];
#pragma unroll
    for (int j = 0; j < 4; ++j) gv[j] = gr[64 * j];
    for (int m = gw; m < T_; m += ngw) {
        f4* xr = (f4*)(x + (size_t)m * DM) + lane; f4 v[4]; float s = 0.f;
#pragma unroll
        for (int j = 0; j < 4; ++j) { v[j] = xr[64 * j]; s += (v[j].x * v[j].x + v[j].y * v[j].y) + (v[j].z * v[j].z + v[j].w * v[j].w); }
        const float rs = 1.0f / sqrtf(wave_sum(s) * (1.0f / DM) + 1e-6f);
#pragma unroll
        for (int j = 0; j < 4; ++j) xr[64 * j] = v[j] * rs * gv[j];
    }
}

__device__ __forceinline__ float fast_sin_rev(float rev) { return __builtin_amdgcn_sinf(__builtin_amdgcn_fractf(rev)); }
__device__ __forceinline__ float fast_cos_rev(float rev) { return __builtin_amdgcn_cosf(__builtin_amdgcn_fractf(rev)); }
__device__ __forceinline__ void qkprep(const Params& P, int l, bool dummy = false) {
    STAGE_IDS
    unsigned char* ws = P.ws;
    bf16* QB = (bf16*)(ws + WS_QB); const bf16* KVB = (const bf16*)(ws + WS_KVB); bf16* QC = (bf16*)(ws + WS_QC); const bf16* KVC = (const bf16*)(ws + WS_KVC);
    bf16* KG = (bf16*)(ws + WS_KG); bf16* KW = (bf16*)(ws + WS_KW);
    const float qg = P.in[I_QN][l * 64 + lane], kg = P.in[I_KN][l * 64 + lane];
    const float inv_ax = exp2f(-(float)(lane & 15) * (LOG2_THETA / 16.0f)), inv_1d = exp2f(-(float)(lane & 31) * (LOG2_THETA / 32.0f));
    const float INV2PI = 0.15915494309189535f;
    for (int t = gw; t < T_; t += ngw) {
        const int b = t >> 11, s = t & 2047;
        const float pos = lane < 32 ? (float)(s >> 6) : (float)(s & 63);
        const float ra = (pos * inv_ax) * INV2PI, r1 = ((float)s * inv_1d) * INV2PI;
        const float csa = fast_cos_rev(ra), sna = (lane & 16) ? fast_sin_rev(ra) : -fast_sin_rev(ra);
        const float cs1 = fast_cos_rev(r1), sn1 = (lane & 32) ? fast_sin_rev(r1) : -fast_sin_rev(r1);
#pragma unroll
        for (int slot = 0; slot < 10; ++slot) {
            bf16* src = slot < 8 ? QB + (size_t)t * 512 + slot * 64 : (bf16*)KVB + (size_t)t * 256 + (slot - 8) * 64;
            const float x = bf2f(src[lane]);
            const float ss = wave_sum(x * x) * (1.0f / 64.0f);
            const float y = x * (1.0f / sqrtf(ss + 1e-6f)) * (slot < 8 ? qg : kg);
            const float r = y * csa + __shfl_xor(y, 16) * sna;
            if (slot < 8) (dummy ? (bf16*)(ws + WS_YA) + (size_t)t * 512 + slot * 64 : src)[lane] = (bf16)f2bf(r * C2);
            else KG[((size_t)(b * 2 + (slot - 8)) * S_ + s) * 64 + lane] = (bf16)f2bf(r);
        }
#pragma unroll
        for (int slot = 0; slot < 10; ++slot) {
            bf16* src = slot < 8 ? QC + (size_t)t * 512 + slot * 64 : (bf16*)KVC + (size_t)t * 256 + (slot - 8) * 64;
            const float x = bf2f(src[lane]);
            const float r = x * cs1 + __shfl_xor(x, 32) * sn1;
            if (slot < 8) (dummy ? (bf16*)(ws + WS_YA) + (size_t)t * 512 + slot * 64 : src)[lane] = (bf16)f2bf(r * C2);
            else KW[((size_t)(b * 2 + (slot - 8)) * S_ + s) * 64 + lane] = (bf16)f2bf(r);
        }
    }
}

__device__ __forceinline__ void vt_prep(const Params& P, unsigned char* ldsg) {
    STAGE_IDS
    unsigned char* ws = P.ws;
    bf16* tile = (bf16*)(ldsg + wave * 8448);
    for (int it = gw; it < 2 * NB * 2 * 32; it += ngw) {
        const int tb = it & 31, kvh = (it >> 5) & 1, b = (it >> 6) & 15, att = it >> 10;
        const bf16* src = (const bf16*)(ws + (att ? WS_KVC : WS_KVB)) + (size_t)(b * S_ + tb * 64) * 256 + 128 + kvh * 64;
        bf16* dst = (bf16*)(ws + (att ? WS_VW : WS_VG)) + (size_t)(b * 2 + kvh) * 64 * S_ + tb * 64;
#pragma unroll 8
        for (int r = 0; r < 64; ++r) tile[r * 66 + lane] = src[(size_t)r * 256 + lane];
        asm volatile("s_waitcnt lgkmcnt(0)" ::: "memory");
#pragma unroll 8
        for (int d = 0; d < 64; ++d) dst[(size_t)d * S_ + lane] = tile[lane * 66 + d];
        asm volatile("s_waitcnt lgkmcnt(0)" ::: "memory");
    }
}

typedef short bf16x8_t __attribute__((ext_vector_type(8)));
typedef short s16x4_t __attribute__((ext_vector_type(4)));
typedef float f32x16 __attribute__((ext_vector_type(16)));
typedef float f32x2a __attribute__((ext_vector_type(2))); typedef __bf16 bf16x2a __attribute__((ext_vector_type(2)));
__device__ __forceinline__ unsigned cvtpk(float lo, float hi) { f32x2a v = {lo, hi}; bf16x2a b = __builtin_convertvector(v, bf16x2a); return __builtin_bit_cast(unsigned, b); }
__device__ __forceinline__ int crow(int r, int hi) { return (r & 3) + 8 * (r >> 2) + 4 * hi; }
template <bool WINDOW>
__device__ __forceinline__ void attn_mfma(bf16* Q, const bf16* Kx, const bf16* VTx, const float* sink, unsigned char* ldsg, bf16* Oalt = nullptr) {
    STAGE_IDS
    const int r32 = lane & 31, hi = lane >> 5, g = wave >> 1, qs = wave & 1;
    const int srow = tid >> 3, sch = tid & 7;
    for (int unit = blockIdx.x; unit < 1024; unit += gridDim.x) {
        const int qb = unit & 31, kvh = (unit >> 5) & 1, b = unit >> 6, h = kvh * 4 + g, q0 = qb * 64 + qs * 32;
        bf16* qp = Q + ((size_t)(b * S_ + q0 + r32)) * 512 + h * 64;
        bf16x8_t qr[4];
#pragma unroll
        for (int d0 = 0; d0 < 4; ++d0) qr[d0] = *(const bf16x8_t*)(qp + 16 * d0 + 8 * hi);
        f32x16 o0, o1;
#pragma unroll
        for (int r = 0; r < 16; ++r) { o0[r] = 0.f; o1[r] = 0.f; }
        float m, l;
        if (WINDOW) { m = sink[h] * LOG2E; l = hi == 0 ? 1.0f : 0.f; } else { m = -1e30f; l = 0.f; }
        const int t0 = WINDOW ? (qb - 2 > 0 ? qb - 2 : 0) : 0, t1 = WINDOW ? (qb + 2 < 31 ? qb + 2 : 31) : 31;
        const bf16* kbase = Kx + (size_t)(b * 2 + kvh) * S_ * 64 + (size_t)srow * 64 + sch * 8;
        const bf16* vbase = VTx + (size_t)(b * 2 + kvh) * 64 * S_ + (size_t)srow * S_ + sch * 8;
        v4u kreg = *(const v4u*)(kbase + (size_t)t0 * 64 * 64);
        v4u vreg = *(const v4u*)(vbase + t0 * 64);
        __syncthreads();
        *(v4u*)(ldsg + srow * 144 + sch * 16) = kreg;
        *(v4u*)(ldsg + 9216 + srow * 144 + sch * 16) = vreg;
        __syncthreads();
        for (int t = t0; t <= t1; ++t) {
            const int buf = (t - t0) & 1;
            if (t < t1) { kreg = *(const v4u*)(kbase + (size_t)(t + 1) * 64 * 64); vreg = *(const v4u*)(vbase + (t + 1) * 64); }
            const unsigned char* Kb = ldsg + buf * 18432; const unsigned char* Vb = Kb + 9216;
            f32x16 p0, p1;
#pragma unroll
            for (int r = 0; r < 16; ++r) { p0[r] = 0.f; p1[r] = 0.f; }
#pragma unroll
            for (int d0 = 0; d0 < 4; ++d0) {
                const bf16x8_t a0 = *(const bf16x8_t*)(Kb + r32 * 144 + (16 * d0 + 8 * hi) * 2);
                const bf16x8_t a1 = *(const bf16x8_t*)(Kb + (32 + r32) * 144 + (16 * d0 + 8 * hi) * 2);
                p0 = __builtin_amdgcn_mfma_f32_32x32x16_bf16(a0, qr[d0], p0, 0, 0, 0);
                p1 = __builtin_amdgcn_mfma_f32_32x32x16_bf16(a1, qr[d0], p1, 0, 0, 0);
            }
            if (WINDOW) {
                const int qpos = q0 + r32;
#pragma unroll
                for (int r = 0; r < 16; ++r) { const int kv = t * 64 + crow(r, hi); int dlt = qpos - kv; dlt = dlt < 0 ? -dlt : dlt; if (dlt > 128) p0[r] = -1e30f;
                    int dl2 = qpos - (kv + 32); dl2 = dl2 < 0 ? -dl2 : dl2; if (dl2 > 128) p1[r] = -1e30f; }
            }
            float mt = fmaxf(p0[0], p1[0]);
#pragma unroll
            for (int r = 1; r < 16; ++r) mt = fmaxf(mt, fmaxf(p0[r], p1[r]));
            mt = fmaxf(mt, __shfl_xor(mt, 32));
            if (__any(mt > m)) {
                const float mn = fmaxf(m, mt), corr = __builtin_amdgcn_exp2f(m - mn); m = mn;
                l *= corr;
#pragma unroll
                for (int r = 0; r < 16; ++r) { o0[r] *= corr; o1[r] *= corr; }
            }
            float ps0 = 0.f, ps1 = 0.f;
#pragma unroll
            for (int r = 0; r < 16; ++r) { p0[r] = __builtin_amdgcn_exp2f(p0[r] - m); p1[r] = __builtin_amdgcn_exp2f(p1[r] - m); ps0 += p0[r]; ps1 += p1[r]; }
            l += ps0 + ps1;
            v4u pw[4];
            pw[0] = (v4u){cvtpk(p0[0], p0[1]), cvtpk(p0[2], p0[3]), cvtpk(p0[4], p0[5]), cvtpk(p0[6], p0[7])};
            pw[1] = (v4u){cvtpk(p0[8], p0[9]), cvtpk(p0[10], p0[11]), cvtpk(p0[12], p0[13]), cvtpk(p0[14], p0[15])};
            pw[2] = (v4u){cvtpk(p1[0], p1[1]), cvtpk(p1[2], p1[3]), cvtpk(p1[4], p1[5]), cvtpk(p1[6], p1[7])};
            pw[3] = (v4u){cvtpk(p1[8], p1[9]), cvtpk(p1[10], p1[11]), cvtpk(p1[12], p1[13]), cvtpk(p1[14], p1[15])};
#pragma unroll
            for (int kb = 0; kb < 4; ++kb) {
                const bf16x8_t pb = __builtin_bit_cast(bf16x8_t, pw[kb]);
                { const unsigned char* vp = Vb + r32 * 144 + (16 * kb + 4 * hi) * 2; const s16x4_t lo = *(const s16x4_t*)vp, hh = *(const s16x4_t*)(vp + 16);
                  const bf16x8_t a = (bf16x8_t){lo[0], lo[1], lo[2], lo[3], hh[0], hh[1], hh[2], hh[3]};
                  o0 = __builtin_amdgcn_mfma_f32_32x32x16_bf16(a, pb, o0, 0, 0, 0); }
                { const unsigned char* vp = Vb + (32 + r32) * 144 + (16 * kb + 4 * hi) * 2; const s16x4_t lo = *(const s16x4_t*)vp, hh = *(const s16x4_t*)(vp + 16);
                  const bf16x8_t a = (bf16x8_t){lo[0], lo[1], lo[2], lo[3], hh[0], hh[1], hh[2], hh[3]};
                  o1 = __builtin_amdgcn_mfma_f32_32x32x16_bf16(a, pb, o1, 0, 0, 0); }
            }
            if (t < t1) { unsigned char* nb = ldsg + (buf ^ 1) * 18432; *(v4u*)(nb + srow * 144 + sch * 16) = kreg; *(v4u*)(nb + 9216 + srow * 144 + sch * 16) = vreg; }
            __syncthreads();
        }
        l += __shfl_xor(l, 32);
        const float inv = 1.0f / l;
        if (Oalt) qp = Oalt + ((size_t)(b * S_ + q0 + r32)) * 512 + h * 64;
#pragma unroll
        for (int g4 = 0; g4 < 4; ++g4) {
            v2u w0, w1;
            w0.x = cvtpk(o0[4 * g4 + 0] * inv, o0[4 * g4 + 1] * inv); w0.y = cvtpk(o0[4 * g4 + 2] * inv, o0[4 * g4 + 3] * inv);
            w1.x = cvtpk(o1[4 * g4 + 0] * inv, o1[4 * g4 + 1] * inv); w1.y = cvtpk(o1[4 * g4 + 2] * inv, o1[4 * g4 + 3] * inv);
            *(v2u*)(qp + 8 * g4 + 4 * hi) = w0;
            *(v2u*)(qp + 32 + 8 * g4 + 4 * hi) = w1;
        }
    }
}

typedef float f8s __attribute__((ext_vector_type(8)));
typedef float f32x4m __attribute__((ext_vector_type(4)));
constexpr int SC_VEC = 0, SC_VS = 81920, SC_W2T = 98304, SC_A2T = 107520, SC_XCH = 116736, SC_YP = 124928, SC_A1 = SC_YP, SC_A2 = SC_YP + 9216, SC_AL = SC_YP + 18432, SC_CS = SC_AL + 16640, SC_END = SC_CS + 128;
static_assert(SC_END <= LDS_BYTES, "scan LDS");
__device__ __forceinline__ void ld8bf(const bf16* p, float (&f)[8]) { const v4u w = *(const v4u*)p;
    f[0] = __uint_as_float(w.x << 16); f[1] = __uint_as_float(w.x & 0xffff0000u); f[2] = __uint_as_float(w.y << 16); f[3] = __uint_as_float(w.y & 0xffff0000u);
    f[4] = __uint_as_float(w.z << 16); f[5] = __uint_as_float(w.z & 0xffff0000u); f[6] = __uint_as_float(w.w << 16); f[7] = __uint_as_float(w.w & 0xffff0000u); }
__device__ __forceinline__ void shifted8(const bf16* pc, int col, bool hasp, bool hasn, const float* mu, float (&o)[8]) {
    float c[8], p[8], n[8];
    ld8bf(pc + col, c);
    if (hasp) ld8bf(pc + col - 2048, p); else { for (int e = 0; e < 8; ++e) p[e] = 0.f; }
    if (hasn) ld8bf(pc + col + 2048, n); else { for (int e = 0; e < 8; ++e) n[e] = 0.f; }
    const f4 m0 = *(const f4*)(mu + col), m1 = *(const f4*)(mu + col + 4);
    const float mm[8] = {m0.x, m0.y, m0.z, m0.w, m1.x, m1.y, m1.z, m1.w};
#pragma unroll
    for (int e = 0; e < 8; ++e) o[e] = c[e] + mm[e] * (0.5f * (p[e] + n[e]) - c[e]);
}
struct Raw3 { v4u c, p, n; };
__device__ __forceinline__ void raw_load(Raw3& r, const bf16* pc, int col, bool hasp, bool hasn) {
    r.c = *(const v4u*)(pc + col);
    r.p = hasp ? *(const v4u*)(pc + col - 2048) : (v4u){0u, 0u, 0u, 0u};
    r.n = hasn ? *(const v4u*)(pc + col + 2048) : (v4u){0u, 0u, 0u, 0u};
}
__device__ __forceinline__ void un8(const v4u w, float (&f)[8]) {
    f[0] = __uint_as_float(w.x << 16); f[1] = __uint_as_float(w.x & 0xffff0000u); f[2] = __uint_as_float(w.y << 16); f[3] = __uint_as_float(w.y & 0xffff0000u);
    f[4] = __uint_as_float(w.z << 16); f[5] = __uint_as_float(w.z & 0xffff0000u); f[6] = __uint_as_float(w.w << 16); f[7] = __uint_as_float(w.w & 0xffff0000u); }
__device__ __forceinline__ void shift_raw(const Raw3& r, const float* mu, int col, float (&o)[8]) {
    float c[8], p[8], n[8]; un8(r.c, c); un8(r.p, p); un8(r.n, n);
    const f4 m0 = *(const f4*)(mu + col), m1 = *(const f4*)(mu + col + 4);
    const float mm[8] = {m0.x, m0.y, m0.z, m0.w, m1.x, m1.y, m1.z, m1.w};
#pragma unroll
    for (int e = 0; e < 8; ++e) o[e] = c[e] + mm[e] * (0.5f * (p[e] + n[e]) - c[e]);
}
__device__ __forceinline__ void scan_fast(const Params& P, int l, unsigned char* ldsg) {
    STAGE_IDS
    unsigned char* ws = P.ws;
    const bf16* PR = (const bf16*)(ws + WS_PR); float* BONUS = (float*)(ws + WS_BONUS);
    float* VEC = (float*)(ldsg + SC_VEC);
    const int fr = lane & 15, fq = lane >> 4, ps = tid >> 3, pcg = tid & 7;
    float* XCH = (float*)(ldsg + SC_XCH); float* YP = (float*)(ldsg + SC_YP); float* VS = (float*)(ldsg + SC_VS); float* AL = (float*)(ldsg + SC_AL);
    for (int sid = blockIdx.x; sid < 256; sid += gridDim.x) {
        const int dir = sid & 1, h = (sid >> 1) & 7, b = sid >> 4, hc0 = h * 64;
        bf16* WKV = (bf16*)(ws + (dir ? WS_WKVB : WS_WKVF));
        const float* mu = P.in[I_MU] + (size_t)l * 1920;
        __syncthreads();
        {
            const float* w2b = P.in[I_W2] + (size_t)(l * 2 + dir) * 64 * 512 + (size_t)ps * 512 + hc0 + 8 * pcg;
            const float* a2b = P.in[I_A2] + (size_t)(l * 2 + dir) * 64 * 512 + (size_t)ps * 512 + hc0 + 8 * pcg;
#pragma unroll
            for (int e = 0; e < 8; ++e) { ((bf16*)(ldsg + SC_W2T))[(8 * pcg + e) * 72 + ps] = (bf16)f2bf(w2b[e]); ((bf16*)(ldsg + SC_A2T))[(8 * pcg + e) * 72 + ps] = (bf16)f2bf(a2b[e]); }
        }
        float S[8];
#pragma unroll
        for (int j = 0; j < 8; ++j) S[j] = 0.f;
        Raw3 pre[5];
#pragma unroll 1
        for (int ch = 0; ch < S_ / 64; ++ch) {
            const int step0 = ch * 64;
            const int tp = dir ? S_ - 1 - (step0 + ps) : step0 + ps;
            const int cR = hc0 + 8 * pcg, cK = 512 + hc0 + 8 * pcg, cV = 1024 + hc0 + 8 * pcg, cW = 1536 + 64 * dir + 8 * pcg, cA = 1664 + 64 * dir + 8 * pcg;
            if (ch == 0) { const bf16* pc = PR + ((size_t)(b * S_ + tp)) * 2048; const bool hasp = tp > 0, hasn = tp < S_ - 1;
                raw_load(pre[0], pc, cR, hasp, hasn); raw_load(pre[1], pc, cK, hasp, hasn); raw_load(pre[2], pc, cV, hasp, hasn); raw_load(pre[3], pc, cW, hasp, hasn); raw_load(pre[4], pc, cA, hasp, hasn); }
            float r8[8], k8[8], v8[8];
            shift_raw(pre[0], mu, cR, r8);
            shift_raw(pre[1], mu, cK, k8);
            shift_raw(pre[2], mu, cV, v8);
            { float wl[8], al[8];
              shift_raw(pre[3], mu, cW, wl);
              shift_raw(pre[4], mu, cA, al);
#pragma unroll
              for (int e = 0; e < 8; ++e) { const float t2 = __builtin_amdgcn_exp2f(2.0f * LOG2E * wl[e]); wl[e] = (t2 - 1.0f) * __builtin_amdgcn_rcpf(t2 + 1.0f); }
              v4u w1, w2v; w1.x = cvtpk(wl[0], wl[1]); w1.y = cvtpk(wl[2], wl[3]); w1.z = cvtpk(wl[4], wl[5]); w1.w = cvtpk(wl[6], wl[7]);
              w2v.x = cvtpk(al[0], al[1]); w2v.y = cvtpk(al[2], al[3]); w2v.z = cvtpk(al[4], al[5]); w2v.w = cvtpk(al[6], al[7]);
              *(v4u*)(ldsg + SC_A1 + ps * 144 + pcg * 16) = w1; *(v4u*)(ldsg + SC_A2 + ps * 144 + pcg * 16) = w2v; }
            *(f4*)(VS + ps * 64 + 8 * pcg) = (f4){v8[0], v8[1], v8[2], v8[3]}; *(f4*)(VS + ps * 64 + 8 * pcg + 4) = (f4){v8[4], v8[5], v8[6], v8[7]};
            __syncthreads();
            {
                const int wq = wave & 3; const bool isw = wave < 4;
                const unsigned char* Ab = ldsg + (isw ? SC_A1 : SC_A2) + (16 * wq + fr) * 144 + 16 * fq;
                const unsigned char* Bb = ldsg + (isw ? SC_W2T : SC_A2T) + fr * 144 + 16 * fq;
                const bf16x8_t a0 = *(const bf16x8_t*)Ab, a1 = *(const bf16x8_t*)(Ab + 64);
                const float* bias = P.in[isw ? I_W0 : I_A0] + (size_t)(l * 2 + dir) * 512 + hc0;
#pragma unroll
                for (int n = 0; n < 4; ++n) {
                    const bf16x8_t b0 = *(const bf16x8_t*)(Bb + n * 16 * 144), b1 = *(const bf16x8_t*)(Bb + n * 16 * 144 + 64);
                    f32x4m acc = (f32x4m){0.f, 0.f, 0.f, 0.f};
                    acc = __builtin_amdgcn_mfma_f32_16x16x32_bf16(a0, b0, acc, 0, 0, 0);
                    acc = __builtin_amdgcn_mfma_f32_16x16x32_bf16(a1, b1, acc, 0, 0, 0);
                    const float bz = bias[16 * n + fr];
#pragma unroll
                    for (int v = 0; v < 4; ++v) {
                        const int st = 16 * wq + 4 * fq + v; const float x = acc[v] + bz;
                        if (isw) { const float sp = __builtin_amdgcn_logf(1.0f + __builtin_amdgcn_exp2f(-x * LOG2E)) * 0.6931471805599453f;
                                   const float wlog = -sp - 0.5f; VEC[st * 320 + (2 * n + (fr >> 3)) * 40 + (fr & 7)] = __builtin_amdgcn_exp2f(-__builtin_amdgcn_exp2f(wlog * LOG2E) * LOG2E); }
                        else AL[st * 65 + 16 * n + fr] = __builtin_amdgcn_rcpf(1.0f + __builtin_amdgcn_exp2f(-x * LOG2E));
                    }
                }
            }
            __syncthreads();
            {
                const float* kkp = P.in[I_KK] + l * 512 + hc0 + 8 * pcg; const float* kap = P.in[I_KA] + l * 512 + hc0 + 8 * pcg; const float* rkp = P.in[I_RK] + l * 512 + hc0 + 8 * pcg;
                float a8[8], kk[8], kd[8]; float ss = 0.f, bon = 0.f;
#pragma unroll
                for (int e = 0; e < 8; ++e) { a8[e] = AL[ps * 65 + 8 * pcg + e]; kk[e] = k8[e] * kkp[e]; ss += kk[e] * kk[e]; kd[e] = k8[e] * (1.0f + (a8[e] - 1.0f) * kap[e]); bon += r8[e] * kd[e] * rkp[e]; }
                ss += __shfl_xor(ss, 1); ss += __shfl_xor(ss, 2); ss += __shfl_xor(ss, 4);
                bon += __shfl_xor(bon, 1); bon += __shfl_xor(bon, 2); bon += __shfl_xor(bon, 4);
                const float rn = 1.0f / fmaxf(sqrtf(ss), 1e-12f);
                float* sp = VEC + ps * 320 + 40 * pcg;
                *(f4*)(sp + 8) = (f4){kd[0], kd[1], kd[2], kd[3]}; *(f4*)(sp + 12) = (f4){kd[4], kd[5], kd[6], kd[7]};
                *(f4*)(sp + 16) = (f4){-kk[0] * rn, -kk[1] * rn, -kk[2] * rn, -kk[3] * rn}; *(f4*)(sp + 20) = (f4){-kk[4] * rn, -kk[5] * rn, -kk[6] * rn, -kk[7] * rn};
                *(f4*)(sp + 24) = (f4){kk[0] * rn * a8[0], kk[1] * rn * a8[1], kk[2] * rn * a8[2], kk[3] * rn * a8[3]}; *(f4*)(sp + 28) = (f4){kk[4] * rn * a8[4], kk[5] * rn * a8[5], kk[6] * rn * a8[6], kk[7] * rn * a8[7]};
                *(f4*)(sp + 32) = (f4){r8[0], r8[1], r8[2], r8[3]}; *(f4*)(sp + 36) = (f4){r8[4], r8[5], r8[6], r8[7]};
                if (pcg == 0) BONUS[((size_t)((dir * NB + b) * 8 + h)) * S_ + tp] = bon;
            }
            asm volatile("s_waitcnt vmcnt(0) lgkmcnt(0)" ::: "memory");
            __syncthreads();
            {
                float* CS = (float*)(ldsg + SC_CS);
                const int p = tid >> 4, q = tid & 15;
                const float* b0 = VEC + (2 * p) * 320 + (q >> 1) * 40 + 24 + (q & 1) * 4; const float* n1 = VEC + (2 * p + 1) * 320 + (q >> 1) * 40 + 16 + (q & 1) * 4;
                float d = (b0[0] * n1[0] + b0[1] * n1[1]) + (b0[2] * n1[2] + b0[3] * n1[3]);
                d += __shfl_xor(d, 1); d += __shfl_xor(d, 2); d += __shfl_xor(d, 4); d += __shfl_xor(d, 8);
                if (q == 0) CS[p] = d;
            }
            asm volatile("s_waitcnt lgkmcnt(0)" ::: "memory");
            __syncthreads();
#define DPP_FMAC(acc, xs, val, N) asm("v_fmac_f32_dpp %0, %1, %2 row_newbcast:" #N " row_mask:0xf bank_mask:0xf" : "+v"(acc) : "v"(xs), "v"(val))
#define DPP_MUL(dst, xs, val, N) asm("v_mul_f32_dpp %0, %1, %2 row_newbcast:" #N " row_mask:0xf bank_mask:0xf" : "=v"(dst) : "v"(xs), "v"(val))
            if (ch + 1 < S_ / 64) { const int tn = dir ? S_ - 1 - (step0 + 64 + ps) : step0 + 64 + ps; const bf16* pc = PR + ((size_t)(b * S_ + tn)) * 2048; const bool hasp = tn > 0, hasn = tn < S_ - 1;
                raw_load(pre[0], pc, cR, hasp, hasn); raw_load(pre[1], pc, cK, hasp, hasn); raw_load(pre[2], pc, cV, hasp, hasn); raw_load(pre[3], pc, cW, hasp, hasn); raw_load(pre[4], pc, cA, hasp, hasn); }
            const float* vecb = VEC + wave * 40 + (lane & 15);
            const int o2 = 32 + (lane & 7) - (lane & 15);
            const float* CSr = (const float*)(ldsg + SC_CS);
#define R8(M) M(0) M(1) M(2) M(3) M(4) M(5) M(6) M(7)
#define R7(M) M(1) M(2) M(3) M(4) M(5) M(6) M(7)
            const int xslot = lane * 8 + ((wave + (lane >> 2)) & 7);
            float pm2 = 0.f;
            auto pair_steps = [&](const int t, float& x0, float& x1, float& x2, float& m0, float& m1, float& m2, const float va, const float vb) __attribute__((always_inline)) {
                const float Cc = CSr[t >> 1];
                asm volatile("s_nop 1" : "+v"(x0), "+v"(x1), "+v"(x2), "+v"(m0), "+v"(m1), "+v"(m2));
                float pa, pb, qa, qb, Tt[8];
                DPP_MUL(pa, x1, S[0], 0); DPP_MUL(pb, x1, S[1], 1);
                DPP_FMAC(pa, x1, S[2], 2); DPP_FMAC(pb, x1, S[3], 3); DPP_FMAC(pa, x1, S[4], 4); DPP_FMAC(pb, x1, S[5], 5); DPP_FMAC(pa, x1, S[6], 6); DPP_FMAC(pb, x1, S[7], 7);
#define M_T0(j) DPP_MUL(Tt[j], x0, S[j], j);
                R8(M_T0)
                DPP_FMAC(Tt[0], x0, va, 8); DPP_FMAC(Tt[1], x0, va, 9); DPP_FMAC(Tt[2], x0, va, 10); DPP_FMAC(Tt[3], x0, va, 11);
                DPP_FMAC(Tt[4], x0, va, 12); DPP_FMAC(Tt[5], x0, va, 13); DPP_FMAC(Tt[6], x0, va, 14); DPP_FMAC(Tt[7], x0, va, 15);
                DPP_MUL(qa, m1, Tt[0], 0); DPP_MUL(qb, m1, Tt[1], 1);
                DPP_FMAC(qa, m1, Tt[2], 2); DPP_FMAC(qb, m1, Tt[3], 3); DPP_FMAC(qa, m1, Tt[4], 4); DPP_FMAC(qb, m1, Tt[5], 5); DPP_FMAC(qa, m1, Tt[6], 6); DPP_FMAC(qb, m1, Tt[7], 7);
                const int par = (t >> 1) & 1;
                XCH[par * 1024 + xslot] = pa + pb; XCH[par * 1024 + 512 + xslot] = qa + qb;
                asm volatile("s_waitcnt lgkmcnt(0)\n\ts_barrier" ::: "memory");
                const f4* xp = (const f4*)(XCH + par * 1024 + lane * 8);
                const f4 e0 = xp[0], e1 = xp[1], g0 = xp[128], g1 = xp[129];
                if (t > 0) {
                    float yc, yd;
                    DPP_MUL(yc, pm2, S[0], 0); DPP_MUL(yd, pm2, S[1], 1);
                    DPP_FMAC(yc, pm2, S[2], 2); DPP_FMAC(yd, pm2, S[3], 3); DPP_FMAC(yc, pm2, S[4], 4); DPP_FMAC(yd, pm2, S[5], 5); DPP_FMAC(yc, pm2, S[6], 6); DPP_FMAC(yd, pm2, S[7], 7);
                    YP[((t - 1) & 15) * 512 + wave * 64 + lane] = yc + yd;
                    if ((t & 7) == 2 && t >= 10) {
                        const int sl = (t - 10) + wave;
                        const float* yp = YP + (sl & 15) * 512 + lane;
                        const float y0 = ((yp[0] + yp[64]) + (yp[128] + yp[192])) + ((yp[256] + yp[320]) + (yp[384] + yp[448]));
                        const int tt = dir ? S_ - 1 - (step0 + sl) : step0 + sl;
                        WKV[((size_t)(b * S_ + tt)) * 512 + hc0 + lane] = (bf16)f2bf(y0);
                    }
                }
                const f4 es = e0 + e1, gs = g0 + g1;
                float sa0 = (es.x + es.y) + (es.z + es.w);
                asm volatile("" : "+v"(sa0));
                const float p1s = (gs.x + gs.y) + (gs.z + gs.w);
                float sa1 = p1s + sa0 * Cc;
                DPP_FMAC(Tt[0], x1, sa0, 8); DPP_FMAC(Tt[1], x1, sa0, 9); DPP_FMAC(Tt[2], x1, sa0, 10); DPP_FMAC(Tt[3], x1, sa0, 11);
                DPP_FMAC(Tt[4], x1, sa0, 12); DPP_FMAC(Tt[5], x1, sa0, 13); DPP_FMAC(Tt[6], x1, sa0, 14); DPP_FMAC(Tt[7], x1, sa0, 15);
                float ya, yb;
                DPP_MUL(ya, x2, Tt[0], 0); DPP_MUL(yb, x2, Tt[1], 1);
                DPP_FMAC(ya, x2, Tt[2], 2); DPP_FMAC(yb, x2, Tt[3], 3); DPP_FMAC(ya, x2, Tt[4], 4); DPP_FMAC(yb, x2, Tt[5], 5); DPP_FMAC(ya, x2, Tt[6], 6); DPP_FMAC(yb, x2, Tt[7], 7);
                YP[(t & 15) * 512 + wave * 64 + lane] = ya + yb;
#define M_T1(j) DPP_MUL(S[j], m0, Tt[j], j);
                R8(M_T1)
                DPP_FMAC(S[0], m0, vb, 8); DPP_FMAC(S[1], m0, vb, 9); DPP_FMAC(S[2], m0, vb, 10); DPP_FMAC(S[3], m0, vb, 11);
                DPP_FMAC(S[4], m0, vb, 12); DPP_FMAC(S[5], m0, vb, 13); DPP_FMAC(S[6], m0, vb, 14); DPP_FMAC(S[7], m0, vb, 15);
                DPP_FMAC(S[0], m1, sa1, 8); DPP_FMAC(S[1], m1, sa1, 9); DPP_FMAC(S[2], m1, sa1, 10); DPP_FMAC(S[3], m1, sa1, 11);
                DPP_FMAC(S[4], m1, sa1, 12); DPP_FMAC(S[5], m1, sa1, 13); DPP_FMAC(S[6], m1, sa1, 14); DPP_FMAC(S[7], m1, sa1, 15);
                pm2 = m2;
            };
            float ax0 = vecb[0], ax1 = vecb[16], ax2 = vecb[o2], am0 = vecb[320], am1 = vecb[336], am2 = vecb[320 + o2], ava = VS[lane], avb = VS[64 + lane];
            float bx0, bx1, bx2, bm0, bm1, bm2, bva, bvb;
#pragma unroll 1
            for (int t = 0; t < 64; t += 4) {
                { const float* np_ = vecb + (t + 2) * 320; const float* nq_ = vecb + (t + 3) * 320;
                  bx0 = np_[0]; bx1 = np_[16]; bx2 = np_[o2]; bm0 = nq_[0]; bm1 = nq_[16]; bm2 = nq_[o2]; bva = VS[(t + 2) * 64 + lane]; bvb = VS[(t + 3) * 64 + lane]; }
                pair_steps(t, ax0, ax1, ax2, am0, am1, am2, ava, avb);
                { const float* np_ = vecb + ((t + 4) & 63) * 320; const float* nq_ = vecb + ((t + 5) & 63) * 320;
                  ax0 = np_[0]; ax1 = np_[16]; ax2 = np_[o2]; am0 = nq_[0]; am1 = nq_[16]; am2 = nq_[o2]; ava = VS[((t + 4) & 63) * 64 + lane]; avb = VS[((t + 5) & 63) * 64 + lane]; }
                pair_steps(t + 2, bx0, bx1, bx2, bm0, bm1, bm2, bva, bvb);
            }
            {
                asm volatile("s_nop 1" : "+v"(pm2));
                float yc, yd;
                DPP_MUL(yc, pm2, S[0], 0); DPP_MUL(yd, pm2, S[1], 1);
                DPP_FMAC(yc, pm2, S[2], 2); DPP_FMAC(yd, pm2, S[3], 3); DPP_FMAC(yc, pm2, S[4], 4); DPP_FMAC(yd, pm2, S[5], 5); DPP_FMAC(yc, pm2, S[6], 6); DPP_FMAC(yd, pm2, S[7], 7);
                YP[(63 & 15) * 512 + wave * 64 + lane] = yc + yd;
                asm volatile("s_waitcnt lgkmcnt(0)\n\ts_barrier" ::: "memory");
                {
                    const int sl = 56 + wave;
                    const float* yp = YP + (sl & 15) * 512 + lane;
                    const float y0 = ((yp[0] + yp[64]) + (yp[128] + yp[192])) + ((yp[256] + yp[320]) + (yp[384] + yp[448]));
                    const int tt = dir ? S_ - 1 - (step0 + sl) : step0 + sl;
                    WKV[((size_t)(b * S_ + tt)) * 512 + hc0 + lane] = (bf16)f2bf(y0);
                }
            }
#undef R7
#undef M_T0
#undef M_T1
#undef R8
#undef DPP_FMAC
#undef DPP_MUL
            __syncthreads();
        }
    }
}

__device__ __forceinline__ void finalize_fast(const Params& P, int l, unsigned char* ldsg) {
    STAGE_IDS
    unsigned char* ws = P.ws;
    const bf16* PR = (const bf16*)(ws + WS_PR); const bf16* WF = (const bf16*)(ws + WS_WKVF); const bf16* WBk = (const bf16*)(ws + WS_WKVB); const float* BONUS = (const float*)(ws + WS_BONUS);
    bf16* YA = (bf16*)(ws + WS_YA);
    const int fr = lane & 15, fq = lane >> 4;
    const float* mu = P.in[I_MU] + (size_t)l * 1920; const float* g2 = P.in[I_G2] + (size_t)l * 128 * 512;
    const float* lngp = P.in[I_LNG] + l * 512; const float* lnbp = P.in[I_LNB] + l * 512;
    bf16x8_t gf[4][4];
#pragma unroll
    for (int n = 0; n < 4; ++n)
#pragma unroll
        for (int ks = 0; ks < 4; ++ks) { float gv[8];
#pragma unroll
            for (int e = 0; e < 8; ++e) gv[e] = g2[(size_t)(32 * ks + 8 * fq + e) * 512 + 64 * wave + 16 * n + fr];
            const v4u w = (v4u){cvtpk(gv[0], gv[1]), cvtpk(gv[2], gv[3]), cvtpk(gv[4], gv[5]), cvtpk(gv[6], gv[7])};
            gf[n][ks] = __builtin_bit_cast(bf16x8_t, w); }
    for (int tile = blockIdx.x; tile < T_ / 32; tile += gridDim.x) {
        const int t0 = tile * 32;
        __syncthreads();
        { const int tok = tid >> 4, mg = tid & 15, t = t0 + tok, s = t & 2047; float x[8];
          shifted8(PR + (size_t)t * 2048, 1792 + 8 * mg, s > 0, s < S_ - 1, mu, x);
#pragma unroll
          for (int e = 0; e < 8; ++e) x[e] = __builtin_amdgcn_rcpf(1.0f + __builtin_amdgcn_exp2f(-x[e] * LOG2E));
          *(v4u*)(ldsg + tok * 272 + mg * 16) = (v4u){cvtpk(x[0], x[1]), cvtpk(x[2], x[3]), cvtpk(x[4], x[5]), cvtpk(x[6], x[7])}; }
        __syncthreads();
#pragma unroll
        for (int mt = 0; mt < 2; ++mt) {
            f32x4m acc[4];
#pragma unroll
            for (int n = 0; n < 4; ++n) acc[n] = (f32x4m){0.f, 0.f, 0.f, 0.f};
#pragma unroll
            for (int ks = 0; ks < 4; ++ks) { const bf16x8_t bb = *(const bf16x8_t*)(ldsg + (16 * mt + fr) * 272 + (32 * ks + 8 * fq) * 2);
#pragma unroll
                for (int n = 0; n < 4; ++n) acc[n] = __builtin_amdgcn_mfma_f32_16x16x32_bf16(gf[n][ks], bb, acc[n], 0, 0, 0); }
            const int t = t0 + 16 * mt + fr, s = t & 2047, bb_ = t >> 11;
            float wk[4][4]; float sm = 0.f;
#pragma unroll
            for (int n = 0; n < 4; ++n) { const int c0 = 64 * wave + 16 * n + 4 * fq;
                const v2u a = *(const v2u*)(WF + (size_t)t * 512 + c0), b2 = *(const v2u*)(WBk + (size_t)t * 512 + c0);
                wk[n][0] = __uint_as_float(a.x << 16) + __uint_as_float(b2.x << 16); wk[n][1] = __uint_as_float(a.x & 0xffff0000u) + __uint_as_float(b2.x & 0xffff0000u);
                wk[n][2] = __uint_as_float(a.y << 16) + __uint_as_float(b2.y << 16); wk[n][3] = __uint_as_float(a.y & 0xffff0000u) + __uint_as_float(b2.y & 0xffff0000u);
                sm += (wk[n][0] + wk[n][1]) + (wk[n][2] + wk[n][3]); }
            sm += __shfl_xor(sm, 16); sm += __shfl_xor(sm, 32);
            const float mean = sm * (1.0f / 64.0f); float sq = 0.f;
#pragma unroll
            for (int n = 0; n < 4; ++n)
#pragma unroll
                for (int v = 0; v < 4; ++v) { wk[n][v] -= mean; sq += wk[n][v] * wk[n][v]; }
            sq += __shfl_xor(sq, 16); sq += __shfl_xor(sq, 32);
            const float rstd = 1.0f / sqrtf(sq * (1.0f / 64.0f) + 64e-5f);
            const float bon = BONUS[((size_t)(bb_ * 8 + wave)) * S_ + s] + BONUS[((size_t)((NB + bb_) * 8 + wave)) * S_ + s];
            const bf16* pc = PR + (size_t)t * 2048;
#pragma unroll
            for (int n = 0; n < 4; ++n) { const int c0 = 64 * wave + 16 * n + 4 * fq;
                const f4 lg = *(const f4*)(lngp + c0), lb = *(const f4*)(lnbp + c0), mv = *(const f4*)(mu + 1024 + c0);
                const v2u vc = *(const v2u*)(pc + 1024 + c0);
                v2u vp = (v2u){0u, 0u}, vn = (v2u){0u, 0u};
                if (s > 0) vp = *(const v2u*)(pc + 1024 + c0 - 2048);
                if (s < S_ - 1) vn = *(const v2u*)(pc + 1024 + c0 + 2048);
                const float cc[4] = {__uint_as_float(vc.x << 16), __uint_as_float(vc.x & 0xffff0000u), __uint_as_float(vc.y << 16), __uint_as_float(vc.y & 0xffff0000u)};
                const float pp[4] = {__uint_as_float(vp.x << 16), __uint_as_float(vp.x & 0xffff0000u), __uint_as_float(vp.y << 16), __uint_as_float(vp.y & 0xffff0000u)};
                const float nn[4] = {__uint_as_float(vn.x << 16), __uint_as_float(vn.x & 0xffff0000u), __uint_as_float(vn.y << 16), __uint_as_float(vn.y & 0xffff0000u)};
                float yv[4];
#pragma unroll
                for (int v = 0; v < 4; ++v) { const float vs = cc[v] + mv[v] * (0.5f * (pp[v] + nn[v]) - cc[v]);
                    yv[v] = (wk[n][v] * rstd * lg[v] + lb[v] + bon * vs) * acc[n][v]; }
                *(v2u*)(YA + (size_t)t * 512 + c0) = (v2u){cvtpk(yv[0], yv[1]), cvtpk(yv[2], yv[3])}; }
        }
    }
}

#define GRID_SYNC_CG() do { asm volatile("s_waitcnt vmcnt(0) lgkmcnt(0)" ::: "memory"); grid.sync(); __builtin_amdgcn_fence(__ATOMIC_ACQUIRE, "agent"); asm volatile("s_waitcnt vmcnt(0)" ::: "memory"); } while (0)
#define GRID_SYNC() grid_barrier(gbar, ground)
#define GEMM_PHASE(EPI, A_, Bt_, M_, N_, K_, E_) do { pg8::Gemm g_{(const pg8::bf16_t*)(A_), (const pg8::bf16_t*)(Bt_), (M_), (N_), (K_)}; pg8::StaticOrder S_o; S_o.init((M_), (N_), (int)gridDim.x, (int)blockIdx.x); \
    pg8::gemm_phase<EPI, pg8::StaticOrder, true, true>((PG8_LAS unsigned char*)lds, g_, S_o, (E_)); } while (0)

__device__ __forceinline__ void rs_rows(const float* SS, float* RS) {
    STAGE_IDS
    for (int row = gtid; row < T_; row += gthreads) {
        const f4 a = *(const f4*)(SS + (size_t)row * 16), b2 = *(const f4*)(SS + (size_t)row * 16 + 4), c2 = *(const f4*)(SS + (size_t)row * 16 + 8), d = *(const f4*)(SS + (size_t)row * 16 + 12);
        const float s = ((a.x + a.y) + (a.z + a.w)) + ((b2.x + b2.y) + (b2.z + b2.w)) + ((c2.x + c2.y) + (c2.z + c2.w)) + ((d.x + d.y) + (d.z + d.w));
        RS[row] = 1.0f / sqrtf(s * (1.0f / 1024.0f) + 1e-6f);
    }
}
__device__ __forceinline__ void grid_barrier(unsigned* bar, unsigned& round) {
    asm volatile("s_waitcnt vmcnt(0) lgkmcnt(0)" ::: "memory");
    __syncthreads();
    ++round;
    if (threadIdx.x == 0) {
        __builtin_amdgcn_fence(__ATOMIC_RELEASE, "agent");
        asm volatile("s_waitcnt vmcnt(0)" ::: "memory");
        const unsigned g = blockIdx.x & 7u, G = gridDim.x, ng = (G + 7u - g) >> 3, ngroups = G < 8u ? G : 8u;
        const unsigned old = __hip_atomic_fetch_add(bar + 64 * (1 + g), 1u, __ATOMIC_RELAXED, __HIP_MEMORY_SCOPE_AGENT);
        if (old + 1u == round * ng) {
            const unsigned old2 = __hip_atomic_fetch_add(bar + 64 * 9, 1u, __ATOMIC_RELAXED, __HIP_MEMORY_SCOPE_AGENT);
            if (old2 + 1u == round * ngroups) __hip_atomic_store(bar, round, __ATOMIC_RELAXED, __HIP_MEMORY_SCOPE_AGENT);
        }
        unsigned spins = 0;
        while (__hip_atomic_load(bar, __ATOMIC_RELAXED, __HIP_MEMORY_SCOPE_AGENT) < round) { __builtin_amdgcn_s_sleep(1); if (++spins > (1u << 24)) break; }
        __builtin_amdgcn_fence(__ATOMIC_ACQUIRE, "agent");
        asm volatile("s_waitcnt vmcnt(0)" ::: "memory");
    }
    __syncthreads();
}
__global__ void __launch_bounds__(NTHREADS, 2) fwd_kernel(Params P) {
    extern __shared__ __attribute__((aligned(16))) unsigned char lds[];
    cg::grid_group grid = cg::this_grid();
    unsigned char* ws = P.ws;
    bf16* H = (bf16*)(ws + WS_H); bf16* ACT = (bf16*)(ws + WS_ACT);
    float* SSB = (float*)(ws + WS_SS); float* RSB = (float*)(ws + WS_RS);
    unsigned* gbar = (unsigned*)(ws + WS_BAR); unsigned ground = 0;
    cvt_up1(P, 0, lds);
    x_to_bf16_ss(P.in[I_X], H, SSB);
    if (P.ws == nullptr) GRID_SYNC_CG();
    GRID_SYNC();
#pragma unroll 1
    for (int l = 0; l < NL; ++l) {
        const float* xin = (l == 0) ? P.in[I_X] : P.out;
        rs_rows(SSB, RSB);
        cvt_rest(P, l, lds);
        __syncthreads();
        GRID_SYNC();
        { pg8::EpiSwiglu E{(pg8::bf16_t*)ACT, FF, RSB}; GEMM_PHASE(pg8::EpiSwiglu, H, ws + ((l & 1) ? WS_WUP1B : WS_WUP1), T_, 2 * FF, DM, E); }
        GRID_SYNC();
        { pg8::EpiResid E{xin, P.out, DM, 0.5f, (pg8::bf16_t*)H, SSB}; GEMM_PHASE(pg8::EpiResid, ACT, ws + WS_WDN1, T_, DM, FF, E); }
        GRID_SYNC();
        rs_rows(SSB, RSB);
        GRID_SYNC();
        { pg8::EpiWin E{(pg8::bf16_t*)(ws + WS_PR), (pg8::bf16_t*)(ws + WS_QB), (pg8::bf16_t*)(ws + WS_KVB), (pg8::bf16_t*)(ws + WS_QC), (pg8::bf16_t*)(ws + WS_KVC), RSB};
          GEMM_PHASE(pg8::EpiWin, H, ws + WS_WIN, T_, 3584, DM, E); }
        GRID_SYNC();
        qkprep(P, l);
        vt_prep(P, lds);
        __syncthreads();
        scan_fast(P, l, lds);
        GRID_SYNC();
        attn_mfma<false>((bf16*)(ws + WS_QB), (const bf16*)(ws + WS_KG), (const bf16*)(ws + WS_VG), nullptr, lds);
        attn_mfma<true>((bf16*)(ws + WS_QC), (const bf16*)(ws + WS_KW), (const bf16*)(ws + WS_VW), P.in[I_SINK] + l * 8, lds);
        __syncthreads();
        finalize_fast(P, l, lds);
        GRID_SYNC();
#pragma unroll 1
        for (int i = 0; i < 3; ++i) {
            { pg8::EpiGate E{(pg8::bf16_t*)(ws + WS_GATE), RSB}; GEMM_PHASE(pg8::EpiGate, H, ws + WS_WG + (size_t)i * DM * DM * 2, T_, DM, DM, E); }
            const unsigned char* yi = ws + (i == 0 ? WS_YA : (i == 1 ? WS_QB : WS_QC));
            { pg8::EpiMerge E{(const pg8::bf16_t*)(ws + WS_GATE), (pg8::bf16_t*)(ws + WS_MERGED), i == 0 ? 1 : 0}; GEMM_PHASE(pg8::EpiMerge, yi, ws + WS_WO + (size_t)i * DM * 512 * 2, T_, DM, 512, E); }
        }
        GRID_SYNC();
        { pg8::EpiResid E{P.out, P.out, DM, 1.0f, (pg8::bf16_t*)H, SSB}; GEMM_PHASE(pg8::EpiResid, ws + WS_MERGED, ws + WS_WOUT, T_, DM, DM, E); }
        GRID_SYNC();
        rs_rows(SSB, RSB);
        GRID_SYNC();
        { pg8::EpiSwiglu E{(pg8::bf16_t*)ACT, FF, RSB}; GEMM_PHASE(pg8::EpiSwiglu, H, ws + WS_WUP2, T_, 2 * FF, DM, E); }
        GRID_SYNC();
        if (l + 1 < NL) { cvt_up1(P, l + 1, lds); __syncthreads(); }
        { pg8::EpiResid E{P.out, P.out, DM, 0.5f, (pg8::bf16_t*)H, SSB}; GEMM_PHASE(pg8::EpiResid, ACT, ws + WS_WDN2, T_, DM, FF, E); }
        GRID_SYNC();
    }
    rms_rows_f32_inplace(P.out, P.in[I_FINN]);
}

extern "C" void kernel_launch(void* const* d_in, const int* in_sizes, int n_in, void* d_out, int out_size, void* d_ws, size_t ws_size, hipStream_t stream) {
    static int grid_blocks = 0;
    if (grid_blocks == 0) {
        if (n_in != N_IN || out_size != T_ * DM || ws_size < WS_END) { fprintf(stderr, "kernel_launch: unexpected shapes (n_in %d, out %d, ws %zu < %zu)\n", n_in, out_size, ws_size, (size_t)WS_END); grid_blocks = -1; return; }
        int dev = 0, cus = 0, per_cu = 0;
        hipGetDevice(&dev);
        hipDeviceGetAttribute(&cus, hipDeviceAttributeMultiprocessorCount, dev);
        hipFuncSetAttribute((const void*)fwd_kernel, hipFuncAttributeMaxDynamicSharedMemorySize, LDS_BYTES);
        hipOccupancyMaxActiveBlocksPerMultiprocessor(&per_cu, (const void*)fwd_kernel, NTHREADS, LDS_BYTES);
        if (per_cu < 1) per_cu = 1;
        grid_blocks = cus * per_cu;
    }
    if (grid_blocks < 0) return;
    Params p{};
    for (int i = 0; i < N_IN; ++i) p.in[i] = (const float*)d_in[i];
    p.out = (float*)d_out; p.ws = (unsigned char*)d_ws;
    if (hipMemsetAsync((char*)d_ws + WS_BAR, 0, 4096, stream) != hipSuccess) { fprintf(stderr, "kernel_launch: hipMemsetAsync failed\n"); return; }
    void* args[] = {&p};
    hipError_t e = hipLaunchCooperativeKernel((const void*)fwd_kernel, dim3(grid_blocks), dim3(NTHREADS), args, LDS_BYTES, stream);
    if (e != hipSuccess) fprintf(stderr, "cooperative launch failed: %s (grid %d)\n", hipGetErrorString(e), grid_blocks);
}
```
